# Optimizing an MI355X kernel written in HIP

```python
import math
import numpy as np
import jax
import jax.numpy as jnp
from jax import lax

D_MODEL = 1024
BATCH = 16
SEQ = 2048
DEPTH = 4

CTX_LEN = 256
GRID_W = 64
HEAD_DIM = 64
ROPE_FREQS = HEAD_DIM // 4
ROPE_THETA = 10000.0
Q_BLOCK = 128
EPS = 1e-6
MOD_SCALE = 0.02

A_HEADS = 4
A_VDIM = 2 * HEAD_DIM
B_HEADS = 4
B_DK = 64
B_DV = 128
GATE_RANK = 16
GATE_TAU = 16.0
GLA_CHUNK = 64
EVEN_SPLITS = (A_HEADS * 2 * HEAD_DIM, A_HEADS * 2 * HEAD_DIM, A_HEADS * A_VDIM,
               B_HEADS * B_DK, B_HEADS * B_DK, B_HEADS * B_DV, B_HEADS * B_DV,
               GATE_RANK, GATE_RANK)
EVEN_IN = sum(EVEN_SPLITS)
EVEN_MIX = A_HEADS * A_VDIM + B_HEADS * B_DV

C_Q_HEADS = 16
C_KV_HEADS = 4
C_GROUP = C_Q_HEADS // C_KV_HEADS
ODD_SPLITS = (C_Q_HEADS * HEAD_DIM, C_KV_HEADS * HEAD_DIM, C_KV_HEADS * HEAD_DIM)
ODD_IN = sum(ODD_SPLITS)
C_WIDTH = C_Q_HEADS * HEAD_DIM

PEER_HEADS = 8
PEER_NKEYS = 128
PEER_EXPERTS = PEER_NKEYS * PEER_NKEYS
PEER_DK = 128
PEER_TOPK = 16
PEER_CHUNK = 128
PEER_V_SCALE = PEER_HEADS ** -0.5

N_EVEN = (DEPTH + 1) // 2
N_ODD = DEPTH // 2

kernel_name = 'hybrid_diffattn_gla_gqa_peer_dit'


def rms_norm(x, g):
    xf = x.astype(jnp.float32)
    y = xf * lax.rsqrt(jnp.mean(xf * xf, axis=-1, keepdims=True) + EPS)
    return (y * g.astype(jnp.float32)).astype(x.dtype)


def modulate(h, shift, scale):
    return h * (1.0 + scale) + shift


def _split(p, sizes):
    return jnp.split(p, np.cumsum(sizes)[:-1].tolist(), axis=-1)


def _heads(t, n, d):
    b, l, _ = t.shape
    return t.reshape(b, l, n, d).transpose(0, 2, 1, 3)


def _merge(t):
    b, n, l, d = t.shape
    return t.transpose(0, 2, 1, 3).reshape(b, l, n * d)


def _flip(t):
    return jnp.flip(t, axis=2)


def axial_rope_tables(n_tokens):
    rows = n_tokens // GRID_W
    row = jnp.repeat(jnp.arange(rows, dtype=jnp.float32), GRID_W)
    col = jnp.tile(jnp.arange(GRID_W, dtype=jnp.float32), rows)
    inv_freq = ROPE_THETA ** (-jnp.arange(ROPE_FREQS, dtype=jnp.float32) / ROPE_FREQS)
    ang = jnp.stack([row, col], axis=-1)[:, :, None] * inv_freq
    return jnp.cos(ang), jnp.sin(ang)


def apply_axial_rope(t, cos, sin):
    ts = t.reshape(t.shape[:-1] + (2, 2, ROPE_FREQS))
    t1, t2 = ts[..., 0, :], ts[..., 1, :]
    cos = cos.astype(t.dtype)
    sin = sin.astype(t.dtype)
    return jnp.stack([t1 * cos - t2 * sin, t2 * cos + t1 * sin], axis=-2).reshape(t.shape)


def sweep_query_blocks(fn, q, axis):
    nb = q.shape[axis] // Q_BLOCK
    qb = q.reshape(q.shape[:axis] + (nb, Q_BLOCK) + q.shape[axis + 1:])
    ob = lax.map(fn, jnp.moveaxis(qb, axis, 0))
    ob = jnp.moveaxis(ob, 0, axis)
    return ob.reshape(ob.shape[:axis] + (nb * Q_BLOCK,) + ob.shape[axis + 2:])


def diff_attend(q, k, v, lam):
    s = jnp.einsum('bhqmd,bhmkd->bhmqk', q, k).astype(jnp.float32) * HEAD_DIM ** -0.5
    p = jax.nn.softmax(s, axis=-1)
    w = p[:, :, 0] - lam * p[:, :, 1]
    return jnp.einsum('bhqk,bhkv->bhqv', w.astype(v.dtype), v)


def gqa_attend(q, k, v):
    s = jnp.einsum('bkgqd,bkld->bkgql', q, k).astype(jnp.float32) * HEAD_DIM ** -0.5
    p = jax.nn.softmax(s, axis=-1)
    return jnp.einsum('bkgql,bkld->bkgqd', p.astype(v.dtype), v)


def gla_chunked(q, k, v, log_a, h0):
    b, h, l, dk = q.shape
    dv = v.shape[-1]
    nc = l // GLA_CHUNK
    q, k, log_a = (t.reshape(b, h, nc, GLA_CHUNK, dk) for t in (q, k, log_a))
    v = v.reshape(b, h, nc, GLA_CHUNK, dv)
    cum = jnp.cumsum(log_a, axis=3)
    last = cum[:, :, :, -1:, :]
    q_dec = q * jnp.exp(cum)
    k_inv = k * jnp.exp(-cum)
    k_end = k * jnp.exp(last - cum)
    tri = jnp.tril(jnp.ones((GLA_CHUNK, GLA_CHUNK), dtype=bool))
    a = jnp.where(tri, jnp.einsum('bhncd,bhnsd->bhncs', q_dec, k_inv), 0.0)
    o_intra = jnp.einsum('bhncs,bhnsv->bhncv', a, v)
    d_state = jnp.einsum('bhncd,bhncv->bhndv', k_end, v)
    decay = jnp.exp(last[:, :, :, 0, :])

    def step(state, inp):
        g, ds = inp
        return g[..., None] * state + ds, state

    h_fin, h_in = lax.scan(step, h0, (jnp.moveaxis(decay, 2, 0), jnp.moveaxis(d_state, 2, 0)))
    o_inter = jnp.einsum('bhncd,bhndv->bhncv', q_dec, jnp.moveaxis(h_in, 0, 2))
    return (o_intra + o_inter).reshape(b, h, l, dv), h_fin


def even_mixer(a_x, a_c, cos, sin, w_in, w_out, q_gain, k_gain, lam_vec, subln,
               w_af, b_af, w_ab, b_ab, gla_gain, lam_init, need_ctx):
    b = a_x.shape[0]
    px = _split(a_x @ w_in, EVEN_SPLITS)
    pc = _split(a_c @ w_in, EVEN_SPLITS)
    lv = lam_vec.astype(jnp.float32)
    lam = jnp.exp(jnp.sum(lv[0] * lv[1])) - jnp.exp(jnp.sum(lv[2] * lv[3])) + lam_init

    def diff_qkv(p, rope):
        q = rms_norm(_heads(p[0], 2 * A_HEADS, HEAD_DIM), q_gain)
        k = rms_norm(_heads(p[1], 2 * A_HEADS, HEAD_DIM), k_gain)
        if rope:
            q = apply_axial_rope(q, cos, sin)
            k = apply_axial_rope(k, cos, sin)
        l = q.shape[2]
        q = q.reshape(b, A_HEADS, 2, l, HEAD_DIM).transpose(0, 1, 3, 2, 4)
        k = k.reshape(b, A_HEADS, 2, l, HEAD_DIM)
        v = _heads(p[2], A_HEADS, A_VDIM)
        return q, k, v

    q_x, k_x, v_x = diff_qkv(px, True)
    q_c, k_c, v_c = diff_qkv(pc, False)
    k_all = jnp.concatenate([k_c, k_x], axis=3)
    v_all = jnp.concatenate([v_c, v_x], axis=2)

    def diff_post(o):
        return _merge(rms_norm(o, subln) * (1.0 - lam_init))

    d_x = diff_post(sweep_query_blocks(lambda qb: diff_attend(qb, k_all, v_all, lam), q_x, 2))

    def gla_in(p):
        q = _heads(p[3], B_HEADS, B_DK).astype(jnp.float32) * B_DK ** -0.5
        k = _heads(p[4], B_HEADS, B_DK).astype(jnp.float32)
        v = _heads(p[5], B_HEADS, B_DV).astype(jnp.float32)
        la_f = _heads(jax.nn.log_sigmoid((p[7] @ w_af + b_af).astype(jnp.float32)) / GATE_TAU, B_HEADS, B_DK)
        la_b = _heads(jax.nn.log_sigmoid((p[8] @ w_ab + b_ab).astype(jnp.float32)) / GATE_TAU, B_HEADS, B_DK)
        return q, k, v, la_f, la_b

    gq_x, gk_x, gv_x, gf_x, gb_x = gla_in(px)
    gq_c, gk_c, gv_c, gf_c, gb_c = gla_in(pc)
    zeros = jnp.zeros((b, B_HEADS, B_DK, B_DV), jnp.float32)
    oc_f, hc_f = gla_chunked(gq_c, gk_c, gv_c, gf_c, zeros)
    oc_b, hc_b = gla_chunked(_flip(gq_c), _flip(gk_c), _flip(gv_c), _flip(gb_c), zeros)
    ox_f, _ = gla_chunked(gq_x, gk_x, gv_x, gf_x, hc_f)
    ox_b, _ = gla_chunked(_flip(gq_x), _flip(gk_x), _flip(gv_x), _flip(gb_x), hc_b)

    def gla_post(o, r):
        return _merge(rms_norm(o, gla_gain).astype(r.dtype)) * jax.nn.silu(r)

    g_x = gla_post(ox_f + _flip(ox_b), px[6])
    y_x = jnp.concatenate([d_x, g_x], axis=-1) @ w_out
    y_c = None
    if need_ctx:
        d_c = diff_post(diff_attend(q_c, k_c, v_c, lam))
        g_c = gla_post(oc_f + _flip(oc_b), pc[6])
        y_c = jnp.concatenate([d_c, g_c], axis=-1) @ w_out
    return y_x, y_c


def odd_mixer(a_x, a_c, cos, sin, w_in, w_out, q_gain, k_gain, need_ctx):
    q_cols = ODD_SPLITS[0]

    def qkv(a, with_q, rope):
        if with_q:
            pq, pk, pv = _split(a @ w_in, ODD_SPLITS)
        else:
            pk, pv = _split(a @ w_in[:, q_cols:], ODD_SPLITS[1:])
        k = rms_norm(_heads(pk, C_KV_HEADS, HEAD_DIM), k_gain)
        v = _heads(pv, C_KV_HEADS, HEAD_DIM)
        if rope:
            k = apply_axial_rope(k, cos, sin)
        q = None
        if with_q:
            q = rms_norm(_heads(pq, C_Q_HEADS, HEAD_DIM), q_gain)
            if rope:
                q = apply_axial_rope(q, cos, sin)
            bq, _, l, _ = q.shape
            q = q.reshape(bq, C_KV_HEADS, C_GROUP, l, HEAD_DIM)
        return q, k, v

    q_x, k_x, v_x = qkv(a_x, True, True)
    q_c, k_c, v_c = qkv(a_c, need_ctx, False)
    k_all = jnp.concatenate([k_c, k_x], axis=2)
    v_all = jnp.concatenate([v_c, v_x], axis=2)

    def post(o):
        bo, _, _, l, _ = o.shape
        return _merge(o.reshape(bo, C_Q_HEADS, l, HEAD_DIM)) @ w_out

    y_x = post(sweep_query_blocks(lambda qb: gqa_attend(qb, k_all, v_all), q_x, 3))
    y_c = post(gqa_attend(q_c, k_c, v_c)) if need_ctx else None
    return y_x, y_c


def peer_ffn(h, w_q, sub_keys, u_tab, v_tab):
    b, l, d = h.shape
    half = PEER_DK // 2

    def chunk(xc):
        q = (xc @ w_q).reshape(PEER_CHUNK, PEER_HEADS, PEER_DK)
        s1 = jnp.einsum('thd,hnd->thn', q[..., :half], sub_keys[:, 0]).astype(jnp.float32)
        s2 = jnp.einsum('thd,hnd->thn', q[..., half:], sub_keys[:, 1]).astype(jnp.float32)
        v1, i1 = lax.top_k(s1, PEER_TOPK)
        v2, i2 = lax.top_k(s2, PEER_TOPK)
        cand = (v1[..., :, None] + v2[..., None, :]).reshape(PEER_CHUNK, PEER_HEADS, PEER_TOPK * PEER_TOPK)
        cidx = (i1[..., :, None] * PEER_NKEYS + i2[..., None, :]).reshape(PEER_CHUNK, PEER_HEADS, PEER_TOPK * PEER_TOPK)
        best, j = lax.top_k(cand, PEER_TOPK)
        idx = jnp.take_along_axis(cidx, j, axis=-1)
        g = jax.nn.softmax(best, axis=-1)
        act = jax.nn.gelu(jnp.einsum('thkd,td->thk', u_tab[idx], xc).astype(jnp.float32))
        w = (g * act).astype(xc.dtype)
        return jnp.einsum('thk,thkd->td', w, v_tab[idx])

    out = lax.map(chunk, h.reshape(-1, PEER_CHUNK, d))
    return out.reshape(b, l, d)


def setup_inputs(seed: int = 0) -> dict:
    key = jax.random.key(seed)
    ks = jax.random.split(key, 30)

    def nrm(k, shape, s):
        return jax.random.normal(k, shape, jnp.float32) * s

    D = D_MODEL
    return {
        'x': nrm(ks[0], (BATCH, SEQ, D), 1.0),
        'c': nrm(ks[1], (BATCH, D), 1.0),
        'ctx': nrm(ks[2], (BATCH, CTX_LEN, D), 1.0),
        'c_ctx': nrm(ks[3], (D,), 1.0),
        'w_mod': nrm(ks[4], (DEPTH, D, 6 * D), MOD_SCALE),
        'b_mod': nrm(ks[5], (DEPTH, 6 * D), 0.01),
        'g_mix': 1.0 + nrm(ks[6], (DEPTH, D), 0.02),
        'g_ffn': 1.0 + nrm(ks[7], (DEPTH, D), 0.02),
        'w_in_even': nrm(ks[8], (N_EVEN, D, EVEN_IN), D ** -0.5),
        'w_out_even': nrm(ks[9], (N_EVEN, EVEN_MIX, D), EVEN_MIX ** -0.5),
        'a_q_gain': 1.0 + nrm(ks[10], (N_EVEN, HEAD_DIM), 0.02),
        'a_k_gain': 1.0 + nrm(ks[11], (N_EVEN, HEAD_DIM), 0.02),
        'a_lambda': nrm(ks[12], (N_EVEN, 4, HEAD_DIM), 0.1),
        'a_subln': 1.0 + nrm(ks[13], (N_EVEN, A_VDIM), 0.02),
        'b_w_af': nrm(ks[14], (N_EVEN, GATE_RANK, B_HEADS * B_DK), GATE_RANK ** -0.5),
        'b_b_af': 1.0 + nrm(ks[15], (N_EVEN, B_HEADS * B_DK), 0.5),
        'b_w_ab': nrm(ks[16], (N_EVEN, GATE_RANK, B_HEADS * B_DK), GATE_RANK ** -0.5),
        'b_b_ab': 1.0 + nrm(ks[17], (N_EVEN, B_HEADS * B_DK), 0.5),
        'b_gain': 1.0 + nrm(ks[18], (N_EVEN, B_DV), 0.02),
        'w_in_odd': nrm(ks[19], (N_ODD, D, ODD_IN), D ** -0.5),
        'w_out_odd': nrm(ks[20], (N_ODD, C_WIDTH, D), C_WIDTH ** -0.5),
        'c_q_gain': 1.0 + nrm(ks[21], (N_ODD, HEAD_DIM), 0.02),
        'c_k_gain': 1.0 + nrm(ks[22], (N_ODD, HEAD_DIM), 0.02),
        'peer_wq': nrm(ks[23], (DEPTH, D, PEER_HEADS * PEER_DK), D ** -0.5),
        'peer_keys': nrm(ks[24], (DEPTH, PEER_HEADS, 2, PEER_NKEYS, PEER_DK // 2), (PEER_DK // 2) ** -0.5),
        'peer_u': nrm(ks[25], (DEPTH, PEER_EXPERTS, D), D ** -0.5),
        'peer_v': nrm(ks[26], (DEPTH, PEER_EXPERTS, D), PEER_V_SCALE),
    }


def reference(x, c, ctx, c_ctx, w_mod, b_mod, g_mix, g_ffn,
              w_in_even, w_out_even, a_q_gain, a_k_gain, a_lambda, a_subln,
              b_w_af, b_b_af, b_w_ab, b_b_ab, b_gain,
              w_in_odd, w_out_odd, c_q_gain, c_k_gain,
              peer_wq, peer_keys, peer_u, peer_v):
    cos, sin = axial_rope_tables(x.shape[1])
    h_c = ctx
    silu_c = jax.nn.silu(c)
    silu_cc = jax.nn.silu(c_ctx)[None, :]
    for layer in range(DEPTH):
        need_ctx = layer < DEPTH - 1
        mx = jnp.split((silu_c @ w_mod[layer] + b_mod[layer])[:, None, :], 6, axis=-1)
        mc = jnp.split((silu_cc @ w_mod[layer] + b_mod[layer])[:, None, :], 6, axis=-1)
        a_x = modulate(rms_norm(x, g_mix[layer]), mx[0], mx[1])
        a_c = modulate(rms_norm(h_c, g_mix[layer]), mc[0], mc[1])
        i = layer // 2
        if layer % 2 == 0:
            lam_init = 0.8 - 0.6 * math.exp(-0.3 * layer)
            y_x, y_c = even_mixer(a_x, a_c, cos, sin, w_in_even[i], w_out_even[i],
                                  a_q_gain[i], a_k_gain[i], a_lambda[i], a_subln[i],
                                  b_w_af[i], b_b_af[i], b_w_ab[i], b_b_ab[i], b_gain[i],
                                  lam_init, need_ctx)
        else:
            y_x, y_c = odd_mixer(a_x, a_c, cos, sin, w_in_odd[i], w_out_odd[i],
                                 c_q_gain[i], c_k_gain[i], need_ctx)
        x = x + mx[2] * y_x
        f_x = peer_ffn(modulate(rms_norm(x, g_ffn[layer]), mx[3], mx[4]),
                       peer_wq[layer], peer_keys[layer], peer_u[layer], peer_v[layer])
        x = x + mx[5] * f_x
        if need_ctx:
            h_c = h_c + mc[2] * y_c
            f_c = peer_ffn(modulate(rms_norm(h_c, g_ffn[layer]), mc[3], mc[4]),
                           peer_wq[layer], peer_keys[layer], peer_u[layer], peer_v[layer])
            h_c = h_c + mc[5] * f_c
    return x
```

```cpp
#include <hip/hip_runtime.h>
#include <stdint.h>

#define DM 1024
#define NB 16
#define SEQ 2048
#define CTX 256
#define RL (NB * SEQ)
#define RC (NB * CTX)
#define RT (RL + RC)
#define DEPTH 4
#define EVEN_IN 3104
#define ODD_IN 1536
#define NMOD 17
#define MODW 6144

__device__ __forceinline__ int row_mod(int r) { return r < RL ? (r >> 11) : 16; }
__device__ __forceinline__ float silu_f(float x) { return x / (1.f + expf(-x)); }
__device__ __forceinline__ float wave_sum(float v) {
#pragma unroll
    for (int o = 1; o < 64; o <<= 1) v += __shfl_xor(v, o);
    return v;
}

__global__ void k_copy_in(const float* __restrict__ x, const float* __restrict__ ctx, float* __restrict__ X) {
    size_t i = (size_t)blockIdx.x * blockDim.x + threadIdx.x;
    size_t n4 = (size_t)RT * DM / 4;
    for (; i < n4; i += (size_t)gridDim.x * blockDim.x) {
        size_t e = i * 4;
        float4 v = e < (size_t)RL * DM ? ((const float4*)x)[i] : ((const float4*)ctx)[i - (size_t)RL * DM / 4];
        ((float4*)X)[i] = v;
    }
}
__global__ void k_copy_out(const float* __restrict__ X, float* __restrict__ out) {
    size_t i = (size_t)blockIdx.x * blockDim.x + threadIdx.x;
    size_t n4 = (size_t)RL * DM / 4;
    for (; i < n4; i += (size_t)gridDim.x * blockDim.x) ((float4*)out)[i] = ((const float4*)X)[i];
}

__global__ __launch_bounds__(256) void k_mods(const float* __restrict__ c, const float* __restrict__ cctx, const float* __restrict__ w_mod,
                                              const float* __restrict__ b_mod, float* __restrict__ mods) {
    __shared__ float S[NMOD][DM];
    for (int i = threadIdx.x; i < NMOD * DM; i += 256) {
        int j = i / DM, k = i % DM;
        float v = j < 16 ? c[j * DM + k] : cctx[k];
        S[j][k] = silu_f(v);
    }
    __syncthreads();
    int l = blockIdx.y, n = blockIdx.x * 256 + threadIdx.x;
    const float* W = w_mod + (size_t)l * DM * MODW;
    float acc[NMOD];
#pragma unroll
    for (int j = 0; j < NMOD; ++j) acc[j] = 0.f;
    for (int k = 0; k < DM; ++k) {
        float w = W[(size_t)k * MODW + n];
#pragma unroll
        for (int j = 0; j < NMOD; ++j) acc[j] += S[j][k] * w;
    }
    float b = b_mod[l * MODW + n];
#pragma unroll
    for (int j = 0; j < NMOD; ++j) mods[((size_t)l * NMOD + j) * MODW + n] = acc[j] + b;
}

__global__ __launch_bounds__(256) void k_norm_mod(const float* __restrict__ X, const float* __restrict__ g, const float* __restrict__ mods_l,
                                                  int shift_chunk, float* __restrict__ A) {
    int wave = (blockIdx.x * 256 + threadIdx.x) >> 6, lane = threadIdx.x & 63;
    int nw = gridDim.x * 4;
    for (int r = wave; r < RT; r += nw) {
        const float4* xr = (const float4*)(X + (size_t)r * DM);
        float4 v[4]; float s = 0.f;
#pragma unroll
        for (int i = 0; i < 4; ++i) { v[i] = xr[lane + 64 * i]; s += v[i].x * v[i].x + v[i].y * v[i].y + v[i].z * v[i].z + v[i].w * v[i].w; }
        s = wave_sum(s);
        float rstd = rsqrtf(s * (1.f / DM) + 1e-6f);
        const float* m = mods_l + (size_t)row_mod(r) * MODW;
        const float4* sh = (const float4*)(m + shift_chunk * DM);
        const float4* sc = (const float4*)(m + (shift_chunk + 1) * DM);
        const float4* g4 = (const float4*)g;
        float4* ar = (float4*)(A + (size_t)r * DM);
#pragma unroll
        for (int i = 0; i < 4; ++i) {
            int c = lane + 64 * i;
            float4 gg = g4[c], a = sh[c], b = sc[c], o;
            o.x = v[i].x * rstd * gg.x * (1.f + b.x) + a.x;
            o.y = v[i].y * rstd * gg.y * (1.f + b.y) + a.y;
            o.z = v[i].z * rstd * gg.z * (1.f + b.z) + a.z;
            o.w = v[i].w * rstd * gg.w * (1.f + b.w) + a.w;
            ar[c] = o;
        }
    }
}

template <int MODE>
__global__ __launch_bounds__(256) void k_gemm(const float* __restrict__ A, int lda, const float* __restrict__ B, int ldb, float* __restrict__ C, int ldc,
                                              int M, int N, int K, const float* __restrict__ gate) {
    __shared__ float As[16][68];
    __shared__ float Bs[16][68];
    int tid = threadIdx.x, tx = tid & 15, ty = tid >> 4;
    int m0 = blockIdx.y * 64, n0 = blockIdx.x * 64;
    float acc[4][4];
#pragma unroll
    for (int i = 0; i < 4; ++i)
#pragma unroll
        for (int j = 0; j < 4; ++j) acc[i][j] = 0.f;
    int ar = tid >> 2, ak = (tid & 3) * 4;
    int bk = tid >> 4, bn = (tid & 15) * 4;
    for (int k0 = 0; k0 < K; k0 += 16) {
        float4 av = *(const float4*)(A + (size_t)(m0 + ar) * lda + k0 + ak);
        float4 bv = make_float4(0.f, 0.f, 0.f, 0.f);
        if (n0 + bn < N) bv = *(const float4*)(B + (size_t)(k0 + bk) * ldb + n0 + bn);
        __syncthreads();
        As[ak + 0][ar] = av.x; As[ak + 1][ar] = av.y; As[ak + 2][ar] = av.z; As[ak + 3][ar] = av.w;
        *(float4*)&Bs[bk][bn] = bv;
        __syncthreads();
#pragma unroll
        for (int k = 0; k < 16; ++k) {
            float4 a = *(const float4*)&As[k][ty * 4];
            float4 b = *(const float4*)&Bs[k][tx * 4];
            float aa[4] = {a.x, a.y, a.z, a.w}, bb[4] = {b.x, b.y, b.z, b.w};
#pragma unroll
            for (int i = 0; i < 4; ++i)
#pragma unroll
                for (int j = 0; j < 4; ++j) acc[i][j] += aa[i] * bb[j];
        }
    }
    int nn = n0 + tx * 4;
    if (nn < N) {
#pragma unroll
        for (int i = 0; i < 4; ++i) {
            int r = m0 + ty * 4 + i;
            float4* cp = (float4*)(C + (size_t)r * ldc + nn);
            if (MODE == 0) { *cp = make_float4(acc[i][0], acc[i][1], acc[i][2], acc[i][3]); }
            else {
                float4 gv = *(const float4*)(gate + (size_t)row_mod(r) * MODW + nn);
                float4 c = *cp;
                c.x += gv.x * acc[i][0]; c.y += gv.y * acc[i][1]; c.z += gv.z * acc[i][2]; c.w += gv.w * acc[i][3];
                *cp = c;
            }
        }
    }
}

__global__ void k_rope_table(float2* __restrict__ rope) {
    int i = blockIdx.x * blockDim.x + threadIdx.x;
    if (i >= SEQ * 32) return;
    int t = i >> 5, a = (i >> 4) & 1, f = i & 15;
    float pos = a == 0 ? (float)(t >> 6) : (float)(t & 63);
    float inv = powf(10000.f, -(float)f / 16.f);
    float ang = pos * inv;
    rope[i] = make_float2(cosf(ang), sinf(ang));
}
__global__ __launch_bounds__(256) void k_headnorm_rope(float* __restrict__ P, int ldp, int col0, int nheads, const float* __restrict__ gain, const float2* __restrict__ rope) {
    int idx = blockIdx.x * 256 + threadIdx.x;
    if (idx >= RT * nheads) return;
    int r = idx / nheads, h = idx % nheads;
    float* p = P + (size_t)r * ldp + col0 + h * 64;
    float v[64]; float s = 0.f;
#pragma unroll
    for (int i = 0; i < 16; ++i) { float4 t = ((const float4*)p)[i]; v[4 * i] = t.x; v[4 * i + 1] = t.y; v[4 * i + 2] = t.z; v[4 * i + 3] = t.w; }
#pragma unroll
    for (int i = 0; i < 64; ++i) s += v[i] * v[i];
    float rstd = rsqrtf(s * (1.f / 64.f) + 1e-6f);
#pragma unroll
    for (int i = 0; i < 64; ++i) v[i] = v[i] * rstd * gain[i];
    if (r < RL) {
        int t = r & (SEQ - 1);
        const float2* tab = rope + (size_t)t * 32;
#pragma unroll
        for (int a = 0; a < 2; ++a)
#pragma unroll
            for (int f = 0; f < 16; ++f) {
                float2 cs = tab[a * 16 + f];
                float x1 = v[a * 32 + f], x2 = v[a * 32 + 16 + f];
                v[a * 32 + f] = x1 * cs.x - x2 * cs.y;
                v[a * 32 + 16 + f] = x2 * cs.x + x1 * cs.y;
            }
    }
#pragma unroll
    for (int i = 0; i < 16; ++i) ((float4*)p)[i] = make_float4(v[4 * i], v[4 * i + 1], v[4 * i + 2], v[4 * i + 3]);
}

template <int DV>
__global__ __launch_bounds__(256) void k_attn(const float* __restrict__ P, int ldp, int qcol0, int kcol0, int kdiv, int vcol0, int vdiv,
                                              float* __restrict__ O, int ldo) {
    __shared__ float Ks[16][64];
    __shared__ float Vs[16][DV];
    int tid = threadIdx.x, qh = blockIdx.y, bx = blockIdx.x;
    int b, r, nkeys;
    if (bx < 128) { b = bx >> 3; r = b * SEQ + (bx & 7) * 256 + tid; nkeys = CTX + SEQ; }
    else { b = bx - 128; r = RL + b * CTX + tid; nkeys = CTX; }
    float q[64], o[DV];
    {
        const float4* qp = (const float4*)(P + (size_t)r * ldp + qcol0 + qh * 64);
#pragma unroll
        for (int i = 0; i < 16; ++i) { float4 t = qp[i]; q[4 * i] = t.x * 0.125f; q[4 * i + 1] = t.y * 0.125f; q[4 * i + 2] = t.z * 0.125f; q[4 * i + 3] = t.w * 0.125f; }
    }
#pragma unroll
    for (int i = 0; i < DV; ++i) o[i] = 0.f;
    float m = -1e30f, l = 0.f;
    int kh = qh / kdiv, vh = qh / vdiv;
    for (int j0 = 0; j0 < nkeys; j0 += 16) {
        __syncthreads();
        {
            int jj = tid >> 4, c4 = tid & 15;
            int j = j0 + jj;
            int kr = j < CTX ? RL + b * CTX + j : b * SEQ + (j - CTX);
            *(float4*)&Ks[jj][c4 * 4] = *(const float4*)(P + (size_t)kr * ldp + kcol0 + kh * 64 + c4 * 4);
#pragma unroll
            for (int u = 0; u < DV / 64; ++u)
                *(float4*)&Vs[jj][(c4 + 16 * u) * 4] = *(const float4*)(P + (size_t)kr * ldp + vcol0 + vh * DV + (c4 + 16 * u) * 4);
        }
        __syncthreads();
        float s[16]; float tm = -1e30f;
#pragma unroll
        for (int jj = 0; jj < 16; ++jj) {
            float a = 0.f;
#pragma unroll
            for (int d4 = 0; d4 < 16; ++d4) { float4 kv = *(const float4*)&Ks[jj][d4 * 4]; a += q[4 * d4] * kv.x + q[4 * d4 + 1] * kv.y + q[4 * d4 + 2] * kv.z + q[4 * d4 + 3] * kv.w; }
            s[jj] = a; tm = fmaxf(tm, a);
        }
        float mn = fmaxf(m, tm), f = expf(m - mn);
        l *= f;
#pragma unroll
        for (int i = 0; i < DV; ++i) o[i] *= f;
        m = mn;
#pragma unroll
        for (int jj = 0; jj < 16; ++jj) {
            float p = expf(s[jj] - m); l += p;
#pragma unroll
            for (int d4 = 0; d4 < DV / 4; ++d4) { float4 vv = *(const float4*)&Vs[jj][d4 * 4]; o[4 * d4] += p * vv.x; o[4 * d4 + 1] += p * vv.y; o[4 * d4 + 2] += p * vv.z; o[4 * d4 + 3] += p * vv.w; }
        }
    }
    float il = 1.f / l;
    float4* op = (float4*)(O + (size_t)r * ldo + qh * DV);
#pragma unroll
    for (int i = 0; i < DV / 4; ++i) op[i] = make_float4(o[4 * i] * il, o[4 * i + 1] * il, o[4 * i + 2] * il, o[4 * i + 3] * il);
}

__global__ __launch_bounds__(256) void k_diff_post(float* __restrict__ ATT, const float* __restrict__ lamv, const float* __restrict__ subln, float lam_init) {
    int wave = (blockIdx.x * 256 + threadIdx.x) >> 6, lane = threadIdx.x & 63;
    int nw = gridDim.x * 4;
    float p1 = lamv[lane] * lamv[64 + lane], p2 = lamv[128 + lane] * lamv[192 + lane];
    p1 = wave_sum(p1); p2 = wave_sum(p2);
    float lam = expf(p1) - expf(p2) + lam_init;
    for (int r = wave; r < RT; r += nw) {
        float* a = ATT + (size_t)r * DM;
        float d[4][2];
#pragma unroll
        for (int h = 0; h < 4; ++h) {
            float2 o0 = *(const float2*)(a + (2 * h) * 128 + lane * 2);
            float2 o1 = *(const float2*)(a + (2 * h + 1) * 128 + lane * 2);
            d[h][0] = o0.x - lam * o1.x; d[h][1] = o0.y - lam * o1.y;
        }
#pragma unroll
        for (int h = 0; h < 4; ++h) {
            float s = wave_sum(d[h][0] * d[h][0] + d[h][1] * d[h][1]);
            float rstd = rsqrtf(s * (1.f / 128.f) + 1e-6f) * (1.f - lam_init);
            float2 sg = *(const float2*)(subln + lane * 2);
            *(float2*)(a + h * 128 + lane * 2) = make_float2(d[h][0] * rstd * sg.x, d[h][1] * rstd * sg.y);
        }
    }
}

__device__ __forceinline__ float log_sigmoid_f(float z) { return fminf(z, 0.f) - log1pf(expf(-fabsf(z))); }
__global__ __launch_bounds__(256) void k_gla_seq(const float* __restrict__ P, const float* __restrict__ w_af, const float* __restrict__ b_af,
                                                 const float* __restrict__ w_ab, const float* __restrict__ b_ab, float* __restrict__ OF, float* __restrict__ OB) {
    __shared__ float sa[64], sk[64], sq[64], spart[2][128];
    int tid = threadIdx.x, col = tid & 127, half = tid >> 7;
    int dir = blockIdx.x & 1, h = (blockIdx.x >> 1) & 3, b = blockIdx.x >> 3;
    const float* wa = dir ? w_ab : w_af; const float* ba = dir ? b_ab : b_af;
    float* Od = dir ? OB : OF;
    float S[32];
#pragma unroll
    for (int i = 0; i < 32; ++i) S[i] = 0.f;
    float wreg[16]; float breg = 0.f;
    if (tid < 64) {
#pragma unroll
        for (int j = 0; j < 16; ++j) wreg[j] = wa[j * 256 + h * 64 + tid];
        breg = ba[h * 64 + tid];
    }
    for (int step = 0; step < CTX + SEQ; ++step) {
        int r;
        if (!dir) r = step < CTX ? RL + b * CTX + step : b * SEQ + (step - CTX);
        else r = step < CTX ? RL + b * CTX + (CTX - 1 - step) : b * SEQ + (SEQ - 1 - (step - CTX));
        const float* p = P + (size_t)r * EVEN_IN;
        if (tid < 64) {
            float z = breg;
#pragma unroll
            for (int j = 0; j < 16; ++j) z += p[3072 + dir * 16 + j] * wreg[j];
            sa[tid] = expf(log_sigmoid_f(z) * (1.f / 16.f));
            sk[tid] = p[1792 + h * 64 + tid];
            sq[tid] = p[1536 + h * 64 + tid] * 0.125f;
        }
        float v = p[2048 + h * 128 + col];
        __syncthreads();
        float part = 0.f;
#pragma unroll
        for (int dd = 0; dd < 32; ++dd) {
            int d = half * 32 + dd;
            S[dd] = sa[d] * S[dd] + sk[d] * v;
            part += sq[d] * S[dd];
        }
        spart[half][col] = part;
        __syncthreads();
        if (half == 0) Od[(size_t)r * 512 + h * 128 + col] = spart[0][col] + spart[1][col];
    }
}
__global__ __launch_bounds__(256) void k_gla_post(const float* __restrict__ OF, const float* __restrict__ OB, const float* __restrict__ P,
                                                  const float* __restrict__ gain, float* __restrict__ MIX) {
    int wave = (blockIdx.x * 256 + threadIdx.x) >> 6, lane = threadIdx.x & 63;
    int nw = gridDim.x * 4;
    for (int r = wave; r < RT; r += nw) {
#pragma unroll
        for (int h = 0; h < 4; ++h) {
            float2 a = *(const float2*)(OF + (size_t)r * 512 + h * 128 + lane * 2);
            float2 c = *(const float2*)(OB + (size_t)r * 512 + h * 128 + lane * 2);
            float o0 = a.x + c.x, o1 = a.y + c.y;
            float s = wave_sum(o0 * o0 + o1 * o1);
            float rstd = rsqrtf(s * (1.f / 128.f) + 1e-6f);
            float2 g = *(const float2*)(gain + lane * 2);
            float2 rr = *(const float2*)(P + (size_t)r * EVEN_IN + 2560 + h * 128 + lane * 2);
            *(float2*)(MIX + (size_t)r * DM + 512 + h * 128 + lane * 2) = make_float2(o0 * rstd * g.x * silu_f(rr.x), o1 * rstd * g.y * silu_f(rr.y));
        }
    }
}

#define INS16(tv, ti, v, n) do { \
    _Pragma("unroll") for (int j_ = 15; j_ >= 1; --j_) { bool c1_ = (v) > tv[j_ - 1]; bool c2_ = (v) > tv[j_]; \
        tv[j_] = c1_ ? tv[j_ - 1] : (c2_ ? (v) : tv[j_]); ti[j_] = c1_ ? ti[j_ - 1] : (c2_ ? (n) : ti[j_]); } \
    { bool c_ = (v) > tv[0]; tv[0] = c_ ? (v) : tv[0]; ti[0] = c_ ? (n) : ti[0]; } } while (0)

__global__ __launch_bounds__(256) void k_peer_route(const float* __restrict__ Qp, const float* __restrict__ keys_l, int* __restrict__ IDX, float* __restrict__ GATE) {
    int r = blockIdx.x * 256 + threadIdx.x, h = blockIdx.y;
    float tv[2][16]; int ti[2][16];
#pragma unroll
    for (int half = 0; half < 2; ++half) {
        float q[64];
        const float4* qp = (const float4*)(Qp + (size_t)r * DM + h * 128 + half * 64);
#pragma unroll
        for (int i = 0; i < 16; ++i) { float4 t = qp[i]; q[4 * i] = t.x; q[4 * i + 1] = t.y; q[4 * i + 2] = t.z; q[4 * i + 3] = t.w; }
#pragma unroll
        for (int j = 0; j < 16; ++j) { tv[half][j] = -3.0e38f; ti[half][j] = 0; }
        const float* kb = keys_l + (size_t)(h * 2 + half) * 128 * 64;
        for (int n = 0; n < 128; ++n) {
            float s = 0.f;
#pragma unroll
            for (int d = 0; d < 64; ++d) s += q[d] * kb[n * 64 + d];
            INS16(tv[half], ti[half], s, n);
        }
    }
    float bv[16]; int bi[16];
#pragma unroll
    for (int j = 0; j < 16; ++j) { bv[j] = -3.0e38f; bi[j] = 0; }
#pragma unroll
    for (int a = 0; a < 16; ++a)
#pragma unroll
        for (int b = 0; b < 16; ++b) {
            float s = tv[0][a] + tv[1][b]; int id = ti[0][a] * 128 + ti[1][b];
            INS16(bv, bi, s, id);
        }
    float mx = bv[0], sum = 0.f, e[16];
#pragma unroll
    for (int j = 0; j < 16; ++j) { e[j] = expf(bv[j] - mx); sum += e[j]; }
    float inv = 1.f / sum;
#pragma unroll
    for (int j = 0; j < 16; ++j) { IDX[(size_t)r * 128 + h * 16 + j] = bi[j]; GATE[(size_t)r * 128 + h * 16 + j] = e[j] * inv; }
}

__device__ __forceinline__ float gelu_tanh(float x) { float u = 0.7978845608028654f * (x + 0.044715f * x * x * x); return 0.5f * x * (1.f + tanhf(u)); }
__global__ __launch_bounds__(256) void k_peer_ffn(const float* __restrict__ A2, const int* __restrict__ IDX, const float* __restrict__ GATE,
                                                  const float* __restrict__ U, const float* __restrict__ V, const float* __restrict__ mods_l, float* __restrict__ X) {
    int wave = (blockIdx.x * 256 + threadIdx.x) >> 6, lane = threadIdx.x & 63;
    int nw = gridDim.x * 4;
    for (int r = wave; r < RT; r += nw) {
        float4 xa[4], acc[4];
#pragma unroll
        for (int i = 0; i < 4; ++i) { xa[i] = ((const float4*)(A2 + (size_t)r * DM))[lane + 64 * i]; acc[i] = make_float4(0.f, 0.f, 0.f, 0.f); }
        for (int e = 0; e < 128; ++e) {
            int id = IDX[(size_t)r * 128 + e]; float g = GATE[(size_t)r * 128 + e];
            const float4* ur = (const float4*)(U + (size_t)id * DM);
            float d = 0.f;
#pragma unroll
            for (int i = 0; i < 4; ++i) { float4 u = ur[lane + 64 * i]; d += u.x * xa[i].x + u.y * xa[i].y + u.z * xa[i].z + u.w * xa[i].w; }
            d = wave_sum(d);
            float w = g * gelu_tanh(d);
            const float4* vr = (const float4*)(V + (size_t)id * DM);
#pragma unroll
            for (int i = 0; i < 4; ++i) { float4 v = vr[lane + 64 * i]; acc[i].x += w * v.x; acc[i].y += w * v.y; acc[i].z += w * v.z; acc[i].w += w * v.w; }
        }
        const float4* g5 = (const float4*)(mods_l + (size_t)row_mod(r) * MODW + 5 * DM);
        float4* xr = (float4*)(X + (size_t)r * DM);
#pragma unroll
        for (int i = 0; i < 4; ++i) { float4 x = xr[lane + 64 * i], gg = g5[lane + 64 * i];
            x.x += gg.x * acc[i].x; x.y += gg.y * acc[i].y; x.z += gg.z * acc[i].z; x.w += gg.w * acc[i].w; xr[lane + 64 * i] = x; }
    }
}

extern "C" void kernel_launch(void* const* d_in, const int* in_sizes, int n_in, void* d_out, int out_size, void* d_ws, size_t ws_size, hipStream_t stream) {
    const float* x = (const float*)d_in[0];       const float* c = (const float*)d_in[1];
    const float* ctx = (const float*)d_in[2];     const float* c_ctx = (const float*)d_in[3];
    const float* w_mod = (const float*)d_in[4];   const float* b_mod = (const float*)d_in[5];
    const float* g_mix = (const float*)d_in[6];   const float* g_ffn = (const float*)d_in[7];
    const float* w_in_even = (const float*)d_in[8];  const float* w_out_even = (const float*)d_in[9];
    const float* a_q_gain = (const float*)d_in[10];  const float* a_k_gain = (const float*)d_in[11];
    const float* a_lambda = (const float*)d_in[12];  const float* a_subln = (const float*)d_in[13];
    const float* b_w_af = (const float*)d_in[14];    const float* b_b_af = (const float*)d_in[15];
    const float* b_w_ab = (const float*)d_in[16];    const float* b_b_ab = (const float*)d_in[17];
    const float* b_gain = (const float*)d_in[18];
    const float* w_in_odd = (const float*)d_in[19];  const float* w_out_odd = (const float*)d_in[20];
    const float* c_q_gain = (const float*)d_in[21];  const float* c_k_gain = (const float*)d_in[22];
    const float* peer_wq = (const float*)d_in[23];   const float* peer_keys = (const float*)d_in[24];
    const float* peer_u = (const float*)d_in[25];    const float* peer_v = (const float*)d_in[26];
    float* out = (float*)d_out;

    float* ws = (float*)d_ws;
    float* X = ws;
    float* A = X + (size_t)RT * DM;
    float* P = A + (size_t)RT * DM;
    float* ATT = P + (size_t)RT * EVEN_IN;
    float* MODS = ATT + (size_t)RT * DM;
    float2* ROPE = (float2*)(MODS + (size_t)DEPTH * NMOD * MODW);
    float* OF = A; float* OB = A + (size_t)RT * 512;
    float* Qp = P; int* IDX = (int*)(P + (size_t)RT * DM); float* GATE = P + (size_t)RT * DM + (size_t)RT * 128;

    k_copy_in<<<2048, 256, 0, stream>>>(x, ctx, X);
    k_mods<<<dim3(MODW / 256, DEPTH), 256, 0, stream>>>(c, c_ctx, w_mod, b_mod, MODS);
    k_rope_table<<<SEQ * 32 / 256, 256, 0, stream>>>(ROPE);

    for (int l = 0; l < DEPTH; ++l) {
        const float* mods_l = MODS + (size_t)l * NMOD * MODW;
        int i = l / 2;
        k_norm_mod<<<2048, 256, 0, stream>>>(X, g_mix + l * DM, mods_l, 0, A);
        if ((l & 1) == 0) {
            float lam_init = 0.8f - 0.6f * expf(-0.3f * (float)l);
            k_gemm<0><<<dim3((EVEN_IN + 63) / 64, RT / 64), 256, 0, stream>>>(A, DM, w_in_even + (size_t)i * DM * EVEN_IN, EVEN_IN, P, EVEN_IN, RT, EVEN_IN, DM, nullptr);
            k_headnorm_rope<<<(RT * 8 + 255) / 256, 256, 0, stream>>>(P, EVEN_IN, 0, 8, a_q_gain + i * 64, ROPE);
            k_headnorm_rope<<<(RT * 8 + 255) / 256, 256, 0, stream>>>(P, EVEN_IN, 512, 8, a_k_gain + i * 64, ROPE);
            k_attn<128><<<dim3(144, 8), 256, 0, stream>>>(P, EVEN_IN, 0, 512, 1, 1024, 2, ATT, DM);
            k_diff_post<<<2048, 256, 0, stream>>>(ATT, a_lambda + i * 256, a_subln + i * 128, lam_init);
            k_gla_seq<<<NB * 4 * 2, 256, 0, stream>>>(P, b_w_af + i * 16 * 256, b_b_af + i * 256, b_w_ab + i * 16 * 256, b_b_ab + i * 256, OF, OB);
            k_gla_post<<<2048, 256, 0, stream>>>(OF, OB, P, b_gain + i * 128, ATT);
            k_gemm<1><<<dim3(DM / 64, RT / 64), 256, 0, stream>>>(ATT, DM, w_out_even + (size_t)i * DM * DM, DM, X, DM, RT, DM, DM, mods_l + 2 * DM);
        } else {
            k_gemm<0><<<dim3(ODD_IN / 64, RT / 64), 256, 0, stream>>>(A, DM, w_in_odd + (size_t)i * DM * ODD_IN, ODD_IN, P, ODD_IN, RT, ODD_IN, DM, nullptr);
            k_headnorm_rope<<<(RT * 16 + 255) / 256, 256, 0, stream>>>(P, ODD_IN, 0, 16, c_q_gain + i * 64, ROPE);
            k_headnorm_rope<<<(RT * 4 + 255) / 256, 256, 0, stream>>>(P, ODD_IN, 1024, 4, c_k_gain + i * 64, ROPE);
            k_attn<64><<<dim3(144, 16), 256, 0, stream>>>(P, ODD_IN, 0, 1024, 4, 1280, 4, ATT, DM);
            k_gemm<1><<<dim3(DM / 64, RT / 64), 256, 0, stream>>>(ATT, DM, w_out_odd + (size_t)i * DM * DM, DM, X, DM, RT, DM, DM, mods_l + 2 * DM);
        }
        k_norm_mod<<<2048, 256, 0, stream>>>(X, g_ffn + l * DM, mods_l, 3, A);
        k_gemm<0><<<dim3(DM / 64, RT / 64), 256, 0, stream>>>(A, DM, peer_wq + (size_t)l * DM * DM, DM, Qp, DM, RT, DM, DM, nullptr);
        k_peer_route<<<dim3(RT / 256, 8), 256, 0, stream>>>(Qp, peer_keys + (size_t)l * 8 * 2 * 128 * 64, IDX, GATE);
        k_peer_ffn<<<2048, 256, 0, stream>>>(A, IDX, GATE, peer_u + (size_t)l * 16384 * DM, peer_v + (size_t)l * 16384 * DM, mods_l, X);
    }
    k_copy_out<<<2048, 256, 0, stream>>>(X, out);
}
```

```cpp
#include <hip/hip_runtime.h>
#include <hip/hip_cooperative_groups.h>
#include <stdint.h>
#include <cstdio>
namespace cg = cooperative_groups;

#define DM 1024
#define NB 16
#define SEQ 2048
#define CTX 256
#define RL (NB * SEQ)
#define RC (NB * CTX)
#define RT (RL + RC)
#define DEPTH 4
#define EVEN_IN 3104
#define ODD_IN 1536
#define NMOD 17
#define MODW 6144
#define NT 512
#define NWV 8

struct Params {
    const float* in[27];
    float* out;
    float* ws;
};

__device__ __forceinline__ int row_mod(int r) { return r < RL ? (r >> 11) : 16; }
__device__ __forceinline__ float silu_f(float x) { return x / (1.f + expf(-x)); }
__device__ __forceinline__ float wave_sum(float v) {
#pragma unroll
    for (int o = 1; o < 64; o <<= 1) v += __shfl_xor(v, o);
    return v;
}
__device__ __forceinline__ float log_sigmoid_f(float z) { return fminf(z, 0.f) - log1pf(expf(-fabsf(z))); }
__device__ __forceinline__ float gelu_tanh(float x) { float u = 0.7978845608028654f * (x + 0.044715f * x * x * x); return 0.5f * x * (1.f + tanhf(u)); }


__device__ __forceinline__ int opaque_tid() { int t = threadIdx.x; asm volatile("" : "+v"(t)); return t; }
__device__ __forceinline__ int opaque_bid() { int b = blockIdx.x; asm volatile("" : "+s"(b)); return b; }
__device__ __forceinline__ void ph_copy_in(const float* __restrict__ x, const float* __restrict__ ctx, float* __restrict__ X) {
    const int TID = opaque_tid(), BID = opaque_bid(); (void)TID; (void)BID;
    size_t i = (size_t)BID * NT + TID;
    const size_t n4 = (size_t)RT * DM / 4, nl4 = (size_t)RL * DM / 4;
    for (; i < n4; i += (size_t)gridDim.x * NT) ((float4*)X)[i] = i < nl4 ? ((const float4*)x)[i] : ((const float4*)ctx)[i - nl4];
}
__device__ __forceinline__ void ph_copy_out(const float* __restrict__ X, float* __restrict__ out) {
    const int TID = opaque_tid(), BID = opaque_bid(); (void)TID; (void)BID;
    size_t i = (size_t)BID * NT + TID;
    const size_t n4 = (size_t)RL * DM / 4;
    for (; i < n4; i += (size_t)gridDim.x * NT) ((float4*)out)[i] = ((const float4*)X)[i];
}
__device__ __forceinline__ void ph_rope_table(float2* __restrict__ rope) {
    const int TID = opaque_tid(), BID = opaque_bid(); (void)TID; (void)BID;
    for (int i = BID * NT + TID; i < SEQ * 32; i += gridDim.x * NT) {
        int t = i >> 5, a = (i >> 4) & 1, f = i & 15;
        float pos = a == 0 ? (float)(t >> 6) : (float)(t & 63);
        float inv = powf(10000.f, -(float)f / 16.f);
        float ang = pos * inv;
        rope[i] = make_float2(cosf(ang), sinf(ang));
    }
}
__device__ __forceinline__ void ph_mods(const float* __restrict__ c, const float* __restrict__ cctx, const float* __restrict__ w_mod,
                        const float* __restrict__ b_mod, float* __restrict__ mods, float* smem) {
    const int TID = opaque_tid(), BID = opaque_bid(); (void)TID; (void)BID;
    const int nvb = DEPTH * MODW / NT;
    if ((int)BID >= nvb) return;
    float (*S)[DM] = (float (*)[DM])smem;
    for (int i = TID; i < NMOD * DM; i += NT) {
        int j = i / DM, k = i % DM;
        float v = j < 16 ? c[j * DM + k] : cctx[k];
        S[j][k] = silu_f(v);
    }
    __syncthreads();
    for (int vb = BID; vb < nvb; vb += gridDim.x) {
        int idx = vb * NT + TID, l = idx / MODW, n = idx % MODW;
        const float* W = w_mod + (size_t)l * DM * MODW;
        float acc[NMOD];
#pragma unroll
        for (int j = 0; j < NMOD; ++j) acc[j] = 0.f;
        for (int k = 0; k < DM; ++k) {
            float w = W[(size_t)k * MODW + n];
#pragma unroll
            for (int j = 0; j < NMOD; ++j) acc[j] += S[j][k] * w;
        }
        float b = b_mod[l * MODW + n];
#pragma unroll
        for (int j = 0; j < NMOD; ++j) mods[((size_t)l * NMOD + j) * MODW + n] = acc[j] + b;
    }
    __syncthreads();
}
__device__ __forceinline__ void ph_norm_mod(const float* __restrict__ X, const float* __restrict__ g, const float* __restrict__ mods_l, int shift_chunk, float* __restrict__ A) {
    const int TID = opaque_tid(), BID = opaque_bid(); (void)TID; (void)BID;
    int wave = BID * NWV + (TID >> 6), lane = TID & 63;
    int nw = gridDim.x * NWV;
    for (int r = wave; r < RT; r += nw) {
        const float4* xr = (const float4*)(X + (size_t)r * DM);
        float4 v[4]; float s = 0.f;
#pragma unroll
        for (int i = 0; i < 4; ++i) { v[i] = xr[lane + 64 * i]; s += v[i].x * v[i].x + v[i].y * v[i].y + v[i].z * v[i].z + v[i].w * v[i].w; }
        s = wave_sum(s);
        float rstd = rsqrtf(s * (1.f / DM) + 1e-6f);
        const float* m = mods_l + (size_t)row_mod(r) * MODW;
        const float4* sh = (const float4*)(m + shift_chunk * DM);
        const float4* sc = (const float4*)(m + (shift_chunk + 1) * DM);
        const float4* g4 = (const float4*)g;
        float4* ar = (float4*)(A + (size_t)r * DM);
#pragma unroll
        for (int i = 0; i < 4; ++i) {
            int c = lane + 64 * i;
            float4 gg = g4[c], a = sh[c], b = sc[c], o;
            o.x = v[i].x * rstd * gg.x * (1.f + b.x) + a.x;
            o.y = v[i].y * rstd * gg.y * (1.f + b.y) + a.y;
            o.z = v[i].z * rstd * gg.z * (1.f + b.z) + a.z;
            o.w = v[i].w * rstd * gg.w * (1.f + b.w) + a.w;
            ar[c] = o;
        }
    }
}
template <int MODE>
__device__ __forceinline__ void ph_gemm(const float* __restrict__ A, int lda, const float* __restrict__ B, int ldb, float* __restrict__ C, int ldc,
                        int M, int N, int K, const float* __restrict__ gate, float* smem) {
    const int TID = opaque_tid(), BID = opaque_bid(); (void)TID; (void)BID;
    float (*As)[132] = (float (*)[132])smem;
    float (*Bs)[68] = (float (*)[68])(smem + 16 * 132);
    const int tid = TID, tx = tid & 15, ty = tid >> 4;
    const int ntn = (N + 63) / 64, ntm = M / 128;
    const int ar = tid >> 2, ak = (tid & 3) * 4;
    const int bk = (tid & 255) >> 4, bn = (tid & 15) * 4;
    for (int vb = BID; vb < ntn * ntm; vb += gridDim.x) {
        const int m0 = (vb / ntn) * 128, n0 = (vb % ntn) * 64;
        float acc[4][4];
#pragma unroll
        for (int i = 0; i < 4; ++i)
#pragma unroll
            for (int j = 0; j < 4; ++j) acc[i][j] = 0.f;
        for (int k0 = 0; k0 < K; k0 += 16) {
            float4 av = *(const float4*)(A + (size_t)(m0 + ar) * lda + k0 + ak);
            float4 bv = make_float4(0.f, 0.f, 0.f, 0.f);
            if (tid < 256 && n0 + bn < N) bv = *(const float4*)(B + (size_t)(k0 + bk) * ldb + n0 + bn);
            __syncthreads();
            As[ak + 0][ar] = av.x; As[ak + 1][ar] = av.y; As[ak + 2][ar] = av.z; As[ak + 3][ar] = av.w;
            if (tid < 256) *(float4*)&Bs[bk][bn] = bv;
            __syncthreads();
#pragma unroll
            for (int k = 0; k < 16; ++k) {
                float4 a = *(const float4*)&As[k][ty * 4];
                float4 b = *(const float4*)&Bs[k][tx * 4];
                float aa[4] = {a.x, a.y, a.z, a.w}, bb[4] = {b.x, b.y, b.z, b.w};
#pragma unroll
                for (int i = 0; i < 4; ++i)
#pragma unroll
                    for (int j = 0; j < 4; ++j) acc[i][j] += aa[i] * bb[j];
            }
        }
        const int nn = n0 + tx * 4;
        if (nn < N) {
#pragma unroll
            for (int i = 0; i < 4; ++i) {
                int r = m0 + ty * 4 + i;
                float4* cp = (float4*)(C + (size_t)r * ldc + nn);
                if (MODE == 0) { *cp = make_float4(acc[i][0], acc[i][1], acc[i][2], acc[i][3]); }
                else {
                    float4 gv = *(const float4*)(gate + (size_t)row_mod(r) * MODW + nn);
                    float4 c = *cp;
                    c.x += gv.x * acc[i][0]; c.y += gv.y * acc[i][1]; c.z += gv.z * acc[i][2]; c.w += gv.w * acc[i][3];
                    *cp = c;
                }
            }
        }
    }
    __syncthreads();
}
__device__ __forceinline__ void ph_headnorm_rope(float* __restrict__ P, int ldp, int col0, int nheads, const float* __restrict__ gain, const float2* __restrict__ rope) {
    const int TID = opaque_tid(), BID = opaque_bid(); (void)TID; (void)BID;
    for (int idx = BID * NT + TID; idx < RT * nheads; idx += gridDim.x * NT) {
        int r = idx / nheads, h = idx % nheads;
        float* p = P + (size_t)r * ldp + col0 + h * 64;
        float v[64]; float s = 0.f;
#pragma unroll
        for (int i = 0; i < 16; ++i) { float4 t = ((const float4*)p)[i]; v[4 * i] = t.x; v[4 * i + 1] = t.y; v[4 * i + 2] = t.z; v[4 * i + 3] = t.w; }
#pragma unroll
        for (int i = 0; i < 64; ++i) s += v[i] * v[i];
        float rstd = rsqrtf(s * (1.f / 64.f) + 1e-6f);
#pragma unroll
        for (int i = 0; i < 64; ++i) v[i] = v[i] * rstd * gain[i];
        if (r < RL) {
            int t = r & (SEQ - 1);
            const float2* tab = rope + (size_t)t * 32;
#pragma unroll
            for (int a = 0; a < 2; ++a)
#pragma unroll
                for (int f = 0; f < 16; ++f) {
                    float2 cs = tab[a * 16 + f];
                    float x1 = v[a * 32 + f], x2 = v[a * 32 + 16 + f];
                    v[a * 32 + f] = x1 * cs.x - x2 * cs.y;
                    v[a * 32 + 16 + f] = x2 * cs.x + x1 * cs.y;
                }
        }
#pragma unroll
        for (int i = 0; i < 16; ++i) ((float4*)p)[i] = make_float4(v[4 * i], v[4 * i + 1], v[4 * i + 2], v[4 * i + 3]);
    }
}
__device__ __forceinline__ void ph_attn(const float* __restrict__ P, int ldp, int qcol0, int kcol0, int kdiv, int vcol0, int vdiv, int DV, int nheads,
                        float* __restrict__ O, int ldo, float* smem) {
    const int TID = opaque_tid(), BID = opaque_bid(); (void)TID; (void)BID;
    const int tid = TID, half = tid >> 8, ht = tid & 255;
    float (*Ks)[64] = (float (*)[64])(smem + half * 2048);
    float (*Vs)[64] = (float (*)[64])(smem + 1024 + half * 2048);
    const int nch = DV / 64;
    const int nunits = 144 * nheads * nch;
    for (int vb = BID; vb < nunits / 2; vb += gridDim.x) {
        const int u = vb * 2 + half;
        const int bx = u / (nheads * nch), rem = u % (nheads * nch), qh = rem / nch, ch = rem % nch;
        int b, r, nkeys;
        if (bx < 128) { b = bx >> 3; r = b * SEQ + (bx & 7) * 256 + ht; nkeys = CTX + SEQ; }
        else { b = bx - 128; r = RL + b * CTX + ht; nkeys = CTX; }
        float q[64], o[64];
        {
            const float4* qp = (const float4*)(P + (size_t)r * ldp + qcol0 + qh * 64);
#pragma unroll
            for (int i = 0; i < 16; ++i) { float4 t = qp[i]; q[4 * i] = t.x * 0.125f; q[4 * i + 1] = t.y * 0.125f; q[4 * i + 2] = t.z * 0.125f; q[4 * i + 3] = t.w * 0.125f; }
        }
#pragma unroll
        for (int i = 0; i < 64; ++i) o[i] = 0.f;
        float m = -1e30f, l = 0.f;
        const int kh = qh / kdiv, vh = qh / vdiv;
        for (int j0 = 0; j0 < CTX + SEQ; j0 += 16) {
            __syncthreads();
            const bool act = j0 < nkeys;
            if (act) {
                int jj = ht >> 4, c4 = ht & 15;
                int j = j0 + jj;
                int kr = j < CTX ? RL + b * CTX + j : b * SEQ + (j - CTX);
                *(float4*)&Ks[jj][c4 * 4] = *(const float4*)(P + (size_t)kr * ldp + kcol0 + kh * 64 + c4 * 4);
                *(float4*)&Vs[jj][c4 * 4] = *(const float4*)(P + (size_t)kr * ldp + vcol0 + vh * DV + ch * 64 + c4 * 4);
            }
            __syncthreads();
            if (act) {
                float s[16]; float tm = -1e30f;
#pragma unroll
                for (int jj = 0; jj < 16; ++jj) {
                    float a = 0.f;
#pragma unroll
                    for (int d4 = 0; d4 < 16; ++d4) { float4 kv = *(const float4*)&Ks[jj][d4 * 4]; a += q[4 * d4] * kv.x + q[4 * d4 + 1] * kv.y + q[4 * d4 + 2] * kv.z + q[4 * d4 + 3] * kv.w; }
                    s[jj] = a; tm = fmaxf(tm, a);
                }
                float mn = fmaxf(m, tm), f = expf(m - mn);
                l *= f;
#pragma unroll
                for (int i = 0; i < 64; ++i) o[i] *= f;
                m = mn;
#pragma unroll
                for (int jj = 0; jj < 16; ++jj) {
                    float p = expf(s[jj] - m); l += p;
#pragma unroll
                    for (int d4 = 0; d4 < 16; ++d4) { float4 vv = *(const float4*)&Vs[jj][d4 * 4]; o[4 * d4] += p * vv.x; o[4 * d4 + 1] += p * vv.y; o[4 * d4 + 2] += p * vv.z; o[4 * d4 + 3] += p * vv.w; }
                }
            }
        }
        float il = 1.f / l;
        float4* op = (float4*)(O + (size_t)r * ldo + qh * DV + ch * 64);
#pragma unroll
        for (int i = 0; i < 16; ++i) op[i] = make_float4(o[4 * i] * il, o[4 * i + 1] * il, o[4 * i + 2] * il, o[4 * i + 3] * il);
    }
    __syncthreads();
}
__device__ __forceinline__ void ph_gla_seq(const float* __restrict__ P, const float* __restrict__ w_af, const float* __restrict__ b_af,
                           const float* __restrict__ w_ab, const float* __restrict__ b_ab, float* __restrict__ OF, float* __restrict__ OB, float* smem) {
    const int TID = opaque_tid(), BID = opaque_bid(); (void)TID; (void)BID;
    const int tid = TID, hb = tid >> 8, ht = tid & 255, col = ht & 127, half = ht >> 7;
    float* sa = smem + hb * 512; float* sk = sa + 64; float* sq = sa + 128; float* spart = sa + 192;
    for (int vb = BID; vb < NB * 4 * 2 / 2; vb += gridDim.x) {
        const int u = vb * 2 + hb;
        const int dir = u & 1, h = (u >> 1) & 3, b = u >> 3;
        const float* wa = dir ? w_ab : w_af; const float* ba = dir ? b_ab : b_af;
        float* Od = dir ? OB : OF;
        float S[32];
#pragma unroll
        for (int i = 0; i < 32; ++i) S[i] = 0.f;
        float wreg[16]; float breg = 0.f;
#pragma unroll
        for (int j = 0; j < 16; ++j) wreg[j] = 0.f;
        if (ht < 64) {
#pragma unroll
            for (int j = 0; j < 16; ++j) wreg[j] = wa[j * 256 + h * 64 + ht];
            breg = ba[h * 64 + ht];
        }
        for (int step = 0; step < CTX + SEQ; ++step) {
            int r;
            if (!dir) r = step < CTX ? RL + b * CTX + step : b * SEQ + (step - CTX);
            else r = step < CTX ? RL + b * CTX + (CTX - 1 - step) : b * SEQ + (SEQ - 1 - (step - CTX));
            const float* p = P + (size_t)r * EVEN_IN;
            if (ht < 64) {
                float z = breg;
#pragma unroll
                for (int j = 0; j < 16; ++j) z += p[3072 + dir * 16 + j] * wreg[j];
                sa[ht] = expf(log_sigmoid_f(z) * (1.f / 16.f));
                sk[ht] = p[1792 + h * 64 + ht];
                sq[ht] = p[1536 + h * 64 + ht] * 0.125f;
            }
            float v = p[2048 + h * 128 + col];
            __syncthreads();
            float part = 0.f;
#pragma unroll
            for (int dd = 0; dd < 32; ++dd) {
                int d = half * 32 + dd;
                S[dd] = sa[d] * S[dd] + sk[d] * v;
                part += sq[d] * S[dd];
            }
            spart[half * 128 + col] = part;
            __syncthreads();
            if (half == 0) Od[(size_t)r * 512 + h * 128 + col] = spart[col] + spart[128 + col];
        }
    }
    __syncthreads();
}
__device__ __forceinline__ void ph_even_post(float* __restrict__ ATT, const float* __restrict__ lamv, const float* __restrict__ subln, float lam_init,
                             const float* __restrict__ OF, const float* __restrict__ OB, const float* __restrict__ P, const float* __restrict__ gain) {
    const int TID = opaque_tid(), BID = opaque_bid(); (void)TID; (void)BID;
    int wave = BID * NWV + (TID >> 6), lane = TID & 63;
    int nw = gridDim.x * NWV;
    float p1 = lamv[lane] * lamv[64 + lane], p2 = lamv[128 + lane] * lamv[192 + lane];
    p1 = wave_sum(p1); p2 = wave_sum(p2);
    const float lam = expf(p1) - expf(p2) + lam_init;
    for (int r = wave; r < RT; r += nw) {
        float* a = ATT + (size_t)r * DM;
        float d[4][2];
#pragma unroll
        for (int h = 0; h < 4; ++h) {
            float2 o0 = *(const float2*)(a + (2 * h) * 128 + lane * 2);
            float2 o1 = *(const float2*)(a + (2 * h + 1) * 128 + lane * 2);
            d[h][0] = o0.x - lam * o1.x; d[h][1] = o0.y - lam * o1.y;
        }
        float2 outd[4];
#pragma unroll
        for (int h = 0; h < 4; ++h) {
            float s = wave_sum(d[h][0] * d[h][0] + d[h][1] * d[h][1]);
            float rstd = rsqrtf(s * (1.f / 128.f) + 1e-6f) * (1.f - lam_init);
            float2 sg = *(const float2*)(subln + lane * 2);
            outd[h] = make_float2(d[h][0] * rstd * sg.x, d[h][1] * rstd * sg.y);
        }
        float2 outg[4];
#pragma unroll
        for (int h = 0; h < 4; ++h) {
            float2 x = *(const float2*)(OF + (size_t)r * 512 + h * 128 + lane * 2);
            float2 c = *(const float2*)(OB + (size_t)r * 512 + h * 128 + lane * 2);
            float o0 = x.x + c.x, o1 = x.y + c.y;
            float s = wave_sum(o0 * o0 + o1 * o1);
            float rstd = rsqrtf(s * (1.f / 128.f) + 1e-6f);
            float2 g = *(const float2*)(gain + lane * 2);
            float2 rr = *(const float2*)(P + (size_t)r * EVEN_IN + 2560 + h * 128 + lane * 2);
            outg[h] = make_float2(o0 * rstd * g.x * silu_f(rr.x), o1 * rstd * g.y * silu_f(rr.y));
        }
#pragma unroll
        for (int h = 0; h < 4; ++h) {
            *(float2*)(a + h * 128 + lane * 2) = outd[h];
            *(float2*)(a + 512 + h * 128 + lane * 2) = outg[h];
        }
    }
}
#define INS16(tv, ti, v, n) do { \
    _Pragma("unroll") for (int j_ = 15; j_ >= 1; --j_) { bool c1_ = (v) > tv[j_ - 1]; bool c2_ = (v) > tv[j_]; \
        tv[j_] = c1_ ? tv[j_ - 1] : (c2_ ? (v) : tv[j_]); ti[j_] = c1_ ? ti[j_ - 1] : (c2_ ? (n) : ti[j_]); } \
    { bool c_ = (v) > tv[0]; tv[0] = c_ ? (v) : tv[0]; ti[0] = c_ ? (n) : ti[0]; } } while (0)

__device__ __forceinline__ void ph_peer_route(const float* __restrict__ Qp, const float* __restrict__ keys_l, int* __restrict__ IDX, float* __restrict__ GATE) {
    const int TID = opaque_tid(), BID = opaque_bid(); (void)TID; (void)BID;
    for (int vb = BID; vb < (RT / NT) * 8; vb += gridDim.x) {
        const int h = vb & 7, r = (vb >> 3) * NT + TID;
        float tv[2][16]; int ti[2][16];
#pragma unroll
        for (int half = 0; half < 2; ++half) {
            float q[64];
            const float4* qp = (const float4*)(Qp + (size_t)r * DM + h * 128 + half * 64);
#pragma unroll
            for (int i = 0; i < 16; ++i) { float4 t = qp[i]; q[4 * i] = t.x; q[4 * i + 1] = t.y; q[4 * i + 2] = t.z; q[4 * i + 3] = t.w; }
#pragma unroll
            for (int j = 0; j < 16; ++j) { tv[half][j] = -3.0e38f; ti[half][j] = 0; }
            const float* kb = keys_l + (size_t)(h * 2 + half) * 128 * 64;
            for (int n = 0; n < 128; ++n) {
                float s = 0.f;
#pragma unroll
                for (int d = 0; d < 64; ++d) s += q[d] * kb[n * 64 + d];
                INS16(tv[half], ti[half], s, n);
            }
        }
        float bv[16]; int bi[16];
#pragma unroll
        for (int j = 0; j < 16; ++j) { bv[j] = -3.0e38f; bi[j] = 0; }
#pragma unroll
        for (int a = 0; a < 16; ++a)
#pragma unroll
            for (int b = 0; b < 16; ++b) {
                if ((a + 1) * (b + 1) <= 16) {
                    float s = tv[0][a] + tv[1][b]; int id = ti[0][a] * 128 + ti[1][b];
                    INS16(bv, bi, s, id);
                }
            }
        float mx = bv[0], sum = 0.f, e[16];
#pragma unroll
        for (int j = 0; j < 16; ++j) { e[j] = expf(bv[j] - mx); sum += e[j]; }
        float inv = 1.f / sum;
#pragma unroll
        for (int j = 0; j < 16; ++j) { IDX[(size_t)r * 128 + h * 16 + j] = bi[j]; GATE[(size_t)r * 128 + h * 16 + j] = e[j] * inv; }
    }
}
__device__ __forceinline__ void ph_peer_ffn(const float* __restrict__ A2, const int* __restrict__ IDX, const float* __restrict__ GATE,
                            const float* __restrict__ U, const float* __restrict__ V, const float* __restrict__ mods_l, float* __restrict__ X) {
    const int TID = opaque_tid(), BID = opaque_bid(); (void)TID; (void)BID;
    int wave = BID * NWV + (TID >> 6), lane = TID & 63;
    int nw = gridDim.x * NWV;
    for (int r = wave; r < RT; r += nw) {
        float4 xa[4], acc[4];
#pragma unroll
        for (int i = 0; i < 4; ++i) { xa[i] = ((const float4*)(A2 + (size_t)r * DM))[lane + 64 * i]; acc[i] = make_float4(0.f, 0.f, 0.f, 0.f); }
        for (int e = 0; e < 128; ++e) {
            int id = IDX[(size_t)r * 128 + e]; float g = GATE[(size_t)r * 128 + e];
            const float4* ur = (const float4*)(U + (size_t)id * DM);
            float d = 0.f;
#pragma unroll
            for (int i = 0; i < 4; ++i) { float4 u = ur[lane + 64 * i]; d += u.x * xa[i].x + u.y * xa[i].y + u.z * xa[i].z + u.w * xa[i].w; }
            d = wave_sum(d);
            float w = g * gelu_tanh(d);
            const float4* vr = (const float4*)(V + (size_t)id * DM);
#pragma unroll
            for (int i = 0; i < 4; ++i) { float4 v = vr[lane + 64 * i]; acc[i].x += w * v.x; acc[i].y += w * v.y; acc[i].z += w * v.z; acc[i].w += w * v.w; }
        }
        const float4* g5 = (const float4*)(mods_l + (size_t)row_mod(r) * MODW + 5 * DM);
        float4* xr = (float4*)(X + (size_t)r * DM);
#pragma unroll
        for (int i = 0; i < 4; ++i) { float4 x = xr[lane + 64 * i], gg = g5[lane + 64 * i];
            x.x += gg.x * acc[i].x; x.y += gg.y * acc[i].y; x.z += gg.z * acc[i].z; x.w += gg.w * acc[i].w; xr[lane + 64 * i] = x; }
    }
}

#define SMEM_FLOATS (NMOD * DM)
__global__ void __launch_bounds__(NT, 2) mega(Params p) {
    __shared__ __attribute__((aligned(16))) float smem[SMEM_FLOATS];
    cg::grid_group grid = cg::this_grid();
    const float* x = p.in[0];       const float* c = p.in[1];       const float* ctx = p.in[2];     const float* c_ctx = p.in[3];
    const float* w_mod = p.in[4];   const float* b_mod = p.in[5];   const float* g_mix = p.in[6];   const float* g_ffn = p.in[7];
    const float* w_in_even = p.in[8];  const float* w_out_even = p.in[9];
    const float* a_q_gain = p.in[10];  const float* a_k_gain = p.in[11]; const float* a_lambda = p.in[12];  const float* a_subln = p.in[13];
    const float* b_w_af = p.in[14];    const float* b_b_af = p.in[15];   const float* b_w_ab = p.in[16];    const float* b_b_ab = p.in[17];
    const float* b_gain = p.in[18];
    const float* w_in_odd = p.in[19];  const float* w_out_odd = p.in[20]; const float* c_q_gain = p.in[21];  const float* c_k_gain = p.in[22];
    const float* peer_wq = p.in[23];   const float* peer_keys = p.in[24]; const float* peer_u = p.in[25];    const float* peer_v = p.in[26];
    float* ws = p.ws;
    float* X = ws;
    float* A = X + (size_t)RT * DM;
    float* P = A + (size_t)RT * DM;
    float* ATT = P + (size_t)RT * EVEN_IN;
    float* MODS = ATT + (size_t)RT * DM;
    float2* ROPE = (float2*)(MODS + (size_t)DEPTH * NMOD * MODW);
    float* OF = A; float* OB = A + (size_t)RT * 512;
    float* Qp = P; int* IDX = (int*)(P + (size_t)RT * DM); float* GATE = P + (size_t)RT * DM + (size_t)RT * 128;

    ph_copy_in(x, ctx, X);
    ph_rope_table(ROPE);
    ph_mods(c, c_ctx, w_mod, b_mod, MODS, smem);
    grid.sync();
    for (int l = 0; l < DEPTH; ++l) {
        const float* mods_l = MODS + (size_t)l * NMOD * MODW;
        const int i = l / 2;
        ph_norm_mod(X, g_mix + l * DM, mods_l, 0, A);
        grid.sync();
        if ((l & 1) == 0) {
            const float lam_init = 0.8f - 0.6f * expf(-0.3f * (float)l);
            ph_gemm<0>(A, DM, w_in_even + (size_t)i * DM * EVEN_IN, EVEN_IN, P, EVEN_IN, RT, EVEN_IN, DM, nullptr, smem);
            grid.sync();
            ph_headnorm_rope(P, EVEN_IN, 0, 8, a_q_gain + i * 64, ROPE);
            ph_headnorm_rope(P, EVEN_IN, 512, 8, a_k_gain + i * 64, ROPE);
            grid.sync();
            ph_gla_seq(P, b_w_af + i * 16 * 256, b_b_af + i * 256, b_w_ab + i * 16 * 256, b_b_ab + i * 256, OF, OB, smem);
            ph_attn(P, EVEN_IN, 0, 512, 1, 1024, 2, 128, 8, ATT, DM, smem);
            grid.sync();
            ph_even_post(ATT, a_lambda + i * 256, a_subln + i * 128, lam_init, OF, OB, P, b_gain + i * 128);
            grid.sync();
            ph_gemm<1>(ATT, DM, w_out_even + (size_t)i * DM * DM, DM, X, DM, RT, DM, DM, mods_l + 2 * DM, smem);
        } else {
            ph_gemm<0>(A, DM, w_in_odd + (size_t)i * DM * ODD_IN, ODD_IN, P, ODD_IN, RT, ODD_IN, DM, nullptr, smem);
            grid.sync();
            ph_headnorm_rope(P, ODD_IN, 0, 16, c_q_gain + i * 64, ROPE);
            ph_headnorm_rope(P, ODD_IN, 1024, 4, c_k_gain + i * 64, ROPE);
            grid.sync();
            ph_attn(P, ODD_IN, 0, 1024, 4, 1280, 4, 64, 16, ATT, DM, smem);
            grid.sync();
            ph_gemm<1>(ATT, DM, w_out_odd + (size_t)i * DM * DM, DM, X, DM, RT, DM, DM, mods_l + 2 * DM, smem);
        }
        grid.sync();
        ph_norm_mod(X, g_ffn + l * DM, mods_l, 3, A);
        grid.sync();
        ph_gemm<0>(A, DM, peer_wq + (size_t)l * DM * DM, DM, Qp, DM, RT, DM, DM, nullptr, smem);
        grid.sync();
        ph_peer_route(Qp, peer_keys + (size_t)l * 8 * 2 * 128 * 64, IDX, GATE);
        grid.sync();
        ph_peer_ffn(A, IDX, GATE, peer_u + (size_t)l * 16384 * DM, peer_v + (size_t)l * 16384 * DM, mods_l, X);
        grid.sync();
    }
    ph_copy_out(X, p.out);
}

extern "C" void kernel_launch(void* const* d_in, const int* in_sizes, int n_in, void* d_out, int out_size, void* d_ws, size_t ws_size, hipStream_t stream) {
    static int grid_blocks = 0;
    if (!grid_blocks) {
        int dev = 0, cus = 0, per_cu = 0;
        hipGetDevice(&dev);
        hipDeviceGetAttribute(&cus, hipDeviceAttributeMultiprocessorCount, dev);
        hipOccupancyMaxActiveBlocksPerMultiprocessor(&per_cu, mega, NT, 0);
        if (per_cu < 1) per_cu = 1;
        if (per_cu > 1) per_cu = 1;
        grid_blocks = cus * per_cu;
    }
    Params p{};
    for (int i = 0; i < 27; ++i) p.in[i] = (const float*)d_in[i];
    p.out = (float*)d_out; p.ws = (float*)d_ws;
    void* args[] = {&p};
    hipError_t e = hipLaunchCooperativeKernel((void*)mega, dim3(grid_blocks), dim3(NT), args, 0, stream);
    if (e != hipSuccess) fprintf(stderr, "cooperative launch failed: %s (grid %d)\n", hipGetErrorString(e), grid_blocks);
}
```

```cpp
#include <hip/hip_runtime.h>
#include <hip/hip_cooperative_groups.h>
#include <stdint.h>
#include <cstdio>
namespace cg = cooperative_groups;

#define DM 1024
#define NB 16
#define SEQ 2048
#define CTX 256
#define RL (NB * SEQ)
#define RC (NB * CTX)
#define RT (RL + RC)
#define DEPTH 4
#define EVEN_IN 3104
#define EVEN_LDP 3328
#define ODD_IN 1536
#define NMOD 17
#define MODW 6144
#define NT 512
#define NWV 8
#define LDS_BYTES 147456

typedef unsigned short bf16;
struct Params {
    const float* in[27];
    float* out;
    unsigned char* ws;
};

__device__ __forceinline__ int row_mod(int r) { return r < RL ? (r >> 11) : 16; }
__device__ __forceinline__ float silu_f(float x) { return x / (1.f + expf(-x)); }
__device__ __forceinline__ float wave_sum(float v) {
#pragma unroll
    for (int o = 1; o < 64; o <<= 1) v += __shfl_xor(v, o);
    return v;
}
__device__ __forceinline__ float log_sigmoid_f(float z) { return fminf(z, 0.f) - log1pf(expf(-fabsf(z))); }
__device__ __forceinline__ float gelu_tanh(float x) { float u = 0.7978845608028654f * (x + 0.044715f * x * x * x); return 0.5f * x * (1.f + tanhf(u)); }
__device__ __forceinline__ float bf2f(bf16 v) { return __uint_as_float((unsigned)v << 16); }
__device__ __forceinline__ unsigned f2bf(float f) { unsigned u = __float_as_uint(f); return (u + 0x7fffu + ((u >> 16) & 1u)) >> 16; }
__device__ __forceinline__ unsigned pk2(float lo, float hi) { return f2bf(lo) | (f2bf(hi) << 16); }
__device__ __forceinline__ float4 ld4bf(const bf16* p) { uint2 u = *(const uint2*)p; return make_float4(__uint_as_float(u.x << 16), __uint_as_float(u.x & 0xffff0000u), __uint_as_float(u.y << 16), __uint_as_float(u.y & 0xffff0000u)); }
__device__ __forceinline__ void st4bf(bf16* p, float4 v) { *(uint2*)p = make_uint2(pk2(v.x, v.y), pk2(v.z, v.w)); }
__device__ __forceinline__ float2 ld2bf(const bf16* p) { unsigned u = *(const unsigned*)p; return make_float2(__uint_as_float(u << 16), __uint_as_float(u & 0xffff0000u)); }
__device__ __forceinline__ void st2bf(bf16* p, float2 v) { *(unsigned*)p = pk2(v.x, v.y); }

__device__ __forceinline__ int opaque_tid() { int t = threadIdx.x; asm volatile("" : "+v"(t)); return t; }
__device__ __forceinline__ int opaque_bid() { int b = blockIdx.x; asm volatile("" : "+s"(b)); return b; }

namespace pg8 {
#define PG8_LAS __attribute__((address_space(3)))
typedef unsigned short bf16_t;
typedef short bf16x8 __attribute__((ext_vector_type(8)));
typedef float f32x4 __attribute__((ext_vector_type(4)));
typedef unsigned u32x4 __attribute__((ext_vector_type(4)));
constexpr int BM = 256, BK = 64, HALF = 128, HTB = HALF * BK * 2  , STAGE_BYTES = 8 * HTB, NXCD = 8, WGM = 8;

__host__ __device__ __forceinline__ int lds_byte(int r, int c) { const int st = (r >> 4) * 2 + (c >> 5), rr = r & 15, cc = c & 31, ob = rr * 64 + cc * 2; return st * 1024 + (ob ^ (((ob >> 9) & 1) << 5)); }
__host__ __device__ __forceinline__ void stage_rc(int b, int& R, int& C) { const int st = b / 1024, sb = b % 1024, swz = sb ^ (((sb >> 9) & 1) << 5); R = (st >> 1) * 16 + swz / 64; C = (st & 1) * 32 + (swz % 64) / 2; }
__host__ __device__ __forceinline__ int perm32(int rho) { const int n = rho >> 4, i = rho & 15; return 8 * (i >> 2) + 4 * n + (i & 3); }

struct Unit { int pm, pn; };
struct Gemm { const bf16_t* A; const bf16_t* Bt; int M, N, K; };

struct StaticOrder {
    int nM, nN, nwg, G, c;
    __host__ __device__ void init(int M, int N, int G_, int c_) { nM = M / BM; nN = N / BM; nwg = nM * nN; G = G_; c = c_; }
    __host__ __device__ bool next(int i, Unit& u) const {
        const long L = (long)i * G + c; if (L >= nwg) return false;
        int wgid = (int)L; { const int q = nwg / NXCD, r = nwg % NXCD, xcd = wgid % NXCD, off = wgid / NXCD; wgid = (xcd < r ? xcd * (q + 1) : r * (q + 1) + (xcd - r) * q) + off; }
        const int nig = WGM * nN, gid = wgid / nig, fm = gid * WGM, gsz = (nM - fm) < WGM ? (nM - fm) : WGM;
        u.pm = fm + ((wgid % nig) % gsz); u.pn = (wgid % nig) / gsz; return true;
    }
    __device__ __forceinline__ void a_ready(const Unit&) const {}
    __device__ __forceinline__ void done(const Unit&) const {}
};

__device__ __forceinline__ unsigned cvt_pk_bf16(float lo, float hi) { unsigned r; asm volatile("v_cvt_pk_bf16_f32 %0, %1, %2" : "=v"(r) : "v"(lo), "v"(hi)); return r; }
typedef float f32x2 __attribute__((ext_vector_type(2)));
__device__ __forceinline__ f32x2 gelu_pk(f32x2 v) {
    const f32x2 av = __builtin_elementwise_abs(v), d = av * 0.2316418882f + 1.0f;
    f32x2 t; t.x = __builtin_amdgcn_rcpf(d.x); t.y = __builtin_amdgcn_rcpf(d.y);
    f32x2 q = t * 0.5307027145f + (-0.7265760135f); q = q * t + 0.7107068705f; q = q * t + (-0.142248368f); q = q * t + 0.127414796f; q = q * t;
    const f32x2 s = (v * v) * (-0.72134752044f);
    f32x2 e; e.x = __builtin_amdgcn_exp2f(s.x); e.y = __builtin_amdgcn_exp2f(s.y);
    const f32x2 m = v * (q * e), r = v - m;
    f32x2 o; o.x = v.x < 0.f ? m.x : r.x; o.y = v.y < 0.f ? m.y : r.y; return o;
}

template <int ACT  > struct EpiBf16 {
    static constexpr bool PERM = true, AFTER_DRAIN = false; static_assert(ACT == 0 || ACT == 1, "EpiBf16: ACT is 0 (none) or 1 (gelu_pk)");
    bf16_t* O; int ldc; const float* bias; int split_cols; size_t split_stride; float scale0;
    __device__ __forceinline__ void operator()(const f32x4 (&acc)[2][2][4][2], const Unit& u, int wr, int wc, int fr, int fq) const {
        const int row0 = u.pm * BM + wr * 64 + fr; int colt = u.pn * BM; bf16_t* base = O;
        float sc = 1.f; if (split_cols) { const int t = colt / split_cols; base += (size_t)t * split_stride; colt -= t * split_cols; if (t == 0) sc = scale0; }
        const int col0 = colt + wc * 32 + 8 * fq, bcol0 = u.pn * BM + wc * 32 + 8 * fq;
        f32x4 bv[2][2];
#pragma unroll
        for (int bj = 0; bj < 2; ++bj)
#pragma unroll
            for (int n = 0; n < 2; ++n) bv[bj][n] = bias ? *(const f32x4*)(bias + bcol0 + bj * HALF + 4 * n) : (f32x4){0.f, 0.f, 0.f, 0.f};
#pragma unroll
        for (int ai = 0; ai < 2; ++ai)
#pragma unroll
            for (int m = 0; m < 4; ++m) { bf16_t* rowp = base + (size_t)(row0 + ai * HALF + m * 16) * ldc + col0;
#pragma unroll
                for (int bj = 0; bj < 2; ++bj) { f32x4 v0 = acc[ai][bj][m][0] + bv[bj][0], v1 = acc[ai][bj][m][1] + bv[bj][1];
                    if (ACT == 1) { f32x2 a = gelu_pk((f32x2){v0[0], v0[1]}), b = gelu_pk((f32x2){v0[2], v0[3]}), c = gelu_pk((f32x2){v1[0], v1[1]}), d = gelu_pk((f32x2){v1[2], v1[3]});
                        v0 = (f32x4){a.x, a.y, b.x, b.y}; v1 = (f32x4){c.x, c.y, d.x, d.y}; }
                    v0 = v0 * sc; v1 = v1 * sc; u32x4 w; w.x = cvt_pk_bf16(v0[0], v0[1]); w.y = cvt_pk_bf16(v0[2], v0[3]); w.z = cvt_pk_bf16(v1[0], v1[1]); w.w = cvt_pk_bf16(v1[2], v1[3]);
                    *(u32x4*)(rowp + bj * HALF) = w; } }
    }
};
template <class Epi, class Sched, bool ALIGN_EPI = false, bool SP2 = false>
__device__ __forceinline__ void gemm_phase(PG8_LAS unsigned char* lds, const Gemm g, const Sched& S, const Epi& E) {
    const int tid = opaque_tid(), wid = __builtin_amdgcn_readfirstlane(tid >> 6), lane = tid & 63, wr = wid >> 2, wc = wid & 3, fr = lane & 15, fq = lane >> 4;
    const int K = g.K, nt = K / BK;
    unsigned voffA[2], voffB[2];
#pragma unroll
    for (int i = 0; i < 2; ++i) { int R, C; stage_rc(tid * 16 + i * 8192, R, C); const int Rb = Epi::PERM ? ((R & ~31) + perm32(R & 31)) : R;
        voffA[i] = (unsigned)(R * K + C) * 2u; voffB[i] = (unsigned)(Rb * K + C) * 2u; }
    const size_t kstep = (size_t)(BK * 2);
    const size_t hstep = (size_t)HALF * K * 2;
    const size_t tstep = 2 * hstep;
    const unsigned ldsw = (unsigned)wid * 1024u;
    const int aoff = lds_byte(wr * 64 + fr, fq * 8), boff = lds_byte(wc * 32 + fr, fq * 8);
#define PG8_SA(b, h) (((b) * 2 + (h)) * HTB)
#define PG8_SB(b, h) ((4 + (b) * 2 + (h)) * HTB)
#define PG8_STAGE(bufoff, gbase, voff) do { _Pragma("unroll") for (int _i = 0; _i < 2; ++_i) \
        __builtin_amdgcn_global_load_lds((const unsigned*)((const char*)(gbase) + (voff)[_i]), (PG8_LAS unsigned*)(lds + (bufoff) + ldsw + _i * 8192), 16, 0, 0); } while (0)
#define PG8_LDA(dst, b, h) do { _Pragma("unroll") for (int m = 0; m < 4; ++m) _Pragma("unroll") for (int k = 0; k < 2; ++k) dst[m][k] = *(const PG8_LAS bf16x8*)(lds + PG8_SA(b, h) + aoff + m * 2048 + k * 1024); } while (0)
#define PG8_LDB(dst, b, h) do { _Pragma("unroll") for (int n = 0; n < 2; ++n) _Pragma("unroll") for (int k = 0; k < 2; ++k) dst[n][k] = *(const PG8_LAS bf16x8*)(lds + PG8_SB(b, h) + boff + n * 2048 + k * 1024); } while (0)
#define PG8_MMA(ai, bj, At, Bt) do { __builtin_amdgcn_s_setprio(1); _Pragma("unroll") for (int m = 0; m < 4; ++m) _Pragma("unroll") for (int n = 0; n < 2; ++n) _Pragma("unroll") for (int k = 0; k < 2; ++k) \
        acc[ai][bj][m][n] = __builtin_amdgcn_mfma_f32_16x16x32_bf16(Bt[n][k], At[m][k], acc[ai][bj][m][n], 0, 0, 0); __builtin_amdgcn_s_setprio(0); } while (0)
#define PG8_WAIT_V(n) asm volatile("s_waitcnt vmcnt(" #n ")" ::: "memory")
#define PG8_WAIT_L(n) asm volatile("s_waitcnt lgkmcnt(" #n ")" ::: "memory")
#define PG8_BAR __builtin_amdgcn_s_barrier()
#define PG8_SCHED __builtin_amdgcn_sched_barrier(0)
    Unit cur, nxt; int ui = 0;
    if (!S.next(0, cur)) return;
    f32x4 acc[2][2][4][2];
#pragma unroll
    for (int a = 0; a < 2; ++a)
#pragma unroll
        for (int b = 0; b < 2; ++b)
#pragma unroll
            for (int m = 0; m < 4; ++m)
#pragma unroll
                for (int n = 0; n < 2; ++n) acc[a][b][m][n] = (f32x4){0.f, 0.f, 0.f, 0.f};
    bf16x8 At[4][2], B0[2][2], B1[2][2];
    const char* cA = (const char*)g.A + (size_t)cur.pm * tstep; const char* cB = (const char*)g.Bt + (size_t)cur.pn * tstep;
    S.a_ready(cur);
    if constexpr (SP2) {
        PG8_STAGE(PG8_SB(0, 0), cB, voffB); PG8_STAGE(PG8_SB(0, 1), cB + hstep, voffB); PG8_STAGE(PG8_SA(0, 0), cA, voffA); PG8_STAGE(PG8_SA(0, 1), cA + hstep, voffA);
        if (wr == 1) PG8_BAR;
        PG8_WAIT_V(2); PG8_BAR;
        PG8_STAGE(PG8_SB(1, 0), cB + kstep, voffB); PG8_STAGE(PG8_SA(1, 0), cA + kstep, voffA); PG8_STAGE(PG8_SB(1, 1), cB + hstep + kstep, voffB);
        PG8_WAIT_V(6); PG8_BAR;
    } else {
        PG8_STAGE(PG8_SB(0, 0), cB, voffB); PG8_STAGE(PG8_SA(0, 0), cA, voffA); PG8_STAGE(PG8_SB(0, 1), cB + hstep, voffB); PG8_STAGE(PG8_SA(0, 1), cA + hstep, voffA);
        if (wr == 1) PG8_BAR;
        PG8_WAIT_V(4); PG8_BAR;
        PG8_STAGE(PG8_SB(1, 0), cB + kstep, voffB); PG8_STAGE(PG8_SA(1, 0), cA + kstep, voffA); PG8_STAGE(PG8_SB(1, 1), cB + hstep + kstep, voffB);
        PG8_WAIT_V(6); PG8_BAR;
    }
    for (;;) {
        const bool has_next = S.next(ui + 1, nxt);
        const char* nA = has_next ? (const char*)g.A + (size_t)nxt.pm * tstep : cA; const char* nB = has_next ? (const char*)g.Bt + (size_t)nxt.pn * tstep : cB;
        for (int t = 0; t < nt; t += 2) {
            const bool last = (t == nt - 2);
            const char* a1 = cA + (size_t)(t + 1) * kstep;
            const char* a2 = last ? nA : cA + (size_t)(t + 2) * kstep; const char* b2 = last ? nB : cB + (size_t)(t + 2) * kstep;
            const char* a3 = a2 + kstep; const char* b3 = b2 + kstep;
            if (last && has_next) S.a_ready(nxt);
            if constexpr (SP2) {
            PG8_LDB(B0, 0, 0); PG8_LDB(B1, 0, 1); PG8_SCHED; PG8_LDA(At, 0, 0); PG8_STAGE(PG8_SA(1, 1), a1 + hstep, voffA);
            PG8_WAIT_V(8); PG8_WAIT_L(0); PG8_BAR; PG8_MMA(0, 0, At, B0); PG8_MMA(0, 1, At, B1); PG8_BAR; PG8_SCHED;
            PG8_LDA(At, 0, 1); PG8_STAGE(PG8_SB(0, 0), b2, voffB); PG8_STAGE(PG8_SB(0, 1), b2 + hstep, voffB); PG8_STAGE(PG8_SA(0, 0), a2, voffA);
            PG8_WAIT_V(8); PG8_WAIT_L(0); PG8_BAR; PG8_MMA(1, 0, At, B0); PG8_MMA(1, 1, At, B1); PG8_BAR; PG8_SCHED;
            PG8_LDB(B0, 1, 0); PG8_LDB(B1, 1, 1); PG8_SCHED; PG8_LDA(At, 1, 0); PG8_STAGE(PG8_SA(0, 1), a2 + hstep, voffA);
            PG8_WAIT_V(8); PG8_WAIT_L(0); PG8_BAR; PG8_MMA(0, 0, At, B0); PG8_MMA(0, 1, At, B1); PG8_BAR; PG8_SCHED;
            PG8_LDA(At, 1, 1); PG8_STAGE(PG8_SB(1, 0), b3, voffB); PG8_STAGE(PG8_SB(1, 1), b3 + hstep, voffB); PG8_STAGE(PG8_SA(1, 0), a3, voffA);
            PG8_WAIT_V(8); PG8_WAIT_L(0); PG8_BAR; PG8_MMA(1, 0, At, B0); PG8_MMA(1, 1, At, B1); PG8_BAR; PG8_SCHED;
            } else {
            PG8_LDB(B0, 0, 0); PG8_SCHED; PG8_LDA(At, 0, 0); PG8_STAGE(PG8_SA(1, 1), a1 + hstep, voffA);
            PG8_WAIT_L(8); PG8_BAR; PG8_WAIT_L(0); PG8_MMA(0, 0, At, B0); PG8_BAR; PG8_SCHED;
            PG8_LDB(B1, 0, 1); PG8_STAGE(PG8_SB(0, 0), b2, voffB);
            PG8_BAR; PG8_WAIT_L(0); PG8_MMA(0, 1, At, B1); PG8_BAR;
            PG8_LDA(At, 0, 1); PG8_STAGE(PG8_SA(0, 0), a2, voffA);
            PG8_BAR; PG8_WAIT_L(0); PG8_MMA(1, 0, At, B0); PG8_BAR; PG8_SCHED;
            PG8_STAGE(PG8_SB(0, 1), b2 + hstep, voffB);
            PG8_WAIT_V(6); PG8_BAR; PG8_MMA(1, 1, At, B1); PG8_BAR;
            PG8_LDB(B0, 1, 0); PG8_SCHED; PG8_LDA(At, 1, 0); PG8_STAGE(PG8_SA(0, 1), a2 + hstep, voffA);
            PG8_WAIT_L(8); PG8_BAR; PG8_WAIT_L(0); PG8_MMA(0, 0, At, B0); PG8_BAR; PG8_SCHED;
            PG8_LDB(B1, 1, 1); PG8_STAGE(PG8_SB(1, 0), b3, voffB);
            PG8_BAR; PG8_WAIT_L(0); PG8_MMA(0, 1, At, B1); PG8_BAR;
            PG8_LDA(At, 1, 1); PG8_STAGE(PG8_SA(1, 0), a3, voffA);
            PG8_BAR; PG8_WAIT_L(0); PG8_MMA(1, 0, At, B0); PG8_BAR; PG8_SCHED;
            PG8_STAGE(PG8_SB(1, 1), b3 + hstep, voffB);
            PG8_WAIT_V(6); PG8_BAR; PG8_MMA(1, 1, At, B1); PG8_BAR;
            }
        }
        if constexpr (ALIGN_EPI) { if (wr == 0) PG8_BAR; }
        if constexpr (!Epi::AFTER_DRAIN) { E(acc, cur, wr, wc, fr, fq); S.done(cur); }
        if (!has_next) break;
#pragma unroll
        for (int a = 0; a < 2; ++a)
#pragma unroll
            for (int b = 0; b < 2; ++b)
#pragma unroll
                for (int m = 0; m < 4; ++m)
#pragma unroll
                    for (int n = 0; n < 2; ++n) acc[a][b][m][n] = (f32x4){0.f, 0.f, 0.f, 0.f};
        cur = nxt; cA = nA; cB = nB; ++ui;
        if constexpr (ALIGN_EPI) { if (wr == 1) PG8_BAR; }
    }
    PG8_WAIT_V(0);
    if constexpr (!ALIGN_EPI) { if (wr == 0) PG8_BAR; }
    PG8_BAR;
    if constexpr (Epi::AFTER_DRAIN) { E.fused(acc, cur, wr, wc, fr, fq, lds, wid, lane); S.done(cur); }
#undef PG8_SA
#undef PG8_SB
#undef PG8_STAGE
#undef PG8_LDA
#undef PG8_LDB
#undef PG8_MMA
#undef PG8_WAIT_V
#undef PG8_WAIT_L
#undef PG8_BAR
#undef PG8_SCHED
}
}

struct EpiResGate {
    static constexpr bool PERM = false, AFTER_DRAIN = false;
    float* X; const float* gate;
    __device__ __forceinline__ void operator()(const pg8::f32x4 (&acc)[2][2][4][2], const pg8::Unit& u, int wr, int wc, int fr, int fq) const {
#pragma unroll
        for (int ai = 0; ai < 2; ++ai)
#pragma unroll
            for (int m = 0; m < 4; ++m) {
                const int r = u.pm * 256 + ai * 128 + wr * 64 + m * 16 + fr;
                const float* g = gate + (size_t)row_mod(r) * MODW; float* xr = X + (size_t)r * DM;
#pragma unroll
                for (int bj = 0; bj < 2; ++bj)
#pragma unroll
                    for (int n = 0; n < 2; ++n) {
                        const int c = u.pn * 256 + bj * 128 + wc * 32 + n * 16 + 4 * fq;
                        pg8::f32x4 xv = *(const pg8::f32x4*)(xr + c); const pg8::f32x4 gv = *(const pg8::f32x4*)(g + c);
                        xv = xv + gv * acc[ai][bj][m][n];
                        *(pg8::f32x4*)(xr + c) = xv;
                    }
            }
    }
};
#define LAS __attribute__((address_space(3)))
#define GAS __attribute__((address_space(1)))

__device__ __forceinline__ void ph_copy_in(const float* __restrict__ x, const float* __restrict__ ctx, float* __restrict__ X) {
    const int TID = opaque_tid(), BID = opaque_bid();
    size_t i = (size_t)BID * NT + TID;
    const size_t n4 = (size_t)RT * DM / 4, nl4 = (size_t)RL * DM / 4;
    for (; i < n4; i += (size_t)gridDim.x * NT) ((float4*)X)[i] = i < nl4 ? ((const float4*)x)[i] : ((const float4*)ctx)[i - nl4];
}
__device__ __forceinline__ void ph_copy_out(const float* __restrict__ X, float* __restrict__ out) {
    const int TID = opaque_tid(), BID = opaque_bid();
    size_t i = (size_t)BID * NT + TID;
    const size_t n4 = (size_t)RL * DM / 4;
    for (; i < n4; i += (size_t)gridDim.x * NT) ((float4*)out)[i] = ((const float4*)X)[i];
}
__device__ __forceinline__ void ph_rope_table(float2* __restrict__ rope) {
    const int TID = opaque_tid(), BID = opaque_bid();
    for (int i = BID * NT + TID; i < SEQ * 32; i += gridDim.x * NT) {
        int t = i >> 5, a = (i >> 4) & 1, f = i & 15;
        float pos = a == 0 ? (float)(t >> 6) : (float)(t & 63);
        float inv = powf(10000.f, -(float)f / 16.f);
        float ang = pos * inv;
        rope[i] = make_float2(cosf(ang), sinf(ang));
    }
}
__device__ __forceinline__ void transpose_item(const float* __restrict__ W, int N, bf16* __restrict__ WT, LAS float* scr, int item, int lane) {
    const int K = DM;
    const int nblk = N / 32, kb = item / nblk, nb = item % nblk, k0 = 64 * kb, n0 = 32 * nb;
#pragma unroll 8
    for (int i = 0; i < 32; ++i) { const int kk = 2 * i + (lane >> 5); scr[kk * 33 + (lane & 31)] = W[(size_t)(k0 + kk) * N + n0 + (lane & 31)]; }
    asm volatile("s_waitcnt lgkmcnt(0)" ::: "memory");
    const int c = lane & 7;
#pragma unroll
    for (int j = 0; j < 4; ++j) { const int n = (lane >> 3) + 8 * j; const LAS float* s = scr + (8 * c) * 33 + n;
        uint4 o; o.x = pk2(s[0 * 33], s[1 * 33]); o.y = pk2(s[2 * 33], s[3 * 33]); o.z = pk2(s[4 * 33], s[5 * 33]); o.w = pk2(s[6 * 33], s[7 * 33]);
        *(uint4*)(WT + (size_t)(n0 + n) * K + k0 + 8 * c) = o; }
    asm volatile("s_waitcnt lgkmcnt(0)" ::: "memory");
}
struct WPrep { const float* src[12]; bf16* dst[12]; };
__device__ __forceinline__ void ph_weight_prep(const float* const* in, bf16* WinE, bf16* WoutE, bf16* WinO, bf16* WoutO, bf16* Wpq, unsigned char* lds) {
    const int TID = opaque_tid(), BID = opaque_bid();
    const int lane = TID & 63, wv = TID >> 6;
    LAS float* scr = (LAS float*)((LAS unsigned char*)lds + wv * 16384);
    const int gw = BID * NWV + wv, NGW = gridDim.x * NWV;
    const int NITEMS = 2 * 1552 + 2 * 512 + 2 * 768 + 2 * 512 + 4 * 512;
    for (int it = gw; it < NITEMS; it += NGW) {
        int r = it;
        if (r < 3104) { int i = r / 1552; transpose_item(in[8] + (size_t)i * DM * EVEN_IN, EVEN_IN, WinE + (size_t)i * EVEN_LDP * DM, scr, r % 1552, lane); continue; } r -= 3104;
        if (r < 1024) { int i = r / 512; transpose_item(in[9] + (size_t)i * DM * DM, DM, WoutE + (size_t)i * DM * DM, scr, r % 512, lane); continue; } r -= 1024;
        if (r < 1536) { int i = r / 768; transpose_item(in[19] + (size_t)i * DM * ODD_IN, ODD_IN, WinO + (size_t)i * ODD_IN * DM, scr, r % 768, lane); continue; } r -= 1536;
        if (r < 1024) { int i = r / 512; transpose_item(in[20] + (size_t)i * DM * DM, DM, WoutO + (size_t)i * DM * DM, scr, r % 512, lane); continue; } r -= 1024;
        { int i = r / 512; transpose_item(in[23] + (size_t)i * DM * DM, DM, Wpq + (size_t)i * DM * DM, scr, r % 512, lane); }
    }
    for (int i = BID * NT + TID; i < 2 * 28672; i += gridDim.x * NT) {
        int w = i / 28672, o = i % 28672;
        ((uint4*)(WinE + (size_t)w * EVEN_LDP * DM + (size_t)EVEN_IN * DM))[o] = make_uint4(0u, 0u, 0u, 0u);
    }
}
__device__ __forceinline__ void ph_mods(const float* __restrict__ c, const float* __restrict__ cctx, const float* __restrict__ w_mod,
                        const float* __restrict__ b_mod, float* __restrict__ mods, float* smem) {
    const int TID = opaque_tid(), BID = opaque_bid();
    const int nvb = DEPTH * MODW / NT;
    if (BID >= nvb) return;
    float (*S)[DM] = (float (*)[DM])smem;
    for (int i = TID; i < NMOD * DM; i += NT) {
        int j = i / DM, k = i % DM;
        float v = j < 16 ? c[j * DM + k] : cctx[k];
        S[j][k] = silu_f(v);
    }
    __syncthreads();
    for (int vb = BID; vb < nvb; vb += gridDim.x) {
        int idx = vb * NT + TID, l = idx / MODW, n = idx % MODW;
        const float* W = w_mod + (size_t)l * DM * MODW;
        float acc[NMOD];
#pragma unroll
        for (int j = 0; j < NMOD; ++j) acc[j] = 0.f;
        for (int k = 0; k < DM; ++k) {
            float w = W[(size_t)k * MODW + n];
#pragma unroll
            for (int j = 0; j < NMOD; ++j) acc[j] += S[j][k] * w;
        }
        float b = b_mod[l * MODW + n];
#pragma unroll
        for (int j = 0; j < NMOD; ++j) mods[((size_t)l * NMOD + j) * MODW + n] = acc[j] + b;
    }
    __syncthreads();
}
__device__ __forceinline__ void ph_norm_mod(const float* __restrict__ X, const float* __restrict__ g, const float* __restrict__ mods_l, int shift_chunk, bf16* __restrict__ A) {
    const int TID = opaque_tid(), BID = opaque_bid();
    int wave = BID * NWV + (TID >> 6), lane = TID & 63;
    int nw = gridDim.x * NWV;
    for (int r = wave; r < RT; r += nw) {
        const float4* xr = (const float4*)(X + (size_t)r * DM);
        float4 v[4]; float s = 0.f;
#pragma unroll
        for (int i = 0; i < 4; ++i) { v[i] = xr[lane + 64 * i]; s += v[i].x * v[i].x + v[i].y * v[i].y + v[i].z * v[i].z + v[i].w * v[i].w; }
        s = wave_sum(s);
        float rstd = rsqrtf(s * (1.f / DM) + 1e-6f);
        const float* m = mods_l + (size_t)row_mod(r) * MODW;
        const float4* sh = (const float4*)(m + shift_chunk * DM);
        const float4* sc = (const float4*)(m + (shift_chunk + 1) * DM);
        const float4* g4 = (const float4*)g;
        bf16* ar = A + (size_t)r * DM;
#pragma unroll
        for (int i = 0; i < 4; ++i) {
            int c = lane + 64 * i;
            float4 gg = g4[c], a = sh[c], b = sc[c], o;
            o.x = v[i].x * rstd * gg.x * (1.f + b.x) + a.x;
            o.y = v[i].y * rstd * gg.y * (1.f + b.y) + a.y;
            o.z = v[i].z * rstd * gg.z * (1.f + b.z) + a.z;
            o.w = v[i].w * rstd * gg.w * (1.f + b.w) + a.w;
            st4bf(ar + 4 * c, o);
        }
    }
}
__device__ __forceinline__ void ph_headnorm_rope(bf16* __restrict__ P, int ldp, int col0, int nheads, const float* __restrict__ gain, const float2* __restrict__ rope) {
    const int TID = opaque_tid(), BID = opaque_bid();
    for (int idx = BID * NT + TID; idx < RT * nheads; idx += gridDim.x * NT) {
        int r = idx / nheads, h = idx % nheads;
        bf16* p = P + (size_t)r * ldp + col0 + h * 64;
        float v[64]; float s = 0.f;
#pragma unroll
        for (int i = 0; i < 16; ++i) { float4 t = ld4bf(p + 4 * i); v[4 * i] = t.x; v[4 * i + 1] = t.y; v[4 * i + 2] = t.z; v[4 * i + 3] = t.w; }
#pragma unroll
        for (int i = 0; i < 64; ++i) s += v[i] * v[i];
        float rstd = rsqrtf(s * (1.f / 64.f) + 1e-6f);
#pragma unroll
        for (int i = 0; i < 64; ++i) v[i] = v[i] * rstd * gain[i];
        if (r < RL) {
            int t = r & (SEQ - 1);
            const float2* tab = rope + (size_t)t * 32;
#pragma unroll
            for (int a = 0; a < 2; ++a)
#pragma unroll
                for (int f = 0; f < 16; ++f) {
                    float2 cs = tab[a * 16 + f];
                    float x1 = v[a * 32 + f], x2 = v[a * 32 + 16 + f];
                    v[a * 32 + f] = x1 * cs.x - x2 * cs.y;
                    v[a * 32 + 16 + f] = x2 * cs.x + x1 * cs.y;
                }
        }
#pragma unroll
        for (int i = 0; i < 16; ++i) st4bf(p + 4 * i, make_float4(v[4 * i], v[4 * i + 1], v[4 * i + 2], v[4 * i + 3]));
    }
}
__device__ __forceinline__ void ph_attn(const bf16* __restrict__ P, int ldp, int qcol0, int kcol0, int kdiv, int vcol0, int vdiv, int DV, int nheads,
                        bf16* __restrict__ O, int ldo, float* smem) {
    const int TID = opaque_tid(), BID = opaque_bid();
    const int tid = TID, half = tid >> 8, ht = tid & 255;
    float (*Ks)[64] = (float (*)[64])(smem + half * 2048);
    float (*Vs)[32] = (float (*)[32])(smem + 1024 + half * 2048);
    const int nch = DV / 32;
    const int nunits = 144 * nheads * nch;
    for (int vb = BID; vb < nunits / 2; vb += gridDim.x) {
        const int u = vb * 2 + half;
        const int bx = u / (nheads * nch), rem = u % (nheads * nch), qh = rem / nch, ch = rem % nch;
        int b, r, nkeys;
        if (bx < 128) { b = bx >> 3; r = b * SEQ + (bx & 7) * 256 + ht; nkeys = CTX + SEQ; }
        else { b = bx - 128; r = RL + b * CTX + ht; nkeys = CTX; }
        float q[64], o[32];
        {
            const bf16* qp = P + (size_t)r * ldp + qcol0 + qh * 64;
#pragma unroll
            for (int i = 0; i < 16; ++i) { float4 t = ld4bf(qp + 4 * i); q[4 * i] = t.x * 0.125f; q[4 * i + 1] = t.y * 0.125f; q[4 * i + 2] = t.z * 0.125f; q[4 * i + 3] = t.w * 0.125f; }
        }
#pragma unroll
        for (int i = 0; i < 32; ++i) o[i] = 0.f;
        float m = -1e30f, l = 0.f;
        const int kh = qh / kdiv, vh = qh / vdiv;
        for (int j0 = 0; j0 < CTX + SEQ; j0 += 8) {
            __syncthreads();
            const bool act = j0 < nkeys;
            if (act && ht < 128) {
                int jj = ht >> 4, c4 = ht & 15;
                int j = j0 + jj;
                int kr = j < CTX ? RL + b * CTX + j : b * SEQ + (j - CTX);
                *(float4*)&Ks[jj][c4 * 4] = ld4bf(P + (size_t)kr * ldp + kcol0 + kh * 64 + c4 * 4);
                if (c4 < 8) *(float4*)&Vs[jj][c4 * 4] = ld4bf(P + (size_t)kr * ldp + vcol0 + vh * DV + ch * 32 + c4 * 4);
            }
            __syncthreads();
            if (act) {
                float s[8]; float tm = -1e30f;
#pragma unroll
                for (int jj = 0; jj < 8; ++jj) {
                    float a = 0.f;
#pragma unroll
                    for (int d4 = 0; d4 < 16; ++d4) { float4 kv = *(const float4*)&Ks[jj][d4 * 4]; a += q[4 * d4] * kv.x + q[4 * d4 + 1] * kv.y + q[4 * d4 + 2] * kv.z + q[4 * d4 + 3] * kv.w; }
                    s[jj] = a; tm = fmaxf(tm, a);
                }
                float mn = fmaxf(m, tm), f = expf(m - mn);
                l *= f;
#pragma unroll
                for (int i = 0; i < 32; ++i) o[i] *= f;
                m = mn;
#pragma unroll
                for (int jj = 0; jj < 8; ++jj) {
                    float p = expf(s[jj] - m); l += p;
#pragma unroll
                    for (int d4 = 0; d4 < 8; ++d4) { float4 vv = *(const float4*)&Vs[jj][d4 * 4]; o[4 * d4] += p * vv.x; o[4 * d4 + 1] += p * vv.y; o[4 * d4 + 2] += p * vv.z; o[4 * d4 + 3] += p * vv.w; }
                }
            }
        }
        float il = 1.f / l;
        bf16* op = O + (size_t)r * ldo + qh * DV + ch * 32;
#pragma unroll
        for (int i = 0; i < 8; ++i) st4bf(op + 4 * i, make_float4(o[4 * i] * il, o[4 * i + 1] * il, o[4 * i + 2] * il, o[4 * i + 3] * il));
    }
    __syncthreads();
}
__device__ __forceinline__ void ph_gla_seq(const bf16* __restrict__ P, const float* __restrict__ w_af, const float* __restrict__ b_af,
                           const float* __restrict__ w_ab, const float* __restrict__ b_ab, float* __restrict__ OF, float* __restrict__ OB, float* smem) {
    const int TID = opaque_tid(), BID = opaque_bid();
    const int tid = TID, hb = tid >> 8, ht = tid & 255, col = ht & 127, half = ht >> 7;
    float* sa = smem + hb * 512; float* sk = sa + 64; float* sq = sa + 128; float* spart = sa + 192;
    for (int vb = BID; vb < NB * 4 * 2 / 2; vb += gridDim.x) {
        const int u = vb * 2 + hb;
        const int dir = u & 1, h = (u >> 1) & 3, b = u >> 3;
        const float* wa = dir ? w_ab : w_af; const float* ba = dir ? b_ab : b_af;
        float* Od = dir ? OB : OF;
        float S[32];
#pragma unroll
        for (int i = 0; i < 32; ++i) S[i] = 0.f;
        float wreg[16]; float breg = 0.f;
#pragma unroll
        for (int j = 0; j < 16; ++j) wreg[j] = 0.f;
        if (ht < 64) {
#pragma unroll
            for (int j = 0; j < 16; ++j) wreg[j] = wa[j * 256 + h * 64 + ht];
            breg = ba[h * 64 + ht];
        }
        for (int step = 0; step < CTX + SEQ; ++step) {
            int r;
            if (!dir) r = step < CTX ? RL + b * CTX + step : b * SEQ + (step - CTX);
            else r = step < CTX ? RL + b * CTX + (CTX - 1 - step) : b * SEQ + (SEQ - 1 - (step - CTX));
            const bf16* p = P + (size_t)r * EVEN_LDP;
            if (ht < 64) {
                float z = breg;
#pragma unroll
                for (int j = 0; j < 16; ++j) z += bf2f(p[3072 + dir * 16 + j]) * wreg[j];
                sa[ht] = expf(log_sigmoid_f(z) * (1.f / 16.f));
                sk[ht] = bf2f(p[1792 + h * 64 + ht]);
                sq[ht] = bf2f(p[1536 + h * 64 + ht]) * 0.125f;
            }
            float v = bf2f(p[2048 + h * 128 + col]);
            __syncthreads();
            float part = 0.f;
#pragma unroll
            for (int dd = 0; dd < 32; ++dd) {
                int d = half * 32 + dd;
                S[dd] = sa[d] * S[dd] + sk[d] * v;
                part += sq[d] * S[dd];
            }
            spart[half * 128 + col] = part;
            __syncthreads();
            if (half == 0) Od[(size_t)r * 512 + h * 128 + col] = spart[col] + spart[128 + col];
        }
    }
    __syncthreads();
}
__device__ __forceinline__ void ph_even_post(bf16* __restrict__ ATT, const float* __restrict__ lamv, const float* __restrict__ subln, float lam_init,
                             const float* __restrict__ OF, const float* __restrict__ OB, const bf16* __restrict__ P, const float* __restrict__ gain) {
    const int TID = opaque_tid(), BID = opaque_bid();
    int wave = BID * NWV + (TID >> 6), lane = TID & 63;
    int nw = gridDim.x * NWV;
    float p1 = lamv[lane] * lamv[64 + lane], p2 = lamv[128 + lane] * lamv[192 + lane];
    p1 = wave_sum(p1); p2 = wave_sum(p2);
    const float lam = expf(p1) - expf(p2) + lam_init;
    for (int r = wave; r < RT; r += nw) {
        bf16* a = ATT + (size_t)r * DM;
        float d[4][2];
#pragma unroll
        for (int h = 0; h < 4; ++h) {
            float2 o0 = ld2bf(a + (2 * h) * 128 + lane * 2);
            float2 o1 = ld2bf(a + (2 * h + 1) * 128 + lane * 2);
            d[h][0] = o0.x - lam * o1.x; d[h][1] = o0.y - lam * o1.y;
        }
        float2 outd[4];
#pragma unroll
        for (int h = 0; h < 4; ++h) {
            float s = wave_sum(d[h][0] * d[h][0] + d[h][1] * d[h][1]);
            float rstd = rsqrtf(s * (1.f / 128.f) + 1e-6f) * (1.f - lam_init);
            float2 sg = *(const float2*)(subln + lane * 2);
            outd[h] = make_float2(d[h][0] * rstd * sg.x, d[h][1] * rstd * sg.y);
        }
        float2 outg[4];
#pragma unroll
        for (int h = 0; h < 4; ++h) {
            float2 x = *(const float2*)(OF + (size_t)r * 512 + h * 128 + lane * 2);
            float2 c = *(const float2*)(OB + (size_t)r * 512 + h * 128 + lane * 2);
            float o0 = x.x + c.x, o1 = x.y + c.y;
            float s = wave_sum(o0 * o0 + o1 * o1);
            float rstd = rsqrtf(s * (1.f / 128.f) + 1e-6f);
            float2 g = *(const float2*)(gain + lane * 2);
            float2 rr = ld2bf(P + (size_t)r * EVEN_LDP + 2560 + h * 128 + lane * 2);
            outg[h] = make_float2(o0 * rstd * g.x * silu_f(rr.x), o1 * rstd * g.y * silu_f(rr.y));
        }
#pragma unroll
        for (int h = 0; h < 4; ++h) {
            st2bf(a + h * 128 + lane * 2, outd[h]);
            st2bf(a + 512 + h * 128 + lane * 2, outg[h]);
        }
    }
}
#define INS16(tv, ti, v, n) do { \
    _Pragma("unroll") for (int j_ = 15; j_ >= 1; --j_) { bool c1_ = (v) > tv[j_ - 1]; bool c2_ = (v) > tv[j_]; \
        tv[j_] = c1_ ? tv[j_ - 1] : (c2_ ? (v) : tv[j_]); ti[j_] = c1_ ? ti[j_ - 1] : (c2_ ? (n) : ti[j_]); } \
    { bool c_ = (v) > tv[0]; tv[0] = c_ ? (v) : tv[0]; ti[0] = c_ ? (n) : ti[0]; } } while (0)

__device__ __forceinline__ void ph_peer_route(const bf16* __restrict__ Qp, const float* __restrict__ keys_l, int* __restrict__ IDX, float* __restrict__ GATE) {
    const int TID = opaque_tid(), BID = opaque_bid();
    for (int vb = BID; vb < (RT / NT) * 8; vb += gridDim.x) {
        const int h = vb & 7, r = (vb >> 3) * NT + TID;
        float tv[2][16]; int ti[2][16];
#pragma unroll
        for (int half = 0; half < 2; ++half) {
            float q[64];
            const bf16* qp = Qp + (size_t)r * DM + h * 128 + half * 64;
#pragma unroll
            for (int i = 0; i < 16; ++i) { float4 t = ld4bf(qp + 4 * i); q[4 * i] = t.x; q[4 * i + 1] = t.y; q[4 * i + 2] = t.z; q[4 * i + 3] = t.w; }
#pragma unroll
            for (int j = 0; j < 16; ++j) { tv[half][j] = -3.0e38f; ti[half][j] = 0; }
            const float* kb = keys_l + (size_t)(h * 2 + half) * 128 * 64;
            for (int n = 0; n < 128; ++n) {
                float s = 0.f;
#pragma unroll
                for (int d = 0; d < 64; ++d) s += q[d] * kb[n * 64 + d];
                INS16(tv[half], ti[half], s, n);
            }
        }
        float bv[16]; int bi[16];
#pragma unroll
        for (int j = 0; j < 16; ++j) { bv[j] = -3.0e38f; bi[j] = 0; }
#pragma unroll
        for (int a = 0; a < 16; ++a)
#pragma unroll
            for (int b = 0; b < 16; ++b) {
                if ((a + 1) * (b + 1) <= 16) {
                    float s = tv[0][a] + tv[1][b]; int id = ti[0][a] * 128 + ti[1][b];
                    INS16(bv, bi, s, id);
                }
            }
        float mx = bv[0], sum = 0.f, e[16];
#pragma unroll
        for (int j = 0; j < 16; ++j) { e[j] = expf(bv[j] - mx); sum += e[j]; }
        float inv = 1.f / sum;
#pragma unroll
        for (int j = 0; j < 16; ++j) { IDX[(size_t)r * 128 + h * 16 + j] = bi[j]; GATE[(size_t)r * 128 + h * 16 + j] = e[j] * inv; }
    }
}
__device__ __forceinline__ void ph_peer_ffn(const bf16* __restrict__ A2, const int* __restrict__ IDX, const float* __restrict__ GATE,
                            const float* __restrict__ U, const float* __restrict__ V, const float* __restrict__ mods_l, float* __restrict__ X) {
    const int TID = opaque_tid(), BID = opaque_bid();
    int wave = BID * NWV + (TID >> 6), lane = TID & 63;
    int nw = gridDim.x * NWV;
    for (int r = wave; r < RT; r += nw) {
        float4 xa[4], acc[4];
#pragma unroll
        for (int i = 0; i < 4; ++i) { xa[i] = ld4bf(A2 + (size_t)r * DM + 4 * (lane + 64 * i)); acc[i] = make_float4(0.f, 0.f, 0.f, 0.f); }
        for (int e = 0; e < 128; ++e) {
            int id = IDX[(size_t)r * 128 + e]; float g = GATE[(size_t)r * 128 + e];
            const float4* ur = (const float4*)(U + (size_t)id * DM);
            float d = 0.f;
#pragma unroll
            for (int i = 0; i < 4; ++i) { float4 u = ur[lane + 64 * i]; d += u.x * xa[i].x + u.y * xa[i].y + u.z * xa[i].z + u.w * xa[i].w; }
            d = wave_sum(d);
            float w = g * gelu_tanh(d);
            const float4* vr = (const float4*)(V + (size_t)id * DM);
#pragma unroll
            for (int i = 0; i < 4; ++i) { float4 v = vr[lane + 64 * i]; acc[i].x += w * v.x; acc[i].y += w * v.y; acc[i].z += w * v.z; acc[i].w += w * v.w; }
        }
        const float4* g5 = (const float4*)(mods_l + (size_t)row_mod(r) * MODW + 5 * DM);
        float4* xr = (float4*)(X + (size_t)r * DM);
#pragma unroll
        for (int i = 0; i < 4; ++i) { float4 x = xr[lane + 64 * i], gg = g5[lane + 64 * i];
            x.x += gg.x * acc[i].x; x.y += gg.y * acc[i].y; x.z += gg.z * acc[i].z; x.w += gg.w * acc[i].w; xr[lane + 64 * i] = x; }
    }
}
template <int N>
__device__ __forceinline__ void ph_gemm_bf16(const bf16* A, const bf16* Bt, bf16* O, unsigned char* lds) {
    pg8::Gemm g{A, Bt, RT, N, DM}; pg8::StaticOrder S; S.init(RT, N, (int)gridDim.x, opaque_bid());
    pg8::EpiBf16<0> E{O, N, nullptr, 0, 0, 1.f};
    pg8::gemm_phase<pg8::EpiBf16<0>, pg8::StaticOrder, true, true>((PG8_LAS unsigned char*)lds, g, S, E);
}
__device__ __forceinline__ void ph_gemm_res(const bf16* A, const bf16* Bt, float* X, const float* gate, unsigned char* lds) {
    pg8::Gemm g{A, Bt, RT, DM, DM}; pg8::StaticOrder S; S.init(RT, DM, (int)gridDim.x, opaque_bid());
    EpiResGate E{X, gate};
    pg8::gemm_phase<EpiResGate, pg8::StaticOrder, true, true>((PG8_LAS unsigned char*)lds, g, S, E);
}

constexpr size_t ALIGN_UP(size_t x) { return (x + 255) & ~(size_t)255; }
constexpr size_t WS_X = 0;
constexpr size_t WS_A = WS_X + (size_t)RT * DM * 4;
constexpr size_t WS_P = WS_A + (size_t)RT * DM * 2;
constexpr size_t WS_ATT = WS_P + (size_t)RT * EVEN_LDP * 2;
constexpr size_t WS_OF = WS_ATT + (size_t)RT * DM * 2;
constexpr size_t WS_MODS = WS_OF + (size_t)RT * 512 * 4 * 2;
constexpr size_t WS_ROPE = WS_MODS + ALIGN_UP((size_t)DEPTH * NMOD * MODW * 4);
constexpr size_t WS_WINE = WS_ROPE + (size_t)SEQ * 32 * 8;
constexpr size_t WS_WOUTE = WS_WINE + (size_t)2 * EVEN_LDP * DM * 2;
constexpr size_t WS_WINO = WS_WOUTE + (size_t)2 * DM * DM * 2;
constexpr size_t WS_WOUTO = WS_WINO + (size_t)2 * ODD_IN * DM * 2;
constexpr size_t WS_WPQ = WS_WOUTO + (size_t)2 * DM * DM * 2;
constexpr size_t WS_END = WS_WPQ + (size_t)4 * DM * DM * 2;

__global__ void __launch_bounds__(NT, 2) mega(Params p) {
    extern __shared__ __attribute__((aligned(16))) unsigned char lds[];
    float* smem = (float*)lds;
    cg::grid_group grid = cg::this_grid();
    unsigned char* ws = p.ws;
#define X_ ((float*)(ws + WS_X))
#define A_ ((bf16*)(ws + WS_A))
#define P_ ((bf16*)(ws + WS_P))
#define ATT_ ((bf16*)(ws + WS_ATT))
#define OF_ ((float*)(ws + WS_OF))
#define OB_ (OF_ + (size_t)RT * 512)
#define MODS_ ((float*)(ws + WS_MODS))
#define ROPE_ ((float2*)(ws + WS_ROPE))
#define WINE_ ((bf16*)(ws + WS_WINE))
#define WOUTE_ ((bf16*)(ws + WS_WOUTE))
#define WINO_ ((bf16*)(ws + WS_WINO))
#define WOUTO_ ((bf16*)(ws + WS_WOUTO))
#define WPQ_ ((bf16*)(ws + WS_WPQ))
#define QP_ P_
#define IDX_ ((int*)(ws + WS_P + (size_t)RT * DM * 2))
#define GATE_ ((float*)(ws + WS_P + (size_t)RT * DM * 2 + (size_t)RT * 128 * 4))

    ph_copy_in(p.in[0], p.in[2], X_);
    ph_rope_table(ROPE_);
    ph_weight_prep(p.in, WINE_, WOUTE_, WINO_, WOUTO_, WPQ_, lds);
    __syncthreads();
    ph_mods(p.in[1], p.in[3], p.in[4], p.in[5], MODS_, smem);
    grid.sync();
    for (int hl = 0; hl < 2 * DEPTH; ++hl) {
        const int l = hl >> 1, part = hl & 1, i = l >> 1, odd = l & 1;
        const float* mods_l = MODS_ + (size_t)l * NMOD * MODW;
        ph_norm_mod(X_, (part ? p.in[7] : p.in[6]) + l * DM, mods_l, part ? 3 : 0, A_);
        grid.sync();
        if (part) ph_gemm_bf16<DM>(A_, WPQ_ + (size_t)l * DM * DM, P_, lds);
        else if (odd) ph_gemm_bf16<ODD_IN>(A_, WINO_ + (size_t)i * ODD_IN * DM, P_, lds);
        else ph_gemm_bf16<EVEN_LDP>(A_, WINE_ + (size_t)i * EVEN_LDP * DM, P_, lds);
        grid.sync();
        if (part == 0) {
            const int ldp = odd ? ODD_IN : EVEN_LDP;
            ph_headnorm_rope(P_, ldp, 0, odd ? 16 : 8, (odd ? p.in[21] : p.in[10]) + i * 64, ROPE_);
            ph_headnorm_rope(P_, ldp, odd ? 1024 : 512, odd ? 4 : 8, (odd ? p.in[22] : p.in[11]) + i * 64, ROPE_);
            grid.sync();
            if (!odd) ph_gla_seq(P_, p.in[14] + i * 16 * 256, p.in[15] + i * 256, p.in[16] + i * 16 * 256, p.in[17] + i * 256, OF_, OB_, smem);
            ph_attn(P_, ldp, 0, odd ? 1024 : 512, odd ? 4 : 1, odd ? 1280 : 1024, odd ? 4 : 2, odd ? 64 : 128, odd ? 16 : 8, ATT_, DM, smem);
            grid.sync();
            if (!odd) {
                const float lam_init = 0.8f - 0.6f * expf(-0.3f * (float)l);
                ph_even_post(ATT_, p.in[12] + i * 256, p.in[13] + i * 128, lam_init, OF_, OB_, P_, p.in[18] + i * 128);
                grid.sync();
            }
            ph_gemm_res(ATT_, odd ? WOUTO_ + (size_t)i * DM * DM : WOUTE_ + (size_t)i * DM * DM, X_, mods_l + 2 * DM, lds);
        } else {
            ph_peer_route(QP_, p.in[24] + (size_t)l * 8 * 2 * 128 * 64, IDX_, GATE_);
            grid.sync();
            ph_peer_ffn(A_, IDX_, GATE_, p.in[25] + (size_t)l * 16384 * DM, p.in[26] + (size_t)l * 16384 * DM, mods_l, X_);
        }
        grid.sync();
    }
    ph_copy_out(X_, p.out);
}

extern "C" void kernel_launch(void* const* d_in, const int* in_sizes, int n_in, void* d_out, int out_size, void* d_ws, size_t ws_size, hipStream_t stream) {
    static int grid_blocks = 0;
    if (!grid_blocks) {
        int dev = 0, cus = 0, per_cu = 0;
        (void)hipGetDevice(&dev);
        (void)hipDeviceGetAttribute(&cus, hipDeviceAttributeMultiprocessorCount, dev);
        (void)hipFuncSetAttribute((const void*)mega, hipFuncAttributeMaxDynamicSharedMemorySize, LDS_BYTES);
        (void)hipOccupancyMaxActiveBlocksPerMultiprocessor(&per_cu, mega, NT, LDS_BYTES);
        if (per_cu < 1) fprintf(stderr, "occupancy query says %d blocks/CU\n", per_cu);
        grid_blocks = cus;
        if (ws_size < WS_END) fprintf(stderr, "workspace too small: %zu < %zu\n", ws_size, (size_t)WS_END);
    }
    Params p{};
    for (int i = 0; i < 27; ++i) p.in[i] = (const float*)d_in[i];
    p.out = (float*)d_out; p.ws = (unsigned char*)d_ws;
    void* args[] = {&p};
    hipError_t e = hipLaunchCooperativeKernel((void*)mega, dim3(grid_blocks), dim3(NT), args, LDS_BYTES, stream);
    if (e != hipSuccess) fprintf(stderr, "cooperative launch failed: %s (grid %d)\n", hipGetErrorString(e), grid_blocks);
}
```

```cpp
#include <hip/hip_runtime.h>
#include <hip/hip_cooperative_groups.h>
#include <stdint.h>
#include <cstdio>
namespace cg = cooperative_groups;

#define DM 1024
#define NB 16
#define SEQ 2048
#define CTX 256
#define RL (NB * SEQ)
#define RC (NB * CTX)
#define RT (RL + RC)
#define DEPTH 4
#define EVEN_IN 3104
#define EVEN_LDP 3328
#define ODD_IN 1536
#define NMOD 17
#define MODW 6144
#define NT 512
#define NWV 8
#define LDS_BYTES 147456

typedef unsigned short bf16;
typedef float f32x2_t __attribute__((ext_vector_type(2)));
typedef __bf16 bf16x2_t __attribute__((ext_vector_type(2)));
struct Params {
    const float* in[27];
    float* out;
    unsigned char* ws;
};

__device__ __forceinline__ int row_mod(int r) { return r < RL ? (r >> 11) : 16; }
__device__ __forceinline__ float silu_f(float x) { return x / (1.f + expf(-x)); }
__device__ __forceinline__ float wave_sum(float v) {
#pragma unroll
    for (int o = 1; o < 64; o <<= 1) v += __shfl_xor(v, o);
    return v;
}
__device__ __forceinline__ float log_sigmoid_f(float z) { return fminf(z, 0.f) - log1pf(expf(-fabsf(z))); }
__device__ __forceinline__ float gelu_tanh(float x) { float u = 0.7978845608028654f * (x + 0.044715f * x * x * x); return 0.5f * x * (1.f + tanhf(u)); }
__device__ __forceinline__ float bf2f(bf16 v) { return __uint_as_float((unsigned)v << 16); }
__device__ __forceinline__ unsigned f2bf(float f) { unsigned u = __float_as_uint(f); return (u + 0x7fffu + ((u >> 16) & 1u)) >> 16; }
__device__ __forceinline__ unsigned pk2(float lo, float hi) { return f2bf(lo) | (f2bf(hi) << 16); }
__device__ __forceinline__ float4 ld4bf(const bf16* p) { uint2 u = *(const uint2*)p; return make_float4(__uint_as_float(u.x << 16), __uint_as_float(u.x & 0xffff0000u), __uint_as_float(u.y << 16), __uint_as_float(u.y & 0xffff0000u)); }
__device__ __forceinline__ void st4bf(bf16* p, float4 v) { *(uint2*)p = make_uint2(pk2(v.x, v.y), pk2(v.z, v.w)); }
__device__ __forceinline__ float2 ld2bf(const bf16* p) { unsigned u = *(const unsigned*)p; return make_float2(__uint_as_float(u << 16), __uint_as_float(u & 0xffff0000u)); }
__device__ __forceinline__ void st2bf(bf16* p, float2 v) { *(unsigned*)p = pk2(v.x, v.y); }

__device__ __forceinline__ int opaque_tid() { int t = threadIdx.x; asm volatile("" : "+v"(t)); return t; }
__device__ __forceinline__ int opaque_bid() { int b = blockIdx.x; asm volatile("" : "+s"(b)); return b; }

namespace pg8 {
#define PG8_LAS __attribute__((address_space(3)))
typedef unsigned short bf16_t;
typedef short bf16x8 __attribute__((ext_vector_type(8)));
typedef float f32x4 __attribute__((ext_vector_type(4)));
typedef unsigned u32x4 __attribute__((ext_vector_type(4)));
constexpr int BM = 256, BK = 64, HALF = 128, HTB = HALF * BK * 2  , STAGE_BYTES = 8 * HTB, NXCD = 8, WGM = 8;

__host__ __device__ __forceinline__ int lds_byte(int r, int c) { const int st = (r >> 4) * 2 + (c >> 5), rr = r & 15, cc = c & 31, ob = rr * 64 + cc * 2; return st * 1024 + (ob ^ (((ob >> 9) & 1) << 5)); }
__host__ __device__ __forceinline__ void stage_rc(int b, int& R, int& C) { const int st = b / 1024, sb = b % 1024, swz = sb ^ (((sb >> 9) & 1) << 5); R = (st >> 1) * 16 + swz / 64; C = (st & 1) * 32 + (swz % 64) / 2; }
__host__ __device__ __forceinline__ int perm32(int rho) { const int n = rho >> 4, i = rho & 15; return 8 * (i >> 2) + 4 * n + (i & 3); }

struct Unit { int pm, pn; };
struct Gemm { const bf16_t* A; const bf16_t* Bt; int M, N, K; };

struct StaticOrder {
    int nM, nN, nwg, G, c;
    __host__ __device__ void init(int M, int N, int G_, int c_) { nM = M / BM; nN = N / BM; nwg = nM * nN; G = G_; c = c_; }
    __host__ __device__ bool next(int i, Unit& u) const {
        const long L = (long)i * G + c; if (L >= nwg) return false;
        int wgid = (int)L; { const int q = nwg / NXCD, r = nwg % NXCD, xcd = wgid % NXCD, off = wgid / NXCD; wgid = (xcd < r ? xcd * (q + 1) : r * (q + 1) + (xcd - r) * q) + off; }
        const int nig = WGM * nN, gid = wgid / nig, fm = gid * WGM, gsz = (nM - fm) < WGM ? (nM - fm) : WGM;
        u.pm = fm + ((wgid % nig) % gsz); u.pn = (wgid % nig) / gsz; return true;
    }
    __device__ __forceinline__ void a_ready(const Unit&) const {}
    __device__ __forceinline__ void done(const Unit&) const {}
};

__device__ __forceinline__ unsigned cvt_pk_bf16(float lo, float hi) { unsigned r; asm volatile("v_cvt_pk_bf16_f32 %0, %1, %2" : "=v"(r) : "v"(lo), "v"(hi)); return r; }
typedef float f32x2 __attribute__((ext_vector_type(2)));
__device__ __forceinline__ f32x2 gelu_pk(f32x2 v) {
    const f32x2 av = __builtin_elementwise_abs(v), d = av * 0.2316418882f + 1.0f;
    f32x2 t; t.x = __builtin_amdgcn_rcpf(d.x); t.y = __builtin_amdgcn_rcpf(d.y);
    f32x2 q = t * 0.5307027145f + (-0.7265760135f); q = q * t + 0.7107068705f; q = q * t + (-0.142248368f); q = q * t + 0.127414796f; q = q * t;
    const f32x2 s = (v * v) * (-0.72134752044f);
    f32x2 e; e.x = __builtin_amdgcn_exp2f(s.x); e.y = __builtin_amdgcn_exp2f(s.y);
    const f32x2 m = v * (q * e), r = v - m;
    f32x2 o; o.x = v.x < 0.f ? m.x : r.x; o.y = v.y < 0.f ? m.y : r.y; return o;
}

template <int ACT  > struct EpiBf16 {
    static constexpr bool PERM = true, AFTER_DRAIN = false; static_assert(ACT == 0 || ACT == 1, "EpiBf16: ACT is 0 (none) or 1 (gelu_pk)");
    bf16_t* O; int ldc; const float* bias; int split_cols; size_t split_stride; float scale0;
    __device__ __forceinline__ void operator()(const f32x4 (&acc)[2][2][4][2], const Unit& u, int wr, int wc, int fr, int fq) const {
        const int row0 = u.pm * BM + wr * 64 + fr; int colt = u.pn * BM; bf16_t* base = O;
        float sc = 1.f; if (split_cols) { const int t = colt / split_cols; base += (size_t)t * split_stride; colt -= t * split_cols; if (t == 0) sc = scale0; }
        const int col0 = colt + wc * 32 + 8 * fq, bcol0 = u.pn * BM + wc * 32 + 8 * fq;
        f32x4 bv[2][2];
#pragma unroll
        for (int bj = 0; bj < 2; ++bj)
#pragma unroll
            for (int n = 0; n < 2; ++n) bv[bj][n] = bias ? *(const f32x4*)(bias + bcol0 + bj * HALF + 4 * n) : (f32x4){0.f, 0.f, 0.f, 0.f};
#pragma unroll
        for (int ai = 0; ai < 2; ++ai)
#pragma unroll
            for (int m = 0; m < 4; ++m) { bf16_t* rowp = base + (size_t)(row0 + ai * HALF + m * 16) * ldc + col0;
#pragma unroll
                for (int bj = 0; bj < 2; ++bj) { f32x4 v0 = acc[ai][bj][m][0] + bv[bj][0], v1 = acc[ai][bj][m][1] + bv[bj][1];
                    if (ACT == 1) { f32x2 a = gelu_pk((f32x2){v0[0], v0[1]}), b = gelu_pk((f32x2){v0[2], v0[3]}), c = gelu_pk((f32x2){v1[0], v1[1]}), d = gelu_pk((f32x2){v1[2], v1[3]});
                        v0 = (f32x4){a.x, a.y, b.x, b.y}; v1 = (f32x4){c.x, c.y, d.x, d.y}; }
                    v0 = v0 * sc; v1 = v1 * sc; u32x4 w; w.x = cvt_pk_bf16(v0[0], v0[1]); w.y = cvt_pk_bf16(v0[2], v0[3]); w.z = cvt_pk_bf16(v1[0], v1[1]); w.w = cvt_pk_bf16(v1[2], v1[3]);
                    *(u32x4*)(rowp + bj * HALF) = w; } }
    }
};
template <class Epi, class Sched, bool ALIGN_EPI = false, bool SP2 = false>
__device__ __forceinline__ void gemm_phase(PG8_LAS unsigned char* lds, const Gemm g, const Sched& S, const Epi& E) {
    const int tid = opaque_tid(), wid = __builtin_amdgcn_readfirstlane(tid >> 6), lane = tid & 63, wr = wid >> 2, wc = wid & 3, fr = lane & 15, fq = lane >> 4;
    const int K = g.K, nt = K / BK;
    unsigned voffA[2], voffB[2];
#pragma unroll
    for (int i = 0; i < 2; ++i) { int R, C; stage_rc(tid * 16 + i * 8192, R, C); const int Rb = Epi::PERM ? ((R & ~31) + perm32(R & 31)) : R;
        voffA[i] = (unsigned)(R * K + C) * 2u; voffB[i] = (unsigned)(Rb * K + C) * 2u; }
    const size_t kstep = (size_t)(BK * 2);
    const size_t hstep = (size_t)HALF * K * 2;
    const size_t tstep = 2 * hstep;
    const unsigned ldsw = (unsigned)wid * 1024u;
    const int aoff = lds_byte(wr * 64 + fr, fq * 8), boff = lds_byte(wc * 32 + fr, fq * 8);
#define PG8_SA(b, h) (((b) * 2 + (h)) * HTB)
#define PG8_SB(b, h) ((4 + (b) * 2 + (h)) * HTB)
#define PG8_STAGE(bufoff, gbase, voff) do { _Pragma("unroll") for (int _i = 0; _i < 2; ++_i) \
        __builtin_amdgcn_global_load_lds((const unsigned*)((const char*)(gbase) + (voff)[_i]), (PG8_LAS unsigned*)(lds + (bufoff) + ldsw + _i * 8192), 16, 0, 0); } while (0)
#define PG8_LDA(dst, b, h) do { _Pragma("unroll") for (int m = 0; m < 4; ++m) _Pragma("unroll") for (int k = 0; k < 2; ++k) dst[m][k] = *(const PG8_LAS bf16x8*)(lds + PG8_SA(b, h) + aoff + m * 2048 + k * 1024); } while (0)
#define PG8_LDB(dst, b, h) do { _Pragma("unroll") for (int n = 0; n < 2; ++n) _Pragma("unroll") for (int k = 0; k < 2; ++k) dst[n][k] = *(const PG8_LAS bf16x8*)(lds + PG8_SB(b, h) + boff + n * 2048 + k * 1024); } while (0)
#define PG8_MMA(ai, bj, At, Bt) do { __builtin_amdgcn_s_setprio(1); _Pragma("unroll") for (int m = 0; m < 4; ++m) _Pragma("unroll") for (int n = 0; n < 2; ++n) _Pragma("unroll") for (int k = 0; k < 2; ++k) \
        acc[ai][bj][m][n] = __builtin_amdgcn_mfma_f32_16x16x32_bf16(Bt[n][k], At[m][k], acc[ai][bj][m][n], 0, 0, 0); __builtin_amdgcn_s_setprio(0); } while (0)
#define PG8_WAIT_V(n) asm volatile("s_waitcnt vmcnt(" #n ")" ::: "memory")
#define PG8_WAIT_L(n) asm volatile("s_waitcnt lgkmcnt(" #n ")" ::: "memory")
#define PG8_BAR __builtin_amdgcn_s_barrier()
#define PG8_SCHED __builtin_amdgcn_sched_barrier(0)
    Unit cur, nxt; int ui = 0;
    if (!S.next(0, cur)) return;
    f32x4 acc[2][2][4][2];
#pragma unroll
    for (int a = 0; a < 2; ++a)
#pragma unroll
        for (int b = 0; b < 2; ++b)
#pragma unroll
            for (int m = 0; m < 4; ++m)
#pragma unroll
                for (int n = 0; n < 2; ++n) acc[a][b][m][n] = (f32x4){0.f, 0.f, 0.f, 0.f};
    bf16x8 At[4][2], B0[2][2], B1[2][2];
    const char* cA = (const char*)g.A + (size_t)cur.pm * tstep; const char* cB = (const char*)g.Bt + (size_t)cur.pn * tstep;
    S.a_ready(cur);
    if constexpr (SP2) {
        PG8_STAGE(PG8_SB(0, 0), cB, voffB); PG8_STAGE(PG8_SB(0, 1), cB + hstep, voffB); PG8_STAGE(PG8_SA(0, 0), cA, voffA); PG8_STAGE(PG8_SA(0, 1), cA + hstep, voffA);
        if (wr == 1) PG8_BAR;
        PG8_WAIT_V(2); PG8_BAR;
        PG8_STAGE(PG8_SB(1, 0), cB + kstep, voffB); PG8_STAGE(PG8_SA(1, 0), cA + kstep, voffA); PG8_STAGE(PG8_SB(1, 1), cB + hstep + kstep, voffB);
        PG8_WAIT_V(6); PG8_BAR;
    } else {
        PG8_STAGE(PG8_SB(0, 0), cB, voffB); PG8_STAGE(PG8_SA(0, 0), cA, voffA); PG8_STAGE(PG8_SB(0, 1), cB + hstep, voffB); PG8_STAGE(PG8_SA(0, 1), cA + hstep, voffA);
        if (wr == 1) PG8_BAR;
        PG8_WAIT_V(4); PG8_BAR;
        PG8_STAGE(PG8_SB(1, 0), cB + kstep, voffB); PG8_STAGE(PG8_SA(1, 0), cA + kstep, voffA); PG8_STAGE(PG8_SB(1, 1), cB + hstep + kstep, voffB);
        PG8_WAIT_V(6); PG8_BAR;
    }
    for (;;) {
        const bool has_next = S.next(ui + 1, nxt);
        const char* nA = has_next ? (const char*)g.A + (size_t)nxt.pm * tstep : cA; const char* nB = has_next ? (const char*)g.Bt + (size_t)nxt.pn * tstep : cB;
        for (int t = 0; t < nt; t += 2) {
            const bool last = (t == nt - 2);
            const char* a1 = cA + (size_t)(t + 1) * kstep;
            const char* a2 = last ? nA : cA + (size_t)(t + 2) * kstep; const char* b2 = last ? nB : cB + (size_t)(t + 2) * kstep;
            const char* a3 = a2 + kstep; const char* b3 = b2 + kstep;
            if (last && has_next) S.a_ready(nxt);
            if constexpr (SP2) {
            PG8_LDB(B0, 0, 0); PG8_LDB(B1, 0, 1); PG8_SCHED; PG8_LDA(At, 0, 0); PG8_STAGE(PG8_SA(1, 1), a1 + hstep, voffA);
            PG8_WAIT_V(8); PG8_WAIT_L(0); PG8_BAR; PG8_MMA(0, 0, At, B0); PG8_MMA(0, 1, At, B1); PG8_BAR; PG8_SCHED;
            PG8_LDA(At, 0, 1); PG8_STAGE(PG8_SB(0, 0), b2, voffB); PG8_STAGE(PG8_SB(0, 1), b2 + hstep, voffB); PG8_STAGE(PG8_SA(0, 0), a2, voffA);
            PG8_WAIT_V(8); PG8_WAIT_L(0); PG8_BAR; PG8_MMA(1, 0, At, B0); PG8_MMA(1, 1, At, B1); PG8_BAR; PG8_SCHED;
            PG8_LDB(B0, 1, 0); PG8_LDB(B1, 1, 1); PG8_SCHED; PG8_LDA(At, 1, 0); PG8_STAGE(PG8_SA(0, 1), a2 + hstep, voffA);
            PG8_WAIT_V(8); PG8_WAIT_L(0); PG8_BAR; PG8_MMA(0, 0, At, B0); PG8_MMA(0, 1, At, B1); PG8_BAR; PG8_SCHED;
            PG8_LDA(At, 1, 1); PG8_STAGE(PG8_SB(1, 0), b3, voffB); PG8_STAGE(PG8_SB(1, 1), b3 + hstep, voffB); PG8_STAGE(PG8_SA(1, 0), a3, voffA);
            PG8_WAIT_V(8); PG8_WAIT_L(0); PG8_BAR; PG8_MMA(1, 0, At, B0); PG8_MMA(1, 1, At, B1); PG8_BAR; PG8_SCHED;
            } else {
            PG8_LDB(B0, 0, 0); PG8_SCHED; PG8_LDA(At, 0, 0); PG8_STAGE(PG8_SA(1, 1), a1 + hstep, voffA);
            PG8_WAIT_L(8); PG8_BAR; PG8_WAIT_L(0); PG8_MMA(0, 0, At, B0); PG8_BAR; PG8_SCHED;
            PG8_LDB(B1, 0, 1); PG8_STAGE(PG8_SB(0, 0), b2, voffB);
            PG8_BAR; PG8_WAIT_L(0); PG8_MMA(0, 1, At, B1); PG8_BAR;
            PG8_LDA(At, 0, 1); PG8_STAGE(PG8_SA(0, 0), a2, voffA);
            PG8_BAR; PG8_WAIT_L(0); PG8_MMA(1, 0, At, B0); PG8_BAR; PG8_SCHED;
            PG8_STAGE(PG8_SB(0, 1), b2 + hstep, voffB);
            PG8_WAIT_V(6); PG8_BAR; PG8_MMA(1, 1, At, B1); PG8_BAR;
            PG8_LDB(B0, 1, 0); PG8_SCHED; PG8_LDA(At, 1, 0); PG8_STAGE(PG8_SA(0, 1), a2 + hstep, voffA);
            PG8_WAIT_L(8); PG8_BAR; PG8_WAIT_L(0); PG8_MMA(0, 0, At, B0); PG8_BAR; PG8_SCHED;
            PG8_LDB(B1, 1, 1); PG8_STAGE(PG8_SB(1, 0), b3, voffB);
            PG8_BAR; PG8_WAIT_L(0); PG8_MMA(0, 1, At, B1); PG8_BAR;
            PG8_LDA(At, 1, 1); PG8_STAGE(PG8_SA(1, 0), a3, voffA);
            PG8_BAR; PG8_WAIT_L(0); PG8_MMA(1, 0, At, B0); PG8_BAR; PG8_SCHED;
            PG8_STAGE(PG8_SB(1, 1), b3 + hstep, voffB);
            PG8_WAIT_V(6); PG8_BAR; PG8_MMA(1, 1, At, B1); PG8_BAR;
            }
        }
        if constexpr (ALIGN_EPI) { if (wr == 0) PG8_BAR; }
        if constexpr (!Epi::AFTER_DRAIN) { E(acc, cur, wr, wc, fr, fq); S.done(cur); }
        if (!has_next) break;
#pragma unroll
        for (int a = 0; a < 2; ++a)
#pragma unroll
            for (int b = 0; b < 2; ++b)
#pragma unroll
                for (int m = 0; m < 4; ++m)
#pragma unroll
                    for (int n = 0; n < 2; ++n) acc[a][b][m][n] = (f32x4){0.f, 0.f, 0.f, 0.f};
        cur = nxt; cA = nA; cB = nB; ++ui;
        if constexpr (ALIGN_EPI) { if (wr == 1) PG8_BAR; }
    }
    PG8_WAIT_V(0);
    if constexpr (!ALIGN_EPI) { if (wr == 0) PG8_BAR; }
    PG8_BAR;
    if constexpr (Epi::AFTER_DRAIN) { E.fused(acc, cur, wr, wc, fr, fq, lds, wid, lane); S.done(cur); }
#undef PG8_SA
#undef PG8_SB
#undef PG8_STAGE
#undef PG8_LDA
#undef PG8_LDB
#undef PG8_MMA
#undef PG8_WAIT_V
#undef PG8_WAIT_L
#undef PG8_BAR
#undef PG8_SCHED
}
}

struct EpiResGate {
    static constexpr bool PERM = false, AFTER_DRAIN = false;
    float* X; const float* gate;
    __device__ __forceinline__ void operator()(const pg8::f32x4 (&acc)[2][2][4][2], const pg8::Unit& u, int wr, int wc, int fr, int fq) const {
#pragma unroll
        for (int ai = 0; ai < 2; ++ai)
#pragma unroll
            for (int m = 0; m < 4; ++m) {
                const int r = u.pm * 256 + ai * 128 + wr * 64 + m * 16 + fr;
                const float* g = gate + (size_t)row_mod(r) * MODW; float* xr = X + (size_t)r * DM;
#pragma unroll
                for (int bj = 0; bj < 2; ++bj)
#pragma unroll
                    for (int n = 0; n < 2; ++n) {
                        const int c = u.pn * 256 + bj * 128 + wc * 32 + n * 16 + 4 * fq;
                        pg8::f32x4 xv = *(const pg8::f32x4*)(xr + c); const pg8::f32x4 gv = *(const pg8::f32x4*)(g + c);
                        xv = xv + gv * acc[ai][bj][m][n];
                        *(pg8::f32x4*)(xr + c) = xv;
                    }
            }
    }
};
#define LAS __attribute__((address_space(3)))
#define GAS __attribute__((address_space(1)))

__device__ __forceinline__ void ph_copy_in(const float* __restrict__ x, const float* __restrict__ ctx, float* __restrict__ X) {
    const int TID = opaque_tid(), BID = opaque_bid();
    size_t i = (size_t)BID * NT + TID;
    const size_t n4 = (size_t)RT * DM / 4, nl4 = (size_t)RL * DM / 4;
    for (; i < n4; i += (size_t)gridDim.x * NT) ((float4*)X)[i] = i < nl4 ? ((const float4*)x)[i] : ((const float4*)ctx)[i - nl4];
}
__device__ __forceinline__ void ph_copy_out(const float* __restrict__ X, float* __restrict__ out) {
    const int TID = opaque_tid(), BID = opaque_bid();
    size_t i = (size_t)BID * NT + TID;
    const size_t n4 = (size_t)RL * DM / 4;
    for (; i < n4; i += (size_t)gridDim.x * NT) ((float4*)out)[i] = ((const float4*)X)[i];
}
__device__ __forceinline__ void ph_rope_table(float2* __restrict__ rope) {
    const int TID = opaque_tid(), BID = opaque_bid();
    for (int i = BID * NT + TID; i < SEQ * 32; i += gridDim.x * NT) {
        int t = i >> 5, a = (i >> 4) & 1, f = i & 15;
        float pos = a == 0 ? (float)(t >> 6) : (float)(t & 63);
        float inv = powf(10000.f, -(float)f / 16.f);
        float ang = pos * inv;
        rope[i] = make_float2(cosf(ang), sinf(ang));
    }
}
__device__ __forceinline__ void transpose_item(const float* __restrict__ W, int N, bf16* __restrict__ WT, LAS float* scr, int item, int lane) {
    const int K = DM;
    const int nblk = N / 32, kb = item / nblk, nb = item % nblk, k0 = 64 * kb, n0 = 32 * nb;
#pragma unroll 8
    for (int i = 0; i < 32; ++i) { const int kk = 2 * i + (lane >> 5); scr[kk * 33 + (lane & 31)] = W[(size_t)(k0 + kk) * N + n0 + (lane & 31)]; }
    asm volatile("s_waitcnt lgkmcnt(0)" ::: "memory");
    const int c = lane & 7;
#pragma unroll
    for (int j = 0; j < 4; ++j) { const int n = (lane >> 3) + 8 * j; const LAS float* s = scr + (8 * c) * 33 + n;
        uint4 o; o.x = pk2(s[0 * 33], s[1 * 33]); o.y = pk2(s[2 * 33], s[3 * 33]); o.z = pk2(s[4 * 33], s[5 * 33]); o.w = pk2(s[6 * 33], s[7 * 33]);
        *(uint4*)(WT + (size_t)(n0 + n) * K + k0 + 8 * c) = o; }
    asm volatile("s_waitcnt lgkmcnt(0)" ::: "memory");
}
struct WPrep { const float* src[12]; bf16* dst[12]; };
__device__ __forceinline__ void ph_weight_prep(const float* const* in, bf16* WinE, bf16* WoutE, bf16* WinO, bf16* WoutO, bf16* Wpq, unsigned char* lds) {
    const int TID = opaque_tid(), BID = opaque_bid();
    const int lane = TID & 63, wv = TID >> 6;
    LAS float* scr = (LAS float*)((LAS unsigned char*)lds + wv * 16384);
    const int gw = BID * NWV + wv, NGW = gridDim.x * NWV;
    const int NITEMS = 2 * 1552 + 2 * 512 + 2 * 768 + 2 * 512 + 4 * 512;
    for (int it = gw; it < NITEMS; it += NGW) {
        int r = it;
        if (r < 3104) { int i = r / 1552; transpose_item(in[8] + (size_t)i * DM * EVEN_IN, EVEN_IN, WinE + (size_t)i * EVEN_LDP * DM, scr, r % 1552, lane); continue; } r -= 3104;
        if (r < 1024) { int i = r / 512; transpose_item(in[9] + (size_t)i * DM * DM, DM, WoutE + (size_t)i * DM * DM, scr, r % 512, lane); continue; } r -= 1024;
        if (r < 1536) { int i = r / 768; transpose_item(in[19] + (size_t)i * DM * ODD_IN, ODD_IN, WinO + (size_t)i * ODD_IN * DM, scr, r % 768, lane); continue; } r -= 1536;
        if (r < 1024) { int i = r / 512; transpose_item(in[20] + (size_t)i * DM * DM, DM, WoutO + (size_t)i * DM * DM, scr, r % 512, lane); continue; } r -= 1024;
        { int i = r / 512; transpose_item(in[23] + (size_t)i * DM * DM, DM, Wpq + (size_t)i * DM * DM, scr, r % 512, lane); }
    }
    for (int i = BID * NT + TID; i < 2 * 28672; i += gridDim.x * NT) {
        int w = i / 28672, o = i % 28672;
        ((uint4*)(WinE + (size_t)w * EVEN_LDP * DM + (size_t)EVEN_IN * DM))[o] = make_uint4(0u, 0u, 0u, 0u);
    }
}
__device__ __forceinline__ void ph_mods(const float* __restrict__ c, const float* __restrict__ cctx, const float* __restrict__ w_mod,
                        const float* __restrict__ b_mod, float* __restrict__ mods, float* smem) {
    const int TID = opaque_tid(), BID = opaque_bid();
    const int nvb = DEPTH * MODW / NT;
    if (BID >= nvb) return;
    float (*S)[DM] = (float (*)[DM])smem;
    for (int i = TID; i < NMOD * DM; i += NT) {
        int j = i / DM, k = i % DM;
        float v = j < 16 ? c[j * DM + k] : cctx[k];
        S[j][k] = silu_f(v);
    }
    __syncthreads();
    for (int vb = BID; vb < nvb; vb += gridDim.x) {
        int idx = vb * NT + TID, l = idx / MODW, n = idx % MODW;
        const float* W = w_mod + (size_t)l * DM * MODW;
        float acc[NMOD];
#pragma unroll
        for (int j = 0; j < NMOD; ++j) acc[j] = 0.f;
        for (int k = 0; k < DM; ++k) {
            float w = W[(size_t)k * MODW + n];
#pragma unroll
            for (int j = 0; j < NMOD; ++j) acc[j] += S[j][k] * w;
        }
        float b = b_mod[l * MODW + n];
#pragma unroll
        for (int j = 0; j < NMOD; ++j) mods[((size_t)l * NMOD + j) * MODW + n] = acc[j] + b;
    }
    __syncthreads();
}
__device__ __forceinline__ void ph_norm_mod(const float* __restrict__ X, const float* __restrict__ g, const float* __restrict__ mods_l, int shift_chunk, bf16* __restrict__ A) {
    const int TID = opaque_tid(), BID = opaque_bid();
    int wave = BID * NWV + (TID >> 6), lane = TID & 63;
    int nw = gridDim.x * NWV;
    for (int r = wave; r < RT; r += nw) {
        const float4* xr = (const float4*)(X + (size_t)r * DM);
        float4 v[4]; float s = 0.f;
#pragma unroll
        for (int i = 0; i < 4; ++i) { v[i] = xr[lane + 64 * i]; s += v[i].x * v[i].x + v[i].y * v[i].y + v[i].z * v[i].z + v[i].w * v[i].w; }
        s = wave_sum(s);
        float rstd = rsqrtf(s * (1.f / DM) + 1e-6f);
        const float* m = mods_l + (size_t)row_mod(r) * MODW;
        const float4* sh = (const float4*)(m + shift_chunk * DM);
        const float4* sc = (const float4*)(m + (shift_chunk + 1) * DM);
        const float4* g4 = (const float4*)g;
        bf16* ar = A + (size_t)r * DM;
#pragma unroll
        for (int i = 0; i < 4; ++i) {
            int c = lane + 64 * i;
            float4 gg = g4[c], a = sh[c], b = sc[c], o;
            o.x = v[i].x * rstd * gg.x * (1.f + b.x) + a.x;
            o.y = v[i].y * rstd * gg.y * (1.f + b.y) + a.y;
            o.z = v[i].z * rstd * gg.z * (1.f + b.z) + a.z;
            o.w = v[i].w * rstd * gg.w * (1.f + b.w) + a.w;
            st4bf(ar + 4 * c, o);
        }
    }
}
#define KVLEN (CTX + SEQ)
__device__ __forceinline__ void ph_post(bf16* __restrict__ P, int ldp, int nq, int kcol0, int nk, int vcol0, int VC, int DV,
                                        const float* __restrict__ qgain, const float* __restrict__ kgain, const float2* __restrict__ rope,
                                        bf16* __restrict__ Kc, bf16* __restrict__ Vt) {
    const int TID = opaque_tid(), BID = opaque_bid();
    const float C2 = 0.125f * 1.4426950408889634f;
    for (int tile = BID; tile < RT / 64; tile += gridDim.x) {
        const int r0 = tile * 64;
        int b, j0;
        if (r0 < RL) { b = r0 >> 11; j0 = CTX + (r0 & (SEQ - 1)); } else { b = (r0 - RL) >> 8; j0 = (r0 - RL) & (CTX - 1); }
        const int nh = nq + nk;
        for (int it = TID; it < 64 * nh; it += NT) {
            const int row = it / nh, hh = it % nh, r = r0 + row;
            const bool isk = hh >= nq; const int h = isk ? hh - nq : hh;
            bf16* src = P + (size_t)r * ldp + (isk ? kcol0 : 0) + h * 64;
            const float* gain = isk ? kgain : qgain;
            float v[64]; float s = 0.f;
#pragma unroll
            for (int i = 0; i < 16; ++i) { float4 t = ld4bf(src + 4 * i); v[4 * i] = t.x; v[4 * i + 1] = t.y; v[4 * i + 2] = t.z; v[4 * i + 3] = t.w; }
#pragma unroll
            for (int i = 0; i < 64; ++i) s += v[i] * v[i];
            const float rstd = rsqrtf(s * (1.f / 64.f) + 1e-6f) * (isk ? 1.f : C2);
#pragma unroll
            for (int i = 0; i < 64; ++i) v[i] = v[i] * rstd * gain[i];
            if (r < RL) {
                const float2* tab = rope + (size_t)(r & (SEQ - 1)) * 32;
#pragma unroll
                for (int a = 0; a < 2; ++a)
#pragma unroll
                    for (int f = 0; f < 16; ++f) {
                        float2 cs = tab[a * 16 + f];
                        float x1 = v[a * 32 + f], x2 = v[a * 32 + 16 + f];
                        v[a * 32 + f] = x1 * cs.x - x2 * cs.y;
                        v[a * 32 + 16 + f] = x2 * cs.x + x1 * cs.y;
                    }
            }
            bf16* dst = isk ? Kc + ((size_t)(b * nk + h) * KVLEN + j0 + row) * 64 : src;
#pragma unroll
            for (int i = 0; i < 16; ++i) st4bf(dst + 4 * i, make_float4(v[4 * i], v[4 * i + 1], v[4 * i + 2], v[4 * i + 3]));
        }
        if (TID < VC) {
            const int c8 = TID >> 3, rg = TID & 7;
            unsigned in[8][4];
#pragma unroll
            for (int rr = 0; rr < 8; ++rr) { uint4 t = *(const uint4*)(P + (size_t)(r0 + rg * 8 + rr) * ldp + vcol0 + c8 * 8); in[rr][0] = t.x; in[rr][1] = t.y; in[rr][2] = t.z; in[rr][3] = t.w; }
#pragma unroll
            for (int c = 0; c < 8; ++c) {
                unsigned o[4];
#pragma unroll
                for (int q = 0; q < 4; ++q)
                    o[q] = (c & 1) ? __builtin_amdgcn_perm(in[2 * q + 1][c >> 1], in[2 * q][c >> 1], 0x07060302u) : __builtin_amdgcn_perm(in[2 * q + 1][c >> 1], in[2 * q][c >> 1], 0x05040100u);
                const int col = c8 * 8 + c, vh = col / DV, d = col % DV;
                *(uint4*)(Vt + ((size_t)(b * 4 + vh) * DV + d) * KVLEN + j0 + rg * 8) = make_uint4(o[0], o[1], o[2], o[3]);
            }
        }
    }
}
typedef short bf16x8 __attribute__((ext_vector_type(8)));
typedef float f32x16 __attribute__((ext_vector_type(16)));
__device__ __forceinline__ int crow(int r, int hi) { return (r & 3) + 8 * (r >> 2) + 4 * hi; }
__device__ __forceinline__ unsigned cvt_pk_bf16_f32(float lo, float hi) { f32x2_t v = {lo, hi}; bf16x2_t b = __builtin_convertvector(v, bf16x2_t); return __builtin_bit_cast(unsigned, b); }
#define ATT_KPITCH 144
#define ATT_VPITCH 136
template <int DV>
__device__ __forceinline__ void attn_unit(const bf16* __restrict__ Qbase, int ldq, const bf16* __restrict__ Kc, const bf16* __restrict__ Vt, int ntiles,
                                          bf16* __restrict__ Obase, int ldo, unsigned char* lds, int tid) {
    constexpr int NDB = DV / 32, NVL = DV / 64, KBYTES = 64 * ATT_KPITCH, BUFSZ = KBYTES + DV * ATT_VPITCH;
    constexpr float THR = 8.f;
    const int lane = tid & 63, wid = tid >> 6, r32 = lane & 31, hi = lane >> 5;
    float* sc = (float*)(lds + 2 * BUFSZ + wid * 128);
    bf16x8 qf[4];
    {
        const bf16* qrow = Qbase + (size_t)(wid * 32 + r32) * ldq;
#pragma unroll
        for (int s = 0; s < 4; ++s) qf[s] = *(const bf16x8*)(qrow + 16 * s + 8 * hi);
    }
    f32x16 o[NDB];
#pragma unroll
    for (int d = 0; d < NDB; ++d)
#pragma unroll
        for (int r = 0; r < 16; ++r) o[d][r] = 0.f;
    float m = -1e30f, l = 0.f;
    uint4 kreg, vreg[NVL];
    const int krow = tid >> 3, kch = tid & 7;
#define ATT_LOAD(t) do { kreg = *(const uint4*)(Kc + (size_t)(t) * 64 * 64 + tid * 8); \
        _Pragma("unroll") for (int u = 0; u < NVL; ++u) { const int idx = tid + NT * u; vreg[u] = *(const uint4*)(Vt + (size_t)(idx >> 3) * KVLEN + (t) * 64 + (idx & 7) * 8); } } while (0)
#define ATT_STORE(buf) do { *(uint4*)(lds + (buf) * BUFSZ + krow * ATT_KPITCH + kch * 16) = kreg; \
        _Pragma("unroll") for (int u = 0; u < NVL; ++u) { const int idx = tid + NT * u; unsigned char* vp = lds + (buf) * BUFSZ + KBYTES + (idx >> 3) * ATT_VPITCH + (idx & 7) * 16; \
            *(uint2*)vp = make_uint2(vreg[u].x, vreg[u].y); *(uint2*)(vp + 8) = make_uint2(vreg[u].z, vreg[u].w); } } while (0)
    ATT_LOAD(0);
    ATT_STORE(0);
    __syncthreads();
    for (int t = 0; t < ntiles; ++t) {
        const int buf = t & 1;
        if (t + 1 < ntiles) ATT_LOAD(t + 1);
        const unsigned char* kb = lds + buf * BUFSZ;
        const unsigned char* vb = kb + KBYTES;
        f32x16 s0, s1;
#pragma unroll
        for (int r = 0; r < 16; ++r) { s0[r] = 0.f; s1[r] = 0.f; }
#pragma unroll
        for (int s = 0; s < 4; ++s) {
            const bf16x8 a0 = *(const bf16x8*)(kb + r32 * ATT_KPITCH + s * 32 + hi * 16);
            const bf16x8 a1 = *(const bf16x8*)(kb + (32 + r32) * ATT_KPITCH + s * 32 + hi * 16);
            s0 = __builtin_amdgcn_mfma_f32_32x32x16_bf16(a0, qf[s], s0, 0, 0, 0);
            s1 = __builtin_amdgcn_mfma_f32_32x32x16_bf16(a1, qf[s], s1, 0, 0, 0);
        }
        float tm = fmaxf(s0[0], s1[0]);
#pragma unroll
        for (int r = 1; r < 16; ++r) tm = fmaxf(tm, fmaxf(s0[r], s1[r]));
        tm = fmaxf(tm, __shfl_xor(tm, 32));
        if (__any(tm > m + THR)) {
            const float mn = fmaxf(m, tm), alpha = exp2f(m - mn);
            m = mn; l *= alpha;
            if (hi == 0) sc[r32] = alpha;
#pragma unroll
            for (int r = 0; r < 16; ++r) { const float a = sc[crow(r, hi)];
#pragma unroll
                for (int d = 0; d < NDB; ++d) o[d][r] *= a; }
        }
        float ps = 0.f;
#pragma unroll
        for (int r = 0; r < 16; ++r) { s0[r] = exp2f(s0[r] - m); s1[r] = exp2f(s1[r] - m); ps += s0[r] + s1[r]; }
        l += ps;
        bf16x8 pa[4];
#pragma unroll
        for (int s = 0; s < 4; ++s) {
            unsigned w[4];
#pragma unroll
            for (int k = 0; k < 4; ++k) w[k] = (s < 2) ? cvt_pk_bf16_f32(s0[8 * (s & 1) + 2 * k], s0[8 * (s & 1) + 2 * k + 1]) : cvt_pk_bf16_f32(s1[8 * (s & 1) + 2 * k], s1[8 * (s & 1) + 2 * k + 1]);
            uint4 pw = make_uint4(w[0], w[1], w[2], w[3]);
            pa[s] = __builtin_bit_cast(bf16x8, pw);
        }
#pragma unroll
        for (int d = 0; d < NDB; ++d) {
#pragma unroll
            for (int s = 0; s < 4; ++s) {
                const unsigned char* vp = vb + (32 * d + r32) * ATT_VPITCH + 32 * s + 8 * hi;
                const uint2 v0 = *(const uint2*)vp, v1 = *(const uint2*)(vp + 16);
                uint4 vw = make_uint4(v0.x, v0.y, v1.x, v1.y);
                o[d] = __builtin_amdgcn_mfma_f32_32x32x16_bf16(pa[s], __builtin_bit_cast(bf16x8, vw), o[d], 0, 0, 0);
            }
        }
        if (t + 1 < ntiles) ATT_STORE(buf ^ 1);
        __syncthreads();
    }
#undef ATT_LOAD
#undef ATT_STORE
    l += __shfl_xor(l, 32);
    if (hi == 0) sc[r32] = 1.f / l;
#pragma unroll
    for (int r = 0; r < 16; ++r) {
        const float iv = sc[crow(r, hi)];
        bf16* orow = Obase + (size_t)(wid * 32 + crow(r, hi)) * ldo + r32;
#pragma unroll
        for (int d = 0; d < NDB; ++d) orow[32 * d] = (bf16)f2bf(o[d][r] * iv);
    }
    __syncthreads();
}
__device__ __forceinline__ void ph_attn_mfma(const bf16* __restrict__ P, int ldp, const bf16* __restrict__ Kc, const bf16* __restrict__ Vt, bf16* __restrict__ ATT,
                                             int odd, int with_ctx, unsigned char* lds) {
    const int TID = opaque_tid(), BID = opaque_bid();
    const int G = gridDim.x, vcu = (G % 8 == 0) ? (BID & 7) * (G >> 3) + (BID >> 3) : BID;
    const int nlat = odd ? 2048 : 1024, nctx = with_ctx ? (odd ? 256 : 128) : 0;
    for (int u = vcu; u < nlat + nctx; u += G) {
        int b, qh, row0, ntiles;
        if (u < nlat) {
            if (odd) { const int grp = u >> 5, w = u & 31; b = grp >> 2; qh = (grp & 3) * 4 + (w >> 3); row0 = b * SEQ + (w & 7) * 256; }
            else { const int grp = u >> 4, w = u & 15; b = grp >> 2; qh = (grp & 3) * 2 + (w >> 3); row0 = b * SEQ + (w & 7) * 256; }
            ntiles = KVLEN / 64;
        } else {
            const int idx = u - nlat;
            if (odd) { b = idx >> 4; qh = idx & 15; } else { b = idx >> 3; qh = idx & 7; }
            row0 = RL + b * CTX; ntiles = CTX / 64;
        }
        if (odd) attn_unit<64>(P + (size_t)row0 * ldp + qh * 64, ldp, Kc + (size_t)(b * 4 + (qh >> 2)) * KVLEN * 64, Vt + (size_t)(b * 4 + (qh >> 2)) * 64 * KVLEN, ntiles,
                               ATT + (size_t)row0 * DM + qh * 64, DM, lds, TID);
        else attn_unit<128>(P + (size_t)row0 * ldp + qh * 64, ldp, Kc + (size_t)(b * 8 + qh) * KVLEN * 64, Vt + (size_t)(b * 4 + (qh >> 1)) * 128 * KVLEN, ntiles,
                            ATT + (size_t)row0 * DM + qh * 128, DM, lds, TID);
    }
}
__device__ __forceinline__ void ph_gla_seq(const bf16* __restrict__ P, const float* __restrict__ w_af, const float* __restrict__ b_af,
                           const float* __restrict__ w_ab, const float* __restrict__ b_ab, float* __restrict__ OF, float* __restrict__ OB, float* smem) {
    const int TID = opaque_tid(), BID = opaque_bid();
    const int tid = TID, hb = tid >> 8, ht = tid & 255, col = ht & 127, half = ht >> 7;
    float* sa = smem + hb * 512; float* sk = sa + 64; float* sq = sa + 128; float* spart = sa + 192;
    for (int vb = BID; vb < NB * 4 * 2 / 2; vb += gridDim.x) {
        const int u = vb * 2 + hb;
        const int dir = u & 1, h = (u >> 1) & 3, b = u >> 3;
        const float* wa = dir ? w_ab : w_af; const float* ba = dir ? b_ab : b_af;
        float* Od = dir ? OB : OF;
        float S[32];
#pragma unroll
        for (int i = 0; i < 32; ++i) S[i] = 0.f;
        float wreg[16]; float breg = 0.f;
#pragma unroll
        for (int j = 0; j < 16; ++j) wreg[j] = 0.f;
        if (ht < 64) {
#pragma unroll
            for (int j = 0; j < 16; ++j) wreg[j] = wa[j * 256 + h * 64 + ht];
            breg = ba[h * 64 + ht];
        }
        for (int step = 0; step < CTX + SEQ; ++step) {
            int r;
            if (!dir) r = step < CTX ? RL + b * CTX + step : b * SEQ + (step - CTX);
            else r = step < CTX ? RL + b * CTX + (CTX - 1 - step) : b * SEQ + (SEQ - 1 - (step - CTX));
            const bf16* p = P + (size_t)r * EVEN_LDP;
            if (ht < 64) {
                float z = breg;
#pragma unroll
                for (int j = 0; j < 16; ++j) z += bf2f(p[3072 + dir * 16 + j]) * wreg[j];
                sa[ht] = expf(log_sigmoid_f(z) * (1.f / 16.f));
                sk[ht] = bf2f(p[1792 + h * 64 + ht]);
                sq[ht] = bf2f(p[1536 + h * 64 + ht]) * 0.125f;
            }
            float v = bf2f(p[2048 + h * 128 + col]);
            __syncthreads();
            float part = 0.f;
#pragma unroll
            for (int dd = 0; dd < 32; ++dd) {
                int d = half * 32 + dd;
                S[dd] = sa[d] * S[dd] + sk[d] * v;
                part += sq[d] * S[dd];
            }
            spart[half * 128 + col] = part;
            __syncthreads();
            if (half == 0) Od[(size_t)r * 512 + h * 128 + col] = spart[col] + spart[128 + col];
        }
    }
    __syncthreads();
}
__device__ __forceinline__ void ph_even_post(bf16* __restrict__ ATT, const float* __restrict__ lamv, const float* __restrict__ subln, float lam_init,
                             const float* __restrict__ OF, const float* __restrict__ OB, const bf16* __restrict__ P, const float* __restrict__ gain) {
    const int TID = opaque_tid(), BID = opaque_bid();
    int wave = BID * NWV + (TID >> 6), lane = TID & 63;
    int nw = gridDim.x * NWV;
    float p1 = lamv[lane] * lamv[64 + lane], p2 = lamv[128 + lane] * lamv[192 + lane];
    p1 = wave_sum(p1); p2 = wave_sum(p2);
    const float lam = expf(p1) - expf(p2) + lam_init;
    for (int r = wave; r < RT; r += nw) {
        bf16* a = ATT + (size_t)r * DM;
        float d[4][2];
#pragma unroll
        for (int h = 0; h < 4; ++h) {
            float2 o0 = ld2bf(a + (2 * h) * 128 + lane * 2);
            float2 o1 = ld2bf(a + (2 * h + 1) * 128 + lane * 2);
            d[h][0] = o0.x - lam * o1.x; d[h][1] = o0.y - lam * o1.y;
        }
        float2 outd[4];
#pragma unroll
        for (int h = 0; h < 4; ++h) {
            float s = wave_sum(d[h][0] * d[h][0] + d[h][1] * d[h][1]);
            float rstd = rsqrtf(s * (1.f / 128.f) + 1e-6f) * (1.f - lam_init);
            float2 sg = *(const float2*)(subln + lane * 2);
            outd[h] = make_float2(d[h][0] * rstd * sg.x, d[h][1] * rstd * sg.y);
        }
        float2 outg[4];
#pragma unroll
        for (int h = 0; h < 4; ++h) {
            float2 x = *(const float2*)(OF + (size_t)r * 512 + h * 128 + lane * 2);
            float2 c = *(const float2*)(OB + (size_t)r * 512 + h * 128 + lane * 2);
            float o0 = x.x + c.x, o1 = x.y + c.y;
            float s = wave_sum(o0 * o0 + o1 * o1);
            float rstd = rsqrtf(s * (1.f / 128.f) + 1e-6f);
            float2 g = *(const float2*)(gain + lane * 2);
            float2 rr = ld2bf(P + (size_t)r * EVEN_LDP + 2560 + h * 128 + lane * 2);
            outg[h] = make_float2(o0 * rstd * g.x * silu_f(rr.x), o1 * rstd * g.y * silu_f(rr.y));
        }
#pragma unroll
        for (int h = 0; h < 4; ++h) {
            st2bf(a + h * 128 + lane * 2, outd[h]);
            st2bf(a + 512 + h * 128 + lane * 2, outg[h]);
        }
    }
}
#define INS16(tv, ti, v, n) do { \
    _Pragma("unroll") for (int j_ = 15; j_ >= 1; --j_) { bool c1_ = (v) > tv[j_ - 1]; bool c2_ = (v) > tv[j_]; \
        tv[j_] = c1_ ? tv[j_ - 1] : (c2_ ? (v) : tv[j_]); ti[j_] = c1_ ? ti[j_ - 1] : (c2_ ? (n) : ti[j_]); } \
    { bool c_ = (v) > tv[0]; tv[0] = c_ ? (v) : tv[0]; ti[0] = c_ ? (n) : ti[0]; } } while (0)

__device__ __forceinline__ void ph_peer_route(const bf16* __restrict__ Qp, const float* __restrict__ keys_l, int* __restrict__ IDX, float* __restrict__ GATE) {
    const int TID = opaque_tid(), BID = opaque_bid();
    for (int vb = BID; vb < (RT / NT) * 8; vb += gridDim.x) {
        const int h = vb & 7, r = (vb >> 3) * NT + TID;
        float tv[2][16]; int ti[2][16];
#pragma unroll
        for (int half = 0; half < 2; ++half) {
            float q[64];
            const bf16* qp = Qp + (size_t)r * DM + h * 128 + half * 64;
#pragma unroll
            for (int i = 0; i < 16; ++i) { float4 t = ld4bf(qp + 4 * i); q[4 * i] = t.x; q[4 * i + 1] = t.y; q[4 * i + 2] = t.z; q[4 * i + 3] = t.w; }
#pragma unroll
            for (int j = 0; j < 16; ++j) { tv[half][j] = -3.0e38f; ti[half][j] = 0; }
            const float* kb = keys_l + (size_t)(h * 2 + half) * 128 * 64;
            for (int n = 0; n < 128; ++n) {
                float s = 0.f;
#pragma unroll
                for (int d = 0; d < 64; ++d) s += q[d] * kb[n * 64 + d];
                INS16(tv[half], ti[half], s, n);
            }
        }
        float bv[16]; int bi[16];
#pragma unroll
        for (int j = 0; j < 16; ++j) { bv[j] = -3.0e38f; bi[j] = 0; }
#pragma unroll
        for (int a = 0; a < 16; ++a)
#pragma unroll
            for (int b = 0; b < 16; ++b) {
                if ((a + 1) * (b + 1) <= 16) {
                    float s = tv[0][a] + tv[1][b]; int id = ti[0][a] * 128 + ti[1][b];
                    INS16(bv, bi, s, id);
                }
            }
        float mx = bv[0], sum = 0.f, e[16];
#pragma unroll
        for (int j = 0; j < 16; ++j) { e[j] = expf(bv[j] - mx); sum += e[j]; }
        float inv = 1.f / sum;
#pragma unroll
        for (int j = 0; j < 16; ++j) { IDX[(size_t)r * 128 + h * 16 + j] = bi[j]; GATE[(size_t)r * 128 + h * 16 + j] = e[j] * inv; }
    }
}
__device__ __forceinline__ void ph_peer_ffn(const bf16* __restrict__ A2, const int* __restrict__ IDX, const float* __restrict__ GATE,
                            const float* __restrict__ U, const float* __restrict__ V, const float* __restrict__ mods_l, float* __restrict__ X) {
    const int TID = opaque_tid(), BID = opaque_bid();
    int wave = BID * NWV + (TID >> 6), lane = TID & 63;
    int nw = gridDim.x * NWV;
    for (int r = wave; r < RT; r += nw) {
        float4 xa[4], acc[4];
#pragma unroll
        for (int i = 0; i < 4; ++i) { xa[i] = ld4bf(A2 + (size_t)r * DM + 4 * (lane + 64 * i)); acc[i] = make_float4(0.f, 0.f, 0.f, 0.f); }
        for (int e = 0; e < 128; ++e) {
            int id = IDX[(size_t)r * 128 + e]; float g = GATE[(size_t)r * 128 + e];
            const float4* ur = (const float4*)(U + (size_t)id * DM);
            float d = 0.f;
#pragma unroll
            for (int i = 0; i < 4; ++i) { float4 u = ur[lane + 64 * i]; d += u.x * xa[i].x + u.y * xa[i].y + u.z * xa[i].z + u.w * xa[i].w; }
            d = wave_sum(d);
            float w = g * gelu_tanh(d);
            const float4* vr = (const float4*)(V + (size_t)id * DM);
#pragma unroll
            for (int i = 0; i < 4; ++i) { float4 v = vr[lane + 64 * i]; acc[i].x += w * v.x; acc[i].y += w * v.y; acc[i].z += w * v.z; acc[i].w += w * v.w; }
        }
        const float4* g5 = (const float4*)(mods_l + (size_t)row_mod(r) * MODW + 5 * DM);
        float4* xr = (float4*)(X + (size_t)r * DM);
#pragma unroll
        for (int i = 0; i < 4; ++i) { float4 x = xr[lane + 64 * i], gg = g5[lane + 64 * i];
            x.x += gg.x * acc[i].x; x.y += gg.y * acc[i].y; x.z += gg.z * acc[i].z; x.w += gg.w * acc[i].w; xr[lane + 64 * i] = x; }
    }
}
__device__ __forceinline__ void ph_table_prep(const float* __restrict__ U, const float* __restrict__ V, unsigned char* __restrict__ T8, float* __restrict__ RS) {
    const int TID = opaque_tid(), BID = opaque_bid();
    const int wave = BID * NWV + (TID >> 6), lane = TID & 63, nw = gridDim.x * NWV;
    const int NROWS = DEPTH * 16384;
    for (int rr = wave; rr < 2 * NROWS; rr += nw) {
        const float* src = (rr < NROWS ? U : V) + (size_t)(rr < NROWS ? rr : rr - NROWS) * DM + lane * 16;
        float4 v[4]; float am = 0.f;
#pragma unroll
        for (int i = 0; i < 4; ++i) { v[i] = ((const float4*)src)[i]; am = fmaxf(am, fmaxf(fmaxf(fabsf(v[i].x), fabsf(v[i].y)), fmaxf(fabsf(v[i].z), fabsf(v[i].w)))); }
#pragma unroll
        for (int o = 1; o < 64; o <<= 1) am = fmaxf(am, __shfl_xor(am, o));
        am = fmaxf(am, 1e-30f);
        const float sc = exp2f(floorf(log2f(448.f / am)) - 1.f);
        int w[4];
#pragma unroll
        for (int i = 0; i < 4; ++i) { int t = 0; t = __builtin_amdgcn_cvt_pk_fp8_f32(v[i].x * sc, v[i].y * sc, t, false); t = __builtin_amdgcn_cvt_pk_fp8_f32(v[i].z * sc, v[i].w * sc, t, true); w[i] = t; }
        *(uint4*)(T8 + (size_t)rr * DM + lane * 16) = make_uint4((unsigned)w[0], (unsigned)w[1], (unsigned)w[2], (unsigned)w[3]);
        if (lane == 0) RS[rr] = 1.f / sc;
    }
}
#define BR4(j) ((((j) & 1) << 3) | (((j) & 2) << 1) | (((j) & 4) >> 1) | (((j) & 8) >> 3))
__device__ __forceinline__ float dot16_fp8_bf16(uint4 u, const unsigned (&x)[8]) {
    float d = 0.f;
    const unsigned uw[4] = {u.x, u.y, u.z, u.w};
#pragma unroll
    for (int i = 0; i < 4; ++i) {
        bf16x2_t lo = __builtin_amdgcn_cvt_scalef32_pk_bf16_fp8(uw[i], 1.0f, false);
        bf16x2_t hi = __builtin_amdgcn_cvt_scalef32_pk_bf16_fp8(uw[i], 1.0f, true);
        d = __builtin_amdgcn_fdot2_f32_bf16(lo, __builtin_bit_cast(bf16x2_t, x[2 * i]), d, false);
        d = __builtin_amdgcn_fdot2_f32_bf16(hi, __builtin_bit_cast(bf16x2_t, x[2 * i + 1]), d, false);
    }
    return d;
}
__device__ __forceinline__ void ph_peer_ffn8(const bf16* __restrict__ A2, const int* __restrict__ IDX, const float* __restrict__ GATE,
                            const unsigned char* __restrict__ U8, const float* __restrict__ RSU, const unsigned char* __restrict__ V8, const float* __restrict__ RSV,
                            const float* __restrict__ mods_l, float* __restrict__ X, int nrows) {
    const int TID = opaque_tid(), BID = opaque_bid();
    const int wave = BID * NWV + (TID >> 6), lane = TID & 63, nw = gridDim.x * NWV;
    const int jl = BR4(lane & 15);
    for (int r = wave; r < nrows; r += nw) {
        unsigned x[8];
        { const uint4* xp = (const uint4*)(A2 + (size_t)r * DM + lane * 16); uint4 a = xp[0], b = xp[1]; x[0] = a.x; x[1] = a.y; x[2] = a.z; x[3] = a.w; x[4] = b.x; x[5] = b.y; x[6] = b.z; x[7] = b.w; }
        float acc[16];
#pragma unroll
        for (int k = 0; k < 16; ++k) acc[k] = 0.f;
        for (int g = 0; g < 8; ++g) {
            const int myid = IDX[(size_t)r * 128 + g * 16 + jl];
            const float mygate = GATE[(size_t)r * 128 + g * 16 + jl];
            const float rsu = RSU[myid], rsv = RSV[myid];
            uint4 ub[16], vb[16];
#pragma unroll
            for (int j = 0; j < 16; ++j) { const int id = __builtin_amdgcn_readlane(myid, BR4(j)); ub[j] = *(const uint4*)(U8 + (size_t)id * DM + lane * 16); }
#pragma unroll
            for (int j = 0; j < 16; ++j) { const int id = __builtin_amdgcn_readlane(myid, BR4(j)); vb[j] = *(const uint4*)(V8 + (size_t)id * DM + lane * 16); }
            float d[16];
#pragma unroll
            for (int j = 0; j < 16; ++j) d[j] = dot16_fp8_bf16(ub[j], x);
#pragma unroll
            for (int st = 0; st < 4; ++st) {
                const int n = 8 >> st, bit = 1 << st;
                const bool up = (lane & bit) != 0;
#pragma unroll
                for (int i = 0; i < 8; ++i) if (i < n) {
                    const float send = up ? d[i] : d[i + n], keep = up ? d[i + n] : d[i];
                    d[i] = keep + __shfl_xor(send, bit);
                }
            }
            float tot = d[0];
            tot += __shfl_xor(tot, 16); tot += __shfl_xor(tot, 32);
            const float w = mygate * gelu_tanh(tot * rsu) * rsv;
#pragma unroll
            for (int j = 0; j < 16; ++j) {
                const float wj = __int_as_float(__builtin_amdgcn_readlane(__float_as_int(w), BR4(j)));
                const unsigned vw[4] = {vb[j].x, vb[j].y, vb[j].z, vb[j].w};
#pragma unroll
                for (int i = 0; i < 4; ++i) {
                    f32x2_t lo = __builtin_amdgcn_cvt_pk_f32_fp8((int)vw[i], false), hi = __builtin_amdgcn_cvt_pk_f32_fp8((int)vw[i], true);
                    acc[4 * i] += wj * lo.x; acc[4 * i + 1] += wj * lo.y; acc[4 * i + 2] += wj * hi.x; acc[4 * i + 3] += wj * hi.y;
                }
            }
        }
        const float4* g5 = (const float4*)(mods_l + (size_t)row_mod(r) * MODW + 5 * DM + lane * 16);
        float4* xr = (float4*)(X + (size_t)r * DM + lane * 16);
#pragma unroll
        for (int i = 0; i < 4; ++i) { float4 xv = xr[i], gg = g5[i];
            xv.x += gg.x * acc[4 * i]; xv.y += gg.y * acc[4 * i + 1]; xv.z += gg.z * acc[4 * i + 2]; xv.w += gg.w * acc[4 * i + 3]; xr[i] = xv; }
    }
}
template <int N>
__device__ __forceinline__ void ph_gemm_bf16(const bf16* A, const bf16* Bt, bf16* O, unsigned char* lds) {
    pg8::Gemm g{A, Bt, RT, N, DM}; pg8::StaticOrder S; S.init(RT, N, (int)gridDim.x, opaque_bid());
    pg8::EpiBf16<0> E{O, N, nullptr, 0, 0, 1.f};
    pg8::gemm_phase<pg8::EpiBf16<0>, pg8::StaticOrder, true, true>((PG8_LAS unsigned char*)lds, g, S, E);
}
__device__ __forceinline__ void ph_gemm_res(const bf16* A, const bf16* Bt, float* X, const float* gate, unsigned char* lds) {
    pg8::Gemm g{A, Bt, RT, DM, DM}; pg8::StaticOrder S; S.init(RT, DM, (int)gridDim.x, opaque_bid());
    EpiResGate E{X, gate};
    pg8::gemm_phase<EpiResGate, pg8::StaticOrder, true, true>((PG8_LAS unsigned char*)lds, g, S, E);
}

constexpr size_t ALIGN_UP(size_t x) { return (x + 255) & ~(size_t)255; }
constexpr size_t WS_X = 0;
constexpr size_t WS_A = WS_X + (size_t)RT * DM * 4;
constexpr size_t WS_P = WS_A + (size_t)RT * DM * 2;
constexpr size_t WS_ATT = WS_P + (size_t)RT * EVEN_LDP * 2;
constexpr size_t WS_OF = WS_ATT + (size_t)RT * DM * 2;
constexpr size_t WS_MODS = WS_OF + (size_t)RT * 512 * 4 * 2;
constexpr size_t WS_ROPE = WS_MODS + ALIGN_UP((size_t)DEPTH * NMOD * MODW * 4);
constexpr size_t WS_WINE = WS_ROPE + (size_t)SEQ * 32 * 8;
constexpr size_t WS_WOUTE = WS_WINE + (size_t)2 * EVEN_LDP * DM * 2;
constexpr size_t WS_WINO = WS_WOUTE + (size_t)2 * DM * DM * 2;
constexpr size_t WS_WOUTO = WS_WINO + (size_t)2 * ODD_IN * DM * 2;
constexpr size_t WS_WPQ = WS_WOUTO + (size_t)2 * DM * DM * 2;
constexpr size_t WS_T8 = WS_WPQ + (size_t)4 * DM * DM * 2;
constexpr size_t WS_RS = WS_T8 + (size_t)2 * DEPTH * 16384 * DM;
constexpr size_t WS_KC = WS_RS + (size_t)2 * DEPTH * 16384 * 4;
constexpr size_t WS_VT = WS_KC + (size_t)NB * 8 * KVLEN * 64 * 2;
constexpr size_t WS_END = WS_VT + (size_t)NB * 4 * 128 * KVLEN * 2;

__global__ void __launch_bounds__(NT, 2) mega(Params p) {
    extern __shared__ __attribute__((aligned(16))) unsigned char lds[];
    float* smem = (float*)lds;
    cg::grid_group grid = cg::this_grid();
    unsigned char* ws = p.ws;
#define X_ ((float*)(ws + WS_X))
#define A_ ((bf16*)(ws + WS_A))
#define P_ ((bf16*)(ws + WS_P))
#define ATT_ ((bf16*)(ws + WS_ATT))
#define OF_ ((float*)(ws + WS_OF))
#define OB_ (OF_ + (size_t)RT * 512)
#define MODS_ ((float*)(ws + WS_MODS))
#define ROPE_ ((float2*)(ws + WS_ROPE))
#define WINE_ ((bf16*)(ws + WS_WINE))
#define WOUTE_ ((bf16*)(ws + WS_WOUTE))
#define WINO_ ((bf16*)(ws + WS_WINO))
#define WOUTO_ ((bf16*)(ws + WS_WOUTO))
#define WPQ_ ((bf16*)(ws + WS_WPQ))
#define QP_ P_
#define KC_ ((bf16*)(ws + WS_KC))
#define VT_ ((bf16*)(ws + WS_VT))
#define T8_ (ws + WS_T8)
#define RS_ ((float*)(ws + WS_RS))
#define IDX_ ((int*)(ws + WS_P + (size_t)RT * DM * 2))
#define GATE_ ((float*)(ws + WS_P + (size_t)RT * DM * 2 + (size_t)RT * 128 * 4))

    ph_copy_in(p.in[0], p.in[2], X_);
    ph_rope_table(ROPE_);
    ph_weight_prep(p.in, WINE_, WOUTE_, WINO_, WOUTO_, WPQ_, lds);
    ph_table_prep(p.in[25], p.in[26], T8_, RS_);
    __syncthreads();
    ph_mods(p.in[1], p.in[3], p.in[4], p.in[5], MODS_, smem);
    grid.sync();
    for (int hl = 0; hl < 2 * DEPTH; ++hl) {
        const int l = hl >> 1, part = hl & 1, i = l >> 1, odd = l & 1;
        const float* mods_l = MODS_ + (size_t)l * NMOD * MODW;
        ph_norm_mod(X_, (part ? p.in[7] : p.in[6]) + l * DM, mods_l, part ? 3 : 0, A_);
        grid.sync();
        if (part) ph_gemm_bf16<DM>(A_, WPQ_ + (size_t)l * DM * DM, P_, lds);
        else if (odd) ph_gemm_bf16<ODD_IN>(A_, WINO_ + (size_t)i * ODD_IN * DM, P_, lds);
        else ph_gemm_bf16<EVEN_LDP>(A_, WINE_ + (size_t)i * EVEN_LDP * DM, P_, lds);
        grid.sync();
        if (part == 0) {
            const int ldp = odd ? ODD_IN : EVEN_LDP;
            ph_post(P_, ldp, odd ? 16 : 8, odd ? 1024 : 512, odd ? 4 : 8, odd ? 1280 : 1024, odd ? 256 : 512, odd ? 64 : 128,
                    (odd ? p.in[21] : p.in[10]) + i * 64, (odd ? p.in[22] : p.in[11]) + i * 64, ROPE_, KC_, VT_);
            grid.sync();
            if (!odd) ph_gla_seq(P_, p.in[14] + i * 16 * 256, p.in[15] + i * 256, p.in[16] + i * 16 * 256, p.in[17] + i * 256, OF_, OB_, smem);
            ph_attn_mfma(P_, ldp, KC_, VT_, ATT_, odd, 1, lds);
            grid.sync();
            if (!odd) {
                const float lam_init = 0.8f - 0.6f * expf(-0.3f * (float)l);
                ph_even_post(ATT_, p.in[12] + i * 256, p.in[13] + i * 128, lam_init, OF_, OB_, P_, p.in[18] + i * 128);
                grid.sync();
            }
            ph_gemm_res(ATT_, odd ? WOUTO_ + (size_t)i * DM * DM : WOUTE_ + (size_t)i * DM * DM, X_, mods_l + 2 * DM, lds);
        } else {
            ph_peer_route(QP_, p.in[24] + (size_t)l * 8 * 2 * 128 * 64, IDX_, GATE_);
            grid.sync();
            ph_peer_ffn8(A_, IDX_, GATE_, T8_ + (size_t)l * 16384 * DM, RS_ + l * 16384, T8_ + (size_t)(DEPTH + l) * 16384 * DM, RS_ + (DEPTH + l) * 16384, mods_l, X_, RT);
        }
        grid.sync();
    }
    ph_copy_out(X_, p.out);
}

extern "C" void kernel_launch(void* const* d_in, const int* in_sizes, int n_in, void* d_out, int out_size, void* d_ws, size_t ws_size, hipStream_t stream) {
    static int grid_blocks = 0;
    if (!grid_blocks) {
        int dev = 0, cus = 0, per_cu = 0;
        (void)hipGetDevice(&dev);
        (void)hipDeviceGetAttribute(&cus, hipDeviceAttributeMultiprocessorCount, dev);
        (void)hipFuncSetAttribute((const void*)mega, hipFuncAttributeMaxDynamicSharedMemorySize, LDS_BYTES);
        (void)hipOccupancyMaxActiveBlocksPerMultiprocessor(&per_cu, mega, NT, LDS_BYTES);
        if (per_cu < 1) fprintf(stderr, "occupancy query says %d blocks/CU\n", per_cu);
        grid_blocks = cus;
        if (ws_size < WS_END) fprintf(stderr, "workspace too small: %zu < %zu\n", ws_size, (size_t)WS_END);
    }
    Params p{};
    for (int i = 0; i < 27; ++i) p.in[i] = (const float*)d_in[i];
    p.out = (float*)d_out; p.ws = (unsigned char*)d_ws;
    void* args[] = {&p};
    hipError_t e = hipLaunchCooperativeKernel((void*)mega, dim3(grid_blocks), dim3(NT), args, LDS_BYTES, stream);
    if (e != hipSuccess) fprintf(stderr, "cooperative launch failed: %s (grid %d)\n", hipGetErrorString(e), grid_blocks);
}
```

```cpp
#include <hip/hip_runtime.h>
#include <hip/hip_cooperative_groups.h>
#include <stdint.h>
#include <cstdio>
namespace cg = cooperative_groups;

#define DM 1024
#define NB 16
#define SEQ 2048
#define CTX 256
#define RL (NB * SEQ)
#define RC (NB * CTX)
#define RT (RL + RC)
#define DEPTH 4
#define EVEN_IN 3104
#define EVEN_LDP 3328
#define ODD_IN 1536
#define NMOD 17
#define MODW 6144
#define NT 512
#define NWV 8
#define LDS_BYTES 147456

typedef unsigned short bf16;
typedef float f32x2_t __attribute__((ext_vector_type(2)));
typedef __bf16 bf16x2_t __attribute__((ext_vector_type(2)));
struct Params {
    const float* in[27];
    float* out;
    unsigned char* ws;
};

__device__ __forceinline__ int row_mod(int r) { return r < RL ? (r >> 11) : 16; }
__device__ __forceinline__ float silu_f(float x) { return x / (1.f + expf(-x)); }
__device__ __forceinline__ float wave_sum(float v) {
#pragma unroll
    for (int o = 1; o < 64; o <<= 1) v += __shfl_xor(v, o);
    return v;
}
__device__ __forceinline__ float log_sigmoid_f(float z) { return fminf(z, 0.f) - log1pf(expf(-fabsf(z))); }
__device__ __forceinline__ float gelu_tanh(float x) { float u = 0.7978845608028654f * (x + 0.044715f * x * x * x); return 0.5f * x * (1.f + tanhf(u)); }
__device__ __forceinline__ float bf2f(bf16 v) { return __uint_as_float((unsigned)v << 16); }
__device__ __forceinline__ unsigned f2bf(float f) { unsigned u = __float_as_uint(f); return (u + 0x7fffu + ((u >> 16) & 1u)) >> 16; }
__device__ __forceinline__ unsigned pk2(float lo, float hi) { return f2bf(lo) | (f2bf(hi) << 16); }
__device__ __forceinline__ float4 ld4bf(const bf16* p) { uint2 u = *(const uint2*)p; return make_float4(__uint_as_float(u.x << 16), __uint_as_float(u.x & 0xffff0000u), __uint_as_float(u.y << 16), __uint_as_float(u.y & 0xffff0000u)); }
__device__ __forceinline__ void st4bf(bf16* p, float4 v) { *(uint2*)p = make_uint2(pk2(v.x, v.y), pk2(v.z, v.w)); }
__device__ __forceinline__ float2 ld2bf(const bf16* p) { unsigned u = *(const unsigned*)p; return make_float2(__uint_as_float(u << 16), __uint_as_float(u & 0xffff0000u)); }
__device__ __forceinline__ void st2bf(bf16* p, float2 v) { *(unsigned*)p = pk2(v.x, v.y); }

__device__ __forceinline__ int opaque_tid() { int t = threadIdx.x; asm volatile("" : "+v"(t)); return t; }
__device__ __forceinline__ int opaque_bid() { int b = blockIdx.x; asm volatile("" : "+s"(b)); return b; }

namespace pg8 {
#define PG8_LAS __attribute__((address_space(3)))
typedef unsigned short bf16_t;
typedef short bf16x8 __attribute__((ext_vector_type(8)));
typedef float f32x4 __attribute__((ext_vector_type(4)));
typedef unsigned u32x4 __attribute__((ext_vector_type(4)));
constexpr int BM = 256, BK = 64, HALF = 128, HTB = HALF * BK * 2  , STAGE_BYTES = 8 * HTB, NXCD = 8, WGM = 8;

__host__ __device__ __forceinline__ int lds_byte(int r, int c) { const int st = (r >> 4) * 2 + (c >> 5), rr = r & 15, cc = c & 31, ob = rr * 64 + cc * 2; return st * 1024 + (ob ^ (((ob >> 9) & 1) << 5)); }
__host__ __device__ __forceinline__ void stage_rc(int b, int& R, int& C) { const int st = b / 1024, sb = b % 1024, swz = sb ^ (((sb >> 9) & 1) << 5); R = (st >> 1) * 16 + swz / 64; C = (st & 1) * 32 + (swz % 64) / 2; }
__host__ __device__ __forceinline__ int perm32(int rho) { const int n = rho >> 4, i = rho & 15; return 8 * (i >> 2) + 4 * n + (i & 3); }

struct Unit { int pm, pn; };
struct Gemm { const bf16_t* A; const bf16_t* Bt; int M, N, K; };

struct StaticOrder {
    int nM, nN, nwg, G, c;
    __host__ __device__ void init(int M, int N, int G_, int c_) { nM = M / BM; nN = N / BM; nwg = nM * nN; G = G_; c = c_; }
    __host__ __device__ bool next(int i, Unit& u) const {
        const long L = (long)i * G + c; if (L >= nwg) return false;
        int wgid = (int)L; { const int q = nwg / NXCD, r = nwg % NXCD, xcd = wgid % NXCD, off = wgid / NXCD; wgid = (xcd < r ? xcd * (q + 1) : r * (q + 1) + (xcd - r) * q) + off; }
        const int nig = WGM * nN, gid = wgid / nig, fm = gid * WGM, gsz = (nM - fm) < WGM ? (nM - fm) : WGM;
        u.pm = fm + ((wgid % nig) % gsz); u.pn = (wgid % nig) / gsz; return true;
    }
    __device__ __forceinline__ void a_ready(const Unit&) const {}
    __device__ __forceinline__ void done(const Unit&) const {}
};

__device__ __forceinline__ unsigned cvt_pk_bf16(float lo, float hi) { unsigned r; asm volatile("v_cvt_pk_bf16_f32 %0, %1, %2" : "=v"(r) : "v"(lo), "v"(hi)); return r; }
typedef float f32x2 __attribute__((ext_vector_type(2)));
__device__ __forceinline__ f32x2 gelu_pk(f32x2 v) {
    const f32x2 av = __builtin_elementwise_abs(v), d = av * 0.2316418882f + 1.0f;
    f32x2 t; t.x = __builtin_amdgcn_rcpf(d.x); t.y = __builtin_amdgcn_rcpf(d.y);
    f32x2 q = t * 0.5307027145f + (-0.7265760135f); q = q * t + 0.7107068705f; q = q * t + (-0.142248368f); q = q * t + 0.127414796f; q = q * t;
    const f32x2 s = (v * v) * (-0.72134752044f);
    f32x2 e; e.x = __builtin_amdgcn_exp2f(s.x); e.y = __builtin_amdgcn_exp2f(s.y);
    const f32x2 m = v * (q * e), r = v - m;
    f32x2 o; o.x = v.x < 0.f ? m.x : r.x; o.y = v.y < 0.f ? m.y : r.y; return o;
}

template <int ACT  > struct EpiBf16 {
    static constexpr bool PERM = true, AFTER_DRAIN = false; static_assert(ACT == 0 || ACT == 1, "EpiBf16: ACT is 0 (none) or 1 (gelu_pk)");
    bf16_t* O; int ldc; const float* bias; int split_cols; size_t split_stride; float scale0;
    __device__ __forceinline__ void operator()(const f32x4 (&acc)[2][2][4][2], const Unit& u, int wr, int wc, int fr, int fq) const {
        const int row0 = u.pm * BM + wr * 64 + fr; int colt = u.pn * BM; bf16_t* base = O;
        float sc = 1.f; if (split_cols) { const int t = colt / split_cols; base += (size_t)t * split_stride; colt -= t * split_cols; if (t == 0) sc = scale0; }
        const int col0 = colt + wc * 32 + 8 * fq, bcol0 = u.pn * BM + wc * 32 + 8 * fq;
        f32x4 bv[2][2];
#pragma unroll
        for (int bj = 0; bj < 2; ++bj)
#pragma unroll
            for (int n = 0; n < 2; ++n) bv[bj][n] = bias ? *(const f32x4*)(bias + bcol0 + bj * HALF + 4 * n) : (f32x4){0.f, 0.f, 0.f, 0.f};
#pragma unroll
        for (int ai = 0; ai < 2; ++ai)
#pragma unroll
            for (int m = 0; m < 4; ++m) { bf16_t* rowp = base + (size_t)(row0 + ai * HALF + m * 16) * ldc + col0;
#pragma unroll
                for (int bj = 0; bj < 2; ++bj) { f32x4 v0 = acc[ai][bj][m][0] + bv[bj][0], v1 = acc[ai][bj][m][1] + bv[bj][1];
                    if (ACT == 1) { f32x2 a = gelu_pk((f32x2){v0[0], v0[1]}), b = gelu_pk((f32x2){v0[2], v0[3]}), c = gelu_pk((f32x2){v1[0], v1[1]}), d = gelu_pk((f32x2){v1[2], v1[3]});
                        v0 = (f32x4){a.x, a.y, b.x, b.y}; v1 = (f32x4){c.x, c.y, d.x, d.y}; }
                    v0 = v0 * sc; v1 = v1 * sc; u32x4 w; w.x = cvt_pk_bf16(v0[0], v0[1]); w.y = cvt_pk_bf16(v0[2], v0[3]); w.z = cvt_pk_bf16(v1[0], v1[1]); w.w = cvt_pk_bf16(v1[2], v1[3]);
                    *(u32x4*)(rowp + bj * HALF) = w; } }
    }
};
template <class Epi, class Sched, bool ALIGN_EPI = false, bool SP2 = false>
__device__ __forceinline__ void gemm_phase(PG8_LAS unsigned char* lds, const Gemm g, const Sched& S, const Epi& E) {
    const int tid = opaque_tid(), wid = __builtin_amdgcn_readfirstlane(tid >> 6), lane = tid & 63, wr = wid >> 2, wc = wid & 3, fr = lane & 15, fq = lane >> 4;
    const int K = g.K, nt = K / BK;
    unsigned voffA[2], voffB[2];
#pragma unroll
    for (int i = 0; i < 2; ++i) { int R, C; stage_rc(tid * 16 + i * 8192, R, C); const int Rb = Epi::PERM ? ((R & ~31) + perm32(R & 31)) : R;
        voffA[i] = (unsigned)(R * K + C) * 2u; voffB[i] = (unsigned)(Rb * K + C) * 2u; }
    const size_t kstep = (size_t)(BK * 2);
    const size_t hstep = (size_t)HALF * K * 2;
    const size_t tstep = 2 * hstep;
    const unsigned ldsw = (unsigned)wid * 1024u;
    const int aoff = lds_byte(wr * 64 + fr, fq * 8), boff = lds_byte(wc * 32 + fr, fq * 8);
#define PG8_SA(b, h) (((b) * 2 + (h)) * HTB)
#define PG8_SB(b, h) ((4 + (b) * 2 + (h)) * HTB)
#define PG8_STAGE(bufoff, gbase, voff) do { _Pragma("unroll") for (int _i = 0; _i < 2; ++_i) \
        __builtin_amdgcn_global_load_lds((const unsigned*)((const char*)(gbase) + (voff)[_i]), (PG8_LAS unsigned*)(lds + (bufoff) + ldsw + _i * 8192), 16, 0, 0); } while (0)
#define PG8_LDA(dst, b, h) do { _Pragma("unroll") for (int m = 0; m < 4; ++m) _Pragma("unroll") for (int k = 0; k < 2; ++k) dst[m][k] = *(const PG8_LAS bf16x8*)(lds + PG8_SA(b, h) + aoff + m * 2048 + k * 1024); } while (0)
#define PG8_LDB(dst, b, h) do { _Pragma("unroll") for (int n = 0; n < 2; ++n) _Pragma("unroll") for (int k = 0; k < 2; ++k) dst[n][k] = *(const PG8_LAS bf16x8*)(lds + PG8_SB(b, h) + boff + n * 2048 + k * 1024); } while (0)
#define PG8_MMA(ai, bj, At, Bt) do { __builtin_amdgcn_s_setprio(1); _Pragma("unroll") for (int m = 0; m < 4; ++m) _Pragma("unroll") for (int n = 0; n < 2; ++n) _Pragma("unroll") for (int k = 0; k < 2; ++k) \
        acc[ai][bj][m][n] = __builtin_amdgcn_mfma_f32_16x16x32_bf16(Bt[n][k], At[m][k], acc[ai][bj][m][n], 0, 0, 0); __builtin_amdgcn_s_setprio(0); } while (0)
#define PG8_WAIT_V(n) asm volatile("s_waitcnt vmcnt(" #n ")" ::: "memory")
#define PG8_WAIT_L(n) asm volatile("s_waitcnt lgkmcnt(" #n ")" ::: "memory")
#define PG8_BAR __builtin_amdgcn_s_barrier()
#define PG8_SCHED __builtin_amdgcn_sched_barrier(0)
    Unit cur, nxt; int ui = 0;
    if (!S.next(0, cur)) return;
    f32x4 acc[2][2][4][2];
#pragma unroll
    for (int a = 0; a < 2; ++a)
#pragma unroll
        for (int b = 0; b < 2; ++b)
#pragma unroll
            for (int m = 0; m < 4; ++m)
#pragma unroll
                for (int n = 0; n < 2; ++n) acc[a][b][m][n] = (f32x4){0.f, 0.f, 0.f, 0.f};
    bf16x8 At[4][2], B0[2][2], B1[2][2];
    const char* cA = (const char*)g.A + (size_t)cur.pm * tstep; const char* cB = (const char*)g.Bt + (size_t)cur.pn * tstep;
    S.a_ready(cur);
    if constexpr (SP2) {
        PG8_STAGE(PG8_SB(0, 0), cB, voffB); PG8_STAGE(PG8_SB(0, 1), cB + hstep, voffB); PG8_STAGE(PG8_SA(0, 0), cA, voffA); PG8_STAGE(PG8_SA(0, 1), cA + hstep, voffA);
        if (wr == 1) PG8_BAR;
        PG8_WAIT_V(2); PG8_BAR;
        PG8_STAGE(PG8_SB(1, 0), cB + kstep, voffB); PG8_STAGE(PG8_SA(1, 0), cA + kstep, voffA); PG8_STAGE(PG8_SB(1, 1), cB + hstep + kstep, voffB);
        PG8_WAIT_V(6); PG8_BAR;
    } else {
        PG8_STAGE(PG8_SB(0, 0), cB, voffB); PG8_STAGE(PG8_SA(0, 0), cA, voffA); PG8_STAGE(PG8_SB(0, 1), cB + hstep, voffB); PG8_STAGE(PG8_SA(0, 1), cA + hstep, voffA);
        if (wr == 1) PG8_BAR;
        PG8_WAIT_V(4); PG8_BAR;
        PG8_STAGE(PG8_SB(1, 0), cB + kstep, voffB); PG8_STAGE(PG8_SA(1, 0), cA + kstep, voffA); PG8_STAGE(PG8_SB(1, 1), cB + hstep + kstep, voffB);
        PG8_WAIT_V(6); PG8_BAR;
    }
    for (;;) {
        const bool has_next = S.next(ui + 1, nxt);
        const char* nA = has_next ? (const char*)g.A + (size_t)nxt.pm * tstep : cA; const char* nB = has_next ? (const char*)g.Bt + (size_t)nxt.pn * tstep : cB;
        for (int t = 0; t < nt; t += 2) {
            const bool last = (t == nt - 2);
            const char* a1 = cA + (size_t)(t + 1) * kstep;
            const char* a2 = last ? nA : cA + (size_t)(t + 2) * kstep; const char* b2 = last ? nB : cB + (size_t)(t + 2) * kstep;
            const char* a3 = a2 + kstep; const char* b3 = b2 + kstep;
            if (last && has_next) S.a_ready(nxt);
            if constexpr (SP2) {
            PG8_LDB(B0, 0, 0); PG8_LDB(B1, 0, 1); PG8_SCHED; PG8_LDA(At, 0, 0); PG8_STAGE(PG8_SA(1, 1), a1 + hstep, voffA);
            PG8_WAIT_V(8); PG8_WAIT_L(0); PG8_BAR; PG8_MMA(0, 0, At, B0); PG8_MMA(0, 1, At, B1); PG8_BAR; PG8_SCHED;
            PG8_LDA(At, 0, 1); PG8_STAGE(PG8_SB(0, 0), b2, voffB); PG8_STAGE(PG8_SB(0, 1), b2 + hstep, voffB); PG8_STAGE(PG8_SA(0, 0), a2, voffA);
            PG8_WAIT_V(8); PG8_WAIT_L(0); PG8_BAR; PG8_MMA(1, 0, At, B0); PG8_MMA(1, 1, At, B1); PG8_BAR; PG8_SCHED;
            PG8_LDB(B0, 1, 0); PG8_LDB(B1, 1, 1); PG8_SCHED; PG8_LDA(At, 1, 0); PG8_STAGE(PG8_SA(0, 1), a2 + hstep, voffA);
            PG8_WAIT_V(8); PG8_WAIT_L(0); PG8_BAR; PG8_MMA(0, 0, At, B0); PG8_MMA(0, 1, At, B1); PG8_BAR; PG8_SCHED;
            PG8_LDA(At, 1, 1); PG8_STAGE(PG8_SB(1, 0), b3, voffB); PG8_STAGE(PG8_SB(1, 1), b3 + hstep, voffB); PG8_STAGE(PG8_SA(1, 0), a3, voffA);
            PG8_WAIT_V(8); PG8_WAIT_L(0); PG8_BAR; PG8_MMA(1, 0, At, B0); PG8_MMA(1, 1, At, B1); PG8_BAR; PG8_SCHED;
            } else {
            PG8_LDB(B0, 0, 0); PG8_SCHED; PG8_LDA(At, 0, 0); PG8_STAGE(PG8_SA(1, 1), a1 + hstep, voffA);
            PG8_WAIT_L(8); PG8_BAR; PG8_WAIT_L(0); PG8_MMA(0, 0, At, B0); PG8_BAR; PG8_SCHED;
            PG8_LDB(B1, 0, 1); PG8_STAGE(PG8_SB(0, 0), b2, voffB);
            PG8_BAR; PG8_WAIT_L(0); PG8_MMA(0, 1, At, B1); PG8_BAR;
            PG8_LDA(At, 0, 1); PG8_STAGE(PG8_SA(0, 0), a2, voffA);
            PG8_BAR; PG8_WAIT_L(0); PG8_MMA(1, 0, At, B0); PG8_BAR; PG8_SCHED;
            PG8_STAGE(PG8_SB(0, 1), b2 + hstep, voffB);
            PG8_WAIT_V(6); PG8_BAR; PG8_MMA(1, 1, At, B1); PG8_BAR;
            PG8_LDB(B0, 1, 0); PG8_SCHED; PG8_LDA(At, 1, 0); PG8_STAGE(PG8_SA(0, 1), a2 + hstep, voffA);
            PG8_WAIT_L(8); PG8_BAR; PG8_WAIT_L(0); PG8_MMA(0, 0, At, B0); PG8_BAR; PG8_SCHED;
            PG8_LDB(B1, 1, 1); PG8_STAGE(PG8_SB(1, 0), b3, voffB);
            PG8_BAR; PG8_WAIT_L(0); PG8_MMA(0, 1, At, B1); PG8_BAR;
            PG8_LDA(At, 1, 1); PG8_STAGE(PG8_SA(1, 0), a3, voffA);
            PG8_BAR; PG8_WAIT_L(0); PG8_MMA(1, 0, At, B0); PG8_BAR; PG8_SCHED;
            PG8_STAGE(PG8_SB(1, 1), b3 + hstep, voffB);
            PG8_WAIT_V(6); PG8_BAR; PG8_MMA(1, 1, At, B1); PG8_BAR;
            }
        }
        if constexpr (ALIGN_EPI) { if (wr == 0) PG8_BAR; }
        if constexpr (!Epi::AFTER_DRAIN) { E(acc, cur, wr, wc, fr, fq); S.done(cur); }
        if (!has_next) break;
#pragma unroll
        for (int a = 0; a < 2; ++a)
#pragma unroll
            for (int b = 0; b < 2; ++b)
#pragma unroll
                for (int m = 0; m < 4; ++m)
#pragma unroll
                    for (int n = 0; n < 2; ++n) acc[a][b][m][n] = (f32x4){0.f, 0.f, 0.f, 0.f};
        cur = nxt; cA = nA; cB = nB; ++ui;
        if constexpr (ALIGN_EPI) { if (wr == 1) PG8_BAR; }
    }
    PG8_WAIT_V(0);
    if constexpr (!ALIGN_EPI) { if (wr == 0) PG8_BAR; }
    PG8_BAR;
    if constexpr (Epi::AFTER_DRAIN) { E.fused(acc, cur, wr, wc, fr, fq, lds, wid, lane); S.done(cur); }
#undef PG8_SA
#undef PG8_SB
#undef PG8_STAGE
#undef PG8_LDA
#undef PG8_LDB
#undef PG8_MMA
#undef PG8_WAIT_V
#undef PG8_WAIT_L
#undef PG8_BAR
#undef PG8_SCHED
}
}

struct EpiResGate {
    static constexpr bool PERM = false, AFTER_DRAIN = false;
    float* X; const float* gate;
    __device__ __forceinline__ void operator()(const pg8::f32x4 (&acc)[2][2][4][2], const pg8::Unit& u, int wr, int wc, int fr, int fq) const {
#pragma unroll
        for (int ai = 0; ai < 2; ++ai)
#pragma unroll
            for (int m = 0; m < 4; ++m) {
                const int r = u.pm * 256 + ai * 128 + wr * 64 + m * 16 + fr;
                const float* g = gate + (size_t)row_mod(r) * MODW; float* xr = X + (size_t)r * DM;
#pragma unroll
                for (int bj = 0; bj < 2; ++bj)
#pragma unroll
                    for (int n = 0; n < 2; ++n) {
                        const int c = u.pn * 256 + bj * 128 + wc * 32 + n * 16 + 4 * fq;
                        pg8::f32x4 xv = *(const pg8::f32x4*)(xr + c); const pg8::f32x4 gv = *(const pg8::f32x4*)(g + c);
                        xv = xv + gv * acc[ai][bj][m][n];
                        *(pg8::f32x4*)(xr + c) = xv;
                    }
            }
    }
};
#define LAS __attribute__((address_space(3)))
#define GAS __attribute__((address_space(1)))

__device__ __forceinline__ void ph_copy_in(const float* __restrict__ x, const float* __restrict__ ctx, float* __restrict__ X) {
    const int TID = opaque_tid(), BID = opaque_bid();
    size_t i = (size_t)BID * NT + TID;
    const size_t n4 = (size_t)RT * DM / 4, nl4 = (size_t)RL * DM / 4;
    for (; i < n4; i += (size_t)gridDim.x * NT) ((float4*)X)[i] = i < nl4 ? ((const float4*)x)[i] : ((const float4*)ctx)[i - nl4];
}
__device__ __forceinline__ void ph_copy_out(const float* __restrict__ X, float* __restrict__ out) {
    const int TID = opaque_tid(), BID = opaque_bid();
    size_t i = (size_t)BID * NT + TID;
    const size_t n4 = (size_t)RL * DM / 4;
    for (; i < n4; i += (size_t)gridDim.x * NT) ((float4*)out)[i] = ((const float4*)X)[i];
}
__device__ __forceinline__ void ph_rope_table(float2* __restrict__ rope) {
    const int TID = opaque_tid(), BID = opaque_bid();
    for (int i = BID * NT + TID; i < SEQ * 32; i += gridDim.x * NT) {
        int t = i >> 5, a = (i >> 4) & 1, f = i & 15;
        float pos = a == 0 ? (float)(t >> 6) : (float)(t & 63);
        float inv = powf(10000.f, -(float)f / 16.f);
        float ang = pos * inv;
        rope[i] = make_float2(cosf(ang), sinf(ang));
    }
}
__device__ __forceinline__ void transpose_item(const float* __restrict__ W, int N, bf16* __restrict__ WT, LAS float* scr, int item, int lane) {
    const int K = DM;
    const int nblk = N / 32, kb = item / nblk, nb = item % nblk, k0 = 64 * kb, n0 = 32 * nb;
#pragma unroll 8
    for (int i = 0; i < 32; ++i) { const int kk = 2 * i + (lane >> 5); scr[kk * 33 + (lane & 31)] = W[(size_t)(k0 + kk) * N + n0 + (lane & 31)]; }
    asm volatile("s_waitcnt lgkmcnt(0)" ::: "memory");
    const int c = lane & 7;
#pragma unroll
    for (int j = 0; j < 4; ++j) { const int n = (lane >> 3) + 8 * j; const LAS float* s = scr + (8 * c) * 33 + n;
        uint4 o; o.x = pk2(s[0 * 33], s[1 * 33]); o.y = pk2(s[2 * 33], s[3 * 33]); o.z = pk2(s[4 * 33], s[5 * 33]); o.w = pk2(s[6 * 33], s[7 * 33]);
        *(uint4*)(WT + (size_t)(n0 + n) * K + k0 + 8 * c) = o; }
    asm volatile("s_waitcnt lgkmcnt(0)" ::: "memory");
}
struct WPrep { const float* src[12]; bf16* dst[12]; };
__device__ __forceinline__ void ph_weight_prep(const float* const* in, bf16* WinE, bf16* WoutE, bf16* WinO, bf16* WoutO, bf16* Wpq, unsigned char* lds) {
    const int TID = opaque_tid(), BID = opaque_bid();
    const int lane = TID & 63, wv = TID >> 6;
    LAS float* scr = (LAS float*)((LAS unsigned char*)lds + wv * 16384);
    const int gw = BID * NWV + wv, NGW = gridDim.x * NWV;
    const int NITEMS = 2 * 1552 + 2 * 512 + 2 * 768 + 2 * 512 + 4 * 512;
    for (int it = gw; it < NITEMS; it += NGW) {
        int r = it;
        if (r < 3104) { int i = r / 1552; transpose_item(in[8] + (size_t)i * DM * EVEN_IN, EVEN_IN, WinE + (size_t)i * EVEN_LDP * DM, scr, r % 1552, lane); continue; } r -= 3104;
        if (r < 1024) { int i = r / 512; transpose_item(in[9] + (size_t)i * DM * DM, DM, WoutE + (size_t)i * DM * DM, scr, r % 512, lane); continue; } r -= 1024;
        if (r < 1536) { int i = r / 768; transpose_item(in[19] + (size_t)i * DM * ODD_IN, ODD_IN, WinO + (size_t)i * ODD_IN * DM, scr, r % 768, lane); continue; } r -= 1536;
        if (r < 1024) { int i = r / 512; transpose_item(in[20] + (size_t)i * DM * DM, DM, WoutO + (size_t)i * DM * DM, scr, r % 512, lane); continue; } r -= 1024;
        { int i = r / 512; transpose_item(in[23] + (size_t)i * DM * DM, DM, Wpq + (size_t)i * DM * DM, scr, r % 512, lane); }
    }
    for (int i = BID * NT + TID; i < 2 * 28672; i += gridDim.x * NT) {
        int w = i / 28672, o = i % 28672;
        ((uint4*)(WinE + (size_t)w * EVEN_LDP * DM + (size_t)EVEN_IN * DM))[o] = make_uint4(0u, 0u, 0u, 0u);
    }
}
__device__ __forceinline__ void ph_mods(const float* __restrict__ c, const float* __restrict__ cctx, const float* __restrict__ w_mod,
                        const float* __restrict__ b_mod, float* __restrict__ mods, float* smem) {
    const int TID = opaque_tid(), BID = opaque_bid();
    const int nvb = DEPTH * MODW / NT;
    if (BID >= nvb) return;
    float (*S)[DM] = (float (*)[DM])smem;
    for (int i = TID; i < NMOD * DM; i += NT) {
        int j = i / DM, k = i % DM;
        float v = j < 16 ? c[j * DM + k] : cctx[k];
        S[j][k] = silu_f(v);
    }
    __syncthreads();
    for (int vb = BID; vb < nvb; vb += gridDim.x) {
        int idx = vb * NT + TID, l = idx / MODW, n = idx % MODW;
        const float* W = w_mod + (size_t)l * DM * MODW;
        float acc[NMOD];
#pragma unroll
        for (int j = 0; j < NMOD; ++j) acc[j] = 0.f;
        for (int k = 0; k < DM; ++k) {
            float w = W[(size_t)k * MODW + n];
#pragma unroll
            for (int j = 0; j < NMOD; ++j) acc[j] += S[j][k] * w;
        }
        float b = b_mod[l * MODW + n];
#pragma unroll
        for (int j = 0; j < NMOD; ++j) mods[((size_t)l * NMOD + j) * MODW + n] = acc[j] + b;
    }
    __syncthreads();
}
__device__ __forceinline__ void ph_norm_mod(const float* __restrict__ X, const float* __restrict__ g, const float* __restrict__ mods_l, int shift_chunk, bf16* __restrict__ A) {
    const int TID = opaque_tid(), BID = opaque_bid();
    int wave = BID * NWV + (TID >> 6), lane = TID & 63;
    int nw = gridDim.x * NWV;
    for (int r = wave; r < RT; r += nw) {
        const float4* xr = (const float4*)(X + (size_t)r * DM);
        float4 v[4]; float s = 0.f;
#pragma unroll
        for (int i = 0; i < 4; ++i) { v[i] = xr[lane + 64 * i]; s += v[i].x * v[i].x + v[i].y * v[i].y + v[i].z * v[i].z + v[i].w * v[i].w; }
        s = wave_sum(s);
        float rstd = rsqrtf(s * (1.f / DM) + 1e-6f);
        const float* m = mods_l + (size_t)row_mod(r) * MODW;
        const float4* sh = (const float4*)(m + shift_chunk * DM);
        const float4* sc = (const float4*)(m + (shift_chunk + 1) * DM);
        const float4* g4 = (const float4*)g;
        bf16* ar = A + (size_t)r * DM;
#pragma unroll
        for (int i = 0; i < 4; ++i) {
            int c = lane + 64 * i;
            float4 gg = g4[c], a = sh[c], b = sc[c], o;
            o.x = v[i].x * rstd * gg.x * (1.f + b.x) + a.x;
            o.y = v[i].y * rstd * gg.y * (1.f + b.y) + a.y;
            o.z = v[i].z * rstd * gg.z * (1.f + b.z) + a.z;
            o.w = v[i].w * rstd * gg.w * (1.f + b.w) + a.w;
            st4bf(ar + 4 * c, o);
        }
    }
}
#define KVLEN (CTX + SEQ)
__device__ __forceinline__ void ph_post(bf16* __restrict__ P, int ldp, int nq, int kcol0, int nk, int vcol0, int VC, int DV,
                                        const float* __restrict__ qgain, const float* __restrict__ kgain, const float2* __restrict__ rope,
                                        bf16* __restrict__ Kc, bf16* __restrict__ Vt) {
    const int TID = opaque_tid(), BID = opaque_bid();
    const float C2 = 0.125f * 1.4426950408889634f;
    for (int tile = BID; tile < RT / 64; tile += gridDim.x) {
        const int r0 = tile * 64;
        int b, j0;
        if (r0 < RL) { b = r0 >> 11; j0 = CTX + (r0 & (SEQ - 1)); } else { b = (r0 - RL) >> 8; j0 = (r0 - RL) & (CTX - 1); }
        const int nh = nq + nk;
        for (int it = TID; it < 64 * nh; it += NT) {
            const int row = it / nh, hh = it % nh, r = r0 + row;
            const bool isk = hh >= nq; const int h = isk ? hh - nq : hh;
            bf16* src = P + (size_t)r * ldp + (isk ? kcol0 : 0) + h * 64;
            const float* gain = isk ? kgain : qgain;
            float v[64]; float s = 0.f;
#pragma unroll
            for (int i = 0; i < 16; ++i) { float4 t = ld4bf(src + 4 * i); v[4 * i] = t.x; v[4 * i + 1] = t.y; v[4 * i + 2] = t.z; v[4 * i + 3] = t.w; }
#pragma unroll
            for (int i = 0; i < 64; ++i) s += v[i] * v[i];
            const float rstd = rsqrtf(s * (1.f / 64.f) + 1e-6f) * (isk ? 1.f : C2);
#pragma unroll
            for (int i = 0; i < 64; ++i) v[i] = v[i] * rstd * gain[i];
            if (r < RL) {
                const float2* tab = rope + (size_t)(r & (SEQ - 1)) * 32;
#pragma unroll
                for (int a = 0; a < 2; ++a)
#pragma unroll
                    for (int f = 0; f < 16; ++f) {
                        float2 cs = tab[a * 16 + f];
                        float x1 = v[a * 32 + f], x2 = v[a * 32 + 16 + f];
                        v[a * 32 + f] = x1 * cs.x - x2 * cs.y;
                        v[a * 32 + 16 + f] = x2 * cs.x + x1 * cs.y;
                    }
            }
            bf16* dst = isk ? Kc + ((size_t)(b * nk + h) * KVLEN + j0 + row) * 64 : src;
#pragma unroll
            for (int i = 0; i < 16; ++i) st4bf(dst + 4 * i, make_float4(v[4 * i], v[4 * i + 1], v[4 * i + 2], v[4 * i + 3]));
        }
        if (TID < VC) {
            const int c8 = TID >> 3, rg = TID & 7;
            unsigned in[8][4];
#pragma unroll
            for (int rr = 0; rr < 8; ++rr) { uint4 t = *(const uint4*)(P + (size_t)(r0 + rg * 8 + rr) * ldp + vcol0 + c8 * 8); in[rr][0] = t.x; in[rr][1] = t.y; in[rr][2] = t.z; in[rr][3] = t.w; }
#pragma unroll
            for (int c = 0; c < 8; ++c) {
                unsigned o[4];
#pragma unroll
                for (int q = 0; q < 4; ++q)
                    o[q] = (c & 1) ? __builtin_amdgcn_perm(in[2 * q + 1][c >> 1], in[2 * q][c >> 1], 0x07060302u) : __builtin_amdgcn_perm(in[2 * q + 1][c >> 1], in[2 * q][c >> 1], 0x05040100u);
                const int col = c8 * 8 + c, vh = col / DV, d = col % DV;
                *(uint4*)(Vt + ((size_t)(b * 4 + vh) * DV + d) * KVLEN + j0 + rg * 8) = make_uint4(o[0], o[1], o[2], o[3]);
            }
        }
    }
}
typedef short bf16x8 __attribute__((ext_vector_type(8)));
typedef float f32x16 __attribute__((ext_vector_type(16)));
__device__ __forceinline__ int crow(int r, int hi) { return (r & 3) + 8 * (r >> 2) + 4 * hi; }
__device__ __forceinline__ unsigned cvt_pk_bf16_f32(float lo, float hi) { f32x2_t v = {lo, hi}; bf16x2_t b = __builtin_convertvector(v, bf16x2_t); return __builtin_bit_cast(unsigned, b); }
#define ATT_KPITCH 144
#define ATT_VPITCH 136
template <int DV>
__device__ __forceinline__ void attn_unit(const bf16* __restrict__ Qbase, int ldq, const bf16* __restrict__ Kc, const bf16* __restrict__ Vt, int ntiles,
                                          bf16* __restrict__ Obase, int ldo, unsigned char* lds, int tid) {
    constexpr int NDB = DV / 32, NVL = DV / 64, KBYTES = 64 * ATT_KPITCH, BUFSZ = KBYTES + DV * ATT_VPITCH;
    constexpr float THR = 8.f;
    const int lane = tid & 63, wid = tid >> 6, r32 = lane & 31, hi = lane >> 5;
    float* sc = (float*)(lds + 2 * BUFSZ + wid * 128);
    bf16x8 qf[4];
    {
        const bf16* qrow = Qbase + (size_t)(wid * 32 + r32) * ldq;
#pragma unroll
        for (int s = 0; s < 4; ++s) qf[s] = *(const bf16x8*)(qrow + 16 * s + 8 * hi);
    }
    f32x16 o[NDB];
#pragma unroll
    for (int d = 0; d < NDB; ++d)
#pragma unroll
        for (int r = 0; r < 16; ++r) o[d][r] = 0.f;
    float m = -1e30f, l = 0.f;
    uint4 kreg, vreg[NVL];
    const int krow = tid >> 3, kch = tid & 7;
#define ATT_LOAD(t) do { kreg = *(const uint4*)(Kc + (size_t)(t) * 64 * 64 + tid * 8); \
        _Pragma("unroll") for (int u = 0; u < NVL; ++u) { const int idx = tid + NT * u; vreg[u] = *(const uint4*)(Vt + (size_t)(idx >> 3) * KVLEN + (t) * 64 + (idx & 7) * 8); } } while (0)
#define ATT_STORE(buf) do { *(uint4*)(lds + (buf) * BUFSZ + krow * ATT_KPITCH + kch * 16) = kreg; \
        _Pragma("unroll") for (int u = 0; u < NVL; ++u) { const int idx = tid + NT * u; unsigned char* vp = lds + (buf) * BUFSZ + KBYTES + (idx >> 3) * ATT_VPITCH + (idx & 7) * 16; \
            *(uint2*)vp = make_uint2(vreg[u].x, vreg[u].y); *(uint2*)(vp + 8) = make_uint2(vreg[u].z, vreg[u].w); } } while (0)
    ATT_LOAD(0);
    ATT_STORE(0);
    __syncthreads();
    for (int t = 0; t < ntiles; ++t) {
        const int buf = t & 1;
        if (t + 1 < ntiles) ATT_LOAD(t + 1);
        const unsigned char* kb = lds + buf * BUFSZ;
        const unsigned char* vb = kb + KBYTES;
        f32x16 s0, s1;
#pragma unroll
        for (int r = 0; r < 16; ++r) { s0[r] = 0.f; s1[r] = 0.f; }
#pragma unroll
        for (int s = 0; s < 4; ++s) {
            const bf16x8 a0 = *(const bf16x8*)(kb + r32 * ATT_KPITCH + s * 32 + hi * 16);
            const bf16x8 a1 = *(const bf16x8*)(kb + (32 + r32) * ATT_KPITCH + s * 32 + hi * 16);
            s0 = __builtin_amdgcn_mfma_f32_32x32x16_bf16(a0, qf[s], s0, 0, 0, 0);
            s1 = __builtin_amdgcn_mfma_f32_32x32x16_bf16(a1, qf[s], s1, 0, 0, 0);
        }
        float tm = fmaxf(s0[0], s1[0]);
#pragma unroll
        for (int r = 1; r < 16; ++r) tm = fmaxf(tm, fmaxf(s0[r], s1[r]));
        tm = fmaxf(tm, __shfl_xor(tm, 32));
        if (__any(tm > m + THR)) {
            const float mn = fmaxf(m, tm), alpha = exp2f(m - mn);
            m = mn; l *= alpha;
            if (hi == 0) sc[r32] = alpha;
#pragma unroll
            for (int r = 0; r < 16; ++r) { const float a = sc[crow(r, hi)];
#pragma unroll
                for (int d = 0; d < NDB; ++d) o[d][r] *= a; }
        }
        float ps = 0.f;
#pragma unroll
        for (int r = 0; r < 16; ++r) { s0[r] = exp2f(s0[r] - m); s1[r] = exp2f(s1[r] - m); ps += s0[r] + s1[r]; }
        l += ps;
        bf16x8 pa[4];
#pragma unroll
        for (int s = 0; s < 4; ++s) {
            unsigned w[4];
#pragma unroll
            for (int k = 0; k < 4; ++k) w[k] = (s < 2) ? cvt_pk_bf16_f32(s0[8 * (s & 1) + 2 * k], s0[8 * (s & 1) + 2 * k + 1]) : cvt_pk_bf16_f32(s1[8 * (s & 1) + 2 * k], s1[8 * (s & 1) + 2 * k + 1]);
            uint4 pw = make_uint4(w[0], w[1], w[2], w[3]);
            pa[s] = __builtin_bit_cast(bf16x8, pw);
        }
#pragma unroll
        for (int d = 0; d < NDB; ++d) {
#pragma unroll
            for (int s = 0; s < 4; ++s) {
                const unsigned char* vp = vb + (32 * d + r32) * ATT_VPITCH + 32 * s + 8 * hi;
                const uint2 v0 = *(const uint2*)vp, v1 = *(const uint2*)(vp + 16);
                uint4 vw = make_uint4(v0.x, v0.y, v1.x, v1.y);
                o[d] = __builtin_amdgcn_mfma_f32_32x32x16_bf16(pa[s], __builtin_bit_cast(bf16x8, vw), o[d], 0, 0, 0);
            }
        }
        if (t + 1 < ntiles) ATT_STORE(buf ^ 1);
        __syncthreads();
    }
#undef ATT_LOAD
#undef ATT_STORE
    l += __shfl_xor(l, 32);
    if (hi == 0) sc[r32] = 1.f / l;
#pragma unroll
    for (int r = 0; r < 16; ++r) {
        const float iv = sc[crow(r, hi)];
        bf16* orow = Obase + (size_t)(wid * 32 + crow(r, hi)) * ldo + r32;
#pragma unroll
        for (int d = 0; d < NDB; ++d) orow[32 * d] = (bf16)f2bf(o[d][r] * iv);
    }
    __syncthreads();
}
__device__ __forceinline__ void ph_attn_mfma(const bf16* __restrict__ P, int ldp, const bf16* __restrict__ Kc, const bf16* __restrict__ Vt, bf16* __restrict__ ATT,
                                             int odd, int with_ctx, unsigned char* lds) {
    const int TID = opaque_tid(), BID = opaque_bid();
    const int G = gridDim.x, vcu = (G % 8 == 0) ? (BID & 7) * (G >> 3) + (BID >> 3) : BID;
    const int nlat = odd ? 2048 : 1024, nctx = with_ctx ? (odd ? 256 : 128) : 0;
    for (int u = vcu; u < nlat + nctx; u += G) {
        int b, qh, row0, ntiles;
        if (u < nlat) {
            if (odd) { const int grp = u >> 5, w = u & 31; b = grp >> 2; qh = (grp & 3) * 4 + (w >> 3); row0 = b * SEQ + (w & 7) * 256; }
            else { const int grp = u >> 4, w = u & 15; b = grp >> 2; qh = (grp & 3) * 2 + (w >> 3); row0 = b * SEQ + (w & 7) * 256; }
            ntiles = KVLEN / 64;
        } else {
            const int idx = u - nlat;
            if (odd) { b = idx >> 4; qh = idx & 15; } else { b = idx >> 3; qh = idx & 7; }
            row0 = RL + b * CTX; ntiles = CTX / 64;
        }
        if (odd) attn_unit<64>(P + (size_t)row0 * ldp + qh * 64, ldp, Kc + (size_t)(b * 4 + (qh >> 2)) * KVLEN * 64, Vt + (size_t)(b * 4 + (qh >> 2)) * 64 * KVLEN, ntiles,
                               ATT + (size_t)row0 * DM + qh * 64, DM, lds, TID);
        else attn_unit<128>(P + (size_t)row0 * ldp + qh * 64, ldp, Kc + (size_t)(b * 8 + qh) * KVLEN * 64, Vt + (size_t)(b * 4 + (qh >> 1)) * 128 * KVLEN, ntiles,
                            ATT + (size_t)row0 * DM + qh * 128, DM, lds, TID);
    }
}
typedef float f32x4_t __attribute__((ext_vector_type(4)));
#define GLA_PITCH 144
__device__ __forceinline__ void ph_gla_chunk(const bf16* __restrict__ P, const float* __restrict__ w_af, const float* __restrict__ b_af,
                                             const float* __restrict__ w_ab, const float* __restrict__ b_ab, float* __restrict__ OF, float* __restrict__ OB, unsigned char* lds) {
    const int TID = opaque_tid(), BID = opaque_bid();
    const int tid = TID, lane = tid & 63, wid = tid >> 6, l15 = lane & 15, q4 = lane >> 4;
    float* SEG = (float*)lds;
    float* DEC = (float*)(lds + 2048);
    unsigned char* QD = lds + 4096;
    unsigned char* KI = QD + 9216;
    unsigned char* KET = KI + 9216;
    unsigned char* AT = KET + 9216;
    unsigned char* VT = AT + 9216;
    for (int unit = BID; unit < NB * 4 * 2; unit += gridDim.x) {
        const int dir = unit & 1, h = (unit >> 1) & 3, b = unit >> 3;
        const float* wa = dir ? w_ab : w_af; const float* ba = dir ? b_ab : b_af;
        float* Od = dir ? OB : OF;
        const int d = tid & 63, seg = tid >> 6;
        float wreg[16];
#pragma unroll
        for (int j = 0; j < 16; ++j) wreg[j] = wa[j * 256 + h * 64 + d];
        const float breg = ba[h * 64 + d];
        for (int i = tid; i < 9216 / 16; i += NT) ((uint4*)AT)[i] = make_uint4(0u, 0u, 0u, 0u);
        f32x4_t S[4];
#pragma unroll
        for (int i = 0; i < 4; ++i) S[i] = (f32x4_t){0.f, 0.f, 0.f, 0.f};
        __syncthreads();
        for (int ch = 0; ch < KVLEN / 64; ++ch) {
            int rbase, rsgn;
            if (!dir) { rbase = ch < 4 ? RL + b * CTX + ch * 64 : b * SEQ + (ch - 4) * 64; rsgn = 1; }
            else { rbase = ch < 4 ? RL + b * CTX + (CTX - 1 - ch * 64) : b * SEQ + (SEQ - 1 - (ch - 4) * 64); rsgn = -1; }
            float cl[8];
            {
                float run = 0.f;
#pragma unroll
                for (int i = 0; i < 8; ++i) {
                    const bf16* pr = P + (size_t)(rbase + rsgn * (8 * seg + i)) * EVEN_LDP + 3072 + dir * 16;
                    const uint4 g0 = *(const uint4*)pr, g1 = *(const uint4*)(pr + 8);
                    const unsigned gw[8] = {g0.x, g0.y, g0.z, g0.w, g1.x, g1.y, g1.z, g1.w};
                    float z = breg;
#pragma unroll
                    for (int j = 0; j < 8; ++j) { z += __uint_as_float(gw[j] << 16) * wreg[2 * j]; z += __uint_as_float(gw[j] & 0xffff0000u) * wreg[2 * j + 1]; }
                    run += log_sigmoid_f(z) * (1.f / 16.f);
                    cl[i] = run;
                }
                SEG[seg * 64 + d] = run;
            }
            __syncthreads();
            {
                float prefix = 0.f, total = 0.f;
#pragma unroll
                for (int s2 = 0; s2 < 8; ++s2) { const float v = SEG[s2 * 64 + d]; total += v; prefix += (s2 < seg) ? v : 0.f; }
                if (seg == 0) DEC[d] = __expf(total);
                unsigned kew[4];
#pragma unroll
                for (int i = 0; i < 8; ++i) {
                    const int c = 8 * seg + i;
                    const bf16* pr = P + (size_t)(rbase + rsgn * c) * EVEN_LDP;
                    const float qv = bf2f(pr[1536 + h * 64 + d]) * 0.125f, kv = bf2f(pr[1792 + h * 64 + d]);
                    const float cum = prefix + cl[i];
                    const float e = __expf(cum), ei = __expf(-cum), ee = __expf(total - cum);
                    *(bf16*)(QD + c * GLA_PITCH + d * 2) = (bf16)f2bf(qv * e);
                    *(bf16*)(KI + c * GLA_PITCH + d * 2) = (bf16)f2bf(kv * ei);
                    const unsigned kb = f2bf(kv * ee);
                    if (i & 1) kew[i >> 1] |= kb << 16; else kew[i >> 1] = kb;
                }
                *(uint4*)(KET + d * GLA_PITCH + seg * 16) = make_uint4(kew[0], kew[1], kew[2], kew[3]);
                const int v = tid & 127, cg = tid >> 7;
                unsigned vw[8];
#pragma unroll
                for (int i = 0; i < 16; ++i) {
                    const unsigned x = P[(size_t)(rbase + rsgn * (16 * cg + i)) * EVEN_LDP + 2048 + h * 128 + v];
                    if (i & 1) vw[i >> 1] |= x << 16; else vw[i >> 1] = x;
                }
                *(uint4*)(VT + v * GLA_PITCH + cg * 32) = make_uint4(vw[0], vw[1], vw[2], vw[3]);
                *(uint4*)(VT + v * GLA_PITCH + cg * 32 + 16) = make_uint4(vw[4], vw[5], vw[6], vw[7]);
            }
            __syncthreads();
            for (int blk = wid; blk < 10; blk += NWV) {
                int sblk, cblk;
                if (blk < 4) { sblk = 0; cblk = blk; } else if (blk < 7) { sblk = 1; cblk = blk - 3; } else if (blk < 9) { sblk = 2; cblk = blk - 5; } else { sblk = 3; cblk = 3; }
                f32x4_t acc = (f32x4_t){0.f, 0.f, 0.f, 0.f};
#pragma unroll
                for (int kk = 0; kk < 2; ++kk) {
                    const bf16x8 a = *(const bf16x8*)(KI + (16 * sblk + l15) * GLA_PITCH + 64 * kk + 16 * q4);
                    const bf16x8 bq = *(const bf16x8*)(QD + (16 * cblk + l15) * GLA_PITCH + 64 * kk + 16 * q4);
                    acc = __builtin_amdgcn_mfma_f32_16x16x32_bf16(a, bq, acc, 0, 0, 0);
                }
                const int c = 16 * cblk + l15, s0 = 16 * sblk + 4 * q4;
                float av[4];
#pragma unroll
                for (int r = 0; r < 4; ++r) av[r] = (s0 + r <= c) ? acc[r] : 0.f;
                *(uint2*)(AT + c * GLA_PITCH + s0 * 2) = make_uint2(pk2(av[0], av[1]), pk2(av[2], av[3]));
            }
            __syncthreads();
            {
                const int v0 = 16 * wid;
                bf16x8 bv[2], sB[2];
#pragma unroll
                for (int kk = 0; kk < 2; ++kk) {
                    bv[kk] = *(const bf16x8*)(VT + (v0 + l15) * GLA_PITCH + 64 * kk + 16 * q4);
                    uint4 w = make_uint4(pk2(S[2 * kk][0], S[2 * kk][1]), pk2(S[2 * kk][2], S[2 * kk][3]), pk2(S[2 * kk + 1][0], S[2 * kk + 1][1]), pk2(S[2 * kk + 1][2], S[2 * kk + 1][3]));
                    sB[kk] = __builtin_bit_cast(bf16x8, w);
                }
#pragma unroll
                for (int cblk = 0; cblk < 4; ++cblk) {
                    f32x4_t acc = (f32x4_t){0.f, 0.f, 0.f, 0.f};
                    const unsigned char* arow = AT + (16 * cblk + l15) * GLA_PITCH;
                    const unsigned char* qrow = QD + (16 * cblk + l15) * GLA_PITCH;
#pragma unroll
                    for (int kk = 0; kk < 2; ++kk) {
                        if (kk == 0 || cblk >= 2) {
                            const bf16x8 a = *(const bf16x8*)(arow + 64 * kk + 16 * q4);
                            acc = __builtin_amdgcn_mfma_f32_16x16x32_bf16(a, bv[kk], acc, 0, 0, 0);
                        }
                    }
#pragma unroll
                    for (int kk = 0; kk < 2; ++kk) {
                        const uint2 a0 = *(const uint2*)(qrow + 64 * kk + 8 * q4), a1 = *(const uint2*)(qrow + 64 * kk + 32 + 8 * q4);
                        uint4 aw = make_uint4(a0.x, a0.y, a1.x, a1.y);
                        acc = __builtin_amdgcn_mfma_f32_16x16x32_bf16(__builtin_bit_cast(bf16x8, aw), sB[kk], acc, 0, 0, 0);
                    }
#pragma unroll
                    for (int r = 0; r < 4; ++r) Od[(size_t)(rbase + rsgn * (16 * cblk + 4 * q4 + r)) * 512 + h * 128 + v0 + l15] = acc[r];
                }
#pragma unroll
                for (int dblk = 0; dblk < 4; ++dblk) {
#pragma unroll
                    for (int r = 0; r < 4; ++r) S[dblk][r] *= DEC[16 * dblk + 4 * q4 + r];
#pragma unroll
                    for (int kk = 0; kk < 2; ++kk) {
                        const bf16x8 a = *(const bf16x8*)(KET + (16 * dblk + l15) * GLA_PITCH + 64 * kk + 16 * q4);
                        S[dblk] = __builtin_amdgcn_mfma_f32_16x16x32_bf16(a, bv[kk], S[dblk], 0, 0, 0);
                    }
                }
            }
            __syncthreads();
        }
    }
}
__device__ __forceinline__ void ph_even_post(bf16* __restrict__ ATT, const float* __restrict__ lamv, const float* __restrict__ subln, float lam_init,
                             const float* __restrict__ OF, const float* __restrict__ OB, const bf16* __restrict__ P, const float* __restrict__ gain) {
    const int TID = opaque_tid(), BID = opaque_bid();
    int wave = BID * NWV + (TID >> 6), lane = TID & 63;
    int nw = gridDim.x * NWV;
    float p1 = lamv[lane] * lamv[64 + lane], p2 = lamv[128 + lane] * lamv[192 + lane];
    p1 = wave_sum(p1); p2 = wave_sum(p2);
    const float lam = expf(p1) - expf(p2) + lam_init;
    for (int r = wave; r < RT; r += nw) {
        bf16* a = ATT + (size_t)r * DM;
        float d[4][2];
#pragma unroll
        for (int h = 0; h < 4; ++h) {
            float2 o0 = ld2bf(a + (2 * h) * 128 + lane * 2);
            float2 o1 = ld2bf(a + (2 * h + 1) * 128 + lane * 2);
            d[h][0] = o0.x - lam * o1.x; d[h][1] = o0.y - lam * o1.y;
        }
        float2 outd[4];
#pragma unroll
        for (int h = 0; h < 4; ++h) {
            float s = wave_sum(d[h][0] * d[h][0] + d[h][1] * d[h][1]);
            float rstd = rsqrtf(s * (1.f / 128.f) + 1e-6f) * (1.f - lam_init);
            float2 sg = *(const float2*)(subln + lane * 2);
            outd[h] = make_float2(d[h][0] * rstd * sg.x, d[h][1] * rstd * sg.y);
        }
        float2 outg[4];
#pragma unroll
        for (int h = 0; h < 4; ++h) {
            float2 x = *(const float2*)(OF + (size_t)r * 512 + h * 128 + lane * 2);
            float2 c = *(const float2*)(OB + (size_t)r * 512 + h * 128 + lane * 2);
            float o0 = x.x + c.x, o1 = x.y + c.y;
            float s = wave_sum(o0 * o0 + o1 * o1);
            float rstd = rsqrtf(s * (1.f / 128.f) + 1e-6f);
            float2 g = *(const float2*)(gain + lane * 2);
            float2 rr = ld2bf(P + (size_t)r * EVEN_LDP + 2560 + h * 128 + lane * 2);
            outg[h] = make_float2(o0 * rstd * g.x * silu_f(rr.x), o1 * rstd * g.y * silu_f(rr.y));
        }
#pragma unroll
        for (int h = 0; h < 4; ++h) {
            st2bf(a + h * 128 + lane * 2, outd[h]);
            st2bf(a + 512 + h * 128 + lane * 2, outg[h]);
        }
    }
}
#define INS16(tv, ti, v, n) do { \
    _Pragma("unroll") for (int j_ = 15; j_ >= 1; --j_) { bool c1_ = (v) > tv[j_ - 1]; bool c2_ = (v) > tv[j_]; \
        tv[j_] = c1_ ? tv[j_ - 1] : (c2_ ? (v) : tv[j_]); ti[j_] = c1_ ? ti[j_ - 1] : (c2_ ? (n) : ti[j_]); } \
    { bool c_ = (v) > tv[0]; tv[0] = c_ ? (v) : tv[0]; ti[0] = c_ ? (n) : ti[0]; } } while (0)

__device__ __forceinline__ void ph_peer_route(const bf16* __restrict__ Qp, const float* __restrict__ keys_l, int* __restrict__ IDX, float* __restrict__ GATE) {
    const int TID = opaque_tid(), BID = opaque_bid();
    for (int vb = BID; vb < (RT / NT) * 8; vb += gridDim.x) {
        const int h = vb & 7, r = (vb >> 3) * NT + TID;
        float tv[2][16]; int ti[2][16];
#pragma unroll
        for (int half = 0; half < 2; ++half) {
            float q[64];
            const bf16* qp = Qp + (size_t)r * DM + h * 128 + half * 64;
#pragma unroll
            for (int i = 0; i < 16; ++i) { float4 t = ld4bf(qp + 4 * i); q[4 * i] = t.x; q[4 * i + 1] = t.y; q[4 * i + 2] = t.z; q[4 * i + 3] = t.w; }
#pragma unroll
            for (int j = 0; j < 16; ++j) { tv[half][j] = -3.0e38f; ti[half][j] = 0; }
            const float* kb = keys_l + (size_t)(h * 2 + half) * 128 * 64;
            for (int n = 0; n < 128; ++n) {
                float s = 0.f;
#pragma unroll
                for (int d = 0; d < 64; ++d) s += q[d] * kb[n * 64 + d];
                INS16(tv[half], ti[half], s, n);
            }
        }
        float bv[16]; int bi[16];
#pragma unroll
        for (int j = 0; j < 16; ++j) { bv[j] = -3.0e38f; bi[j] = 0; }
#pragma unroll
        for (int a = 0; a < 16; ++a)
#pragma unroll
            for (int b = 0; b < 16; ++b) {
                if ((a + 1) * (b + 1) <= 16) {
                    float s = tv[0][a] + tv[1][b]; int id = ti[0][a] * 128 + ti[1][b];
                    INS16(bv, bi, s, id);
                }
            }
        float mx = bv[0], sum = 0.f, e[16];
#pragma unroll
        for (int j = 0; j < 16; ++j) { e[j] = expf(bv[j] - mx); sum += e[j]; }
        float inv = 1.f / sum;
#pragma unroll
        for (int j = 0; j < 16; ++j) { IDX[(size_t)r * 128 + h * 16 + j] = bi[j]; GATE[(size_t)r * 128 + h * 16 + j] = e[j] * inv; }
    }
}
__device__ __forceinline__ void ph_peer_ffn(const bf16* __restrict__ A2, const int* __restrict__ IDX, const float* __restrict__ GATE,
                            const float* __restrict__ U, const float* __restrict__ V, const float* __restrict__ mods_l, float* __restrict__ X) {
    const int TID = opaque_tid(), BID = opaque_bid();
    int wave = BID * NWV + (TID >> 6), lane = TID & 63;
    int nw = gridDim.x * NWV;
    for (int r = wave; r < RT; r += nw) {
        float4 xa[4], acc[4];
#pragma unroll
        for (int i = 0; i < 4; ++i) { xa[i] = ld4bf(A2 + (size_t)r * DM + 4 * (lane + 64 * i)); acc[i] = make_float4(0.f, 0.f, 0.f, 0.f); }
        for (int e = 0; e < 128; ++e) {
            int id = IDX[(size_t)r * 128 + e]; float g = GATE[(size_t)r * 128 + e];
            const float4* ur = (const float4*)(U + (size_t)id * DM);
            float d = 0.f;
#pragma unroll
            for (int i = 0; i < 4; ++i) { float4 u = ur[lane + 64 * i]; d += u.x * xa[i].x + u.y * xa[i].y + u.z * xa[i].z + u.w * xa[i].w; }
            d = wave_sum(d);
            float w = g * gelu_tanh(d);
            const float4* vr = (const float4*)(V + (size_t)id * DM);
#pragma unroll
            for (int i = 0; i < 4; ++i) { float4 v = vr[lane + 64 * i]; acc[i].x += w * v.x; acc[i].y += w * v.y; acc[i].z += w * v.z; acc[i].w += w * v.w; }
        }
        const float4* g5 = (const float4*)(mods_l + (size_t)row_mod(r) * MODW + 5 * DM);
        float4* xr = (float4*)(X + (size_t)r * DM);
#pragma unroll
        for (int i = 0; i < 4; ++i) { float4 x = xr[lane + 64 * i], gg = g5[lane + 64 * i];
            x.x += gg.x * acc[i].x; x.y += gg.y * acc[i].y; x.z += gg.z * acc[i].z; x.w += gg.w * acc[i].w; xr[lane + 64 * i] = x; }
    }
}
__device__ __forceinline__ void ph_table_prep(const float* __restrict__ U, const float* __restrict__ V, unsigned char* __restrict__ T8, float* __restrict__ RS) {
    const int TID = opaque_tid(), BID = opaque_bid();
    const int wave = BID * NWV + (TID >> 6), lane = TID & 63, nw = gridDim.x * NWV;
    const int NROWS = DEPTH * 16384;
    for (int rr = wave; rr < 2 * NROWS; rr += nw) {
        const float* src = (rr < NROWS ? U : V) + (size_t)(rr < NROWS ? rr : rr - NROWS) * DM + lane * 16;
        float4 v[4]; float am = 0.f;
#pragma unroll
        for (int i = 0; i < 4; ++i) { v[i] = ((const float4*)src)[i]; am = fmaxf(am, fmaxf(fmaxf(fabsf(v[i].x), fabsf(v[i].y)), fmaxf(fabsf(v[i].z), fabsf(v[i].w)))); }
#pragma unroll
        for (int o = 1; o < 64; o <<= 1) am = fmaxf(am, __shfl_xor(am, o));
        am = fmaxf(am, 1e-30f);
        const float sc = exp2f(floorf(log2f(448.f / am)) - 1.f);
        int w[4];
#pragma unroll
        for (int i = 0; i < 4; ++i) { int t = 0; t = __builtin_amdgcn_cvt_pk_fp8_f32(v[i].x * sc, v[i].y * sc, t, false); t = __builtin_amdgcn_cvt_pk_fp8_f32(v[i].z * sc, v[i].w * sc, t, true); w[i] = t; }
        *(uint4*)(T8 + (size_t)rr * DM + lane * 16) = make_uint4((unsigned)w[0], (unsigned)w[1], (unsigned)w[2], (unsigned)w[3]);
        if (lane == 0) RS[rr] = 1.f / sc;
    }
}
#define BR4(j) ((((j) & 1) << 3) | (((j) & 2) << 1) | (((j) & 4) >> 1) | (((j) & 8) >> 3))
__device__ __forceinline__ float dot16_fp8_bf16(uint4 u, const unsigned (&x)[8]) {
    float d = 0.f;
    const unsigned uw[4] = {u.x, u.y, u.z, u.w};
#pragma unroll
    for (int i = 0; i < 4; ++i) {
        bf16x2_t lo = __builtin_amdgcn_cvt_scalef32_pk_bf16_fp8(uw[i], 1.0f, false);
        bf16x2_t hi = __builtin_amdgcn_cvt_scalef32_pk_bf16_fp8(uw[i], 1.0f, true);
        d = __builtin_amdgcn_fdot2_f32_bf16(lo, __builtin_bit_cast(bf16x2_t, x[2 * i]), d, false);
        d = __builtin_amdgcn_fdot2_f32_bf16(hi, __builtin_bit_cast(bf16x2_t, x[2 * i + 1]), d, false);
    }
    return d;
}
__device__ __forceinline__ void ph_peer_ffn8(const bf16* __restrict__ A2, const int* __restrict__ IDX, const float* __restrict__ GATE,
                            const unsigned char* __restrict__ U8, const float* __restrict__ RSU, const unsigned char* __restrict__ V8, const float* __restrict__ RSV,
                            const float* __restrict__ mods_l, float* __restrict__ X, int nrows) {
    const int TID = opaque_tid(), BID = opaque_bid();
    const int wave = BID * NWV + (TID >> 6), lane = TID & 63, nw = gridDim.x * NWV;
    const int jl = BR4(lane & 15);
    for (int r = wave; r < nrows; r += nw) {
        unsigned x[8];
        { const uint4* xp = (const uint4*)(A2 + (size_t)r * DM + lane * 16); uint4 a = xp[0], b = xp[1]; x[0] = a.x; x[1] = a.y; x[2] = a.z; x[3] = a.w; x[4] = b.x; x[5] = b.y; x[6] = b.z; x[7] = b.w; }
        float acc[16];
#pragma unroll
        for (int k = 0; k < 16; ++k) acc[k] = 0.f;
        for (int g = 0; g < 8; ++g) {
            const int myid = IDX[(size_t)r * 128 + g * 16 + jl];
            const float mygate = GATE[(size_t)r * 128 + g * 16 + jl];
            const float rsu = RSU[myid], rsv = RSV[myid];
            uint4 ub[16], vb[16];
#pragma unroll
            for (int j = 0; j < 16; ++j) { const int id = __builtin_amdgcn_readlane(myid, BR4(j)); ub[j] = *(const uint4*)(U8 + (size_t)id * DM + lane * 16); }
#pragma unroll
            for (int j = 0; j < 16; ++j) { const int id = __builtin_amdgcn_readlane(myid, BR4(j)); vb[j] = *(const uint4*)(V8 + (size_t)id * DM + lane * 16); }
            float d[16];
#pragma unroll
            for (int j = 0; j < 16; ++j) d[j] = dot16_fp8_bf16(ub[j], x);
#pragma unroll
            for (int st = 0; st < 4; ++st) {
                const int n = 8 >> st, bit = 1 << st;
                const bool up = (lane & bit) != 0;
#pragma unroll
                for (int i = 0; i < 8; ++i) if (i < n) {
                    const float send = up ? d[i] : d[i + n], keep = up ? d[i + n] : d[i];
                    d[i] = keep + __shfl_xor(send, bit);
                }
            }
            float tot = d[0];
            tot += __shfl_xor(tot, 16); tot += __shfl_xor(tot, 32);
            const float w = mygate * gelu_tanh(tot * rsu) * rsv;
#pragma unroll
            for (int j = 0; j < 16; ++j) {
                const float wj = __int_as_float(__builtin_amdgcn_readlane(__float_as_int(w), BR4(j)));
                const unsigned vw[4] = {vb[j].x, vb[j].y, vb[j].z, vb[j].w};
#pragma unroll
                for (int i = 0; i < 4; ++i) {
                    f32x2_t lo = __builtin_amdgcn_cvt_pk_f32_fp8((int)vw[i], false), hi = __builtin_amdgcn_cvt_pk_f32_fp8((int)vw[i], true);
                    acc[4 * i] += wj * lo.x; acc[4 * i + 1] += wj * lo.y; acc[4 * i + 2] += wj * hi.x; acc[4 * i + 3] += wj * hi.y;
                }
            }
        }
        const float4* g5 = (const float4*)(mods_l + (size_t)row_mod(r) * MODW + 5 * DM + lane * 16);
        float4* xr = (float4*)(X + (size_t)r * DM + lane * 16);
#pragma unroll
        for (int i = 0; i < 4; ++i) { float4 xv = xr[i], gg = g5[i];
            xv.x += gg.x * acc[4 * i]; xv.y += gg.y * acc[4 * i + 1]; xv.z += gg.z * acc[4 * i + 2]; xv.w += gg.w * acc[4 * i + 3]; xr[i] = xv; }
    }
}
template <int N>
__device__ __forceinline__ void ph_gemm_bf16(const bf16* A, const bf16* Bt, bf16* O, unsigned char* lds) {
    pg8::Gemm g{A, Bt, RT, N, DM}; pg8::StaticOrder S; S.init(RT, N, (int)gridDim.x, opaque_bid());
    pg8::EpiBf16<0> E{O, N, nullptr, 0, 0, 1.f};
    pg8::gemm_phase<pg8::EpiBf16<0>, pg8::StaticOrder, true, true>((PG8_LAS unsigned char*)lds, g, S, E);
}
__device__ __forceinline__ void ph_gemm_res(const bf16* A, const bf16* Bt, float* X, const float* gate, unsigned char* lds) {
    pg8::Gemm g{A, Bt, RT, DM, DM}; pg8::StaticOrder S; S.init(RT, DM, (int)gridDim.x, opaque_bid());
    EpiResGate E{X, gate};
    pg8::gemm_phase<EpiResGate, pg8::StaticOrder, true, true>((PG8_LAS unsigned char*)lds, g, S, E);
}

constexpr size_t ALIGN_UP(size_t x) { return (x + 255) & ~(size_t)255; }
constexpr size_t WS_X = 0;
constexpr size_t WS_A = WS_X + (size_t)RT * DM * 4;
constexpr size_t WS_P = WS_A + (size_t)RT * DM * 2;
constexpr size_t WS_ATT = WS_P + (size_t)RT * EVEN_LDP * 2;
constexpr size_t WS_OF = WS_ATT + (size_t)RT * DM * 2;
constexpr size_t WS_MODS = WS_OF + (size_t)RT * 512 * 4 * 2;
constexpr size_t WS_ROPE = WS_MODS + ALIGN_UP((size_t)DEPTH * NMOD * MODW * 4);
constexpr size_t WS_WINE = WS_ROPE + (size_t)SEQ * 32 * 8;
constexpr size_t WS_WOUTE = WS_WINE + (size_t)2 * EVEN_LDP * DM * 2;
constexpr size_t WS_WINO = WS_WOUTE + (size_t)2 * DM * DM * 2;
constexpr size_t WS_WOUTO = WS_WINO + (size_t)2 * ODD_IN * DM * 2;
constexpr size_t WS_WPQ = WS_WOUTO + (size_t)2 * DM * DM * 2;
constexpr size_t WS_T8 = WS_WPQ + (size_t)4 * DM * DM * 2;
constexpr size_t WS_RS = WS_T8 + (size_t)2 * DEPTH * 16384 * DM;
constexpr size_t WS_KC = WS_RS + (size_t)2 * DEPTH * 16384 * 4;
constexpr size_t WS_VT = WS_KC + (size_t)NB * 8 * KVLEN * 64 * 2;
constexpr size_t WS_END = WS_VT + (size_t)NB * 4 * 128 * KVLEN * 2;

__global__ void __launch_bounds__(NT, 2) mega(Params p) {
    extern __shared__ __attribute__((aligned(16))) unsigned char lds[];
    float* smem = (float*)lds;
    cg::grid_group grid = cg::this_grid();
    unsigned char* ws = p.ws;
#define X_ ((float*)(ws + WS_X))
#define A_ ((bf16*)(ws + WS_A))
#define P_ ((bf16*)(ws + WS_P))
#define ATT_ ((bf16*)(ws + WS_ATT))
#define OF_ ((float*)(ws + WS_OF))
#define OB_ (OF_ + (size_t)RT * 512)
#define MODS_ ((float*)(ws + WS_MODS))
#define ROPE_ ((float2*)(ws + WS_ROPE))
#define WINE_ ((bf16*)(ws + WS_WINE))
#define WOUTE_ ((bf16*)(ws + WS_WOUTE))
#define WINO_ ((bf16*)(ws + WS_WINO))
#define WOUTO_ ((bf16*)(ws + WS_WOUTO))
#define WPQ_ ((bf16*)(ws + WS_WPQ))
#define QP_ P_
#define KC_ ((bf16*)(ws + WS_KC))
#define VT_ ((bf16*)(ws + WS_VT))
#define T8_ (ws + WS_T8)
#define RS_ ((float*)(ws + WS_RS))
#define IDX_ ((int*)(ws + WS_P + (size_t)RT * DM * 2))
#define GATE_ ((float*)(ws + WS_P + (size_t)RT * DM * 2 + (size_t)RT * 128 * 4))

    ph_copy_in(p.in[0], p.in[2], X_);
    ph_rope_table(ROPE_);
    ph_weight_prep(p.in, WINE_, WOUTE_, WINO_, WOUTO_, WPQ_, lds);
    ph_table_prep(p.in[25], p.in[26], T8_, RS_);
    __syncthreads();
    ph_mods(p.in[1], p.in[3], p.in[4], p.in[5], MODS_, smem);
    grid.sync();
    for (int hl = 0; hl < 2 * DEPTH; ++hl) {
        const int l = hl >> 1, part = hl & 1, i = l >> 1, odd = l & 1;
        const float* mods_l = MODS_ + (size_t)l * NMOD * MODW;
        ph_norm_mod(X_, (part ? p.in[7] : p.in[6]) + l * DM, mods_l, part ? 3 : 0, A_);
        grid.sync();
        if (part) ph_gemm_bf16<DM>(A_, WPQ_ + (size_t)l * DM * DM, P_, lds);
        else if (odd) ph_gemm_bf16<ODD_IN>(A_, WINO_ + (size_t)i * ODD_IN * DM, P_, lds);
        else ph_gemm_bf16<EVEN_LDP>(A_, WINE_ + (size_t)i * EVEN_LDP * DM, P_, lds);
        grid.sync();
        if (part == 0) {
            const int ldp = odd ? ODD_IN : EVEN_LDP;
            ph_post(P_, ldp, odd ? 16 : 8, odd ? 1024 : 512, odd ? 4 : 8, odd ? 1280 : 1024, odd ? 256 : 512, odd ? 64 : 128,
                    (odd ? p.in[21] : p.in[10]) + i * 64, (odd ? p.in[22] : p.in[11]) + i * 64, ROPE_, KC_, VT_);
            grid.sync();
            if (!odd) ph_gla_chunk(P_, p.in[14] + i * 16 * 256, p.in[15] + i * 256, p.in[16] + i * 16 * 256, p.in[17] + i * 256, OF_, OB_, lds);
            ph_attn_mfma(P_, ldp, KC_, VT_, ATT_, odd, 1, lds);
            grid.sync();
            if (!odd) {
                const float lam_init = 0.8f - 0.6f * expf(-0.3f * (float)l);
                ph_even_post(ATT_, p.in[12] + i * 256, p.in[13] + i * 128, lam_init, OF_, OB_, P_, p.in[18] + i * 128);
                grid.sync();
            }
            ph_gemm_res(ATT_, odd ? WOUTO_ + (size_t)i * DM * DM : WOUTE_ + (size_t)i * DM * DM, X_, mods_l + 2 * DM, lds);
        } else {
            ph_peer_route(QP_, p.in[24] + (size_t)l * 8 * 2 * 128 * 64, IDX_, GATE_);
            grid.sync();
            ph_peer_ffn8(A_, IDX_, GATE_, T8_ + (size_t)l * 16384 * DM, RS_ + l * 16384, T8_ + (size_t)(DEPTH + l) * 16384 * DM, RS_ + (DEPTH + l) * 16384, mods_l, X_, RT);
        }
        grid.sync();
    }
    ph_copy_out(X_, p.out);
}

extern "C" void kernel_launch(void* const* d_in, const int* in_sizes, int n_in, void* d_out, int out_size, void* d_ws, size_t ws_size, hipStream_t stream) {
    static int grid_blocks = 0;
    if (!grid_blocks) {
        int dev = 0, cus = 0, per_cu = 0;
        (void)hipGetDevice(&dev);
        (void)hipDeviceGetAttribute(&cus, hipDeviceAttributeMultiprocessorCount, dev);
        (void)hipFuncSetAttribute((const void*)mega, hipFuncAttributeMaxDynamicSharedMemorySize, LDS_BYTES);
        (void)hipOccupancyMaxActiveBlocksPerMultiprocessor(&per_cu, mega, NT, LDS_BYTES);
        if (per_cu < 1) fprintf(stderr, "occupancy query says %d blocks/CU\n", per_cu);
        grid_blocks = cus;
        if (ws_size < WS_END) fprintf(stderr, "workspace too small: %zu < %zu\n", ws_size, (size_t)WS_END);
    }
    Params p{};
    for (int i = 0; i < 27; ++i) p.in[i] = (const float*)d_in[i];
    p.out = (float*)d_out; p.ws = (unsigned char*)d_ws;
    void* args[] = {&p};
    hipError_t e = hipLaunchCooperativeKernel((void*)mega, dim3(grid_blocks), dim3(NT), args, LDS_BYTES, stream);
    if (e != hipSuccess) fprintf(stderr, "cooperative launch failed: %s (grid %d)\n", hipGetErrorString(e), grid_blocks);
}
```

```cpp
#include <hip/hip_runtime.h>
#include <hip/hip_cooperative_groups.h>
#include <stdint.h>
#include <cstdio>
namespace cg = cooperative_groups;

#define DM 1024
#define NB 16
#define SEQ 2048
#define CTX 256
#define RL (NB * SEQ)
#define RC (NB * CTX)
#define RT (RL + RC)
#define DEPTH 4
#define EVEN_IN 3104
#define EVEN_LDP 3328
#define ODD_IN 1536
#define NMOD 17
#define MODW 6144
#define NT 512
#define NWV 8
#define LDS_BYTES 147456
#ifndef DUP_FFN
#define DUP_FFN 0
#endif
#ifndef DUP_ROUTE
#define DUP_ROUTE 0
#endif
#ifndef DUP_ATTN
#define DUP_ATTN 0
#endif
#ifndef DUP_GEMM
#define DUP_GEMM 0
#endif

typedef unsigned short bf16;
typedef float f32x2_t __attribute__((ext_vector_type(2)));
typedef __bf16 bf16x2_t __attribute__((ext_vector_type(2)));
struct Params {
    const float* in[27];
    float* out;
    unsigned char* ws;
};

__device__ __forceinline__ int row_mod(int r) { return r < RL ? (r >> 11) : 16; }
__device__ __forceinline__ float silu_f(float x) { return x / (1.f + expf(-x)); }
__device__ __forceinline__ float wave_sum(float v) {
#pragma unroll
    for (int o = 1; o < 64; o <<= 1) v += __shfl_xor(v, o);
    return v;
}
__device__ __forceinline__ float log_sigmoid_f(float z) { return fminf(z, 0.f) - log1pf(expf(-fabsf(z))); }
__device__ __forceinline__ float gelu_tanh(float x) { float u = 0.7978845608028654f * (x + 0.044715f * x * x * x); return 0.5f * x * (1.f + tanhf(u)); }
__device__ __forceinline__ float bf2f(bf16 v) { return __uint_as_float((unsigned)v << 16); }
__device__ __forceinline__ unsigned f2bf(float f) { unsigned u = __float_as_uint(f); return (u + 0x7fffu + ((u >> 16) & 1u)) >> 16; }
__device__ __forceinline__ unsigned pk2(float lo, float hi) { return f2bf(lo) | (f2bf(hi) << 16); }
__device__ __forceinline__ float4 ld4bf(const bf16* p) { uint2 u = *(const uint2*)p; return make_float4(__uint_as_float(u.x << 16), __uint_as_float(u.x & 0xffff0000u), __uint_as_float(u.y << 16), __uint_as_float(u.y & 0xffff0000u)); }
__device__ __forceinline__ void st4bf(bf16* p, float4 v) { *(uint2*)p = make_uint2(pk2(v.x, v.y), pk2(v.z, v.w)); }
__device__ __forceinline__ float2 ld2bf(const bf16* p) { unsigned u = *(const unsigned*)p; return make_float2(__uint_as_float(u << 16), __uint_as_float(u & 0xffff0000u)); }
__device__ __forceinline__ void st2bf(bf16* p, float2 v) { *(unsigned*)p = pk2(v.x, v.y); }

__device__ __forceinline__ int opaque_tid() { int t = threadIdx.x; asm volatile("" : "+v"(t)); return t; }
__device__ __forceinline__ int opaque_bid() { int b = blockIdx.x; asm volatile("" : "+s"(b)); return b; }

namespace pg8 {
#define PG8_LAS __attribute__((address_space(3)))
typedef unsigned short bf16_t;
typedef short bf16x8 __attribute__((ext_vector_type(8)));
typedef float f32x4 __attribute__((ext_vector_type(4)));
typedef unsigned u32x4 __attribute__((ext_vector_type(4)));
constexpr int BM = 256, BK = 64, HALF = 128, HTB = HALF * BK * 2  , STAGE_BYTES = 8 * HTB, NXCD = 8, WGM = 8;

__host__ __device__ __forceinline__ int lds_byte(int r, int c) { const int st = (r >> 4) * 2 + (c >> 5), rr = r & 15, cc = c & 31, ob = rr * 64 + cc * 2; return st * 1024 + (ob ^ (((ob >> 9) & 1) << 5)); }
__host__ __device__ __forceinline__ void stage_rc(int b, int& R, int& C) { const int st = b / 1024, sb = b % 1024, swz = sb ^ (((sb >> 9) & 1) << 5); R = (st >> 1) * 16 + swz / 64; C = (st & 1) * 32 + (swz % 64) / 2; }
__host__ __device__ __forceinline__ int perm32(int rho) { const int n = rho >> 4, i = rho & 15; return 8 * (i >> 2) + 4 * n + (i & 3); }

struct Unit { int pm, pn; };
struct Gemm { const bf16_t* A; const bf16_t* Bt; int M, N, K; };

struct StaticOrder {
    int nM, nN, nwg, G, c;
    __host__ __device__ void init(int M, int N, int G_, int c_) { nM = M / BM; nN = N / BM; nwg = nM * nN; G = G_; c = c_; }
    __host__ __device__ bool next(int i, Unit& u) const {
        const long L = (long)i * G + c; if (L >= nwg) return false;
        int wgid = (int)L; { const int q = nwg / NXCD, r = nwg % NXCD, xcd = wgid % NXCD, off = wgid / NXCD; wgid = (xcd < r ? xcd * (q + 1) : r * (q + 1) + (xcd - r) * q) + off; }
        const int nig = WGM * nN, gid = wgid / nig, fm = gid * WGM, gsz = (nM - fm) < WGM ? (nM - fm) : WGM;
        u.pm = fm + ((wgid % nig) % gsz); u.pn = (wgid % nig) / gsz; return true;
    }
    __device__ __forceinline__ void a_ready(const Unit&) const {}
    __device__ __forceinline__ void done(const Unit&) const {}
};

__device__ __forceinline__ unsigned cvt_pk_bf16(float lo, float hi) { unsigned r; asm volatile("v_cvt_pk_bf16_f32 %0, %1, %2" : "=v"(r) : "v"(lo), "v"(hi)); return r; }
typedef float f32x2 __attribute__((ext_vector_type(2)));
__device__ __forceinline__ f32x2 gelu_pk(f32x2 v) {
    const f32x2 av = __builtin_elementwise_abs(v), d = av * 0.2316418882f + 1.0f;
    f32x2 t; t.x = __builtin_amdgcn_rcpf(d.x); t.y = __builtin_amdgcn_rcpf(d.y);
    f32x2 q = t * 0.5307027145f + (-0.7265760135f); q = q * t + 0.7107068705f; q = q * t + (-0.142248368f); q = q * t + 0.127414796f; q = q * t;
    const f32x2 s = (v * v) * (-0.72134752044f);
    f32x2 e; e.x = __builtin_amdgcn_exp2f(s.x); e.y = __builtin_amdgcn_exp2f(s.y);
    const f32x2 m = v * (q * e), r = v - m;
    f32x2 o; o.x = v.x < 0.f ? m.x : r.x; o.y = v.y < 0.f ? m.y : r.y; return o;
}

template <int ACT  > struct EpiBf16 {
    static constexpr bool PERM = true, AFTER_DRAIN = false; static_assert(ACT == 0 || ACT == 1, "EpiBf16: ACT is 0 (none) or 1 (gelu_pk)");
    bf16_t* O; int ldc; const float* bias; int split_cols; size_t split_stride; float scale0;
    __device__ __forceinline__ void operator()(const f32x4 (&acc)[2][2][4][2], const Unit& u, int wr, int wc, int fr, int fq) const {
        const int row0 = u.pm * BM + wr * 64 + fr; int colt = u.pn * BM; bf16_t* base = O;
        float sc = 1.f; if (split_cols) { const int t = colt / split_cols; base += (size_t)t * split_stride; colt -= t * split_cols; if (t == 0) sc = scale0; }
        const int col0 = colt + wc * 32 + 8 * fq, bcol0 = u.pn * BM + wc * 32 + 8 * fq;
        f32x4 bv[2][2];
#pragma unroll
        for (int bj = 0; bj < 2; ++bj)
#pragma unroll
            for (int n = 0; n < 2; ++n) bv[bj][n] = bias ? *(const f32x4*)(bias + bcol0 + bj * HALF + 4 * n) : (f32x4){0.f, 0.f, 0.f, 0.f};
#pragma unroll
        for (int ai = 0; ai < 2; ++ai)
#pragma unroll
            for (int m = 0; m < 4; ++m) { bf16_t* rowp = base + (size_t)(row0 + ai * HALF + m * 16) * ldc + col0;
#pragma unroll
                for (int bj = 0; bj < 2; ++bj) { f32x4 v0 = acc[ai][bj][m][0] + bv[bj][0], v1 = acc[ai][bj][m][1] + bv[bj][1];
                    if (ACT == 1) { f32x2 a = gelu_pk((f32x2){v0[0], v0[1]}), b = gelu_pk((f32x2){v0[2], v0[3]}), c = gelu_pk((f32x2){v1[0], v1[1]}), d = gelu_pk((f32x2){v1[2], v1[3]});
                        v0 = (f32x4){a.x, a.y, b.x, b.y}; v1 = (f32x4){c.x, c.y, d.x, d.y}; }
                    v0 = v0 * sc; v1 = v1 * sc; u32x4 w; w.x = cvt_pk_bf16(v0[0], v0[1]); w.y = cvt_pk_bf16(v0[2], v0[3]); w.z = cvt_pk_bf16(v1[0], v1[1]); w.w = cvt_pk_bf16(v1[2], v1[3]);
                    *(u32x4*)(rowp + bj * HALF) = w; } }
    }
};
template <class Epi, class Sched, bool ALIGN_EPI = false, bool SP2 = false>
__device__ __forceinline__ void gemm_phase(PG8_LAS unsigned char* lds, const Gemm g, const Sched& S, const Epi& E) {
    const int tid = opaque_tid(), wid = __builtin_amdgcn_readfirstlane(tid >> 6), lane = tid & 63, wr = wid >> 2, wc = wid & 3, fr = lane & 15, fq = lane >> 4;
    const int K = g.K, nt = K / BK;
    unsigned voffA[2], voffB[2];
#pragma unroll
    for (int i = 0; i < 2; ++i) { int R, C; stage_rc(tid * 16 + i * 8192, R, C); const int Rb = Epi::PERM ? ((R & ~31) + perm32(R & 31)) : R;
        voffA[i] = (unsigned)(R * K + C) * 2u; voffB[i] = (unsigned)(Rb * K + C) * 2u; }
    const size_t kstep = (size_t)(BK * 2);
    const size_t hstep = (size_t)HALF * K * 2;
    const size_t tstep = 2 * hstep;
    const unsigned ldsw = (unsigned)wid * 1024u;
    const int aoff = lds_byte(wr * 64 + fr, fq * 8), boff = lds_byte(wc * 32 + fr, fq * 8);
#define PG8_SA(b, h) (((b) * 2 + (h)) * HTB)
#define PG8_SB(b, h) ((4 + (b) * 2 + (h)) * HTB)
#define PG8_STAGE(bufoff, gbase, voff) do { _Pragma("unroll") for (int _i = 0; _i < 2; ++_i) \
        __builtin_amdgcn_global_load_lds((const unsigned*)((const char*)(gbase) + (voff)[_i]), (PG8_LAS unsigned*)(lds + (bufoff) + ldsw + _i * 8192), 16, 0, 0); } while (0)
#define PG8_LDA(dst, b, h) do { _Pragma("unroll") for (int m = 0; m < 4; ++m) _Pragma("unroll") for (int k = 0; k < 2; ++k) dst[m][k] = *(const PG8_LAS bf16x8*)(lds + PG8_SA(b, h) + aoff + m * 2048 + k * 1024); } while (0)
#define PG8_LDB(dst, b, h) do { _Pragma("unroll") for (int n = 0; n < 2; ++n) _Pragma("unroll") for (int k = 0; k < 2; ++k) dst[n][k] = *(const PG8_LAS bf16x8*)(lds + PG8_SB(b, h) + boff + n * 2048 + k * 1024); } while (0)
#define PG8_MMA(ai, bj, At, Bt) do { __builtin_amdgcn_s_setprio(1); _Pragma("unroll") for (int m = 0; m < 4; ++m) _Pragma("unroll") for (int n = 0; n < 2; ++n) _Pragma("unroll") for (int k = 0; k < 2; ++k) \
        acc[ai][bj][m][n] = __builtin_amdgcn_mfma_f32_16x16x32_bf16(Bt[n][k], At[m][k], acc[ai][bj][m][n], 0, 0, 0); __builtin_amdgcn_s_setprio(0); } while (0)
#define PG8_WAIT_V(n) asm volatile("s_waitcnt vmcnt(" #n ")" ::: "memory")
#define PG8_WAIT_L(n) asm volatile("s_waitcnt lgkmcnt(" #n ")" ::: "memory")
#define PG8_BAR __builtin_amdgcn_s_barrier()
#define PG8_SCHED __builtin_amdgcn_sched_barrier(0)
    Unit cur, nxt; int ui = 0;
    if (!S.next(0, cur)) return;
    f32x4 acc[2][2][4][2];
#pragma unroll
    for (int a = 0; a < 2; ++a)
#pragma unroll
        for (int b = 0; b < 2; ++b)
#pragma unroll
            for (int m = 0; m < 4; ++m)
#pragma unroll
                for (int n = 0; n < 2; ++n) acc[a][b][m][n] = (f32x4){0.f, 0.f, 0.f, 0.f};
    bf16x8 At[4][2], B0[2][2], B1[2][2];
    const char* cA = (const char*)g.A + (size_t)cur.pm * tstep; const char* cB = (const char*)g.Bt + (size_t)cur.pn * tstep;
    S.a_ready(cur);
    if constexpr (SP2) {
        PG8_STAGE(PG8_SB(0, 0), cB, voffB); PG8_STAGE(PG8_SB(0, 1), cB + hstep, voffB); PG8_STAGE(PG8_SA(0, 0), cA, voffA); PG8_STAGE(PG8_SA(0, 1), cA + hstep, voffA);
        if (wr == 1) PG8_BAR;
        PG8_WAIT_V(2); PG8_BAR;
        PG8_STAGE(PG8_SB(1, 0), cB + kstep, voffB); PG8_STAGE(PG8_SA(1, 0), cA + kstep, voffA); PG8_STAGE(PG8_SB(1, 1), cB + hstep + kstep, voffB);
        PG8_WAIT_V(6); PG8_BAR;
    } else {
        PG8_STAGE(PG8_SB(0, 0), cB, voffB); PG8_STAGE(PG8_SA(0, 0), cA, voffA); PG8_STAGE(PG8_SB(0, 1), cB + hstep, voffB); PG8_STAGE(PG8_SA(0, 1), cA + hstep, voffA);
        if (wr == 1) PG8_BAR;
        PG8_WAIT_V(4); PG8_BAR;
        PG8_STAGE(PG8_SB(1, 0), cB + kstep, voffB); PG8_STAGE(PG8_SA(1, 0), cA + kstep, voffA); PG8_STAGE(PG8_SB(1, 1), cB + hstep + kstep, voffB);
        PG8_WAIT_V(6); PG8_BAR;
    }
    for (;;) {
        const bool has_next = S.next(ui + 1, nxt);
        const char* nA = has_next ? (const char*)g.A + (size_t)nxt.pm * tstep : cA; const char* nB = has_next ? (const char*)g.Bt + (size_t)nxt.pn * tstep : cB;
        for (int t = 0; t < nt; t += 2) {
            const bool last = (t == nt - 2);
            const char* a1 = cA + (size_t)(t + 1) * kstep;
            const char* a2 = last ? nA : cA + (size_t)(t + 2) * kstep; const char* b2 = last ? nB : cB + (size_t)(t + 2) * kstep;
            const char* a3 = a2 + kstep; const char* b3 = b2 + kstep;
            if (last && has_next) S.a_ready(nxt);
            if constexpr (SP2) {
            PG8_LDB(B0, 0, 0); PG8_LDB(B1, 0, 1); PG8_SCHED; PG8_LDA(At, 0, 0); PG8_STAGE(PG8_SA(1, 1), a1 + hstep, voffA);
            PG8_WAIT_V(8); PG8_WAIT_L(0); PG8_BAR; PG8_MMA(0, 0, At, B0); PG8_MMA(0, 1, At, B1); PG8_BAR; PG8_SCHED;
            PG8_LDA(At, 0, 1); PG8_STAGE(PG8_SB(0, 0), b2, voffB); PG8_STAGE(PG8_SB(0, 1), b2 + hstep, voffB); PG8_STAGE(PG8_SA(0, 0), a2, voffA);
            PG8_WAIT_V(8); PG8_WAIT_L(0); PG8_BAR; PG8_MMA(1, 0, At, B0); PG8_MMA(1, 1, At, B1); PG8_BAR; PG8_SCHED;
            PG8_LDB(B0, 1, 0); PG8_LDB(B1, 1, 1); PG8_SCHED; PG8_LDA(At, 1, 0); PG8_STAGE(PG8_SA(0, 1), a2 + hstep, voffA);
            PG8_WAIT_V(8); PG8_WAIT_L(0); PG8_BAR; PG8_MMA(0, 0, At, B0); PG8_MMA(0, 1, At, B1); PG8_BAR; PG8_SCHED;
            PG8_LDA(At, 1, 1); PG8_STAGE(PG8_SB(1, 0), b3, voffB); PG8_STAGE(PG8_SB(1, 1), b3 + hstep, voffB); PG8_STAGE(PG8_SA(1, 0), a3, voffA);
            PG8_WAIT_V(8); PG8_WAIT_L(0); PG8_BAR; PG8_MMA(1, 0, At, B0); PG8_MMA(1, 1, At, B1); PG8_BAR; PG8_SCHED;
            } else {
            PG8_LDB(B0, 0, 0); PG8_SCHED; PG8_LDA(At, 0, 0); PG8_STAGE(PG8_SA(1, 1), a1 + hstep, voffA);
            PG8_WAIT_L(8); PG8_BAR; PG8_WAIT_L(0); PG8_MMA(0, 0, At, B0); PG8_BAR; PG8_SCHED;
            PG8_LDB(B1, 0, 1); PG8_STAGE(PG8_SB(0, 0), b2, voffB);
            PG8_BAR; PG8_WAIT_L(0); PG8_MMA(0, 1, At, B1); PG8_BAR;
            PG8_LDA(At, 0, 1); PG8_STAGE(PG8_SA(0, 0), a2, voffA);
            PG8_BAR; PG8_WAIT_L(0); PG8_MMA(1, 0, At, B0); PG8_BAR; PG8_SCHED;
            PG8_STAGE(PG8_SB(0, 1), b2 + hstep, voffB);
            PG8_WAIT_V(6); PG8_BAR; PG8_MMA(1, 1, At, B1); PG8_BAR;
            PG8_LDB(B0, 1, 0); PG8_SCHED; PG8_LDA(At, 1, 0); PG8_STAGE(PG8_SA(0, 1), a2 + hstep, voffA);
            PG8_WAIT_L(8); PG8_BAR; PG8_WAIT_L(0); PG8_MMA(0, 0, At, B0); PG8_BAR; PG8_SCHED;
            PG8_LDB(B1, 1, 1); PG8_STAGE(PG8_SB(1, 0), b3, voffB);
            PG8_BAR; PG8_WAIT_L(0); PG8_MMA(0, 1, At, B1); PG8_BAR;
            PG8_LDA(At, 1, 1); PG8_STAGE(PG8_SA(1, 0), a3, voffA);
            PG8_BAR; PG8_WAIT_L(0); PG8_MMA(1, 0, At, B0); PG8_BAR; PG8_SCHED;
            PG8_STAGE(PG8_SB(1, 1), b3 + hstep, voffB);
            PG8_WAIT_V(6); PG8_BAR; PG8_MMA(1, 1, At, B1); PG8_BAR;
            }
        }
        if constexpr (ALIGN_EPI) { if (wr == 0) PG8_BAR; }
        if constexpr (!Epi::AFTER_DRAIN) { E(acc, cur, wr, wc, fr, fq); S.done(cur); }
        if (!has_next) break;
#pragma unroll
        for (int a = 0; a < 2; ++a)
#pragma unroll
            for (int b = 0; b < 2; ++b)
#pragma unroll
                for (int m = 0; m < 4; ++m)
#pragma unroll
                    for (int n = 0; n < 2; ++n) acc[a][b][m][n] = (f32x4){0.f, 0.f, 0.f, 0.f};
        cur = nxt; cA = nA; cB = nB; ++ui;
        if constexpr (ALIGN_EPI) { if (wr == 1) PG8_BAR; }
    }
    PG8_WAIT_V(0);
    if constexpr (!ALIGN_EPI) { if (wr == 0) PG8_BAR; }
    PG8_BAR;
    if constexpr (Epi::AFTER_DRAIN) { E.fused(acc, cur, wr, wc, fr, fq, lds, wid, lane); S.done(cur); }
#undef PG8_SA
#undef PG8_SB
#undef PG8_STAGE
#undef PG8_LDA
#undef PG8_LDB
#undef PG8_MMA
#undef PG8_WAIT_V
#undef PG8_WAIT_L
#undef PG8_BAR
#undef PG8_SCHED
}
}

struct EpiResGate {
    static constexpr bool PERM = false, AFTER_DRAIN = false;
    float* X; const float* gate;
    __device__ __forceinline__ void operator()(const pg8::f32x4 (&acc)[2][2][4][2], const pg8::Unit& u, int wr, int wc, int fr, int fq) const {
#pragma unroll
        for (int ai = 0; ai < 2; ++ai)
#pragma unroll
            for (int m = 0; m < 4; ++m) {
                const int r = u.pm * 256 + ai * 128 + wr * 64 + m * 16 + fr;
                const float* g = gate + (size_t)row_mod(r) * MODW; float* xr = X + (size_t)r * DM;
#pragma unroll
                for (int bj = 0; bj < 2; ++bj)
#pragma unroll
                    for (int n = 0; n < 2; ++n) {
                        const int c = u.pn * 256 + bj * 128 + wc * 32 + n * 16 + 4 * fq;
                        pg8::f32x4 xv = *(const pg8::f32x4*)(xr + c); const pg8::f32x4 gv = *(const pg8::f32x4*)(g + c);
                        xv = xv + gv * acc[ai][bj][m][n];
                        *(pg8::f32x4*)(xr + c) = xv;
                    }
            }
    }
};
#define LAS __attribute__((address_space(3)))
#define GAS __attribute__((address_space(1)))

__device__ __forceinline__ void ph_copy_in(const float* __restrict__ x, const float* __restrict__ ctx, float* __restrict__ X) {
    const int TID = opaque_tid(), BID = opaque_bid();
    size_t i = (size_t)BID * NT + TID;
    const size_t n4 = (size_t)RT * DM / 4, nl4 = (size_t)RL * DM / 4;
    for (; i < n4; i += (size_t)gridDim.x * NT) ((float4*)X)[i] = i < nl4 ? ((const float4*)x)[i] : ((const float4*)ctx)[i - nl4];
}
__device__ __forceinline__ void ph_copy_out(const float* __restrict__ X, float* __restrict__ out) {
    const int TID = opaque_tid(), BID = opaque_bid();
    size_t i = (size_t)BID * NT + TID;
    const size_t n4 = (size_t)RL * DM / 4;
    for (; i < n4; i += (size_t)gridDim.x * NT) ((float4*)out)[i] = ((const float4*)X)[i];
}
__device__ __forceinline__ void ph_rope_table(float2* __restrict__ rope) {
    const int TID = opaque_tid(), BID = opaque_bid();
    for (int i = BID * NT + TID; i < SEQ * 32; i += gridDim.x * NT) {
        int t = i >> 5, a = (i >> 4) & 1, f = i & 15;
        float pos = a == 0 ? (float)(t >> 6) : (float)(t & 63);
        float inv = powf(10000.f, -(float)f / 16.f);
        float ang = pos * inv;
        rope[i] = make_float2(cosf(ang), sinf(ang));
    }
}
__device__ __forceinline__ void transpose_item(const float* __restrict__ W, int N, bf16* __restrict__ WT, LAS float* scr, int item, int lane) {
    const int K = DM;
    const int nblk = N / 32, kb = item / nblk, nb = item % nblk, k0 = 64 * kb, n0 = 32 * nb;
#pragma unroll 8
    for (int i = 0; i < 32; ++i) { const int kk = 2 * i + (lane >> 5); scr[kk * 33 + (lane & 31)] = W[(size_t)(k0 + kk) * N + n0 + (lane & 31)]; }
    asm volatile("s_waitcnt lgkmcnt(0)" ::: "memory");
    const int c = lane & 7;
#pragma unroll
    for (int j = 0; j < 4; ++j) { const int n = (lane >> 3) + 8 * j; const LAS float* s = scr + (8 * c) * 33 + n;
        uint4 o; o.x = pk2(s[0 * 33], s[1 * 33]); o.y = pk2(s[2 * 33], s[3 * 33]); o.z = pk2(s[4 * 33], s[5 * 33]); o.w = pk2(s[6 * 33], s[7 * 33]);
        *(uint4*)(WT + (size_t)(n0 + n) * K + k0 + 8 * c) = o; }
    asm volatile("s_waitcnt lgkmcnt(0)" ::: "memory");
}
struct WPrep { const float* src[12]; bf16* dst[12]; };
__device__ __forceinline__ void ph_weight_prep(const float* const* in, bf16* WinE, bf16* WoutE, bf16* WinO, bf16* WoutO, bf16* Wpq, bf16* Kb, unsigned char* lds) {
    const int TID = opaque_tid(), BID = opaque_bid();
    const int lane = TID & 63, wv = TID >> 6;
    LAS float* scr = (LAS float*)((LAS unsigned char*)lds + wv * 16384);
    const int gw = BID * NWV + wv, NGW = gridDim.x * NWV;
    const int NITEMS = 2 * 1552 + 2 * 512 + 2 * 768 + 2 * 512 + 4 * 512;
    for (int it = gw; it < NITEMS; it += NGW) {
        int r = it;
        if (r < 3104) { int i = r / 1552; transpose_item(in[8] + (size_t)i * DM * EVEN_IN, EVEN_IN, WinE + (size_t)i * EVEN_LDP * DM, scr, r % 1552, lane); continue; } r -= 3104;
        if (r < 1024) { int i = r / 512; transpose_item(in[9] + (size_t)i * DM * DM, DM, WoutE + (size_t)i * DM * DM, scr, r % 512, lane); continue; } r -= 1024;
        if (r < 1536) { int i = r / 768; transpose_item(in[19] + (size_t)i * DM * ODD_IN, ODD_IN, WinO + (size_t)i * ODD_IN * DM, scr, r % 768, lane); continue; } r -= 1536;
        if (r < 1024) { int i = r / 512; transpose_item(in[20] + (size_t)i * DM * DM, DM, WoutO + (size_t)i * DM * DM, scr, r % 512, lane); continue; } r -= 1024;
        { int i = r / 512; transpose_item(in[23] + (size_t)i * DM * DM, DM, Wpq + (size_t)i * DM * DM, scr, r % 512, lane); }
    }
    for (int i4 = BID * NT + TID; i4 < DEPTH * 8 * 2 * 128 * 64 / 4; i4 += gridDim.x * NT) st4bf(Kb + 4 * (size_t)i4, ((const float4*)in[24])[i4]);
    for (int i = BID * NT + TID; i < 2 * 28672; i += gridDim.x * NT) {
        int w = i / 28672, o = i % 28672;
        ((uint4*)(WinE + (size_t)w * EVEN_LDP * DM + (size_t)EVEN_IN * DM))[o] = make_uint4(0u, 0u, 0u, 0u);
    }
}
__device__ __forceinline__ void ph_mods(const float* __restrict__ c, const float* __restrict__ cctx, const float* __restrict__ w_mod,
                        const float* __restrict__ b_mod, float* __restrict__ mods, float* smem) {
    const int TID = opaque_tid(), BID = opaque_bid();
    const int nvb = DEPTH * MODW / NT;
    if (BID >= nvb) return;
    float (*S)[DM] = (float (*)[DM])smem;
    for (int i = TID; i < NMOD * DM; i += NT) {
        int j = i / DM, k = i % DM;
        float v = j < 16 ? c[j * DM + k] : cctx[k];
        S[j][k] = silu_f(v);
    }
    __syncthreads();
    for (int vb = BID; vb < nvb; vb += gridDim.x) {
        int idx = vb * NT + TID, l = idx / MODW, n = idx % MODW;
        const float* W = w_mod + (size_t)l * DM * MODW;
        float acc[NMOD];
#pragma unroll
        for (int j = 0; j < NMOD; ++j) acc[j] = 0.f;
        for (int k = 0; k < DM; ++k) {
            float w = W[(size_t)k * MODW + n];
#pragma unroll
            for (int j = 0; j < NMOD; ++j) acc[j] += S[j][k] * w;
        }
        float b = b_mod[l * MODW + n];
#pragma unroll
        for (int j = 0; j < NMOD; ++j) mods[((size_t)l * NMOD + j) * MODW + n] = acc[j] + b;
    }
    __syncthreads();
}
__device__ __forceinline__ void ph_norm_mod(const float* __restrict__ X, const float* __restrict__ g, const float* __restrict__ mods_l, int shift_chunk, bf16* __restrict__ A) {
    const int TID = opaque_tid(), BID = opaque_bid();
    int wave = BID * NWV + (TID >> 6), lane = TID & 63;
    int nw = gridDim.x * NWV;
    for (int r = wave; r < RT; r += nw) {
        const float4* xr = (const float4*)(X + (size_t)r * DM);
        float4 v[4]; float s = 0.f;
#pragma unroll
        for (int i = 0; i < 4; ++i) { v[i] = xr[lane + 64 * i]; s += v[i].x * v[i].x + v[i].y * v[i].y + v[i].z * v[i].z + v[i].w * v[i].w; }
        s = wave_sum(s);
        float rstd = rsqrtf(s * (1.f / DM) + 1e-6f);
        const float* m = mods_l + (size_t)row_mod(r) * MODW;
        const float4* sh = (const float4*)(m + shift_chunk * DM);
        const float4* sc = (const float4*)(m + (shift_chunk + 1) * DM);
        const float4* g4 = (const float4*)g;
        bf16* ar = A + (size_t)r * DM;
#pragma unroll
        for (int i = 0; i < 4; ++i) {
            int c = lane + 64 * i;
            float4 gg = g4[c], a = sh[c], b = sc[c], o;
            o.x = v[i].x * rstd * gg.x * (1.f + b.x) + a.x;
            o.y = v[i].y * rstd * gg.y * (1.f + b.y) + a.y;
            o.z = v[i].z * rstd * gg.z * (1.f + b.z) + a.z;
            o.w = v[i].w * rstd * gg.w * (1.f + b.w) + a.w;
            st4bf(ar + 4 * c, o);
        }
    }
}
#define KVLEN (CTX + SEQ)
__device__ __forceinline__ void ph_post(bf16* __restrict__ P, int ldp, int nq, int kcol0, int nk, int vcol0, int VC, int DV,
                                        const float* __restrict__ qgain, const float* __restrict__ kgain, const float2* __restrict__ rope,
                                        bf16* __restrict__ Kc, bf16* __restrict__ Vt) {
    const int TID = opaque_tid(), BID = opaque_bid();
    const float C2 = 0.125f * 1.4426950408889634f;
    for (int tile = BID; tile < RT / 64; tile += gridDim.x) {
        const int r0 = tile * 64;
        int b, j0;
        if (r0 < RL) { b = r0 >> 11; j0 = CTX + (r0 & (SEQ - 1)); } else { b = (r0 - RL) >> 8; j0 = (r0 - RL) & (CTX - 1); }
        const int nh = nq + nk;
        for (int it = TID; it < 64 * nh; it += NT) {
            const int row = it / nh, hh = it % nh, r = r0 + row;
            const bool isk = hh >= nq; const int h = isk ? hh - nq : hh;
            bf16* src = P + (size_t)r * ldp + (isk ? kcol0 : 0) + h * 64;
            const float* gain = isk ? kgain : qgain;
            float v[64]; float s = 0.f;
#pragma unroll
            for (int i = 0; i < 16; ++i) { float4 t = ld4bf(src + 4 * i); v[4 * i] = t.x; v[4 * i + 1] = t.y; v[4 * i + 2] = t.z; v[4 * i + 3] = t.w; }
#pragma unroll
            for (int i = 0; i < 64; ++i) s += v[i] * v[i];
            const float rstd = rsqrtf(s * (1.f / 64.f) + 1e-6f) * (isk ? 1.f : C2);
#pragma unroll
            for (int i = 0; i < 64; ++i) v[i] = v[i] * rstd * gain[i];
            if (r < RL) {
                const float2* tab = rope + (size_t)(r & (SEQ - 1)) * 32;
#pragma unroll
                for (int a = 0; a < 2; ++a)
#pragma unroll
                    for (int f = 0; f < 16; ++f) {
                        float2 cs = tab[a * 16 + f];
                        float x1 = v[a * 32 + f], x2 = v[a * 32 + 16 + f];
                        v[a * 32 + f] = x1 * cs.x - x2 * cs.y;
                        v[a * 32 + 16 + f] = x2 * cs.x + x1 * cs.y;
                    }
            }
            bf16* dst = isk ? Kc + ((size_t)(b * nk + h) * KVLEN + j0 + row) * 64 : src;
#pragma unroll
            for (int i = 0; i < 16; ++i) st4bf(dst + 4 * i, make_float4(v[4 * i], v[4 * i + 1], v[4 * i + 2], v[4 * i + 3]));
        }
        if (TID < VC) {
            const int c8 = TID >> 3, rg = TID & 7;
            unsigned in[8][4];
#pragma unroll
            for (int rr = 0; rr < 8; ++rr) { uint4 t = *(const uint4*)(P + (size_t)(r0 + rg * 8 + rr) * ldp + vcol0 + c8 * 8); in[rr][0] = t.x; in[rr][1] = t.y; in[rr][2] = t.z; in[rr][3] = t.w; }
#pragma unroll
            for (int c = 0; c < 8; ++c) {
                unsigned o[4];
#pragma unroll
                for (int q = 0; q < 4; ++q)
                    o[q] = (c & 1) ? __builtin_amdgcn_perm(in[2 * q + 1][c >> 1], in[2 * q][c >> 1], 0x07060302u) : __builtin_amdgcn_perm(in[2 * q + 1][c >> 1], in[2 * q][c >> 1], 0x05040100u);
                const int col = c8 * 8 + c, vh = col / DV, d = col % DV;
                *(uint4*)(Vt + ((size_t)(b * 4 + vh) * DV + d) * KVLEN + j0 + rg * 8) = make_uint4(o[0], o[1], o[2], o[3]);
            }
        }
    }
}
typedef short bf16x8 __attribute__((ext_vector_type(8)));
typedef float f32x16 __attribute__((ext_vector_type(16)));
__device__ __forceinline__ int crow(int r, int hi) { return (r & 3) + 8 * (r >> 2) + 4 * hi; }
__device__ __forceinline__ unsigned cvt_pk_bf16_f32(float lo, float hi) { f32x2_t v = {lo, hi}; bf16x2_t b = __builtin_convertvector(v, bf16x2_t); return __builtin_bit_cast(unsigned, b); }
#define ATT_KPITCH 144
#define ATT_VPITCH 136
template <int DV>
__device__ __forceinline__ void attn_unit(const bf16* __restrict__ Qbase, int ldq, const bf16* __restrict__ Kc, const bf16* __restrict__ Vt, int ntiles,
                                          bf16* __restrict__ Obase, int ldo, unsigned char* lds, int tid) {
    constexpr int NDB = DV / 32, NVL = DV / 64, KBYTES = 64 * ATT_KPITCH, BUFSZ = KBYTES + DV * ATT_VPITCH;
    constexpr float THR = 8.f;
    const int lane = tid & 63, wid = tid >> 6, r32 = lane & 31, hi = lane >> 5;
    float* sc = (float*)(lds + 2 * BUFSZ + wid * 128);
    bf16x8 qf[4];
    {
        const bf16* qrow = Qbase + (size_t)(wid * 32 + r32) * ldq;
#pragma unroll
        for (int s = 0; s < 4; ++s) qf[s] = *(const bf16x8*)(qrow + 16 * s + 8 * hi);
    }
    f32x16 o[NDB];
#pragma unroll
    for (int d = 0; d < NDB; ++d)
#pragma unroll
        for (int r = 0; r < 16; ++r) o[d][r] = 0.f;
    float m = -1e30f, l = 0.f;
    uint4 kreg, vreg[NVL];
    const int krow = tid >> 3, kch = tid & 7;
#define ATT_LOAD(t) do { kreg = *(const uint4*)(Kc + (size_t)(t) * 64 * 64 + tid * 8); \
        _Pragma("unroll") for (int u = 0; u < NVL; ++u) { const int idx = tid + NT * u; vreg[u] = *(const uint4*)(Vt + (size_t)(idx >> 3) * KVLEN + (t) * 64 + (idx & 7) * 8); } } while (0)
#define ATT_STORE(buf) do { *(uint4*)(lds + (buf) * BUFSZ + krow * ATT_KPITCH + kch * 16) = kreg; \
        _Pragma("unroll") for (int u = 0; u < NVL; ++u) { const int idx = tid + NT * u; unsigned char* vp = lds + (buf) * BUFSZ + KBYTES + (idx >> 3) * ATT_VPITCH + (idx & 7) * 16; \
            *(uint2*)vp = make_uint2(vreg[u].x, vreg[u].y); *(uint2*)(vp + 8) = make_uint2(vreg[u].z, vreg[u].w); } } while (0)
    ATT_LOAD(0);
    ATT_STORE(0);
    __syncthreads();
    for (int t = 0; t < ntiles; ++t) {
        const int buf = t & 1;
        if (t + 1 < ntiles) ATT_LOAD(t + 1);
        const unsigned char* kb = lds + buf * BUFSZ;
        const unsigned char* vb = kb + KBYTES;
        f32x16 s0, s1;
#pragma unroll
        for (int r = 0; r < 16; ++r) { s0[r] = 0.f; s1[r] = 0.f; }
#pragma unroll
        for (int s = 0; s < 4; ++s) {
            const bf16x8 a0 = *(const bf16x8*)(kb + r32 * ATT_KPITCH + s * 32 + hi * 16);
            const bf16x8 a1 = *(const bf16x8*)(kb + (32 + r32) * ATT_KPITCH + s * 32 + hi * 16);
            s0 = __builtin_amdgcn_mfma_f32_32x32x16_bf16(a0, qf[s], s0, 0, 0, 0);
            s1 = __builtin_amdgcn_mfma_f32_32x32x16_bf16(a1, qf[s], s1, 0, 0, 0);
        }
        float tm = fmaxf(s0[0], s1[0]);
#pragma unroll
        for (int r = 1; r < 16; ++r) tm = fmaxf(tm, fmaxf(s0[r], s1[r]));
        tm = fmaxf(tm, __shfl_xor(tm, 32));
        if (__any(tm > m + THR)) {
            const float mn = fmaxf(m, tm), alpha = exp2f(m - mn);
            m = mn; l *= alpha;
            if (hi == 0) sc[r32] = alpha;
#pragma unroll
            for (int r = 0; r < 16; ++r) { const float a = sc[crow(r, hi)];
#pragma unroll
                for (int d = 0; d < NDB; ++d) o[d][r] *= a; }
        }
        float ps = 0.f;
#pragma unroll
        for (int r = 0; r < 16; ++r) { s0[r] = exp2f(s0[r] - m); s1[r] = exp2f(s1[r] - m); ps += s0[r] + s1[r]; }
        l += ps;
        bf16x8 pa[4];
#pragma unroll
        for (int s = 0; s < 4; ++s) {
            unsigned w[4];
#pragma unroll
            for (int k = 0; k < 4; ++k) w[k] = (s < 2) ? cvt_pk_bf16_f32(s0[8 * (s & 1) + 2 * k], s0[8 * (s & 1) + 2 * k + 1]) : cvt_pk_bf16_f32(s1[8 * (s & 1) + 2 * k], s1[8 * (s & 1) + 2 * k + 1]);
            uint4 pw = make_uint4(w[0], w[1], w[2], w[3]);
            pa[s] = __builtin_bit_cast(bf16x8, pw);
        }
#pragma unroll
        for (int d = 0; d < NDB; ++d) {
#pragma unroll
            for (int s = 0; s < 4; ++s) {
                const unsigned char* vp = vb + (32 * d + r32) * ATT_VPITCH + 32 * s + 8 * hi;
                const uint2 v0 = *(const uint2*)vp, v1 = *(const uint2*)(vp + 16);
                uint4 vw = make_uint4(v0.x, v0.y, v1.x, v1.y);
                o[d] = __builtin_amdgcn_mfma_f32_32x32x16_bf16(pa[s], __builtin_bit_cast(bf16x8, vw), o[d], 0, 0, 0);
            }
        }
        if (t + 1 < ntiles) ATT_STORE(buf ^ 1);
        __syncthreads();
    }
#undef ATT_LOAD
#undef ATT_STORE
    l += __shfl_xor(l, 32);
    if (hi == 0) sc[r32] = 1.f / l;
#pragma unroll
    for (int r = 0; r < 16; ++r) {
        const float iv = sc[crow(r, hi)];
        bf16* orow = Obase + (size_t)(wid * 32 + crow(r, hi)) * ldo + r32;
#pragma unroll
        for (int d = 0; d < NDB; ++d) orow[32 * d] = (bf16)f2bf(o[d][r] * iv);
    }
    __syncthreads();
}
__device__ __forceinline__ void ph_attn_mfma(const bf16* __restrict__ P, int ldp, const bf16* __restrict__ Kc, const bf16* __restrict__ Vt, bf16* __restrict__ ATT,
                                             int odd, int with_ctx, unsigned char* lds) {
    const int TID = opaque_tid(), BID = opaque_bid();
    const int G = gridDim.x, vcu = (G % 8 == 0) ? (BID & 7) * (G >> 3) + (BID >> 3) : BID;
    const int nlat = odd ? 2048 : 1024, nctx = with_ctx ? (odd ? 256 : 128) : 0;
    for (int u = vcu; u < nlat + nctx; u += G) {
        int b, qh, row0, ntiles;
        if (u < nlat) {
            if (odd) { const int grp = u >> 5, w = u & 31; b = grp >> 2; qh = (grp & 3) * 4 + (w >> 3); row0 = b * SEQ + (w & 7) * 256; }
            else { const int grp = u >> 4, w = u & 15; b = grp >> 2; qh = (grp & 3) * 2 + (w >> 3); row0 = b * SEQ + (w & 7) * 256; }
            ntiles = KVLEN / 64;
        } else {
            const int idx = u - nlat;
            if (odd) { b = idx >> 4; qh = idx & 15; } else { b = idx >> 3; qh = idx & 7; }
            row0 = RL + b * CTX; ntiles = CTX / 64;
        }
        if (odd) attn_unit<64>(P + (size_t)row0 * ldp + qh * 64, ldp, Kc + (size_t)(b * 4 + (qh >> 2)) * KVLEN * 64, Vt + (size_t)(b * 4 + (qh >> 2)) * 64 * KVLEN, ntiles,
                               ATT + (size_t)row0 * DM + qh * 64, DM, lds, TID);
        else attn_unit<128>(P + (size_t)row0 * ldp + qh * 64, ldp, Kc + (size_t)(b * 8 + qh) * KVLEN * 64, Vt + (size_t)(b * 4 + (qh >> 1)) * 128 * KVLEN, ntiles,
                            ATT + (size_t)row0 * DM + qh * 128, DM, lds, TID);
    }
}
typedef float f32x4_t __attribute__((ext_vector_type(4)));
#define GLA_PITCH 144
__device__ __forceinline__ void ph_gla_chunk(const bf16* __restrict__ P, const float* __restrict__ w_af, const float* __restrict__ b_af,
                                             const float* __restrict__ w_ab, const float* __restrict__ b_ab, float* __restrict__ OF, float* __restrict__ OB, unsigned char* lds) {
    const int TID = opaque_tid(), BID = opaque_bid();
    const int tid = TID, lane = tid & 63, wid = tid >> 6, l15 = lane & 15, q4 = lane >> 4;
    float* SEG = (float*)lds;
    float* DEC = (float*)(lds + 2048);
    unsigned char* QD = lds + 4096;
    unsigned char* KI = QD + 9216;
    unsigned char* KET = KI + 9216;
    unsigned char* AT = KET + 9216;
    unsigned char* VT = AT + 9216;
    for (int unit = BID; unit < NB * 4 * 2; unit += gridDim.x) {
        const int dir = unit & 1, h = (unit >> 1) & 3, b = unit >> 3;
        const float* wa = dir ? w_ab : w_af; const float* ba = dir ? b_ab : b_af;
        float* Od = dir ? OB : OF;
        const int d = tid & 63, seg = tid >> 6;
        float wreg[16];
#pragma unroll
        for (int j = 0; j < 16; ++j) wreg[j] = wa[j * 256 + h * 64 + d];
        const float breg = ba[h * 64 + d];
        for (int i = tid; i < 9216 / 16; i += NT) ((uint4*)AT)[i] = make_uint4(0u, 0u, 0u, 0u);
        f32x4_t S[4];
#pragma unroll
        for (int i = 0; i < 4; ++i) S[i] = (f32x4_t){0.f, 0.f, 0.f, 0.f};
        __syncthreads();
        for (int ch = 0; ch < KVLEN / 64; ++ch) {
            int rbase, rsgn;
            if (!dir) { rbase = ch < 4 ? RL + b * CTX + ch * 64 : b * SEQ + (ch - 4) * 64; rsgn = 1; }
            else { rbase = ch < 4 ? RL + b * CTX + (CTX - 1 - ch * 64) : b * SEQ + (SEQ - 1 - (ch - 4) * 64); rsgn = -1; }
            float cl[8];
            {
                float run = 0.f;
#pragma unroll
                for (int i = 0; i < 8; ++i) {
                    const bf16* pr = P + (size_t)(rbase + rsgn * (8 * seg + i)) * EVEN_LDP + 3072 + dir * 16;
                    const uint4 g0 = *(const uint4*)pr, g1 = *(const uint4*)(pr + 8);
                    const unsigned gw[8] = {g0.x, g0.y, g0.z, g0.w, g1.x, g1.y, g1.z, g1.w};
                    float z = breg;
#pragma unroll
                    for (int j = 0; j < 8; ++j) { z += __uint_as_float(gw[j] << 16) * wreg[2 * j]; z += __uint_as_float(gw[j] & 0xffff0000u) * wreg[2 * j + 1]; }
                    run += log_sigmoid_f(z) * (1.f / 16.f);
                    cl[i] = run;
                }
                SEG[seg * 64 + d] = run;
            }
            __syncthreads();
            {
                float prefix = 0.f, total = 0.f;
#pragma unroll
                for (int s2 = 0; s2 < 8; ++s2) { const float v = SEG[s2 * 64 + d]; total += v; prefix += (s2 < seg) ? v : 0.f; }
                if (seg == 0) DEC[d] = __expf(total);
                unsigned kew[4];
#pragma unroll
                for (int i = 0; i < 8; ++i) {
                    const int c = 8 * seg + i;
                    const bf16* pr = P + (size_t)(rbase + rsgn * c) * EVEN_LDP;
                    const float qv = bf2f(pr[1536 + h * 64 + d]) * 0.125f, kv = bf2f(pr[1792 + h * 64 + d]);
                    const float cum = prefix + cl[i];
                    const float e = __expf(cum), ei = __expf(-cum), ee = __expf(total - cum);
                    *(bf16*)(QD + c * GLA_PITCH + d * 2) = (bf16)f2bf(qv * e);
                    *(bf16*)(KI + c * GLA_PITCH + d * 2) = (bf16)f2bf(kv * ei);
                    const unsigned kb = f2bf(kv * ee);
                    if (i & 1) kew[i >> 1] |= kb << 16; else kew[i >> 1] = kb;
                }
                *(uint4*)(KET + d * GLA_PITCH + seg * 16) = make_uint4(kew[0], kew[1], kew[2], kew[3]);
                const int v = tid & 127, cg = tid >> 7;
                unsigned vw[8];
#pragma unroll
                for (int i = 0; i < 16; ++i) {
                    const unsigned x = P[(size_t)(rbase + rsgn * (16 * cg + i)) * EVEN_LDP + 2048 + h * 128 + v];
                    if (i & 1) vw[i >> 1] |= x << 16; else vw[i >> 1] = x;
                }
                *(uint4*)(VT + v * GLA_PITCH + cg * 32) = make_uint4(vw[0], vw[1], vw[2], vw[3]);
                *(uint4*)(VT + v * GLA_PITCH + cg * 32 + 16) = make_uint4(vw[4], vw[5], vw[6], vw[7]);
            }
            __syncthreads();
            for (int blk = wid; blk < 10; blk += NWV) {
                int sblk, cblk;
                if (blk < 4) { sblk = 0; cblk = blk; } else if (blk < 7) { sblk = 1; cblk = blk - 3; } else if (blk < 9) { sblk = 2; cblk = blk - 5; } else { sblk = 3; cblk = 3; }
                f32x4_t acc = (f32x4_t){0.f, 0.f, 0.f, 0.f};
#pragma unroll
                for (int kk = 0; kk < 2; ++kk) {
                    const bf16x8 a = *(const bf16x8*)(KI + (16 * sblk + l15) * GLA_PITCH + 64 * kk + 16 * q4);
                    const bf16x8 bq = *(const bf16x8*)(QD + (16 * cblk + l15) * GLA_PITCH + 64 * kk + 16 * q4);
                    acc = __builtin_amdgcn_mfma_f32_16x16x32_bf16(a, bq, acc, 0, 0, 0);
                }
                const int c = 16 * cblk + l15, s0 = 16 * sblk + 4 * q4;
                float av[4];
#pragma unroll
                for (int r = 0; r < 4; ++r) av[r] = (s0 + r <= c) ? acc[r] : 0.f;
                *(uint2*)(AT + c * GLA_PITCH + s0 * 2) = make_uint2(pk2(av[0], av[1]), pk2(av[2], av[3]));
            }
            __syncthreads();
            {
                const int v0 = 16 * wid;
                bf16x8 bv[2], sB[2];
#pragma unroll
                for (int kk = 0; kk < 2; ++kk) {
                    bv[kk] = *(const bf16x8*)(VT + (v0 + l15) * GLA_PITCH + 64 * kk + 16 * q4);
                    uint4 w = make_uint4(pk2(S[2 * kk][0], S[2 * kk][1]), pk2(S[2 * kk][2], S[2 * kk][3]), pk2(S[2 * kk + 1][0], S[2 * kk + 1][1]), pk2(S[2 * kk + 1][2], S[2 * kk + 1][3]));
                    sB[kk] = __builtin_bit_cast(bf16x8, w);
                }
#pragma unroll
                for (int cblk = 0; cblk < 4; ++cblk) {
                    f32x4_t acc = (f32x4_t){0.f, 0.f, 0.f, 0.f};
                    const unsigned char* arow = AT + (16 * cblk + l15) * GLA_PITCH;
                    const unsigned char* qrow = QD + (16 * cblk + l15) * GLA_PITCH;
#pragma unroll
                    for (int kk = 0; kk < 2; ++kk) {
                        if (kk == 0 || cblk >= 2) {
                            const bf16x8 a = *(const bf16x8*)(arow + 64 * kk + 16 * q4);
                            acc = __builtin_amdgcn_mfma_f32_16x16x32_bf16(a, bv[kk], acc, 0, 0, 0);
                        }
                    }
#pragma unroll
                    for (int kk = 0; kk < 2; ++kk) {
                        const uint2 a0 = *(const uint2*)(qrow + 64 * kk + 8 * q4), a1 = *(const uint2*)(qrow + 64 * kk + 32 + 8 * q4);
                        uint4 aw = make_uint4(a0.x, a0.y, a1.x, a1.y);
                        acc = __builtin_amdgcn_mfma_f32_16x16x32_bf16(__builtin_bit_cast(bf16x8, aw), sB[kk], acc, 0, 0, 0);
                    }
#pragma unroll
                    for (int r = 0; r < 4; ++r) Od[(size_t)(rbase + rsgn * (16 * cblk + 4 * q4 + r)) * 512 + h * 128 + v0 + l15] = acc[r];
                }
#pragma unroll
                for (int dblk = 0; dblk < 4; ++dblk) {
#pragma unroll
                    for (int r = 0; r < 4; ++r) S[dblk][r] *= DEC[16 * dblk + 4 * q4 + r];
#pragma unroll
                    for (int kk = 0; kk < 2; ++kk) {
                        const bf16x8 a = *(const bf16x8*)(KET + (16 * dblk + l15) * GLA_PITCH + 64 * kk + 16 * q4);
                        S[dblk] = __builtin_amdgcn_mfma_f32_16x16x32_bf16(a, bv[kk], S[dblk], 0, 0, 0);
                    }
                }
            }
            __syncthreads();
        }
    }
}
__device__ __forceinline__ void ph_even_post(bf16* __restrict__ ATT, const float* __restrict__ lamv, const float* __restrict__ subln, float lam_init,
                             const float* __restrict__ OF, const float* __restrict__ OB, const bf16* __restrict__ P, const float* __restrict__ gain) {
    const int TID = opaque_tid(), BID = opaque_bid();
    int wave = BID * NWV + (TID >> 6), lane = TID & 63;
    int nw = gridDim.x * NWV;
    float p1 = lamv[lane] * lamv[64 + lane], p2 = lamv[128 + lane] * lamv[192 + lane];
    p1 = wave_sum(p1); p2 = wave_sum(p2);
    const float lam = expf(p1) - expf(p2) + lam_init;
    for (int r = wave; r < RT; r += nw) {
        bf16* a = ATT + (size_t)r * DM;
        float d[4][2];
#pragma unroll
        for (int h = 0; h < 4; ++h) {
            float2 o0 = ld2bf(a + (2 * h) * 128 + lane * 2);
            float2 o1 = ld2bf(a + (2 * h + 1) * 128 + lane * 2);
            d[h][0] = o0.x - lam * o1.x; d[h][1] = o0.y - lam * o1.y;
        }
        float2 outd[4];
#pragma unroll
        for (int h = 0; h < 4; ++h) {
            float s = wave_sum(d[h][0] * d[h][0] + d[h][1] * d[h][1]);
            float rstd = rsqrtf(s * (1.f / 128.f) + 1e-6f) * (1.f - lam_init);
            float2 sg = *(const float2*)(subln + lane * 2);
            outd[h] = make_float2(d[h][0] * rstd * sg.x, d[h][1] * rstd * sg.y);
        }
        float2 outg[4];
#pragma unroll
        for (int h = 0; h < 4; ++h) {
            float2 x = *(const float2*)(OF + (size_t)r * 512 + h * 128 + lane * 2);
            float2 c = *(const float2*)(OB + (size_t)r * 512 + h * 128 + lane * 2);
            float o0 = x.x + c.x, o1 = x.y + c.y;
            float s = wave_sum(o0 * o0 + o1 * o1);
            float rstd = rsqrtf(s * (1.f / 128.f) + 1e-6f);
            float2 g = *(const float2*)(gain + lane * 2);
            float2 rr = ld2bf(P + (size_t)r * EVEN_LDP + 2560 + h * 128 + lane * 2);
            outg[h] = make_float2(o0 * rstd * g.x * silu_f(rr.x), o1 * rstd * g.y * silu_f(rr.y));
        }
#pragma unroll
        for (int h = 0; h < 4; ++h) {
            st2bf(a + h * 128 + lane * 2, outd[h]);
            st2bf(a + 512 + h * 128 + lane * 2, outg[h]);
        }
    }
}
#define INS16(tv, ti, v, n) do { \
    _Pragma("unroll") for (int j_ = 15; j_ >= 1; --j_) { bool c1_ = (v) > tv[j_ - 1]; bool c2_ = (v) > tv[j_]; \
        tv[j_] = c1_ ? tv[j_ - 1] : (c2_ ? (v) : tv[j_]); ti[j_] = c1_ ? ti[j_ - 1] : (c2_ ? (n) : ti[j_]); } \
    { bool c_ = (v) > tv[0]; tv[0] = c_ ? (v) : tv[0]; ti[0] = c_ ? (n) : ti[0]; } } while (0)

__device__ __forceinline__ void ph_peer_ffn(const bf16* __restrict__ A2, const int* __restrict__ IDX, const float* __restrict__ GATE,
                            const float* __restrict__ U, const float* __restrict__ V, const float* __restrict__ mods_l, float* __restrict__ X) {
    const int TID = opaque_tid(), BID = opaque_bid();
    int wave = BID * NWV + (TID >> 6), lane = TID & 63;
    int nw = gridDim.x * NWV;
    for (int r = wave; r < RT; r += nw) {
        float4 xa[4], acc[4];
#pragma unroll
        for (int i = 0; i < 4; ++i) { xa[i] = ld4bf(A2 + (size_t)r * DM + 4 * (lane + 64 * i)); acc[i] = make_float4(0.f, 0.f, 0.f, 0.f); }
        for (int e = 0; e < 128; ++e) {
            int id = IDX[(size_t)r * 128 + e]; float g = GATE[(size_t)r * 128 + e];
            const float4* ur = (const float4*)(U + (size_t)id * DM);
            float d = 0.f;
#pragma unroll
            for (int i = 0; i < 4; ++i) { float4 u = ur[lane + 64 * i]; d += u.x * xa[i].x + u.y * xa[i].y + u.z * xa[i].z + u.w * xa[i].w; }
            d = wave_sum(d);
            float w = g * gelu_tanh(d);
            const float4* vr = (const float4*)(V + (size_t)id * DM);
#pragma unroll
            for (int i = 0; i < 4; ++i) { float4 v = vr[lane + 64 * i]; acc[i].x += w * v.x; acc[i].y += w * v.y; acc[i].z += w * v.z; acc[i].w += w * v.w; }
        }
        const float4* g5 = (const float4*)(mods_l + (size_t)row_mod(r) * MODW + 5 * DM);
        float4* xr = (float4*)(X + (size_t)r * DM);
#pragma unroll
        for (int i = 0; i < 4; ++i) { float4 x = xr[lane + 64 * i], gg = g5[lane + 64 * i];
            x.x += gg.x * acc[i].x; x.y += gg.y * acc[i].y; x.z += gg.z * acc[i].z; x.w += gg.w * acc[i].w; xr[lane + 64 * i] = x; }
    }
}
#define RT_KPITCH 144
#define INSP16(t, x) do { unsigned x_ = (x); _Pragma("unroll") for (int j_ = 0; j_ < 16; ++j_) { const unsigned h_ = max(t[j_], x_); x_ = min(t[j_], x_); t[j_] = h_; } } while (0)
__device__ __forceinline__ void ph_route_mfma(const bf16* __restrict__ Qp, const bf16* __restrict__ Kb, int* __restrict__ IDX, float* __restrict__ GATE, unsigned char* lds, int nrows) {
    const int TID = opaque_tid(), BID = opaque_bid();
    const int tid = TID, lane = tid & 63, wid = tid >> 6, r32 = lane & 31, hi = lane >> 5;
    for (int u = BID; u < (nrows / 256) * 8; u += gridDim.x) {
        const int h = u & 7, row = (u >> 3) * 256 + wid * 32 + r32;
        __syncthreads();
        for (int i = tid; i < 2 * 128 * 8; i += NT) *(uint4*)(lds + (i >> 3) * RT_KPITCH + (i & 7) * 16) = *(const uint4*)(Kb + ((size_t)h * 256 + (i >> 3)) * 64 + (i & 7) * 8);
        __syncthreads();
        unsigned L[2][16];
#pragma unroll
        for (int half = 0; half < 2; ++half) {
            bf16x8 qf[4];
            const bf16* qrow = Qp + (size_t)row * DM + h * 128 + half * 64;
#pragma unroll
            for (int s = 0; s < 4; ++s) qf[s] = *(const bf16x8*)(qrow + 16 * s + 8 * hi);
#pragma unroll
            for (int j = 0; j < 16; ++j) L[half][j] = 0u;
#pragma unroll
            for (int nb = 0; nb < 4; ++nb) {
                f32x16 acc;
#pragma unroll
                for (int r = 0; r < 16; ++r) acc[r] = 0.f;
#pragma unroll
                for (int s = 0; s < 4; ++s) {
                    const bf16x8 a = *(const bf16x8*)(lds + (half * 128 + 32 * nb + r32) * RT_KPITCH + 32 * s + 16 * hi);
                    acc = __builtin_amdgcn_mfma_f32_32x32x16_bf16(a, qf[s], acc, 0, 0, 0);
                }
#pragma unroll
                for (int r = 0; r < 16; ++r) {
                    unsigned ub = __float_as_uint(acc[r]);
                    ub = (ub & 0x80000000u) ? ~ub : (ub | 0x80000000u);
                    const unsigned x = (ub & ~127u) | (unsigned)(127 - (32 * nb + (r & 3) + 8 * (r >> 2)) - 4 * hi);
                    INSP16(L[half], x);
                }
                __builtin_amdgcn_sched_barrier(0);
            }
            unsigned o[16];
#pragma unroll
            for (int j = 0; j < 16; ++j) o[j] = __shfl_xor(L[half][j], 32);
#pragma unroll
            for (int j = 0; j < 16; ++j) INSP16(L[half], o[j]);
            __builtin_amdgcn_sched_barrier(0);
        }
        float v1[16], v2[16];
        {
            unsigned w1[4] = {0u, 0u, 0u, 0u}, w2[4] = {0u, 0u, 0u, 0u};
#pragma unroll
            for (int j = 0; j < 16; ++j) {
                unsigned a = L[0][j] & ~127u, b = L[1][j] & ~127u;
                a = (a & 0x80000000u) ? (a & 0x7fffffffu) : ~a; b = (b & 0x80000000u) ? (b & 0x7fffffffu) : ~b;
                v1[j] = __uint_as_float(a); v2[j] = __uint_as_float(b);
                w1[j >> 2] |= (127u - (L[0][j] & 127u)) << (8 * (j & 3)); w2[j >> 2] |= (127u - (L[1][j] & 127u)) << (8 * (j & 3));
            }
            unsigned char* sb = lds + 2 * 128 * RT_KPITCH + tid * 4;
#pragma unroll
            for (int k = 0; k < 4; ++k) { *(unsigned*)(sb + k * 2048) = w1[k]; *(unsigned*)(sb + (4 + k) * 2048) = w2[k]; }
        }
        unsigned T[16];
#pragma unroll
        for (int j = 0; j < 16; ++j) T[j] = 0u;
#pragma unroll
        for (int a = 0; a < 16; ++a)
#pragma unroll
            for (int b = 0; b < 16; ++b) {
                if ((a + 1) * (b + 1) <= 16) {
                    unsigned ub = __float_as_uint(v1[a] + v2[b]);
                    ub = (ub & 0x80000000u) ? ~ub : (ub | 0x80000000u);
                    const unsigned x = (ub & ~255u) | (unsigned)(255 - (16 * a + b));
                    INSP16(T, x);
                }
            }
        float e[16]; int bi[16]; float sum = 0.f, v0 = 0.f;
        {
            const unsigned char* sb = lds + 2 * 128 * RT_KPITCH + tid * 4;
#pragma unroll
            for (int j = 0; j < 16; ++j) {
                unsigned ub = T[j] & ~255u;
                ub = (ub & 0x80000000u) ? (ub & 0x7fffffffu) : ~ub;
                const float val = __uint_as_float(ub);
                if (j == 0) v0 = val;
                e[j] = __expf(val - v0); sum += e[j];
                const unsigned flat = 255u - (T[j] & 255u), ca = flat >> 4, cb = flat & 15u;
                const unsigned ia = *(const unsigned char*)(sb + (ca >> 2) * 2048 + (ca & 3)), ib = *(const unsigned char*)(sb + (4 + (cb >> 2)) * 2048 + (cb & 3));
                bi[j] = (int)(ia * 128u + ib);
            }
        }
        const float inv = 1.f / sum;
        if (hi == 0) {
            int* ip = IDX + (size_t)row * 128 + h * 16; float* gp = GATE + (size_t)row * 128 + h * 16;
#pragma unroll
            for (int j = 0; j < 4; ++j) {
                *(int4*)(ip + 4 * j) = make_int4(bi[4 * j], bi[4 * j + 1], bi[4 * j + 2], bi[4 * j + 3]);
                *(float4*)(gp + 4 * j) = make_float4(e[4 * j] * inv, e[4 * j + 1] * inv, e[4 * j + 2] * inv, e[4 * j + 3] * inv);
            }
        }
    }
    __syncthreads();
}
__device__ __forceinline__ void ph_table_prep(const float* __restrict__ U, const float* __restrict__ V, unsigned char* __restrict__ T8, float* __restrict__ RS) {
    const int TID = opaque_tid(), BID = opaque_bid();
    const int wave = BID * NWV + (TID >> 6), lane = TID & 63, nw = gridDim.x * NWV;
    const int NROWS = DEPTH * 16384;
    for (int rr = wave; rr < 2 * NROWS; rr += nw) {
        const float* src = (rr < NROWS ? U : V) + (size_t)(rr < NROWS ? rr : rr - NROWS) * DM + lane * 16;
        float4 v[4]; float am = 0.f;
#pragma unroll
        for (int i = 0; i < 4; ++i) { v[i] = ((const float4*)src)[i]; am = fmaxf(am, fmaxf(fmaxf(fabsf(v[i].x), fabsf(v[i].y)), fmaxf(fabsf(v[i].z), fabsf(v[i].w)))); }
#pragma unroll
        for (int o = 1; o < 64; o <<= 1) am = fmaxf(am, __shfl_xor(am, o));
        am = fmaxf(am, 1e-30f);
        const float sc = exp2f(floorf(log2f(448.f / am)) - 1.f);
        int w[4];
#pragma unroll
        for (int i = 0; i < 4; ++i) { int t = 0; t = __builtin_amdgcn_cvt_pk_fp8_f32(v[i].x * sc, v[i].y * sc, t, false); t = __builtin_amdgcn_cvt_pk_fp8_f32(v[i].z * sc, v[i].w * sc, t, true); w[i] = t; }
        *(uint4*)(T8 + (size_t)rr * DM + lane * 16) = make_uint4((unsigned)w[0], (unsigned)w[1], (unsigned)w[2], (unsigned)w[3]);
        if (lane == 0) RS[rr] = 1.f / sc;
    }
}
#define BR4(j) ((((j) & 1) << 3) | (((j) & 2) << 1) | (((j) & 4) >> 1) | (((j) & 8) >> 3))
__device__ __forceinline__ float dot16_fp8_bf16(uint4 u, const unsigned (&x)[8]) {
    float d = 0.f;
    const unsigned uw[4] = {u.x, u.y, u.z, u.w};
#pragma unroll
    for (int i = 0; i < 4; ++i) {
        bf16x2_t lo = __builtin_amdgcn_cvt_scalef32_pk_bf16_fp8(uw[i], 1.0f, false);
        bf16x2_t hi = __builtin_amdgcn_cvt_scalef32_pk_bf16_fp8(uw[i], 1.0f, true);
        d = __builtin_amdgcn_fdot2_f32_bf16(lo, __builtin_bit_cast(bf16x2_t, x[2 * i]), d, false);
        d = __builtin_amdgcn_fdot2_f32_bf16(hi, __builtin_bit_cast(bf16x2_t, x[2 * i + 1]), d, false);
    }
    return d;
}
__device__ __forceinline__ void ph_peer_ffn8(const bf16* __restrict__ A2, const int* __restrict__ IDX, const float* __restrict__ GATE,
                            const unsigned char* __restrict__ U8, const float* __restrict__ RSU, const unsigned char* __restrict__ V8, const float* __restrict__ RSV,
                            const float* __restrict__ mods_l, float* __restrict__ X, int nrows) {
    const int TID = opaque_tid(), BID = opaque_bid();
    const int wave = BID * NWV + (TID >> 6), lane = TID & 63, nw = gridDim.x * NWV;
    const int jl = BR4(lane & 15);
    for (int r = wave; r < nrows; r += nw) {
        unsigned x[8];
        { const uint4* xp = (const uint4*)(A2 + (size_t)r * DM + lane * 16); uint4 a = xp[0], b = xp[1]; x[0] = a.x; x[1] = a.y; x[2] = a.z; x[3] = a.w; x[4] = b.x; x[5] = b.y; x[6] = b.z; x[7] = b.w; }
        float acc[16];
#pragma unroll
        for (int k = 0; k < 16; ++k) acc[k] = 0.f;
        for (int g = 0; g < 8; ++g) {
            const int myid = IDX[(size_t)r * 128 + g * 16 + jl];
            const float mygate = GATE[(size_t)r * 128 + g * 16 + jl];
            const float rsu = RSU[myid], rsv = RSV[myid];
            uint4 ub[16], vb[16];
#pragma unroll
            for (int j = 0; j < 16; ++j) { const int id = __builtin_amdgcn_readlane(myid, BR4(j)); ub[j] = *(const uint4*)(U8 + (size_t)id * DM + lane * 16); }
#pragma unroll
            for (int j = 0; j < 16; ++j) { const int id = __builtin_amdgcn_readlane(myid, BR4(j)); vb[j] = *(const uint4*)(V8 + (size_t)id * DM + lane * 16); }
            float d[16];
#pragma unroll
            for (int j = 0; j < 16; ++j) d[j] = dot16_fp8_bf16(ub[j], x);
#pragma unroll
            for (int st = 0; st < 4; ++st) {
                const int n = 8 >> st, bit = 1 << st;
                const bool up = (lane & bit) != 0;
#pragma unroll
                for (int i = 0; i < 8; ++i) if (i < n) {
                    const float send = up ? d[i] : d[i + n], keep = up ? d[i + n] : d[i];
                    d[i] = keep + __shfl_xor(send, bit);
                }
            }
            float tot = d[0];
            tot += __shfl_xor(tot, 16); tot += __shfl_xor(tot, 32);
            const float w = mygate * gelu_tanh(tot * rsu) * rsv;
#pragma unroll
            for (int j = 0; j < 16; ++j) {
                const float wj = __int_as_float(__builtin_amdgcn_readlane(__float_as_int(w), BR4(j)));
                const unsigned vw[4] = {vb[j].x, vb[j].y, vb[j].z, vb[j].w};
#pragma unroll
                for (int i = 0; i < 4; ++i) {
                    f32x2_t lo = __builtin_amdgcn_cvt_pk_f32_fp8((int)vw[i], false), hi = __builtin_amdgcn_cvt_pk_f32_fp8((int)vw[i], true);
                    acc[4 * i] += wj * lo.x; acc[4 * i + 1] += wj * lo.y; acc[4 * i + 2] += wj * hi.x; acc[4 * i + 3] += wj * hi.y;
                }
            }
        }
        const float4* g5 = (const float4*)(mods_l + (size_t)row_mod(r) * MODW + 5 * DM + lane * 16);
        float4* xr = (float4*)(X + (size_t)r * DM + lane * 16);
#pragma unroll
        for (int i = 0; i < 4; ++i) { float4 xv = xr[i], gg = g5[i];
            xv.x += gg.x * acc[4 * i]; xv.y += gg.y * acc[4 * i + 1]; xv.z += gg.z * acc[4 * i + 2]; xv.w += gg.w * acc[4 * i + 3]; xr[i] = xv; }
    }
}
template <int N>
__device__ __forceinline__ void ph_gemm_bf16(const bf16* A, const bf16* Bt, bf16* O, unsigned char* lds) {
    pg8::Gemm g{A, Bt, RT, N, DM}; pg8::StaticOrder S; S.init(RT, N, (int)gridDim.x, opaque_bid());
    pg8::EpiBf16<0> E{O, N, nullptr, 0, 0, 1.f};
    pg8::gemm_phase<pg8::EpiBf16<0>, pg8::StaticOrder, true, true>((PG8_LAS unsigned char*)lds, g, S, E);
}
__device__ __forceinline__ void ph_gemm_res(const bf16* A, const bf16* Bt, float* X, const float* gate, unsigned char* lds) {
    pg8::Gemm g{A, Bt, RT, DM, DM}; pg8::StaticOrder S; S.init(RT, DM, (int)gridDim.x, opaque_bid());
    EpiResGate E{X, gate};
    pg8::gemm_phase<EpiResGate, pg8::StaticOrder, true, true>((PG8_LAS unsigned char*)lds, g, S, E);
}

constexpr size_t ALIGN_UP(size_t x) { return (x + 255) & ~(size_t)255; }
constexpr size_t WS_X = 0;
constexpr size_t WS_A = WS_X + (size_t)RT * DM * 4;
constexpr size_t WS_P = WS_A + (size_t)RT * DM * 2;
constexpr size_t WS_ATT = WS_P + (size_t)RT * EVEN_LDP * 2;
constexpr size_t WS_OF = WS_ATT + (size_t)RT * DM * 2;
constexpr size_t WS_MODS = WS_OF + (size_t)RT * 512 * 4 * 2;
constexpr size_t WS_ROPE = WS_MODS + ALIGN_UP((size_t)DEPTH * NMOD * MODW * 4);
constexpr size_t WS_WINE = WS_ROPE + (size_t)SEQ * 32 * 8;
constexpr size_t WS_WOUTE = WS_WINE + (size_t)2 * EVEN_LDP * DM * 2;
constexpr size_t WS_WINO = WS_WOUTE + (size_t)2 * DM * DM * 2;
constexpr size_t WS_WOUTO = WS_WINO + (size_t)2 * ODD_IN * DM * 2;
constexpr size_t WS_WPQ = WS_WOUTO + (size_t)2 * DM * DM * 2;
constexpr size_t WS_T8 = WS_WPQ + (size_t)4 * DM * DM * 2;
constexpr size_t WS_RS = WS_T8 + (size_t)2 * DEPTH * 16384 * DM;
constexpr size_t WS_KC = WS_RS + (size_t)2 * DEPTH * 16384 * 4;
constexpr size_t WS_VT = WS_KC + (size_t)NB * 8 * KVLEN * 64 * 2;
constexpr size_t WS_KEYS = WS_VT + (size_t)NB * 4 * 128 * KVLEN * 2;
constexpr size_t WS_END = WS_KEYS + (size_t)DEPTH * 8 * 2 * 128 * 64 * 2;

__global__ void __launch_bounds__(NT, 2) mega(Params p) {
    extern __shared__ __attribute__((aligned(16))) unsigned char lds[];
    float* smem = (float*)lds;
    cg::grid_group grid = cg::this_grid();
    unsigned char* ws = p.ws;
#define X_ ((float*)(ws + WS_X))
#define A_ ((bf16*)(ws + WS_A))
#define P_ ((bf16*)(ws + WS_P))
#define ATT_ ((bf16*)(ws + WS_ATT))
#define OF_ ((float*)(ws + WS_OF))
#define OB_ (OF_ + (size_t)RT * 512)
#define MODS_ ((float*)(ws + WS_MODS))
#define ROPE_ ((float2*)(ws + WS_ROPE))
#define WINE_ ((bf16*)(ws + WS_WINE))
#define WOUTE_ ((bf16*)(ws + WS_WOUTE))
#define WINO_ ((bf16*)(ws + WS_WINO))
#define WOUTO_ ((bf16*)(ws + WS_WOUTO))
#define WPQ_ ((bf16*)(ws + WS_WPQ))
#define QP_ P_
#define KEYS_ ((bf16*)(ws + WS_KEYS))
#define KC_ ((bf16*)(ws + WS_KC))
#define VT_ ((bf16*)(ws + WS_VT))
#define T8_ (ws + WS_T8)
#define RS_ ((float*)(ws + WS_RS))
#define IDX_ ((int*)(ws + WS_P + (size_t)RT * DM * 2))
#define GATE_ ((float*)(ws + WS_P + (size_t)RT * DM * 2 + (size_t)RT * 128 * 4))

    ph_copy_in(p.in[0], p.in[2], X_);
    ph_rope_table(ROPE_);
    ph_weight_prep(p.in, WINE_, WOUTE_, WINO_, WOUTO_, WPQ_, KEYS_, lds);
    ph_table_prep(p.in[25], p.in[26], T8_, RS_);
    __syncthreads();
    ph_mods(p.in[1], p.in[3], p.in[4], p.in[5], MODS_, smem);
    grid.sync();
    for (int hl = 0; hl < 2 * DEPTH; ++hl) {
        const int l = hl >> 1, part = hl & 1, i = l >> 1, odd = l & 1;
        const float* mods_l = MODS_ + (size_t)l * NMOD * MODW;
        ph_norm_mod(X_, (part ? p.in[7] : p.in[6]) + l * DM, mods_l, part ? 3 : 0, A_);
        grid.sync();
        if (part) ph_gemm_bf16<DM>(A_, WPQ_ + (size_t)l * DM * DM, P_, lds);
        else if (odd) ph_gemm_bf16<ODD_IN>(A_, WINO_ + (size_t)i * ODD_IN * DM, P_, lds);
        else ph_gemm_bf16<EVEN_LDP>(A_, WINE_ + (size_t)i * EVEN_LDP * DM, P_, lds);
        grid.sync();
        if (part == 0) {
            const int ldp = odd ? ODD_IN : EVEN_LDP;
            ph_post(P_, ldp, odd ? 16 : 8, odd ? 1024 : 512, odd ? 4 : 8, odd ? 1280 : 1024, odd ? 256 : 512, odd ? 64 : 128,
                    (odd ? p.in[21] : p.in[10]) + i * 64, (odd ? p.in[22] : p.in[11]) + i * 64, ROPE_, KC_, VT_);
            grid.sync();
            if (!odd) ph_gla_chunk(P_, p.in[14] + i * 16 * 256, p.in[15] + i * 256, p.in[16] + i * 16 * 256, p.in[17] + i * 256, OF_, OB_, lds);
            ph_attn_mfma(P_, ldp, KC_, VT_, ATT_, odd, 1, lds);
            if (DUP_ATTN) ph_attn_mfma(P_, ldp, KC_, VT_, ATT_, odd, 1, lds);
            grid.sync();
            if (!odd) {
                const float lam_init = 0.8f - 0.6f * expf(-0.3f * (float)l);
                ph_even_post(ATT_, p.in[12] + i * 256, p.in[13] + i * 128, lam_init, OF_, OB_, P_, p.in[18] + i * 128);
                grid.sync();
            }
            ph_gemm_res(ATT_, odd ? WOUTO_ + (size_t)i * DM * DM : WOUTE_ + (size_t)i * DM * DM, X_, mods_l + 2 * DM, lds);
        } else {
            ph_route_mfma(QP_, KEYS_ + (size_t)l * 8 * 2 * 128 * 64, IDX_, GATE_, lds, RT);
            if (DUP_ROUTE) ph_route_mfma(QP_, KEYS_ + (size_t)l * 8 * 2 * 128 * 64, IDX_, GATE_, lds, RT);
            grid.sync();
            ph_peer_ffn8(A_, IDX_, GATE_, T8_ + (size_t)l * 16384 * DM, RS_ + l * 16384, T8_ + (size_t)(DEPTH + l) * 16384 * DM, RS_ + (DEPTH + l) * 16384, mods_l, X_, RT);
            if (DUP_FFN) ph_peer_ffn8(A_, IDX_, GATE_, T8_ + (size_t)l * 16384 * DM, RS_ + l * 16384, T8_ + (size_t)(DEPTH + l) * 16384 * DM, RS_ + (DEPTH + l) * 16384, mods_l, OF_, RT);
        }
        grid.sync();
    }
    ph_copy_out(X_, p.out);
}

extern "C" void kernel_launch(void* const* d_in, const int* in_sizes, int n_in, void* d_out, int out_size, void* d_ws, size_t ws_size, hipStream_t stream) {
    static int grid_blocks = 0;
    if (!grid_blocks) {
        int dev = 0, cus = 0, per_cu = 0;
        (void)hipGetDevice(&dev);
        (void)hipDeviceGetAttribute(&cus, hipDeviceAttributeMultiprocessorCount, dev);
        (void)hipFuncSetAttribute((const void*)mega, hipFuncAttributeMaxDynamicSharedMemorySize, LDS_BYTES);
        (void)hipOccupancyMaxActiveBlocksPerMultiprocessor(&per_cu, mega, NT, LDS_BYTES);
        if (per_cu < 1) fprintf(stderr, "occupancy query says %d blocks/CU\n", per_cu);
        grid_blocks = cus;
        if (ws_size < WS_END) fprintf(stderr, "workspace too small: %zu < %zu\n", ws_size, (size_t)WS_END);
    }
    Params p{};
    for (int i = 0; i < 27; ++i) p.in[i] = (const float*)d_in[i];
    p.out = (float*)d_out; p.ws = (unsigned char*)d_ws;
    void* args[] = {&p};
    hipError_t e = hipLaunchCooperativeKernel((void*)mega, dim3(grid_blocks), dim3(NT), args, LDS_BYTES, stream);
    if (e != hipSuccess) fprintf(stderr, "cooperative launch failed: %s (grid %d)\n", hipGetErrorString(e), grid_blocks);
}
```

```cpp
#include <hip/hip_runtime.h>
#include <hip/hip_cooperative_groups.h>
#include <stdint.h>
#include <cstdio>
namespace cg = cooperative_groups;

#define DM 1024
#define NB 16
#define SEQ 2048
#define CTX 256
#define RL (NB * SEQ)
#define RC (NB * CTX)
#define RT (RL + RC)
#define DEPTH 4
#define EVEN_IN 3104
#define EVEN_LDP 3328
#define ODD_IN 1536
#define NMOD 17
#define MODW 6144
#define NT 512
#define NWV 8
#define LDS_BYTES 147456
#ifndef DUP_FFN
#define DUP_FFN 0
#endif
#ifndef DUP_ROUTE
#define DUP_ROUTE 0
#endif
#ifndef DUP_ATTN
#define DUP_ATTN 0
#endif
#ifndef DUP_GEMM
#define DUP_GEMM 0
#endif

typedef unsigned short bf16;
typedef float f32x2_t __attribute__((ext_vector_type(2)));
typedef __bf16 bf16x2_t __attribute__((ext_vector_type(2)));
struct Params {
    const float* in[27];
    float* out;
    unsigned char* ws;
};

__device__ __forceinline__ int row_mod(int r) { return r < RL ? (r >> 11) : 16; }
__device__ __forceinline__ float silu_f(float x) { return x / (1.f + expf(-x)); }
__device__ __forceinline__ float wave_sum(float v) {
#pragma unroll
    for (int o = 1; o < 64; o <<= 1) v += __shfl_xor(v, o);
    return v;
}
__device__ __forceinline__ float log_sigmoid_f(float z) { return fminf(z, 0.f) - log1pf(expf(-fabsf(z))); }
__device__ __forceinline__ float gelu_tanh(float x) { float u = 0.7978845608028654f * (x + 0.044715f * x * x * x); return 0.5f * x * (1.f + tanhf(u)); }
__device__ __forceinline__ float bf2f(bf16 v) { return __uint_as_float((unsigned)v << 16); }
__device__ __forceinline__ unsigned f2bf(float f) { unsigned u = __float_as_uint(f); return (u + 0x7fffu + ((u >> 16) & 1u)) >> 16; }
__device__ __forceinline__ unsigned pk2(float lo, float hi) { return f2bf(lo) | (f2bf(hi) << 16); }
__device__ __forceinline__ float4 ld4bf(const bf16* p) { uint2 u = *(const uint2*)p; return make_float4(__uint_as_float(u.x << 16), __uint_as_float(u.x & 0xffff0000u), __uint_as_float(u.y << 16), __uint_as_float(u.y & 0xffff0000u)); }
__device__ __forceinline__ void st4bf(bf16* p, float4 v) { *(uint2*)p = make_uint2(pk2(v.x, v.y), pk2(v.z, v.w)); }
__device__ __forceinline__ float2 ld2bf(const bf16* p) { unsigned u = *(const unsigned*)p; return make_float2(__uint_as_float(u << 16), __uint_as_float(u & 0xffff0000u)); }
__device__ __forceinline__ void st2bf(bf16* p, float2 v) { *(unsigned*)p = pk2(v.x, v.y); }

__device__ __forceinline__ int opaque_tid() { int t = threadIdx.x; asm volatile("" : "+v"(t)); return t; }
__device__ __forceinline__ int opaque_bid() { int b = blockIdx.x; asm volatile("" : "+s"(b)); return b; }

namespace pg8 {
#define PG8_LAS __attribute__((address_space(3)))
typedef unsigned short bf16_t;
typedef short bf16x8 __attribute__((ext_vector_type(8)));
typedef float f32x4 __attribute__((ext_vector_type(4)));
typedef unsigned u32x4 __attribute__((ext_vector_type(4)));
constexpr int BM = 256, BK = 64, HALF = 128, HTB = HALF * BK * 2  , STAGE_BYTES = 8 * HTB, NXCD = 8, WGM = 8;

__host__ __device__ __forceinline__ int lds_byte(int r, int c) { const int st = (r >> 4) * 2 + (c >> 5), rr = r & 15, cc = c & 31, ob = rr * 64 + cc * 2; return st * 1024 + (ob ^ (((ob >> 9) & 1) << 5)); }
__host__ __device__ __forceinline__ void stage_rc(int b, int& R, int& C) { const int st = b / 1024, sb = b % 1024, swz = sb ^ (((sb >> 9) & 1) << 5); R = (st >> 1) * 16 + swz / 64; C = (st & 1) * 32 + (swz % 64) / 2; }
__host__ __device__ __forceinline__ int perm32(int rho) { const int n = rho >> 4, i = rho & 15; return 8 * (i >> 2) + 4 * n + (i & 3); }

struct Unit { int pm, pn; };
struct Gemm { const bf16_t* A; const bf16_t* Bt; int M, N, K; };

struct StaticOrder {
    int nM, nN, nwg, G, c;
    __host__ __device__ void init(int M, int N, int G_, int c_) { nM = M / BM; nN = N / BM; nwg = nM * nN; G = G_; c = c_; }
    __host__ __device__ bool next(int i, Unit& u) const {
        const long L = (long)i * G + c; if (L >= nwg) return false;
        int wgid = (int)L; { const int q = nwg / NXCD, r = nwg % NXCD, xcd = wgid % NXCD, off = wgid / NXCD; wgid = (xcd < r ? xcd * (q + 1) : r * (q + 1) + (xcd - r) * q) + off; }
        const int nig = WGM * nN, gid = wgid / nig, fm = gid * WGM, gsz = (nM - fm) < WGM ? (nM - fm) : WGM;
        u.pm = fm + ((wgid % nig) % gsz); u.pn = (wgid % nig) / gsz; return true;
    }
    __device__ __forceinline__ void a_ready(const Unit&) const {}
    __device__ __forceinline__ void done(const Unit&) const {}
};

__device__ __forceinline__ unsigned cvt_pk_bf16(float lo, float hi) { unsigned r; asm volatile("v_cvt_pk_bf16_f32 %0, %1, %2" : "=v"(r) : "v"(lo), "v"(hi)); return r; }
typedef float f32x2 __attribute__((ext_vector_type(2)));
__device__ __forceinline__ f32x2 gelu_pk(f32x2 v) {
    const f32x2 av = __builtin_elementwise_abs(v), d = av * 0.2316418882f + 1.0f;
    f32x2 t; t.x = __builtin_amdgcn_rcpf(d.x); t.y = __builtin_amdgcn_rcpf(d.y);
    f32x2 q = t * 0.5307027145f + (-0.7265760135f); q = q * t + 0.7107068705f; q = q * t + (-0.142248368f); q = q * t + 0.127414796f; q = q * t;
    const f32x2 s = (v * v) * (-0.72134752044f);
    f32x2 e; e.x = __builtin_amdgcn_exp2f(s.x); e.y = __builtin_amdgcn_exp2f(s.y);
    const f32x2 m = v * (q * e), r = v - m;
    f32x2 o; o.x = v.x < 0.f ? m.x : r.x; o.y = v.y < 0.f ? m.y : r.y; return o;
}

template <int ACT  > struct EpiBf16 {
    static constexpr bool PERM = true, AFTER_DRAIN = false; static_assert(ACT == 0 || ACT == 1, "EpiBf16: ACT is 0 (none) or 1 (gelu_pk)");
    bf16_t* O; int ldc; const float* bias; int split_cols; size_t split_stride; float scale0;
    __device__ __forceinline__ void operator()(const f32x4 (&acc)[2][2][4][2], const Unit& u, int wr, int wc, int fr, int fq) const {
        const int row0 = u.pm * BM + wr * 64 + fr; int colt = u.pn * BM; bf16_t* base = O;
        float sc = 1.f; if (split_cols) { const int t = colt / split_cols; base += (size_t)t * split_stride; colt -= t * split_cols; if (t == 0) sc = scale0; }
        const int col0 = colt + wc * 32 + 8 * fq, bcol0 = u.pn * BM + wc * 32 + 8 * fq;
        f32x4 bv[2][2];
#pragma unroll
        for (int bj = 0; bj < 2; ++bj)
#pragma unroll
            for (int n = 0; n < 2; ++n) bv[bj][n] = bias ? *(const f32x4*)(bias + bcol0 + bj * HALF + 4 * n) : (f32x4){0.f, 0.f, 0.f, 0.f};
#pragma unroll
        for (int ai = 0; ai < 2; ++ai)
#pragma unroll
            for (int m = 0; m < 4; ++m) { bf16_t* rowp = base + (size_t)(row0 + ai * HALF + m * 16) * ldc + col0;
#pragma unroll
                for (int bj = 0; bj < 2; ++bj) { f32x4 v0 = acc[ai][bj][m][0] + bv[bj][0], v1 = acc[ai][bj][m][1] + bv[bj][1];
                    if (ACT == 1) { f32x2 a = gelu_pk((f32x2){v0[0], v0[1]}), b = gelu_pk((f32x2){v0[2], v0[3]}), c = gelu_pk((f32x2){v1[0], v1[1]}), d = gelu_pk((f32x2){v1[2], v1[3]});
                        v0 = (f32x4){a.x, a.y, b.x, b.y}; v1 = (f32x4){c.x, c.y, d.x, d.y}; }
                    v0 = v0 * sc; v1 = v1 * sc; u32x4 w; w.x = cvt_pk_bf16(v0[0], v0[1]); w.y = cvt_pk_bf16(v0[2], v0[3]); w.z = cvt_pk_bf16(v1[0], v1[1]); w.w = cvt_pk_bf16(v1[2], v1[3]);
                    *(u32x4*)(rowp + bj * HALF) = w; } }
    }
};
template <class Epi, class Sched, bool ALIGN_EPI = false, bool SP2 = false>
__device__ __forceinline__ void gemm_phase(PG8_LAS unsigned char* lds, const Gemm g, const Sched& S, const Epi& E) {
    const int tid = opaque_tid(), wid = __builtin_amdgcn_readfirstlane(tid >> 6), lane = tid & 63, wr = wid >> 2, wc = wid & 3, fr = lane & 15, fq = lane >> 4;
    const int K = g.K, nt = K / BK;
    unsigned voffA[2], voffB[2];
#pragma unroll
    for (int i = 0; i < 2; ++i) { int R, C; stage_rc(tid * 16 + i * 8192, R, C); const int Rb = Epi::PERM ? ((R & ~31) + perm32(R & 31)) : R;
        voffA[i] = (unsigned)(R * K + C) * 2u; voffB[i] = (unsigned)(Rb * K + C) * 2u; }
    const size_t kstep = (size_t)(BK * 2);
    const size_t hstep = (size_t)HALF * K * 2;
    const size_t tstep = 2 * hstep;
    const unsigned ldsw = (unsigned)wid * 1024u;
    const int aoff = lds_byte(wr * 64 + fr, fq * 8), boff = lds_byte(wc * 32 + fr, fq * 8);
#define PG8_SA(b, h) (((b) * 2 + (h)) * HTB)
#define PG8_SB(b, h) ((4 + (b) * 2 + (h)) * HTB)
#define PG8_STAGE(bufoff, gbase, voff) do { _Pragma("unroll") for (int _i = 0; _i < 2; ++_i) \
        __builtin_amdgcn_global_load_lds((const unsigned*)((const char*)(gbase) + (voff)[_i]), (PG8_LAS unsigned*)(lds + (bufoff) + ldsw + _i * 8192), 16, 0, 0); } while (0)
#define PG8_LDA(dst, b, h) do { _Pragma("unroll") for (int m = 0; m < 4; ++m) _Pragma("unroll") for (int k = 0; k < 2; ++k) dst[m][k] = *(const PG8_LAS bf16x8*)(lds + PG8_SA(b, h) + aoff + m * 2048 + k * 1024); } while (0)
#define PG8_LDB(dst, b, h) do { _Pragma("unroll") for (int n = 0; n < 2; ++n) _Pragma("unroll") for (int k = 0; k < 2; ++k) dst[n][k] = *(const PG8_LAS bf16x8*)(lds + PG8_SB(b, h) + boff + n * 2048 + k * 1024); } while (0)
#define PG8_MMA(ai, bj, At, Bt) do { __builtin_amdgcn_s_setprio(1); _Pragma("unroll") for (int m = 0; m < 4; ++m) _Pragma("unroll") for (int n = 0; n < 2; ++n) _Pragma("unroll") for (int k = 0; k < 2; ++k) \
        acc[ai][bj][m][n] = __builtin_amdgcn_mfma_f32_16x16x32_bf16(Bt[n][k], At[m][k], acc[ai][bj][m][n], 0, 0, 0); __builtin_amdgcn_s_setprio(0); } while (0)
#define PG8_WAIT_V(n) asm volatile("s_waitcnt vmcnt(" #n ")" ::: "memory")
#define PG8_WAIT_L(n) asm volatile("s_waitcnt lgkmcnt(" #n ")" ::: "memory")
#define PG8_BAR __builtin_amdgcn_s_barrier()
#define PG8_SCHED __builtin_amdgcn_sched_barrier(0)
    Unit cur, nxt; int ui = 0;
    if (!S.next(0, cur)) return;
    f32x4 acc[2][2][4][2];
#pragma unroll
    for (int a = 0; a < 2; ++a)
#pragma unroll
        for (int b = 0; b < 2; ++b)
#pragma unroll
            for (int m = 0; m < 4; ++m)
#pragma unroll
                for (int n = 0; n < 2; ++n) acc[a][b][m][n] = (f32x4){0.f, 0.f, 0.f, 0.f};
    bf16x8 At[4][2], B0[2][2], B1[2][2];
    const char* cA = (const char*)g.A + (size_t)cur.pm * tstep; const char* cB = (const char*)g.Bt + (size_t)cur.pn * tstep;
    S.a_ready(cur);
    if constexpr (SP2) {
        PG8_STAGE(PG8_SB(0, 0), cB, voffB); PG8_STAGE(PG8_SB(0, 1), cB + hstep, voffB); PG8_STAGE(PG8_SA(0, 0), cA, voffA); PG8_STAGE(PG8_SA(0, 1), cA + hstep, voffA);
        if (wr == 1) PG8_BAR;
        PG8_WAIT_V(2); PG8_BAR;
        PG8_STAGE(PG8_SB(1, 0), cB + kstep, voffB); PG8_STAGE(PG8_SA(1, 0), cA + kstep, voffA); PG8_STAGE(PG8_SB(1, 1), cB + hstep + kstep, voffB);
        PG8_WAIT_V(6); PG8_BAR;
    } else {
        PG8_STAGE(PG8_SB(0, 0), cB, voffB); PG8_STAGE(PG8_SA(0, 0), cA, voffA); PG8_STAGE(PG8_SB(0, 1), cB + hstep, voffB); PG8_STAGE(PG8_SA(0, 1), cA + hstep, voffA);
        if (wr == 1) PG8_BAR;
        PG8_WAIT_V(4); PG8_BAR;
        PG8_STAGE(PG8_SB(1, 0), cB + kstep, voffB); PG8_STAGE(PG8_SA(1, 0), cA + kstep, voffA); PG8_STAGE(PG8_SB(1, 1), cB + hstep + kstep, voffB);
        PG8_WAIT_V(6); PG8_BAR;
    }
    for (;;) {
        const bool has_next = S.next(ui + 1, nxt);
        const char* nA = has_next ? (const char*)g.A + (size_t)nxt.pm * tstep : cA; const char* nB = has_next ? (const char*)g.Bt + (size_t)nxt.pn * tstep : cB;
        for (int t = 0; t < nt; t += 2) {
            const bool last = (t == nt - 2);
            const char* a1 = cA + (size_t)(t + 1) * kstep;
            const char* a2 = last ? nA : cA + (size_t)(t + 2) * kstep; const char* b2 = last ? nB : cB + (size_t)(t + 2) * kstep;
            const char* a3 = a2 + kstep; const char* b3 = b2 + kstep;
            if (last && has_next) S.a_ready(nxt);
            if constexpr (SP2) {
            PG8_LDB(B0, 0, 0); PG8_LDB(B1, 0, 1); PG8_SCHED; PG8_LDA(At, 0, 0); PG8_STAGE(PG8_SA(1, 1), a1 + hstep, voffA);
            PG8_WAIT_V(8); PG8_WAIT_L(0); PG8_BAR; PG8_MMA(0, 0, At, B0); PG8_MMA(0, 1, At, B1); PG8_BAR; PG8_SCHED;
            PG8_LDA(At, 0, 1); PG8_STAGE(PG8_SB(0, 0), b2, voffB); PG8_STAGE(PG8_SB(0, 1), b2 + hstep, voffB); PG8_STAGE(PG8_SA(0, 0), a2, voffA);
            PG8_WAIT_V(8); PG8_WAIT_L(0); PG8_BAR; PG8_MMA(1, 0, At, B0); PG8_MMA(1, 1, At, B1); PG8_BAR; PG8_SCHED;
            PG8_LDB(B0, 1, 0); PG8_LDB(B1, 1, 1); PG8_SCHED; PG8_LDA(At, 1, 0); PG8_STAGE(PG8_SA(0, 1), a2 + hstep, voffA);
            PG8_WAIT_V(8); PG8_WAIT_L(0); PG8_BAR; PG8_MMA(0, 0, At, B0); PG8_MMA(0, 1, At, B1); PG8_BAR; PG8_SCHED;
            PG8_LDA(At, 1, 1); PG8_STAGE(PG8_SB(1, 0), b3, voffB); PG8_STAGE(PG8_SB(1, 1), b3 + hstep, voffB); PG8_STAGE(PG8_SA(1, 0), a3, voffA);
            PG8_WAIT_V(8); PG8_WAIT_L(0); PG8_BAR; PG8_MMA(1, 0, At, B0); PG8_MMA(1, 1, At, B1); PG8_BAR; PG8_SCHED;
            } else {
            PG8_LDB(B0, 0, 0); PG8_SCHED; PG8_LDA(At, 0, 0); PG8_STAGE(PG8_SA(1, 1), a1 + hstep, voffA);
            PG8_WAIT_L(8); PG8_BAR; PG8_WAIT_L(0); PG8_MMA(0, 0, At, B0); PG8_BAR; PG8_SCHED;
            PG8_LDB(B1, 0, 1); PG8_STAGE(PG8_SB(0, 0), b2, voffB);
            PG8_BAR; PG8_WAIT_L(0); PG8_MMA(0, 1, At, B1); PG8_BAR;
            PG8_LDA(At, 0, 1); PG8_STAGE(PG8_SA(0, 0), a2, voffA);
            PG8_BAR; PG8_WAIT_L(0); PG8_MMA(1, 0, At, B0); PG8_BAR; PG8_SCHED;
            PG8_STAGE(PG8_SB(0, 1), b2 + hstep, voffB);
            PG8_WAIT_V(6); PG8_BAR; PG8_MMA(1, 1, At, B1); PG8_BAR;
            PG8_LDB(B0, 1, 0); PG8_SCHED; PG8_LDA(At, 1, 0); PG8_STAGE(PG8_SA(0, 1), a2 + hstep, voffA);
            PG8_WAIT_L(8); PG8_BAR; PG8_WAIT_L(0); PG8_MMA(0, 0, At, B0); PG8_BAR; PG8_SCHED;
            PG8_LDB(B1, 1, 1); PG8_STAGE(PG8_SB(1, 0), b3, voffB);
            PG8_BAR; PG8_WAIT_L(0); PG8_MMA(0, 1, At, B1); PG8_BAR;
            PG8_LDA(At, 1, 1); PG8_STAGE(PG8_SA(1, 0), a3, voffA);
            PG8_BAR; PG8_WAIT_L(0); PG8_MMA(1, 0, At, B0); PG8_BAR; PG8_SCHED;
            PG8_STAGE(PG8_SB(1, 1), b3 + hstep, voffB);
            PG8_WAIT_V(6); PG8_BAR; PG8_MMA(1, 1, At, B1); PG8_BAR;
            }
        }
        if constexpr (ALIGN_EPI) { if (wr == 0) PG8_BAR; }
        if constexpr (!Epi::AFTER_DRAIN) { E(acc, cur, wr, wc, fr, fq); S.done(cur); }
        if (!has_next) break;
#pragma unroll
        for (int a = 0; a < 2; ++a)
#pragma unroll
            for (int b = 0; b < 2; ++b)
#pragma unroll
                for (int m = 0; m < 4; ++m)
#pragma unroll
                    for (int n = 0; n < 2; ++n) acc[a][b][m][n] = (f32x4){0.f, 0.f, 0.f, 0.f};
        cur = nxt; cA = nA; cB = nB; ++ui;
        if constexpr (ALIGN_EPI) { if (wr == 1) PG8_BAR; }
    }
    PG8_WAIT_V(0);
    if constexpr (!ALIGN_EPI) { if (wr == 0) PG8_BAR; }
    PG8_BAR;
    if constexpr (Epi::AFTER_DRAIN) { E.fused(acc, cur, wr, wc, fr, fq, lds, wid, lane); S.done(cur); }
#undef PG8_SA
#undef PG8_SB
#undef PG8_STAGE
#undef PG8_LDA
#undef PG8_LDB
#undef PG8_MMA
#undef PG8_WAIT_V
#undef PG8_WAIT_L
#undef PG8_BAR
#undef PG8_SCHED
}
}

struct EpiResGate {
    static constexpr bool PERM = false, AFTER_DRAIN = false;
    float* X; const float* gate;
    __device__ __forceinline__ void operator()(const pg8::f32x4 (&acc)[2][2][4][2], const pg8::Unit& u, int wr, int wc, int fr, int fq) const {
#pragma unroll
        for (int ai = 0; ai < 2; ++ai)
#pragma unroll
            for (int m = 0; m < 4; ++m) {
                const int r = u.pm * 256 + ai * 128 + wr * 64 + m * 16 + fr;
                const float* g = gate + (size_t)row_mod(r) * MODW; float* xr = X + (size_t)r * DM;
#pragma unroll
                for (int bj = 0; bj < 2; ++bj)
#pragma unroll
                    for (int n = 0; n < 2; ++n) {
                        const int c = u.pn * 256 + bj * 128 + wc * 32 + n * 16 + 4 * fq;
                        pg8::f32x4 xv = *(const pg8::f32x4*)(xr + c); const pg8::f32x4 gv = *(const pg8::f32x4*)(g + c);
                        xv = xv + gv * acc[ai][bj][m][n];
                        *(pg8::f32x4*)(xr + c) = xv;
                    }
            }
    }
};
#define LAS __attribute__((address_space(3)))
#define GAS __attribute__((address_space(1)))

__device__ __forceinline__ void ph_copy_in(const float* __restrict__ x, const float* __restrict__ ctx, float* __restrict__ X) {
    const int TID = opaque_tid(), BID = opaque_bid();
    size_t i = (size_t)BID * NT + TID;
    const size_t n4 = (size_t)RT * DM / 4, nl4 = (size_t)RL * DM / 4;
    for (; i < n4; i += (size_t)gridDim.x * NT) ((float4*)X)[i] = i < nl4 ? ((const float4*)x)[i] : ((const float4*)ctx)[i - nl4];
}
__device__ __forceinline__ void ph_copy_out(const float* __restrict__ X, float* __restrict__ out) {
    const int TID = opaque_tid(), BID = opaque_bid();
    size_t i = (size_t)BID * NT + TID;
    const size_t n4 = (size_t)RL * DM / 4;
    for (; i < n4; i += (size_t)gridDim.x * NT) ((float4*)out)[i] = ((const float4*)X)[i];
}
__device__ __forceinline__ void ph_rope_table(float2* __restrict__ rope) {
    const int TID = opaque_tid(), BID = opaque_bid();
    for (int i = BID * NT + TID; i < SEQ * 32; i += gridDim.x * NT) {
        int t = i >> 5, a = (i >> 4) & 1, f = i & 15;
        float pos = a == 0 ? (float)(t >> 6) : (float)(t & 63);
        float inv = powf(10000.f, -(float)f / 16.f);
        float ang = pos * inv;
        rope[i] = make_float2(cosf(ang), sinf(ang));
    }
}
__device__ __forceinline__ void transpose_item(const float* __restrict__ W, int N, bf16* __restrict__ WT, LAS float* scr, int item, int lane) {
    const int K = DM;
    const int nblk = N / 32, kb = item / nblk, nb = item % nblk, k0 = 64 * kb, n0 = 32 * nb;
#pragma unroll 8
    for (int i = 0; i < 32; ++i) { const int kk = 2 * i + (lane >> 5); scr[kk * 33 + (lane & 31)] = W[(size_t)(k0 + kk) * N + n0 + (lane & 31)]; }
    asm volatile("s_waitcnt lgkmcnt(0)" ::: "memory");
    const int c = lane & 7;
#pragma unroll
    for (int j = 0; j < 4; ++j) { const int n = (lane >> 3) + 8 * j; const LAS float* s = scr + (8 * c) * 33 + n;
        uint4 o; o.x = pk2(s[0 * 33], s[1 * 33]); o.y = pk2(s[2 * 33], s[3 * 33]); o.z = pk2(s[4 * 33], s[5 * 33]); o.w = pk2(s[6 * 33], s[7 * 33]);
        *(uint4*)(WT + (size_t)(n0 + n) * K + k0 + 8 * c) = o; }
    asm volatile("s_waitcnt lgkmcnt(0)" ::: "memory");
}
struct WPrep { const float* src[12]; bf16* dst[12]; };
__device__ __forceinline__ void ph_weight_prep(const float* const* in, bf16* WinE, bf16* WoutE, bf16* WinO, bf16* WoutO, bf16* Wpq, bf16* Kb, unsigned char* lds) {
    const int TID = opaque_tid(), BID = opaque_bid();
    const int lane = TID & 63, wv = TID >> 6;
    LAS float* scr = (LAS float*)((LAS unsigned char*)lds + wv * 16384);
    const int gw = BID * NWV + wv, NGW = gridDim.x * NWV;
    const int NITEMS = 2 * 1552 + 2 * 512 + 2 * 768 + 2 * 512 + 4 * 512;
    for (int it = gw; it < NITEMS; it += NGW) {
        int r = it;
        if (r < 3104) { int i = r / 1552; transpose_item(in[8] + (size_t)i * DM * EVEN_IN, EVEN_IN, WinE + (size_t)i * EVEN_LDP * DM, scr, r % 1552, lane); continue; } r -= 3104;
        if (r < 1024) { int i = r / 512; transpose_item(in[9] + (size_t)i * DM * DM, DM, WoutE + (size_t)i * DM * DM, scr, r % 512, lane); continue; } r -= 1024;
        if (r < 1536) { int i = r / 768; transpose_item(in[19] + (size_t)i * DM * ODD_IN, ODD_IN, WinO + (size_t)i * ODD_IN * DM, scr, r % 768, lane); continue; } r -= 1536;
        if (r < 1024) { int i = r / 512; transpose_item(in[20] + (size_t)i * DM * DM, DM, WoutO + (size_t)i * DM * DM, scr, r % 512, lane); continue; } r -= 1024;
        { int i = r / 512; transpose_item(in[23] + (size_t)i * DM * DM, DM, Wpq + (size_t)i * DM * DM, scr, r % 512, lane); }
    }
    for (int i4 = BID * NT + TID; i4 < DEPTH * 8 * 2 * 128 * 64 / 4; i4 += gridDim.x * NT) st4bf(Kb + 4 * (size_t)i4, ((const float4*)in[24])[i4]);
    for (int i = BID * NT + TID; i < 2 * 28672; i += gridDim.x * NT) {
        int w = i / 28672, o = i % 28672;
        ((uint4*)(WinE + (size_t)w * EVEN_LDP * DM + (size_t)EVEN_IN * DM))[o] = make_uint4(0u, 0u, 0u, 0u);
    }
}
__device__ __forceinline__ void ph_mods(const float* __restrict__ c, const float* __restrict__ cctx, const float* __restrict__ w_mod,
                        const float* __restrict__ b_mod, float* __restrict__ mods, float* smem) {
    const int TID = opaque_tid(), BID = opaque_bid();
    const int nvb = DEPTH * MODW / NT;
    if (BID >= nvb) return;
    float (*S)[DM] = (float (*)[DM])smem;
    for (int i = TID; i < NMOD * DM; i += NT) {
        int j = i / DM, k = i % DM;
        float v = j < 16 ? c[j * DM + k] : cctx[k];
        S[j][k] = silu_f(v);
    }
    __syncthreads();
    for (int vb = BID; vb < nvb; vb += gridDim.x) {
        int idx = vb * NT + TID, l = idx / MODW, n = idx % MODW;
        const float* W = w_mod + (size_t)l * DM * MODW;
        float acc[NMOD];
#pragma unroll
        for (int j = 0; j < NMOD; ++j) acc[j] = 0.f;
        for (int k = 0; k < DM; ++k) {
            float w = W[(size_t)k * MODW + n];
#pragma unroll
            for (int j = 0; j < NMOD; ++j) acc[j] += S[j][k] * w;
        }
        float b = b_mod[l * MODW + n];
#pragma unroll
        for (int j = 0; j < NMOD; ++j) mods[((size_t)l * NMOD + j) * MODW + n] = acc[j] + b;
    }
    __syncthreads();
}
__device__ __forceinline__ void ph_norm_mod(const float* __restrict__ X, const float* __restrict__ g, const float* __restrict__ mods_l, int shift_chunk, bf16* __restrict__ A) {
    const int TID = opaque_tid(), BID = opaque_bid();
    int wave = BID * NWV + (TID >> 6), lane = TID & 63;
    int nw = gridDim.x * NWV;
    for (int r = wave; r < RT; r += nw) {
        const float4* xr = (const float4*)(X + (size_t)r * DM);
        float4 v[4]; float s = 0.f;
#pragma unroll
        for (int i = 0; i < 4; ++i) { v[i] = xr[lane + 64 * i]; s += v[i].x * v[i].x + v[i].y * v[i].y + v[i].z * v[i].z + v[i].w * v[i].w; }
        s = wave_sum(s);
        float rstd = rsqrtf(s * (1.f / DM) + 1e-6f);
        const float* m = mods_l + (size_t)row_mod(r) * MODW;
        const float4* sh = (const float4*)(m + shift_chunk * DM);
        const float4* sc = (const float4*)(m + (shift_chunk + 1) * DM);
        const float4* g4 = (const float4*)g;
        bf16* ar = A + (size_t)r * DM;
#pragma unroll
        for (int i = 0; i < 4; ++i) {
            int c = lane + 64 * i;
            float4 gg = g4[c], a = sh[c], b = sc[c], o;
            o.x = v[i].x * rstd * gg.x * (1.f + b.x) + a.x;
            o.y = v[i].y * rstd * gg.y * (1.f + b.y) + a.y;
            o.z = v[i].z * rstd * gg.z * (1.f + b.z) + a.z;
            o.w = v[i].w * rstd * gg.w * (1.f + b.w) + a.w;
            st4bf(ar + 4 * c, o);
        }
    }
}
#define KVLEN (CTX + SEQ)
__device__ __forceinline__ void ph_post(bf16* __restrict__ P, int ldp, int nq, int kcol0, int nk, int vcol0, int VC, int DV,
                                        const float* __restrict__ qgain, const float* __restrict__ kgain, const float2* __restrict__ rope,
                                        bf16* __restrict__ Kc, bf16* __restrict__ Vt) {
    const int TID = opaque_tid(), BID = opaque_bid();
    const float C2 = 0.125f * 1.4426950408889634f;
    for (int tile = BID; tile < RT / 64; tile += gridDim.x) {
        const int r0 = tile * 64;
        int b, j0;
        if (r0 < RL) { b = r0 >> 11; j0 = CTX + (r0 & (SEQ - 1)); } else { b = (r0 - RL) >> 8; j0 = (r0 - RL) & (CTX - 1); }
        const int nh = nq + nk;
        for (int it = TID; it < 64 * nh; it += NT) {
            const int row = it / nh, hh = it % nh, r = r0 + row;
            const bool isk = hh >= nq; const int h = isk ? hh - nq : hh;
            bf16* src = P + (size_t)r * ldp + (isk ? kcol0 : 0) + h * 64;
            const float* gain = isk ? kgain : qgain;
            float v[64]; float s = 0.f;
#pragma unroll
            for (int i = 0; i < 16; ++i) { float4 t = ld4bf(src + 4 * i); v[4 * i] = t.x; v[4 * i + 1] = t.y; v[4 * i + 2] = t.z; v[4 * i + 3] = t.w; }
#pragma unroll
            for (int i = 0; i < 64; ++i) s += v[i] * v[i];
            const float rstd = rsqrtf(s * (1.f / 64.f) + 1e-6f) * (isk ? 1.f : C2);
#pragma unroll
            for (int i = 0; i < 64; ++i) v[i] = v[i] * rstd * gain[i];
            if (r < RL) {
                const float2* tab = rope + (size_t)(r & (SEQ - 1)) * 32;
#pragma unroll
                for (int a = 0; a < 2; ++a)
#pragma unroll
                    for (int f = 0; f < 16; ++f) {
                        float2 cs = tab[a * 16 + f];
                        float x1 = v[a * 32 + f], x2 = v[a * 32 + 16 + f];
                        v[a * 32 + f] = x1 * cs.x - x2 * cs.y;
                        v[a * 32 + 16 + f] = x2 * cs.x + x1 * cs.y;
                    }
            }
            bf16* dst = isk ? Kc + ((size_t)(b * nk + h) * KVLEN + j0 + row) * 64 : src;
#pragma unroll
            for (int i = 0; i < 16; ++i) st4bf(dst + 4 * i, make_float4(v[4 * i], v[4 * i + 1], v[4 * i + 2], v[4 * i + 3]));
        }
        if (TID < VC) {
            const int c8 = TID >> 3, rg = TID & 7;
            unsigned in[8][4];
#pragma unroll
            for (int rr = 0; rr < 8; ++rr) { uint4 t = *(const uint4*)(P + (size_t)(r0 + rg * 8 + rr) * ldp + vcol0 + c8 * 8); in[rr][0] = t.x; in[rr][1] = t.y; in[rr][2] = t.z; in[rr][3] = t.w; }
#pragma unroll
            for (int c = 0; c < 8; ++c) {
                unsigned o[4];
#pragma unroll
                for (int q = 0; q < 4; ++q)
                    o[q] = (c & 1) ? __builtin_amdgcn_perm(in[2 * q + 1][c >> 1], in[2 * q][c >> 1], 0x07060302u) : __builtin_amdgcn_perm(in[2 * q + 1][c >> 1], in[2 * q][c >> 1], 0x05040100u);
                const int col = c8 * 8 + c, vh = col / DV, d = col % DV;
                *(uint4*)(Vt + ((size_t)(b * 4 + vh) * DV + d) * KVLEN + j0 + rg * 8) = make_uint4(o[0], o[1], o[2], o[3]);
            }
        }
    }
}
typedef short bf16x8 __attribute__((ext_vector_type(8)));
typedef float f32x16 __attribute__((ext_vector_type(16)));
__device__ __forceinline__ int crow(int r, int hi) { return (r & 3) + 8 * (r >> 2) + 4 * hi; }
__device__ __forceinline__ unsigned cvt_pk_bf16_f32(float lo, float hi) { f32x2_t v = {lo, hi}; bf16x2_t b = __builtin_convertvector(v, bf16x2_t); return __builtin_bit_cast(unsigned, b); }
#define ATT_KPITCH 144
#define ATT_VPITCH 136
template <int DV>
__device__ __forceinline__ void attn_unit(const bf16* __restrict__ Qbase, int ldq, const bf16* __restrict__ Kc, const bf16* __restrict__ Vt, int ntiles,
                                          bf16* __restrict__ Obase, int ldo, unsigned char* lds, int tid) {
    constexpr int NDB = DV / 32, NVL = DV / 64, KBYTES = 64 * ATT_KPITCH, BUFSZ = KBYTES + DV * ATT_VPITCH;
    constexpr float THR = 8.f;
    const int lane = tid & 63, wid = tid >> 6, r32 = lane & 31, hi = lane >> 5;
    float* sc = (float*)(lds + 2 * BUFSZ + wid * 128);
    bf16x8 qf[4];
    {
        const bf16* qrow = Qbase + (size_t)(wid * 32 + r32) * ldq;
#pragma unroll
        for (int s = 0; s < 4; ++s) qf[s] = *(const bf16x8*)(qrow + 16 * s + 8 * hi);
    }
    f32x16 o[NDB];
#pragma unroll
    for (int d = 0; d < NDB; ++d)
#pragma unroll
        for (int r = 0; r < 16; ++r) o[d][r] = 0.f;
    float m = -1e30f, l = 0.f;
    uint4 kreg, vreg[NVL];
    const int krow = tid >> 3, kch = tid & 7;
#define ATT_LOAD(t) do { kreg = *(const uint4*)(Kc + (size_t)(t) * 64 * 64 + tid * 8); \
        _Pragma("unroll") for (int u = 0; u < NVL; ++u) { const int idx = tid + NT * u; vreg[u] = *(const uint4*)(Vt + (size_t)(idx >> 3) * KVLEN + (t) * 64 + (idx & 7) * 8); } } while (0)
#define ATT_STORE(buf) do { *(uint4*)(lds + (buf) * BUFSZ + krow * ATT_KPITCH + kch * 16) = kreg; \
        _Pragma("unroll") for (int u = 0; u < NVL; ++u) { const int idx = tid + NT * u; unsigned char* vp = lds + (buf) * BUFSZ + KBYTES + (idx >> 3) * ATT_VPITCH + (idx & 7) * 16; \
            *(uint2*)vp = make_uint2(vreg[u].x, vreg[u].y); *(uint2*)(vp + 8) = make_uint2(vreg[u].z, vreg[u].w); } } while (0)
    ATT_LOAD(0);
    ATT_STORE(0);
    __syncthreads();
    for (int t = 0; t < ntiles; ++t) {
        const int buf = t & 1;
        if (t + 1 < ntiles) ATT_LOAD(t + 1);
        const unsigned char* kb = lds + buf * BUFSZ;
        const unsigned char* vb = kb + KBYTES;
        f32x16 s0, s1;
#pragma unroll
        for (int r = 0; r < 16; ++r) { s0[r] = 0.f; s1[r] = 0.f; }
#pragma unroll
        for (int s = 0; s < 4; ++s) {
            const bf16x8 a0 = *(const bf16x8*)(kb + r32 * ATT_KPITCH + s * 32 + hi * 16);
            const bf16x8 a1 = *(const bf16x8*)(kb + (32 + r32) * ATT_KPITCH + s * 32 + hi * 16);
            s0 = __builtin_amdgcn_mfma_f32_32x32x16_bf16(a0, qf[s], s0, 0, 0, 0);
            s1 = __builtin_amdgcn_mfma_f32_32x32x16_bf16(a1, qf[s], s1, 0, 0, 0);
        }
        float tm = fmaxf(s0[0], s1[0]);
#pragma unroll
        for (int r = 1; r < 16; ++r) tm = fmaxf(tm, fmaxf(s0[r], s1[r]));
        tm = fmaxf(tm, __shfl_xor(tm, 32));
        if (__any(tm > m + THR)) {
            const float mn = fmaxf(m, tm), alpha = exp2f(m - mn);
            m = mn; l *= alpha;
            if (hi == 0) sc[r32] = alpha;
#pragma unroll
            for (int r = 0; r < 16; ++r) { const float a = sc[crow(r, hi)];
#pragma unroll
                for (int d = 0; d < NDB; ++d) o[d][r] *= a; }
        }
        float ps = 0.f;
#pragma unroll
        for (int r = 0; r < 16; ++r) { s0[r] = exp2f(s0[r] - m); s1[r] = exp2f(s1[r] - m); ps += s0[r] + s1[r]; }
        l += ps;
        bf16x8 pa[4];
#pragma unroll
        for (int s = 0; s < 4; ++s) {
            unsigned w[4];
#pragma unroll
            for (int k = 0; k < 4; ++k) w[k] = (s < 2) ? cvt_pk_bf16_f32(s0[8 * (s & 1) + 2 * k], s0[8 * (s & 1) + 2 * k + 1]) : cvt_pk_bf16_f32(s1[8 * (s & 1) + 2 * k], s1[8 * (s & 1) + 2 * k + 1]);
            uint4 pw = make_uint4(w[0], w[1], w[2], w[3]);
            pa[s] = __builtin_bit_cast(bf16x8, pw);
        }
#pragma unroll
        for (int d = 0; d < NDB; ++d) {
#pragma unroll
            for (int s = 0; s < 4; ++s) {
                const unsigned char* vp = vb + (32 * d + r32) * ATT_VPITCH + 32 * s + 8 * hi;
                const uint2 v0 = *(const uint2*)vp, v1 = *(const uint2*)(vp + 16);
                uint4 vw = make_uint4(v0.x, v0.y, v1.x, v1.y);
                o[d] = __builtin_amdgcn_mfma_f32_32x32x16_bf16(pa[s], __builtin_bit_cast(bf16x8, vw), o[d], 0, 0, 0);
            }
        }
        if (t + 1 < ntiles) ATT_STORE(buf ^ 1);
        __syncthreads();
    }
#undef ATT_LOAD
#undef ATT_STORE
    l += __shfl_xor(l, 32);
    if (hi == 0) sc[r32] = 1.f / l;
#pragma unroll
    for (int r = 0; r < 16; ++r) {
        const float iv = sc[crow(r, hi)];
        bf16* orow = Obase + (size_t)(wid * 32 + crow(r, hi)) * ldo + r32;
#pragma unroll
        for (int d = 0; d < NDB; ++d) orow[32 * d] = (bf16)f2bf(o[d][r] * iv);
    }
    __syncthreads();
}
__device__ __forceinline__ void ph_attn_mfma(const bf16* __restrict__ P, int ldp, const bf16* __restrict__ Kc, const bf16* __restrict__ Vt, bf16* __restrict__ ATT,
                                             int odd, int with_ctx, unsigned char* lds) {
    const int TID = opaque_tid(), BID = opaque_bid();
    const int G = gridDim.x, vcu = (G % 8 == 0) ? (BID & 7) * (G >> 3) + (BID >> 3) : BID;
    const int nlat = odd ? 2048 : 1024, nctx = with_ctx ? (odd ? 256 : 128) : 0;
    for (int u = vcu; u < nlat + nctx; u += G) {
        int b, qh, row0, ntiles;
        if (u < nlat) {
            if (odd) { const int grp = u >> 5, w = u & 31; b = grp >> 2; qh = (grp & 3) * 4 + (w >> 3); row0 = b * SEQ + (w & 7) * 256; }
            else { const int grp = u >> 4, w = u & 15; b = grp >> 2; qh = (grp & 3) * 2 + (w >> 3); row0 = b * SEQ + (w & 7) * 256; }
            ntiles = KVLEN / 64;
        } else {
            const int idx = u - nlat;
            if (odd) { b = idx >> 4; qh = idx & 15; } else { b = idx >> 3; qh = idx & 7; }
            row0 = RL + b * CTX; ntiles = CTX / 64;
        }
        if (odd) attn_unit<64>(P + (size_t)row0 * ldp + qh * 64, ldp, Kc + (size_t)(b * 4 + (qh >> 2)) * KVLEN * 64, Vt + (size_t)(b * 4 + (qh >> 2)) * 64 * KVLEN, ntiles,
                               ATT + (size_t)row0 * DM + qh * 64, DM, lds, TID);
        else attn_unit<128>(P + (size_t)row0 * ldp + qh * 64, ldp, Kc + (size_t)(b * 8 + qh) * KVLEN * 64, Vt + (size_t)(b * 4 + (qh >> 1)) * 128 * KVLEN, ntiles,
                            ATT + (size_t)row0 * DM + qh * 128, DM, lds, TID);
    }
}
typedef float f32x4_t __attribute__((ext_vector_type(4)));
#define GLA_PITCH 144
__device__ __forceinline__ void ph_gla_chunk(const bf16* __restrict__ P, const float* __restrict__ w_af, const float* __restrict__ b_af,
                                             const float* __restrict__ w_ab, const float* __restrict__ b_ab, float* __restrict__ OF, float* __restrict__ OB, unsigned char* lds) {
    const int TID = opaque_tid(), BID = opaque_bid();
    const int tid = TID, lane = tid & 63, wid = tid >> 6, l15 = lane & 15, q4 = lane >> 4;
    float* SEG = (float*)lds;
    float* DEC = (float*)(lds + 2048);
    unsigned char* QD = lds + 4096;
    unsigned char* KI = QD + 9216;
    unsigned char* KET = KI + 9216;
    unsigned char* AT = KET + 9216;
    unsigned char* VT = AT + 9216;
    for (int unit = BID; unit < NB * 4 * 2; unit += gridDim.x) {
        const int dir = unit & 1, h = (unit >> 1) & 3, b = unit >> 3;
        const float* wa = dir ? w_ab : w_af; const float* ba = dir ? b_ab : b_af;
        float* Od = dir ? OB : OF;
        const int d = tid & 63, seg = tid >> 6;
        float wreg[16];
#pragma unroll
        for (int j = 0; j < 16; ++j) wreg[j] = wa[j * 256 + h * 64 + d];
        const float breg = ba[h * 64 + d];
        for (int i = tid; i < 9216 / 16; i += NT) ((uint4*)AT)[i] = make_uint4(0u, 0u, 0u, 0u);
        f32x4_t S[4];
#pragma unroll
        for (int i = 0; i < 4; ++i) S[i] = (f32x4_t){0.f, 0.f, 0.f, 0.f};
        __syncthreads();
        for (int ch = 0; ch < KVLEN / 64; ++ch) {
            int rbase, rsgn;
            if (!dir) { rbase = ch < 4 ? RL + b * CTX + ch * 64 : b * SEQ + (ch - 4) * 64; rsgn = 1; }
            else { rbase = ch < 4 ? RL + b * CTX + (CTX - 1 - ch * 64) : b * SEQ + (SEQ - 1 - (ch - 4) * 64); rsgn = -1; }
            float cl[8];
            {
                float run = 0.f;
#pragma unroll
                for (int i = 0; i < 8; ++i) {
                    const bf16* pr = P + (size_t)(rbase + rsgn * (8 * seg + i)) * EVEN_LDP + 3072 + dir * 16;
                    const uint4 g0 = *(const uint4*)pr, g1 = *(const uint4*)(pr + 8);
                    const unsigned gw[8] = {g0.x, g0.y, g0.z, g0.w, g1.x, g1.y, g1.z, g1.w};
                    float z = breg;
#pragma unroll
                    for (int j = 0; j < 8; ++j) { z += __uint_as_float(gw[j] << 16) * wreg[2 * j]; z += __uint_as_float(gw[j] & 0xffff0000u) * wreg[2 * j + 1]; }
                    run += log_sigmoid_f(z) * (1.f / 16.f);
                    cl[i] = run;
                }
                SEG[seg * 64 + d] = run;
            }
            __syncthreads();
            {
                float prefix = 0.f, total = 0.f;
#pragma unroll
                for (int s2 = 0; s2 < 8; ++s2) { const float v = SEG[s2 * 64 + d]; total += v; prefix += (s2 < seg) ? v : 0.f; }
                if (seg == 0) DEC[d] = __expf(total);
                unsigned kew[4];
#pragma unroll
                for (int i = 0; i < 8; ++i) {
                    const int c = 8 * seg + i;
                    const bf16* pr = P + (size_t)(rbase + rsgn * c) * EVEN_LDP;
                    const float qv = bf2f(pr[1536 + h * 64 + d]) * 0.125f, kv = bf2f(pr[1792 + h * 64 + d]);
                    const float cum = prefix + cl[i];
                    const float e = __expf(cum), ei = __expf(-cum), ee = __expf(total - cum);
                    *(bf16*)(QD + c * GLA_PITCH + d * 2) = (bf16)f2bf(qv * e);
                    *(bf16*)(KI + c * GLA_PITCH + d * 2) = (bf16)f2bf(kv * ei);
                    const unsigned kb = f2bf(kv * ee);
                    if (i & 1) kew[i >> 1] |= kb << 16; else kew[i >> 1] = kb;
                }
                *(uint4*)(KET + d * GLA_PITCH + seg * 16) = make_uint4(kew[0], kew[1], kew[2], kew[3]);
                const int v = tid & 127, cg = tid >> 7;
                unsigned vw[8];
#pragma unroll
                for (int i = 0; i < 16; ++i) {
                    const unsigned x = P[(size_t)(rbase + rsgn * (16 * cg + i)) * EVEN_LDP + 2048 + h * 128 + v];
                    if (i & 1) vw[i >> 1] |= x << 16; else vw[i >> 1] = x;
                }
                *(uint4*)(VT + v * GLA_PITCH + cg * 32) = make_uint4(vw[0], vw[1], vw[2], vw[3]);
                *(uint4*)(VT + v * GLA_PITCH + cg * 32 + 16) = make_uint4(vw[4], vw[5], vw[6], vw[7]);
            }
            __syncthreads();
            for (int blk = wid; blk < 10; blk += NWV) {
                int sblk, cblk;
                if (blk < 4) { sblk = 0; cblk = blk; } else if (blk < 7) { sblk = 1; cblk = blk - 3; } else if (blk < 9) { sblk = 2; cblk = blk - 5; } else { sblk = 3; cblk = 3; }
                f32x4_t acc = (f32x4_t){0.f, 0.f, 0.f, 0.f};
#pragma unroll
                for (int kk = 0; kk < 2; ++kk) {
                    const bf16x8 a = *(const bf16x8*)(KI + (16 * sblk + l15) * GLA_PITCH + 64 * kk + 16 * q4);
                    const bf16x8 bq = *(const bf16x8*)(QD + (16 * cblk + l15) * GLA_PITCH + 64 * kk + 16 * q4);
                    acc = __builtin_amdgcn_mfma_f32_16x16x32_bf16(a, bq, acc, 0, 0, 0);
                }
                const int c = 16 * cblk + l15, s0 = 16 * sblk + 4 * q4;
                float av[4];
#pragma unroll
                for (int r = 0; r < 4; ++r) av[r] = (s0 + r <= c) ? acc[r] : 0.f;
                *(uint2*)(AT + c * GLA_PITCH + s0 * 2) = make_uint2(pk2(av[0], av[1]), pk2(av[2], av[3]));
            }
            __syncthreads();
            {
                const int v0 = 16 * wid;
                bf16x8 bv[2], sB[2];
#pragma unroll
                for (int kk = 0; kk < 2; ++kk) {
                    bv[kk] = *(const bf16x8*)(VT + (v0 + l15) * GLA_PITCH + 64 * kk + 16 * q4);
                    uint4 w = make_uint4(pk2(S[2 * kk][0], S[2 * kk][1]), pk2(S[2 * kk][2], S[2 * kk][3]), pk2(S[2 * kk + 1][0], S[2 * kk + 1][1]), pk2(S[2 * kk + 1][2], S[2 * kk + 1][3]));
                    sB[kk] = __builtin_bit_cast(bf16x8, w);
                }
#pragma unroll
                for (int cblk = 0; cblk < 4; ++cblk) {
                    f32x4_t acc = (f32x4_t){0.f, 0.f, 0.f, 0.f};
                    const unsigned char* arow = AT + (16 * cblk + l15) * GLA_PITCH;
                    const unsigned char* qrow = QD + (16 * cblk + l15) * GLA_PITCH;
#pragma unroll
                    for (int kk = 0; kk < 2; ++kk) {
                        if (kk == 0 || cblk >= 2) {
                            const bf16x8 a = *(const bf16x8*)(arow + 64 * kk + 16 * q4);
                            acc = __builtin_amdgcn_mfma_f32_16x16x32_bf16(a, bv[kk], acc, 0, 0, 0);
                        }
                    }
#pragma unroll
                    for (int kk = 0; kk < 2; ++kk) {
                        const uint2 a0 = *(const uint2*)(qrow + 64 * kk + 8 * q4), a1 = *(const uint2*)(qrow + 64 * kk + 32 + 8 * q4);
                        uint4 aw = make_uint4(a0.x, a0.y, a1.x, a1.y);
                        acc = __builtin_amdgcn_mfma_f32_16x16x32_bf16(__builtin_bit_cast(bf16x8, aw), sB[kk], acc, 0, 0, 0);
                    }
#pragma unroll
                    for (int r = 0; r < 4; ++r) Od[(size_t)(rbase + rsgn * (16 * cblk + 4 * q4 + r)) * 512 + h * 128 + v0 + l15] = acc[r];
                }
#pragma unroll
                for (int dblk = 0; dblk < 4; ++dblk) {
#pragma unroll
                    for (int r = 0; r < 4; ++r) S[dblk][r] *= DEC[16 * dblk + 4 * q4 + r];
#pragma unroll
                    for (int kk = 0; kk < 2; ++kk) {
                        const bf16x8 a = *(const bf16x8*)(KET + (16 * dblk + l15) * GLA_PITCH + 64 * kk + 16 * q4);
                        S[dblk] = __builtin_amdgcn_mfma_f32_16x16x32_bf16(a, bv[kk], S[dblk], 0, 0, 0);
                    }
                }
            }
            __syncthreads();
        }
    }
}
__device__ __forceinline__ void ph_even_post(bf16* __restrict__ ATT, const float* __restrict__ lamv, const float* __restrict__ subln, float lam_init,
                             const float* __restrict__ OF, const float* __restrict__ OB, const bf16* __restrict__ P, const float* __restrict__ gain) {
    const int TID = opaque_tid(), BID = opaque_bid();
    int wave = BID * NWV + (TID >> 6), lane = TID & 63;
    int nw = gridDim.x * NWV;
    float p1 = lamv[lane] * lamv[64 + lane], p2 = lamv[128 + lane] * lamv[192 + lane];
    p1 = wave_sum(p1); p2 = wave_sum(p2);
    const float lam = expf(p1) - expf(p2) + lam_init;
    for (int r = wave; r < RT; r += nw) {
        bf16* a = ATT + (size_t)r * DM;
        float d[4][2];
#pragma unroll
        for (int h = 0; h < 4; ++h) {
            float2 o0 = ld2bf(a + (2 * h) * 128 + lane * 2);
            float2 o1 = ld2bf(a + (2 * h + 1) * 128 + lane * 2);
            d[h][0] = o0.x - lam * o1.x; d[h][1] = o0.y - lam * o1.y;
        }
        float2 outd[4];
#pragma unroll
        for (int h = 0; h < 4; ++h) {
            float s = wave_sum(d[h][0] * d[h][0] + d[h][1] * d[h][1]);
            float rstd = rsqrtf(s * (1.f / 128.f) + 1e-6f) * (1.f - lam_init);
            float2 sg = *(const float2*)(subln + lane * 2);
            outd[h] = make_float2(d[h][0] * rstd * sg.x, d[h][1] * rstd * sg.y);
        }
        float2 outg[4];
#pragma unroll
        for (int h = 0; h < 4; ++h) {
            float2 x = *(const float2*)(OF + (size_t)r * 512 + h * 128 + lane * 2);
            float2 c = *(const float2*)(OB + (size_t)r * 512 + h * 128 + lane * 2);
            float o0 = x.x + c.x, o1 = x.y + c.y;
            float s = wave_sum(o0 * o0 + o1 * o1);
            float rstd = rsqrtf(s * (1.f / 128.f) + 1e-6f);
            float2 g = *(const float2*)(gain + lane * 2);
            float2 rr = ld2bf(P + (size_t)r * EVEN_LDP + 2560 + h * 128 + lane * 2);
            outg[h] = make_float2(o0 * rstd * g.x * silu_f(rr.x), o1 * rstd * g.y * silu_f(rr.y));
        }
#pragma unroll
        for (int h = 0; h < 4; ++h) {
            st2bf(a + h * 128 + lane * 2, outd[h]);
            st2bf(a + 512 + h * 128 + lane * 2, outg[h]);
        }
    }
}
#define INS16(tv, ti, v, n) do { \
    _Pragma("unroll") for (int j_ = 15; j_ >= 1; --j_) { bool c1_ = (v) > tv[j_ - 1]; bool c2_ = (v) > tv[j_]; \
        tv[j_] = c1_ ? tv[j_ - 1] : (c2_ ? (v) : tv[j_]); ti[j_] = c1_ ? ti[j_ - 1] : (c2_ ? (n) : ti[j_]); } \
    { bool c_ = (v) > tv[0]; tv[0] = c_ ? (v) : tv[0]; ti[0] = c_ ? (n) : ti[0]; } } while (0)

__device__ __forceinline__ void ph_peer_ffn(const bf16* __restrict__ A2, const int* __restrict__ IDX, const float* __restrict__ GATE,
                            const float* __restrict__ U, const float* __restrict__ V, const float* __restrict__ mods_l, float* __restrict__ X) {
    const int TID = opaque_tid(), BID = opaque_bid();
    int wave = BID * NWV + (TID >> 6), lane = TID & 63;
    int nw = gridDim.x * NWV;
    for (int r = wave; r < RT; r += nw) {
        float4 xa[4], acc[4];
#pragma unroll
        for (int i = 0; i < 4; ++i) { xa[i] = ld4bf(A2 + (size_t)r * DM + 4 * (lane + 64 * i)); acc[i] = make_float4(0.f, 0.f, 0.f, 0.f); }
        for (int e = 0; e < 128; ++e) {
            int id = IDX[(size_t)r * 128 + e]; float g = GATE[(size_t)r * 128 + e];
            const float4* ur = (const float4*)(U + (size_t)id * DM);
            float d = 0.f;
#pragma unroll
            for (int i = 0; i < 4; ++i) { float4 u = ur[lane + 64 * i]; d += u.x * xa[i].x + u.y * xa[i].y + u.z * xa[i].z + u.w * xa[i].w; }
            d = wave_sum(d);
            float w = g * gelu_tanh(d);
            const float4* vr = (const float4*)(V + (size_t)id * DM);
#pragma unroll
            for (int i = 0; i < 4; ++i) { float4 v = vr[lane + 64 * i]; acc[i].x += w * v.x; acc[i].y += w * v.y; acc[i].z += w * v.z; acc[i].w += w * v.w; }
        }
        const float4* g5 = (const float4*)(mods_l + (size_t)row_mod(r) * MODW + 5 * DM);
        float4* xr = (float4*)(X + (size_t)r * DM);
#pragma unroll
        for (int i = 0; i < 4; ++i) { float4 x = xr[lane + 64 * i], gg = g5[lane + 64 * i];
            x.x += gg.x * acc[i].x; x.y += gg.y * acc[i].y; x.z += gg.z * acc[i].z; x.w += gg.w * acc[i].w; xr[lane + 64 * i] = x; }
    }
}
#define RT_KPITCH 144
#define INSP16(t, x) do { unsigned x_ = (x); _Pragma("unroll") for (int j_ = 0; j_ < 16; ++j_) { const unsigned h_ = max(t[j_], x_); x_ = min(t[j_], x_); t[j_] = h_; } } while (0)
__device__ __forceinline__ void ph_route_mfma(const bf16* __restrict__ Qp, const bf16* __restrict__ Kb, int* __restrict__ IDX, float* __restrict__ GATE, unsigned char* lds, int nrows) {
    const int TID = opaque_tid(), BID = opaque_bid();
    const int tid = TID, lane = tid & 63, wid = tid >> 6, r32 = lane & 31, hi = lane >> 5;
    for (int u = BID; u < (nrows / 256) * 8; u += gridDim.x) {
        const int h = u & 7, row = (u >> 3) * 256 + wid * 32 + r32;
        __syncthreads();
        for (int i = tid; i < 2 * 128 * 8; i += NT) *(uint4*)(lds + (i >> 3) * RT_KPITCH + (i & 7) * 16) = *(const uint4*)(Kb + ((size_t)h * 256 + (i >> 3)) * 64 + (i & 7) * 8);
        __syncthreads();
        unsigned L[2][16];
#pragma unroll
        for (int half = 0; half < 2; ++half) {
            bf16x8 qf[4];
            const bf16* qrow = Qp + (size_t)row * DM + h * 128 + half * 64;
#pragma unroll
            for (int s = 0; s < 4; ++s) qf[s] = *(const bf16x8*)(qrow + 16 * s + 8 * hi);
#pragma unroll
            for (int j = 0; j < 16; ++j) L[half][j] = 0u;
#pragma unroll
            for (int nb = 0; nb < 4; ++nb) {
                f32x16 acc;
#pragma unroll
                for (int r = 0; r < 16; ++r) acc[r] = 0.f;
#pragma unroll
                for (int s = 0; s < 4; ++s) {
                    const bf16x8 a = *(const bf16x8*)(lds + (half * 128 + 32 * nb + r32) * RT_KPITCH + 32 * s + 16 * hi);
                    acc = __builtin_amdgcn_mfma_f32_32x32x16_bf16(a, qf[s], acc, 0, 0, 0);
                }
#pragma unroll
                for (int r = 0; r < 16; ++r) {
                    unsigned ub = __float_as_uint(acc[r]);
                    ub = (ub & 0x80000000u) ? ~ub : (ub | 0x80000000u);
                    const unsigned x = (ub & ~127u) | (unsigned)(127 - (32 * nb + (r & 3) + 8 * (r >> 2)) - 4 * hi);
                    INSP16(L[half], x);
                }
                __builtin_amdgcn_sched_barrier(0);
            }
            unsigned o[16];
#pragma unroll
            for (int j = 0; j < 16; ++j) o[j] = __shfl_xor(L[half][j], 32);
#pragma unroll
            for (int j = 0; j < 16; ++j) INSP16(L[half], o[j]);
            __builtin_amdgcn_sched_barrier(0);
        }
        float v1[16], v2[16];
        {
            unsigned w1[4] = {0u, 0u, 0u, 0u}, w2[4] = {0u, 0u, 0u, 0u};
#pragma unroll
            for (int j = 0; j < 16; ++j) {
                unsigned a = L[0][j] & ~127u, b = L[1][j] & ~127u;
                a = (a & 0x80000000u) ? (a & 0x7fffffffu) : ~a; b = (b & 0x80000000u) ? (b & 0x7fffffffu) : ~b;
                v1[j] = __uint_as_float(a); v2[j] = __uint_as_float(b);
                w1[j >> 2] |= (127u - (L[0][j] & 127u)) << (8 * (j & 3)); w2[j >> 2] |= (127u - (L[1][j] & 127u)) << (8 * (j & 3));
            }
            unsigned char* sb = lds + 2 * 128 * RT_KPITCH + tid * 4;
#pragma unroll
            for (int k = 0; k < 4; ++k) { *(unsigned*)(sb + k * 2048) = w1[k]; *(unsigned*)(sb + (4 + k) * 2048) = w2[k]; }
        }
        unsigned T[16];
#pragma unroll
        for (int j = 0; j < 16; ++j) T[j] = 0u;
#pragma unroll
        for (int a = 0; a < 16; ++a)
#pragma unroll
            for (int b = 0; b < 16; ++b) {
                if ((a + 1) * (b + 1) <= 16) {
                    unsigned ub = __float_as_uint(v1[a] + v2[b]);
                    ub = (ub & 0x80000000u) ? ~ub : (ub | 0x80000000u);
                    const unsigned x = (ub & ~255u) | (unsigned)(255 - (16 * a + b));
                    INSP16(T, x);
                }
            }
        float e[16]; int bi[16]; float sum = 0.f, v0 = 0.f;
        {
            const unsigned char* sb = lds + 2 * 128 * RT_KPITCH + tid * 4;
#pragma unroll
            for (int j = 0; j < 16; ++j) {
                unsigned ub = T[j] & ~255u;
                ub = (ub & 0x80000000u) ? (ub & 0x7fffffffu) : ~ub;
                const float val = __uint_as_float(ub);
                if (j == 0) v0 = val;
                e[j] = __expf(val - v0); sum += e[j];
                const unsigned flat = 255u - (T[j] & 255u), ca = flat >> 4, cb = flat & 15u;
                const unsigned ia = *(const unsigned char*)(sb + (ca >> 2) * 2048 + (ca & 3)), ib = *(const unsigned char*)(sb + (4 + (cb >> 2)) * 2048 + (cb & 3));
                bi[j] = (int)(ia * 128u + ib);
            }
        }
        const float inv = 1.f / sum;
        if (hi == 0) {
            int* ip = IDX + (size_t)row * 128 + h * 16; float* gp = GATE + (size_t)row * 128 + h * 16;
#pragma unroll
            for (int j = 0; j < 4; ++j) {
                *(int4*)(ip + 4 * j) = make_int4(bi[4 * j], bi[4 * j + 1], bi[4 * j + 2], bi[4 * j + 3]);
                *(float4*)(gp + 4 * j) = make_float4(e[4 * j] * inv, e[4 * j + 1] * inv, e[4 * j + 2] * inv, e[4 * j + 3] * inv);
            }
        }
    }
    __syncthreads();
}
__device__ __forceinline__ void ph_table_prep(const float* __restrict__ U, const float* __restrict__ V, unsigned char* __restrict__ T8, float* __restrict__ RS) {
    const int TID = opaque_tid(), BID = opaque_bid();
    const int wave = BID * NWV + (TID >> 6), lane = TID & 63, nw = gridDim.x * NWV;
    const int NROWS = DEPTH * 16384;
    for (int rr = wave; rr < 2 * NROWS; rr += nw) {
        const float* src = (rr < NROWS ? U : V) + (size_t)(rr < NROWS ? rr : rr - NROWS) * DM + lane * 16;
        float4 v[4]; float am = 0.f;
#pragma unroll
        for (int i = 0; i < 4; ++i) { v[i] = ((const float4*)src)[i]; am = fmaxf(am, fmaxf(fmaxf(fabsf(v[i].x), fabsf(v[i].y)), fmaxf(fabsf(v[i].z), fabsf(v[i].w)))); }
#pragma unroll
        for (int o = 1; o < 64; o <<= 1) am = fmaxf(am, __shfl_xor(am, o));
        am = fmaxf(am, 1e-30f);
        const float sc = exp2f(floorf(log2f(448.f / am)) - 1.f);
        int w[4];
#pragma unroll
        for (int i = 0; i < 4; ++i) { int t = 0; t = __builtin_amdgcn_cvt_pk_fp8_f32(v[i].x * sc, v[i].y * sc, t, false); t = __builtin_amdgcn_cvt_pk_fp8_f32(v[i].z * sc, v[i].w * sc, t, true); w[i] = t; }
        *(uint4*)(T8 + (size_t)rr * DM + lane * 16) = make_uint4((unsigned)w[0], (unsigned)w[1], (unsigned)w[2], (unsigned)w[3]);
        if (lane == 0) RS[rr] = 1.f / sc;
    }
}
#define BR4(j) ((((j) & 1) << 3) | (((j) & 2) << 1) | (((j) & 4) >> 1) | (((j) & 8) >> 3))
__device__ __forceinline__ float dot16_fp8_bf16(uint4 u, const unsigned (&x)[8]) {
    float d = 0.f;
    const unsigned uw[4] = {u.x, u.y, u.z, u.w};
#pragma unroll
    for (int i = 0; i < 4; ++i) {
        bf16x2_t lo = __builtin_amdgcn_cvt_scalef32_pk_bf16_fp8(uw[i], 1.0f, false);
        bf16x2_t hi = __builtin_amdgcn_cvt_scalef32_pk_bf16_fp8(uw[i], 1.0f, true);
        d = __builtin_amdgcn_fdot2_f32_bf16(lo, __builtin_bit_cast(bf16x2_t, x[2 * i]), d, false);
        d = __builtin_amdgcn_fdot2_f32_bf16(hi, __builtin_bit_cast(bf16x2_t, x[2 * i + 1]), d, false);
    }
    return d;
}
__device__ __forceinline__ void ph_peer_ffn8(const bf16* __restrict__ A2, const int* __restrict__ IDX, const float* __restrict__ GATE,
                            const unsigned char* __restrict__ U8, const float* __restrict__ RSU, const unsigned char* __restrict__ V8, const float* __restrict__ RSV,
                            const float* __restrict__ mods_l, float* __restrict__ X, int nrows) {
    const int TID = opaque_tid(), BID = opaque_bid();
    const int wave = BID * NWV + (TID >> 6), lane = TID & 63, nw = gridDim.x * NWV;
    const int jl = BR4(lane & 15);
    for (int r = wave; r < nrows; r += nw) {
        unsigned x[8];
        { const uint4* xp = (const uint4*)(A2 + (size_t)r * DM + lane * 16); uint4 a = xp[0], b = xp[1]; x[0] = a.x; x[1] = a.y; x[2] = a.z; x[3] = a.w; x[4] = b.x; x[5] = b.y; x[6] = b.z; x[7] = b.w; }
        float acc[16];
#pragma unroll
        for (int k = 0; k < 16; ++k) acc[k] = 0.f;
        for (int g = 0; g < 8; ++g) {
            const int myid = IDX[(size_t)r * 128 + g * 16 + jl];
            const float mygate = GATE[(size_t)r * 128 + g * 16 + jl];
            const float rsu = RSU[myid], rsv = RSV[myid];
            uint4 ub[16], vb[16];
#pragma unroll
            for (int j = 0; j < 16; ++j) { const int id = __builtin_amdgcn_readlane(myid, BR4(j)); ub[j] = *(const uint4*)(U8 + (size_t)id * DM + lane * 16); }
#pragma unroll
            for (int j = 0; j < 16; ++j) { const int id = __builtin_amdgcn_readlane(myid, BR4(j)); vb[j] = *(const uint4*)(V8 + (size_t)id * DM + lane * 16); }
            float d[16];
#pragma unroll
            for (int j = 0; j < 16; ++j) d[j] = dot16_fp8_bf16(ub[j], x);
#pragma unroll
            for (int st = 0; st < 4; ++st) {
                const int n = 8 >> st, bit = 1 << st;
                const bool up = (lane & bit) != 0;
#pragma unroll
                for (int i = 0; i < 8; ++i) if (i < n) {
                    const float send = up ? d[i] : d[i + n], keep = up ? d[i + n] : d[i];
                    d[i] = keep + __shfl_xor(send, bit);
                }
            }
            float tot = d[0];
            tot += __shfl_xor(tot, 16); tot += __shfl_xor(tot, 32);
            const float w = mygate * gelu_tanh(tot * rsu) * rsv;
#pragma unroll
            for (int j = 0; j < 16; ++j) {
                const float wj = __int_as_float(__builtin_amdgcn_readlane(__float_as_int(w), BR4(j)));
                const unsigned vw[4] = {vb[j].x, vb[j].y, vb[j].z, vb[j].w};
#pragma unroll
                for (int i = 0; i < 4; ++i) {
                    f32x2_t lo = __builtin_amdgcn_cvt_pk_f32_fp8((int)vw[i], false), hi = __builtin_amdgcn_cvt_pk_f32_fp8((int)vw[i], true);
                    acc[4 * i] += wj * lo.x; acc[4 * i + 1] += wj * lo.y; acc[4 * i + 2] += wj * hi.x; acc[4 * i + 3] += wj * hi.y;
                }
            }
        }
        const float4* g5 = (const float4*)(mods_l + (size_t)row_mod(r) * MODW + 5 * DM + lane * 16);
        float4* xr = (float4*)(X + (size_t)r * DM + lane * 16);
#pragma unroll
        for (int i = 0; i < 4; ++i) { float4 xv = xr[i], gg = g5[i];
            xv.x += gg.x * acc[4 * i]; xv.y += gg.y * acc[4 * i + 1]; xv.z += gg.z * acc[4 * i + 2]; xv.w += gg.w * acc[4 * i + 3]; xr[i] = xv; }
    }
}
template <int N>
__device__ __forceinline__ void ph_gemm_bf16(const bf16* A, const bf16* Bt, bf16* O, unsigned char* lds) {
    pg8::Gemm g{A, Bt, RT, N, DM}; pg8::StaticOrder S; S.init(RT, N, (int)gridDim.x, opaque_bid());
    pg8::EpiBf16<0> E{O, N, nullptr, 0, 0, 1.f};
    pg8::gemm_phase<pg8::EpiBf16<0>, pg8::StaticOrder, true, true>((PG8_LAS unsigned char*)lds, g, S, E);
}
__device__ __forceinline__ void ph_gemm_res(const bf16* A, const bf16* Bt, float* X, const float* gate, unsigned char* lds) {
    pg8::Gemm g{A, Bt, RT, DM, DM}; pg8::StaticOrder S; S.init(RT, DM, (int)gridDim.x, opaque_bid());
    EpiResGate E{X, gate};
    pg8::gemm_phase<EpiResGate, pg8::StaticOrder, true, true>((PG8_LAS unsigned char*)lds, g, S, E);
}

#define XB_TMO      128
#define XB_XCNT(j)  (256  + 64 * (j))
#define XB_XSUB(j)  (1280 + 64 * (j))
#define XB_XGEN(j)  (2304 + 64 * (j))
#define XB_TOP      3328
#define XB_TOPGEN   3392
#define XCD_BAR_WORDS 3456
#define XB_SPIN_CAP (1u << 18)

__device__ __forceinline__ unsigned xb_ld(unsigned* p)              { return __hip_atomic_load(p, __ATOMIC_RELAXED, __HIP_MEMORY_SCOPE_AGENT); }
__device__ __forceinline__ unsigned xb_add(unsigned* p, unsigned v) { return __hip_atomic_fetch_add(p, v, __ATOMIC_RELAXED, __HIP_MEMORY_SCOPE_AGENT); }
__device__ __forceinline__ unsigned xb_xcc_id() { return (unsigned)__builtin_amdgcn_s_getreg((3 << 11) | 20) & 0xFu; }
#define XB_SPIN(cond, bar) do { unsigned _sp = 0; while (cond) { __builtin_amdgcn_s_sleep(1); \
    if ((++_sp & 255u) == 0u) { if (xb_ld(&(bar)[XB_TMO])) break; if (_sp > XB_SPIN_CAP) { atomicAdd(&(bar)[XB_TMO], 1u); break; } } } } while (0)

struct XcdBarrier {
    unsigned* bar; unsigned x;
    volatile LAS unsigned* st;
};

__device__ __forceinline__ XcdBarrier xcd_barrier_post(unsigned* bar, volatile LAS unsigned* st) {
    XcdBarrier b; b.bar = bar; b.x = xb_xcc_id(); b.st = st;
    if (threadIdx.x == 0) (void)xb_add(&bar[XB_XCNT(b.x)], 1u);
    return b;
}
__device__ __forceinline__ void xcd_barrier_complete(unsigned* bar, unsigned x, unsigned& nloc, unsigned& nx) {
    const unsigned G = gridDim.x * gridDim.y * gridDim.z;
    unsigned sum, cnt, mine, sp = 0u;
    for (;;) {
        sum = 0u; cnt = 0u; mine = 0u;
#pragma unroll
        for (unsigned j = 0; j < 16; ++j) { const unsigned c = xb_ld(&bar[XB_XCNT(j)]); sum += c; cnt += (c > 0u) ? 1u : 0u; mine = (j == x) ? c : mine; }
        if (sum == G) break;
        __builtin_amdgcn_s_sleep(1);
        if ((++sp & 255u) == 0u) { if (xb_ld(&bar[XB_TMO])) break; if (sp > XB_SPIN_CAP) { atomicAdd(&bar[XB_TMO], 1u); break; } }
    }
    nloc = mine > 0u ? mine : 1u; nx = cnt > 0u ? cnt : 1u;
}

__device__ __forceinline__ void xcd_barrier(const XcdBarrier& b) {
    asm volatile("s_waitcnt vmcnt(0)" ::: "memory");
    __syncthreads();
    if (threadIdx.x == 0) {
        unsigned* bar = b.bar;
        __builtin_amdgcn_s_waitcnt(0);
        unsigned nloc = b.st[0], nx = b.st[1];
        if (nloc == 0u) { xcd_barrier_complete(bar, b.x, nloc, nx); b.st[0] = nloc; b.st[1] = nx; }
        const unsigned old = xb_add(&bar[XB_XSUB(b.x)], 1u);
        const unsigned gen = old / nloc;
        if (old + 1u == (gen + 1u) * nloc) {
            __builtin_amdgcn_fence(__ATOMIC_RELEASE, "agent");
            asm volatile("s_waitcnt vmcnt(0)" ::: "memory");
            const unsigned og = xb_add(&bar[XB_TOP], 1u);
            const unsigned tg = og / nx;
            if (og + 1u == (tg + 1u) * nx) xb_add(&bar[XB_TOPGEN], 1u);
            else XB_SPIN(xb_ld(&bar[XB_TOPGEN]) == tg, bar);
            __builtin_amdgcn_fence(__ATOMIC_ACQUIRE, "agent");
            xb_add(&bar[XB_XGEN(b.x)], 1u);
            asm volatile("s_waitcnt vmcnt(0)" ::: "memory");
        } else {
            XB_SPIN(xb_ld(&bar[XB_XGEN(b.x)]) == gen, bar);
            __builtin_amdgcn_fence(__ATOMIC_ACQUIRE, "agent");
            asm volatile("s_waitcnt vmcnt(0)" ::: "memory");
        }
    }
    __syncthreads();
}

constexpr size_t ALIGN_UP(size_t x) { return (x + 255) & ~(size_t)255; }
constexpr size_t WS_X = 0;
constexpr size_t WS_A = WS_X + (size_t)RT * DM * 4;
constexpr size_t WS_P = WS_A + (size_t)RT * DM * 2;
constexpr size_t WS_ATT = WS_P + (size_t)RT * EVEN_LDP * 2;
constexpr size_t WS_OF = WS_ATT + (size_t)RT * DM * 2;
constexpr size_t WS_MODS = WS_OF + (size_t)RT * 512 * 4 * 2;
constexpr size_t WS_ROPE = WS_MODS + ALIGN_UP((size_t)DEPTH * NMOD * MODW * 4);
constexpr size_t WS_WINE = WS_ROPE + (size_t)SEQ * 32 * 8;
constexpr size_t WS_WOUTE = WS_WINE + (size_t)2 * EVEN_LDP * DM * 2;
constexpr size_t WS_WINO = WS_WOUTE + (size_t)2 * DM * DM * 2;
constexpr size_t WS_WOUTO = WS_WINO + (size_t)2 * ODD_IN * DM * 2;
constexpr size_t WS_WPQ = WS_WOUTO + (size_t)2 * DM * DM * 2;
constexpr size_t WS_T8 = WS_WPQ + (size_t)4 * DM * DM * 2;
constexpr size_t WS_RS = WS_T8 + (size_t)2 * DEPTH * 16384 * DM;
constexpr size_t WS_KC = WS_RS + (size_t)2 * DEPTH * 16384 * 4;
constexpr size_t WS_VT = WS_KC + (size_t)NB * 8 * KVLEN * 64 * 2;
constexpr size_t WS_KEYS = WS_VT + (size_t)NB * 4 * 128 * KVLEN * 2;
constexpr size_t WS_BAR = WS_KEYS + (size_t)DEPTH * 8 * 2 * 128 * 64 * 2;
constexpr size_t WS_BAR_BYTES = 16384;
constexpr size_t WS_END = WS_BAR + WS_BAR_BYTES;

__global__ void __launch_bounds__(NT, 2) mega(Params p) {
    extern __shared__ __attribute__((aligned(16))) unsigned char lds[];
    float* smem = (float*)lds;
    cg::grid_group grid = cg::this_grid();
    unsigned char* ws = p.ws;
    volatile LAS unsigned* bst = (volatile LAS unsigned*)((LAS unsigned char*)lds + 131072 + 512);
    if (threadIdx.x < 2) bst[threadIdx.x] = 0u;
    __syncthreads();
    XcdBarrier xbar = xcd_barrier_post((unsigned*)(ws + WS_BAR), bst);
#define GSYNC() xcd_barrier(xbar)
#define X_ ((float*)(ws + WS_X))
#define A_ ((bf16*)(ws + WS_A))
#define P_ ((bf16*)(ws + WS_P))
#define ATT_ ((bf16*)(ws + WS_ATT))
#define OF_ ((float*)(ws + WS_OF))
#define OB_ (OF_ + (size_t)RT * 512)
#define MODS_ ((float*)(ws + WS_MODS))
#define ROPE_ ((float2*)(ws + WS_ROPE))
#define WINE_ ((bf16*)(ws + WS_WINE))
#define WOUTE_ ((bf16*)(ws + WS_WOUTE))
#define WINO_ ((bf16*)(ws + WS_WINO))
#define WOUTO_ ((bf16*)(ws + WS_WOUTO))
#define WPQ_ ((bf16*)(ws + WS_WPQ))
#define QP_ P_
#define KEYS_ ((bf16*)(ws + WS_KEYS))
#define KC_ ((bf16*)(ws + WS_KC))
#define VT_ ((bf16*)(ws + WS_VT))
#define T8_ (ws + WS_T8)
#define RS_ ((float*)(ws + WS_RS))
#define IDX_ ((int*)(ws + WS_P + (size_t)RT * DM * 2))
#define GATE_ ((float*)(ws + WS_P + (size_t)RT * DM * 2 + (size_t)RT * 128 * 4))

    ph_copy_in(p.in[0], p.in[2], X_);
    ph_rope_table(ROPE_);
    ph_weight_prep(p.in, WINE_, WOUTE_, WINO_, WOUTO_, WPQ_, KEYS_, lds);
    ph_table_prep(p.in[25], p.in[26], T8_, RS_);
    __syncthreads();
    ph_mods(p.in[1], p.in[3], p.in[4], p.in[5], MODS_, smem);
    grid.sync();
    for (int hl = 0; hl < 2 * DEPTH; ++hl) {
        const int l = hl >> 1, part = hl & 1, i = l >> 1, odd = l & 1;
        const float* mods_l = MODS_ + (size_t)l * NMOD * MODW;
        ph_norm_mod(X_, (part ? p.in[7] : p.in[6]) + l * DM, mods_l, part ? 3 : 0, A_);
        GSYNC();
        if (part) ph_gemm_bf16<DM>(A_, WPQ_ + (size_t)l * DM * DM, P_, lds);
        else if (odd) ph_gemm_bf16<ODD_IN>(A_, WINO_ + (size_t)i * ODD_IN * DM, P_, lds);
        else ph_gemm_bf16<EVEN_LDP>(A_, WINE_ + (size_t)i * EVEN_LDP * DM, P_, lds);
        GSYNC();
        if (part == 0) {
            const int ldp = odd ? ODD_IN : EVEN_LDP;
            ph_post(P_, ldp, odd ? 16 : 8, odd ? 1024 : 512, odd ? 4 : 8, odd ? 1280 : 1024, odd ? 256 : 512, odd ? 64 : 128,
                    (odd ? p.in[21] : p.in[10]) + i * 64, (odd ? p.in[22] : p.in[11]) + i * 64, ROPE_, KC_, VT_);
            GSYNC();
            if (!odd) ph_gla_chunk(P_, p.in[14] + i * 16 * 256, p.in[15] + i * 256, p.in[16] + i * 16 * 256, p.in[17] + i * 256, OF_, OB_, lds);
            ph_attn_mfma(P_, ldp, KC_, VT_, ATT_, odd, 1, lds);
            if (DUP_ATTN) ph_attn_mfma(P_, ldp, KC_, VT_, ATT_, odd, 1, lds);
            GSYNC();
            if (!odd) {
                const float lam_init = 0.8f - 0.6f * expf(-0.3f * (float)l);
                ph_even_post(ATT_, p.in[12] + i * 256, p.in[13] + i * 128, lam_init, OF_, OB_, P_, p.in[18] + i * 128);
                GSYNC();
            }
            ph_gemm_res(ATT_, odd ? WOUTO_ + (size_t)i * DM * DM : WOUTE_ + (size_t)i * DM * DM, X_, mods_l + 2 * DM, lds);
        } else {
            ph_route_mfma(QP_, KEYS_ + (size_t)l * 8 * 2 * 128 * 64, IDX_, GATE_, lds, RT);
            if (DUP_ROUTE) ph_route_mfma(QP_, KEYS_ + (size_t)l * 8 * 2 * 128 * 64, IDX_, GATE_, lds, RT);
            GSYNC();
            ph_peer_ffn8(A_, IDX_, GATE_, T8_ + (size_t)l * 16384 * DM, RS_ + l * 16384, T8_ + (size_t)(DEPTH + l) * 16384 * DM, RS_ + (DEPTH + l) * 16384, mods_l, X_, RT);
            if (DUP_FFN) ph_peer_ffn8(A_, IDX_, GATE_, T8_ + (size_t)l * 16384 * DM, RS_ + l * 16384, T8_ + (size_t)(DEPTH + l) * 16384 * DM, RS_ + (DEPTH + l) * 16384, mods_l, OF_, RT);
        }
        GSYNC();
    }
    ph_copy_out(X_, p.out);
}

extern "C" void kernel_launch(void* const* d_in, const int* in_sizes, int n_in, void* d_out, int out_size, void* d_ws, size_t ws_size, hipStream_t stream) {
    static int grid_blocks = 0;
    if (!grid_blocks) {
        int dev = 0, cus = 0, per_cu = 0;
        (void)hipGetDevice(&dev);
        (void)hipDeviceGetAttribute(&cus, hipDeviceAttributeMultiprocessorCount, dev);
        (void)hipFuncSetAttribute((const void*)mega, hipFuncAttributeMaxDynamicSharedMemorySize, LDS_BYTES);
        (void)hipOccupancyMaxActiveBlocksPerMultiprocessor(&per_cu, mega, NT, LDS_BYTES);
        if (per_cu < 1) fprintf(stderr, "occupancy query says %d blocks/CU\n", per_cu);
        grid_blocks = cus;
        if (ws_size < WS_END) fprintf(stderr, "workspace too small: %zu < %zu\n", ws_size, (size_t)WS_END);
    }
    (void)hipMemsetAsync((unsigned char*)d_ws + WS_BAR, 0, WS_BAR_BYTES, stream);
    Params p{};
    for (int i = 0; i < 27; ++i) p.in[i] = (const float*)d_in[i];
    p.out = (float*)d_out; p.ws = (unsigned char*)d_ws;
    void* args[] = {&p};
    hipError_t e = hipLaunchCooperativeKernel((void*)mega, dim3(grid_blocks), dim3(NT), args, LDS_BYTES, stream);
    if (e != hipSuccess) fprintf(stderr, "cooperative launch failed: %s (grid %d)\n", hipGetErrorString(e), grid_blocks);
}
```

```cpp
#include <hip/hip_runtime.h>
#include <hip/hip_cooperative_groups.h>
#include <stdint.h>
#include <cstdio>
namespace cg = cooperative_groups;

#define DM 1024
#define NB 16
#define SEQ 2048
#define CTX 256
#define RL (NB * SEQ)
#define RC (NB * CTX)
#define RT (RL + RC)
#define DEPTH 4
#define EVEN_IN 3104
#define EVEN_LDP 3328
#define ODD_IN 1536
#define NMOD 17
#define MODW 6144
#define NT 512
#define NWV 8
#define LDS_BYTES 147456
#ifndef DUP_FFN
#define DUP_FFN 0
#endif
#ifndef DUP_ROUTE
#define DUP_ROUTE 0
#endif
#ifndef DUP_ATTN
#define DUP_ATTN 0
#endif
#ifndef DUP_GEMM
#define DUP_GEMM 0
#endif

typedef unsigned short bf16;
typedef float f32x2_t __attribute__((ext_vector_type(2)));
typedef __bf16 bf16x2_t __attribute__((ext_vector_type(2)));
struct Params {
    const float* in[27];
    float* out;
    unsigned char* ws;
};

__device__ __forceinline__ int row_mod(int r) { return r < RL ? (r >> 11) : 16; }
__device__ __forceinline__ float silu_f(float x) { return x / (1.f + expf(-x)); }
__device__ __forceinline__ float wave_sum(float v) {
#pragma unroll
    for (int o = 1; o < 64; o <<= 1) v += __shfl_xor(v, o);
    return v;
}
__device__ __forceinline__ float log_sigmoid_f(float z) { return fminf(z, 0.f) - log1pf(expf(-fabsf(z))); }
__device__ __forceinline__ float gelu_tanh(float x) { float u = 0.7978845608028654f * (x + 0.044715f * x * x * x); return 0.5f * x * (1.f + tanhf(u)); }
__device__ __forceinline__ float bf2f(bf16 v) { return __uint_as_float((unsigned)v << 16); }
__device__ __forceinline__ unsigned f2bf(float f) { unsigned u = __float_as_uint(f); return (u + 0x7fffu + ((u >> 16) & 1u)) >> 16; }
__device__ __forceinline__ unsigned pk2(float lo, float hi) { return f2bf(lo) | (f2bf(hi) << 16); }
__device__ __forceinline__ float4 ld4bf(const bf16* p) { uint2 u = *(const uint2*)p; return make_float4(__uint_as_float(u.x << 16), __uint_as_float(u.x & 0xffff0000u), __uint_as_float(u.y << 16), __uint_as_float(u.y & 0xffff0000u)); }
__device__ __forceinline__ void st4bf(bf16* p, float4 v) { *(uint2*)p = make_uint2(pk2(v.x, v.y), pk2(v.z, v.w)); }
__device__ __forceinline__ float2 ld2bf(const bf16* p) { unsigned u = *(const unsigned*)p; return make_float2(__uint_as_float(u << 16), __uint_as_float(u & 0xffff0000u)); }
__device__ __forceinline__ void st2bf(bf16* p, float2 v) { *(unsigned*)p = pk2(v.x, v.y); }

__device__ __forceinline__ int opaque_tid() { int t = threadIdx.x; asm volatile("" : "+v"(t)); return t; }
__device__ __forceinline__ int opaque_bid() { int b = blockIdx.x; asm volatile("" : "+s"(b)); return b; }

namespace pg8 {
#define PG8_LAS __attribute__((address_space(3)))
typedef unsigned short bf16_t;
typedef short bf16x8 __attribute__((ext_vector_type(8)));
typedef float f32x4 __attribute__((ext_vector_type(4)));
typedef unsigned u32x4 __attribute__((ext_vector_type(4)));
constexpr int BM = 256, BK = 64, HALF = 128, HTB = HALF * BK * 2  , STAGE_BYTES = 8 * HTB, NXCD = 8, WGM = 8;

__host__ __device__ __forceinline__ int lds_byte(int r, int c) { const int st = (r >> 4) * 2 + (c >> 5), rr = r & 15, cc = c & 31, ob = rr * 64 + cc * 2; return st * 1024 + (ob ^ (((ob >> 9) & 1) << 5)); }
__host__ __device__ __forceinline__ void stage_rc(int b, int& R, int& C) { const int st = b / 1024, sb = b % 1024, swz = sb ^ (((sb >> 9) & 1) << 5); R = (st >> 1) * 16 + swz / 64; C = (st & 1) * 32 + (swz % 64) / 2; }
__host__ __device__ __forceinline__ int perm32(int rho) { const int n = rho >> 4, i = rho & 15; return 8 * (i >> 2) + 4 * n + (i & 3); }

struct Unit { int pm, pn; };
struct Gemm { const bf16_t* A; const bf16_t* Bt; int M, N, K; };

struct StaticOrder {
    int nM, nN, nwg, G, c;
    __host__ __device__ void init(int M, int N, int G_, int c_) { nM = M / BM; nN = N / BM; nwg = nM * nN; G = G_; c = c_; }
    __host__ __device__ bool next(int i, Unit& u) const {
        const long L = (long)i * G + c; if (L >= nwg) return false;
        int wgid = (int)L; { const int q = nwg / NXCD, r = nwg % NXCD, xcd = wgid % NXCD, off = wgid / NXCD; wgid = (xcd < r ? xcd * (q + 1) : r * (q + 1) + (xcd - r) * q) + off; }
        const int nig = WGM * nN, gid = wgid / nig, fm = gid * WGM, gsz = (nM - fm) < WGM ? (nM - fm) : WGM;
        u.pm = fm + ((wgid % nig) % gsz); u.pn = (wgid % nig) / gsz; return true;
    }
    __device__ __forceinline__ void a_ready(const Unit&) const {}
    __device__ __forceinline__ void done(const Unit&) const {}
};

__device__ __forceinline__ unsigned cvt_pk_bf16(float lo, float hi) { unsigned r; asm volatile("v_cvt_pk_bf16_f32 %0, %1, %2" : "=v"(r) : "v"(lo), "v"(hi)); return r; }
typedef float f32x2 __attribute__((ext_vector_type(2)));
__device__ __forceinline__ f32x2 gelu_pk(f32x2 v) {
    const f32x2 av = __builtin_elementwise_abs(v), d = av * 0.2316418882f + 1.0f;
    f32x2 t; t.x = __builtin_amdgcn_rcpf(d.x); t.y = __builtin_amdgcn_rcpf(d.y);
    f32x2 q = t * 0.5307027145f + (-0.7265760135f); q = q * t + 0.7107068705f; q = q * t + (-0.142248368f); q = q * t + 0.127414796f; q = q * t;
    const f32x2 s = (v * v) * (-0.72134752044f);
    f32x2 e; e.x = __builtin_amdgcn_exp2f(s.x); e.y = __builtin_amdgcn_exp2f(s.y);
    const f32x2 m = v * (q * e), r = v - m;
    f32x2 o; o.x = v.x < 0.f ? m.x : r.x; o.y = v.y < 0.f ? m.y : r.y; return o;
}

template <int ACT  > struct EpiBf16 {
    static constexpr bool PERM = true, AFTER_DRAIN = false; static_assert(ACT == 0 || ACT == 1, "EpiBf16: ACT is 0 (none) or 1 (gelu_pk)");
    bf16_t* O; int ldc; const float* bias; int split_cols; size_t split_stride; float scale0;
    __device__ __forceinline__ void operator()(const f32x4 (&acc)[2][2][4][2], const Unit& u, int wr, int wc, int fr, int fq) const {
        const int row0 = u.pm * BM + wr * 64 + fr; int colt = u.pn * BM; bf16_t* base = O;
        float sc = 1.f; if (split_cols) { const int t = colt / split_cols; base += (size_t)t * split_stride; colt -= t * split_cols; if (t == 0) sc = scale0; }
        const int col0 = colt + wc * 32 + 8 * fq, bcol0 = u.pn * BM + wc * 32 + 8 * fq;
        f32x4 bv[2][2];
#pragma unroll
        for (int bj = 0; bj < 2; ++bj)
#pragma unroll
            for (int n = 0; n < 2; ++n) bv[bj][n] = bias ? *(const f32x4*)(bias + bcol0 + bj * HALF + 4 * n) : (f32x4){0.f, 0.f, 0.f, 0.f};
#pragma unroll
        for (int ai = 0; ai < 2; ++ai)
#pragma unroll
            for (int m = 0; m < 4; ++m) { bf16_t* rowp = base + (size_t)(row0 + ai * HALF + m * 16) * ldc + col0;
#pragma unroll
                for (int bj = 0; bj < 2; ++bj) { f32x4 v0 = acc[ai][bj][m][0] + bv[bj][0], v1 = acc[ai][bj][m][1] + bv[bj][1];
                    if (ACT == 1) { f32x2 a = gelu_pk((f32x2){v0[0], v0[1]}), b = gelu_pk((f32x2){v0[2], v0[3]}), c = gelu_pk((f32x2){v1[0], v1[1]}), d = gelu_pk((f32x2){v1[2], v1[3]});
                        v0 = (f32x4){a.x, a.y, b.x, b.y}; v1 = (f32x4){c.x, c.y, d.x, d.y}; }
                    v0 = v0 * sc; v1 = v1 * sc; u32x4 w; w.x = cvt_pk_bf16(v0[0], v0[1]); w.y = cvt_pk_bf16(v0[2], v0[3]); w.z = cvt_pk_bf16(v1[0], v1[1]); w.w = cvt_pk_bf16(v1[2], v1[3]);
                    *(u32x4*)(rowp + bj * HALF) = w; } }
    }
};
template <class Epi, class Sched, bool ALIGN_EPI = false, bool SP2 = false>
__device__ __forceinline__ void gemm_phase(PG8_LAS unsigned char* lds, const Gemm g, const Sched& S, const Epi& E) {
    const int tid = opaque_tid(), wid = __builtin_amdgcn_readfirstlane(tid >> 6), lane = tid & 63, wr = wid >> 2, wc = wid & 3, fr = lane & 15, fq = lane >> 4;
    const int K = g.K, nt = K / BK;
    unsigned voffA[2], voffB[2];
#pragma unroll
    for (int i = 0; i < 2; ++i) { int R, C; stage_rc(tid * 16 + i * 8192, R, C); const int Rb = Epi::PERM ? ((R & ~31) + perm32(R & 31)) : R;
        voffA[i] = (unsigned)(R * K + C) * 2u; voffB[i] = (unsigned)(Rb * K + C) * 2u; }
    const size_t kstep = (size_t)(BK * 2);
    const size_t hstep = (size_t)HALF * K * 2;
    const size_t tstep = 2 * hstep;
    const unsigned ldsw = (unsigned)wid * 1024u;
    const int aoff = lds_byte(wr * 64 + fr, fq * 8), boff = lds_byte(wc * 32 + fr, fq * 8);
#define PG8_SA(b, h) (((b) * 2 + (h)) * HTB)
#define PG8_SB(b, h) ((4 + (b) * 2 + (h)) * HTB)
#define PG8_STAGE(bufoff, gbase, voff) do { _Pragma("unroll") for (int _i = 0; _i < 2; ++_i) \
        __builtin_amdgcn_global_load_lds((const unsigned*)((const char*)(gbase) + (voff)[_i]), (PG8_LAS unsigned*)(lds + (bufoff) + ldsw + _i * 8192), 16, 0, 0); } while (0)
#define PG8_LDA(dst, b, h) do { _Pragma("unroll") for (int m = 0; m < 4; ++m) _Pragma("unroll") for (int k = 0; k < 2; ++k) dst[m][k] = *(const PG8_LAS bf16x8*)(lds + PG8_SA(b, h) + aoff + m * 2048 + k * 1024); } while (0)
#define PG8_LDB(dst, b, h) do { _Pragma("unroll") for (int n = 0; n < 2; ++n) _Pragma("unroll") for (int k = 0; k < 2; ++k) dst[n][k] = *(const PG8_LAS bf16x8*)(lds + PG8_SB(b, h) + boff + n * 2048 + k * 1024); } while (0)
#define PG8_MMA(ai, bj, At, Bt) do { __builtin_amdgcn_s_setprio(1); _Pragma("unroll") for (int m = 0; m < 4; ++m) _Pragma("unroll") for (int n = 0; n < 2; ++n) _Pragma("unroll") for (int k = 0; k < 2; ++k) \
        acc[ai][bj][m][n] = __builtin_amdgcn_mfma_f32_16x16x32_bf16(Bt[n][k], At[m][k], acc[ai][bj][m][n], 0, 0, 0); __builtin_amdgcn_s_setprio(0); } while (0)
#define PG8_WAIT_V(n) asm volatile("s_waitcnt vmcnt(" #n ")" ::: "memory")
#define PG8_WAIT_L(n) asm volatile("s_waitcnt lgkmcnt(" #n ")" ::: "memory")
#define PG8_BAR __builtin_amdgcn_s_barrier()
#define PG8_SCHED __builtin_amdgcn_sched_barrier(0)
    Unit cur, nxt; int ui = 0;
    if (!S.next(0, cur)) return;
    f32x4 acc[2][2][4][2];
#pragma unroll
    for (int a = 0; a < 2; ++a)
#pragma unroll
        for (int b = 0; b < 2; ++b)
#pragma unroll
            for (int m = 0; m < 4; ++m)
#pragma unroll
                for (int n = 0; n < 2; ++n) acc[a][b][m][n] = (f32x4){0.f, 0.f, 0.f, 0.f};
    bf16x8 At[4][2], B0[2][2], B1[2][2];
    const char* cA = (const char*)g.A + (size_t)cur.pm * tstep; const char* cB = (const char*)g.Bt + (size_t)cur.pn * tstep;
    S.a_ready(cur);
    if constexpr (SP2) {
        PG8_STAGE(PG8_SB(0, 0), cB, voffB); PG8_STAGE(PG8_SB(0, 1), cB + hstep, voffB); PG8_STAGE(PG8_SA(0, 0), cA, voffA); PG8_STAGE(PG8_SA(0, 1), cA + hstep, voffA);
        if (wr == 1) PG8_BAR;
        PG8_WAIT_V(2); PG8_BAR;
        PG8_STAGE(PG8_SB(1, 0), cB + kstep, voffB); PG8_STAGE(PG8_SA(1, 0), cA + kstep, voffA); PG8_STAGE(PG8_SB(1, 1), cB + hstep + kstep, voffB);
        PG8_WAIT_V(6); PG8_BAR;
    } else {
        PG8_STAGE(PG8_SB(0, 0), cB, voffB); PG8_STAGE(PG8_SA(0, 0), cA, voffA); PG8_STAGE(PG8_SB(0, 1), cB + hstep, voffB); PG8_STAGE(PG8_SA(0, 1), cA + hstep, voffA);
        if (wr == 1) PG8_BAR;
        PG8_WAIT_V(4); PG8_BAR;
        PG8_STAGE(PG8_SB(1, 0), cB + kstep, voffB); PG8_STAGE(PG8_SA(1, 0), cA + kstep, voffA); PG8_STAGE(PG8_SB(1, 1), cB + hstep + kstep, voffB);
        PG8_WAIT_V(6); PG8_BAR;
    }
    for (;;) {
        const bool has_next = S.next(ui + 1, nxt);
        const char* nA = has_next ? (const char*)g.A + (size_t)nxt.pm * tstep : cA; const char* nB = has_next ? (const char*)g.Bt + (size_t)nxt.pn * tstep : cB;
        for (int t = 0; t < nt; t += 2) {
            const bool last = (t == nt - 2);
            const char* a1 = cA + (size_t)(t + 1) * kstep;
            const char* a2 = last ? nA : cA + (size_t)(t + 2) * kstep; const char* b2 = last ? nB : cB + (size_t)(t + 2) * kstep;
            const char* a3 = a2 + kstep; const char* b3 = b2 + kstep;
            if (last && has_next) S.a_ready(nxt);
            if constexpr (SP2) {
            PG8_LDB(B0, 0, 0); PG8_LDB(B1, 0, 1); PG8_SCHED; PG8_LDA(At, 0, 0); PG8_STAGE(PG8_SA(1, 1), a1 + hstep, voffA);
            PG8_WAIT_V(8); PG8_WAIT_L(0); PG8_BAR; PG8_MMA(0, 0, At, B0); PG8_MMA(0, 1, At, B1); PG8_BAR; PG8_SCHED;
            PG8_LDA(At, 0, 1); PG8_STAGE(PG8_SB(0, 0), b2, voffB); PG8_STAGE(PG8_SB(0, 1), b2 + hstep, voffB); PG8_STAGE(PG8_SA(0, 0), a2, voffA);
            PG8_WAIT_V(8); PG8_WAIT_L(0); PG8_BAR; PG8_MMA(1, 0, At, B0); PG8_MMA(1, 1, At, B1); PG8_BAR; PG8_SCHED;
            PG8_LDB(B0, 1, 0); PG8_LDB(B1, 1, 1); PG8_SCHED; PG8_LDA(At, 1, 0); PG8_STAGE(PG8_SA(0, 1), a2 + hstep, voffA);
            PG8_WAIT_V(8); PG8_WAIT_L(0); PG8_BAR; PG8_MMA(0, 0, At, B0); PG8_MMA(0, 1, At, B1); PG8_BAR; PG8_SCHED;
            PG8_LDA(At, 1, 1); PG8_STAGE(PG8_SB(1, 0), b3, voffB); PG8_STAGE(PG8_SB(1, 1), b3 + hstep, voffB); PG8_STAGE(PG8_SA(1, 0), a3, voffA);
            PG8_WAIT_V(8); PG8_WAIT_L(0); PG8_BAR; PG8_MMA(1, 0, At, B0); PG8_MMA(1, 1, At, B1); PG8_BAR; PG8_SCHED;
            } else {
            PG8_LDB(B0, 0, 0); PG8_SCHED; PG8_LDA(At, 0, 0); PG8_STAGE(PG8_SA(1, 1), a1 + hstep, voffA);
            PG8_WAIT_L(8); PG8_BAR; PG8_WAIT_L(0); PG8_MMA(0, 0, At, B0); PG8_BAR; PG8_SCHED;
            PG8_LDB(B1, 0, 1); PG8_STAGE(PG8_SB(0, 0), b2, voffB);
            PG8_BAR; PG8_WAIT_L(0); PG8_MMA(0, 1, At, B1); PG8_BAR;
            PG8_LDA(At, 0, 1); PG8_STAGE(PG8_SA(0, 0), a2, voffA);
            PG8_BAR; PG8_WAIT_L(0); PG8_MMA(1, 0, At, B0); PG8_BAR; PG8_SCHED;
            PG8_STAGE(PG8_SB(0, 1), b2 + hstep, voffB);
            PG8_WAIT_V(6); PG8_BAR; PG8_MMA(1, 1, At, B1); PG8_BAR;
            PG8_LDB(B0, 1, 0); PG8_SCHED; PG8_LDA(At, 1, 0); PG8_STAGE(PG8_SA(0, 1), a2 + hstep, voffA);
            PG8_WAIT_L(8); PG8_BAR; PG8_WAIT_L(0); PG8_MMA(0, 0, At, B0); PG8_BAR; PG8_SCHED;
            PG8_LDB(B1, 1, 1); PG8_STAGE(PG8_SB(1, 0), b3, voffB);
            PG8_BAR; PG8_WAIT_L(0); PG8_MMA(0, 1, At, B1); PG8_BAR;
            PG8_LDA(At, 1, 1); PG8_STAGE(PG8_SA(1, 0), a3, voffA);
            PG8_BAR; PG8_WAIT_L(0); PG8_MMA(1, 0, At, B0); PG8_BAR; PG8_SCHED;
            PG8_STAGE(PG8_SB(1, 1), b3 + hstep, voffB);
            PG8_WAIT_V(6); PG8_BAR; PG8_MMA(1, 1, At, B1); PG8_BAR;
            }
        }
        if constexpr (ALIGN_EPI) { if (wr == 0) PG8_BAR; }
        if constexpr (!Epi::AFTER_DRAIN) { E(acc, cur, wr, wc, fr, fq); S.done(cur); }
        if (!has_next) break;
#pragma unroll
        for (int a = 0; a < 2; ++a)
#pragma unroll
            for (int b = 0; b < 2; ++b)
#pragma unroll
                for (int m = 0; m < 4; ++m)
#pragma unroll
                    for (int n = 0; n < 2; ++n) acc[a][b][m][n] = (f32x4){0.f, 0.f, 0.f, 0.f};
        cur = nxt; cA = nA; cB = nB; ++ui;
        if constexpr (ALIGN_EPI) { if (wr == 1) PG8_BAR; }
    }
    PG8_WAIT_V(0);
    if constexpr (!ALIGN_EPI) { if (wr == 0) PG8_BAR; }
    PG8_BAR;
    if constexpr (Epi::AFTER_DRAIN) { E.fused(acc, cur, wr, wc, fr, fq, lds, wid, lane); S.done(cur); }
#undef PG8_SA
#undef PG8_SB
#undef PG8_STAGE
#undef PG8_LDA
#undef PG8_LDB
#undef PG8_MMA
#undef PG8_WAIT_V
#undef PG8_WAIT_L
#undef PG8_BAR
#undef PG8_SCHED
}
}

struct EpiResGate {
    static constexpr bool PERM = false, AFTER_DRAIN = false;
    float* X; const float* gate;
    __device__ __forceinline__ void operator()(const pg8::f32x4 (&acc)[2][2][4][2], const pg8::Unit& u, int wr, int wc, int fr, int fq) const {
#pragma unroll
        for (int ai = 0; ai < 2; ++ai)
#pragma unroll
            for (int m = 0; m < 4; ++m) {
                const int r = u.pm * 256 + ai * 128 + wr * 64 + m * 16 + fr;
                const float* g = gate + (size_t)row_mod(r) * MODW; float* xr = X + (size_t)r * DM;
#pragma unroll
                for (int bj = 0; bj < 2; ++bj)
#pragma unroll
                    for (int n = 0; n < 2; ++n) {
                        const int c = u.pn * 256 + bj * 128 + wc * 32 + n * 16 + 4 * fq;
                        pg8::f32x4 xv = *(const pg8::f32x4*)(xr + c); const pg8::f32x4 gv = *(const pg8::f32x4*)(g + c);
                        xv = xv + gv * acc[ai][bj][m][n];
                        *(pg8::f32x4*)(xr + c) = xv;
                    }
            }
    }
};
#define LAS __attribute__((address_space(3)))
#define GAS __attribute__((address_space(1)))

__device__ __forceinline__ void ph_copy_in(const float* __restrict__ x, const float* __restrict__ ctx, float* __restrict__ X) {
    const int TID = opaque_tid(), BID = opaque_bid();
    size_t i = (size_t)BID * NT + TID;
    const size_t n4 = (size_t)RT * DM / 4, nl4 = (size_t)RL * DM / 4;
    for (; i < n4; i += (size_t)gridDim.x * NT) ((float4*)X)[i] = i < nl4 ? ((const float4*)x)[i] : ((const float4*)ctx)[i - nl4];
}
__device__ __forceinline__ void ph_copy_out(const float* __restrict__ X, float* __restrict__ out) {
    const int TID = opaque_tid(), BID = opaque_bid();
    size_t i = (size_t)BID * NT + TID;
    const size_t n4 = (size_t)RL * DM / 4;
    for (; i < n4; i += (size_t)gridDim.x * NT) ((float4*)out)[i] = ((const float4*)X)[i];
}
__device__ __forceinline__ void ph_rope_table(float2* __restrict__ rope) {
    const int TID = opaque_tid(), BID = opaque_bid();
    for (int i = BID * NT + TID; i < SEQ * 32; i += gridDim.x * NT) {
        int t = i >> 5, a = (i >> 4) & 1, f = i & 15;
        float pos = a == 0 ? (float)(t >> 6) : (float)(t & 63);
        float inv = powf(10000.f, -(float)f / 16.f);
        float ang = pos * inv;
        rope[i] = make_float2(cosf(ang), sinf(ang));
    }
}
__device__ __forceinline__ void transpose_item(const float* __restrict__ W, int N, bf16* __restrict__ WT, LAS float* scr, int item, int lane) {
    const int K = DM;
    const int nblk = N / 32, kb = item / nblk, nb = item % nblk, k0 = 64 * kb, n0 = 32 * nb;
#pragma unroll 8
    for (int i = 0; i < 32; ++i) { const int kk = 2 * i + (lane >> 5); scr[kk * 33 + (lane & 31)] = W[(size_t)(k0 + kk) * N + n0 + (lane & 31)]; }
    asm volatile("s_waitcnt lgkmcnt(0)" ::: "memory");
    const int c = lane & 7;
#pragma unroll
    for (int j = 0; j < 4; ++j) { const int n = (lane >> 3) + 8 * j; const LAS float* s = scr + (8 * c) * 33 + n;
        uint4 o; o.x = pk2(s[0 * 33], s[1 * 33]); o.y = pk2(s[2 * 33], s[3 * 33]); o.z = pk2(s[4 * 33], s[5 * 33]); o.w = pk2(s[6 * 33], s[7 * 33]);
        *(uint4*)(WT + (size_t)(n0 + n) * K + k0 + 8 * c) = o; }
    asm volatile("s_waitcnt lgkmcnt(0)" ::: "memory");
}
struct WPrep { const float* src[12]; bf16* dst[12]; };
__device__ __forceinline__ void ph_weight_prep(const float* const* in, bf16* WinE, bf16* WoutE, bf16* WinO, bf16* WoutO, bf16* Wpq, bf16* Kb, unsigned char* lds) {
    const int TID = opaque_tid(), BID = opaque_bid();
    const int lane = TID & 63, wv = TID >> 6;
    LAS float* scr = (LAS float*)((LAS unsigned char*)lds + wv * 16384);
    const int gw = BID * NWV + wv, NGW = gridDim.x * NWV;
    const int NITEMS = 2 * 1552 + 2 * 512 + 2 * 768 + 2 * 512 + 4 * 512;
    for (int it = gw; it < NITEMS; it += NGW) {
        int r = it;
        if (r < 3104) { int i = r / 1552; transpose_item(in[8] + (size_t)i * DM * EVEN_IN, EVEN_IN, WinE + (size_t)i * EVEN_LDP * DM, scr, r % 1552, lane); continue; } r -= 3104;
        if (r < 1024) { int i = r / 512; transpose_item(in[9] + (size_t)i * DM * DM, DM, WoutE + (size_t)i * DM * DM, scr, r % 512, lane); continue; } r -= 1024;
        if (r < 1536) { int i = r / 768; transpose_item(in[19] + (size_t)i * DM * ODD_IN, ODD_IN, WinO + (size_t)i * ODD_IN * DM, scr, r % 768, lane); continue; } r -= 1536;
        if (r < 1024) { int i = r / 512; transpose_item(in[20] + (size_t)i * DM * DM, DM, WoutO + (size_t)i * DM * DM, scr, r % 512, lane); continue; } r -= 1024;
        { int i = r / 512; transpose_item(in[23] + (size_t)i * DM * DM, DM, Wpq + (size_t)i * DM * DM, scr, r % 512, lane); }
    }
    for (int i4 = BID * NT + TID; i4 < DEPTH * 8 * 2 * 128 * 64 / 4; i4 += gridDim.x * NT) st4bf(Kb + 4 * (size_t)i4, ((const float4*)in[24])[i4]);
    for (int i = BID * NT + TID; i < 2 * 28672; i += gridDim.x * NT) {
        int w = i / 28672, o = i % 28672;
        ((uint4*)(WinE + (size_t)w * EVEN_LDP * DM + (size_t)EVEN_IN * DM))[o] = make_uint4(0u, 0u, 0u, 0u);
    }
}
__device__ __forceinline__ void ph_mods(const float* __restrict__ c, const float* __restrict__ cctx, const float* __restrict__ w_mod,
                        const float* __restrict__ b_mod, float* __restrict__ mods, float* smem) {
    const int TID = opaque_tid(), BID = opaque_bid();
    const int nslab = DEPTH * MODW / 128;
    if (BID >= nslab) return;
    const int lane = TID & 63, wv = TID >> 6, cl = lane & 15, kp = lane >> 4;
    float (*S)[DM] = (float (*)[DM])smem;
    for (int i = TID; i < NMOD * DM; i += NT) {
        int j = i / DM, k = i % DM;
        float v = j < 16 ? c[j * DM + k] : cctx[k];
        S[j][k] = silu_f(v);
    }
    __syncthreads();
    for (int slab = BID; slab < nslab; slab += gridDim.x) {
        const int l = slab / 48, n = (slab % 48) * 128 + wv * 16 + cl;
        const float* W = w_mod + (size_t)l * DM * MODW + n;
        float acc[NMOD];
#pragma unroll
        for (int j = 0; j < NMOD; ++j) acc[j] = 0.f;
#pragma unroll 4
        for (int kk = 0; kk < 256; ++kk) {
            const int k = kp * 256 + kk;
            const float w = W[(size_t)k * MODW];
#pragma unroll
            for (int j = 0; j < NMOD; ++j) acc[j] += S[j][k] * w;
        }
        const float bias = b_mod[l * MODW + n];
#pragma unroll
        for (int j = 0; j < NMOD; ++j) {
            float v = acc[j];
            v += __shfl_xor(v, 16); v += __shfl_xor(v, 32);
            if (kp == 0) mods[((size_t)l * NMOD + j) * MODW + n] = v + bias;
        }
    }
    __syncthreads();
}
__device__ __forceinline__ void ph_norm_mod(const float* __restrict__ X, const float* __restrict__ g, const float* __restrict__ mods_l, int shift_chunk, bf16* __restrict__ A) {
    const int TID = opaque_tid(), BID = opaque_bid();
    int wave = BID * NWV + (TID >> 6), lane = TID & 63;
    int nw = gridDim.x * NWV;
    for (int r = wave; r < RT; r += nw) {
        const float4* xr = (const float4*)(X + (size_t)r * DM);
        float4 v[4]; float s = 0.f;
#pragma unroll
        for (int i = 0; i < 4; ++i) { v[i] = xr[lane + 64 * i]; s += v[i].x * v[i].x + v[i].y * v[i].y + v[i].z * v[i].z + v[i].w * v[i].w; }
        s = wave_sum(s);
        float rstd = rsqrtf(s * (1.f / DM) + 1e-6f);
        const float* m = mods_l + (size_t)row_mod(r) * MODW;
        const float4* sh = (const float4*)(m + shift_chunk * DM);
        const float4* sc = (const float4*)(m + (shift_chunk + 1) * DM);
        const float4* g4 = (const float4*)g;
        bf16* ar = A + (size_t)r * DM;
#pragma unroll
        for (int i = 0; i < 4; ++i) {
            int c = lane + 64 * i;
            float4 gg = g4[c], a = sh[c], b = sc[c], o;
            o.x = v[i].x * rstd * gg.x * (1.f + b.x) + a.x;
            o.y = v[i].y * rstd * gg.y * (1.f + b.y) + a.y;
            o.z = v[i].z * rstd * gg.z * (1.f + b.z) + a.z;
            o.w = v[i].w * rstd * gg.w * (1.f + b.w) + a.w;
            st4bf(ar + 4 * c, o);
        }
    }
}
#define KVLEN (CTX + SEQ)
__device__ __forceinline__ void ph_post(bf16* __restrict__ P, int ldp, int nq, int kcol0, int nk, int vcol0, int VC, int DV,
                                        const float* __restrict__ qgain, const float* __restrict__ kgain, const float2* __restrict__ rope,
                                        bf16* __restrict__ Kc, bf16* __restrict__ Vt) {
    const int TID = opaque_tid(), BID = opaque_bid();
    const float C2 = 0.125f * 1.4426950408889634f;
    for (int tile = BID; tile < RT / 64; tile += gridDim.x) {
        const int r0 = tile * 64;
        int b, j0;
        if (r0 < RL) { b = r0 >> 11; j0 = CTX + (r0 & (SEQ - 1)); } else { b = (r0 - RL) >> 8; j0 = (r0 - RL) & (CTX - 1); }
        const int nh = nq + nk;
        for (int it = TID; it < 64 * nh; it += NT) {
            const int row = it / nh, hh = it % nh, r = r0 + row;
            const bool isk = hh >= nq; const int h = isk ? hh - nq : hh;
            bf16* src = P + (size_t)r * ldp + (isk ? kcol0 : 0) + h * 64;
            const float* gain = isk ? kgain : qgain;
            float v[64]; float s = 0.f;
#pragma unroll
            for (int i = 0; i < 16; ++i) { float4 t = ld4bf(src + 4 * i); v[4 * i] = t.x; v[4 * i + 1] = t.y; v[4 * i + 2] = t.z; v[4 * i + 3] = t.w; }
#pragma unroll
            for (int i = 0; i < 64; ++i) s += v[i] * v[i];
            const float rstd = rsqrtf(s * (1.f / 64.f) + 1e-6f) * (isk ? 1.f : C2);
#pragma unroll
            for (int i = 0; i < 64; ++i) v[i] = v[i] * rstd * gain[i];
            if (r < RL) {
                const float2* tab = rope + (size_t)(r & (SEQ - 1)) * 32;
#pragma unroll
                for (int a = 0; a < 2; ++a)
#pragma unroll
                    for (int f = 0; f < 16; ++f) {
                        float2 cs = tab[a * 16 + f];
                        float x1 = v[a * 32 + f], x2 = v[a * 32 + 16 + f];
                        v[a * 32 + f] = x1 * cs.x - x2 * cs.y;
                        v[a * 32 + 16 + f] = x2 * cs.x + x1 * cs.y;
                    }
            }
            bf16* dst = isk ? Kc + ((size_t)(b * nk + h) * KVLEN + j0 + row) * 64 : src;
#pragma unroll
            for (int i = 0; i < 16; ++i) st4bf(dst + 4 * i, make_float4(v[4 * i], v[4 * i + 1], v[4 * i + 2], v[4 * i + 3]));
        }
        if (TID < VC) {
            const int c8 = TID >> 3, rg = TID & 7;
            unsigned in[8][4];
#pragma unroll
            for (int rr = 0; rr < 8; ++rr) { uint4 t = *(const uint4*)(P + (size_t)(r0 + rg * 8 + rr) * ldp + vcol0 + c8 * 8); in[rr][0] = t.x; in[rr][1] = t.y; in[rr][2] = t.z; in[rr][3] = t.w; }
#pragma unroll
            for (int c = 0; c < 8; ++c) {
                unsigned o[4];
#pragma unroll
                for (int q = 0; q < 4; ++q)
                    o[q] = (c & 1) ? __builtin_amdgcn_perm(in[2 * q + 1][c >> 1], in[2 * q][c >> 1], 0x07060302u) : __builtin_amdgcn_perm(in[2 * q + 1][c >> 1], in[2 * q][c >> 1], 0x05040100u);
                const int col = c8 * 8 + c, vh = col / DV, d = col % DV;
                *(uint4*)(Vt + ((size_t)(b * 4 + vh) * DV + d) * KVLEN + j0 + rg * 8) = make_uint4(o[0], o[1], o[2], o[3]);
            }
        }
    }
}
typedef short bf16x8 __attribute__((ext_vector_type(8)));
typedef float f32x16 __attribute__((ext_vector_type(16)));
__device__ __forceinline__ int crow(int r, int hi) { return (r & 3) + 8 * (r >> 2) + 4 * hi; }
__device__ __forceinline__ unsigned cvt_pk_bf16_f32(float lo, float hi) { f32x2_t v = {lo, hi}; bf16x2_t b = __builtin_convertvector(v, bf16x2_t); return __builtin_bit_cast(unsigned, b); }
#define ATT_KPITCH 144
#define ATT_VPITCH 136
template <int DV>
__device__ __forceinline__ void attn_unit(const bf16* __restrict__ Qbase, int ldq, const bf16* __restrict__ Kc, const bf16* __restrict__ Vt, int ntiles,
                                          bf16* __restrict__ Obase, int ldo, unsigned char* lds, int tid) {
    constexpr int NDB = DV / 32, NVL = DV / 64, KBYTES = 64 * ATT_KPITCH, BUFSZ = KBYTES + DV * ATT_VPITCH;
    constexpr float THR = 8.f;
    const int lane = tid & 63, wid = tid >> 6, r32 = lane & 31, hi = lane >> 5;
    float* sc = (float*)(lds + 2 * BUFSZ + wid * 128);
    bf16x8 qf[4];
    {
        const bf16* qrow = Qbase + (size_t)(wid * 32 + r32) * ldq;
#pragma unroll
        for (int s = 0; s < 4; ++s) qf[s] = *(const bf16x8*)(qrow + 16 * s + 8 * hi);
    }
    f32x16 o[NDB];
#pragma unroll
    for (int d = 0; d < NDB; ++d)
#pragma unroll
        for (int r = 0; r < 16; ++r) o[d][r] = 0.f;
    float m = -1e30f, l = 0.f;
    uint4 kreg, vreg[NVL];
    const int krow = tid >> 3, kch = tid & 7;
#define ATT_LOAD(t) do { kreg = *(const uint4*)(Kc + (size_t)(t) * 64 * 64 + tid * 8); \
        _Pragma("unroll") for (int u = 0; u < NVL; ++u) { const int idx = tid + NT * u; vreg[u] = *(const uint4*)(Vt + (size_t)(idx >> 3) * KVLEN + (t) * 64 + (idx & 7) * 8); } } while (0)
#define ATT_STORE(buf) do { *(uint4*)(lds + (buf) * BUFSZ + krow * ATT_KPITCH + kch * 16) = kreg; \
        _Pragma("unroll") for (int u = 0; u < NVL; ++u) { const int idx = tid + NT * u; unsigned char* vp = lds + (buf) * BUFSZ + KBYTES + (idx >> 3) * ATT_VPITCH + (idx & 7) * 16; \
            *(uint2*)vp = make_uint2(vreg[u].x, vreg[u].y); *(uint2*)(vp + 8) = make_uint2(vreg[u].z, vreg[u].w); } } while (0)
    ATT_LOAD(0);
    ATT_STORE(0);
    __syncthreads();
    for (int t = 0; t < ntiles; ++t) {
        const int buf = t & 1;
        if (t + 1 < ntiles) ATT_LOAD(t + 1);
        const unsigned char* kb = lds + buf * BUFSZ;
        const unsigned char* vb = kb + KBYTES;
        f32x16 s0, s1;
#pragma unroll
        for (int r = 0; r < 16; ++r) { s0[r] = 0.f; s1[r] = 0.f; }
#pragma unroll
        for (int s = 0; s < 4; ++s) {
            const bf16x8 a0 = *(const bf16x8*)(kb + r32 * ATT_KPITCH + s * 32 + hi * 16);
            const bf16x8 a1 = *(const bf16x8*)(kb + (32 + r32) * ATT_KPITCH + s * 32 + hi * 16);
            s0 = __builtin_amdgcn_mfma_f32_32x32x16_bf16(a0, qf[s], s0, 0, 0, 0);
            s1 = __builtin_amdgcn_mfma_f32_32x32x16_bf16(a1, qf[s], s1, 0, 0, 0);
        }
        float tm = fmaxf(s0[0], s1[0]);
#pragma unroll
        for (int r = 1; r < 16; ++r) tm = fmaxf(tm, fmaxf(s0[r], s1[r]));
        tm = fmaxf(tm, __shfl_xor(tm, 32));
        if (__any(tm > m + THR)) {
            const float mn = fmaxf(m, tm), alpha = exp2f(m - mn);
            m = mn; l *= alpha;
            if (hi == 0) sc[r32] = alpha;
#pragma unroll
            for (int r = 0; r < 16; ++r) { const float a = sc[crow(r, hi)];
#pragma unroll
                for (int d = 0; d < NDB; ++d) o[d][r] *= a; }
        }
        float ps = 0.f;
#pragma unroll
        for (int r = 0; r < 16; ++r) { s0[r] = exp2f(s0[r] - m); s1[r] = exp2f(s1[r] - m); ps += s0[r] + s1[r]; }
        l += ps;
        bf16x8 pa[4];
#pragma unroll
        for (int s = 0; s < 4; ++s) {
            unsigned w[4];
#pragma unroll
            for (int k = 0; k < 4; ++k) w[k] = (s < 2) ? cvt_pk_bf16_f32(s0[8 * (s & 1) + 2 * k], s0[8 * (s & 1) + 2 * k + 1]) : cvt_pk_bf16_f32(s1[8 * (s & 1) + 2 * k], s1[8 * (s & 1) + 2 * k + 1]);
            uint4 pw = make_uint4(w[0], w[1], w[2], w[3]);
            pa[s] = __builtin_bit_cast(bf16x8, pw);
        }
#pragma unroll
        for (int d = 0; d < NDB; ++d) {
#pragma unroll
            for (int s = 0; s < 4; ++s) {
                const unsigned char* vp = vb + (32 * d + r32) * ATT_VPITCH + 32 * s + 8 * hi;
                const uint2 v0 = *(const uint2*)vp, v1 = *(const uint2*)(vp + 16);
                uint4 vw = make_uint4(v0.x, v0.y, v1.x, v1.y);
                o[d] = __builtin_amdgcn_mfma_f32_32x32x16_bf16(pa[s], __builtin_bit_cast(bf16x8, vw), o[d], 0, 0, 0);
            }
        }
        if (t + 1 < ntiles) ATT_STORE(buf ^ 1);
        __syncthreads();
    }
#undef ATT_LOAD
#undef ATT_STORE
    l += __shfl_xor(l, 32);
    if (hi == 0) sc[r32] = 1.f / l;
#pragma unroll
    for (int r = 0; r < 16; ++r) {
        const float iv = sc[crow(r, hi)];
        bf16* orow = Obase + (size_t)(wid * 32 + crow(r, hi)) * ldo + r32;
#pragma unroll
        for (int d = 0; d < NDB; ++d) orow[32 * d] = (bf16)f2bf(o[d][r] * iv);
    }
    __syncthreads();
}
__device__ __forceinline__ void ph_attn_mfma(const bf16* __restrict__ P, int ldp, const bf16* __restrict__ Kc, const bf16* __restrict__ Vt, bf16* __restrict__ ATT,
                                             int odd, int with_ctx, unsigned char* lds) {
    const int TID = opaque_tid(), BID = opaque_bid();
    const int G = gridDim.x, vcu = (G % 8 == 0) ? (BID & 7) * (G >> 3) + (BID >> 3) : BID;
    const int nlat = odd ? 2048 : 1024, nctx = with_ctx ? (odd ? 256 : 128) : 0;
    for (int u = vcu; u < nlat + nctx; u += G) {
        int b, qh, row0, ntiles;
        if (u < nlat) {
            if (odd) { const int grp = u >> 5, w = u & 31; b = grp >> 2; qh = (grp & 3) * 4 + (w >> 3); row0 = b * SEQ + (w & 7) * 256; }
            else { const int grp = u >> 4, w = u & 15; b = grp >> 2; qh = (grp & 3) * 2 + (w >> 3); row0 = b * SEQ + (w & 7) * 256; }
            ntiles = KVLEN / 64;
        } else {
            const int idx = u - nlat;
            if (odd) { b = idx >> 4; qh = idx & 15; } else { b = idx >> 3; qh = idx & 7; }
            row0 = RL + b * CTX; ntiles = CTX / 64;
        }
        if (odd) attn_unit<64>(P + (size_t)row0 * ldp + qh * 64, ldp, Kc + (size_t)(b * 4 + (qh >> 2)) * KVLEN * 64, Vt + (size_t)(b * 4 + (qh >> 2)) * 64 * KVLEN, ntiles,
                               ATT + (size_t)row0 * DM + qh * 64, DM, lds, TID);
        else attn_unit<128>(P + (size_t)row0 * ldp + qh * 64, ldp, Kc + (size_t)(b * 8 + qh) * KVLEN * 64, Vt + (size_t)(b * 4 + (qh >> 1)) * 128 * KVLEN, ntiles,
                            ATT + (size_t)row0 * DM + qh * 128, DM, lds, TID);
    }
}
typedef float f32x4_t __attribute__((ext_vector_type(4)));
#define GLA_PITCH 144
__device__ __forceinline__ void ph_gla_chunk(const bf16* __restrict__ P, const float* __restrict__ w_af, const float* __restrict__ b_af,
                                             const float* __restrict__ w_ab, const float* __restrict__ b_ab, float* __restrict__ OF, float* __restrict__ OB, unsigned char* lds) {
    const int TID = opaque_tid(), BID = opaque_bid();
    const int tid = TID, lane = tid & 63, wid = tid >> 6, l15 = lane & 15, q4 = lane >> 4;
    float* SEG = (float*)lds;
    float* DEC = (float*)(lds + 2048);
    unsigned char* QD = lds + 4096;
    unsigned char* KI = QD + 9216;
    unsigned char* KET = KI + 9216;
    unsigned char* AT = KET + 9216;
    unsigned char* VT = AT + 9216;
    for (int unit = BID; unit < NB * 4 * 2; unit += gridDim.x) {
        const int dir = unit & 1, h = (unit >> 1) & 3, b = unit >> 3;
        const float* wa = dir ? w_ab : w_af; const float* ba = dir ? b_ab : b_af;
        float* Od = dir ? OB : OF;
        const int d = tid & 63, seg = tid >> 6;
        float wreg[16];
#pragma unroll
        for (int j = 0; j < 16; ++j) wreg[j] = wa[j * 256 + h * 64 + d];
        const float breg = ba[h * 64 + d];
        for (int i = tid; i < 9216 / 16; i += NT) ((uint4*)AT)[i] = make_uint4(0u, 0u, 0u, 0u);
        f32x4_t S[4];
#pragma unroll
        for (int i = 0; i < 4; ++i) S[i] = (f32x4_t){0.f, 0.f, 0.f, 0.f};
        __syncthreads();
        for (int ch = 0; ch < KVLEN / 64; ++ch) {
            int rbase, rsgn;
            if (!dir) { rbase = ch < 4 ? RL + b * CTX + ch * 64 : b * SEQ + (ch - 4) * 64; rsgn = 1; }
            else { rbase = ch < 4 ? RL + b * CTX + (CTX - 1 - ch * 64) : b * SEQ + (SEQ - 1 - (ch - 4) * 64); rsgn = -1; }
            float cl[8];
            {
                float run = 0.f;
#pragma unroll
                for (int i = 0; i < 8; ++i) {
                    const bf16* pr = P + (size_t)(rbase + rsgn * (8 * seg + i)) * EVEN_LDP + 3072 + dir * 16;
                    const uint4 g0 = *(const uint4*)pr, g1 = *(const uint4*)(pr + 8);
                    const unsigned gw[8] = {g0.x, g0.y, g0.z, g0.w, g1.x, g1.y, g1.z, g1.w};
                    float z = breg;
#pragma unroll
                    for (int j = 0; j < 8; ++j) { z += __uint_as_float(gw[j] << 16) * wreg[2 * j]; z += __uint_as_float(gw[j] & 0xffff0000u) * wreg[2 * j + 1]; }
                    run += log_sigmoid_f(z) * (1.f / 16.f);
                    cl[i] = run;
                }
                SEG[seg * 64 + d] = run;
            }
            __syncthreads();
            {
                float prefix = 0.f, total = 0.f;
#pragma unroll
                for (int s2 = 0; s2 < 8; ++s2) { const float v = SEG[s2 * 64 + d]; total += v; prefix += (s2 < seg) ? v : 0.f; }
                if (seg == 0) DEC[d] = __expf(total);
                unsigned kew[4];
#pragma unroll
                for (int i = 0; i < 8; ++i) {
                    const int c = 8 * seg + i;
                    const bf16* pr = P + (size_t)(rbase + rsgn * c) * EVEN_LDP;
                    const float qv = bf2f(pr[1536 + h * 64 + d]) * 0.125f, kv = bf2f(pr[1792 + h * 64 + d]);
                    const float cum = prefix + cl[i];
                    const float e = __expf(cum), ei = __expf(-cum), ee = __expf(total - cum);
                    *(bf16*)(QD + c * GLA_PITCH + d * 2) = (bf16)f2bf(qv * e);
                    *(bf16*)(KI + c * GLA_PITCH + d * 2) = (bf16)f2bf(kv * ei);
                    const unsigned kb = f2bf(kv * ee);
                    if (i & 1) kew[i >> 1] |= kb << 16; else kew[i >> 1] = kb;
                }
                *(uint4*)(KET + d * GLA_PITCH + seg * 16) = make_uint4(kew[0], kew[1], kew[2], kew[3]);
                const int v = tid & 127, cg = tid >> 7;
                unsigned vw[8];
#pragma unroll
                for (int i = 0; i < 16; ++i) {
                    const unsigned x = P[(size_t)(rbase + rsgn * (16 * cg + i)) * EVEN_LDP + 2048 + h * 128 + v];
                    if (i & 1) vw[i >> 1] |= x << 16; else vw[i >> 1] = x;
                }
                *(uint4*)(VT + v * GLA_PITCH + cg * 32) = make_uint4(vw[0], vw[1], vw[2], vw[3]);
                *(uint4*)(VT + v * GLA_PITCH + cg * 32 + 16) = make_uint4(vw[4], vw[5], vw[6], vw[7]);
            }
            __syncthreads();
            for (int blk = wid; blk < 10; blk += NWV) {
                int sblk, cblk;
                if (blk < 4) { sblk = 0; cblk = blk; } else if (blk < 7) { sblk = 1; cblk = blk - 3; } else if (blk < 9) { sblk = 2; cblk = blk - 5; } else { sblk = 3; cblk = 3; }
                f32x4_t acc = (f32x4_t){0.f, 0.f, 0.f, 0.f};
#pragma unroll
                for (int kk = 0; kk < 2; ++kk) {
                    const bf16x8 a = *(const bf16x8*)(KI + (16 * sblk + l15) * GLA_PITCH + 64 * kk + 16 * q4);
                    const bf16x8 bq = *(const bf16x8*)(QD + (16 * cblk + l15) * GLA_PITCH + 64 * kk + 16 * q4);
                    acc = __builtin_amdgcn_mfma_f32_16x16x32_bf16(a, bq, acc, 0, 0, 0);
                }
                const int c = 16 * cblk + l15, s0 = 16 * sblk + 4 * q4;
                float av[4];
#pragma unroll
                for (int r = 0; r < 4; ++r) av[r] = (s0 + r <= c) ? acc[r] : 0.f;
                *(uint2*)(AT + c * GLA_PITCH + s0 * 2) = make_uint2(pk2(av[0], av[1]), pk2(av[2], av[3]));
            }
            __syncthreads();
            {
                const int v0 = 16 * wid;
                bf16x8 bv[2], sB[2];
#pragma unroll
                for (int kk = 0; kk < 2; ++kk) {
                    bv[kk] = *(const bf16x8*)(VT + (v0 + l15) * GLA_PITCH + 64 * kk + 16 * q4);
                    uint4 w = make_uint4(pk2(S[2 * kk][0], S[2 * kk][1]), pk2(S[2 * kk][2], S[2 * kk][3]), pk2(S[2 * kk + 1][0], S[2 * kk + 1][1]), pk2(S[2 * kk + 1][2], S[2 * kk + 1][3]));
                    sB[kk] = __builtin_bit_cast(bf16x8, w);
                }
#pragma unroll
                for (int cblk = 0; cblk < 4; ++cblk) {
                    f32x4_t acc = (f32x4_t){0.f, 0.f, 0.f, 0.f};
                    const unsigned char* arow = AT + (16 * cblk + l15) * GLA_PITCH;
                    const unsigned char* qrow = QD + (16 * cblk + l15) * GLA_PITCH;
#pragma unroll
                    for (int kk = 0; kk < 2; ++kk) {
                        if (kk == 0 || cblk >= 2) {
                            const bf16x8 a = *(const bf16x8*)(arow + 64 * kk + 16 * q4);
                            acc = __builtin_amdgcn_mfma_f32_16x16x32_bf16(a, bv[kk], acc, 0, 0, 0);
                        }
                    }
#pragma unroll
                    for (int kk = 0; kk < 2; ++kk) {
                        const uint2 a0 = *(const uint2*)(qrow + 64 * kk + 8 * q4), a1 = *(const uint2*)(qrow + 64 * kk + 32 + 8 * q4);
                        uint4 aw = make_uint4(a0.x, a0.y, a1.x, a1.y);
                        acc = __builtin_amdgcn_mfma_f32_16x16x32_bf16(__builtin_bit_cast(bf16x8, aw), sB[kk], acc, 0, 0, 0);
                    }
#pragma unroll
                    for (int r = 0; r < 4; ++r) Od[(size_t)(rbase + rsgn * (16 * cblk + 4 * q4 + r)) * 512 + h * 128 + v0 + l15] = acc[r];
                }
#pragma unroll
                for (int dblk = 0; dblk < 4; ++dblk) {
#pragma unroll
                    for (int r = 0; r < 4; ++r) S[dblk][r] *= DEC[16 * dblk + 4 * q4 + r];
#pragma unroll
                    for (int kk = 0; kk < 2; ++kk) {
                        const bf16x8 a = *(const bf16x8*)(KET + (16 * dblk + l15) * GLA_PITCH + 64 * kk + 16 * q4);
                        S[dblk] = __builtin_amdgcn_mfma_f32_16x16x32_bf16(a, bv[kk], S[dblk], 0, 0, 0);
                    }
                }
            }
            __syncthreads();
        }
    }
}
__device__ __forceinline__ void ph_even_post(bf16* __restrict__ ATT, const float* __restrict__ lamv, const float* __restrict__ subln, float lam_init,
                             const float* __restrict__ OF, const float* __restrict__ OB, const bf16* __restrict__ P, const float* __restrict__ gain) {
    const int TID = opaque_tid(), BID = opaque_bid();
    int wave = BID * NWV + (TID >> 6), lane = TID & 63;
    int nw = gridDim.x * NWV;
    float p1 = lamv[lane] * lamv[64 + lane], p2 = lamv[128 + lane] * lamv[192 + lane];
    p1 = wave_sum(p1); p2 = wave_sum(p2);
    const float lam = expf(p1) - expf(p2) + lam_init;
    for (int r = wave; r < RT; r += nw) {
        bf16* a = ATT + (size_t)r * DM;
        float d[4][2];
#pragma unroll
        for (int h = 0; h < 4; ++h) {
            float2 o0 = ld2bf(a + (2 * h) * 128 + lane * 2);
            float2 o1 = ld2bf(a + (2 * h + 1) * 128 + lane * 2);
            d[h][0] = o0.x - lam * o1.x; d[h][1] = o0.y - lam * o1.y;
        }
        float2 outd[4];
#pragma unroll
        for (int h = 0; h < 4; ++h) {
            float s = wave_sum(d[h][0] * d[h][0] + d[h][1] * d[h][1]);
            float rstd = rsqrtf(s * (1.f / 128.f) + 1e-6f) * (1.f - lam_init);
            float2 sg = *(const float2*)(subln + lane * 2);
            outd[h] = make_float2(d[h][0] * rstd * sg.x, d[h][1] * rstd * sg.y);
        }
        float2 outg[4];
#pragma unroll
        for (int h = 0; h < 4; ++h) {
            float2 x = *(const float2*)(OF + (size_t)r * 512 + h * 128 + lane * 2);
            float2 c = *(const float2*)(OB + (size_t)r * 512 + h * 128 + lane * 2);
            float o0 = x.x + c.x, o1 = x.y + c.y;
            float s = wave_sum(o0 * o0 + o1 * o1);
            float rstd = rsqrtf(s * (1.f / 128.f) + 1e-6f);
            float2 g = *(const float2*)(gain + lane * 2);
            float2 rr = ld2bf(P + (size_t)r * EVEN_LDP + 2560 + h * 128 + lane * 2);
            outg[h] = make_float2(o0 * rstd * g.x * silu_f(rr.x), o1 * rstd * g.y * silu_f(rr.y));
        }
#pragma unroll
        for (int h = 0; h < 4; ++h) {
            st2bf(a + h * 128 + lane * 2, outd[h]);
            st2bf(a + 512 + h * 128 + lane * 2, outg[h]);
        }
    }
}
#define INS16(tv, ti, v, n) do { \
    _Pragma("unroll") for (int j_ = 15; j_ >= 1; --j_) { bool c1_ = (v) > tv[j_ - 1]; bool c2_ = (v) > tv[j_]; \
        tv[j_] = c1_ ? tv[j_ - 1] : (c2_ ? (v) : tv[j_]); ti[j_] = c1_ ? ti[j_ - 1] : (c2_ ? (n) : ti[j_]); } \
    { bool c_ = (v) > tv[0]; tv[0] = c_ ? (v) : tv[0]; ti[0] = c_ ? (n) : ti[0]; } } while (0)

__device__ __forceinline__ void ph_peer_ffn(const bf16* __restrict__ A2, const int* __restrict__ IDX, const float* __restrict__ GATE,
                            const float* __restrict__ U, const float* __restrict__ V, const float* __restrict__ mods_l, float* __restrict__ X) {
    const int TID = opaque_tid(), BID = opaque_bid();
    int wave = BID * NWV + (TID >> 6), lane = TID & 63;
    int nw = gridDim.x * NWV;
    for (int r = wave; r < RT; r += nw) {
        float4 xa[4], acc[4];
#pragma unroll
        for (int i = 0; i < 4; ++i) { xa[i] = ld4bf(A2 + (size_t)r * DM + 4 * (lane + 64 * i)); acc[i] = make_float4(0.f, 0.f, 0.f, 0.f); }
        for (int e = 0; e < 128; ++e) {
            int id = IDX[(size_t)r * 128 + e]; float g = GATE[(size_t)r * 128 + e];
            const float4* ur = (const float4*)(U + (size_t)id * DM);
            float d = 0.f;
#pragma unroll
            for (int i = 0; i < 4; ++i) { float4 u = ur[lane + 64 * i]; d += u.x * xa[i].x + u.y * xa[i].y + u.z * xa[i].z + u.w * xa[i].w; }
            d = wave_sum(d);
            float w = g * gelu_tanh(d);
            const float4* vr = (const float4*)(V + (size_t)id * DM);
#pragma unroll
            for (int i = 0; i < 4; ++i) { float4 v = vr[lane + 64 * i]; acc[i].x += w * v.x; acc[i].y += w * v.y; acc[i].z += w * v.z; acc[i].w += w * v.w; }
        }
        const float4* g5 = (const float4*)(mods_l + (size_t)row_mod(r) * MODW + 5 * DM);
        float4* xr = (float4*)(X + (size_t)r * DM);
#pragma unroll
        for (int i = 0; i < 4; ++i) { float4 x = xr[lane + 64 * i], gg = g5[lane + 64 * i];
            x.x += gg.x * acc[i].x; x.y += gg.y * acc[i].y; x.z += gg.z * acc[i].z; x.w += gg.w * acc[i].w; xr[lane + 64 * i] = x; }
    }
}
#define RT_KPITCH 144
#define INSP16(t, x) do { unsigned x_ = (x); _Pragma("unroll") for (int j_ = 0; j_ < 16; ++j_) { const unsigned h_ = max(t[j_], x_); x_ = min(t[j_], x_); t[j_] = h_; } } while (0)
__device__ __forceinline__ void ph_route_mfma(const bf16* __restrict__ Qp, const bf16* __restrict__ Kb, int* __restrict__ IDX, float* __restrict__ GATE, unsigned char* lds, int nrows) {
    const int TID = opaque_tid(), BID = opaque_bid();
    const int tid = TID, lane = tid & 63, wid = tid >> 6, r32 = lane & 31, hi = lane >> 5;
    for (int u = BID; u < (nrows / 256) * 8; u += gridDim.x) {
        const int h = u & 7, row = (u >> 3) * 256 + wid * 32 + r32;
        __syncthreads();
        for (int i = tid; i < 2 * 128 * 8; i += NT) *(uint4*)(lds + (i >> 3) * RT_KPITCH + (i & 7) * 16) = *(const uint4*)(Kb + ((size_t)h * 256 + (i >> 3)) * 64 + (i & 7) * 8);
        __syncthreads();
        unsigned L[2][16];
#pragma unroll
        for (int half = 0; half < 2; ++half) {
            bf16x8 qf[4];
            const bf16* qrow = Qp + (size_t)row * DM + h * 128 + half * 64;
#pragma unroll
            for (int s = 0; s < 4; ++s) qf[s] = *(const bf16x8*)(qrow + 16 * s + 8 * hi);
#pragma unroll
            for (int j = 0; j < 16; ++j) L[half][j] = 0u;
#pragma unroll
            for (int nb = 0; nb < 4; ++nb) {
                f32x16 acc;
#pragma unroll
                for (int r = 0; r < 16; ++r) acc[r] = 0.f;
#pragma unroll
                for (int s = 0; s < 4; ++s) {
                    const bf16x8 a = *(const bf16x8*)(lds + (half * 128 + 32 * nb + r32) * RT_KPITCH + 32 * s + 16 * hi);
                    acc = __builtin_amdgcn_mfma_f32_32x32x16_bf16(a, qf[s], acc, 0, 0, 0);
                }
#pragma unroll
                for (int r = 0; r < 16; ++r) {
                    unsigned ub = __float_as_uint(acc[r]);
                    ub = (ub & 0x80000000u) ? ~ub : (ub | 0x80000000u);
                    const unsigned x = (ub & ~127u) | (unsigned)(127 - (32 * nb + (r & 3) + 8 * (r >> 2)) - 4 * hi);
                    INSP16(L[half], x);
                }
                __builtin_amdgcn_sched_barrier(0);
            }
            unsigned o[16];
#pragma unroll
            for (int j = 0; j < 16; ++j) o[j] = __shfl_xor(L[half][j], 32);
#pragma unroll
            for (int j = 0; j < 16; ++j) INSP16(L[half], o[j]);
            __builtin_amdgcn_sched_barrier(0);
        }
        float v1[16], v2[16];
        {
            unsigned w1[4] = {0u, 0u, 0u, 0u}, w2[4] = {0u, 0u, 0u, 0u};
#pragma unroll
            for (int j = 0; j < 16; ++j) {
                unsigned a = L[0][j] & ~127u, b = L[1][j] & ~127u;
                a = (a & 0x80000000u) ? (a & 0x7fffffffu) : ~a; b = (b & 0x80000000u) ? (b & 0x7fffffffu) : ~b;
                v1[j] = __uint_as_float(a); v2[j] = __uint_as_float(b);
                w1[j >> 2] |= (127u - (L[0][j] & 127u)) << (8 * (j & 3)); w2[j >> 2] |= (127u - (L[1][j] & 127u)) << (8 * (j & 3));
            }
            unsigned char* sb = lds + 2 * 128 * RT_KPITCH + tid * 4;
#pragma unroll
            for (int k = 0; k < 4; ++k) { *(unsigned*)(sb + k * 2048) = w1[k]; *(unsigned*)(sb + (4 + k) * 2048) = w2[k]; }
        }
        unsigned T[16];
#pragma unroll
        for (int j = 0; j < 16; ++j) T[j] = 0u;
#pragma unroll
        for (int a = 0; a < 16; ++a)
#pragma unroll
            for (int b = 0; b < 16; ++b) {
                if ((a + 1) * (b + 1) <= 16) {
                    unsigned ub = __float_as_uint(v1[a] + v2[b]);
                    ub = (ub & 0x80000000u) ? ~ub : (ub | 0x80000000u);
                    const unsigned x = (ub & ~255u) | (unsigned)(255 - (16 * a + b));
                    INSP16(T, x);
                }
            }
        float e[16]; int bi[16]; float sum = 0.f, v0 = 0.f;
        {
            const unsigned char* sb = lds + 2 * 128 * RT_KPITCH + tid * 4;
#pragma unroll
            for (int j = 0; j < 16; ++j) {
                unsigned ub = T[j] & ~255u;
                ub = (ub & 0x80000000u) ? (ub & 0x7fffffffu) : ~ub;
                const float val = __uint_as_float(ub);
                if (j == 0) v0 = val;
                e[j] = __expf(val - v0); sum += e[j];
                const unsigned flat = 255u - (T[j] & 255u), ca = flat >> 4, cb = flat & 15u;
                const unsigned ia = *(const unsigned char*)(sb + (ca >> 2) * 2048 + (ca & 3)), ib = *(const unsigned char*)(sb + (4 + (cb >> 2)) * 2048 + (cb & 3));
                bi[j] = (int)(ia * 128u + ib);
            }
        }
        const float inv = 1.f / sum;
        if (hi == 0) {
            int* ip = IDX + (size_t)row * 128 + h * 16; float* gp = GATE + (size_t)row * 128 + h * 16;
#pragma unroll
            for (int j = 0; j < 4; ++j) {
                *(int4*)(ip + 4 * j) = make_int4(bi[4 * j], bi[4 * j + 1], bi[4 * j + 2], bi[4 * j + 3]);
                *(float4*)(gp + 4 * j) = make_float4(e[4 * j] * inv, e[4 * j + 1] * inv, e[4 * j + 2] * inv, e[4 * j + 3] * inv);
            }
        }
    }
    __syncthreads();
}
__device__ __forceinline__ void ph_table_prep(const float* __restrict__ U, const float* __restrict__ V, unsigned char* __restrict__ T8, float* __restrict__ RS) {
    const int TID = opaque_tid(), BID = opaque_bid();
    const int wave = BID * NWV + (TID >> 6), lane = TID & 63, nw = gridDim.x * NWV;
    const int NROWS = DEPTH * 16384;
    for (int rr = wave; rr < 2 * NROWS; rr += nw) {
        const float* src = (rr < NROWS ? U : V) + (size_t)(rr < NROWS ? rr : rr - NROWS) * DM + lane * 16;
        float4 v[4]; float am = 0.f;
#pragma unroll
        for (int i = 0; i < 4; ++i) { v[i] = ((const float4*)src)[i]; am = fmaxf(am, fmaxf(fmaxf(fabsf(v[i].x), fabsf(v[i].y)), fmaxf(fabsf(v[i].z), fabsf(v[i].w)))); }
#pragma unroll
        for (int o = 1; o < 64; o <<= 1) am = fmaxf(am, __shfl_xor(am, o));
        am = fmaxf(am, 1e-30f);
        const float sc = exp2f(floorf(log2f(448.f / am)) - 1.f);
        int w[4];
#pragma unroll
        for (int i = 0; i < 4; ++i) { int t = 0; t = __builtin_amdgcn_cvt_pk_fp8_f32(v[i].x * sc, v[i].y * sc, t, false); t = __builtin_amdgcn_cvt_pk_fp8_f32(v[i].z * sc, v[i].w * sc, t, true); w[i] = t; }
        *(uint4*)(T8 + (size_t)rr * DM + lane * 16) = make_uint4((unsigned)w[0], (unsigned)w[1], (unsigned)w[2], (unsigned)w[3]);
        if (lane == 0) RS[rr] = 1.f / sc;
    }
}
#define BR4(j) ((((j) & 1) << 3) | (((j) & 2) << 1) | (((j) & 4) >> 1) | (((j) & 8) >> 3))
__device__ __forceinline__ float dot16_fp8_bf16(uint4 u, const unsigned (&x)[8]) {
    float d = 0.f;
    const unsigned uw[4] = {u.x, u.y, u.z, u.w};
#pragma unroll
    for (int i = 0; i < 4; ++i) {
        bf16x2_t lo = __builtin_amdgcn_cvt_scalef32_pk_bf16_fp8(uw[i], 1.0f, false);
        bf16x2_t hi = __builtin_amdgcn_cvt_scalef32_pk_bf16_fp8(uw[i], 1.0f, true);
        d = __builtin_amdgcn_fdot2_f32_bf16(lo, __builtin_bit_cast(bf16x2_t, x[2 * i]), d, false);
        d = __builtin_amdgcn_fdot2_f32_bf16(hi, __builtin_bit_cast(bf16x2_t, x[2 * i + 1]), d, false);
    }
    return d;
}
__device__ __forceinline__ void ph_peer_ffn8(const bf16* A2, const int* __restrict__ IDX, const float* __restrict__ GATE,
                            const unsigned char* __restrict__ U8, const float* __restrict__ RSU, const unsigned char* __restrict__ V8, const float* __restrict__ RSV,
                            const float* __restrict__ mods_l, const float* X, float* Xout, int nrows,
                            const float* __restrict__ gnext, const float* __restrict__ mods_next, bf16* Anext) {
    const int TID = opaque_tid(), BID = opaque_bid();
    const int wave = BID * NWV + (TID >> 6), lane = TID & 63, nw = gridDim.x * NWV;
    const int jl = BR4(lane & 15);
    for (int r = wave; r < nrows; r += nw) {
        unsigned x[8];
        { const uint4* xp = (const uint4*)(A2 + (size_t)r * DM + lane * 16); uint4 a = xp[0], b = xp[1]; x[0] = a.x; x[1] = a.y; x[2] = a.z; x[3] = a.w; x[4] = b.x; x[5] = b.y; x[6] = b.z; x[7] = b.w; }
        float acc[16];
#pragma unroll
        for (int k = 0; k < 16; ++k) acc[k] = 0.f;
        for (int g = 0; g < 8; ++g) {
            const int myid = IDX[(size_t)r * 128 + g * 16 + jl];
            const float mygate = GATE[(size_t)r * 128 + g * 16 + jl];
            const float rsu = RSU[myid], rsv = RSV[myid];
            uint4 ub[16], vb[16];
#pragma unroll
            for (int j = 0; j < 16; ++j) { const int id = __builtin_amdgcn_readlane(myid, BR4(j)); ub[j] = *(const uint4*)(U8 + (size_t)id * DM + lane * 16); }
#pragma unroll
            for (int j = 0; j < 16; ++j) { const int id = __builtin_amdgcn_readlane(myid, BR4(j)); vb[j] = *(const uint4*)(V8 + (size_t)id * DM + lane * 16); }
            float d[16];
#pragma unroll
            for (int j = 0; j < 16; ++j) d[j] = dot16_fp8_bf16(ub[j], x);
#pragma unroll
            for (int st = 0; st < 4; ++st) {
                const int n = 8 >> st, bit = 1 << st;
                const bool up = (lane & bit) != 0;
#pragma unroll
                for (int i = 0; i < 8; ++i) if (i < n) {
                    const float send = up ? d[i] : d[i + n], keep = up ? d[i + n] : d[i];
                    d[i] = keep + __shfl_xor(send, bit);
                }
            }
            float tot = d[0];
            tot += __shfl_xor(tot, 16); tot += __shfl_xor(tot, 32);
            const float w = mygate * gelu_tanh(tot * rsu) * rsv;
#pragma unroll
            for (int j = 0; j < 16; ++j) {
                const float wj = __int_as_float(__builtin_amdgcn_readlane(__float_as_int(w), BR4(j)));
                const unsigned vw[4] = {vb[j].x, vb[j].y, vb[j].z, vb[j].w};
#pragma unroll
                for (int i = 0; i < 4; ++i) {
                    f32x2_t lo = __builtin_amdgcn_cvt_pk_f32_fp8((int)vw[i], false), hi = __builtin_amdgcn_cvt_pk_f32_fp8((int)vw[i], true);
                    acc[4 * i] += wj * lo.x; acc[4 * i + 1] += wj * lo.y; acc[4 * i + 2] += wj * hi.x; acc[4 * i + 3] += wj * hi.y;
                }
            }
        }
        const float4* g5 = (const float4*)(mods_l + (size_t)row_mod(r) * MODW + 5 * DM + lane * 16);
        const float4* xr = (const float4*)(X + (size_t)r * DM + lane * 16);
        float4 xn[4]; float ss = 0.f;
#pragma unroll
        for (int i = 0; i < 4; ++i) { float4 xv = xr[i], gg = g5[i];
            xv.x += gg.x * acc[4 * i]; xv.y += gg.y * acc[4 * i + 1]; xv.z += gg.z * acc[4 * i + 2]; xv.w += gg.w * acc[4 * i + 3]; xn[i] = xv;
            ss += xv.x * xv.x + xv.y * xv.y + xv.z * xv.z + xv.w * xv.w; }
        float4* xo = (float4*)(Xout + (size_t)r * DM + lane * 16);
#pragma unroll
        for (int i = 0; i < 4; ++i) xo[i] = xn[i];
        if (gnext) {
            const float rstd = rsqrtf(wave_sum(ss) * (1.f / DM) + 1e-6f);
            const float* mn = mods_next + (size_t)row_mod(r) * MODW + lane * 16;
            bf16* ar = Anext + (size_t)r * DM + lane * 16;
#pragma unroll
            for (int i = 0; i < 4; ++i) {
                const float4 gg = ((const float4*)(gnext + lane * 16))[i], sh = ((const float4*)mn)[i], sc = ((const float4*)(mn + DM))[i];
                float4 o;
                o.x = xn[i].x * rstd * gg.x * (1.f + sc.x) + sh.x; o.y = xn[i].y * rstd * gg.y * (1.f + sc.y) + sh.y;
                o.z = xn[i].z * rstd * gg.z * (1.f + sc.z) + sh.z; o.w = xn[i].w * rstd * gg.w * (1.f + sc.w) + sh.w;
                st4bf(ar + 4 * i, o);
            }
        }
    }
}
template <int N>
__device__ __forceinline__ void ph_gemm_bf16(const bf16* A, const bf16* Bt, bf16* O, unsigned char* lds) {
    pg8::Gemm g{A, Bt, RT, N, DM}; pg8::StaticOrder S; S.init(RT, N, (int)gridDim.x, opaque_bid());
    pg8::EpiBf16<0> E{O, N, nullptr, 0, 0, 1.f};
    pg8::gemm_phase<pg8::EpiBf16<0>, pg8::StaticOrder, true, true>((PG8_LAS unsigned char*)lds, g, S, E);
}
__device__ __forceinline__ void ph_gemm_res(const bf16* A, const bf16* Bt, float* X, const float* gate, unsigned char* lds) {
    pg8::Gemm g{A, Bt, RT, DM, DM}; pg8::StaticOrder S; S.init(RT, DM, (int)gridDim.x, opaque_bid());
    EpiResGate E{X, gate};
    pg8::gemm_phase<EpiResGate, pg8::StaticOrder, true, true>((PG8_LAS unsigned char*)lds, g, S, E);
}

#define XB_TMO      128
#define XB_XCNT(j)  (256  + 64 * (j))
#define XB_XSUB(j)  (1280 + 64 * (j))
#define XB_XGEN(j)  (2304 + 64 * (j))
#define XB_TOP      3328
#define XB_TOPGEN   3392
#define XCD_BAR_WORDS 3456
#define XB_SPIN_CAP (1u << 18)

__device__ __forceinline__ unsigned xb_ld(unsigned* p)              { return __hip_atomic_load(p, __ATOMIC_RELAXED, __HIP_MEMORY_SCOPE_AGENT); }
__device__ __forceinline__ unsigned xb_add(unsigned* p, unsigned v) { return __hip_atomic_fetch_add(p, v, __ATOMIC_RELAXED, __HIP_MEMORY_SCOPE_AGENT); }
__device__ __forceinline__ unsigned xb_xcc_id() { return (unsigned)__builtin_amdgcn_s_getreg((3 << 11) | 20) & 0xFu; }
#define XB_SPIN(cond, bar) do { unsigned _sp = 0; while (cond) { __builtin_amdgcn_s_sleep(1); \
    if ((++_sp & 255u) == 0u) { if (xb_ld(&(bar)[XB_TMO])) break; if (_sp > XB_SPIN_CAP) { atomicAdd(&(bar)[XB_TMO], 1u); break; } } } } while (0)

struct XcdBarrier {
    unsigned* bar; unsigned x;
    volatile LAS unsigned* st;
};

__device__ __forceinline__ XcdBarrier xcd_barrier_post(unsigned* bar, volatile LAS unsigned* st) {
    XcdBarrier b; b.bar = bar; b.x = xb_xcc_id(); b.st = st;
    if (threadIdx.x == 0) (void)xb_add(&bar[XB_XCNT(b.x)], 1u);
    return b;
}
__device__ __forceinline__ void xcd_barrier_complete(unsigned* bar, unsigned x, unsigned& nloc, unsigned& nx) {
    const unsigned G = gridDim.x * gridDim.y * gridDim.z;
    unsigned sum, cnt, mine, sp = 0u;
    for (;;) {
        sum = 0u; cnt = 0u; mine = 0u;
#pragma unroll
        for (unsigned j = 0; j < 16; ++j) { const unsigned c = xb_ld(&bar[XB_XCNT(j)]); sum += c; cnt += (c > 0u) ? 1u : 0u; mine = (j == x) ? c : mine; }
        if (sum == G) break;
        __builtin_amdgcn_s_sleep(1);
        if ((++sp & 255u) == 0u) { if (xb_ld(&bar[XB_TMO])) break; if (sp > XB_SPIN_CAP) { atomicAdd(&bar[XB_TMO], 1u); break; } }
    }
    nloc = mine > 0u ? mine : 1u; nx = cnt > 0u ? cnt : 1u;
}

__device__ __forceinline__ void xcd_barrier(const XcdBarrier& b) {
    asm volatile("s_waitcnt vmcnt(0)" ::: "memory");
    __syncthreads();
    if (threadIdx.x == 0) {
        unsigned* bar = b.bar;
        __builtin_amdgcn_s_waitcnt(0);
        unsigned nloc = b.st[0], nx = b.st[1];
        if (nloc == 0u) { xcd_barrier_complete(bar, b.x, nloc, nx); b.st[0] = nloc; b.st[1] = nx; }
        const unsigned old = xb_add(&bar[XB_XSUB(b.x)], 1u);
        const unsigned gen = old / nloc;
        if (old + 1u == (gen + 1u) * nloc) {
            __builtin_amdgcn_fence(__ATOMIC_RELEASE, "agent");
            asm volatile("s_waitcnt vmcnt(0)" ::: "memory");
            const unsigned og = xb_add(&bar[XB_TOP], 1u);
            const unsigned tg = og / nx;
            if (og + 1u == (tg + 1u) * nx) xb_add(&bar[XB_TOPGEN], 1u);
            else XB_SPIN(xb_ld(&bar[XB_TOPGEN]) == tg, bar);
            __builtin_amdgcn_fence(__ATOMIC_ACQUIRE, "agent");
            xb_add(&bar[XB_XGEN(b.x)], 1u);
            asm volatile("s_waitcnt vmcnt(0)" ::: "memory");
        } else {
            XB_SPIN(xb_ld(&bar[XB_XGEN(b.x)]) == gen, bar);
            __builtin_amdgcn_fence(__ATOMIC_ACQUIRE, "agent");
            asm volatile("s_waitcnt vmcnt(0)" ::: "memory");
        }
    }
    __syncthreads();
}

constexpr size_t ALIGN_UP(size_t x) { return (x + 255) & ~(size_t)255; }
constexpr size_t WS_X = 0;
constexpr size_t WS_A = WS_X + (size_t)RT * DM * 4;
constexpr size_t WS_P = WS_A + (size_t)RT * DM * 2;
constexpr size_t WS_ATT = WS_P + (size_t)RT * EVEN_LDP * 2;
constexpr size_t WS_OF = WS_ATT + (size_t)RT * DM * 2;
constexpr size_t WS_MODS = WS_OF + (size_t)RT * 512 * 4 * 2;
constexpr size_t WS_ROPE = WS_MODS + ALIGN_UP((size_t)DEPTH * NMOD * MODW * 4);
constexpr size_t WS_WINE = WS_ROPE + (size_t)SEQ * 32 * 8;
constexpr size_t WS_WOUTE = WS_WINE + (size_t)2 * EVEN_LDP * DM * 2;
constexpr size_t WS_WINO = WS_WOUTE + (size_t)2 * DM * DM * 2;
constexpr size_t WS_WOUTO = WS_WINO + (size_t)2 * ODD_IN * DM * 2;
constexpr size_t WS_WPQ = WS_WOUTO + (size_t)2 * DM * DM * 2;
constexpr size_t WS_T8 = WS_WPQ + (size_t)4 * DM * DM * 2;
constexpr size_t WS_RS = WS_T8 + (size_t)2 * DEPTH * 16384 * DM;
constexpr size_t WS_KC = WS_RS + (size_t)2 * DEPTH * 16384 * 4;
constexpr size_t WS_VT = WS_KC + (size_t)NB * 8 * KVLEN * 64 * 2;
constexpr size_t WS_KEYS = WS_VT + (size_t)NB * 4 * 128 * KVLEN * 2;
constexpr size_t WS_BAR = WS_KEYS + (size_t)DEPTH * 8 * 2 * 128 * 64 * 2;
constexpr size_t WS_BAR_BYTES = 16384;
constexpr size_t WS_END = WS_BAR + WS_BAR_BYTES;

__global__ void __launch_bounds__(NT, 2) mega(Params p) {
    extern __shared__ __attribute__((aligned(16))) unsigned char lds[];
    float* smem = (float*)lds;
    cg::grid_group grid = cg::this_grid();
    unsigned char* ws = p.ws;
    volatile LAS unsigned* bst = (volatile LAS unsigned*)((LAS unsigned char*)lds + 131072 + 512);
    if (threadIdx.x < 2) bst[threadIdx.x] = 0u;
    __syncthreads();
    XcdBarrier xbar = xcd_barrier_post((unsigned*)(ws + WS_BAR), bst);
#define GSYNC() xcd_barrier(xbar)
#define X_ ((float*)(ws + WS_X))
#define A_ ((bf16*)(ws + WS_A))
#define P_ ((bf16*)(ws + WS_P))
#define ATT_ ((bf16*)(ws + WS_ATT))
#define OF_ ((float*)(ws + WS_OF))
#define OB_ (OF_ + (size_t)RT * 512)
#define MODS_ ((float*)(ws + WS_MODS))
#define ROPE_ ((float2*)(ws + WS_ROPE))
#define WINE_ ((bf16*)(ws + WS_WINE))
#define WOUTE_ ((bf16*)(ws + WS_WOUTE))
#define WINO_ ((bf16*)(ws + WS_WINO))
#define WOUTO_ ((bf16*)(ws + WS_WOUTO))
#define WPQ_ ((bf16*)(ws + WS_WPQ))
#define QP_ P_
#define KEYS_ ((bf16*)(ws + WS_KEYS))
#define KC_ ((bf16*)(ws + WS_KC))
#define VT_ ((bf16*)(ws + WS_VT))
#define T8_ (ws + WS_T8)
#define RS_ ((float*)(ws + WS_RS))
#define IDX_ ((int*)(ws + WS_P + (size_t)RT * DM * 2))
#define GATE_ ((float*)(ws + WS_P + (size_t)RT * DM * 2 + (size_t)RT * 128 * 4))

    ph_copy_in(p.in[0], p.in[2], X_);
    ph_rope_table(ROPE_);
    ph_weight_prep(p.in, WINE_, WOUTE_, WINO_, WOUTO_, WPQ_, KEYS_, lds);
    ph_table_prep(p.in[25], p.in[26], T8_, RS_);
    __syncthreads();
    ph_mods(p.in[1], p.in[3], p.in[4], p.in[5], MODS_, smem);
    grid.sync();
    ph_norm_mod(X_, p.in[6], MODS_, 0, A_);
    GSYNC();
    for (int hl = 0; hl < 2 * DEPTH; ++hl) {
        const int l = hl >> 1, part = hl & 1, i = l >> 1, odd = l & 1;
        const float* mods_l = MODS_ + (size_t)l * NMOD * MODW;
        if (part) {
            ph_norm_mod(X_, p.in[7] + l * DM, mods_l, 3, A_);
            GSYNC();
        }
        if (part) ph_gemm_bf16<DM>(A_, WPQ_ + (size_t)l * DM * DM, P_, lds);
        else if (odd) ph_gemm_bf16<ODD_IN>(A_, WINO_ + (size_t)i * ODD_IN * DM, P_, lds);
        else ph_gemm_bf16<EVEN_LDP>(A_, WINE_ + (size_t)i * EVEN_LDP * DM, P_, lds);
        GSYNC();
        if (part == 0) {
            const int ldp = odd ? ODD_IN : EVEN_LDP;
            ph_post(P_, ldp, odd ? 16 : 8, odd ? 1024 : 512, odd ? 4 : 8, odd ? 1280 : 1024, odd ? 256 : 512, odd ? 64 : 128,
                    (odd ? p.in[21] : p.in[10]) + i * 64, (odd ? p.in[22] : p.in[11]) + i * 64, ROPE_, KC_, VT_);
            GSYNC();
            if (!odd) ph_gla_chunk(P_, p.in[14] + i * 16 * 256, p.in[15] + i * 256, p.in[16] + i * 16 * 256, p.in[17] + i * 256, OF_, OB_, lds);
            ph_attn_mfma(P_, ldp, KC_, VT_, ATT_, odd, l < DEPTH - 1, lds);
            GSYNC();
            if (!odd) {
                const float lam_init = 0.8f - 0.6f * expf(-0.3f * (float)l);
                ph_even_post(ATT_, p.in[12] + i * 256, p.in[13] + i * 128, lam_init, OF_, OB_, P_, p.in[18] + i * 128);
                GSYNC();
            }
            ph_gemm_res(ATT_, odd ? WOUTO_ + (size_t)i * DM * DM : WOUTE_ + (size_t)i * DM * DM, X_, mods_l + 2 * DM, lds);
            GSYNC();
        } else {
            const int last = (l == DEPTH - 1);
            const int nrows = last ? RL : RT;
            ph_route_mfma(QP_, KEYS_ + (size_t)l * 8 * 2 * 128 * 64, IDX_, GATE_, lds, nrows);
            GSYNC();
            ph_peer_ffn8(A_, IDX_, GATE_, T8_ + (size_t)l * 16384 * DM, RS_ + l * 16384, T8_ + (size_t)(DEPTH + l) * 16384 * DM, RS_ + (DEPTH + l) * 16384, mods_l,
                         X_, last ? p.out : X_, nrows, last ? nullptr : p.in[6] + (l + 1) * DM, mods_l + NMOD * MODW, A_);
            if (!last) GSYNC();
        }
    }
}

extern "C" void kernel_launch(void* const* d_in, const int* in_sizes, int n_in, void* d_out, int out_size, void* d_ws, size_t ws_size, hipStream_t stream) {
    static int grid_blocks = 0;
    if (!grid_blocks) {
        int dev = 0, cus = 0, per_cu = 0;
        (void)hipGetDevice(&dev);
        (void)hipDeviceGetAttribute(&cus, hipDeviceAttributeMultiprocessorCount, dev);
        (void)hipFuncSetAttribute((const void*)mega, hipFuncAttributeMaxDynamicSharedMemorySize, LDS_BYTES);
        (void)hipOccupancyMaxActiveBlocksPerMultiprocessor(&per_cu, mega, NT, LDS_BYTES);
        if (per_cu < 1) fprintf(stderr, "occupancy query says %d blocks/CU\n", per_cu);
        grid_blocks = cus;
        if (ws_size < WS_END) fprintf(stderr, "workspace too small: %zu < %zu\n", ws_size, (size_t)WS_END);
    }
    (void)hipMemsetAsync((unsigned char*)d_ws + WS_BAR, 0, WS_BAR_BYTES, stream);
    Params p{};
    for (int i = 0; i < 27; ++i) p.in[i] = (const float*)d_in[i];
    p.out = (float*)d_out; p.ws = (unsigned char*)d_ws;
    void* args[] = {&p};
    hipError_t e = hipLaunchCooperativeKernel((void*)mega, dim3(grid_blocks), dim3(NT), args, LDS_BYTES, stream);
    if (e != hipSuccess) fprintf(stderr, "cooperative launch failed: %s (grid %d)\n", hipGetErrorString(e), grid_blocks);
}
```

```cpp
#include <hip/hip_runtime.h>
#include <hip/hip_cooperative_groups.h>
#include <stdint.h>
#include <cstdio>
namespace cg = cooperative_groups;

#define DM 1024
#define NB 16
#define SEQ 2048
#define CTX 256
#define RL (NB * SEQ)
#define RC (NB * CTX)
#define RT (RL + RC)
#define DEPTH 4
#define EVEN_IN 3104
#define EVEN_LDP 3328
#define ODD_IN 1536
#define NMOD 17
#define MODW 6144
#define NT 512
#define NWV 8
#define LDS_BYTES 147456
#ifndef DUP_FFN
#define DUP_FFN 0
#endif
#ifndef DUP_ROUTE
#define DUP_ROUTE 0
#endif
#ifndef DUP_ATTN
#define DUP_ATTN 0
#endif
#ifndef DUP_GEMM
#define DUP_GEMM 0
#endif

typedef unsigned short bf16;
typedef float f32x2_t __attribute__((ext_vector_type(2)));
typedef __bf16 bf16x2_t __attribute__((ext_vector_type(2)));
struct Params {
    const float* in[27];
    float* out;
    unsigned char* ws;
};

__device__ __forceinline__ int row_mod(int r) { return r < RL ? (r >> 11) : 16; }
__device__ __forceinline__ float silu_f(float x) { return x / (1.f + expf(-x)); }
__device__ __forceinline__ float wave_sum(float v) {
#pragma unroll
    for (int o = 1; o < 64; o <<= 1) v += __shfl_xor(v, o);
    return v;
}
__device__ __forceinline__ float log_sigmoid_f(float z) { return fminf(z, 0.f) - log1pf(expf(-fabsf(z))); }
__device__ __forceinline__ float gelu_tanh(float x) { float u = 0.7978845608028654f * (x + 0.044715f * x * x * x); return 0.5f * x * (1.f + tanhf(u)); }
__device__ __forceinline__ float bf2f(bf16 v) { return __uint_as_float((unsigned)v << 16); }
__device__ __forceinline__ unsigned f2bf(float f) { unsigned u = __float_as_uint(f); return (u + 0x7fffu + ((u >> 16) & 1u)) >> 16; }
__device__ __forceinline__ unsigned pk2(float lo, float hi) { return f2bf(lo) | (f2bf(hi) << 16); }
__device__ __forceinline__ float4 ld4bf(const bf16* p) { uint2 u = *(const uint2*)p; return make_float4(__uint_as_float(u.x << 16), __uint_as_float(u.x & 0xffff0000u), __uint_as_float(u.y << 16), __uint_as_float(u.y & 0xffff0000u)); }
__device__ __forceinline__ void st4bf(bf16* p, float4 v) { *(uint2*)p = make_uint2(pk2(v.x, v.y), pk2(v.z, v.w)); }
__device__ __forceinline__ float2 ld2bf(const bf16* p) { unsigned u = *(const unsigned*)p; return make_float2(__uint_as_float(u << 16), __uint_as_float(u & 0xffff0000u)); }
__device__ __forceinline__ void st2bf(bf16* p, float2 v) { *(unsigned*)p = pk2(v.x, v.y); }

__device__ __forceinline__ int opaque_tid() { int t = threadIdx.x; asm volatile("" : "+v"(t)); return t; }
__device__ __forceinline__ int opaque_bid() { int b = blockIdx.x; asm volatile("" : "+s"(b)); return b; }

namespace pg8 {
#define PG8_LAS __attribute__((address_space(3)))
typedef unsigned short bf16_t;
typedef short bf16x8 __attribute__((ext_vector_type(8)));
typedef float f32x4 __attribute__((ext_vector_type(4)));
typedef unsigned u32x4 __attribute__((ext_vector_type(4)));
constexpr int BM = 256, BK = 64, HALF = 128, HTB = HALF * BK * 2  , STAGE_BYTES = 8 * HTB, NXCD = 8, WGM = 8;

__host__ __device__ __forceinline__ int lds_byte(int r, int c) { const int st = (r >> 4) * 2 + (c >> 5), rr = r & 15, cc = c & 31, ob = rr * 64 + cc * 2; return st * 1024 + (ob ^ (((ob >> 9) & 1) << 5)); }
__host__ __device__ __forceinline__ void stage_rc(int b, int& R, int& C) { const int st = b / 1024, sb = b % 1024, swz = sb ^ (((sb >> 9) & 1) << 5); R = (st >> 1) * 16 + swz / 64; C = (st & 1) * 32 + (swz % 64) / 2; }
__host__ __device__ __forceinline__ int perm32(int rho) { const int n = rho >> 4, i = rho & 15; return 8 * (i >> 2) + 4 * n + (i & 3); }

struct Unit { int pm, pn; };
struct Gemm { const bf16_t* A; const bf16_t* Bt; int M, N, K; };

struct StaticOrder {
    int nM, nN, nwg, G, c;
    __host__ __device__ void init(int M, int N, int G_, int c_) { nM = M / BM; nN = N / BM; nwg = nM * nN; G = G_; c = c_; }
    __host__ __device__ bool next(int i, Unit& u) const {
        const long L = (long)i * G + c; if (L >= nwg) return false;
        int wgid = (int)L; { const int q = nwg / NXCD, r = nwg % NXCD, xcd = wgid % NXCD, off = wgid / NXCD; wgid = (xcd < r ? xcd * (q + 1) : r * (q + 1) + (xcd - r) * q) + off; }
        const int nig = WGM * nN, gid = wgid / nig, fm = gid * WGM, gsz = (nM - fm) < WGM ? (nM - fm) : WGM;
        u.pm = fm + ((wgid % nig) % gsz); u.pn = (wgid % nig) / gsz; return true;
    }
    __device__ __forceinline__ void a_ready(const Unit&) const {}
    __device__ __forceinline__ void done(const Unit&) const {}
};

__device__ __forceinline__ unsigned cvt_pk_bf16(float lo, float hi) { unsigned r; asm volatile("v_cvt_pk_bf16_f32 %0, %1, %2" : "=v"(r) : "v"(lo), "v"(hi)); return r; }
typedef float f32x2 __attribute__((ext_vector_type(2)));
__device__ __forceinline__ f32x2 gelu_pk(f32x2 v) {
    const f32x2 av = __builtin_elementwise_abs(v), d = av * 0.2316418882f + 1.0f;
    f32x2 t; t.x = __builtin_amdgcn_rcpf(d.x); t.y = __builtin_amdgcn_rcpf(d.y);
    f32x2 q = t * 0.5307027145f + (-0.7265760135f); q = q * t + 0.7107068705f; q = q * t + (-0.142248368f); q = q * t + 0.127414796f; q = q * t;
    const f32x2 s = (v * v) * (-0.72134752044f);
    f32x2 e; e.x = __builtin_amdgcn_exp2f(s.x); e.y = __builtin_amdgcn_exp2f(s.y);
    const f32x2 m = v * (q * e), r = v - m;
    f32x2 o; o.x = v.x < 0.f ? m.x : r.x; o.y = v.y < 0.f ? m.y : r.y; return o;
}

template <int ACT  > struct EpiBf16 {
    static constexpr bool PERM = true, AFTER_DRAIN = false; static_assert(ACT == 0 || ACT == 1, "EpiBf16: ACT is 0 (none) or 1 (gelu_pk)");
    bf16_t* O; int ldc; const float* bias; int split_cols; size_t split_stride; float scale0;
    __device__ __forceinline__ void operator()(const f32x4 (&acc)[2][2][4][2], const Unit& u, int wr, int wc, int fr, int fq) const {
        const int row0 = u.pm * BM + wr * 64 + fr; int colt = u.pn * BM; bf16_t* base = O;
        float sc = 1.f; if (split_cols) { const int t = colt / split_cols; base += (size_t)t * split_stride; colt -= t * split_cols; if (t == 0) sc = scale0; }
        const int col0 = colt + wc * 32 + 8 * fq, bcol0 = u.pn * BM + wc * 32 + 8 * fq;
        f32x4 bv[2][2];
#pragma unroll
        for (int bj = 0; bj < 2; ++bj)
#pragma unroll
            for (int n = 0; n < 2; ++n) bv[bj][n] = bias ? *(const f32x4*)(bias + bcol0 + bj * HALF + 4 * n) : (f32x4){0.f, 0.f, 0.f, 0.f};
#pragma unroll
        for (int ai = 0; ai < 2; ++ai)
#pragma unroll
            for (int m = 0; m < 4; ++m) { bf16_t* rowp = base + (size_t)(row0 + ai * HALF + m * 16) * ldc + col0;
#pragma unroll
                for (int bj = 0; bj < 2; ++bj) { f32x4 v0 = acc[ai][bj][m][0] + bv[bj][0], v1 = acc[ai][bj][m][1] + bv[bj][1];
                    if (ACT == 1) { f32x2 a = gelu_pk((f32x2){v0[0], v0[1]}), b = gelu_pk((f32x2){v0[2], v0[3]}), c = gelu_pk((f32x2){v1[0], v1[1]}), d = gelu_pk((f32x2){v1[2], v1[3]});
                        v0 = (f32x4){a.x, a.y, b.x, b.y}; v1 = (f32x4){c.x, c.y, d.x, d.y}; }
                    v0 = v0 * sc; v1 = v1 * sc; u32x4 w; w.x = cvt_pk_bf16(v0[0], v0[1]); w.y = cvt_pk_bf16(v0[2], v0[3]); w.z = cvt_pk_bf16(v1[0], v1[1]); w.w = cvt_pk_bf16(v1[2], v1[3]);
                    *(u32x4*)(rowp + bj * HALF) = w; } }
    }
};
template <class Epi, class Sched, bool ALIGN_EPI = false, bool SP2 = false>
__device__ __forceinline__ void gemm_phase(PG8_LAS unsigned char* lds, const Gemm g, const Sched& S, const Epi& E) {
    const int tid = opaque_tid(), wid = __builtin_amdgcn_readfirstlane(tid >> 6), lane = tid & 63, wr = wid >> 2, wc = wid & 3, fr = lane & 15, fq = lane >> 4;
    const int K = g.K, nt = K / BK;
    unsigned voffA[2], voffB[2];
#pragma unroll
    for (int i = 0; i < 2; ++i) { int R, C; stage_rc(tid * 16 + i * 8192, R, C); const int Rb = Epi::PERM ? ((R & ~31) + perm32(R & 31)) : R;
        voffA[i] = (unsigned)(R * K + C) * 2u; voffB[i] = (unsigned)(Rb * K + C) * 2u; }
    const size_t kstep = (size_t)(BK * 2);
    const size_t hstep = (size_t)HALF * K * 2;
    const size_t tstep = 2 * hstep;
    const unsigned ldsw = (unsigned)wid * 1024u;
    const int aoff = lds_byte(wr * 64 + fr, fq * 8), boff = lds_byte(wc * 32 + fr, fq * 8);
#define PG8_SA(b, h) (((b) * 2 + (h)) * HTB)
#define PG8_SB(b, h) ((4 + (b) * 2 + (h)) * HTB)
#define PG8_STAGE(bufoff, gbase, voff) do { _Pragma("unroll") for (int _i = 0; _i < 2; ++_i) \
        __builtin_amdgcn_global_load_lds((const unsigned*)((const char*)(gbase) + (voff)[_i]), (PG8_LAS unsigned*)(lds + (bufoff) + ldsw + _i * 8192), 16, 0, 0); } while (0)
#define PG8_LDA(dst, b, h) do { _Pragma("unroll") for (int m = 0; m < 4; ++m) _Pragma("unroll") for (int k = 0; k < 2; ++k) dst[m][k] = *(const PG8_LAS bf16x8*)(lds + PG8_SA(b, h) + aoff + m * 2048 + k * 1024); } while (0)
#define PG8_LDB(dst, b, h) do { _Pragma("unroll") for (int n = 0; n < 2; ++n) _Pragma("unroll") for (int k = 0; k < 2; ++k) dst[n][k] = *(const PG8_LAS bf16x8*)(lds + PG8_SB(b, h) + boff + n * 2048 + k * 1024); } while (0)
#define PG8_MMA(ai, bj, At, Bt) do { __builtin_amdgcn_s_setprio(1); _Pragma("unroll") for (int m = 0; m < 4; ++m) _Pragma("unroll") for (int n = 0; n < 2; ++n) _Pragma("unroll") for (int k = 0; k < 2; ++k) \
        acc[ai][bj][m][n] = __builtin_amdgcn_mfma_f32_16x16x32_bf16(Bt[n][k], At[m][k], acc[ai][bj][m][n], 0, 0, 0); __builtin_amdgcn_s_setprio(0); } while (0)
#define PG8_WAIT_V(n) asm volatile("s_waitcnt vmcnt(" #n ")" ::: "memory")
#define PG8_WAIT_L(n) asm volatile("s_waitcnt lgkmcnt(" #n ")" ::: "memory")
#define PG8_BAR __builtin_amdgcn_s_barrier()
#define PG8_SCHED __builtin_amdgcn_sched_barrier(0)
    Unit cur, nxt; int ui = 0;
    if (!S.next(0, cur)) return;
    f32x4 acc[2][2][4][2];
#pragma unroll
    for (int a = 0; a < 2; ++a)
#pragma unroll
        for (int b = 0; b < 2; ++b)
#pragma unroll
            for (int m = 0; m < 4; ++m)
#pragma unroll
                for (int n = 0; n < 2; ++n) acc[a][b][m][n] = (f32x4){0.f, 0.f, 0.f, 0.f};
    bf16x8 At[4][2], B0[2][2], B1[2][2];
    const char* cA = (const char*)g.A + (size_t)cur.pm * tstep; const char* cB = (const char*)g.Bt + (size_t)cur.pn * tstep;
    S.a_ready(cur);
    if constexpr (SP2) {
        PG8_STAGE(PG8_SB(0, 0), cB, voffB); PG8_STAGE(PG8_SB(0, 1), cB + hstep, voffB); PG8_STAGE(PG8_SA(0, 0), cA, voffA); PG8_STAGE(PG8_SA(0, 1), cA + hstep, voffA);
        if (wr == 1) PG8_BAR;
        PG8_WAIT_V(2); PG8_BAR;
        PG8_STAGE(PG8_SB(1, 0), cB + kstep, voffB); PG8_STAGE(PG8_SA(1, 0), cA + kstep, voffA); PG8_STAGE(PG8_SB(1, 1), cB + hstep + kstep, voffB);
        PG8_WAIT_V(6); PG8_BAR;
    } else {
        PG8_STAGE(PG8_SB(0, 0), cB, voffB); PG8_STAGE(PG8_SA(0, 0), cA, voffA); PG8_STAGE(PG8_SB(0, 1), cB + hstep, voffB); PG8_STAGE(PG8_SA(0, 1), cA + hstep, voffA);
        if (wr == 1) PG8_BAR;
        PG8_WAIT_V(4); PG8_BAR;
        PG8_STAGE(PG8_SB(1, 0), cB + kstep, voffB); PG8_STAGE(PG8_SA(1, 0), cA + kstep, voffA); PG8_STAGE(PG8_SB(1, 1), cB + hstep + kstep, voffB);
        PG8_WAIT_V(6); PG8_BAR;
    }
    for (;;) {
        const bool has_next = S.next(ui + 1, nxt);
        const char* nA = has_next ? (const char*)g.A + (size_t)nxt.pm * tstep : cA; const char* nB = has_next ? (const char*)g.Bt + (size_t)nxt.pn * tstep : cB;
        for (int t = 0; t < nt; t += 2) {
            const bool last = (t == nt - 2);
            const char* a1 = cA + (size_t)(t + 1) * kstep;
            const char* a2 = last ? nA : cA + (size_t)(t + 2) * kstep; const char* b2 = last ? nB : cB + (size_t)(t + 2) * kstep;
            const char* a3 = a2 + kstep; const char* b3 = b2 + kstep;
            if (last && has_next) S.a_ready(nxt);
            if constexpr (SP2) {
            PG8_LDB(B0, 0, 0); PG8_LDB(B1, 0, 1); PG8_SCHED; PG8_LDA(At, 0, 0); PG8_STAGE(PG8_SA(1, 1), a1 + hstep, voffA);
            PG8_WAIT_V(8); PG8_WAIT_L(0); PG8_BAR; PG8_MMA(0, 0, At, B0); PG8_MMA(0, 1, At, B1); PG8_BAR; PG8_SCHED;
            PG8_LDA(At, 0, 1); PG8_STAGE(PG8_SB(0, 0), b2, voffB); PG8_STAGE(PG8_SB(0, 1), b2 + hstep, voffB); PG8_STAGE(PG8_SA(0, 0), a2, voffA);
            PG8_WAIT_V(8); PG8_WAIT_L(0); PG8_BAR; PG8_MMA(1, 0, At, B0); PG8_MMA(1, 1, At, B1); PG8_BAR; PG8_SCHED;
            PG8_LDB(B0, 1, 0); PG8_LDB(B1, 1, 1); PG8_SCHED; PG8_LDA(At, 1, 0); PG8_STAGE(PG8_SA(0, 1), a2 + hstep, voffA);
            PG8_WAIT_V(8); PG8_WAIT_L(0); PG8_BAR; PG8_MMA(0, 0, At, B0); PG8_MMA(0, 1, At, B1); PG8_BAR; PG8_SCHED;
            PG8_LDA(At, 1, 1); PG8_STAGE(PG8_SB(1, 0), b3, voffB); PG8_STAGE(PG8_SB(1, 1), b3 + hstep, voffB); PG8_STAGE(PG8_SA(1, 0), a3, voffA);
            PG8_WAIT_V(8); PG8_WAIT_L(0); PG8_BAR; PG8_MMA(1, 0, At, B0); PG8_MMA(1, 1, At, B1); PG8_BAR; PG8_SCHED;
            } else {
            PG8_LDB(B0, 0, 0); PG8_SCHED; PG8_LDA(At, 0, 0); PG8_STAGE(PG8_SA(1, 1), a1 + hstep, voffA);
            PG8_WAIT_L(8); PG8_BAR; PG8_WAIT_L(0); PG8_MMA(0, 0, At, B0); PG8_BAR; PG8_SCHED;
            PG8_LDB(B1, 0, 1); PG8_STAGE(PG8_SB(0, 0), b2, voffB);
            PG8_BAR; PG8_WAIT_L(0); PG8_MMA(0, 1, At, B1); PG8_BAR;
            PG8_LDA(At, 0, 1); PG8_STAGE(PG8_SA(0, 0), a2, voffA);
            PG8_BAR; PG8_WAIT_L(0); PG8_MMA(1, 0, At, B0); PG8_BAR; PG8_SCHED;
            PG8_STAGE(PG8_SB(0, 1), b2 + hstep, voffB);
            PG8_WAIT_V(6); PG8_BAR; PG8_MMA(1, 1, At, B1); PG8_BAR;
            PG8_LDB(B0, 1, 0); PG8_SCHED; PG8_LDA(At, 1, 0); PG8_STAGE(PG8_SA(0, 1), a2 + hstep, voffA);
            PG8_WAIT_L(8); PG8_BAR; PG8_WAIT_L(0); PG8_MMA(0, 0, At, B0); PG8_BAR; PG8_SCHED;
            PG8_LDB(B1, 1, 1); PG8_STAGE(PG8_SB(1, 0), b3, voffB);
            PG8_BAR; PG8_WAIT_L(0); PG8_MMA(0, 1, At, B1); PG8_BAR;
            PG8_LDA(At, 1, 1); PG8_STAGE(PG8_SA(1, 0), a3, voffA);
            PG8_BAR; PG8_WAIT_L(0); PG8_MMA(1, 0, At, B0); PG8_BAR; PG8_SCHED;
            PG8_STAGE(PG8_SB(1, 1), b3 + hstep, voffB);
            PG8_WAIT_V(6); PG8_BAR; PG8_MMA(1, 1, At, B1); PG8_BAR;
            }
        }
        if constexpr (ALIGN_EPI) { if (wr == 0) PG8_BAR; }
        if constexpr (!Epi::AFTER_DRAIN) { E(acc, cur, wr, wc, fr, fq); S.done(cur); }
        if (!has_next) break;
#pragma unroll
        for (int a = 0; a < 2; ++a)
#pragma unroll
            for (int b = 0; b < 2; ++b)
#pragma unroll
                for (int m = 0; m < 4; ++m)
#pragma unroll
                    for (int n = 0; n < 2; ++n) acc[a][b][m][n] = (f32x4){0.f, 0.f, 0.f, 0.f};
        cur = nxt; cA = nA; cB = nB; ++ui;
        if constexpr (ALIGN_EPI) { if (wr == 1) PG8_BAR; }
    }
    PG8_WAIT_V(0);
    if constexpr (!ALIGN_EPI) { if (wr == 0) PG8_BAR; }
    PG8_BAR;
    if constexpr (Epi::AFTER_DRAIN) { E.fused(acc, cur, wr, wc, fr, fq, lds, wid, lane); S.done(cur); }
#undef PG8_SA
#undef PG8_SB
#undef PG8_STAGE
#undef PG8_LDA
#undef PG8_LDB
#undef PG8_MMA
#undef PG8_WAIT_V
#undef PG8_WAIT_L
#undef PG8_BAR
#undef PG8_SCHED
}
}

struct EpiResGate {
    static constexpr bool PERM = false, AFTER_DRAIN = false;
    float* X; const float* gate;
    __device__ __forceinline__ void operator()(const pg8::f32x4 (&acc)[2][2][4][2], const pg8::Unit& u, int wr, int wc, int fr, int fq) const {
#pragma unroll
        for (int ai = 0; ai < 2; ++ai)
#pragma unroll
            for (int m = 0; m < 4; ++m) {
                const int r = u.pm * 256 + ai * 128 + wr * 64 + m * 16 + fr;
                const float* g = gate + (size_t)row_mod(r) * MODW; float* xr = X + (size_t)r * DM;
#pragma unroll
                for (int bj = 0; bj < 2; ++bj)
#pragma unroll
                    for (int n = 0; n < 2; ++n) {
                        const int c = u.pn * 256 + bj * 128 + wc * 32 + n * 16 + 4 * fq;
                        pg8::f32x4 xv = *(const pg8::f32x4*)(xr + c); const pg8::f32x4 gv = *(const pg8::f32x4*)(g + c);
                        xv = xv + gv * acc[ai][bj][m][n];
                        *(pg8::f32x4*)(xr + c) = xv;
                    }
            }
    }
};
#define LAS __attribute__((address_space(3)))
#define GAS __attribute__((address_space(1)))

__device__ __forceinline__ void ph_copy_in(const float* __restrict__ x, const float* __restrict__ ctx, float* __restrict__ X) {
    const int TID = opaque_tid(), BID = opaque_bid();
    size_t i = (size_t)BID * NT + TID;
    const size_t n4 = (size_t)RT * DM / 4, nl4 = (size_t)RL * DM / 4;
    for (; i < n4; i += (size_t)gridDim.x * NT) ((float4*)X)[i] = i < nl4 ? ((const float4*)x)[i] : ((const float4*)ctx)[i - nl4];
}
__device__ __forceinline__ void ph_copy_out(const float* __restrict__ X, float* __restrict__ out) {
    const int TID = opaque_tid(), BID = opaque_bid();
    size_t i = (size_t)BID * NT + TID;
    const size_t n4 = (size_t)RL * DM / 4;
    for (; i < n4; i += (size_t)gridDim.x * NT) ((float4*)out)[i] = ((const float4*)X)[i];
}
__device__ __forceinline__ void ph_rope_table(float2* __restrict__ rope) {
    const int TID = opaque_tid(), BID = opaque_bid();
    for (int i = BID * NT + TID; i < SEQ * 32; i += gridDim.x * NT) {
        int t = i >> 5, a = (i >> 4) & 1, f = i & 15;
        float pos = a == 0 ? (float)(t >> 6) : (float)(t & 63);
        float inv = powf(10000.f, -(float)f / 16.f);
        float ang = pos * inv;
        rope[i] = make_float2(cosf(ang), sinf(ang));
    }
}
__device__ __forceinline__ void transpose_item(const float* __restrict__ W, int N, bf16* __restrict__ WT, LAS float* scr, int item, int lane) {
    const int K = DM;
    const int nblk = N / 32, kb = item / nblk, nb = item % nblk, k0 = 64 * kb, n0 = 32 * nb;
#pragma unroll 8
    for (int i = 0; i < 32; ++i) { const int kk = 2 * i + (lane >> 5); scr[kk * 33 + (lane & 31)] = W[(size_t)(k0 + kk) * N + n0 + (lane & 31)]; }
    asm volatile("s_waitcnt lgkmcnt(0)" ::: "memory");
    const int c = lane & 7;
#pragma unroll
    for (int j = 0; j < 4; ++j) { const int n = (lane >> 3) + 8 * j; const LAS float* s = scr + (8 * c) * 33 + n;
        uint4 o; o.x = pk2(s[0 * 33], s[1 * 33]); o.y = pk2(s[2 * 33], s[3 * 33]); o.z = pk2(s[4 * 33], s[5 * 33]); o.w = pk2(s[6 * 33], s[7 * 33]);
        *(uint4*)(WT + (size_t)(n0 + n) * K + k0 + 8 * c) = o; }
    asm volatile("s_waitcnt lgkmcnt(0)" ::: "memory");
}
struct WPrep { const float* src[12]; bf16* dst[12]; };
__device__ __forceinline__ void ph_weight_prep(const float* const* in, bf16* WinE, bf16* WoutE, bf16* WinO, bf16* WoutO, bf16* Wpq, bf16* Kb, unsigned char* lds) {
    const int TID = opaque_tid(), BID = opaque_bid();
    const int lane = TID & 63, wv = TID >> 6;
    LAS float* scr = (LAS float*)((LAS unsigned char*)lds + wv * 16384);
    const int gw = BID * NWV + wv, NGW = gridDim.x * NWV;
    const int NITEMS = 2 * 1552 + 2 * 512 + 2 * 768 + 2 * 512 + 4 * 512;
    for (int it = gw; it < NITEMS; it += NGW) {
        int r = it;
        if (r < 3104) { int i = r / 1552; transpose_item(in[8] + (size_t)i * DM * EVEN_IN, EVEN_IN, WinE + (size_t)i * EVEN_LDP * DM, scr, r % 1552, lane); continue; } r -= 3104;
        if (r < 1024) { int i = r / 512; transpose_item(in[9] + (size_t)i * DM * DM, DM, WoutE + (size_t)i * DM * DM, scr, r % 512, lane); continue; } r -= 1024;
        if (r < 1536) { int i = r / 768; transpose_item(in[19] + (size_t)i * DM * ODD_IN, ODD_IN, WinO + (size_t)i * ODD_IN * DM, scr, r % 768, lane); continue; } r -= 1536;
        if (r < 1024) { int i = r / 512; transpose_item(in[20] + (size_t)i * DM * DM, DM, WoutO + (size_t)i * DM * DM, scr, r % 512, lane); continue; } r -= 1024;
        { int i = r / 512; transpose_item(in[23] + (size_t)i * DM * DM, DM, Wpq + (size_t)i * DM * DM, scr, r % 512, lane); }
    }
    for (int i4 = BID * NT + TID; i4 < DEPTH * 8 * 2 * 128 * 64 / 4; i4 += gridDim.x * NT) st4bf(Kb + 4 * (size_t)i4, ((const float4*)in[24])[i4]);
    for (int i = BID * NT + TID; i < 2 * 28672; i += gridDim.x * NT) {
        int w = i / 28672, o = i % 28672;
        ((uint4*)(WinE + (size_t)w * EVEN_LDP * DM + (size_t)EVEN_IN * DM))[o] = make_uint4(0u, 0u, 0u, 0u);
    }
}
__device__ __forceinline__ void ph_mods(const float* __restrict__ c, const float* __restrict__ cctx, const float* __restrict__ w_mod,
                        const float* __restrict__ b_mod, float* __restrict__ mods, float* smem) {
    const int TID = opaque_tid(), BID = opaque_bid();
    const int nslab = DEPTH * MODW / 128;
    if (BID >= nslab) return;
    const int lane = TID & 63, wv = TID >> 6, cl = lane & 15, kp = lane >> 4;
    float (*S)[DM] = (float (*)[DM])smem;
    for (int i = TID; i < NMOD * DM; i += NT) {
        int j = i / DM, k = i % DM;
        float v = j < 16 ? c[j * DM + k] : cctx[k];
        S[j][k] = silu_f(v);
    }
    __syncthreads();
    for (int slab = BID; slab < nslab; slab += gridDim.x) {
        const int l = slab / 48, n = (slab % 48) * 128 + wv * 16 + cl;
        const float* W = w_mod + (size_t)l * DM * MODW + n;
        float acc[NMOD];
#pragma unroll
        for (int j = 0; j < NMOD; ++j) acc[j] = 0.f;
#pragma unroll 4
        for (int kk = 0; kk < 256; ++kk) {
            const int k = kp * 256 + kk;
            const float w = W[(size_t)k * MODW];
#pragma unroll
            for (int j = 0; j < NMOD; ++j) acc[j] += S[j][k] * w;
        }
        const float bias = b_mod[l * MODW + n];
#pragma unroll
        for (int j = 0; j < NMOD; ++j) {
            float v = acc[j];
            v += __shfl_xor(v, 16); v += __shfl_xor(v, 32);
            if (kp == 0) mods[((size_t)l * NMOD + j) * MODW + n] = v + bias;
        }
    }
    __syncthreads();
}
__device__ __forceinline__ void ph_norm_mod(const float* __restrict__ X, const float* __restrict__ g, const float* __restrict__ mods_l, int shift_chunk, bf16* __restrict__ A) {
    const int TID = opaque_tid(), BID = opaque_bid();
    int wave = BID * NWV + (TID >> 6), lane = TID & 63;
    int nw = gridDim.x * NWV;
    for (int r = wave; r < RT; r += nw) {
        const float4* xr = (const float4*)(X + (size_t)r * DM);
        float4 v[4]; float s = 0.f;
#pragma unroll
        for (int i = 0; i < 4; ++i) { v[i] = xr[lane + 64 * i]; s += v[i].x * v[i].x + v[i].y * v[i].y + v[i].z * v[i].z + v[i].w * v[i].w; }
        s = wave_sum(s);
        float rstd = rsqrtf(s * (1.f / DM) + 1e-6f);
        const float* m = mods_l + (size_t)row_mod(r) * MODW;
        const float4* sh = (const float4*)(m + shift_chunk * DM);
        const float4* sc = (const float4*)(m + (shift_chunk + 1) * DM);
        const float4* g4 = (const float4*)g;
        bf16* ar = A + (size_t)r * DM;
#pragma unroll
        for (int i = 0; i < 4; ++i) {
            int c = lane + 64 * i;
            float4 gg = g4[c], a = sh[c], b = sc[c], o;
            o.x = v[i].x * rstd * gg.x * (1.f + b.x) + a.x;
            o.y = v[i].y * rstd * gg.y * (1.f + b.y) + a.y;
            o.z = v[i].z * rstd * gg.z * (1.f + b.z) + a.z;
            o.w = v[i].w * rstd * gg.w * (1.f + b.w) + a.w;
            st4bf(ar + 4 * c, o);
        }
    }
}
#define KVLEN (CTX + SEQ)
__device__ __forceinline__ void ph_post(bf16* __restrict__ P, int ldp, int nq, int kcol0, int nk, int vcol0, int VC, int DV,
                                        const float* __restrict__ qgain, const float* __restrict__ kgain, const float2* __restrict__ rope,
                                        bf16* __restrict__ Kc, bf16* __restrict__ Vt) {
    const int TID = opaque_tid(), BID = opaque_bid();
    const float C2 = 0.125f * 1.4426950408889634f;
    for (int tile = BID; tile < RT / 64; tile += gridDim.x) {
        const int r0 = tile * 64;
        int b, j0;
        if (r0 < RL) { b = r0 >> 11; j0 = CTX + (r0 & (SEQ - 1)); } else { b = (r0 - RL) >> 8; j0 = (r0 - RL) & (CTX - 1); }
        const int nh = nq + nk;
        for (int it = TID; it < 64 * nh; it += NT) {
            const int row = it / nh, hh = it % nh, r = r0 + row;
            const bool isk = hh >= nq; const int h = isk ? hh - nq : hh;
            bf16* src = P + (size_t)r * ldp + (isk ? kcol0 : 0) + h * 64;
            const float* gain = isk ? kgain : qgain;
            float v[64]; float s = 0.f;
#pragma unroll
            for (int i = 0; i < 16; ++i) { float4 t = ld4bf(src + 4 * i); v[4 * i] = t.x; v[4 * i + 1] = t.y; v[4 * i + 2] = t.z; v[4 * i + 3] = t.w; }
#pragma unroll
            for (int i = 0; i < 64; ++i) s += v[i] * v[i];
            const float rstd = rsqrtf(s * (1.f / 64.f) + 1e-6f) * (isk ? 1.f : C2);
#pragma unroll
            for (int i = 0; i < 64; ++i) v[i] = v[i] * rstd * gain[i];
            if (r < RL) {
                const float2* tab = rope + (size_t)(r & (SEQ - 1)) * 32;
#pragma unroll
                for (int a = 0; a < 2; ++a)
#pragma unroll
                    for (int f = 0; f < 16; ++f) {
                        float2 cs = tab[a * 16 + f];
                        float x1 = v[a * 32 + f], x2 = v[a * 32 + 16 + f];
                        v[a * 32 + f] = x1 * cs.x - x2 * cs.y;
                        v[a * 32 + 16 + f] = x2 * cs.x + x1 * cs.y;
                    }
            }
            bf16* dst = isk ? Kc + ((size_t)(b * nk + h) * KVLEN + j0 + row) * 64 : src;
#pragma unroll
            for (int i = 0; i < 16; ++i) st4bf(dst + 4 * i, make_float4(v[4 * i], v[4 * i + 1], v[4 * i + 2], v[4 * i + 3]));
        }
        if (TID < VC) {
            const int c8 = TID >> 3, rg = TID & 7;
            unsigned in[8][4];
#pragma unroll
            for (int rr = 0; rr < 8; ++rr) { uint4 t = *(const uint4*)(P + (size_t)(r0 + rg * 8 + rr) * ldp + vcol0 + c8 * 8); in[rr][0] = t.x; in[rr][1] = t.y; in[rr][2] = t.z; in[rr][3] = t.w; }
#pragma unroll
            for (int c = 0; c < 8; ++c) {
                unsigned o[4];
#pragma unroll
                for (int q = 0; q < 4; ++q)
                    o[q] = (c & 1) ? __builtin_amdgcn_perm(in[2 * q + 1][c >> 1], in[2 * q][c >> 1], 0x07060302u) : __builtin_amdgcn_perm(in[2 * q + 1][c >> 1], in[2 * q][c >> 1], 0x05040100u);
                const int col = c8 * 8 + c, vh = col / DV, d = col % DV;
                *(uint4*)(Vt + ((size_t)(b * 4 + vh) * DV + d) * KVLEN + j0 + rg * 8) = make_uint4(o[0], o[1], o[2], o[3]);
            }
        }
    }
}
typedef short bf16x8 __attribute__((ext_vector_type(8)));
typedef float f32x16 __attribute__((ext_vector_type(16)));
__device__ __forceinline__ int crow(int r, int hi) { return (r & 3) + 8 * (r >> 2) + 4 * hi; }
__device__ __forceinline__ unsigned cvt_pk_bf16_f32(float lo, float hi) { f32x2_t v = {lo, hi}; bf16x2_t b = __builtin_convertvector(v, bf16x2_t); return __builtin_bit_cast(unsigned, b); }
#define ATT_KPITCH 144
#define ATT_VPITCH 136
template <int DV>
__device__ __forceinline__ void attn_unit(const bf16* __restrict__ Qbase, int ldq, const bf16* __restrict__ Kc, const bf16* __restrict__ Vt, int ntiles,
                                          bf16* __restrict__ Obase, int ldo, unsigned char* lds, int tid) {
    constexpr int NDB = DV / 32, NVL = DV / 64, KBYTES = 64 * ATT_KPITCH, BUFSZ = KBYTES + DV * ATT_VPITCH;
    constexpr float THR = 8.f;
    const int lane = tid & 63, wid = tid >> 6, r32 = lane & 31, hi = lane >> 5;
    float* sc = (float*)(lds + 2 * BUFSZ + wid * 128);
    bf16x8 qf[4];
    {
        const bf16* qrow = Qbase + (size_t)(wid * 32 + r32) * ldq;
#pragma unroll
        for (int s = 0; s < 4; ++s) qf[s] = *(const bf16x8*)(qrow + 16 * s + 8 * hi);
    }
    f32x16 o[NDB];
#pragma unroll
    for (int d = 0; d < NDB; ++d)
#pragma unroll
        for (int r = 0; r < 16; ++r) o[d][r] = 0.f;
    float m = -1e30f, l = 0.f;
    uint4 kreg, vreg[NVL];
    const int krow = tid >> 3, kch = tid & 7;
#define ATT_LOAD(t) do { kreg = *(const uint4*)(Kc + (size_t)(t) * 64 * 64 + tid * 8); \
        _Pragma("unroll") for (int u = 0; u < NVL; ++u) { const int idx = tid + NT * u; vreg[u] = *(const uint4*)(Vt + (size_t)(idx >> 3) * KVLEN + (t) * 64 + (idx & 7) * 8); } } while (0)
#define ATT_STORE(buf) do { *(uint4*)(lds + (buf) * BUFSZ + krow * ATT_KPITCH + kch * 16) = kreg; \
        _Pragma("unroll") for (int u = 0; u < NVL; ++u) { const int idx = tid + NT * u; unsigned char* vp = lds + (buf) * BUFSZ + KBYTES + (idx >> 3) * ATT_VPITCH + (idx & 7) * 16; \
            *(uint2*)vp = make_uint2(vreg[u].x, vreg[u].y); *(uint2*)(vp + 8) = make_uint2(vreg[u].z, vreg[u].w); } } while (0)
    ATT_LOAD(0);
    ATT_STORE(0);
    __syncthreads();
    for (int t = 0; t < ntiles; ++t) {
        const int buf = t & 1;
        if (t + 1 < ntiles) ATT_LOAD(t + 1);
        const unsigned char* kb = lds + buf * BUFSZ;
        const unsigned char* vb = kb + KBYTES;
        f32x16 s0, s1;
#pragma unroll
        for (int r = 0; r < 16; ++r) { s0[r] = 0.f; s1[r] = 0.f; }
#pragma unroll
        for (int s = 0; s < 4; ++s) {
            const bf16x8 a0 = *(const bf16x8*)(kb + r32 * ATT_KPITCH + s * 32 + hi * 16);
            const bf16x8 a1 = *(const bf16x8*)(kb + (32 + r32) * ATT_KPITCH + s * 32 + hi * 16);
            s0 = __builtin_amdgcn_mfma_f32_32x32x16_bf16(a0, qf[s], s0, 0, 0, 0);
            s1 = __builtin_amdgcn_mfma_f32_32x32x16_bf16(a1, qf[s], s1, 0, 0, 0);
        }
        float tm = fmaxf(s0[0], s1[0]);
#pragma unroll
        for (int r = 1; r < 16; ++r) tm = fmaxf(tm, fmaxf(s0[r], s1[r]));
        tm = fmaxf(tm, __shfl_xor(tm, 32));
        if (__any(tm > m + THR)) {
            const float mn = fmaxf(m, tm), alpha = exp2f(m - mn);
            m = mn; l *= alpha;
            if (hi == 0) sc[r32] = alpha;
#pragma unroll
            for (int r = 0; r < 16; ++r) { const float a = sc[crow(r, hi)];
#pragma unroll
                for (int d = 0; d < NDB; ++d) o[d][r] *= a; }
        }
        float ps = 0.f;
#pragma unroll
        for (int r = 0; r < 16; ++r) { s0[r] = exp2f(s0[r] - m); s1[r] = exp2f(s1[r] - m); ps += s0[r] + s1[r]; }
        l += ps;
        bf16x8 pa[4];
#pragma unroll
        for (int s = 0; s < 4; ++s) {
            unsigned w[4];
#pragma unroll
            for (int k = 0; k < 4; ++k) w[k] = (s < 2) ? cvt_pk_bf16_f32(s0[8 * (s & 1) + 2 * k], s0[8 * (s & 1) + 2 * k + 1]) : cvt_pk_bf16_f32(s1[8 * (s & 1) + 2 * k], s1[8 * (s & 1) + 2 * k + 1]);
            uint4 pw = make_uint4(w[0], w[1], w[2], w[3]);
            pa[s] = __builtin_bit_cast(bf16x8, pw);
        }
#pragma unroll
        for (int d = 0; d < NDB; ++d) {
#pragma unroll
            for (int s = 0; s < 4; ++s) {
                const unsigned char* vp = vb + (32 * d + r32) * ATT_VPITCH + 32 * s + 8 * hi;
                const uint2 v0 = *(const uint2*)vp, v1 = *(const uint2*)(vp + 16);
                uint4 vw = make_uint4(v0.x, v0.y, v1.x, v1.y);
                o[d] = __builtin_amdgcn_mfma_f32_32x32x16_bf16(pa[s], __builtin_bit_cast(bf16x8, vw), o[d], 0, 0, 0);
            }
        }
        if (t + 1 < ntiles) ATT_STORE(buf ^ 1);
        __syncthreads();
    }
#undef ATT_LOAD
#undef ATT_STORE
    l += __shfl_xor(l, 32);
    if (hi == 0) sc[r32] = 1.f / l;
#pragma unroll
    for (int r = 0; r < 16; ++r) {
        const float iv = sc[crow(r, hi)];
        bf16* orow = Obase + (size_t)(wid * 32 + crow(r, hi)) * ldo + r32;
#pragma unroll
        for (int d = 0; d < NDB; ++d) orow[32 * d] = (bf16)f2bf(o[d][r] * iv);
    }
    __syncthreads();
}
__device__ __forceinline__ void attn_run_unit(const bf16* __restrict__ P, int ldp, const bf16* __restrict__ Kc, const bf16* __restrict__ Vt, bf16* __restrict__ ATT,
                                              int odd, int u, int nlat, unsigned char* lds, int TID) {
    int b, qh, row0, ntiles;
    if (u < nlat) {
        if (odd) { const int grp = u >> 5, w = u & 31; b = grp >> 2; qh = (grp & 3) * 4 + (w >> 3); row0 = b * SEQ + (w & 7) * 256; }
        else { const int grp = u >> 4, w = u & 15; b = grp >> 2; qh = (grp & 3) * 2 + (w >> 3); row0 = b * SEQ + (w & 7) * 256; }
        ntiles = KVLEN / 64;
    } else {
        const int idx = u - nlat;
        if (odd) { b = idx >> 4; qh = idx & 15; } else { b = idx >> 3; qh = idx & 7; }
        row0 = RL + b * CTX; ntiles = CTX / 64;
    }
    if (odd) attn_unit<64>(P + (size_t)row0 * ldp + qh * 64, ldp, Kc + (size_t)(b * 4 + (qh >> 2)) * KVLEN * 64, Vt + (size_t)(b * 4 + (qh >> 2)) * 64 * KVLEN, ntiles,
                           ATT + (size_t)row0 * DM + qh * 64, DM, lds, TID);
    else attn_unit<128>(P + (size_t)row0 * ldp + qh * 64, ldp, Kc + (size_t)(b * 8 + qh) * KVLEN * 64, Vt + (size_t)(b * 4 + (qh >> 1)) * 128 * KVLEN, ntiles,
                        ATT + (size_t)row0 * DM + qh * 128, DM, lds, TID);
}
__device__ __forceinline__ void ph_attn_mfma(const bf16* __restrict__ P, int ldp, const bf16* __restrict__ Kc, const bf16* __restrict__ Vt, bf16* __restrict__ ATT,
                                             int odd, int with_ctx, unsigned char* lds) {
    const int TID = opaque_tid(), BID = opaque_bid();
    const int G = gridDim.x, vcu = (G % 8 == 0) ? (BID & 7) * (G >> 3) + (BID >> 3) : BID;
    const int nlat = odd ? 2048 : 1024, nctx = with_ctx ? (odd ? 256 : 128) : 0;
    if (!odd && G == 256) {
        const int x = BID & 7, w = BID >> 3;
        if (w >= 16) { for (int i = 0; i < 6; ++i) attn_run_unit(P, ldp, Kc, Vt, ATT, odd, x * 128 + 16 * i + (w - 16), nlat, lds, TID); }
        else {
            attn_run_unit(P, ldp, Kc, Vt, ATT, odd, x * 128 + 96 + w, nlat, lds, TID);
            attn_run_unit(P, ldp, Kc, Vt, ATT, odd, x * 128 + 112 + w, nlat, lds, TID);
            if (nctx) attn_run_unit(P, ldp, Kc, Vt, ATT, odd, nlat + x * 16 + w, nlat, lds, TID);
        }
        return;
    }
    for (int u = vcu; u < nlat + nctx; u += G) attn_run_unit(P, ldp, Kc, Vt, ATT, odd, u, nlat, lds, TID);
}
typedef float f32x4_t __attribute__((ext_vector_type(4)));
#define GLA_PITCH 144
__device__ __forceinline__ void ph_gla_chunk(const bf16* __restrict__ P, const float* __restrict__ w_af, const float* __restrict__ b_af,
                                             const float* __restrict__ w_ab, const float* __restrict__ b_ab, float* __restrict__ OF, float* __restrict__ OB, unsigned char* lds, int unit0, int ustride) {
    const int TID = opaque_tid(), BID = opaque_bid();
    const int tid = TID, lane = tid & 63, wid = tid >> 6, l15 = lane & 15, q4 = lane >> 4;
    float* SEG = (float*)lds;
    float* DEC = (float*)(lds + 2048);
    unsigned char* QD = lds + 4096;
    unsigned char* KI = QD + 9216;
    unsigned char* KET = KI + 9216;
    unsigned char* AT = KET + 9216;
    unsigned char* VT = AT + 9216;
    (void)BID;
    for (int unit = unit0; unit >= 0 && unit < NB * 4 * 2; unit += ustride) {
        const int dir = unit & 1, h = (unit >> 1) & 3, b = unit >> 3;
        const float* wa = dir ? w_ab : w_af; const float* ba = dir ? b_ab : b_af;
        float* Od = dir ? OB : OF;
        const int d = tid & 63, seg = tid >> 6;
        float wreg[16];
#pragma unroll
        for (int j = 0; j < 16; ++j) wreg[j] = wa[j * 256 + h * 64 + d];
        const float breg = ba[h * 64 + d];
        { unsigned z_; asm volatile("v_mov_b32 %0, 0" : "=v"(z_)); for (int i = tid; i < 9216 / 16; i += NT) ((uint4*)AT)[i] = make_uint4(z_, z_, z_, z_); }
        f32x4_t S[4];
#pragma unroll
        for (int i = 0; i < 4; ++i) S[i] = (f32x4_t){0.f, 0.f, 0.f, 0.f};
        __syncthreads();
        for (int ch = 0; ch < KVLEN / 64; ++ch) {
            int rbase, rsgn;
            if (!dir) { rbase = ch < 4 ? RL + b * CTX + ch * 64 : b * SEQ + (ch - 4) * 64; rsgn = 1; }
            else { rbase = ch < 4 ? RL + b * CTX + (CTX - 1 - ch * 64) : b * SEQ + (SEQ - 1 - (ch - 4) * 64); rsgn = -1; }
            float cl[8];
            {
                float run = 0.f;
#pragma unroll
                for (int i = 0; i < 8; ++i) {
                    const bf16* pr = P + (size_t)(rbase + rsgn * (8 * seg + i)) * EVEN_LDP + 3072 + dir * 16;
                    const uint4 g0 = *(const uint4*)pr, g1 = *(const uint4*)(pr + 8);
                    const unsigned gw[8] = {g0.x, g0.y, g0.z, g0.w, g1.x, g1.y, g1.z, g1.w};
                    float z = breg;
#pragma unroll
                    for (int j = 0; j < 8; ++j) { z += __uint_as_float(gw[j] << 16) * wreg[2 * j]; z += __uint_as_float(gw[j] & 0xffff0000u) * wreg[2 * j + 1]; }
                    run += log_sigmoid_f(z) * (1.f / 16.f);
                    cl[i] = run;
                }
                SEG[seg * 64 + d] = run;
            }
            __syncthreads();
            {
                float prefix = 0.f, total = 0.f;
#pragma unroll
                for (int s2 = 0; s2 < 8; ++s2) { const float v = SEG[s2 * 64 + d]; total += v; prefix += (s2 < seg) ? v : 0.f; }
                if (seg == 0) DEC[d] = __expf(total);
                unsigned kew[4];
#pragma unroll
                for (int i = 0; i < 8; ++i) {
                    const int c = 8 * seg + i;
                    const bf16* pr = P + (size_t)(rbase + rsgn * c) * EVEN_LDP;
                    const float qv = bf2f(pr[1536 + h * 64 + d]) * 0.125f, kv = bf2f(pr[1792 + h * 64 + d]);
                    const float cum = prefix + cl[i];
                    const float e = __expf(cum), ei = __expf(-cum), ee = __expf(total - cum);
                    *(bf16*)(QD + c * GLA_PITCH + d * 2) = (bf16)f2bf(qv * e);
                    *(bf16*)(KI + c * GLA_PITCH + d * 2) = (bf16)f2bf(kv * ei);
                    const unsigned kb = f2bf(kv * ee);
                    if (i & 1) kew[i >> 1] |= kb << 16; else kew[i >> 1] = kb;
                }
                *(uint4*)(KET + d * GLA_PITCH + seg * 16) = make_uint4(kew[0], kew[1], kew[2], kew[3]);
                const int v = tid & 127, cg = tid >> 7;
                unsigned vw[8];
#pragma unroll
                for (int i = 0; i < 16; ++i) {
                    const unsigned x = P[(size_t)(rbase + rsgn * (16 * cg + i)) * EVEN_LDP + 2048 + h * 128 + v];
                    if (i & 1) vw[i >> 1] |= x << 16; else vw[i >> 1] = x;
                }
                *(uint4*)(VT + v * GLA_PITCH + cg * 32) = make_uint4(vw[0], vw[1], vw[2], vw[3]);
                *(uint4*)(VT + v * GLA_PITCH + cg * 32 + 16) = make_uint4(vw[4], vw[5], vw[6], vw[7]);
            }
            __syncthreads();
            for (int blk = wid; blk < 10; blk += NWV) {
                int sblk, cblk;
                if (blk < 4) { sblk = 0; cblk = blk; } else if (blk < 7) { sblk = 1; cblk = blk - 3; } else if (blk < 9) { sblk = 2; cblk = blk - 5; } else { sblk = 3; cblk = 3; }
                f32x4_t acc = (f32x4_t){0.f, 0.f, 0.f, 0.f};
#pragma unroll
                for (int kk = 0; kk < 2; ++kk) {
                    const bf16x8 a = *(const bf16x8*)(KI + (16 * sblk + l15) * GLA_PITCH + 64 * kk + 16 * q4);
                    const bf16x8 bq = *(const bf16x8*)(QD + (16 * cblk + l15) * GLA_PITCH + 64 * kk + 16 * q4);
                    acc = __builtin_amdgcn_mfma_f32_16x16x32_bf16(a, bq, acc, 0, 0, 0);
                }
                const int c = 16 * cblk + l15, s0 = 16 * sblk + 4 * q4;
                float av[4];
#pragma unroll
                for (int r = 0; r < 4; ++r) av[r] = (s0 + r <= c) ? acc[r] : 0.f;
                *(uint2*)(AT + c * GLA_PITCH + s0 * 2) = make_uint2(pk2(av[0], av[1]), pk2(av[2], av[3]));
            }
            __syncthreads();
            {
                const int v0 = 16 * wid;
                bf16x8 bv[2], sB[2];
#pragma unroll
                for (int kk = 0; kk < 2; ++kk) {
                    bv[kk] = *(const bf16x8*)(VT + (v0 + l15) * GLA_PITCH + 64 * kk + 16 * q4);
                    uint4 w = make_uint4(pk2(S[2 * kk][0], S[2 * kk][1]), pk2(S[2 * kk][2], S[2 * kk][3]), pk2(S[2 * kk + 1][0], S[2 * kk + 1][1]), pk2(S[2 * kk + 1][2], S[2 * kk + 1][3]));
                    sB[kk] = __builtin_bit_cast(bf16x8, w);
                }
#pragma unroll
                for (int cblk = 0; cblk < 4; ++cblk) {
                    f32x4_t acc = (f32x4_t){0.f, 0.f, 0.f, 0.f};
                    const unsigned char* arow = AT + (16 * cblk + l15) * GLA_PITCH;
                    const unsigned char* qrow = QD + (16 * cblk + l15) * GLA_PITCH;
#pragma unroll
                    for (int kk = 0; kk < 2; ++kk) {
                        if (kk == 0 || cblk >= 2) {
                            const bf16x8 a = *(const bf16x8*)(arow + 64 * kk + 16 * q4);
                            acc = __builtin_amdgcn_mfma_f32_16x16x32_bf16(a, bv[kk], acc, 0, 0, 0);
                        }
                    }
#pragma unroll
                    for (int kk = 0; kk < 2; ++kk) {
                        const uint2 a0 = *(const uint2*)(qrow + 64 * kk + 8 * q4), a1 = *(const uint2*)(qrow + 64 * kk + 32 + 8 * q4);
                        uint4 aw = make_uint4(a0.x, a0.y, a1.x, a1.y);
                        acc = __builtin_amdgcn_mfma_f32_16x16x32_bf16(__builtin_bit_cast(bf16x8, aw), sB[kk], acc, 0, 0, 0);
                    }
#pragma unroll
                    for (int r = 0; r < 4; ++r) Od[(size_t)(rbase + rsgn * (16 * cblk + 4 * q4 + r)) * 512 + h * 128 + v0 + l15] = acc[r];
                }
#pragma unroll
                for (int dblk = 0; dblk < 4; ++dblk) {
#pragma unroll
                    for (int r = 0; r < 4; ++r) S[dblk][r] *= DEC[16 * dblk + 4 * q4 + r];
#pragma unroll
                    for (int kk = 0; kk < 2; ++kk) {
                        const bf16x8 a = *(const bf16x8*)(KET + (16 * dblk + l15) * GLA_PITCH + 64 * kk + 16 * q4);
                        S[dblk] = __builtin_amdgcn_mfma_f32_16x16x32_bf16(a, bv[kk], S[dblk], 0, 0, 0);
                    }
                }
            }
            __syncthreads();
        }
    }
}
__device__ __forceinline__ void ph_even_post(bf16* __restrict__ ATT, const float* __restrict__ lamv, const float* __restrict__ subln, float lam_init,
                             const float* __restrict__ OF, const float* __restrict__ OB, const bf16* __restrict__ P, const float* __restrict__ gain) {
    const int TID = opaque_tid(), BID = opaque_bid();
    int wave = BID * NWV + (TID >> 6), lane = TID & 63;
    int nw = gridDim.x * NWV;
    float p1 = lamv[lane] * lamv[64 + lane], p2 = lamv[128 + lane] * lamv[192 + lane];
    p1 = wave_sum(p1); p2 = wave_sum(p2);
    const float lam = expf(p1) - expf(p2) + lam_init;
    for (int r = wave; r < RT; r += nw) {
        bf16* a = ATT + (size_t)r * DM;
        float d[4][2];
#pragma unroll
        for (int h = 0; h < 4; ++h) {
            float2 o0 = ld2bf(a + (2 * h) * 128 + lane * 2);
            float2 o1 = ld2bf(a + (2 * h + 1) * 128 + lane * 2);
            d[h][0] = o0.x - lam * o1.x; d[h][1] = o0.y - lam * o1.y;
        }
        float2 outd[4];
#pragma unroll
        for (int h = 0; h < 4; ++h) {
            float s = wave_sum(d[h][0] * d[h][0] + d[h][1] * d[h][1]);
            float rstd = rsqrtf(s * (1.f / 128.f) + 1e-6f) * (1.f - lam_init);
            float2 sg = *(const float2*)(subln + lane * 2);
            outd[h] = make_float2(d[h][0] * rstd * sg.x, d[h][1] * rstd * sg.y);
        }
        float2 outg[4];
#pragma unroll
        for (int h = 0; h < 4; ++h) {
            float2 x = *(const float2*)(OF + (size_t)r * 512 + h * 128 + lane * 2);
            float2 c = *(const float2*)(OB + (size_t)r * 512 + h * 128 + lane * 2);
            float o0 = x.x + c.x, o1 = x.y + c.y;
            float s = wave_sum(o0 * o0 + o1 * o1);
            float rstd = rsqrtf(s * (1.f / 128.f) + 1e-6f);
            float2 g = *(const float2*)(gain + lane * 2);
            float2 rr = ld2bf(P + (size_t)r * EVEN_LDP + 2560 + h * 128 + lane * 2);
            outg[h] = make_float2(o0 * rstd * g.x * silu_f(rr.x), o1 * rstd * g.y * silu_f(rr.y));
        }
#pragma unroll
        for (int h = 0; h < 4; ++h) {
            st2bf(a + h * 128 + lane * 2, outd[h]);
            st2bf(a + 512 + h * 128 + lane * 2, outg[h]);
        }
    }
}
#define INS16(tv, ti, v, n) do { \
    _Pragma("unroll") for (int j_ = 15; j_ >= 1; --j_) { bool c1_ = (v) > tv[j_ - 1]; bool c2_ = (v) > tv[j_]; \
        tv[j_] = c1_ ? tv[j_ - 1] : (c2_ ? (v) : tv[j_]); ti[j_] = c1_ ? ti[j_ - 1] : (c2_ ? (n) : ti[j_]); } \
    { bool c_ = (v) > tv[0]; tv[0] = c_ ? (v) : tv[0]; ti[0] = c_ ? (n) : ti[0]; } } while (0)

__device__ __forceinline__ void ph_peer_ffn(const bf16* __restrict__ A2, const int* __restrict__ IDX, const float* __restrict__ GATE,
                            const float* __restrict__ U, const float* __restrict__ V, const float* __restrict__ mods_l, float* __restrict__ X) {
    const int TID = opaque_tid(), BID = opaque_bid();
    int wave = BID * NWV + (TID >> 6), lane = TID & 63;
    int nw = gridDim.x * NWV;
    for (int r = wave; r < RT; r += nw) {
        float4 xa[4], acc[4];
#pragma unroll
        for (int i = 0; i < 4; ++i) { xa[i] = ld4bf(A2 + (size_t)r * DM + 4 * (lane + 64 * i)); acc[i] = make_float4(0.f, 0.f, 0.f, 0.f); }
        for (int e = 0; e < 128; ++e) {
            int id = IDX[(size_t)r * 128 + e]; float g = GATE[(size_t)r * 128 + e];
            const float4* ur = (const float4*)(U + (size_t)id * DM);
            float d = 0.f;
#pragma unroll
            for (int i = 0; i < 4; ++i) { float4 u = ur[lane + 64 * i]; d += u.x * xa[i].x + u.y * xa[i].y + u.z * xa[i].z + u.w * xa[i].w; }
            d = wave_sum(d);
            float w = g * gelu_tanh(d);
            const float4* vr = (const float4*)(V + (size_t)id * DM);
#pragma unroll
            for (int i = 0; i < 4; ++i) { float4 v = vr[lane + 64 * i]; acc[i].x += w * v.x; acc[i].y += w * v.y; acc[i].z += w * v.z; acc[i].w += w * v.w; }
        }
        const float4* g5 = (const float4*)(mods_l + (size_t)row_mod(r) * MODW + 5 * DM);
        float4* xr = (float4*)(X + (size_t)r * DM);
#pragma unroll
        for (int i = 0; i < 4; ++i) { float4 x = xr[lane + 64 * i], gg = g5[lane + 64 * i];
            x.x += gg.x * acc[i].x; x.y += gg.y * acc[i].y; x.z += gg.z * acc[i].z; x.w += gg.w * acc[i].w; xr[lane + 64 * i] = x; }
    }
}
#define RT_KPITCH 144
#define INSP16(t, x) do { unsigned x_ = (x); _Pragma("unroll") for (int j_ = 0; j_ < 16; ++j_) { const unsigned h_ = max(t[j_], x_); x_ = min(t[j_], x_); t[j_] = h_; } } while (0)
__device__ __forceinline__ void ph_route_mfma(const bf16* __restrict__ Qp, const bf16* __restrict__ Kb, int* __restrict__ IDX, float* __restrict__ GATE, unsigned char* lds, int nrows) {
    const int TID = opaque_tid(), BID = opaque_bid();
    const int tid = TID, lane = tid & 63, wid = tid >> 6, r32 = lane & 31, hi = lane >> 5;
    for (int u = BID; u < (nrows / 256) * 8; u += gridDim.x) {
        const int h = u & 7, row = (u >> 3) * 256 + wid * 32 + r32;
        __syncthreads();
        for (int i = tid; i < 2 * 128 * 8; i += NT) *(uint4*)(lds + (i >> 3) * RT_KPITCH + (i & 7) * 16) = *(const uint4*)(Kb + ((size_t)h * 256 + (i >> 3)) * 64 + (i & 7) * 8);
        __syncthreads();
        unsigned L[2][16];
#pragma unroll
        for (int half = 0; half < 2; ++half) {
            bf16x8 qf[4];
            const bf16* qrow = Qp + (size_t)row * DM + h * 128 + half * 64;
#pragma unroll
            for (int s = 0; s < 4; ++s) qf[s] = *(const bf16x8*)(qrow + 16 * s + 8 * hi);
#pragma unroll
            for (int j = 0; j < 16; ++j) L[half][j] = 0u;
#pragma unroll
            for (int nb = 0; nb < 4; ++nb) {
                f32x16 acc;
#pragma unroll
                for (int r = 0; r < 16; ++r) acc[r] = 0.f;
#pragma unroll
                for (int s = 0; s < 4; ++s) {
                    const bf16x8 a = *(const bf16x8*)(lds + (half * 128 + 32 * nb + r32) * RT_KPITCH + 32 * s + 16 * hi);
                    acc = __builtin_amdgcn_mfma_f32_32x32x16_bf16(a, qf[s], acc, 0, 0, 0);
                }
#pragma unroll
                for (int r = 0; r < 16; ++r) {
                    unsigned ub = __float_as_uint(acc[r]);
                    ub = (ub & 0x80000000u) ? ~ub : (ub | 0x80000000u);
                    const unsigned x = (ub & ~127u) | (unsigned)(127 - (32 * nb + (r & 3) + 8 * (r >> 2)) - 4 * hi);
                    INSP16(L[half], x);
                }
                __builtin_amdgcn_sched_barrier(0);
            }
            unsigned o[16];
#pragma unroll
            for (int j = 0; j < 16; ++j) o[j] = __shfl_xor(L[half][j], 32);
#pragma unroll
            for (int j = 0; j < 16; ++j) INSP16(L[half], o[j]);
            __builtin_amdgcn_sched_barrier(0);
        }
        float v1[16], v2[16];
        {
            unsigned w1[4] = {0u, 0u, 0u, 0u}, w2[4] = {0u, 0u, 0u, 0u};
#pragma unroll
            for (int j = 0; j < 16; ++j) {
                unsigned a = L[0][j] & ~127u, b = L[1][j] & ~127u;
                a = (a & 0x80000000u) ? (a & 0x7fffffffu) : ~a; b = (b & 0x80000000u) ? (b & 0x7fffffffu) : ~b;
                v1[j] = __uint_as_float(a); v2[j] = __uint_as_float(b);
                w1[j >> 2] |= (127u - (L[0][j] & 127u)) << (8 * (j & 3)); w2[j >> 2] |= (127u - (L[1][j] & 127u)) << (8 * (j & 3));
            }
            unsigned char* sb = lds + 2 * 128 * RT_KPITCH + tid * 4;
#pragma unroll
            for (int k = 0; k < 4; ++k) { *(unsigned*)(sb + k * 2048) = w1[k]; *(unsigned*)(sb + (4 + k) * 2048) = w2[k]; }
        }
        unsigned T[16];
#pragma unroll
        for (int j = 0; j < 16; ++j) T[j] = 0u;
#pragma unroll
        for (int a = 0; a < 16; ++a)
#pragma unroll
            for (int b = 0; b < 16; ++b) {
                if ((a + 1) * (b + 1) <= 16) {
                    unsigned ub = __float_as_uint(v1[a] + v2[b]);
                    ub = (ub & 0x80000000u) ? ~ub : (ub | 0x80000000u);
                    const unsigned x = (ub & ~255u) | (unsigned)(255 - (16 * a + b));
                    INSP16(T, x);
                }
            }
        float e[16]; int bi[16]; float sum = 0.f, v0 = 0.f;
        {
            const unsigned char* sb = lds + 2 * 128 * RT_KPITCH + tid * 4;
#pragma unroll
            for (int j = 0; j < 16; ++j) {
                unsigned ub = T[j] & ~255u;
                ub = (ub & 0x80000000u) ? (ub & 0x7fffffffu) : ~ub;
                const float val = __uint_as_float(ub);
                if (j == 0) v0 = val;
                e[j] = __expf(val - v0); sum += e[j];
                const unsigned flat = 255u - (T[j] & 255u), ca = flat >> 4, cb = flat & 15u;
                const unsigned ia = *(const unsigned char*)(sb + (ca >> 2) * 2048 + (ca & 3)), ib = *(const unsigned char*)(sb + (4 + (cb >> 2)) * 2048 + (cb & 3));
                bi[j] = (int)(ia * 128u + ib);
            }
        }
        const float inv = 1.f / sum;
        if (hi == 0) {
            int* ip = IDX + (size_t)row * 128 + h * 16; float* gp = GATE + (size_t)row * 128 + h * 16;
#pragma unroll
            for (int j = 0; j < 4; ++j) {
                *(int4*)(ip + 4 * j) = make_int4(bi[4 * j], bi[4 * j + 1], bi[4 * j + 2], bi[4 * j + 3]);
                *(float4*)(gp + 4 * j) = make_float4(e[4 * j] * inv, e[4 * j + 1] * inv, e[4 * j + 2] * inv, e[4 * j + 3] * inv);
            }
        }
    }
    __syncthreads();
}
__device__ __forceinline__ unsigned fp6_e2m3(float v) {
    const float a = fabsf(v);
    float c;
    if (a < 2.f) c = rintf(a * 8.f);
    else if (a < 4.f) c = 16.f + rintf((a - 2.f) * 4.f);
    else c = fminf(24.f + rintf((a - 4.f) * 2.f), 31.f);
    return (unsigned)c | (v < 0.f ? 32u : 0u);
}
__device__ __forceinline__ void ph_table_prep(const float* __restrict__ U, const float* __restrict__ V, unsigned char* __restrict__ T6, float* __restrict__ RS) {
    const int TID = opaque_tid(), BID = opaque_bid();
    const int wave = BID * NWV + (TID >> 6), lane = TID & 63, nw = gridDim.x * NWV;
    const int NROWS = DEPTH * 16384;
    for (int rr = wave; rr < 2 * NROWS; rr += nw) {
        const float* src = (rr < NROWS ? U : V) + (size_t)(rr < NROWS ? rr : rr - NROWS) * DM + lane * 16;
        float4 v[4]; float am = 0.f;
#pragma unroll
        for (int i = 0; i < 4; ++i) { v[i] = ((const float4*)src)[i]; am = fmaxf(am, fmaxf(fmaxf(fabsf(v[i].x), fabsf(v[i].y)), fmaxf(fabsf(v[i].z), fabsf(v[i].w)))); }
#pragma unroll
        for (int o = 1; o < 64; o <<= 1) am = fmaxf(am, __shfl_xor(am, o));
        am = fmaxf(am, 1e-30f);
        const float sc = exp2f(floorf(log2f(7.5f / am)));
        unsigned e[16];
#pragma unroll
        for (int i = 0; i < 4; ++i) { e[4 * i] = fp6_e2m3(v[i].x * sc); e[4 * i + 1] = fp6_e2m3(v[i].y * sc); e[4 * i + 2] = fp6_e2m3(v[i].z * sc); e[4 * i + 3] = fp6_e2m3(v[i].w * sc); }
        const unsigned d0 = e[0] | (e[1] << 6) | (e[2] << 12) | (e[3] << 18) | (e[4] << 24) | (e[5] << 30);
        const unsigned d1 = (e[5] >> 2) | (e[6] << 4) | (e[7] << 10) | (e[8] << 16) | (e[9] << 22) | (e[10] << 28);
        const unsigned d2 = (e[10] >> 4) | (e[11] << 2) | (e[12] << 8) | (e[13] << 14) | (e[14] << 20) | (e[15] << 26);
        unsigned* dst = (unsigned*)(T6 + (size_t)rr * 768 + lane * 12);
        dst[0] = d0; dst[1] = d1; dst[2] = d2;
        if (lane == 0) RS[rr] = 1.f / sc;
    }
}
typedef unsigned v6u32_t __attribute__((ext_vector_type(6)));
typedef float v32f_t __attribute__((ext_vector_type(32)));
typedef __bf16 v32bf_t __attribute__((ext_vector_type(32)));
typedef unsigned v16u_t __attribute__((ext_vector_type(16)));
struct u3 { unsigned x, y, z; };
#define BR4(j) ((((j) & 1) << 3) | (((j) & 2) << 1) | (((j) & 4) >> 1) | (((j) & 8) >> 3))
__device__ __forceinline__ void ph_peer_ffn8(const bf16* A2, const int* __restrict__ IDX, const float* __restrict__ GATE,
                            const unsigned char* __restrict__ U8, const float* __restrict__ RSU, const unsigned char* __restrict__ V8, const float* __restrict__ RSV,
                            const float* __restrict__ mods_l, const float* X, float* Xout, int nrows,
                            const float* __restrict__ gnext, const float* __restrict__ mods_next, bf16* Anext) {
    const int TID = opaque_tid(), BID = opaque_bid();
    const int wave = BID * NWV + (TID >> 6), lane = TID & 63, nw = gridDim.x * NWV;
    const int jl = BR4(lane & 15);
    const unsigned lane12 = (unsigned)lane * 12u;
    for (int r = wave; r < nrows; r += nw) {
        float xf[16];
        { int lx = lane; asm volatile("" : "+v"(lx)); const uint4* xp = (const uint4*)(A2 + (size_t)r * DM + lx * 16); const uint4 a = xp[0], b = xp[1]; const unsigned xw[8] = {a.x, a.y, a.z, a.w, b.x, b.y, b.z, b.w};
#pragma unroll
          for (int i = 0; i < 8; ++i) { xf[2 * i] = __uint_as_float(xw[i] << 16); xf[2 * i + 1] = __uint_as_float(xw[i] & 0xffff0000u); } }
        float acc[16];
#pragma unroll
        for (int k = 0; k < 16; ++k) acc[k] = 0.f;
        for (int g = 0; g < 8; ++g) {
            const int myid = IDX[(size_t)r * 128 + g * 16 + jl];
            u3 ub[16], vb[16];
#pragma unroll
            for (int j = 0; j < 16; ++j) { unsigned idv; asm volatile("v_mov_b32 %0, %1" : "=v"(idv) : "s"(__builtin_amdgcn_readlane(myid, BR4(j)))); ub[j] = *(const u3*)(U8 + (idv * 768u + lane12)); }
#pragma unroll
            for (int j = 0; j < 16; ++j) { unsigned idv; asm volatile("v_mov_b32 %0, %1" : "=v"(idv) : "s"(__builtin_amdgcn_readlane(myid, BR4(j)))); vb[j] = *(const u3*)(V8 + (idv * 768u + lane12)); }
            float d[16];
#pragma unroll
            for (int j = 0; j < 16; j += 2) {
                const v6u32_t src = {ub[j].x, ub[j].y, ub[j].z, ub[j + 1].x, ub[j + 1].y, ub[j + 1].z};
                const v32f_t f = __builtin_amdgcn_cvt_scalef32_pk32_f32_fp6(src, 1.0f);
                float d0 = 0.f, d1 = 0.f;
#pragma unroll
                for (int k = 0; k < 16; ++k) { d0 = __builtin_fmaf(f[k], xf[k], d0); d1 = __builtin_fmaf(f[16 + k], xf[k], d1); }
                d[j] = d0; d[j + 1] = d1;
                __builtin_amdgcn_sched_barrier(0);
            }
#pragma unroll
            for (int st = 0; st < 4; ++st) {
                const int n = 8 >> st, bit = 1 << st;
                const bool up = (lane & bit) != 0;
#pragma unroll
                for (int i = 0; i < 8; ++i) if (i < n) {
                    const float send = up ? d[i] : d[i + n], keep = up ? d[i + n] : d[i];
                    d[i] = keep + __shfl_xor(send, bit);
                }
            }
            float tot = d[0];
            tot += __shfl_xor(tot, 16); tot += __shfl_xor(tot, 32);
            const float w = GATE[(size_t)r * 128 + g * 16 + jl] * gelu_tanh(tot * RSU[myid]) * RSV[myid];
#pragma unroll
            for (int j = 0; j < 16; j += 2) {
                const float w0 = __int_as_float(__builtin_amdgcn_readlane(__float_as_int(w), BR4(j))), w1 = __int_as_float(__builtin_amdgcn_readlane(__float_as_int(w), BR4(j + 1)));
                const v6u32_t src = {vb[j].x, vb[j].y, vb[j].z, vb[j + 1].x, vb[j + 1].y, vb[j + 1].z};
                const v32f_t f = __builtin_amdgcn_cvt_scalef32_pk32_f32_fp6(src, 1.0f);
#pragma unroll
                for (int k = 0; k < 16; ++k) { acc[k] = __builtin_fmaf(w0, f[k], acc[k]); acc[k] = __builtin_fmaf(w1, f[16 + k], acc[k]); }
                __builtin_amdgcn_sched_barrier(0);
            }
        }
        int re = __builtin_amdgcn_readfirstlane(r); asm volatile("" : "+s"(re)); int le = lane; asm volatile("" : "+v"(le));
        const float4* g5 = (const float4*)(mods_l + (size_t)row_mod(re) * MODW + 5 * DM + le * 16);
        const float4* xr = (const float4*)(X + (size_t)re * DM + le * 16);
        float4 xn[4]; float ss = 0.f;
#pragma unroll
        for (int i = 0; i < 4; ++i) { float4 xv = xr[i], gg = g5[i];
            xv.x += gg.x * acc[4 * i]; xv.y += gg.y * acc[4 * i + 1]; xv.z += gg.z * acc[4 * i + 2]; xv.w += gg.w * acc[4 * i + 3]; xn[i] = xv;
            ss += xv.x * xv.x + xv.y * xv.y + xv.z * xv.z + xv.w * xv.w; }
        float4* xo = (float4*)(Xout + (size_t)re * DM + le * 16);
#pragma unroll
        for (int i = 0; i < 4; ++i) xo[i] = xn[i];
        if (gnext) {
            const float rstd = rsqrtf(wave_sum(ss) * (1.f / DM) + 1e-6f);
            const float* mn = mods_next + (size_t)row_mod(re) * MODW + le * 16;
            bf16* ar = Anext + (size_t)re * DM + le * 16;
#pragma unroll
            for (int i = 0; i < 4; ++i) {
                const float4 gg = ((const float4*)(gnext + le * 16))[i], sh = ((const float4*)mn)[i], sc = ((const float4*)(mn + DM))[i];
                float4 o;
                o.x = xn[i].x * rstd * gg.x * (1.f + sc.x) + sh.x; o.y = xn[i].y * rstd * gg.y * (1.f + sc.y) + sh.y;
                o.z = xn[i].z * rstd * gg.z * (1.f + sc.z) + sh.z; o.w = xn[i].w * rstd * gg.w * (1.f + sc.w) + sh.w;
                st4bf(ar + 4 * i, o);
            }
        }
    }
}
template <int N>
__device__ __forceinline__ void ph_gemm_bf16(const bf16* A, const bf16* Bt, bf16* O, unsigned char* lds) {
    pg8::Gemm g{A, Bt, RT, N, DM}; pg8::StaticOrder S; S.init(RT, N, (int)gridDim.x, opaque_bid());
    pg8::EpiBf16<0> E{O, N, nullptr, 0, 0, 1.f};
    pg8::gemm_phase<pg8::EpiBf16<0>, pg8::StaticOrder, true, true>((PG8_LAS unsigned char*)lds, g, S, E);
}
__device__ __forceinline__ void ph_gemm_res(const bf16* A, const bf16* Bt, float* X, const float* gate, unsigned char* lds) {
    pg8::Gemm g{A, Bt, RT, DM, DM}; pg8::StaticOrder S; S.init(RT, DM, (int)gridDim.x, opaque_bid());
    EpiResGate E{X, gate};
    pg8::gemm_phase<EpiResGate, pg8::StaticOrder, true, true>((PG8_LAS unsigned char*)lds, g, S, E);
}

#define XB_TMO      128
#define XB_XCNT(j)  (256  + 64 * (j))
#define XB_XSUB(j)  (1280 + 64 * (j))
#define XB_XGEN(j)  (2304 + 64 * (j))
#define XB_TOP      3328
#define XB_TOPGEN   3392
#define XCD_BAR_WORDS 3456
#define XB_SPIN_CAP (1u << 18)

__device__ __forceinline__ unsigned xb_ld(unsigned* p)              { return __hip_atomic_load(p, __ATOMIC_RELAXED, __HIP_MEMORY_SCOPE_AGENT); }
__device__ __forceinline__ unsigned xb_add(unsigned* p, unsigned v) { return __hip_atomic_fetch_add(p, v, __ATOMIC_RELAXED, __HIP_MEMORY_SCOPE_AGENT); }
__device__ __forceinline__ unsigned xb_xcc_id() { return (unsigned)__builtin_amdgcn_s_getreg((3 << 11) | 20) & 0xFu; }
#define XB_SPIN(cond, bar) do { unsigned _sp = 0; while (cond) { __builtin_amdgcn_s_sleep(1); \
    if ((++_sp & 255u) == 0u) { if (xb_ld(&(bar)[XB_TMO])) break; if (_sp > XB_SPIN_CAP) { atomicAdd(&(bar)[XB_TMO], 1u); break; } } } } while (0)

struct XcdBarrier {
    unsigned* bar; unsigned x;
    volatile LAS unsigned* st;
};

__device__ __forceinline__ XcdBarrier xcd_barrier_post(unsigned* bar, volatile LAS unsigned* st) {
    XcdBarrier b; b.bar = bar; b.x = xb_xcc_id(); b.st = st;
    if (threadIdx.x == 0) (void)xb_add(&bar[XB_XCNT(b.x)], 1u);
    return b;
}
__device__ __forceinline__ void xcd_barrier_complete(unsigned* bar, unsigned x, unsigned& nloc, unsigned& nx) {
    const unsigned G = gridDim.x * gridDim.y * gridDim.z;
    unsigned sum, cnt, mine, sp = 0u;
    for (;;) {
        sum = 0u; cnt = 0u; mine = 0u;
#pragma unroll
        for (unsigned j = 0; j < 16; ++j) { const unsigned c = xb_ld(&bar[XB_XCNT(j)]); sum += c; cnt += (c > 0u) ? 1u : 0u; mine = (j == x) ? c : mine; }
        if (sum == G) break;
        __builtin_amdgcn_s_sleep(1);
        if ((++sp & 255u) == 0u) { if (xb_ld(&bar[XB_TMO])) break; if (sp > XB_SPIN_CAP) { atomicAdd(&bar[XB_TMO], 1u); break; } }
    }
    nloc = mine > 0u ? mine : 1u; nx = cnt > 0u ? cnt : 1u;
}

__device__ __forceinline__ void xcd_barrier(const XcdBarrier& b) {
    asm volatile("s_waitcnt vmcnt(0)" ::: "memory");
    __syncthreads();
    if (threadIdx.x == 0) {
        unsigned* bar = b.bar;
        __builtin_amdgcn_s_waitcnt(0);
        unsigned nloc = b.st[0], nx = b.st[1];
        if (nloc == 0u) { xcd_barrier_complete(bar, b.x, nloc, nx); b.st[0] = nloc; b.st[1] = nx; }
        const unsigned old = xb_add(&bar[XB_XSUB(b.x)], 1u);
        const unsigned gen = old / nloc;
        if (old + 1u == (gen + 1u) * nloc) {
            __builtin_amdgcn_fence(__ATOMIC_RELEASE, "agent");
            asm volatile("s_waitcnt vmcnt(0)" ::: "memory");
            const unsigned og = xb_add(&bar[XB_TOP], 1u);
            const unsigned tg = og / nx;
            if (og + 1u == (tg + 1u) * nx) xb_add(&bar[XB_TOPGEN], 1u);
            else XB_SPIN(xb_ld(&bar[XB_TOPGEN]) == tg, bar);
            __builtin_amdgcn_fence(__ATOMIC_ACQUIRE, "agent");
            xb_add(&bar[XB_XGEN(b.x)], 1u);
            asm volatile("s_waitcnt vmcnt(0)" ::: "memory");
        } else {
            XB_SPIN(xb_ld(&bar[XB_XGEN(b.x)]) == gen, bar);
            __builtin_amdgcn_fence(__ATOMIC_ACQUIRE, "agent");
            asm volatile("s_waitcnt vmcnt(0)" ::: "memory");
        }
    }
    __syncthreads();
}

constexpr size_t ALIGN_UP(size_t x) { return (x + 255) & ~(size_t)255; }
constexpr size_t WS_X = 0;
constexpr size_t WS_A = WS_X + (size_t)RT * DM * 4;
constexpr size_t WS_P = WS_A + (size_t)RT * DM * 2;
constexpr size_t WS_ATT = WS_P + (size_t)RT * EVEN_LDP * 2;
constexpr size_t WS_OF = WS_ATT + (size_t)RT * DM * 2;
constexpr size_t WS_MODS = WS_OF + (size_t)RT * 512 * 4 * 2;
constexpr size_t WS_ROPE = WS_MODS + ALIGN_UP((size_t)DEPTH * NMOD * MODW * 4);
constexpr size_t WS_WINE = WS_ROPE + (size_t)SEQ * 32 * 8;
constexpr size_t WS_WOUTE = WS_WINE + (size_t)2 * EVEN_LDP * DM * 2;
constexpr size_t WS_WINO = WS_WOUTE + (size_t)2 * DM * DM * 2;
constexpr size_t WS_WOUTO = WS_WINO + (size_t)2 * ODD_IN * DM * 2;
constexpr size_t WS_WPQ = WS_WOUTO + (size_t)2 * DM * DM * 2;
constexpr size_t WS_T8 = WS_WPQ + (size_t)4 * DM * DM * 2;
constexpr size_t WS_RS = WS_T8 + (size_t)2 * DEPTH * 16384 * DM;
constexpr size_t WS_KC = WS_RS + (size_t)2 * DEPTH * 16384 * 4;
constexpr size_t WS_VT = WS_KC + (size_t)NB * 8 * KVLEN * 64 * 2;
constexpr size_t WS_KEYS = WS_VT + (size_t)NB * 4 * 128 * KVLEN * 2;
constexpr size_t WS_BAR = WS_KEYS + (size_t)DEPTH * 8 * 2 * 128 * 64 * 2;
constexpr size_t WS_BAR_BYTES = 16384;
constexpr size_t WS_END = WS_BAR + WS_BAR_BYTES;

__global__ void __launch_bounds__(NT, 2) mega(Params p) {
    extern __shared__ __attribute__((aligned(16))) unsigned char lds[];
    float* smem = (float*)lds;
    cg::grid_group grid = cg::this_grid();
    unsigned char* ws = p.ws;
    volatile LAS unsigned* bst = (volatile LAS unsigned*)((LAS unsigned char*)lds + 131072 + 512);
    if (threadIdx.x < 2) bst[threadIdx.x] = 0u;
    __syncthreads();
    (void)xcd_barrier_post((unsigned*)(ws + WS_BAR), bst);
#define GSYNC() do { XcdBarrier b_; b_.bar = (unsigned*)(ws + WS_BAR); b_.x = xb_xcc_id(); b_.st = (volatile LAS unsigned*)((LAS unsigned char*)lds + 131072 + 512); xcd_barrier(b_); } while (0)
#define X_ ((float*)(ws + WS_X))
#define A_ ((bf16*)(ws + WS_A))
#define P_ ((bf16*)(ws + WS_P))
#define ATT_ ((bf16*)(ws + WS_ATT))
#define OF_ ((float*)(ws + WS_OF))
#define OB_ (OF_ + (size_t)RT * 512)
#define MODS_ ((float*)(ws + WS_MODS))
#define ROPE_ ((float2*)(ws + WS_ROPE))
#define WINE_ ((bf16*)(ws + WS_WINE))
#define WOUTE_ ((bf16*)(ws + WS_WOUTE))
#define WINO_ ((bf16*)(ws + WS_WINO))
#define WOUTO_ ((bf16*)(ws + WS_WOUTO))
#define WPQ_ ((bf16*)(ws + WS_WPQ))
#define QP_ P_
#define KEYS_ ((bf16*)(ws + WS_KEYS))
#define KC_ ((bf16*)(ws + WS_KC))
#define VT_ ((bf16*)(ws + WS_VT))
#define T8_ (ws + WS_T8)
#define RS_ ((float*)(ws + WS_RS))
#define IDX_ ((int*)(ws + WS_P + (size_t)RT * DM * 2))
#define GATE_ ((float*)(ws + WS_P + (size_t)RT * DM * 2 + (size_t)RT * 128 * 4))

    ph_copy_in(p.in[0], p.in[2], X_);
    ph_rope_table(ROPE_);
    ph_weight_prep(p.in, WINE_, WOUTE_, WINO_, WOUTO_, WPQ_, KEYS_, lds);
    ph_table_prep(p.in[25], p.in[26], T8_, RS_);
    __syncthreads();
    ph_mods(p.in[1], p.in[3], p.in[4], p.in[5], MODS_, smem);
    grid.sync();
    ph_norm_mod(X_, p.in[6], MODS_, 0, A_);
    GSYNC();
    for (int hl = 0; hl < 2 * DEPTH; ++hl) {
        ws = p.ws; asm volatile("" : "+s"(ws));
        const int l = hl >> 1, part = hl & 1, i = l >> 1, odd = l & 1;
        const float* mods_l = MODS_ + (size_t)l * NMOD * MODW;
        if (part) {
            ph_norm_mod(X_, p.in[7] + l * DM, mods_l, 3, A_);
            GSYNC();
        }
        if (part) ph_gemm_bf16<DM>(A_, WPQ_ + (size_t)l * DM * DM, P_, lds);
        else if (odd) ph_gemm_bf16<ODD_IN>(A_, WINO_ + (size_t)i * ODD_IN * DM, P_, lds);
        else ph_gemm_bf16<EVEN_LDP>(A_, WINE_ + (size_t)i * EVEN_LDP * DM, P_, lds);
        GSYNC();
        if (part == 0) {
            const int ldp = odd ? ODD_IN : EVEN_LDP;
            ph_post(P_, ldp, odd ? 16 : 8, odd ? 1024 : 512, odd ? 4 : 8, odd ? 1280 : 1024, odd ? 256 : 512, odd ? 64 : 128,
                    (odd ? p.in[21] : p.in[10]) + i * 64, (odd ? p.in[22] : p.in[11]) + i * 64, ROPE_, KC_, VT_);
            GSYNC();
            if (!odd) {
                const int G_ = (int)gridDim.x, bid_ = (int)blockIdx.x;
                const int gu = (G_ == 256) ? (((bid_ >> 3) < 16) ? (bid_ & 7) * 16 + (bid_ >> 3) : -1) : bid_;
                ph_gla_chunk(P_, p.in[14] + i * 16 * 256, p.in[15] + i * 256, p.in[16] + i * 16 * 256, p.in[17] + i * 256, OF_, OB_, lds, gu, (G_ == 256) ? 1 << 20 : G_);
            }
            ph_attn_mfma(P_, ldp, KC_, VT_, ATT_, odd, l < DEPTH - 1, lds);
            GSYNC();
            if (!odd) {
                const float lam_init = 0.8f - 0.6f * expf(-0.3f * (float)l);
                ph_even_post(ATT_, p.in[12] + i * 256, p.in[13] + i * 128, lam_init, OF_, OB_, P_, p.in[18] + i * 128);
                GSYNC();
            }
            ph_gemm_res(ATT_, odd ? WOUTO_ + (size_t)i * DM * DM : WOUTE_ + (size_t)i * DM * DM, X_, mods_l + 2 * DM, lds);
            GSYNC();
        } else {
            const int last = (l == DEPTH - 1);
            const int nrows = last ? RL : RT;
            ph_route_mfma(QP_, KEYS_ + (size_t)l * 8 * 2 * 128 * 64, IDX_, GATE_, lds, nrows);
            GSYNC();
            ph_peer_ffn8(A_, IDX_, GATE_, T8_ + (size_t)l * 16384 * 768, RS_ + l * 16384, T8_ + (size_t)(DEPTH + l) * 16384 * 768, RS_ + (DEPTH + l) * 16384, mods_l,
                         X_, last ? p.out : X_, nrows, last ? nullptr : p.in[6] + (l + 1) * DM, mods_l + NMOD * MODW, A_);
            if (!last) GSYNC();
        }
    }
}

extern "C" void kernel_launch(void* const* d_in, const int* in_sizes, int n_in, void* d_out, int out_size, void* d_ws, size_t ws_size, hipStream_t stream) {
    static int grid_blocks = 0;
    if (!grid_blocks) {
        int dev = 0, cus = 0, per_cu = 0;
        (void)hipGetDevice(&dev);
        (void)hipDeviceGetAttribute(&cus, hipDeviceAttributeMultiprocessorCount, dev);
        (void)hipFuncSetAttribute((const void*)mega, hipFuncAttributeMaxDynamicSharedMemorySize, LDS_BYTES);
        (void)hipOccupancyMaxActiveBlocksPerMultiprocessor(&per_cu, mega, NT, LDS_BYTES);
        if (per_cu < 1) fprintf(stderr, "occupancy query says %d blocks/CU\n", per_cu);
        grid_blocks = cus;
        if (ws_size < WS_END) fprintf(stderr, "workspace too small: %zu < %zu\n", ws_size, (size_t)WS_END);
    }
    (void)hipMemsetAsync((unsigned char*)d_ws + WS_BAR, 0, WS_BAR_BYTES, stream);
    Params p{};
    for (int i = 0; i < 27; ++i) p.in[i] = (const float*)d_in[i];
    p.out = (float*)d_out; p.ws = (unsigned char*)d_ws;
    void* args[] = {&p};
    hipError_t e = hipLaunchCooperativeKernel((void*)mega, dim3(grid_blocks), dim3(NT), args, LDS_BYTES, stream);
    if (e != hipSuccess) fprintf(stderr, "cooperative launch failed: %s (grid %d)\n", hipGetErrorString(e), grid_blocks);
}
```

```cpp
#include <hip/hip_runtime.h>
#include <hip/hip_cooperative_groups.h>
#include <stdint.h>
#include <cstdio>
namespace cg = cooperative_groups;

#define DM 1024
#define NB 16
#define SEQ 2048
#define CTX 256
#define RL (NB * SEQ)
#define RC (NB * CTX)
#define RT (RL + RC)
#define DEPTH 4
#define EVEN_IN 3104
#define EVEN_LDP 3328
#define ODD_IN 1536
#define NMOD 17
#define MODW 6144
#define NT 512
#define NWV 8
#define LDS_BYTES 147456
#ifndef DUP_FFN
#define DUP_FFN 0
#endif
#ifndef DUP_ROUTE
#define DUP_ROUTE 0
#endif
#ifndef DUP_ATTN
#define DUP_ATTN 0
#endif
#ifndef DUP_GEMM
#define DUP_GEMM 0
#endif

typedef unsigned short bf16;
typedef float f32x2_t __attribute__((ext_vector_type(2)));
typedef __bf16 bf16x2_t __attribute__((ext_vector_type(2)));
struct Params {
    const float* in[27];
    float* out;
    unsigned char* ws;
};

__device__ __forceinline__ int row_mod(int r) { return r < RL ? (r >> 11) : 16; }
__device__ __forceinline__ float silu_f(float x) { return x / (1.f + expf(-x)); }
__device__ __forceinline__ float wave_sum(float v) {
#pragma unroll
    for (int o = 1; o < 64; o <<= 1) v += __shfl_xor(v, o);
    return v;
}
__device__ __forceinline__ float log_sigmoid_f(float z) { return fminf(z, 0.f) - log1pf(expf(-fabsf(z))); }
__device__ __forceinline__ float gelu_tanh(float x) { float u = 0.7978845608028654f * (x + 0.044715f * x * x * x); return 0.5f * x * (1.f + tanhf(u)); }
__device__ __forceinline__ float bf2f(bf16 v) { return __uint_as_float((unsigned)v << 16); }
__device__ __forceinline__ unsigned f2bf(float f) { unsigned u = __float_as_uint(f); return (u + 0x7fffu + ((u >> 16) & 1u)) >> 16; }
__device__ __forceinline__ unsigned pk2(float lo, float hi) { return f2bf(lo) | (f2bf(hi) << 16); }
__device__ __forceinline__ float4 ld4bf(const bf16* p) { uint2 u = *(const uint2*)p; return make_float4(__uint_as_float(u.x << 16), __uint_as_float(u.x & 0xffff0000u), __uint_as_float(u.y << 16), __uint_as_float(u.y & 0xffff0000u)); }
__device__ __forceinline__ void st4bf(bf16* p, float4 v) { *(uint2*)p = make_uint2(pk2(v.x, v.y), pk2(v.z, v.w)); }
__device__ __forceinline__ float2 ld2bf(const bf16* p) { unsigned u = *(const unsigned*)p; return make_float2(__uint_as_float(u << 16), __uint_as_float(u & 0xffff0000u)); }
__device__ __forceinline__ void st2bf(bf16* p, float2 v) { *(unsigned*)p = pk2(v.x, v.y); }

__device__ __forceinline__ int opaque_tid() { int t = threadIdx.x; asm volatile("" : "+v"(t)); return t; }
__device__ __forceinline__ int opaque_bid() { int b = blockIdx.x; asm volatile("" : "+s"(b)); return b; }

namespace pg8 {
#define PG8_LAS __attribute__((address_space(3)))
typedef unsigned short bf16_t;
typedef short bf16x8 __attribute__((ext_vector_type(8)));
typedef float f32x4 __attribute__((ext_vector_type(4)));
typedef unsigned u32x4 __attribute__((ext_vector_type(4)));
constexpr int BM = 256, BK = 64, HALF = 128, HTB = HALF * BK * 2  , STAGE_BYTES = 8 * HTB, NXCD = 8, WGM = 8;

__host__ __device__ __forceinline__ int lds_byte(int r, int c) { const int st = (r >> 4) * 2 + (c >> 5), rr = r & 15, cc = c & 31, ob = rr * 64 + cc * 2; return st * 1024 + (ob ^ (((ob >> 9) & 1) << 5)); }
__host__ __device__ __forceinline__ void stage_rc(int b, int& R, int& C) { const int st = b / 1024, sb = b % 1024, swz = sb ^ (((sb >> 9) & 1) << 5); R = (st >> 1) * 16 + swz / 64; C = (st & 1) * 32 + (swz % 64) / 2; }
__host__ __device__ __forceinline__ int perm32(int rho) { const int n = rho >> 4, i = rho & 15; return 8 * (i >> 2) + 4 * n + (i & 3); }

struct Unit { int pm, pn; };
struct Gemm { const bf16_t* A; const bf16_t* Bt; int M, N, K; };

struct StaticOrder {
    int nM, nN, nwg, G, c;
    __host__ __device__ void init(int M, int N, int G_, int c_) { nM = M / BM; nN = N / BM; nwg = nM * nN; G = G_; c = c_; }
    __host__ __device__ bool next(int i, Unit& u) const {
        const long L = (long)i * G + c; if (L >= nwg) return false;
        int wgid = (int)L; { const int q = nwg / NXCD, r = nwg % NXCD, xcd = wgid % NXCD, off = wgid / NXCD; wgid = (xcd < r ? xcd * (q + 1) : r * (q + 1) + (xcd - r) * q) + off; }
        const int nig = WGM * nN, gid = wgid / nig, fm = gid * WGM, gsz = (nM - fm) < WGM ? (nM - fm) : WGM;
        u.pm = fm + ((wgid % nig) % gsz); u.pn = (wgid % nig) / gsz; return true;
    }
    __device__ __forceinline__ void a_ready(const Unit&) const {}
    __device__ __forceinline__ void done(const Unit&) const {}
};

__device__ __forceinline__ unsigned cvt_pk_bf16(float lo, float hi) { unsigned r; asm volatile("v_cvt_pk_bf16_f32 %0, %1, %2" : "=v"(r) : "v"(lo), "v"(hi)); return r; }
typedef float f32x2 __attribute__((ext_vector_type(2)));
__device__ __forceinline__ f32x2 gelu_pk(f32x2 v) {
    const f32x2 av = __builtin_elementwise_abs(v), d = av * 0.2316418882f + 1.0f;
    f32x2 t; t.x = __builtin_amdgcn_rcpf(d.x); t.y = __builtin_amdgcn_rcpf(d.y);
    f32x2 q = t * 0.5307027145f + (-0.7265760135f); q = q * t + 0.7107068705f; q = q * t + (-0.142248368f); q = q * t + 0.127414796f; q = q * t;
    const f32x2 s = (v * v) * (-0.72134752044f);
    f32x2 e; e.x = __builtin_amdgcn_exp2f(s.x); e.y = __builtin_amdgcn_exp2f(s.y);
    const f32x2 m = v * (q * e), r = v - m;
    f32x2 o; o.x = v.x < 0.f ? m.x : r.x; o.y = v.y < 0.f ? m.y : r.y; return o;
}

template <int ACT  > struct EpiBf16 {
    static constexpr bool PERM = true, AFTER_DRAIN = false; static_assert(ACT == 0 || ACT == 1, "EpiBf16: ACT is 0 (none) or 1 (gelu_pk)");
    bf16_t* O; int ldc; const float* bias; int split_cols; size_t split_stride; float scale0;
    __device__ __forceinline__ void operator()(const f32x4 (&acc)[2][2][4][2], const Unit& u, int wr, int wc, int fr, int fq) const {
        const int row0 = u.pm * BM + wr * 64 + fr; int colt = u.pn * BM; bf16_t* base = O;
        float sc = 1.f; if (split_cols) { const int t = colt / split_cols; base += (size_t)t * split_stride; colt -= t * split_cols; if (t == 0) sc = scale0; }
        const int col0 = colt + wc * 32 + 8 * fq, bcol0 = u.pn * BM + wc * 32 + 8 * fq;
        f32x4 bv[2][2];
#pragma unroll
        for (int bj = 0; bj < 2; ++bj)
#pragma unroll
            for (int n = 0; n < 2; ++n) bv[bj][n] = bias ? *(const f32x4*)(bias + bcol0 + bj * HALF + 4 * n) : (f32x4){0.f, 0.f, 0.f, 0.f};
#pragma unroll
        for (int ai = 0; ai < 2; ++ai)
#pragma unroll
            for (int m = 0; m < 4; ++m) { bf16_t* rowp = base + (size_t)(row0 + ai * HALF + m * 16) * ldc + col0;
#pragma unroll
                for (int bj = 0; bj < 2; ++bj) { f32x4 v0 = acc[ai][bj][m][0] + bv[bj][0], v1 = acc[ai][bj][m][1] + bv[bj][1];
                    if (ACT == 1) { f32x2 a = gelu_pk((f32x2){v0[0], v0[1]}), b = gelu_pk((f32x2){v0[2], v0[3]}), c = gelu_pk((f32x2){v1[0], v1[1]}), d = gelu_pk((f32x2){v1[2], v1[3]});
                        v0 = (f32x4){a.x, a.y, b.x, b.y}; v1 = (f32x4){c.x, c.y, d.x, d.y}; }
                    v0 = v0 * sc; v1 = v1 * sc; u32x4 w; w.x = cvt_pk_bf16(v0[0], v0[1]); w.y = cvt_pk_bf16(v0[2], v0[3]); w.z = cvt_pk_bf16(v1[0], v1[1]); w.w = cvt_pk_bf16(v1[2], v1[3]);
                    *(u32x4*)(rowp + bj * HALF) = w; } }
    }
};
template <class Epi, class Sched, bool ALIGN_EPI = false, bool SP2 = false>
__device__ __forceinline__ void gemm_phase(PG8_LAS unsigned char* lds, const Gemm g, const Sched& S, const Epi& E) {
    const int tid = opaque_tid(), wid = __builtin_amdgcn_readfirstlane(tid >> 6), lane = tid & 63, wr = wid >> 2, wc = wid & 3, fr = lane & 15, fq = lane >> 4;
    const int K = g.K, nt = K / BK;
    unsigned voffA[2], voffB[2];
#pragma unroll
    for (int i = 0; i < 2; ++i) { int R, C; stage_rc(tid * 16 + i * 8192, R, C); const int Rb = Epi::PERM ? ((R & ~31) + perm32(R & 31)) : R;
        voffA[i] = (unsigned)(R * K + C) * 2u; voffB[i] = (unsigned)(Rb * K + C) * 2u; }
    const size_t kstep = (size_t)(BK * 2);
    const size_t hstep = (size_t)HALF * K * 2;
    const size_t tstep = 2 * hstep;
    const unsigned ldsw = (unsigned)wid * 1024u;
    const int aoff = lds_byte(wr * 64 + fr, fq * 8), boff = lds_byte(wc * 32 + fr, fq * 8);
#define PG8_SA(b, h) (((b) * 2 + (h)) * HTB)
#define PG8_SB(b, h) ((4 + (b) * 2 + (h)) * HTB)
#define PG8_STAGE(bufoff, gbase, voff) do { _Pragma("unroll") for (int _i = 0; _i < 2; ++_i) \
        __builtin_amdgcn_global_load_lds((const unsigned*)((const char*)(gbase) + (voff)[_i]), (PG8_LAS unsigned*)(lds + (bufoff) + ldsw + _i * 8192), 16, 0, 0); } while (0)
#define PG8_LDA(dst, b, h) do { _Pragma("unroll") for (int m = 0; m < 4; ++m) _Pragma("unroll") for (int k = 0; k < 2; ++k) dst[m][k] = *(const PG8_LAS bf16x8*)(lds + PG8_SA(b, h) + aoff + m * 2048 + k * 1024); } while (0)
#define PG8_LDB(dst, b, h) do { _Pragma("unroll") for (int n = 0; n < 2; ++n) _Pragma("unroll") for (int k = 0; k < 2; ++k) dst[n][k] = *(const PG8_LAS bf16x8*)(lds + PG8_SB(b, h) + boff + n * 2048 + k * 1024); } while (0)
#define PG8_MMA(ai, bj, At, Bt) do { __builtin_amdgcn_s_setprio(1); _Pragma("unroll") for (int m = 0; m < 4; ++m) _Pragma("unroll") for (int n = 0; n < 2; ++n) _Pragma("unroll") for (int k = 0; k < 2; ++k) \
        acc[ai][bj][m][n] = __builtin_amdgcn_mfma_f32_16x16x32_bf16(Bt[n][k], At[m][k], acc[ai][bj][m][n], 0, 0, 0); __builtin_amdgcn_s_setprio(0); } while (0)
#define PG8_WAIT_V(n) asm volatile("s_waitcnt vmcnt(" #n ")" ::: "memory")
#define PG8_WAIT_L(n) asm volatile("s_waitcnt lgkmcnt(" #n ")" ::: "memory")
#define PG8_BAR __builtin_amdgcn_s_barrier()
#define PG8_SCHED __builtin_amdgcn_sched_barrier(0)
    Unit cur, nxt; int ui = 0;
    if (!S.next(0, cur)) return;
    f32x4 acc[2][2][4][2];
#pragma unroll
    for (int a = 0; a < 2; ++a)
#pragma unroll
        for (int b = 0; b < 2; ++b)
#pragma unroll
            for (int m = 0; m < 4; ++m)
#pragma unroll
                for (int n = 0; n < 2; ++n) acc[a][b][m][n] = (f32x4){0.f, 0.f, 0.f, 0.f};
    bf16x8 At[4][2], B0[2][2], B1[2][2];
    const char* cA = (const char*)g.A + (size_t)cur.pm * tstep; const char* cB = (const char*)g.Bt + (size_t)cur.pn * tstep;
    S.a_ready(cur);
    if constexpr (SP2) {
        PG8_STAGE(PG8_SB(0, 0), cB, voffB); PG8_STAGE(PG8_SB(0, 1), cB + hstep, voffB); PG8_STAGE(PG8_SA(0, 0), cA, voffA); PG8_STAGE(PG8_SA(0, 1), cA + hstep, voffA);
        if (wr == 1) PG8_BAR;
        PG8_WAIT_V(2); PG8_BAR;
        PG8_STAGE(PG8_SB(1, 0), cB + kstep, voffB); PG8_STAGE(PG8_SA(1, 0), cA + kstep, voffA); PG8_STAGE(PG8_SB(1, 1), cB + hstep + kstep, voffB);
        PG8_WAIT_V(6); PG8_BAR;
    } else {
        PG8_STAGE(PG8_SB(0, 0), cB, voffB); PG8_STAGE(PG8_SA(0, 0), cA, voffA); PG8_STAGE(PG8_SB(0, 1), cB + hstep, voffB); PG8_STAGE(PG8_SA(0, 1), cA + hstep, voffA);
        if (wr == 1) PG8_BAR;
        PG8_WAIT_V(4); PG8_BAR;
        PG8_STAGE(PG8_SB(1, 0), cB + kstep, voffB); PG8_STAGE(PG8_SA(1, 0), cA + kstep, voffA); PG8_STAGE(PG8_SB(1, 1), cB + hstep + kstep, voffB);
        PG8_WAIT_V(6); PG8_BAR;
    }
    for (;;) {
        const bool has_next = S.next(ui + 1, nxt);
        const char* nA = has_next ? (const char*)g.A + (size_t)nxt.pm * tstep : cA; const char* nB = has_next ? (const char*)g.Bt + (size_t)nxt.pn * tstep : cB;
        for (int t = 0; t < nt; t += 2) {
            const bool last = (t == nt - 2);
            const char* a1 = cA + (size_t)(t + 1) * kstep;
            const char* a2 = last ? nA : cA + (size_t)(t + 2) * kstep; const char* b2 = last ? nB : cB + (size_t)(t + 2) * kstep;
            const char* a3 = a2 + kstep; const char* b3 = b2 + kstep;
            if (last && has_next) S.a_ready(nxt);
            if constexpr (SP2) {
            PG8_LDB(B0, 0, 0); PG8_LDB(B1, 0, 1); PG8_SCHED; PG8_LDA(At, 0, 0); PG8_STAGE(PG8_SA(1, 1), a1 + hstep, voffA);
            PG8_WAIT_V(8); PG8_WAIT_L(0); PG8_BAR; PG8_MMA(0, 0, At, B0); PG8_MMA(0, 1, At, B1); PG8_BAR; PG8_SCHED;
            PG8_LDA(At, 0, 1); PG8_STAGE(PG8_SB(0, 0), b2, voffB); PG8_STAGE(PG8_SB(0, 1), b2 + hstep, voffB); PG8_STAGE(PG8_SA(0, 0), a2, voffA);
            PG8_WAIT_V(8); PG8_WAIT_L(0); PG8_BAR; PG8_MMA(1, 0, At, B0); PG8_MMA(1, 1, At, B1); PG8_BAR; PG8_SCHED;
            PG8_LDB(B0, 1, 0); PG8_LDB(B1, 1, 1); PG8_SCHED; PG8_LDA(At, 1, 0); PG8_STAGE(PG8_SA(0, 1), a2 + hstep, voffA);
            PG8_WAIT_V(8); PG8_WAIT_L(0); PG8_BAR; PG8_MMA(0, 0, At, B0); PG8_MMA(0, 1, At, B1); PG8_BAR; PG8_SCHED;
            PG8_LDA(At, 1, 1); PG8_STAGE(PG8_SB(1, 0), b3, voffB); PG8_STAGE(PG8_SB(1, 1), b3 + hstep, voffB); PG8_STAGE(PG8_SA(1, 0), a3, voffA);
            PG8_WAIT_V(8); PG8_WAIT_L(0); PG8_BAR; PG8_MMA(1, 0, At, B0); PG8_MMA(1, 1, At, B1); PG8_BAR; PG8_SCHED;
            } else {
            PG8_LDB(B0, 0, 0); PG8_SCHED; PG8_LDA(At, 0, 0); PG8_STAGE(PG8_SA(1, 1), a1 + hstep, voffA);
            PG8_WAIT_L(8); PG8_BAR; PG8_WAIT_L(0); PG8_MMA(0, 0, At, B0); PG8_BAR; PG8_SCHED;
            PG8_LDB(B1, 0, 1); PG8_STAGE(PG8_SB(0, 0), b2, voffB);
            PG8_BAR; PG8_WAIT_L(0); PG8_MMA(0, 1, At, B1); PG8_BAR;
            PG8_LDA(At, 0, 1); PG8_STAGE(PG8_SA(0, 0), a2, voffA);
            PG8_BAR; PG8_WAIT_L(0); PG8_MMA(1, 0, At, B0); PG8_BAR; PG8_SCHED;
            PG8_STAGE(PG8_SB(0, 1), b2 + hstep, voffB);
            PG8_WAIT_V(6); PG8_BAR; PG8_MMA(1, 1, At, B1); PG8_BAR;
            PG8_LDB(B0, 1, 0); PG8_SCHED; PG8_LDA(At, 1, 0); PG8_STAGE(PG8_SA(0, 1), a2 + hstep, voffA);
            PG8_WAIT_L(8); PG8_BAR; PG8_WAIT_L(0); PG8_MMA(0, 0, At, B0); PG8_BAR; PG8_SCHED;
            PG8_LDB(B1, 1, 1); PG8_STAGE(PG8_SB(1, 0), b3, voffB);
            PG8_BAR; PG8_WAIT_L(0); PG8_MMA(0, 1, At, B1); PG8_BAR;
            PG8_LDA(At, 1, 1); PG8_STAGE(PG8_SA(1, 0), a3, voffA);
            PG8_BAR; PG8_WAIT_L(0); PG8_MMA(1, 0, At, B0); PG8_BAR; PG8_SCHED;
            PG8_STAGE(PG8_SB(1, 1), b3 + hstep, voffB);
            PG8_WAIT_V(6); PG8_BAR; PG8_MMA(1, 1, At, B1); PG8_BAR;
            }
        }
        if constexpr (ALIGN_EPI) { if (wr == 0) PG8_BAR; }
        if constexpr (!Epi::AFTER_DRAIN) { E(acc, cur, wr, wc, fr, fq); S.done(cur); }
        if (!has_next) break;
#pragma unroll
        for (int a = 0; a < 2; ++a)
#pragma unroll
            for (int b = 0; b < 2; ++b)
#pragma unroll
                for (int m = 0; m < 4; ++m)
#pragma unroll
                    for (int n = 0; n < 2; ++n) acc[a][b][m][n] = (f32x4){0.f, 0.f, 0.f, 0.f};
        cur = nxt; cA = nA; cB = nB; ++ui;
        if constexpr (ALIGN_EPI) { if (wr == 1) PG8_BAR; }
    }
    PG8_WAIT_V(0);
    if constexpr (!ALIGN_EPI) { if (wr == 0) PG8_BAR; }
    PG8_BAR;
    if constexpr (Epi::AFTER_DRAIN) { E.fused(acc, cur, wr, wc, fr, fq, lds, wid, lane); S.done(cur); }
#undef PG8_SA
#undef PG8_SB
#undef PG8_STAGE
#undef PG8_LDA
#undef PG8_LDB
#undef PG8_MMA
#undef PG8_WAIT_V
#undef PG8_WAIT_L
#undef PG8_BAR
#undef PG8_SCHED
}
}

struct EpiResGate {
    static constexpr bool PERM = false, AFTER_DRAIN = false;
    float* X; const float* gate;
    __device__ __forceinline__ void operator()(const pg8::f32x4 (&acc)[2][2][4][2], const pg8::Unit& u, int wr, int wc, int fr, int fq) const {
#pragma unroll
        for (int ai = 0; ai < 2; ++ai)
#pragma unroll
            for (int m = 0; m < 4; ++m) {
                const int r = u.pm * 256 + ai * 128 + wr * 64 + m * 16 + fr;
                const float* g = gate + (size_t)row_mod(r) * MODW; float* xr = X + (size_t)r * DM;
#pragma unroll
                for (int bj = 0; bj < 2; ++bj)
#pragma unroll
                    for (int n = 0; n < 2; ++n) {
                        const int c = u.pn * 256 + bj * 128 + wc * 32 + n * 16 + 4 * fq;
                        pg8::f32x4 xv = *(const pg8::f32x4*)(xr + c); const pg8::f32x4 gv = *(const pg8::f32x4*)(g + c);
                        xv = xv + gv * acc[ai][bj][m][n];
                        *(pg8::f32x4*)(xr + c) = xv;
                    }
            }
    }
};
#define LAS __attribute__((address_space(3)))
#define GAS __attribute__((address_space(1)))

__device__ __forceinline__ void ph_copy_in(const float* __restrict__ x, const float* __restrict__ ctx, float* __restrict__ X) {
    const int TID = opaque_tid(), BID = opaque_bid();
    size_t i = (size_t)BID * NT + TID;
    const size_t n4 = (size_t)RT * DM / 4, nl4 = (size_t)RL * DM / 4;
    for (; i < n4; i += (size_t)gridDim.x * NT) ((float4*)X)[i] = i < nl4 ? ((const float4*)x)[i] : ((const float4*)ctx)[i - nl4];
}
__device__ __forceinline__ void ph_copy_out(const float* __restrict__ X, float* __restrict__ out) {
    const int TID = opaque_tid(), BID = opaque_bid();
    size_t i = (size_t)BID * NT + TID;
    const size_t n4 = (size_t)RL * DM / 4;
    for (; i < n4; i += (size_t)gridDim.x * NT) ((float4*)out)[i] = ((const float4*)X)[i];
}
__device__ __forceinline__ void ph_rope_table(float2* __restrict__ rope) {
    const int TID = opaque_tid(), BID = opaque_bid();
    for (int i = BID * NT + TID; i < SEQ * 32; i += gridDim.x * NT) {
        int t = i >> 5, a = (i >> 4) & 1, f = i & 15;
        float pos = a == 0 ? (float)(t >> 6) : (float)(t & 63);
        float inv = powf(10000.f, -(float)f / 16.f);
        float ang = pos * inv;
        rope[i] = make_float2(cosf(ang), sinf(ang));
    }
}
__device__ __forceinline__ void transpose_item(const float* __restrict__ W, int N, bf16* __restrict__ WT, LAS float* scr, int item, int lane) {
    const int K = DM;
    const int nblk = N / 32, kb = item / nblk, nb = item % nblk, k0 = 64 * kb, n0 = 32 * nb;
#pragma unroll 8
    for (int i = 0; i < 32; ++i) { const int kk = 2 * i + (lane >> 5); scr[kk * 33 + (lane & 31)] = W[(size_t)(k0 + kk) * N + n0 + (lane & 31)]; }
    asm volatile("s_waitcnt lgkmcnt(0)" ::: "memory");
    const int c = lane & 7;
#pragma unroll
    for (int j = 0; j < 4; ++j) { const int n = (lane >> 3) + 8 * j; const LAS float* s = scr + (8 * c) * 33 + n;
        uint4 o; o.x = pk2(s[0 * 33], s[1 * 33]); o.y = pk2(s[2 * 33], s[3 * 33]); o.z = pk2(s[4 * 33], s[5 * 33]); o.w = pk2(s[6 * 33], s[7 * 33]);
        *(uint4*)(WT + (size_t)(n0 + n) * K + k0 + 8 * c) = o; }
    asm volatile("s_waitcnt lgkmcnt(0)" ::: "memory");
}
struct WPrep { const float* src[12]; bf16* dst[12]; };
__device__ __forceinline__ void ph_weight_prep(const float* const* in, bf16* WinE, bf16* WoutE, bf16* WinO, bf16* WoutO, bf16* Wpq, bf16* Kb, unsigned char* lds) {
    const int TID = opaque_tid(), BID = opaque_bid();
    const int lane = TID & 63, wv = TID >> 6;
    LAS float* scr = (LAS float*)((LAS unsigned char*)lds + wv * 16384);
    const int gw = BID * NWV + wv, NGW = gridDim.x * NWV;
    const int NITEMS = 2 * 1552 + 2 * 512 + 2 * 768 + 2 * 512 + 4 * 512;
    for (int it = gw; it < NITEMS; it += NGW) {
        int r = it;
        if (r < 3104) { int i = r / 1552; transpose_item(in[8] + (size_t)i * DM * EVEN_IN, EVEN_IN, WinE + (size_t)i * EVEN_LDP * DM, scr, r % 1552, lane); continue; } r -= 3104;
        if (r < 1024) { int i = r / 512; transpose_item(in[9] + (size_t)i * DM * DM, DM, WoutE + (size_t)i * DM * DM, scr, r % 512, lane); continue; } r -= 1024;
        if (r < 1536) { int i = r / 768; transpose_item(in[19] + (size_t)i * DM * ODD_IN, ODD_IN, WinO + (size_t)i * ODD_IN * DM, scr, r % 768, lane); continue; } r -= 1536;
        if (r < 1024) { int i = r / 512; transpose_item(in[20] + (size_t)i * DM * DM, DM, WoutO + (size_t)i * DM * DM, scr, r % 512, lane); continue; } r -= 1024;
        { int i = r / 512; transpose_item(in[23] + (size_t)i * DM * DM, DM, Wpq + (size_t)i * DM * DM, scr, r % 512, lane); }
    }
    for (int i4 = BID * NT + TID; i4 < DEPTH * 8 * 2 * 128 * 64 / 4; i4 += gridDim.x * NT) st4bf(Kb + 4 * (size_t)i4, ((const float4*)in[24])[i4]);
    for (int i = BID * NT + TID; i < 2 * 28672; i += gridDim.x * NT) {
        int w = i / 28672, o = i % 28672;
        ((uint4*)(WinE + (size_t)w * EVEN_LDP * DM + (size_t)EVEN_IN * DM))[o] = make_uint4(0u, 0u, 0u, 0u);
    }
}
__device__ __forceinline__ void ph_mods(const float* __restrict__ c, const float* __restrict__ cctx, const float* __restrict__ w_mod,
                        const float* __restrict__ b_mod, float* __restrict__ mods, float* smem) {
    const int TID = opaque_tid(), BID = opaque_bid();
    const int nslab = DEPTH * MODW / 128;
    if (BID >= nslab) return;
    const int lane = TID & 63, wv = TID >> 6, cl = lane & 15, kp = lane >> 4;
    float (*S)[DM] = (float (*)[DM])smem;
    for (int i = TID; i < NMOD * DM; i += NT) {
        int j = i / DM, k = i % DM;
        float v = j < 16 ? c[j * DM + k] : cctx[k];
        S[j][k] = silu_f(v);
    }
    __syncthreads();
    for (int slab = BID; slab < nslab; slab += gridDim.x) {
        const int l = slab / 48, n = (slab % 48) * 128 + wv * 16 + cl;
        const float* W = w_mod + (size_t)l * DM * MODW + n;
        float acc[NMOD];
#pragma unroll
        for (int j = 0; j < NMOD; ++j) acc[j] = 0.f;
#pragma unroll 4
        for (int kk = 0; kk < 256; ++kk) {
            const int k = kp * 256 + kk;
            const float w = W[(size_t)k * MODW];
#pragma unroll
            for (int j = 0; j < NMOD; ++j) acc[j] += S[j][k] * w;
        }
        const float bias = b_mod[l * MODW + n];
#pragma unroll
        for (int j = 0; j < NMOD; ++j) {
            float v = acc[j];
            v += __shfl_xor(v, 16); v += __shfl_xor(v, 32);
            if (kp == 0) mods[((size_t)l * NMOD + j) * MODW + n] = v + bias;
        }
    }
    __syncthreads();
}
__device__ __forceinline__ void ph_norm_mod(const float* __restrict__ X, const float* __restrict__ g, const float* __restrict__ mods_l, int shift_chunk, bf16* __restrict__ A) {
    const int TID = opaque_tid(), BID = opaque_bid();
    int wave = BID * NWV + (TID >> 6), lane = TID & 63;
    int nw = gridDim.x * NWV;
    for (int r = wave; r < RT; r += nw) {
        const float4* xr = (const float4*)(X + (size_t)r * DM);
        float4 v[4]; float s = 0.f;
#pragma unroll
        for (int i = 0; i < 4; ++i) { v[i] = xr[lane + 64 * i]; s += v[i].x * v[i].x + v[i].y * v[i].y + v[i].z * v[i].z + v[i].w * v[i].w; }
        s = wave_sum(s);
        float rstd = rsqrtf(s * (1.f / DM) + 1e-6f);
        const float* m = mods_l + (size_t)row_mod(r) * MODW;
        const float4* sh = (const float4*)(m + shift_chunk * DM);
        const float4* sc = (const float4*)(m + (shift_chunk + 1) * DM);
        const float4* g4 = (const float4*)g;
        bf16* ar = A + (size_t)r * DM;
#pragma unroll
        for (int i = 0; i < 4; ++i) {
            int c = lane + 64 * i;
            float4 gg = g4[c], a = sh[c], b = sc[c], o;
            o.x = v[i].x * rstd * gg.x * (1.f + b.x) + a.x;
            o.y = v[i].y * rstd * gg.y * (1.f + b.y) + a.y;
            o.z = v[i].z * rstd * gg.z * (1.f + b.z) + a.z;
            o.w = v[i].w * rstd * gg.w * (1.f + b.w) + a.w;
            st4bf(ar + 4 * c, o);
        }
    }
}
#define KVLEN (CTX + SEQ)
__device__ __forceinline__ void ph_post(bf16* __restrict__ P, int ldp, int nq, int kcol0, int nk, int vcol0, int VC, int DV,
                                        const float* __restrict__ qgain, const float* __restrict__ kgain, const float2* __restrict__ rope,
                                        bf16* __restrict__ Kc, bf16* __restrict__ Vt) {
    const int TID = opaque_tid(), BID = opaque_bid();
    const float C2 = 0.125f * 1.4426950408889634f;
    for (int tile = BID; tile < RT / 64; tile += gridDim.x) {
        const int r0 = tile * 64;
        int b, j0;
        if (r0 < RL) { b = r0 >> 11; j0 = CTX + (r0 & (SEQ - 1)); } else { b = (r0 - RL) >> 8; j0 = (r0 - RL) & (CTX - 1); }
        const int nh = nq + nk, sub = TID & 7;
        for (int ti = TID; ti < 64 * nh * 8; ti += NT) {
            const int item = ti >> 3, row = item / nh, hh = item % nh, r = r0 + row;
            const bool isk = hh >= nq; const int h = isk ? hh - nq : hh;
            bf16* src = P + (size_t)r * ldp + (isk ? kcol0 : 0) + h * 64 + sub * 8;
            const float* gain = (isk ? kgain : qgain) + sub * 8;
            const uint4 raw = *(const uint4*)src;
            const unsigned rw[4] = {raw.x, raw.y, raw.z, raw.w};
            float v[8]; float ssq = 0.f;
#pragma unroll
            for (int i = 0; i < 4; ++i) { v[2 * i] = __uint_as_float(rw[i] << 16); v[2 * i + 1] = __uint_as_float(rw[i] & 0xffff0000u); ssq += v[2 * i] * v[2 * i] + v[2 * i + 1] * v[2 * i + 1]; }
            ssq += __shfl_xor(ssq, 1); ssq += __shfl_xor(ssq, 2); ssq += __shfl_xor(ssq, 4);
            const float rstd = rsqrtf(ssq * (1.f / 64.f) + 1e-6f) * (isk ? 1.f : C2);
            const float4 g0 = ((const float4*)gain)[0], g1 = ((const float4*)gain)[1];
            const float gg[8] = {g0.x, g0.y, g0.z, g0.w, g1.x, g1.y, g1.z, g1.w};
#pragma unroll
            for (int i = 0; i < 8; ++i) v[i] = v[i] * rstd * gg[i];
            float pv[8];
#pragma unroll
            for (int i = 0; i < 8; ++i) pv[i] = __shfl_xor(v[i], 2);
            if (r < RL) {
                const float2* tab = rope + (size_t)(r & (SEQ - 1)) * 32 + (sub >> 2) * 16 + (sub & 1) * 8;
                const bool second = (sub & 2) != 0;
#pragma unroll
                for (int i = 0; i < 8; ++i) { const float2 cs = tab[i]; v[i] = second ? (v[i] * cs.x + pv[i] * cs.y) : (v[i] * cs.x - pv[i] * cs.y); }
            }
            bf16* dst = isk ? Kc + ((size_t)(b * nk + h) * KVLEN + j0 + row) * 64 + sub * 8 : src;
            *(uint4*)dst = make_uint4(pk2(v[0], v[1]), pk2(v[2], v[3]), pk2(v[4], v[5]), pk2(v[6], v[7]));
        }
        if (TID < VC) {
            const int c8 = TID >> 3, rg = TID & 7;
            unsigned in[8][4];
#pragma unroll
            for (int rr = 0; rr < 8; ++rr) { uint4 t = *(const uint4*)(P + (size_t)(r0 + rg * 8 + rr) * ldp + vcol0 + c8 * 8); in[rr][0] = t.x; in[rr][1] = t.y; in[rr][2] = t.z; in[rr][3] = t.w; }
#pragma unroll
            for (int c = 0; c < 8; ++c) {
                unsigned o[4];
#pragma unroll
                for (int q = 0; q < 4; ++q)
                    o[q] = (c & 1) ? __builtin_amdgcn_perm(in[2 * q + 1][c >> 1], in[2 * q][c >> 1], 0x07060302u) : __builtin_amdgcn_perm(in[2 * q + 1][c >> 1], in[2 * q][c >> 1], 0x05040100u);
                const int col = c8 * 8 + c, vh = col / DV, d = col % DV;
                bf16* vrow = Vt + ((size_t)(b * 4 + vh) * DV + d) * KVLEN + j0 + 16 * (rg >> 1) + 4 * (rg & 1);
                *(uint2*)vrow = make_uint2(o[0], o[1]);
                *(uint2*)(vrow + 8) = make_uint2(o[2], o[3]);
            }
        }
    }
}
typedef short bf16x8 __attribute__((ext_vector_type(8)));
typedef float f32x16 __attribute__((ext_vector_type(16)));
__device__ __forceinline__ int crow(int r, int hi) { return (r & 3) + 8 * (r >> 2) + 4 * hi; }
__device__ __forceinline__ unsigned cvt_pk_bf16_f32(float lo, float hi) { f32x2_t v = {lo, hi}; bf16x2_t b = __builtin_convertvector(v, bf16x2_t); return __builtin_bit_cast(unsigned, b); }
__device__ __forceinline__ float max3f(float a, float b, float c) { return fmaxf(fmaxf(a, b), c); }
__device__ __forceinline__ float max2f(float a, float b) { return fmaxf(a, b); }
#define ATT_KPITCH 144
#define ATT_VPITCH 144
template <int DV>
__device__ __forceinline__ void attn_unit(const bf16* __restrict__ Qbase, int ldq, const bf16* __restrict__ Kc, const bf16* __restrict__ Vt, int ntiles,
                                          bf16* __restrict__ Obase, int ldo, unsigned char* lds, int tid) {
    constexpr int NDB = DV / 32, NVL = DV / 64, KBYTES = 64 * ATT_KPITCH, VBYTES = DV * ATT_VPITCH;
    constexpr float THR = 8.f;
    const int lane = tid & 63, wid = tid >> 6, r32 = lane & 31, hi = lane >> 5;
    unsigned char* Kb0 = lds; unsigned char* Vb0 = lds + 2 * KBYTES;
    float* sc = (float*)(lds + 2 * KBYTES + 2 * VBYTES + wid * 128);
    bf16x8 qf[4];
    {
        const bf16* qrow = Qbase + (size_t)(wid * 32 + r32) * ldq;
#pragma unroll
        for (int s = 0; s < 4; ++s) qf[s] = *(const bf16x8*)(qrow + 16 * s + 8 * hi);
    }
    f32x16 o[NDB];
#pragma unroll
    for (int d = 0; d < NDB; ++d)
#pragma unroll
        for (int r = 0; r < 16; ++r) o[d][r] = 0.f;
    float m = -1e30f, l = 0.f;
    uint4 kreg, vreg0, vreg1 = make_uint4(0u, 0u, 0u, 0u);
    const int krow = tid >> 3, kch = tid & 7;
    const unsigned voff0 = (unsigned)(tid >> 3) * (unsigned)(KVLEN * 2) + (unsigned)(tid & 7) * 16u, voff1 = voff0 + 64u * (unsigned)(KVLEN * 2);
    const unsigned vlds0 = (unsigned)(tid >> 3) * ATT_VPITCH + (unsigned)(tid & 7) * 16u, vlds1 = vlds0 + 64u * ATT_VPITCH;
#define ATT_GLOAD_K(t) do { kreg = *(const uint4*)((const unsigned char*)Kc + ((unsigned)(t) * 8192u + (unsigned)tid * 16u)); } while (0)
#define ATT_GLOAD_V(t) do { vreg0 = *(const uint4*)((const unsigned char*)Vt + (voff0 + (unsigned)(t) * 128u)); if (NVL == 2) vreg1 = *(const uint4*)((const unsigned char*)Vt + (voff1 + (unsigned)(t) * 128u)); } while (0)
#define ATT_STORE_K(buf) do { *(uint4*)(Kb0 + (buf) * KBYTES + krow * ATT_KPITCH + kch * 16) = kreg; } while (0)
#define ATT_STORE_V(buf) do { *(uint4*)(Vb0 + (buf) * VBYTES + vlds0) = vreg0; if (NVL == 2) *(uint4*)(Vb0 + (buf) * VBYTES + vlds1) = vreg1; } while (0)
#define ATT_QK(S0, S1, buf) do { const unsigned char* kb_ = Kb0 + (buf) * KBYTES; \
        _Pragma("unroll") for (int r = 0; r < 16; ++r) { S0[r] = 0.f; S1[r] = 0.f; } \
        _Pragma("unroll") for (int s = 0; s < 4; ++s) { \
            const bf16x8 a0 = *(const bf16x8*)(kb_ + r32 * ATT_KPITCH + s * 32 + hi * 16); \
            const bf16x8 a1 = *(const bf16x8*)(kb_ + (32 + r32) * ATT_KPITCH + s * 32 + hi * 16); \
            S0 = __builtin_amdgcn_mfma_f32_32x32x16_bf16(a0, qf[s], S0, 0, 0, 0); \
            S1 = __builtin_amdgcn_mfma_f32_32x32x16_bf16(a1, qf[s], S1, 0, 0, 0); } } while (0)
    ATT_GLOAD_K(0); ATT_GLOAD_V(0);
    ATT_STORE_K(0); ATT_STORE_V(0); ATT_STORE_V(1);
    if (ntiles > 1) { ATT_GLOAD_K(1); ATT_STORE_K(1); }
    __syncthreads();
    f32x16 s0, s1;
    ATT_QK(s0, s1, 0);
    __syncthreads();
    uint4 pa0 = make_uint4(0u, 0u, 0u, 0u), pa1 = pa0, pa2 = pa0, pa3 = pa0;
#define ATT_PA(s) __builtin_bit_cast(bf16x8, (s) == 0 ? pa0 : (s) == 1 ? pa1 : (s) == 2 ? pa2 : pa3)
    for (int t = 0; t < ntiles; ++t) {
        if (t + 2 < ntiles) ATT_GLOAD_K(t + 2);
        if (t > 0) ATT_GLOAD_V(t);
        f32x16 n0, n1;
        ATT_QK(n0, n1, (t + 1) & 1);
        {
            const unsigned char* vb = Vb0 + ((t + 1) & 1) * VBYTES;
#pragma unroll
            for (int d = 0; d < NDB; ++d) {
#pragma unroll
                for (int s = 0; s < 4; ++s) {
                    const bf16x8 vf = *(const bf16x8*)(vb + (32 * d + r32) * ATT_VPITCH + 32 * s + 16 * hi);
                    o[d] = __builtin_amdgcn_mfma_f32_32x32x16_bf16(ATT_PA(s), vf, o[d], 0, 0, 0);
                }
            }
        }
        float tm = max3f(s0[0], s1[0], s0[1]);
        tm = max3f(tm, s1[1], s0[2]); tm = max3f(tm, s1[2], s0[3]); tm = max3f(tm, s1[3], s0[4]);
#pragma unroll
        for (int r = 4; r < 15; r += 2) { tm = max3f(tm, s1[r], s0[r + 1]); tm = max3f(tm, s1[r + 1], s0[r + 2 < 16 ? r + 2 : 15]); }
        tm = max2f(tm, s1[15]);
        tm = max2f(tm, __shfl_xor(tm, 32));
        const bool up = tm > m + THR;
        const float mn = up ? max2f(m, tm) : m, alpha = exp2f(m - mn);
        m = mn; l *= alpha;
        float ps = 0.f;
#pragma unroll
        for (int r = 0; r < 16; ++r) { s0[r] = exp2f(s0[r] - m); s1[r] = exp2f(s1[r] - m); ps += s0[r] + s1[r]; }
        l += ps;
        uint4 pn0 = make_uint4(cvt_pk_bf16_f32(s0[0], s0[1]), cvt_pk_bf16_f32(s0[2], s0[3]), cvt_pk_bf16_f32(s0[4], s0[5]), cvt_pk_bf16_f32(s0[6], s0[7]));
        uint4 pn1 = make_uint4(cvt_pk_bf16_f32(s0[8], s0[9]), cvt_pk_bf16_f32(s0[10], s0[11]), cvt_pk_bf16_f32(s0[12], s0[13]), cvt_pk_bf16_f32(s0[14], s0[15]));
        uint4 pn2 = make_uint4(cvt_pk_bf16_f32(s1[0], s1[1]), cvt_pk_bf16_f32(s1[2], s1[3]), cvt_pk_bf16_f32(s1[4], s1[5]), cvt_pk_bf16_f32(s1[6], s1[7]));
        uint4 pn3 = make_uint4(cvt_pk_bf16_f32(s1[8], s1[9]), cvt_pk_bf16_f32(s1[10], s1[11]), cvt_pk_bf16_f32(s1[12], s1[13]), cvt_pk_bf16_f32(s1[14], s1[15]));
        asm volatile("" : "+v"(pn0.x), "+v"(pn0.y), "+v"(pn0.z), "+v"(pn0.w), "+v"(pn1.x), "+v"(pn1.y), "+v"(pn1.z), "+v"(pn1.w));
        asm volatile("" : "+v"(pn2.x), "+v"(pn2.y), "+v"(pn2.z), "+v"(pn2.w), "+v"(pn3.x), "+v"(pn3.y), "+v"(pn3.z), "+v"(pn3.w), "+v"(l));
        __builtin_amdgcn_sched_group_barrier(0x100, 4, 0);
#pragma unroll
        for (int i = 0; i < 8 + 4 * NDB; ++i) {
            __builtin_amdgcn_sched_group_barrier(0x008, 1, 0);
            __builtin_amdgcn_sched_group_barrier(0x100, 1, 0);
            __builtin_amdgcn_sched_group_barrier(0x002, NDB == 2 ? 8 : 6, 0);
            __builtin_amdgcn_sched_group_barrier(0x400, NDB == 2 ? 2 : 1, 0);
        }
        if (__any(up)) {
            if (hi == 0) sc[r32] = alpha;
#pragma unroll
            for (int r = 0; r < 16; ++r) { const float a = sc[crow(r, hi)];
#pragma unroll
                for (int d = 0; d < NDB; ++d) o[d][r] *= a; }
        }
        if (t + 2 < ntiles) ATT_STORE_K(t & 1);
        if (t > 0) ATT_STORE_V(t & 1);
        __syncthreads();
        s0 = n0; s1 = n1;
        pa0 = pn0; pa1 = pn1; pa2 = pn2; pa3 = pn3;
    }
    {
        const unsigned char* vb = Vb0 + ((ntiles - 1) & 1) * VBYTES;
#pragma unroll
        for (int d = 0; d < NDB; ++d) {
#pragma unroll
            for (int s = 0; s < 4; ++s) {
                const bf16x8 vf = *(const bf16x8*)(vb + (32 * d + r32) * ATT_VPITCH + 32 * s + 16 * hi);
                o[d] = __builtin_amdgcn_mfma_f32_32x32x16_bf16(ATT_PA(s), vf, o[d], 0, 0, 0);
            }
        }
    }
#undef ATT_GLOAD_K
#undef ATT_GLOAD_V
#undef ATT_STORE_K
#undef ATT_STORE_V
#undef ATT_QK
#undef ATT_PA
    l += __shfl_xor(l, 32);
    if (hi == 0) sc[r32] = 1.f / l;
    int tide = tid; asm volatile("" : "+v"(tide));
    const unsigned obase_off = (unsigned)(((tide >> 6) * 32 + 4 * ((tide >> 5) & 1)) * ldo + (tide & 31)) * 2u;
#pragma unroll
    for (int r = 0; r < 16; ++r) {
        const float iv = sc[crow(r, hi)];
        bf16* orow = (bf16*)((unsigned char*)Obase + (obase_off + (unsigned)(((r & 3) + 8 * (r >> 2)) * ldo) * 2u));
#pragma unroll
        for (int d = 0; d < NDB; ++d) orow[32 * d] = (bf16)f2bf(o[d][r] * iv);
    }
    __syncthreads();
}
__device__ __forceinline__ void attn_run_unit(const bf16* __restrict__ P, int ldp, const bf16* __restrict__ Kc, const bf16* __restrict__ Vt, bf16* __restrict__ ATT,
                                              int odd, int u, int nlat, unsigned char* lds, int TID) {
    int b, qh, row0, ntiles;
    if (u < nlat) {
        if (odd) { const int grp = u >> 5, w = u & 31; b = grp >> 2; qh = (grp & 3) * 4 + (w >> 3); row0 = b * SEQ + (w & 7) * 256; }
        else { const int grp = u >> 4, w = u & 15; b = grp >> 2; qh = (grp & 3) * 2 + (w >> 3); row0 = b * SEQ + (w & 7) * 256; }
        ntiles = KVLEN / 64;
    } else {
        const int idx = u - nlat;
        if (odd) { b = idx >> 4; qh = idx & 15; } else { b = idx >> 3; qh = idx & 7; }
        row0 = RL + b * CTX; ntiles = CTX / 64;
    }
    if (odd) attn_unit<64>(P + (size_t)row0 * ldp + qh * 64, ldp, Kc + (size_t)(b * 4 + (qh >> 2)) * KVLEN * 64, Vt + (size_t)(b * 4 + (qh >> 2)) * 64 * KVLEN, ntiles,
                           ATT + (size_t)row0 * DM + qh * 64, DM, lds, TID);
    else attn_unit<128>(P + (size_t)row0 * ldp + qh * 64, ldp, Kc + (size_t)(b * 8 + qh) * KVLEN * 64, Vt + (size_t)(b * 4 + (qh >> 1)) * 128 * KVLEN, ntiles,
                        ATT + (size_t)row0 * DM + qh * 128, DM, lds, TID);
}
__device__ __forceinline__ void ph_attn_mfma(const bf16* __restrict__ P, int ldp, const bf16* __restrict__ Kc, const bf16* __restrict__ Vt, bf16* __restrict__ ATT,
                                             int odd, int with_ctx, unsigned char* lds) {
    const int TID = opaque_tid(), BID = opaque_bid();
    const int G = gridDim.x, vcu = (G % 8 == 0) ? (BID & 7) * (G >> 3) + (BID >> 3) : BID;
    const int nlat = odd ? 2048 : 1024, nctx = with_ctx ? (odd ? 256 : 128) : 0;
    if (!odd && G == 256) {
        const int x = BID & 7, w = BID >> 3;
        if (w >= 16) { for (int i = 0; i < 6; ++i) attn_run_unit(P, ldp, Kc, Vt, ATT, odd, x * 128 + 16 * i + (w - 16), nlat, lds, TID); }
        else {
            attn_run_unit(P, ldp, Kc, Vt, ATT, odd, x * 128 + 96 + w, nlat, lds, TID);
            attn_run_unit(P, ldp, Kc, Vt, ATT, odd, x * 128 + 112 + w, nlat, lds, TID);
            if (nctx) attn_run_unit(P, ldp, Kc, Vt, ATT, odd, nlat + x * 16 + w, nlat, lds, TID);
        }
        return;
    }
    for (int u = vcu; u < nlat + nctx; u += G) attn_run_unit(P, ldp, Kc, Vt, ATT, odd, u, nlat, lds, TID);
}
typedef float f32x4_t __attribute__((ext_vector_type(4)));
#define GLA_PITCH 144
__device__ __forceinline__ void ph_gla_chunk(const bf16* __restrict__ P, const float* __restrict__ w_af, const float* __restrict__ b_af,
                                             const float* __restrict__ w_ab, const float* __restrict__ b_ab, float* __restrict__ OF, float* __restrict__ OB, unsigned char* lds, int unit0, int ustride) {
    const int TID = opaque_tid(), BID = opaque_bid();
    const int tid = TID, lane = tid & 63, wid = tid >> 6, l15 = lane & 15, q4 = lane >> 4;
    float* SEG = (float*)lds;
    float* DEC = (float*)(lds + 2048);
    unsigned char* QD = lds + 4096;
    unsigned char* KI = QD + 9216;
    unsigned char* KET = KI + 9216;
    unsigned char* AT = KET + 9216;
    unsigned char* VT = AT + 9216;
    (void)BID;
    for (int unit = unit0; unit >= 0 && unit < NB * 4 * 2; unit += ustride) {
        const int dir = unit & 1, h = (unit >> 1) & 3, b = unit >> 3;
        const float* wa = dir ? w_ab : w_af; const float* ba = dir ? b_ab : b_af;
        float* Od = dir ? OB : OF;
        const int d = tid & 63, seg = tid >> 6;
        float wreg[16];
#pragma unroll
        for (int j = 0; j < 16; ++j) wreg[j] = wa[j * 256 + h * 64 + d];
        const float breg = ba[h * 64 + d];
        { unsigned z_; asm volatile("v_mov_b32 %0, 0" : "=v"(z_)); for (int i = tid; i < 9216 / 16; i += NT) ((uint4*)AT)[i] = make_uint4(z_, z_, z_, z_); }
        f32x4_t S[4];
#pragma unroll
        for (int i = 0; i < 4; ++i) S[i] = (f32x4_t){0.f, 0.f, 0.f, 0.f};
        __syncthreads();
        for (int ch = 0; ch < KVLEN / 64; ++ch) {
            int rbase, rsgn;
            if (!dir) { rbase = ch < 4 ? RL + b * CTX + ch * 64 : b * SEQ + (ch - 4) * 64; rsgn = 1; }
            else { rbase = ch < 4 ? RL + b * CTX + (CTX - 1 - ch * 64) : b * SEQ + (SEQ - 1 - (ch - 4) * 64); rsgn = -1; }
            float cl[8];
            {
                float run = 0.f;
#pragma unroll
                for (int i = 0; i < 8; ++i) {
                    const bf16* pr = P + (size_t)(rbase + rsgn * (8 * seg + i)) * EVEN_LDP + 3072 + dir * 16;
                    const uint4 g0 = *(const uint4*)pr, g1 = *(const uint4*)(pr + 8);
                    const unsigned gw[8] = {g0.x, g0.y, g0.z, g0.w, g1.x, g1.y, g1.z, g1.w};
                    float z = breg;
#pragma unroll
                    for (int j = 0; j < 8; ++j) { z += __uint_as_float(gw[j] << 16) * wreg[2 * j]; z += __uint_as_float(gw[j] & 0xffff0000u) * wreg[2 * j + 1]; }
                    run += log_sigmoid_f(z) * (1.f / 16.f);
                    cl[i] = run;
                }
                SEG[seg * 64 + d] = run;
            }
            __syncthreads();
            {
                float prefix = 0.f, total = 0.f;
#pragma unroll
                for (int s2 = 0; s2 < 8; ++s2) { const float v = SEG[s2 * 64 + d]; total += v; prefix += (s2 < seg) ? v : 0.f; }
                if (seg == 0) DEC[d] = __expf(total);
                unsigned kew[4];
#pragma unroll
                for (int i = 0; i < 8; ++i) {
                    const int c = 8 * seg + i;
                    const bf16* pr = P + (size_t)(rbase + rsgn * c) * EVEN_LDP;
                    const float qv = bf2f(pr[1536 + h * 64 + d]) * 0.125f, kv = bf2f(pr[1792 + h * 64 + d]);
                    const float cum = prefix + cl[i];
                    const float e = __expf(cum), ei = __expf(-cum), ee = __expf(total - cum);
                    *(bf16*)(QD + c * GLA_PITCH + d * 2) = (bf16)f2bf(qv * e);
                    *(bf16*)(KI + c * GLA_PITCH + d * 2) = (bf16)f2bf(kv * ei);
                    const unsigned kb = f2bf(kv * ee);
                    if (i & 1) kew[i >> 1] |= kb << 16; else kew[i >> 1] = kb;
                }
                *(uint4*)(KET + d * GLA_PITCH + seg * 16) = make_uint4(kew[0], kew[1], kew[2], kew[3]);
                const int v = tid & 127, cg = tid >> 7;
                unsigned vw[8];
#pragma unroll
                for (int i = 0; i < 16; ++i) {
                    const unsigned x = P[(size_t)(rbase + rsgn * (16 * cg + i)) * EVEN_LDP + 2048 + h * 128 + v];
                    if (i & 1) vw[i >> 1] |= x << 16; else vw[i >> 1] = x;
                }
                *(uint4*)(VT + v * GLA_PITCH + cg * 32) = make_uint4(vw[0], vw[1], vw[2], vw[3]);
                *(uint4*)(VT + v * GLA_PITCH + cg * 32 + 16) = make_uint4(vw[4], vw[5], vw[6], vw[7]);
            }
            __syncthreads();
            for (int blk = wid; blk < 10; blk += NWV) {
                int sblk, cblk;
                if (blk < 4) { sblk = 0; cblk = blk; } else if (blk < 7) { sblk = 1; cblk = blk - 3; } else if (blk < 9) { sblk = 2; cblk = blk - 5; } else { sblk = 3; cblk = 3; }
                f32x4_t acc = (f32x4_t){0.f, 0.f, 0.f, 0.f};
#pragma unroll
                for (int kk = 0; kk < 2; ++kk) {
                    const bf16x8 a = *(const bf16x8*)(KI + (16 * sblk + l15) * GLA_PITCH + 64 * kk + 16 * q4);
                    const bf16x8 bq = *(const bf16x8*)(QD + (16 * cblk + l15) * GLA_PITCH + 64 * kk + 16 * q4);
                    acc = __builtin_amdgcn_mfma_f32_16x16x32_bf16(a, bq, acc, 0, 0, 0);
                }
                const int c = 16 * cblk + l15, s0 = 16 * sblk + 4 * q4;
                float av[4];
#pragma unroll
                for (int r = 0; r < 4; ++r) av[r] = (s0 + r <= c) ? acc[r] : 0.f;
                *(uint2*)(AT + c * GLA_PITCH + s0 * 2) = make_uint2(pk2(av[0], av[1]), pk2(av[2], av[3]));
            }
            __syncthreads();
            {
                const int v0 = 16 * wid;
                bf16x8 bv[2], sB[2];
#pragma unroll
                for (int kk = 0; kk < 2; ++kk) {
                    bv[kk] = *(const bf16x8*)(VT + (v0 + l15) * GLA_PITCH + 64 * kk + 16 * q4);
                    uint4 w = make_uint4(pk2(S[2 * kk][0], S[2 * kk][1]), pk2(S[2 * kk][2], S[2 * kk][3]), pk2(S[2 * kk + 1][0], S[2 * kk + 1][1]), pk2(S[2 * kk + 1][2], S[2 * kk + 1][3]));
                    sB[kk] = __builtin_bit_cast(bf16x8, w);
                }
#pragma unroll
                for (int cblk = 0; cblk < 4; ++cblk) {
                    f32x4_t acc = (f32x4_t){0.f, 0.f, 0.f, 0.f};
                    const unsigned char* arow = AT + (16 * cblk + l15) * GLA_PITCH;
                    const unsigned char* qrow = QD + (16 * cblk + l15) * GLA_PITCH;
#pragma unroll
                    for (int kk = 0; kk < 2; ++kk) {
                        if (kk == 0 || cblk >= 2) {
                            const bf16x8 a = *(const bf16x8*)(arow + 64 * kk + 16 * q4);
                            acc = __builtin_amdgcn_mfma_f32_16x16x32_bf16(a, bv[kk], acc, 0, 0, 0);
                        }
                    }
#pragma unroll
                    for (int kk = 0; kk < 2; ++kk) {
                        const uint2 a0 = *(const uint2*)(qrow + 64 * kk + 8 * q4), a1 = *(const uint2*)(qrow + 64 * kk + 32 + 8 * q4);
                        uint4 aw = make_uint4(a0.x, a0.y, a1.x, a1.y);
                        acc = __builtin_amdgcn_mfma_f32_16x16x32_bf16(__builtin_bit_cast(bf16x8, aw), sB[kk], acc, 0, 0, 0);
                    }
#pragma unroll
                    for (int r = 0; r < 4; ++r) Od[(size_t)(rbase + rsgn * (16 * cblk + 4 * q4 + r)) * 512 + h * 128 + v0 + l15] = acc[r];
                }
#pragma unroll
                for (int dblk = 0; dblk < 4; ++dblk) {
#pragma unroll
                    for (int r = 0; r < 4; ++r) S[dblk][r] *= DEC[16 * dblk + 4 * q4 + r];
#pragma unroll
                    for (int kk = 0; kk < 2; ++kk) {
                        const bf16x8 a = *(const bf16x8*)(KET + (16 * dblk + l15) * GLA_PITCH + 64 * kk + 16 * q4);
                        S[dblk] = __builtin_amdgcn_mfma_f32_16x16x32_bf16(a, bv[kk], S[dblk], 0, 0, 0);
                    }
                }
            }
            __syncthreads();
        }
    }
}
__device__ __forceinline__ void ph_even_post(bf16* __restrict__ ATT, const float* __restrict__ lamv, const float* __restrict__ subln, float lam_init,
                             const float* __restrict__ OF, const float* __restrict__ OB, const bf16* __restrict__ P, const float* __restrict__ gain) {
    const int TID = opaque_tid(), BID = opaque_bid();
    int wave = BID * NWV + (TID >> 6), lane = TID & 63;
    int nw = gridDim.x * NWV;
    float p1 = lamv[lane] * lamv[64 + lane], p2 = lamv[128 + lane] * lamv[192 + lane];
    p1 = wave_sum(p1); p2 = wave_sum(p2);
    const float lam = expf(p1) - expf(p2) + lam_init;
    for (int r = wave; r < RT; r += nw) {
        bf16* a = ATT + (size_t)r * DM;
        float d[4][2];
#pragma unroll
        for (int h = 0; h < 4; ++h) {
            float2 o0 = ld2bf(a + (2 * h) * 128 + lane * 2);
            float2 o1 = ld2bf(a + (2 * h + 1) * 128 + lane * 2);
            d[h][0] = o0.x - lam * o1.x; d[h][1] = o0.y - lam * o1.y;
        }
        float2 outd[4];
#pragma unroll
        for (int h = 0; h < 4; ++h) {
            float s = wave_sum(d[h][0] * d[h][0] + d[h][1] * d[h][1]);
            float rstd = rsqrtf(s * (1.f / 128.f) + 1e-6f) * (1.f - lam_init);
            float2 sg = *(const float2*)(subln + lane * 2);
            outd[h] = make_float2(d[h][0] * rstd * sg.x, d[h][1] * rstd * sg.y);
        }
        float2 outg[4];
#pragma unroll
        for (int h = 0; h < 4; ++h) {
            float2 x = *(const float2*)(OF + (size_t)r * 512 + h * 128 + lane * 2);
            float2 c = *(const float2*)(OB + (size_t)r * 512 + h * 128 + lane * 2);
            float o0 = x.x + c.x, o1 = x.y + c.y;
            float s = wave_sum(o0 * o0 + o1 * o1);
            float rstd = rsqrtf(s * (1.f / 128.f) + 1e-6f);
            float2 g = *(const float2*)(gain + lane * 2);
            float2 rr = ld2bf(P + (size_t)r * EVEN_LDP + 2560 + h * 128 + lane * 2);
            outg[h] = make_float2(o0 * rstd * g.x * silu_f(rr.x), o1 * rstd * g.y * silu_f(rr.y));
        }
#pragma unroll
        for (int h = 0; h < 4; ++h) {
            st2bf(a + h * 128 + lane * 2, outd[h]);
            st2bf(a + 512 + h * 128 + lane * 2, outg[h]);
        }
    }
}
#define INS16(tv, ti, v, n) do { \
    _Pragma("unroll") for (int j_ = 15; j_ >= 1; --j_) { bool c1_ = (v) > tv[j_ - 1]; bool c2_ = (v) > tv[j_]; \
        tv[j_] = c1_ ? tv[j_ - 1] : (c2_ ? (v) : tv[j_]); ti[j_] = c1_ ? ti[j_ - 1] : (c2_ ? (n) : ti[j_]); } \
    { bool c_ = (v) > tv[0]; tv[0] = c_ ? (v) : tv[0]; ti[0] = c_ ? (n) : ti[0]; } } while (0)

__device__ __forceinline__ void ph_peer_ffn(const bf16* __restrict__ A2, const int* __restrict__ IDX, const float* __restrict__ GATE,
                            const float* __restrict__ U, const float* __restrict__ V, const float* __restrict__ mods_l, float* __restrict__ X) {
    const int TID = opaque_tid(), BID = opaque_bid();
    int wave = BID * NWV + (TID >> 6), lane = TID & 63;
    int nw = gridDim.x * NWV;
    for (int r = wave; r < RT; r += nw) {
        float4 xa[4], acc[4];
#pragma unroll
        for (int i = 0; i < 4; ++i) { xa[i] = ld4bf(A2 + (size_t)r * DM + 4 * (lane + 64 * i)); acc[i] = make_float4(0.f, 0.f, 0.f, 0.f); }
        for (int e = 0; e < 128; ++e) {
            int id = IDX[(size_t)r * 128 + e]; float g = GATE[(size_t)r * 128 + e];
            const float4* ur = (const float4*)(U + (size_t)id * DM);
            float d = 0.f;
#pragma unroll
            for (int i = 0; i < 4; ++i) { float4 u = ur[lane + 64 * i]; d += u.x * xa[i].x + u.y * xa[i].y + u.z * xa[i].z + u.w * xa[i].w; }
            d = wave_sum(d);
            float w = g * gelu_tanh(d);
            const float4* vr = (const float4*)(V + (size_t)id * DM);
#pragma unroll
            for (int i = 0; i < 4; ++i) { float4 v = vr[lane + 64 * i]; acc[i].x += w * v.x; acc[i].y += w * v.y; acc[i].z += w * v.z; acc[i].w += w * v.w; }
        }
        const float4* g5 = (const float4*)(mods_l + (size_t)row_mod(r) * MODW + 5 * DM);
        float4* xr = (float4*)(X + (size_t)r * DM);
#pragma unroll
        for (int i = 0; i < 4; ++i) { float4 x = xr[lane + 64 * i], gg = g5[lane + 64 * i];
            x.x += gg.x * acc[i].x; x.y += gg.y * acc[i].y; x.z += gg.z * acc[i].z; x.w += gg.w * acc[i].w; xr[lane + 64 * i] = x; }
    }
}
#define RT_KPITCH 144
#define INSP16(t, x) do { unsigned x_ = (x); _Pragma("unroll") for (int j_ = 0; j_ < 16; ++j_) { const unsigned h_ = max(t[j_], x_); x_ = min(t[j_], x_); t[j_] = h_; } } while (0)
__device__ __forceinline__ void ph_route_mfma(const bf16* __restrict__ Qp, const bf16* __restrict__ Kb, int* __restrict__ IDX, float* __restrict__ GATE, unsigned char* lds, int nrows) {
    const int TID = opaque_tid(), BID = opaque_bid();
    const int tid = TID, lane = tid & 63, wid = tid >> 6, r32 = lane & 31, hi = lane >> 5;
    for (int u = BID; u < (nrows / 256) * 8; u += gridDim.x) {
        const int h = u & 7, row = (u >> 3) * 256 + wid * 32 + r32;
        __syncthreads();
        for (int i = tid; i < 2 * 128 * 8; i += NT) *(uint4*)(lds + (i >> 3) * RT_KPITCH + (i & 7) * 16) = *(const uint4*)(Kb + ((size_t)h * 256 + (i >> 3)) * 64 + (i & 7) * 8);
        __syncthreads();
        unsigned L[2][16];
#pragma unroll
        for (int half = 0; half < 2; ++half) {
            bf16x8 qf[4];
            const bf16* qrow = Qp + (size_t)row * DM + h * 128 + half * 64;
#pragma unroll
            for (int s = 0; s < 4; ++s) qf[s] = *(const bf16x8*)(qrow + 16 * s + 8 * hi);
#pragma unroll
            for (int j = 0; j < 16; ++j) L[half][j] = 0u;
#pragma unroll
            for (int nb = 0; nb < 4; ++nb) {
                f32x16 acc;
#pragma unroll
                for (int r = 0; r < 16; ++r) acc[r] = 0.f;
#pragma unroll
                for (int s = 0; s < 4; ++s) {
                    const bf16x8 a = *(const bf16x8*)(lds + (half * 128 + 32 * nb + r32) * RT_KPITCH + 32 * s + 16 * hi);
                    acc = __builtin_amdgcn_mfma_f32_32x32x16_bf16(a, qf[s], acc, 0, 0, 0);
                }
#pragma unroll
                for (int r = 0; r < 16; ++r) {
                    unsigned ub = __float_as_uint(acc[r]);
                    ub = (ub & 0x80000000u) ? ~ub : (ub | 0x80000000u);
                    const unsigned x = (ub & ~127u) | (unsigned)(127 - (32 * nb + (r & 3) + 8 * (r >> 2)) - 4 * hi);
                    INSP16(L[half], x);
                }
                __builtin_amdgcn_sched_barrier(0);
            }
            unsigned o[16];
#pragma unroll
            for (int j = 0; j < 16; ++j) o[j] = __shfl_xor(L[half][j], 32);
#pragma unroll
            for (int j = 0; j < 16; ++j) INSP16(L[half], o[j]);
            __builtin_amdgcn_sched_barrier(0);
        }
        float v1[16], v2[16];
        {
            unsigned w1[4] = {0u, 0u, 0u, 0u}, w2[4] = {0u, 0u, 0u, 0u};
#pragma unroll
            for (int j = 0; j < 16; ++j) {
                unsigned a = L[0][j] & ~127u, b = L[1][j] & ~127u;
                a = (a & 0x80000000u) ? (a & 0x7fffffffu) : ~a; b = (b & 0x80000000u) ? (b & 0x7fffffffu) : ~b;
                v1[j] = __uint_as_float(a); v2[j] = __uint_as_float(b);
                w1[j >> 2] |= (127u - (L[0][j] & 127u)) << (8 * (j & 3)); w2[j >> 2] |= (127u - (L[1][j] & 127u)) << (8 * (j & 3));
            }
            unsigned char* sb = lds + 2 * 128 * RT_KPITCH + tid * 4;
#pragma unroll
            for (int k = 0; k < 4; ++k) { *(unsigned*)(sb + k * 2048) = w1[k]; *(unsigned*)(sb + (4 + k) * 2048) = w2[k]; }
        }
        unsigned T[16];
#pragma unroll
        for (int j = 0; j < 16; ++j) T[j] = 0u;
#pragma unroll
        for (int a = 0; a < 16; ++a)
#pragma unroll
            for (int b = 0; b < 16; ++b) {
                if ((a + 1) * (b + 1) <= 16) {
                    unsigned ub = __float_as_uint(v1[a] + v2[b]);
                    ub = (ub & 0x80000000u) ? ~ub : (ub | 0x80000000u);
                    const unsigned x = (ub & ~255u) | (unsigned)(255 - (16 * a + b));
                    INSP16(T, x);
                }
            }
        float e[16]; int bi[16]; float sum = 0.f, v0 = 0.f;
        {
            const unsigned char* sb = lds + 2 * 128 * RT_KPITCH + tid * 4;
#pragma unroll
            for (int j = 0; j < 16; ++j) {
                unsigned ub = T[j] & ~255u;
                ub = (ub & 0x80000000u) ? (ub & 0x7fffffffu) : ~ub;
                const float val = __uint_as_float(ub);
                if (j == 0) v0 = val;
                e[j] = __expf(val - v0); sum += e[j];
                const unsigned flat = 255u - (T[j] & 255u), ca = flat >> 4, cb = flat & 15u;
                const unsigned ia = *(const unsigned char*)(sb + (ca >> 2) * 2048 + (ca & 3)), ib = *(const unsigned char*)(sb + (4 + (cb >> 2)) * 2048 + (cb & 3));
                bi[j] = (int)(ia * 128u + ib);
            }
        }
        const float inv = 1.f / sum;
        if (hi == 0) {
            int* ip = IDX + (size_t)row * 128 + h * 16; float* gp = GATE + (size_t)row * 128 + h * 16;
#pragma unroll
            for (int j = 0; j < 4; ++j) {
                *(int4*)(ip + 4 * j) = make_int4(bi[4 * j], bi[4 * j + 1], bi[4 * j + 2], bi[4 * j + 3]);
                *(float4*)(gp + 4 * j) = make_float4(e[4 * j] * inv, e[4 * j + 1] * inv, e[4 * j + 2] * inv, e[4 * j + 3] * inv);
            }
        }
    }
    __syncthreads();
}
__device__ __forceinline__ unsigned fp6_e2m3(float v) {
    const float a = fabsf(v);
    float c;
    if (a < 2.f) c = rintf(a * 8.f);
    else if (a < 4.f) c = 16.f + rintf((a - 2.f) * 4.f);
    else c = fminf(24.f + rintf((a - 4.f) * 2.f), 31.f);
    return (unsigned)c | (v < 0.f ? 32u : 0u);
}
__device__ __forceinline__ void ph_table_prep(const float* __restrict__ U, const float* __restrict__ V, unsigned char* __restrict__ T6, float* __restrict__ RS) {
    const int TID = opaque_tid(), BID = opaque_bid();
    const int wave = BID * NWV + (TID >> 6), lane = TID & 63, nw = gridDim.x * NWV;
    const int NROWS = DEPTH * 16384;
    for (int rr = wave; rr < 2 * NROWS; rr += nw) {
        const float* src = (rr < NROWS ? U : V) + (size_t)(rr < NROWS ? rr : rr - NROWS) * DM + lane * 16;
        float4 v[4]; float am = 0.f;
#pragma unroll
        for (int i = 0; i < 4; ++i) { v[i] = ((const float4*)src)[i]; am = fmaxf(am, fmaxf(fmaxf(fabsf(v[i].x), fabsf(v[i].y)), fmaxf(fabsf(v[i].z), fabsf(v[i].w)))); }
#pragma unroll
        for (int o = 1; o < 64; o <<= 1) am = fmaxf(am, __shfl_xor(am, o));
        am = fmaxf(am, 1e-30f);
        const float sc = exp2f(floorf(log2f(7.5f / am)));
        unsigned e[16];
#pragma unroll
        for (int i = 0; i < 4; ++i) { e[4 * i] = fp6_e2m3(v[i].x * sc); e[4 * i + 1] = fp6_e2m3(v[i].y * sc); e[4 * i + 2] = fp6_e2m3(v[i].z * sc); e[4 * i + 3] = fp6_e2m3(v[i].w * sc); }
        const unsigned d0 = e[0] | (e[1] << 6) | (e[2] << 12) | (e[3] << 18) | (e[4] << 24) | (e[5] << 30);
        const unsigned d1 = (e[5] >> 2) | (e[6] << 4) | (e[7] << 10) | (e[8] << 16) | (e[9] << 22) | (e[10] << 28);
        const unsigned d2 = (e[10] >> 4) | (e[11] << 2) | (e[12] << 8) | (e[13] << 14) | (e[14] << 20) | (e[15] << 26);
        unsigned* dst = (unsigned*)(T6 + (size_t)rr * 768 + lane * 12);
        dst[0] = d0; dst[1] = d1; dst[2] = d2;
        if (lane == 0) RS[rr] = 1.f / sc;
    }
}
typedef unsigned v6u32_t __attribute__((ext_vector_type(6)));
typedef float v32f_t __attribute__((ext_vector_type(32)));
typedef __bf16 v32bf_t __attribute__((ext_vector_type(32)));
typedef unsigned v16u_t __attribute__((ext_vector_type(16)));
struct u3 { unsigned x, y, z; };
#define BR4(j) ((((j) & 1) << 3) | (((j) & 2) << 1) | (((j) & 4) >> 1) | (((j) & 8) >> 3))
__device__ __forceinline__ void ph_peer_ffn8(const bf16* A2, const int* __restrict__ IDX, const float* __restrict__ GATE,
                            const unsigned char* __restrict__ U8, const float* __restrict__ RSU, const unsigned char* __restrict__ V8, const float* __restrict__ RSV,
                            const float* __restrict__ mods_l, const float* X, float* Xout, int nrows,
                            const float* __restrict__ gnext, const float* __restrict__ mods_next, bf16* Anext) {
    const int TID = opaque_tid(), BID = opaque_bid();
    const int wave = BID * NWV + (TID >> 6), lane = TID & 63, nw = gridDim.x * NWV;
    const int jl = BR4(lane & 15);
    const unsigned lane12 = (unsigned)lane * 12u;
    for (int r = wave; r < nrows; r += nw) {
        float xf[16];
        { int lx = lane; asm volatile("" : "+v"(lx)); const uint4* xp = (const uint4*)(A2 + (size_t)r * DM + lx * 16); const uint4 a = xp[0], b = xp[1]; const unsigned xw[8] = {a.x, a.y, a.z, a.w, b.x, b.y, b.z, b.w};
#pragma unroll
          for (int i = 0; i < 8; ++i) { xf[2 * i] = __uint_as_float(xw[i] << 16); xf[2 * i + 1] = __uint_as_float(xw[i] & 0xffff0000u); } }
        float acc[16];
#pragma unroll
        for (int k = 0; k < 16; ++k) acc[k] = 0.f;
        for (int g = 0; g < 8; ++g) {
            const int myid = IDX[(size_t)r * 128 + g * 16 + jl];
            u3 ub[16], vb[16];
#pragma unroll
            for (int j = 0; j < 16; ++j) { unsigned idv; asm volatile("v_mov_b32 %0, %1" : "=v"(idv) : "s"(__builtin_amdgcn_readlane(myid, BR4(j)))); ub[j] = *(const u3*)(U8 + (idv * 768u + lane12)); }
#pragma unroll
            for (int j = 0; j < 16; ++j) { unsigned idv; asm volatile("v_mov_b32 %0, %1" : "=v"(idv) : "s"(__builtin_amdgcn_readlane(myid, BR4(j)))); vb[j] = *(const u3*)(V8 + (idv * 768u + lane12)); }
            float d[16];
#pragma unroll
            for (int j = 0; j < 16; j += 2) {
                const v6u32_t src = {ub[j].x, ub[j].y, ub[j].z, ub[j + 1].x, ub[j + 1].y, ub[j + 1].z};
                const v32f_t f = __builtin_amdgcn_cvt_scalef32_pk32_f32_fp6(src, 1.0f);
                float d0 = 0.f, d1 = 0.f;
#pragma unroll
                for (int k = 0; k < 16; ++k) { d0 = __builtin_fmaf(f[k], xf[k], d0); d1 = __builtin_fmaf(f[16 + k], xf[k], d1); }
                d[j] = d0; d[j + 1] = d1;
                __builtin_amdgcn_sched_barrier(0);
            }
#pragma unroll
            for (int st = 0; st < 4; ++st) {
                const int n = 8 >> st, bit = 1 << st;
                const bool up = (lane & bit) != 0;
#pragma unroll
                for (int i = 0; i < 8; ++i) if (i < n) {
                    const float send = up ? d[i] : d[i + n], keep = up ? d[i + n] : d[i];
                    d[i] = keep + __shfl_xor(send, bit);
                }
            }
            float tot = d[0];
            tot += __shfl_xor(tot, 16); tot += __shfl_xor(tot, 32);
            const float w = GATE[(size_t)r * 128 + g * 16 + jl] * gelu_tanh(tot * RSU[myid]) * RSV[myid];
#pragma unroll
            for (int j = 0; j < 16; j += 2) {
                const float w0 = __int_as_float(__builtin_amdgcn_readlane(__float_as_int(w), BR4(j))), w1 = __int_as_float(__builtin_amdgcn_readlane(__float_as_int(w), BR4(j + 1)));
                const v6u32_t src = {vb[j].x, vb[j].y, vb[j].z, vb[j + 1].x, vb[j + 1].y, vb[j + 1].z};
                const v32f_t f = __builtin_amdgcn_cvt_scalef32_pk32_f32_fp6(src, 1.0f);
#pragma unroll
                for (int k = 0; k < 16; ++k) { acc[k] = __builtin_fmaf(w0, f[k], acc[k]); acc[k] = __builtin_fmaf(w1, f[16 + k], acc[k]); }
                __builtin_amdgcn_sched_barrier(0);
            }
        }
        int re = __builtin_amdgcn_readfirstlane(r); asm volatile("" : "+s"(re)); int le = lane; asm volatile("" : "+v"(le));
        const float4* g5 = (const float4*)(mods_l + (size_t)row_mod(re) * MODW + 5 * DM + le * 16);
        const float4* xr = (const float4*)(X + (size_t)re * DM + le * 16);
        float4 xn[4]; float ss = 0.f;
#pragma unroll
        for (int i = 0; i < 4; ++i) { float4 xv = xr[i], gg = g5[i];
            xv.x += gg.x * acc[4 * i]; xv.y += gg.y * acc[4 * i + 1]; xv.z += gg.z * acc[4 * i + 2]; xv.w += gg.w * acc[4 * i + 3]; xn[i] = xv;
            ss += xv.x * xv.x + xv.y * xv.y + xv.z * xv.z + xv.w * xv.w; }
        float4* xo = (float4*)(Xout + (size_t)re * DM + le * 16);
#pragma unroll
        for (int i = 0; i < 4; ++i) xo[i] = xn[i];
        if (gnext) {
            const float rstd = rsqrtf(wave_sum(ss) * (1.f / DM) + 1e-6f);
            const float* mn = mods_next + (size_t)row_mod(re) * MODW + le * 16;
            bf16* ar = Anext + (size_t)re * DM + le * 16;
#pragma unroll
            for (int i = 0; i < 4; ++i) {
                const float4 gg = ((const float4*)(gnext + le * 16))[i], sh = ((const float4*)mn)[i], sc = ((const float4*)(mn + DM))[i];
                float4 o;
                o.x = xn[i].x * rstd * gg.x * (1.f + sc.x) + sh.x; o.y = xn[i].y * rstd * gg.y * (1.f + sc.y) + sh.y;
                o.z = xn[i].z * rstd * gg.z * (1.f + sc.z) + sh.z; o.w = xn[i].w * rstd * gg.w * (1.f + sc.w) + sh.w;
                st4bf(ar + 4 * i, o);
            }
        }
    }
}
template <int N>
__device__ __forceinline__ void ph_gemm_bf16(const bf16* A, const bf16* Bt, bf16* O, unsigned char* lds) {
    pg8::Gemm g{A, Bt, RT, N, DM}; pg8::StaticOrder S; S.init(RT, N, (int)gridDim.x, opaque_bid());
    pg8::EpiBf16<0> E{O, N, nullptr, 0, 0, 1.f};
    pg8::gemm_phase<pg8::EpiBf16<0>, pg8::StaticOrder, true, true>((PG8_LAS unsigned char*)lds, g, S, E);
}
__device__ __forceinline__ void ph_gemm_res(const bf16* A, const bf16* Bt, float* X, const float* gate, unsigned char* lds) {
    pg8::Gemm g{A, Bt, RT, DM, DM}; pg8::StaticOrder S; S.init(RT, DM, (int)gridDim.x, opaque_bid());
    EpiResGate E{X, gate};
    pg8::gemm_phase<EpiResGate, pg8::StaticOrder, true, true>((PG8_LAS unsigned char*)lds, g, S, E);
}

#define XB_TMO      128
#define XB_XCNT(j)  (256  + 64 * (j))
#define XB_XSUB(j)  (1280 + 64 * (j))
#define XB_XGEN(j)  (2304 + 64 * (j))
#define XB_TOP      3328
#define XB_TOPGEN   3392
#define XCD_BAR_WORDS 3456
#define XB_SPIN_CAP (1u << 18)

__device__ __forceinline__ unsigned xb_ld(unsigned* p)              { return __hip_atomic_load(p, __ATOMIC_RELAXED, __HIP_MEMORY_SCOPE_AGENT); }
__device__ __forceinline__ unsigned xb_add(unsigned* p, unsigned v) { return __hip_atomic_fetch_add(p, v, __ATOMIC_RELAXED, __HIP_MEMORY_SCOPE_AGENT); }
__device__ __forceinline__ unsigned xb_xcc_id() { return (unsigned)__builtin_amdgcn_s_getreg((3 << 11) | 20) & 0xFu; }
#define XB_SPIN(cond, bar) do { unsigned _sp = 0; while (cond) { __builtin_amdgcn_s_sleep(1); \
    if ((++_sp & 255u) == 0u) { if (xb_ld(&(bar)[XB_TMO])) break; if (_sp > XB_SPIN_CAP) { atomicAdd(&(bar)[XB_TMO], 1u); break; } } } } while (0)

struct XcdBarrier {
    unsigned* bar; unsigned x;
    volatile LAS unsigned* st;
};

__device__ __forceinline__ XcdBarrier xcd_barrier_post(unsigned* bar, volatile LAS unsigned* st) {
    XcdBarrier b; b.bar = bar; b.x = xb_xcc_id(); b.st = st;
    if (threadIdx.x == 0) (void)xb_add(&bar[XB_XCNT(b.x)], 1u);
    return b;
}
__device__ __forceinline__ void xcd_barrier_complete(unsigned* bar, unsigned x, unsigned& nloc, unsigned& nx) {
    const unsigned G = gridDim.x * gridDim.y * gridDim.z;
    unsigned sum, cnt, mine, sp = 0u;
    for (;;) {
        sum = 0u; cnt = 0u; mine = 0u;
#pragma unroll
        for (unsigned j = 0; j < 16; ++j) { const unsigned c = xb_ld(&bar[XB_XCNT(j)]); sum += c; cnt += (c > 0u) ? 1u : 0u; mine = (j == x) ? c : mine; }
        if (sum == G) break;
        __builtin_amdgcn_s_sleep(1);
        if ((++sp & 255u) == 0u) { if (xb_ld(&bar[XB_TMO])) break; if (sp > XB_SPIN_CAP) { atomicAdd(&bar[XB_TMO], 1u); break; } }
    }
    nloc = mine > 0u ? mine : 1u; nx = cnt > 0u ? cnt : 1u;
}

__device__ __forceinline__ void xcd_barrier(const XcdBarrier& b) {
    asm volatile("s_waitcnt vmcnt(0)" ::: "memory");
    __syncthreads();
    if (threadIdx.x == 0) {
        unsigned* bar = b.bar;
        __builtin_amdgcn_s_waitcnt(0);
        unsigned nloc = b.st[0], nx = b.st[1];
        if (nloc == 0u) { xcd_barrier_complete(bar, b.x, nloc, nx); b.st[0] = nloc; b.st[1] = nx; }
        const unsigned old = xb_add(&bar[XB_XSUB(b.x)], 1u);
        const unsigned gen = old / nloc;
        if (old + 1u == (gen + 1u) * nloc) {
            __builtin_amdgcn_fence(__ATOMIC_RELEASE, "agent");
            asm volatile("s_waitcnt vmcnt(0)" ::: "memory");
            const unsigned og = xb_add(&bar[XB_TOP], 1u);
            const unsigned tg = og / nx;
            if (og + 1u == (tg + 1u) * nx) xb_add(&bar[XB_TOPGEN], 1u);
            else XB_SPIN(xb_ld(&bar[XB_TOPGEN]) == tg, bar);
            __builtin_amdgcn_fence(__ATOMIC_ACQUIRE, "agent");
            xb_add(&bar[XB_XGEN(b.x)], 1u);
            asm volatile("s_waitcnt vmcnt(0)" ::: "memory");
        } else {
            XB_SPIN(xb_ld(&bar[XB_XGEN(b.x)]) == gen, bar);
            __builtin_amdgcn_fence(__ATOMIC_ACQUIRE, "agent");
            asm volatile("s_waitcnt vmcnt(0)" ::: "memory");
        }
    }
    __syncthreads();
}

constexpr size_t ALIGN_UP(size_t x) { return (x + 255) & ~(size_t)255; }
constexpr size_t WS_X = 0;
constexpr size_t WS_A = WS_X + (size_t)RT * DM * 4;
constexpr size_t WS_P = WS_A + (size_t)RT * DM * 2;
constexpr size_t WS_ATT = WS_P + (size_t)RT * EVEN_LDP * 2;
constexpr size_t WS_OF = WS_ATT + (size_t)RT * DM * 2;
constexpr size_t WS_MODS = WS_OF + (size_t)RT * 512 * 4 * 2;
constexpr size_t WS_ROPE = WS_MODS + ALIGN_UP((size_t)DEPTH * NMOD * MODW * 4);
constexpr size_t WS_WINE = WS_ROPE + (size_t)SEQ * 32 * 8;
constexpr size_t WS_WOUTE = WS_WINE + (size_t)2 * EVEN_LDP * DM * 2;
constexpr size_t WS_WINO = WS_WOUTE + (size_t)2 * DM * DM * 2;
constexpr size_t WS_WOUTO = WS_WINO + (size_t)2 * ODD_IN * DM * 2;
constexpr size_t WS_WPQ = WS_WOUTO + (size_t)2 * DM * DM * 2;
constexpr size_t WS_T8 = WS_WPQ + (size_t)4 * DM * DM * 2;
constexpr size_t WS_RS = WS_T8 + (size_t)2 * DEPTH * 16384 * DM;
constexpr size_t WS_KC = WS_RS + (size_t)2 * DEPTH * 16384 * 4;
constexpr size_t WS_VT = WS_KC + (size_t)NB * 8 * KVLEN * 64 * 2;
constexpr size_t WS_KEYS = WS_VT + (size_t)NB * 4 * 128 * KVLEN * 2;
constexpr size_t WS_BAR = WS_KEYS + (size_t)DEPTH * 8 * 2 * 128 * 64 * 2;
constexpr size_t WS_BAR_BYTES = 16384;
constexpr size_t WS_END = WS_BAR + WS_BAR_BYTES;

__global__ void __launch_bounds__(NT, 2) mega(Params p) {
    extern __shared__ __attribute__((aligned(16))) unsigned char lds[];
    float* smem = (float*)lds;
    cg::grid_group grid = cg::this_grid();
    unsigned char* ws = p.ws;
    volatile LAS unsigned* bst = (volatile LAS unsigned*)((LAS unsigned char*)lds + 131072 + 512);
    if (threadIdx.x < 2) bst[threadIdx.x] = 0u;
    __syncthreads();
    (void)xcd_barrier_post((unsigned*)(ws + WS_BAR), bst);
#define GSYNC() do { XcdBarrier b_; b_.bar = (unsigned*)(ws + WS_BAR); b_.x = xb_xcc_id(); b_.st = (volatile LAS unsigned*)((LAS unsigned char*)lds + 131072 + 512); xcd_barrier(b_); } while (0)
#define X_ ((float*)(ws + WS_X))
#define A_ ((bf16*)(ws + WS_A))
#define P_ ((bf16*)(ws + WS_P))
#define ATT_ ((bf16*)(ws + WS_ATT))
#define OF_ ((float*)(ws + WS_OF))
#define OB_ (OF_ + (size_t)RT * 512)
#define MODS_ ((float*)(ws + WS_MODS))
#define ROPE_ ((float2*)(ws + WS_ROPE))
#define WINE_ ((bf16*)(ws + WS_WINE))
#define WOUTE_ ((bf16*)(ws + WS_WOUTE))
#define WINO_ ((bf16*)(ws + WS_WINO))
#define WOUTO_ ((bf16*)(ws + WS_WOUTO))
#define WPQ_ ((bf16*)(ws + WS_WPQ))
#define QP_ P_
#define KEYS_ ((bf16*)(ws + WS_KEYS))
#define KC_ ((bf16*)(ws + WS_KC))
#define VT_ ((bf16*)(ws + WS_VT))
#define T8_ (ws + WS_T8)
#define RS_ ((float*)(ws + WS_RS))
#define IDX_ ((int*)(ws + WS_P + (size_t)RT * DM * 2))
#define GATE_ ((float*)(ws + WS_P + (size_t)RT * DM * 2 + (size_t)RT * 128 * 4))

    ph_copy_in(p.in[0], p.in[2], X_);
    ph_rope_table(ROPE_);
    ph_weight_prep(p.in, WINE_, WOUTE_, WINO_, WOUTO_, WPQ_, KEYS_, lds);
    ph_table_prep(p.in[25], p.in[26], T8_, RS_);
    __syncthreads();
    ph_mods(p.in[1], p.in[3], p.in[4], p.in[5], MODS_, smem);
    grid.sync();
    ph_norm_mod(X_, p.in[6], MODS_, 0, A_);
    GSYNC();
    for (int hl = 0; hl < 2 * DEPTH; ++hl) {
        ws = p.ws; asm volatile("" : "+s"(ws));
        const int l = hl >> 1, part = hl & 1, i = l >> 1, odd = l & 1;
        const float* mods_l = MODS_ + (size_t)l * NMOD * MODW;
        if (part) {
            ph_norm_mod(X_, p.in[7] + l * DM, mods_l, 3, A_);
            GSYNC();
        }
        if (part) ph_gemm_bf16<DM>(A_, WPQ_ + (size_t)l * DM * DM, P_, lds);
        else if (odd) ph_gemm_bf16<ODD_IN>(A_, WINO_ + (size_t)i * ODD_IN * DM, P_, lds);
        else ph_gemm_bf16<EVEN_LDP>(A_, WINE_ + (size_t)i * EVEN_LDP * DM, P_, lds);
        GSYNC();
        if (part == 0) {
            const int ldp = odd ? ODD_IN : EVEN_LDP;
            ph_post(P_, ldp, odd ? 16 : 8, odd ? 1024 : 512, odd ? 4 : 8, odd ? 1280 : 1024, odd ? 256 : 512, odd ? 64 : 128,
                    (odd ? p.in[21] : p.in[10]) + i * 64, (odd ? p.in[22] : p.in[11]) + i * 64, ROPE_, KC_, VT_);
            GSYNC();
            if (!odd) {
                const int G_ = (int)gridDim.x, bid_ = (int)blockIdx.x;
                const int gu = (G_ == 256) ? (((bid_ >> 3) < 16) ? (bid_ & 7) * 16 + (bid_ >> 3) : -1) : bid_;
                ph_gla_chunk(P_, p.in[14] + i * 16 * 256, p.in[15] + i * 256, p.in[16] + i * 16 * 256, p.in[17] + i * 256, OF_, OB_, lds, gu, (G_ == 256) ? 1 << 20 : G_);
            }
            ph_attn_mfma(P_, ldp, KC_, VT_, ATT_, odd, l < DEPTH - 1, lds);
            GSYNC();
            if (!odd) {
                const float lam_init = 0.8f - 0.6f * expf(-0.3f * (float)l);
                ph_even_post(ATT_, p.in[12] + i * 256, p.in[13] + i * 128, lam_init, OF_, OB_, P_, p.in[18] + i * 128);
                GSYNC();
            }
            ph_gemm_res(ATT_, odd ? WOUTO_ + (size_t)i * DM * DM : WOUTE_ + (size_t)i * DM * DM, X_, mods_l + 2 * DM, lds);
            GSYNC();
        } else {
            const int last = (l == DEPTH - 1);
            const int nrows = last ? RL : RT;
            ph_route_mfma(QP_, KEYS_ + (size_t)l * 8 * 2 * 128 * 64, IDX_, GATE_, lds, nrows);
            GSYNC();
            ph_peer_ffn8(A_, IDX_, GATE_, T8_ + (size_t)l * 16384 * 768, RS_ + l * 16384, T8_ + (size_t)(DEPTH + l) * 16384 * 768, RS_ + (DEPTH + l) * 16384, mods_l,
                         X_, last ? p.out : X_, nrows, last ? nullptr : p.in[6] + (l + 1) * DM, mods_l + NMOD * MODW, A_);
            if (!last) GSYNC();
        }
    }
}

extern "C" void kernel_launch(void* const* d_in, const int* in_sizes, int n_in, void* d_out, int out_size, void* d_ws, size_t ws_size, hipStream_t stream) {
    static int grid_blocks = 0;
    if (!grid_blocks) {
        int dev = 0, cus = 0, per_cu = 0;
        (void)hipGetDevice(&dev);
        (void)hipDeviceGetAttribute(&cus, hipDeviceAttributeMultiprocessorCount, dev);
        (void)hipFuncSetAttribute((const void*)mega, hipFuncAttributeMaxDynamicSharedMemorySize, LDS_BYTES);
        (void)hipOccupancyMaxActiveBlocksPerMultiprocessor(&per_cu, mega, NT, LDS_BYTES);
        if (per_cu < 1) fprintf(stderr, "occupancy query says %d blocks/CU\n", per_cu);
        grid_blocks = cus;
        if (ws_size < WS_END) fprintf(stderr, "workspace too small: %zu < %zu\n", ws_size, (size_t)WS_END);
    }
    (void)hipMemsetAsync((unsigned char*)d_ws + WS_BAR, 0, WS_BAR_BYTES, stream);
    Params p{};
    for (int i = 0; i < 27; ++i) p.in[i] = (const float*)d_in[i];
    p.out = (float*)d_out; p.ws = (unsigned char*)d_ws;
    void* args[] = {&p};
    hipError_t e = hipLaunchCooperativeKernel((void*)mega, dim3(grid_blocks), dim3(NT), args, LDS_BYTES, stream);
    if (e != hipSuccess) fprintf(stderr, "cooperative launch failed: %s (grid %d)\n", hipGetErrorString(e), grid_blocks);
}
```

```cpp
#include <hip/hip_runtime.h>
#include <hip/hip_cooperative_groups.h>
#include <stdint.h>
#include <cstdio>
namespace cg = cooperative_groups;

#define DM 1024
#define NB 16
#define SEQ 2048
#define CTX 256
#define RL (NB * SEQ)
#define RC (NB * CTX)
#define RT (RL + RC)
#define DEPTH 4
#define EVEN_IN 3104
#define EVEN_LDP 3328
#define ODD_IN 1536
#define NMOD 17
#define MODW 6144
#define NT 512
#define NWV 8
#define LDS_BYTES 147456
#ifndef DUP_FFN
#define DUP_FFN 0
#endif
#ifndef DUP_ROUTE
#define DUP_ROUTE 0
#endif
#ifndef DUP_ATTN
#define DUP_ATTN 0
#endif
#ifndef DUP_GEMM
#define DUP_GEMM 0
#endif

typedef unsigned short bf16;
typedef float f32x2_t __attribute__((ext_vector_type(2)));
typedef __bf16 bf16x2_t __attribute__((ext_vector_type(2)));
struct Params {
    const float* in[27];
    float* out;
    unsigned char* ws;
};

__device__ __forceinline__ int row_mod(int r) { return r < RL ? (r >> 11) : 16; }
__device__ __forceinline__ float silu_f(float x) { return x / (1.f + expf(-x)); }
__device__ __forceinline__ float wave_sum(float v) {
#pragma unroll
    for (int o = 1; o < 64; o <<= 1) v += __shfl_xor(v, o);
    return v;
}
__device__ __forceinline__ float log_sigmoid_f(float z) { return fminf(z, 0.f) - log1pf(expf(-fabsf(z))); }
__device__ __forceinline__ float gelu_tanh(float x) { float u = 0.7978845608028654f * (x + 0.044715f * x * x * x); return 0.5f * x * (1.f + tanhf(u)); }
__device__ __forceinline__ float bf2f(bf16 v) { return __uint_as_float((unsigned)v << 16); }
__device__ __forceinline__ unsigned f2bf(float f) { unsigned u = __float_as_uint(f); return (u + 0x7fffu + ((u >> 16) & 1u)) >> 16; }
__device__ __forceinline__ unsigned pk2(float lo, float hi) { return f2bf(lo) | (f2bf(hi) << 16); }
__device__ __forceinline__ float4 ld4bf(const bf16* p) { uint2 u = *(const uint2*)p; return make_float4(__uint_as_float(u.x << 16), __uint_as_float(u.x & 0xffff0000u), __uint_as_float(u.y << 16), __uint_as_float(u.y & 0xffff0000u)); }
__device__ __forceinline__ void st4bf(bf16* p, float4 v) { *(uint2*)p = make_uint2(pk2(v.x, v.y), pk2(v.z, v.w)); }
__device__ __forceinline__ float2 ld2bf(const bf16* p) { unsigned u = *(const unsigned*)p; return make_float2(__uint_as_float(u << 16), __uint_as_float(u & 0xffff0000u)); }
__device__ __forceinline__ void st2bf(bf16* p, float2 v) { *(unsigned*)p = pk2(v.x, v.y); }

__device__ __forceinline__ int opaque_tid() { int t = threadIdx.x; asm volatile("" : "+v"(t)); return t; }
__device__ __forceinline__ int opaque_bid() { int b = blockIdx.x; asm volatile("" : "+s"(b)); return b; }

namespace pg8 {
#define PG8_LAS __attribute__((address_space(3)))
typedef unsigned short bf16_t;
typedef short bf16x8 __attribute__((ext_vector_type(8)));
typedef float f32x4 __attribute__((ext_vector_type(4)));
typedef unsigned u32x4 __attribute__((ext_vector_type(4)));
constexpr int BM = 256, BK = 64, HALF = 128, HTB = HALF * BK * 2  , STAGE_BYTES = 8 * HTB, NXCD = 8, WGM = 8;

__host__ __device__ __forceinline__ int lds_byte(int r, int c) { const int st = (r >> 4) * 2 + (c >> 5), rr = r & 15, cc = c & 31, ob = rr * 64 + cc * 2; return st * 1024 + (ob ^ (((ob >> 9) & 1) << 5)); }
__host__ __device__ __forceinline__ void stage_rc(int b, int& R, int& C) { const int st = b / 1024, sb = b % 1024, swz = sb ^ (((sb >> 9) & 1) << 5); R = (st >> 1) * 16 + swz / 64; C = (st & 1) * 32 + (swz % 64) / 2; }
__host__ __device__ __forceinline__ int perm32(int rho) { const int n = rho >> 4, i = rho & 15; return 8 * (i >> 2) + 4 * n + (i & 3); }

struct Unit { int pm, pn; };
struct Gemm { const bf16_t* A; const bf16_t* Bt; int M, N, K; };

struct StaticOrder {
    int nM, nN, nwg, G, c;
    __host__ __device__ void init(int M, int N, int G_, int c_) { nM = M / BM; nN = N / BM; nwg = nM * nN; G = G_; c = c_; }
    __host__ __device__ bool next(int i, Unit& u) const {
        const long L = (long)i * G + c; if (L >= nwg) return false;
        int wgid = (int)L; { const int q = nwg / NXCD, r = nwg % NXCD, xcd = wgid % NXCD, off = wgid / NXCD; wgid = (xcd < r ? xcd * (q + 1) : r * (q + 1) + (xcd - r) * q) + off; }
        const int nig = WGM * nN, gid = wgid / nig, fm = gid * WGM, gsz = (nM - fm) < WGM ? (nM - fm) : WGM;
        u.pm = fm + ((wgid % nig) % gsz); u.pn = (wgid % nig) / gsz; return true;
    }
    __device__ __forceinline__ void a_ready(const Unit&) const {}
    __device__ __forceinline__ void done(const Unit&) const {}
};

__device__ __forceinline__ unsigned cvt_pk_bf16(float lo, float hi) { unsigned r; asm volatile("v_cvt_pk_bf16_f32 %0, %1, %2" : "=v"(r) : "v"(lo), "v"(hi)); return r; }
typedef float f32x2 __attribute__((ext_vector_type(2)));
__device__ __forceinline__ f32x2 gelu_pk(f32x2 v) {
    const f32x2 av = __builtin_elementwise_abs(v), d = av * 0.2316418882f + 1.0f;
    f32x2 t; t.x = __builtin_amdgcn_rcpf(d.x); t.y = __builtin_amdgcn_rcpf(d.y);
    f32x2 q = t * 0.5307027145f + (-0.7265760135f); q = q * t + 0.7107068705f; q = q * t + (-0.142248368f); q = q * t + 0.127414796f; q = q * t;
    const f32x2 s = (v * v) * (-0.72134752044f);
    f32x2 e; e.x = __builtin_amdgcn_exp2f(s.x); e.y = __builtin_amdgcn_exp2f(s.y);
    const f32x2 m = v * (q * e), r = v - m;
    f32x2 o; o.x = v.x < 0.f ? m.x : r.x; o.y = v.y < 0.f ? m.y : r.y; return o;
}

template <int ACT  > struct EpiBf16 {
    static constexpr bool PERM = true, AFTER_DRAIN = false; static_assert(ACT == 0 || ACT == 1, "EpiBf16: ACT is 0 (none) or 1 (gelu_pk)");
    bf16_t* O; int ldc; const float* bias; int split_cols; size_t split_stride; float scale0;
    __device__ __forceinline__ void operator()(const f32x4 (&acc)[2][2][4][2], const Unit& u, int wr, int wc, int fr, int fq) const {
        const int row0 = u.pm * BM + wr * 64 + fr; int colt = u.pn * BM; bf16_t* base = O;
        float sc = 1.f; if (split_cols) { const int t = colt / split_cols; base += (size_t)t * split_stride; colt -= t * split_cols; if (t == 0) sc = scale0; }
        const int col0 = colt + wc * 32 + 8 * fq, bcol0 = u.pn * BM + wc * 32 + 8 * fq;
        f32x4 bv[2][2];
#pragma unroll
        for (int bj = 0; bj < 2; ++bj)
#pragma unroll
            for (int n = 0; n < 2; ++n) bv[bj][n] = bias ? *(const f32x4*)(bias + bcol0 + bj * HALF + 4 * n) : (f32x4){0.f, 0.f, 0.f, 0.f};
#pragma unroll
        for (int ai = 0; ai < 2; ++ai)
#pragma unroll
            for (int m = 0; m < 4; ++m) { bf16_t* rowp = base + (size_t)(row0 + ai * HALF + m * 16) * ldc + col0;
#pragma unroll
                for (int bj = 0; bj < 2; ++bj) { f32x4 v0 = acc[ai][bj][m][0] + bv[bj][0], v1 = acc[ai][bj][m][1] + bv[bj][1];
                    if (ACT == 1) { f32x2 a = gelu_pk((f32x2){v0[0], v0[1]}), b = gelu_pk((f32x2){v0[2], v0[3]}), c = gelu_pk((f32x2){v1[0], v1[1]}), d = gelu_pk((f32x2){v1[2], v1[3]});
                        v0 = (f32x4){a.x, a.y, b.x, b.y}; v1 = (f32x4){c.x, c.y, d.x, d.y}; }
                    v0 = v0 * sc; v1 = v1 * sc; u32x4 w; w.x = cvt_pk_bf16(v0[0], v0[1]); w.y = cvt_pk_bf16(v0[2], v0[3]); w.z = cvt_pk_bf16(v1[0], v1[1]); w.w = cvt_pk_bf16(v1[2], v1[3]);
                    *(u32x4*)(rowp + bj * HALF) = w; } }
    }
};
template <class Epi, class Sched, bool ALIGN_EPI = false, bool SP2 = false>
__device__ __forceinline__ void gemm_phase(PG8_LAS unsigned char* lds, const Gemm g, const Sched& S, const Epi& E) {
    const int tid = opaque_tid(), wid = __builtin_amdgcn_readfirstlane(tid >> 6), lane = tid & 63, wr = wid >> 2, wc = wid & 3, fr = lane & 15, fq = lane >> 4;
    const int K = g.K, nt = K / BK;
    unsigned voffA[2], voffB[2];
#pragma unroll
    for (int i = 0; i < 2; ++i) { int R, C; stage_rc(tid * 16 + i * 8192, R, C); const int Rb = Epi::PERM ? ((R & ~31) + perm32(R & 31)) : R;
        voffA[i] = (unsigned)(R * K + C) * 2u; voffB[i] = (unsigned)(Rb * K + C) * 2u; }
    const size_t kstep = (size_t)(BK * 2);
    const size_t hstep = (size_t)HALF * K * 2;
    const size_t tstep = 2 * hstep;
    const unsigned ldsw = (unsigned)wid * 1024u;
    const int aoff = lds_byte(wr * 64 + fr, fq * 8), boff = lds_byte(wc * 32 + fr, fq * 8);
#define PG8_SA(b, h) (((b) * 2 + (h)) * HTB)
#define PG8_SB(b, h) ((4 + (b) * 2 + (h)) * HTB)
#define PG8_STAGE(bufoff, gbase, voff) do { _Pragma("unroll") for (int _i = 0; _i < 2; ++_i) \
        __builtin_amdgcn_global_load_lds((const unsigned*)((const char*)(gbase) + (voff)[_i]), (PG8_LAS unsigned*)(lds + (bufoff) + ldsw + _i * 8192), 16, 0, 0); } while (0)
#define PG8_LDA(dst, b, h) do { _Pragma("unroll") for (int m = 0; m < 4; ++m) _Pragma("unroll") for (int k = 0; k < 2; ++k) dst[m][k] = *(const PG8_LAS bf16x8*)(lds + PG8_SA(b, h) + aoff + m * 2048 + k * 1024); } while (0)
#define PG8_LDB(dst, b, h) do { _Pragma("unroll") for (int n = 0; n < 2; ++n) _Pragma("unroll") for (int k = 0; k < 2; ++k) dst[n][k] = *(const PG8_LAS bf16x8*)(lds + PG8_SB(b, h) + boff + n * 2048 + k * 1024); } while (0)
#define PG8_MMA(ai, bj, At, Bt) do { __builtin_amdgcn_s_setprio(1); _Pragma("unroll") for (int m = 0; m < 4; ++m) _Pragma("unroll") for (int n = 0; n < 2; ++n) _Pragma("unroll") for (int k = 0; k < 2; ++k) \
        acc[ai][bj][m][n] = __builtin_amdgcn_mfma_f32_16x16x32_bf16(Bt[n][k], At[m][k], acc[ai][bj][m][n], 0, 0, 0); __builtin_amdgcn_s_setprio(0); } while (0)
#define PG8_WAIT_V(n) asm volatile("s_waitcnt vmcnt(" #n ")" ::: "memory")
#define PG8_WAIT_L(n) asm volatile("s_waitcnt lgkmcnt(" #n ")" ::: "memory")
#define PG8_BAR __builtin_amdgcn_s_barrier()
#define PG8_SCHED __builtin_amdgcn_sched_barrier(0)
    Unit cur, nxt; int ui = 0;
    if (!S.next(0, cur)) return;
    f32x4 acc[2][2][4][2];
#pragma unroll
    for (int a = 0; a < 2; ++a)
#pragma unroll
        for (int b = 0; b < 2; ++b)
#pragma unroll
            for (int m = 0; m < 4; ++m)
#pragma unroll
                for (int n = 0; n < 2; ++n) acc[a][b][m][n] = (f32x4){0.f, 0.f, 0.f, 0.f};
    bf16x8 At[4][2], B0[2][2], B1[2][2];
    const char* cA = (const char*)g.A + (size_t)cur.pm * tstep; const char* cB = (const char*)g.Bt + (size_t)cur.pn * tstep;
    S.a_ready(cur);
    if constexpr (SP2) {
        PG8_STAGE(PG8_SB(0, 0), cB, voffB); PG8_STAGE(PG8_SB(0, 1), cB + hstep, voffB); PG8_STAGE(PG8_SA(0, 0), cA, voffA); PG8_STAGE(PG8_SA(0, 1), cA + hstep, voffA);
        if (wr == 1) PG8_BAR;
        PG8_WAIT_V(2); PG8_BAR;
        PG8_STAGE(PG8_SB(1, 0), cB + kstep, voffB); PG8_STAGE(PG8_SA(1, 0), cA + kstep, voffA); PG8_STAGE(PG8_SB(1, 1), cB + hstep + kstep, voffB);
        PG8_WAIT_V(6); PG8_BAR;
    } else {
        PG8_STAGE(PG8_SB(0, 0), cB, voffB); PG8_STAGE(PG8_SA(0, 0), cA, voffA); PG8_STAGE(PG8_SB(0, 1), cB + hstep, voffB); PG8_STAGE(PG8_SA(0, 1), cA + hstep, voffA);
        if (wr == 1) PG8_BAR;
        PG8_WAIT_V(4); PG8_BAR;
        PG8_STAGE(PG8_SB(1, 0), cB + kstep, voffB); PG8_STAGE(PG8_SA(1, 0), cA + kstep, voffA); PG8_STAGE(PG8_SB(1, 1), cB + hstep + kstep, voffB);
        PG8_WAIT_V(6); PG8_BAR;
    }
    for (;;) {
        const bool has_next = S.next(ui + 1, nxt);
        const char* nA = has_next ? (const char*)g.A + (size_t)nxt.pm * tstep : cA; const char* nB = has_next ? (const char*)g.Bt + (size_t)nxt.pn * tstep : cB;
        for (int t = 0; t < nt; t += 2) {
            const bool last = (t == nt - 2);
            const char* a1 = cA + (size_t)(t + 1) * kstep;
            const char* a2 = last ? nA : cA + (size_t)(t + 2) * kstep; const char* b2 = last ? nB : cB + (size_t)(t + 2) * kstep;
            const char* a3 = a2 + kstep; const char* b3 = b2 + kstep;
            if (last && has_next) S.a_ready(nxt);
            if constexpr (SP2) {
            PG8_LDB(B0, 0, 0); PG8_LDB(B1, 0, 1); PG8_SCHED; PG8_LDA(At, 0, 0); PG8_STAGE(PG8_SA(1, 1), a1 + hstep, voffA);
            PG8_WAIT_V(8); PG8_WAIT_L(0); PG8_BAR; PG8_MMA(0, 0, At, B0); PG8_MMA(0, 1, At, B1); PG8_BAR; PG8_SCHED;
            PG8_LDA(At, 0, 1); PG8_STAGE(PG8_SB(0, 0), b2, voffB); PG8_STAGE(PG8_SB(0, 1), b2 + hstep, voffB); PG8_STAGE(PG8_SA(0, 0), a2, voffA);
            PG8_WAIT_V(8); PG8_WAIT_L(0); PG8_BAR; PG8_MMA(1, 0, At, B0); PG8_MMA(1, 1, At, B1); PG8_BAR; PG8_SCHED;
            PG8_LDB(B0, 1, 0); PG8_LDB(B1, 1, 1); PG8_SCHED; PG8_LDA(At, 1, 0); PG8_STAGE(PG8_SA(0, 1), a2 + hstep, voffA);
            PG8_WAIT_V(8); PG8_WAIT_L(0); PG8_BAR; PG8_MMA(0, 0, At, B0); PG8_MMA(0, 1, At, B1); PG8_BAR; PG8_SCHED;
            PG8_LDA(At, 1, 1); PG8_STAGE(PG8_SB(1, 0), b3, voffB); PG8_STAGE(PG8_SB(1, 1), b3 + hstep, voffB); PG8_STAGE(PG8_SA(1, 0), a3, voffA);
            PG8_WAIT_V(8); PG8_WAIT_L(0); PG8_BAR; PG8_MMA(1, 0, At, B0); PG8_MMA(1, 1, At, B1); PG8_BAR; PG8_SCHED;
            } else {
            PG8_LDB(B0, 0, 0); PG8_SCHED; PG8_LDA(At, 0, 0); PG8_STAGE(PG8_SA(1, 1), a1 + hstep, voffA);
            PG8_WAIT_L(8); PG8_BAR; PG8_WAIT_L(0); PG8_MMA(0, 0, At, B0); PG8_BAR; PG8_SCHED;
            PG8_LDB(B1, 0, 1); PG8_STAGE(PG8_SB(0, 0), b2, voffB);
            PG8_BAR; PG8_WAIT_L(0); PG8_MMA(0, 1, At, B1); PG8_BAR;
            PG8_LDA(At, 0, 1); PG8_STAGE(PG8_SA(0, 0), a2, voffA);
            PG8_BAR; PG8_WAIT_L(0); PG8_MMA(1, 0, At, B0); PG8_BAR; PG8_SCHED;
            PG8_STAGE(PG8_SB(0, 1), b2 + hstep, voffB);
            PG8_WAIT_V(6); PG8_BAR; PG8_MMA(1, 1, At, B1); PG8_BAR;
            PG8_LDB(B0, 1, 0); PG8_SCHED; PG8_LDA(At, 1, 0); PG8_STAGE(PG8_SA(0, 1), a2 + hstep, voffA);
            PG8_WAIT_L(8); PG8_BAR; PG8_WAIT_L(0); PG8_MMA(0, 0, At, B0); PG8_BAR; PG8_SCHED;
            PG8_LDB(B1, 1, 1); PG8_STAGE(PG8_SB(1, 0), b3, voffB);
            PG8_BAR; PG8_WAIT_L(0); PG8_MMA(0, 1, At, B1); PG8_BAR;
            PG8_LDA(At, 1, 1); PG8_STAGE(PG8_SA(1, 0), a3, voffA);
            PG8_BAR; PG8_WAIT_L(0); PG8_MMA(1, 0, At, B0); PG8_BAR; PG8_SCHED;
            PG8_STAGE(PG8_SB(1, 1), b3 + hstep, voffB);
            PG8_WAIT_V(6); PG8_BAR; PG8_MMA(1, 1, At, B1); PG8_BAR;
            }
        }
        if constexpr (ALIGN_EPI) { if (wr == 0) PG8_BAR; }
        if constexpr (!Epi::AFTER_DRAIN) { E(acc, cur, wr, wc, fr, fq); S.done(cur); }
        if (!has_next) break;
#pragma unroll
        for (int a = 0; a < 2; ++a)
#pragma unroll
            for (int b = 0; b < 2; ++b)
#pragma unroll
                for (int m = 0; m < 4; ++m)
#pragma unroll
                    for (int n = 0; n < 2; ++n) acc[a][b][m][n] = (f32x4){0.f, 0.f, 0.f, 0.f};
        cur = nxt; cA = nA; cB = nB; ++ui;
        if constexpr (ALIGN_EPI) { if (wr == 1) PG8_BAR; }
    }
    PG8_WAIT_V(0);
    if constexpr (!ALIGN_EPI) { if (wr == 0) PG8_BAR; }
    PG8_BAR;
    if constexpr (Epi::AFTER_DRAIN) { E.fused(acc, cur, wr, wc, fr, fq, lds, wid, lane); S.done(cur); }
#undef PG8_SA
#undef PG8_SB
#undef PG8_STAGE
#undef PG8_LDA
#undef PG8_LDB
#undef PG8_MMA
#undef PG8_WAIT_V
#undef PG8_WAIT_L
#undef PG8_BAR
#undef PG8_SCHED
}
}

struct EpiResGate {
    static constexpr bool PERM = false, AFTER_DRAIN = false;
    float* X; const float* gate;
    __device__ __forceinline__ void operator()(const pg8::f32x4 (&acc)[2][2][4][2], const pg8::Unit& u, int wr, int wc, int fr, int fq) const {
#pragma unroll
        for (int ai = 0; ai < 2; ++ai)
#pragma unroll
            for (int m = 0; m < 4; ++m) {
                const int r = u.pm * 256 + ai * 128 + wr * 64 + m * 16 + fr;
                const float* g = gate + (size_t)row_mod(r) * MODW; float* xr = X + (size_t)r * DM;
#pragma unroll
                for (int bj = 0; bj < 2; ++bj)
#pragma unroll
                    for (int n = 0; n < 2; ++n) {
                        const int c = u.pn * 256 + bj * 128 + wc * 32 + n * 16 + 4 * fq;
                        pg8::f32x4 xv = *(const pg8::f32x4*)(xr + c); const pg8::f32x4 gv = *(const pg8::f32x4*)(g + c);
                        xv = xv + gv * acc[ai][bj][m][n];
                        *(pg8::f32x4*)(xr + c) = xv;
                    }
            }
    }
};
#define LAS __attribute__((address_space(3)))
#define GAS __attribute__((address_space(1)))

__device__ __forceinline__ void ph_copy_in(const float* __restrict__ x, const float* __restrict__ ctx, float* __restrict__ X) {
    const int TID = opaque_tid(), BID = opaque_bid();
    size_t i = (size_t)BID * NT + TID;
    const size_t n4 = (size_t)RT * DM / 4, nl4 = (size_t)RL * DM / 4;
    for (; i < n4; i += (size_t)gridDim.x * NT) ((float4*)X)[i] = i < nl4 ? ((const float4*)x)[i] : ((const float4*)ctx)[i - nl4];
}
__device__ __forceinline__ void ph_copy_out(const float* __restrict__ X, float* __restrict__ out) {
    const int TID = opaque_tid(), BID = opaque_bid();
    size_t i = (size_t)BID * NT + TID;
    const size_t n4 = (size_t)RL * DM / 4;
    for (; i < n4; i += (size_t)gridDim.x * NT) ((float4*)out)[i] = ((const float4*)X)[i];
}
__device__ __forceinline__ void ph_rope_table(float2* __restrict__ rope) {
    const int TID = opaque_tid(), BID = opaque_bid();
    for (int i = BID * NT + TID; i < SEQ * 32; i += gridDim.x * NT) {
        int t = i >> 5, a = (i >> 4) & 1, f = i & 15;
        float pos = a == 0 ? (float)(t >> 6) : (float)(t & 63);
        float inv = powf(10000.f, -(float)f / 16.f);
        float ang = pos * inv;
        rope[i] = make_float2(cosf(ang), sinf(ang));
    }
}
__device__ __forceinline__ void transpose_item(const float* __restrict__ W, int N, bf16* __restrict__ WT, LAS float* scr, int item, int lane) {
    const int K = DM;
    const int nblk = N / 32, kb = item / nblk, nb = item % nblk, k0 = 64 * kb, n0 = 32 * nb;
#pragma unroll 8
    for (int i = 0; i < 32; ++i) { const int kk = 2 * i + (lane >> 5); scr[kk * 33 + (lane & 31)] = W[(size_t)(k0 + kk) * N + n0 + (lane & 31)]; }
    asm volatile("s_waitcnt lgkmcnt(0)" ::: "memory");
    const int c = lane & 7;
#pragma unroll
    for (int j = 0; j < 4; ++j) { const int n = (lane >> 3) + 8 * j; const LAS float* s = scr + (8 * c) * 33 + n;
        uint4 o; o.x = pk2(s[0 * 33], s[1 * 33]); o.y = pk2(s[2 * 33], s[3 * 33]); o.z = pk2(s[4 * 33], s[5 * 33]); o.w = pk2(s[6 * 33], s[7 * 33]);
        *(uint4*)(WT + (size_t)(n0 + n) * K + k0 + 8 * c) = o; }
    asm volatile("s_waitcnt lgkmcnt(0)" ::: "memory");
}
struct WPrep { const float* src[12]; bf16* dst[12]; };
__device__ __forceinline__ void ph_weight_prep(const float* const* in, bf16* WinE, bf16* WoutE, bf16* WinO, bf16* WoutO, bf16* Wpq, bf16* Kb, unsigned char* lds) {
    const int TID = opaque_tid(), BID = opaque_bid();
    const int lane = TID & 63, wv = TID >> 6;
    LAS float* scr = (LAS float*)((LAS unsigned char*)lds + wv * 16384);
    const int gw = BID * NWV + wv, NGW = gridDim.x * NWV;
    const int NITEMS = 2 * 1552 + 2 * 512 + 2 * 768 + 2 * 512 + 4 * 512;
    for (int it = gw; it < NITEMS; it += NGW) {
        int r = it;
        if (r < 3104) { int i = r / 1552; transpose_item(in[8] + (size_t)i * DM * EVEN_IN, EVEN_IN, WinE + (size_t)i * EVEN_LDP * DM, scr, r % 1552, lane); continue; } r -= 3104;
        if (r < 1024) { int i = r / 512; transpose_item(in[9] + (size_t)i * DM * DM, DM, WoutE + (size_t)i * DM * DM, scr, r % 512, lane); continue; } r -= 1024;
        if (r < 1536) { int i = r / 768; transpose_item(in[19] + (size_t)i * DM * ODD_IN, ODD_IN, WinO + (size_t)i * ODD_IN * DM, scr, r % 768, lane); continue; } r -= 1536;
        if (r < 1024) { int i = r / 512; transpose_item(in[20] + (size_t)i * DM * DM, DM, WoutO + (size_t)i * DM * DM, scr, r % 512, lane); continue; } r -= 1024;
        { int i = r / 512; transpose_item(in[23] + (size_t)i * DM * DM, DM, Wpq + (size_t)i * DM * DM, scr, r % 512, lane); }
    }
    for (int i4 = BID * NT + TID; i4 < DEPTH * 8 * 2 * 128 * 64 / 4; i4 += gridDim.x * NT) st4bf(Kb + 4 * (size_t)i4, ((const float4*)in[24])[i4]);
    for (int i = BID * NT + TID; i < 2 * 28672; i += gridDim.x * NT) {
        int w = i / 28672, o = i % 28672;
        ((uint4*)(WinE + (size_t)w * EVEN_LDP * DM + (size_t)EVEN_IN * DM))[o] = make_uint4(0u, 0u, 0u, 0u);
    }
}
__device__ __forceinline__ void ph_mods(const float* __restrict__ c, const float* __restrict__ cctx, const float* __restrict__ w_mod,
                        const float* __restrict__ b_mod, float* __restrict__ mods, float* smem) {
    const int TID = opaque_tid(), BID = opaque_bid();
    const int nslab = DEPTH * MODW / 128;
    if (BID >= nslab) return;
    const int lane = TID & 63, wv = TID >> 6, cl = lane & 15, kp = lane >> 4;
    float (*S)[DM] = (float (*)[DM])smem;
    for (int i = TID; i < NMOD * DM; i += NT) {
        int j = i / DM, k = i % DM;
        float v = j < 16 ? c[j * DM + k] : cctx[k];
        S[j][k] = silu_f(v);
    }
    __syncthreads();
    for (int slab = BID; slab < nslab; slab += gridDim.x) {
        const int l = slab / 48, n = (slab % 48) * 128 + wv * 16 + cl;
        const float* W = w_mod + (size_t)l * DM * MODW + n;
        float acc[NMOD];
#pragma unroll
        for (int j = 0; j < NMOD; ++j) acc[j] = 0.f;
#pragma unroll 4
        for (int kk = 0; kk < 256; ++kk) {
            const int k = kp * 256 + kk;
            const float w = W[(size_t)k * MODW];
#pragma unroll
            for (int j = 0; j < NMOD; ++j) acc[j] += S[j][k] * w;
        }
        const float bias = b_mod[l * MODW + n];
#pragma unroll
        for (int j = 0; j < NMOD; ++j) {
            float v = acc[j];
            v += __shfl_xor(v, 16); v += __shfl_xor(v, 32);
            if (kp == 0) mods[((size_t)l * NMOD + j) * MODW + n] = v + bias;
        }
    }
    __syncthreads();
}
__device__ __forceinline__ void ph_norm_mod(const float* __restrict__ X, const float* __restrict__ g, const float* __restrict__ mods_l, int shift_chunk, bf16* __restrict__ A) {
    const int TID = opaque_tid(), BID = opaque_bid();
    int wave = BID * NWV + (TID >> 6), lane = TID & 63;
    int nw = gridDim.x * NWV;
    for (int r = wave; r < RT; r += nw) {
        const float4* xr = (const float4*)(X + (size_t)r * DM);
        float4 v[4]; float s = 0.f;
#pragma unroll
        for (int i = 0; i < 4; ++i) { v[i] = xr[lane + 64 * i]; s += v[i].x * v[i].x + v[i].y * v[i].y + v[i].z * v[i].z + v[i].w * v[i].w; }
        s = wave_sum(s);
        float rstd = rsqrtf(s * (1.f / DM) + 1e-6f);
        const float* m = mods_l + (size_t)row_mod(r) * MODW;
        const float4* sh = (const float4*)(m + shift_chunk * DM);
        const float4* sc = (const float4*)(m + (shift_chunk + 1) * DM);
        const float4* g4 = (const float4*)g;
        bf16* ar = A + (size_t)r * DM;
#pragma unroll
        for (int i = 0; i < 4; ++i) {
            int c = lane + 64 * i;
            float4 gg = g4[c], a = sh[c], b = sc[c], o;
            o.x = v[i].x * rstd * gg.x * (1.f + b.x) + a.x;
            o.y = v[i].y * rstd * gg.y * (1.f + b.y) + a.y;
            o.z = v[i].z * rstd * gg.z * (1.f + b.z) + a.z;
            o.w = v[i].w * rstd * gg.w * (1.f + b.w) + a.w;
            st4bf(ar + 4 * c, o);
        }
    }
}
#define KVLEN (CTX + SEQ)
__device__ __forceinline__ void ph_post(bf16* __restrict__ P, int ldp, int nq, int kcol0, int nk, int vcol0, int VC, int DV,
                                        const float* __restrict__ qgain, const float* __restrict__ kgain, const float2* __restrict__ rope,
                                        bf16* __restrict__ Kc, bf16* __restrict__ Vt) {
    const int TID = opaque_tid(), BID = opaque_bid();
    const float C2 = 0.125f * 1.4426950408889634f;
    for (int tile = BID; tile < RT / 64; tile += gridDim.x) {
        const int r0 = tile * 64;
        int b, j0;
        if (r0 < RL) { b = r0 >> 11; j0 = CTX + (r0 & (SEQ - 1)); } else { b = (r0 - RL) >> 8; j0 = (r0 - RL) & (CTX - 1); }
        const int nh = nq + nk, sub = TID & 7;
        for (int ti = TID; ti < 64 * nh * 8; ti += NT) {
            const int item = ti >> 3, row = item / nh, hh = item % nh, r = r0 + row;
            const bool isk = hh >= nq; const int h = isk ? hh - nq : hh;
            bf16* src = P + (size_t)r * ldp + (isk ? kcol0 : 0) + h * 64 + sub * 8;
            const float* gain = (isk ? kgain : qgain) + sub * 8;
            const uint4 raw = *(const uint4*)src;
            const unsigned rw[4] = {raw.x, raw.y, raw.z, raw.w};
            float v[8]; float ssq = 0.f;
#pragma unroll
            for (int i = 0; i < 4; ++i) { v[2 * i] = __uint_as_float(rw[i] << 16); v[2 * i + 1] = __uint_as_float(rw[i] & 0xffff0000u); ssq += v[2 * i] * v[2 * i] + v[2 * i + 1] * v[2 * i + 1]; }
            ssq += __shfl_xor(ssq, 1); ssq += __shfl_xor(ssq, 2); ssq += __shfl_xor(ssq, 4);
            const float rstd = rsqrtf(ssq * (1.f / 64.f) + 1e-6f) * (isk ? 1.f : C2);
            const float4 g0 = ((const float4*)gain)[0], g1 = ((const float4*)gain)[1];
            const float gg[8] = {g0.x, g0.y, g0.z, g0.w, g1.x, g1.y, g1.z, g1.w};
#pragma unroll
            for (int i = 0; i < 8; ++i) v[i] = v[i] * rstd * gg[i];
            float pv[8];
#pragma unroll
            for (int i = 0; i < 8; ++i) pv[i] = __shfl_xor(v[i], 2);
            if (r < RL) {
                const float2* tab = rope + (size_t)(r & (SEQ - 1)) * 32 + (sub >> 2) * 16 + (sub & 1) * 8;
                const bool second = (sub & 2) != 0;
#pragma unroll
                for (int i = 0; i < 8; ++i) { const float2 cs = tab[i]; v[i] = second ? (v[i] * cs.x + pv[i] * cs.y) : (v[i] * cs.x - pv[i] * cs.y); }
            }
            bf16* dst = isk ? Kc + ((size_t)(b * nk + h) * KVLEN + j0 + row) * 64 + sub * 8 : src;
            *(uint4*)dst = make_uint4(pk2(v[0], v[1]), pk2(v[2], v[3]), pk2(v[4], v[5]), pk2(v[6], v[7]));
        }
        if (TID < VC) {
            const int c8 = TID >> 3, rg = TID & 7;
            unsigned in[8][4];
#pragma unroll
            for (int rr = 0; rr < 8; ++rr) { uint4 t = *(const uint4*)(P + (size_t)(r0 + rg * 8 + rr) * ldp + vcol0 + c8 * 8); in[rr][0] = t.x; in[rr][1] = t.y; in[rr][2] = t.z; in[rr][3] = t.w; }
#pragma unroll
            for (int c = 0; c < 8; ++c) {
                unsigned o[4];
#pragma unroll
                for (int q = 0; q < 4; ++q)
                    o[q] = (c & 1) ? __builtin_amdgcn_perm(in[2 * q + 1][c >> 1], in[2 * q][c >> 1], 0x07060302u) : __builtin_amdgcn_perm(in[2 * q + 1][c >> 1], in[2 * q][c >> 1], 0x05040100u);
                const int col = c8 * 8 + c, vh = col / DV, d = col % DV;
                bf16* vrow = Vt + ((size_t)(b * 4 + vh) * DV + d) * KVLEN + j0 + 16 * (rg >> 1) + 4 * (rg & 1);
                *(uint2*)vrow = make_uint2(o[0], o[1]);
                *(uint2*)(vrow + 8) = make_uint2(o[2], o[3]);
            }
        }
    }
}
typedef short bf16x8 __attribute__((ext_vector_type(8)));
typedef float f32x16 __attribute__((ext_vector_type(16)));
__device__ __forceinline__ int crow(int r, int hi) { return (r & 3) + 8 * (r >> 2) + 4 * hi; }
__device__ __forceinline__ unsigned cvt_pk_bf16_f32(float lo, float hi) { f32x2_t v = {lo, hi}; bf16x2_t b = __builtin_convertvector(v, bf16x2_t); return __builtin_bit_cast(unsigned, b); }
__device__ __forceinline__ float max3f(float a, float b, float c) { return fmaxf(fmaxf(a, b), c); }
__device__ __forceinline__ float max2f(float a, float b) { return fmaxf(a, b); }
#define ATT_KPITCH 144
#define ATT_VPITCH 144
template <int DV>
__device__ __forceinline__ void attn_unit(const bf16* __restrict__ Qbase, int ldq, const bf16* __restrict__ Kc, const bf16* __restrict__ Vt, int ntiles,
                                          bf16* __restrict__ Obase, int ldo, unsigned char* lds, int tid) {
    constexpr int NDB = DV / 32, NVL = DV / 64, KBYTES = 64 * ATT_KPITCH, VBYTES = DV * ATT_VPITCH;
    constexpr float THR = 8.f;
    const int lane = tid & 63, wid = tid >> 6, r32 = lane & 31, hi = lane >> 5;
    unsigned char* Kb0 = lds; unsigned char* Vb0 = lds + 2 * KBYTES;
    float* sc = (float*)(lds + 2 * KBYTES + 2 * VBYTES + wid * 128);
    bf16x8 qf[4];
    {
        const bf16* qrow = Qbase + (size_t)(wid * 32 + r32) * ldq;
#pragma unroll
        for (int s = 0; s < 4; ++s) qf[s] = *(const bf16x8*)(qrow + 16 * s + 8 * hi);
    }
    f32x16 o[NDB];
#pragma unroll
    for (int d = 0; d < NDB; ++d)
#pragma unroll
        for (int r = 0; r < 16; ++r) o[d][r] = 0.f;
    float m = -1e30f, l = 0.f;
    uint4 kreg, vreg0, vreg1 = make_uint4(0u, 0u, 0u, 0u);
    const int krow = tid >> 3, kch = tid & 7;
    const unsigned voff0 = (unsigned)(tid >> 3) * (unsigned)(KVLEN * 2) + (unsigned)(tid & 7) * 16u, voff1 = voff0 + 64u * (unsigned)(KVLEN * 2);
    const unsigned vlds0 = (unsigned)(tid >> 3) * ATT_VPITCH + (unsigned)(tid & 7) * 16u, vlds1 = vlds0 + 64u * ATT_VPITCH;
#define ATT_GLOAD_K(t) do { kreg = *(const uint4*)((const unsigned char*)Kc + ((unsigned)(t) * 8192u + (unsigned)tid * 16u)); } while (0)
#define ATT_GLOAD_V(t) do { vreg0 = *(const uint4*)((const unsigned char*)Vt + (voff0 + (unsigned)(t) * 128u)); if (NVL == 2) vreg1 = *(const uint4*)((const unsigned char*)Vt + (voff1 + (unsigned)(t) * 128u)); } while (0)
#define ATT_STORE_K(buf) do { *(uint4*)(Kb0 + (buf) * KBYTES + krow * ATT_KPITCH + kch * 16) = kreg; } while (0)
#define ATT_STORE_V(buf) do { *(uint4*)(Vb0 + (buf) * VBYTES + vlds0) = vreg0; if (NVL == 2) *(uint4*)(Vb0 + (buf) * VBYTES + vlds1) = vreg1; } while (0)
#define ATT_QK(S0, S1, buf) do { const unsigned char* kb_ = Kb0 + (buf) * KBYTES; \
        _Pragma("unroll") for (int r = 0; r < 16; ++r) { S0[r] = 0.f; S1[r] = 0.f; } \
        _Pragma("unroll") for (int s = 0; s < 4; ++s) { \
            const bf16x8 a0 = *(const bf16x8*)(kb_ + r32 * ATT_KPITCH + s * 32 + hi * 16); \
            const bf16x8 a1 = *(const bf16x8*)(kb_ + (32 + r32) * ATT_KPITCH + s * 32 + hi * 16); \
            S0 = __builtin_amdgcn_mfma_f32_32x32x16_bf16(a0, qf[s], S0, 0, 0, 0); \
            S1 = __builtin_amdgcn_mfma_f32_32x32x16_bf16(a1, qf[s], S1, 0, 0, 0); } } while (0)
    ATT_GLOAD_K(0); ATT_GLOAD_V(0);
    ATT_STORE_K(0); ATT_STORE_V(0); ATT_STORE_V(1);
    if (ntiles > 1) { ATT_GLOAD_K(1); ATT_STORE_K(1); }
    __syncthreads();
    f32x16 s0, s1;
    ATT_QK(s0, s1, 0);
    __syncthreads();
    uint4 pa0 = make_uint4(0u, 0u, 0u, 0u), pa1 = pa0, pa2 = pa0, pa3 = pa0;
#define ATT_PA(s) __builtin_bit_cast(bf16x8, (s) == 0 ? pa0 : (s) == 1 ? pa1 : (s) == 2 ? pa2 : pa3)
    for (int t = 0; t < ntiles; ++t) {
        if (t + 2 < ntiles) ATT_GLOAD_K(t + 2);
        if (t > 0) ATT_GLOAD_V(t);
        f32x16 n0, n1;
        ATT_QK(n0, n1, (t + 1) & 1);
        {
            const unsigned char* vb = Vb0 + ((t + 1) & 1) * VBYTES;
#pragma unroll
            for (int d = 0; d < NDB; ++d) {
#pragma unroll
                for (int s = 0; s < 4; ++s) {
                    const bf16x8 vf = *(const bf16x8*)(vb + (32 * d + r32) * ATT_VPITCH + 32 * s + 16 * hi);
                    o[d] = __builtin_amdgcn_mfma_f32_32x32x16_bf16(ATT_PA(s), vf, o[d], 0, 0, 0);
                }
            }
        }
        float tm = max3f(s0[0], s1[0], s0[1]);
        tm = max3f(tm, s1[1], s0[2]); tm = max3f(tm, s1[2], s0[3]); tm = max3f(tm, s1[3], s0[4]);
#pragma unroll
        for (int r = 4; r < 15; r += 2) { tm = max3f(tm, s1[r], s0[r + 1]); tm = max3f(tm, s1[r + 1], s0[r + 2 < 16 ? r + 2 : 15]); }
        tm = max2f(tm, s1[15]);
        tm = max2f(tm, __shfl_xor(tm, 32));
        const bool up = tm > m + THR;
        const float mn = up ? max2f(m, tm) : m, alpha = exp2f(m - mn);
        m = mn; l *= alpha;
        float ps = 0.f;
#pragma unroll
        for (int r = 0; r < 16; ++r) { s0[r] = exp2f(s0[r] - m); s1[r] = exp2f(s1[r] - m); ps += s0[r] + s1[r]; }
        l += ps;
        uint4 pn0 = make_uint4(cvt_pk_bf16_f32(s0[0], s0[1]), cvt_pk_bf16_f32(s0[2], s0[3]), cvt_pk_bf16_f32(s0[4], s0[5]), cvt_pk_bf16_f32(s0[6], s0[7]));
        uint4 pn1 = make_uint4(cvt_pk_bf16_f32(s0[8], s0[9]), cvt_pk_bf16_f32(s0[10], s0[11]), cvt_pk_bf16_f32(s0[12], s0[13]), cvt_pk_bf16_f32(s0[14], s0[15]));
        uint4 pn2 = make_uint4(cvt_pk_bf16_f32(s1[0], s1[1]), cvt_pk_bf16_f32(s1[2], s1[3]), cvt_pk_bf16_f32(s1[4], s1[5]), cvt_pk_bf16_f32(s1[6], s1[7]));
        uint4 pn3 = make_uint4(cvt_pk_bf16_f32(s1[8], s1[9]), cvt_pk_bf16_f32(s1[10], s1[11]), cvt_pk_bf16_f32(s1[12], s1[13]), cvt_pk_bf16_f32(s1[14], s1[15]));
        asm volatile("" : "+v"(pn0.x), "+v"(pn0.y), "+v"(pn0.z), "+v"(pn0.w), "+v"(pn1.x), "+v"(pn1.y), "+v"(pn1.z), "+v"(pn1.w));
        asm volatile("" : "+v"(pn2.x), "+v"(pn2.y), "+v"(pn2.z), "+v"(pn2.w), "+v"(pn3.x), "+v"(pn3.y), "+v"(pn3.z), "+v"(pn3.w), "+v"(l));
        __builtin_amdgcn_sched_group_barrier(0x100, 4, 0);
#pragma unroll
        for (int i = 0; i < 8 + 4 * NDB; ++i) {
            __builtin_amdgcn_sched_group_barrier(0x008, 1, 0);
            __builtin_amdgcn_sched_group_barrier(0x100, 1, 0);
            __builtin_amdgcn_sched_group_barrier(0x002, NDB == 2 ? 8 : 6, 0);
            __builtin_amdgcn_sched_group_barrier(0x400, NDB == 2 ? 2 : 1, 0);
        }
        if (__any(up)) {
            if (hi == 0) sc[r32] = alpha;
#pragma unroll
            for (int r = 0; r < 16; ++r) { const float a = sc[crow(r, hi)];
#pragma unroll
                for (int d = 0; d < NDB; ++d) o[d][r] *= a; }
        }
        if (t + 2 < ntiles) ATT_STORE_K(t & 1);
        if (t > 0) ATT_STORE_V(t & 1);
        __syncthreads();
        s0 = n0; s1 = n1;
        pa0 = pn0; pa1 = pn1; pa2 = pn2; pa3 = pn3;
    }
    {
        const unsigned char* vb = Vb0 + ((ntiles - 1) & 1) * VBYTES;
#pragma unroll
        for (int d = 0; d < NDB; ++d) {
#pragma unroll
            for (int s = 0; s < 4; ++s) {
                const bf16x8 vf = *(const bf16x8*)(vb + (32 * d + r32) * ATT_VPITCH + 32 * s + 16 * hi);
                o[d] = __builtin_amdgcn_mfma_f32_32x32x16_bf16(ATT_PA(s), vf, o[d], 0, 0, 0);
            }
        }
    }
#undef ATT_GLOAD_K
#undef ATT_GLOAD_V
#undef ATT_STORE_K
#undef ATT_STORE_V
#undef ATT_QK
#undef ATT_PA
    l += __shfl_xor(l, 32);
    if (hi == 0) sc[r32] = 1.f / l;
    int tide = tid; asm volatile("" : "+v"(tide));
    const unsigned obase_off = (unsigned)(((tide >> 6) * 32 + 4 * ((tide >> 5) & 1)) * ldo + (tide & 31)) * 2u;
#pragma unroll
    for (int r = 0; r < 16; ++r) {
        const float iv = sc[crow(r, hi)];
        bf16* orow = (bf16*)((unsigned char*)Obase + (obase_off + (unsigned)(((r & 3) + 8 * (r >> 2)) * ldo) * 2u));
#pragma unroll
        for (int d = 0; d < NDB; ++d) orow[32 * d] = (bf16)f2bf(o[d][r] * iv);
    }
    __syncthreads();
}
__device__ __forceinline__ void attn_run_unit(const bf16* __restrict__ P, int ldp, const bf16* __restrict__ Kc, const bf16* __restrict__ Vt, bf16* __restrict__ ATT,
                                              int odd, int u, int nlat, unsigned char* lds, int TID) {
    int b, qh, row0, ntiles;
    if (u < nlat) {
        if (odd) { const int grp = u >> 5, w = u & 31; b = grp >> 2; qh = (grp & 3) * 4 + (w >> 3); row0 = b * SEQ + (w & 7) * 256; }
        else { const int grp = u >> 4, w = u & 15; b = grp >> 2; qh = (grp & 3) * 2 + (w >> 3); row0 = b * SEQ + (w & 7) * 256; }
        ntiles = KVLEN / 64;
    } else {
        const int idx = u - nlat;
        if (odd) { b = idx >> 4; qh = idx & 15; } else { b = idx >> 3; qh = idx & 7; }
        row0 = RL + b * CTX; ntiles = CTX / 64;
    }
    if (odd) attn_unit<64>(P + (size_t)row0 * ldp + qh * 64, ldp, Kc + (size_t)(b * 4 + (qh >> 2)) * KVLEN * 64, Vt + (size_t)(b * 4 + (qh >> 2)) * 64 * KVLEN, ntiles,
                           ATT + (size_t)row0 * DM + qh * 64, DM, lds, TID);
    else attn_unit<128>(P + (size_t)row0 * ldp + qh * 64, ldp, Kc + (size_t)(b * 8 + qh) * KVLEN * 64, Vt + (size_t)(b * 4 + (qh >> 1)) * 128 * KVLEN, ntiles,
                        ATT + (size_t)row0 * DM + qh * 128, DM, lds, TID);
}
__device__ __forceinline__ void ph_attn_mfma(const bf16* __restrict__ P, int ldp, const bf16* __restrict__ Kc, const bf16* __restrict__ Vt, bf16* __restrict__ ATT,
                                             int odd, int with_ctx, unsigned char* lds) {
    const int TID = opaque_tid(), BID = opaque_bid();
    const int G = gridDim.x, vcu = (G % 8 == 0) ? (BID & 7) * (G >> 3) + (BID >> 3) : BID;
    const int nlat = odd ? 2048 : 1024, nctx = with_ctx ? (odd ? 256 : 128) : 0;
    if (!odd && G == 256) {
        const int x = BID & 7, w = BID >> 3;
        if (w >= 16) { for (int i = 0; i < 5; ++i) attn_run_unit(P, ldp, Kc, Vt, ATT, odd, x * 128 + 16 * i + (w - 16), nlat, lds, TID); }
        else {
            for (int i = 5; i < 8; ++i) attn_run_unit(P, ldp, Kc, Vt, ATT, odd, x * 128 + 16 * i + w, nlat, lds, TID);
            if (nctx) attn_run_unit(P, ldp, Kc, Vt, ATT, odd, nlat + x * 16 + w, nlat, lds, TID);
        }
        return;
    }
    for (int u = vcu; u < nlat + nctx; u += G) attn_run_unit(P, ldp, Kc, Vt, ATT, odd, u, nlat, lds, TID);
}
typedef float f32x4_t __attribute__((ext_vector_type(4)));
#define GLA_PITCH 144
__device__ __forceinline__ void ph_gla_chunk(const bf16* __restrict__ P, const float* __restrict__ w_af, const float* __restrict__ b_af,
                                             const float* __restrict__ w_ab, const float* __restrict__ b_ab, float* __restrict__ OF, float* __restrict__ OB, unsigned char* lds, int unit0, int ustride) {
    const int TID = opaque_tid(), BID = opaque_bid();
    const int tid = TID, lane = tid & 63, wid = tid >> 6, l15 = lane & 15, q4 = lane >> 4;
    float* SEG = (float*)lds;
    float* DEC = (float*)(lds + 2048);
    unsigned char* QD = lds + 4096;
    unsigned char* KI = QD + 9216;
    unsigned char* KET = KI + 9216;
    unsigned char* AT = KET + 9216;
    unsigned char* VT = AT + 9216;
    unsigned char* QRAW = VT + 18432;
    unsigned char* KRAW = QRAW + 9216;
    unsigned char* VRAW = KRAW + 9216;
    unsigned char* GRAW = VRAW + 64 * 272;
#define GLA_ROWS(ch_, rb_, rs_) do { if (!dir) { rb_ = (ch_) < 4 ? RL + b * CTX + (ch_) * 64 : b * SEQ + ((ch_) - 4) * 64; rs_ = 1; } \
        else { rb_ = (ch_) < 4 ? RL + b * CTX + (CTX - 1 - (ch_) * 64) : b * SEQ + (SEQ - 1 - ((ch_) - 4) * 64); rs_ = -1; } } while (0)
#define GLA_GLOAD(ch_) do { int rb_, rs_; GLA_ROWS(ch_, rb_, rs_); \
        const bf16* pq_ = P + (size_t)(rb_ + rs_ * (tid >> 3)) * EVEN_LDP + h * 64 + (tid & 7) * 8; rq = *(const uint4*)(pq_ + 1536); rk = *(const uint4*)(pq_ + 1792); \
        rv0 = *(const uint4*)(P + (size_t)(rb_ + rs_ * (tid >> 4)) * EVEN_LDP + 2048 + h * 128 + (tid & 15) * 8); \
        rv1 = *(const uint4*)(P + (size_t)(rb_ + rs_ * (32 + (tid >> 4))) * EVEN_LDP + 2048 + h * 128 + (tid & 15) * 8); \
        if (tid < 128) rg = *(const uint4*)(P + (size_t)(rb_ + rs_ * (tid >> 1)) * EVEN_LDP + 3072 + dir * 16 + (tid & 1) * 8); } while (0)
#define GLA_STAGE() do { *(uint4*)(QRAW + (tid >> 3) * GLA_PITCH + (tid & 7) * 16) = rq; *(uint4*)(KRAW + (tid >> 3) * GLA_PITCH + (tid & 7) * 16) = rk; \
        *(uint4*)(VRAW + (tid >> 4) * 272 + (tid & 15) * 16) = rv0; *(uint4*)(VRAW + (32 + (tid >> 4)) * 272 + (tid & 15) * 16) = rv1; \
        if (tid < 128) *(uint4*)(GRAW + (tid >> 1) * 32 + (tid & 1) * 16) = rg; } while (0)
    for (int unit = unit0; unit >= 0 && unit < NB * 4 * 2; unit += ustride) {
        const int dir = unit & 1, h = (unit >> 1) & 3, b = unit >> 3;
        const float* wa = dir ? w_ab : w_af; const float* ba = dir ? b_ab : b_af;
        float* Od = dir ? OB : OF;
        const int d = tid & 63, seg = tid >> 6;
        float wreg[16];
#pragma unroll
        for (int j = 0; j < 16; ++j) wreg[j] = wa[j * 256 + h * 64 + d];
        const float breg = ba[h * 64 + d];
        { unsigned z_; asm volatile("v_mov_b32 %0, 0" : "=v"(z_)); for (int i = tid; i < 9216 / 16; i += NT) ((uint4*)AT)[i] = make_uint4(z_, z_, z_, z_); }
        f32x4_t S[4];
#pragma unroll
        for (int i = 0; i < 4; ++i) S[i] = (f32x4_t){0.f, 0.f, 0.f, 0.f};
        uint4 rq, rk, rv0, rv1, rg = make_uint4(0u, 0u, 0u, 0u);
        GLA_GLOAD(0);
        GLA_STAGE();
        __syncthreads();
        for (int ch = 0; ch < KVLEN / 64; ++ch) {
            int rbase, rsgn;
            GLA_ROWS(ch, rbase, rsgn);
            if (ch + 1 < KVLEN / 64) GLA_GLOAD(ch + 1);
            float cl[8];
            {
                float run = 0.f;
#pragma unroll
                for (int i = 0; i < 8; ++i) {
                    const uint4 g0 = *(const uint4*)(GRAW + (8 * seg + i) * 32), g1 = *(const uint4*)(GRAW + (8 * seg + i) * 32 + 16);
                    const unsigned gw[8] = {g0.x, g0.y, g0.z, g0.w, g1.x, g1.y, g1.z, g1.w};
                    float z = breg;
#pragma unroll
                    for (int j = 0; j < 8; ++j) { z += __uint_as_float(gw[j] << 16) * wreg[2 * j]; z += __uint_as_float(gw[j] & 0xffff0000u) * wreg[2 * j + 1]; }
                    run += (fminf(z, 0.f) - __logf(1.f + __expf(-fabsf(z)))) * (1.f / 16.f);
                    cl[i] = run;
                }
                SEG[seg * 64 + d] = run;
            }
            __syncthreads();
            {
                float prefix = 0.f, total = 0.f;
#pragma unroll
                for (int s2 = 0; s2 < 8; ++s2) { const float v = SEG[s2 * 64 + d]; total += v; prefix += (s2 < seg) ? v : 0.f; }
                const float etot = __expf(total);
                if (seg == 0) DEC[d] = etot;
                unsigned kew[4];
#pragma unroll
                for (int i = 0; i < 8; ++i) {
                    const int c = 8 * seg + i;
                    const float qv = bf2f(*(const bf16*)(QRAW + c * GLA_PITCH + d * 2)) * 0.125f, kv = bf2f(*(const bf16*)(KRAW + c * GLA_PITCH + d * 2));
                    const float e = __expf(prefix + cl[i]), ei = __builtin_amdgcn_rcpf(e);
                    *(bf16*)(QD + c * GLA_PITCH + d * 2) = (bf16)f2bf(qv * e);
                    *(bf16*)(KI + c * GLA_PITCH + d * 2) = (bf16)f2bf(kv * ei);
                    const unsigned kb = f2bf(kv * (etot * ei));
                    if (i & 1) kew[i >> 1] |= kb << 16; else kew[i >> 1] = kb;
                }
                *(uint4*)(KET + d * GLA_PITCH + seg * 16) = make_uint4(kew[0], kew[1], kew[2], kew[3]);
                const int v = tid & 127, cg = tid >> 7;
                unsigned vw[8];
#pragma unroll
                for (int i = 0; i < 16; ++i) {
                    const unsigned x = *(const bf16*)(VRAW + (16 * cg + i) * 272 + v * 2);
                    if (i & 1) vw[i >> 1] |= x << 16; else vw[i >> 1] = x;
                }
                *(uint4*)(VT + v * GLA_PITCH + cg * 32) = make_uint4(vw[0], vw[1], vw[2], vw[3]);
                *(uint4*)(VT + v * GLA_PITCH + cg * 32 + 16) = make_uint4(vw[4], vw[5], vw[6], vw[7]);
            }
            __syncthreads();
            for (int blk = wid; blk < 10; blk += NWV) {
                int sblk, cblk;
                if (blk < 4) { sblk = 0; cblk = blk; } else if (blk < 7) { sblk = 1; cblk = blk - 3; } else if (blk < 9) { sblk = 2; cblk = blk - 5; } else { sblk = 3; cblk = 3; }
                f32x4_t acc = (f32x4_t){0.f, 0.f, 0.f, 0.f};
#pragma unroll
                for (int kk = 0; kk < 2; ++kk) {
                    const bf16x8 a = *(const bf16x8*)(KI + (16 * sblk + l15) * GLA_PITCH + 64 * kk + 16 * q4);
                    const bf16x8 bq = *(const bf16x8*)(QD + (16 * cblk + l15) * GLA_PITCH + 64 * kk + 16 * q4);
                    acc = __builtin_amdgcn_mfma_f32_16x16x32_bf16(a, bq, acc, 0, 0, 0);
                }
                const int c = 16 * cblk + l15, s0 = 16 * sblk + 4 * q4;
                float av[4];
#pragma unroll
                for (int r = 0; r < 4; ++r) av[r] = (s0 + r <= c) ? acc[r] : 0.f;
                *(uint2*)(AT + c * GLA_PITCH + s0 * 2) = make_uint2(pk2(av[0], av[1]), pk2(av[2], av[3]));
            }
            __syncthreads();
            {
                const int v0 = 16 * wid;
                bf16x8 bv[2], sB[2];
#pragma unroll
                for (int kk = 0; kk < 2; ++kk) {
                    bv[kk] = *(const bf16x8*)(VT + (v0 + l15) * GLA_PITCH + 64 * kk + 16 * q4);
                    uint4 w = make_uint4(pk2(S[2 * kk][0], S[2 * kk][1]), pk2(S[2 * kk][2], S[2 * kk][3]), pk2(S[2 * kk + 1][0], S[2 * kk + 1][1]), pk2(S[2 * kk + 1][2], S[2 * kk + 1][3]));
                    sB[kk] = __builtin_bit_cast(bf16x8, w);
                }
#pragma unroll
                for (int cblk = 0; cblk < 4; ++cblk) {
                    f32x4_t acc = (f32x4_t){0.f, 0.f, 0.f, 0.f};
                    const unsigned char* arow = AT + (16 * cblk + l15) * GLA_PITCH;
                    const unsigned char* qrow = QD + (16 * cblk + l15) * GLA_PITCH;
#pragma unroll
                    for (int kk = 0; kk < 2; ++kk) {
                        if (kk == 0 || cblk >= 2) {
                            const bf16x8 a = *(const bf16x8*)(arow + 64 * kk + 16 * q4);
                            acc = __builtin_amdgcn_mfma_f32_16x16x32_bf16(a, bv[kk], acc, 0, 0, 0);
                        }
                    }
#pragma unroll
                    for (int kk = 0; kk < 2; ++kk) {
                        const uint2 a0 = *(const uint2*)(qrow + 64 * kk + 8 * q4), a1 = *(const uint2*)(qrow + 64 * kk + 32 + 8 * q4);
                        uint4 aw = make_uint4(a0.x, a0.y, a1.x, a1.y);
                        acc = __builtin_amdgcn_mfma_f32_16x16x32_bf16(__builtin_bit_cast(bf16x8, aw), sB[kk], acc, 0, 0, 0);
                    }
#pragma unroll
                    for (int r = 0; r < 4; ++r) Od[(size_t)(rbase + rsgn * (16 * cblk + 4 * q4 + r)) * 512 + h * 128 + v0 + l15] = acc[r];
                }
#pragma unroll
                for (int dblk = 0; dblk < 4; ++dblk) {
#pragma unroll
                    for (int r = 0; r < 4; ++r) S[dblk][r] *= DEC[16 * dblk + 4 * q4 + r];
#pragma unroll
                    for (int kk = 0; kk < 2; ++kk) {
                        const bf16x8 a = *(const bf16x8*)(KET + (16 * dblk + l15) * GLA_PITCH + 64 * kk + 16 * q4);
                        S[dblk] = __builtin_amdgcn_mfma_f32_16x16x32_bf16(a, bv[kk], S[dblk], 0, 0, 0);
                    }
                }
            }
            if (ch + 1 < KVLEN / 64) GLA_STAGE();
            __syncthreads();
        }
    }
#undef GLA_ROWS
#undef GLA_GLOAD
#undef GLA_STAGE
}
__device__ __forceinline__ void ph_even_post(bf16* __restrict__ ATT, const float* __restrict__ lamv, const float* __restrict__ subln, float lam_init,
                             const float* __restrict__ OF, const float* __restrict__ OB, const bf16* __restrict__ P, const float* __restrict__ gain) {
    const int TID = opaque_tid(), BID = opaque_bid();
    int wave = BID * NWV + (TID >> 6), lane = TID & 63;
    int nw = gridDim.x * NWV;
    float p1 = lamv[lane] * lamv[64 + lane], p2 = lamv[128 + lane] * lamv[192 + lane];
    p1 = wave_sum(p1); p2 = wave_sum(p2);
    const float lam = expf(p1) - expf(p2) + lam_init;
    for (int r = wave; r < RT; r += nw) {
        bf16* a = ATT + (size_t)r * DM;
        float d[4][2];
#pragma unroll
        for (int h = 0; h < 4; ++h) {
            float2 o0 = ld2bf(a + (2 * h) * 128 + lane * 2);
            float2 o1 = ld2bf(a + (2 * h + 1) * 128 + lane * 2);
            d[h][0] = o0.x - lam * o1.x; d[h][1] = o0.y - lam * o1.y;
        }
        float2 outd[4];
#pragma unroll
        for (int h = 0; h < 4; ++h) {
            float s = wave_sum(d[h][0] * d[h][0] + d[h][1] * d[h][1]);
            float rstd = rsqrtf(s * (1.f / 128.f) + 1e-6f) * (1.f - lam_init);
            float2 sg = *(const float2*)(subln + lane * 2);
            outd[h] = make_float2(d[h][0] * rstd * sg.x, d[h][1] * rstd * sg.y);
        }
        float2 outg[4];
#pragma unroll
        for (int h = 0; h < 4; ++h) {
            float2 x = *(const float2*)(OF + (size_t)r * 512 + h * 128 + lane * 2);
            float2 c = *(const float2*)(OB + (size_t)r * 512 + h * 128 + lane * 2);
            float o0 = x.x + c.x, o1 = x.y + c.y;
            float s = wave_sum(o0 * o0 + o1 * o1);
            float rstd = rsqrtf(s * (1.f / 128.f) + 1e-6f);
            float2 g = *(const float2*)(gain + lane * 2);
            float2 rr = ld2bf(P + (size_t)r * EVEN_LDP + 2560 + h * 128 + lane * 2);
            outg[h] = make_float2(o0 * rstd * g.x * silu_f(rr.x), o1 * rstd * g.y * silu_f(rr.y));
        }
#pragma unroll
        for (int h = 0; h < 4; ++h) {
            st2bf(a + h * 128 + lane * 2, outd[h]);
            st2bf(a + 512 + h * 128 + lane * 2, outg[h]);
        }
    }
}
#define INS16(tv, ti, v, n) do { \
    _Pragma("unroll") for (int j_ = 15; j_ >= 1; --j_) { bool c1_ = (v) > tv[j_ - 1]; bool c2_ = (v) > tv[j_]; \
        tv[j_] = c1_ ? tv[j_ - 1] : (c2_ ? (v) : tv[j_]); ti[j_] = c1_ ? ti[j_ - 1] : (c2_ ? (n) : ti[j_]); } \
    { bool c_ = (v) > tv[0]; tv[0] = c_ ? (v) : tv[0]; ti[0] = c_ ? (n) : ti[0]; } } while (0)

__device__ __forceinline__ void ph_peer_ffn(const bf16* __restrict__ A2, const int* __restrict__ IDX, const float* __restrict__ GATE,
                            const float* __restrict__ U, const float* __restrict__ V, const float* __restrict__ mods_l, float* __restrict__ X) {
    const int TID = opaque_tid(), BID = opaque_bid();
    int wave = BID * NWV + (TID >> 6), lane = TID & 63;
    int nw = gridDim.x * NWV;
    for (int r = wave; r < RT; r += nw) {
        float4 xa[4], acc[4];
#pragma unroll
        for (int i = 0; i < 4; ++i) { xa[i] = ld4bf(A2 + (size_t)r * DM + 4 * (lane + 64 * i)); acc[i] = make_float4(0.f, 0.f, 0.f, 0.f); }
        for (int e = 0; e < 128; ++e) {
            int id = IDX[(size_t)r * 128 + e]; float g = GATE[(size_t)r * 128 + e];
            const float4* ur = (const float4*)(U + (size_t)id * DM);
            float d = 0.f;
#pragma unroll
            for (int i = 0; i < 4; ++i) { float4 u = ur[lane + 64 * i]; d += u.x * xa[i].x + u.y * xa[i].y + u.z * xa[i].z + u.w * xa[i].w; }
            d = wave_sum(d);
            float w = g * gelu_tanh(d);
            const float4* vr = (const float4*)(V + (size_t)id * DM);
#pragma unroll
            for (int i = 0; i < 4; ++i) { float4 v = vr[lane + 64 * i]; acc[i].x += w * v.x; acc[i].y += w * v.y; acc[i].z += w * v.z; acc[i].w += w * v.w; }
        }
        const float4* g5 = (const float4*)(mods_l + (size_t)row_mod(r) * MODW + 5 * DM);
        float4* xr = (float4*)(X + (size_t)r * DM);
#pragma unroll
        for (int i = 0; i < 4; ++i) { float4 x = xr[lane + 64 * i], gg = g5[lane + 64 * i];
            x.x += gg.x * acc[i].x; x.y += gg.y * acc[i].y; x.z += gg.z * acc[i].z; x.w += gg.w * acc[i].w; xr[lane + 64 * i] = x; }
    }
}
#define RT_KPITCH 144
#define INSP16(t, x) do { unsigned x_ = (x); _Pragma("unroll") for (int j_ = 0; j_ < 16; ++j_) { const unsigned h_ = max(t[j_], x_); x_ = min(t[j_], x_); t[j_] = h_; } } while (0)
__device__ __forceinline__ void ph_route_mfma(const bf16* __restrict__ Qp, const bf16* __restrict__ Kb, int* __restrict__ IDX, float* __restrict__ GATE, unsigned char* lds, int nrows) {
    const int TID = opaque_tid(), BID = opaque_bid();
    const int tid = TID, lane = tid & 63, wid = tid >> 6, r32 = lane & 31, hi = lane >> 5;
    for (int u = BID; u < (nrows / 256) * 8; u += gridDim.x) {
        const int h = u & 7, row = (u >> 3) * 256 + wid * 32 + r32;
        __syncthreads();
        for (int i = tid; i < 2 * 128 * 8; i += NT) *(uint4*)(lds + (i >> 3) * RT_KPITCH + (i & 7) * 16) = *(const uint4*)(Kb + ((size_t)h * 256 + (i >> 3)) * 64 + (i & 7) * 8);
        __syncthreads();
        unsigned L[2][16];
#pragma unroll
        for (int half = 0; half < 2; ++half) {
            bf16x8 qf[4];
            const bf16* qrow = Qp + (size_t)row * DM + h * 128 + half * 64;
#pragma unroll
            for (int s = 0; s < 4; ++s) qf[s] = *(const bf16x8*)(qrow + 16 * s + 8 * hi);
#pragma unroll
            for (int j = 0; j < 16; ++j) L[half][j] = 0u;
#pragma unroll
            for (int nb = 0; nb < 4; ++nb) {
                f32x16 acc;
#pragma unroll
                for (int r = 0; r < 16; ++r) acc[r] = 0.f;
#pragma unroll
                for (int s = 0; s < 4; ++s) {
                    const bf16x8 a = *(const bf16x8*)(lds + (half * 128 + 32 * nb + r32) * RT_KPITCH + 32 * s + 16 * hi);
                    acc = __builtin_amdgcn_mfma_f32_32x32x16_bf16(a, qf[s], acc, 0, 0, 0);
                }
#pragma unroll
                for (int r = 0; r < 16; ++r) {
                    unsigned ub = __float_as_uint(acc[r]);
                    ub = (ub & 0x80000000u) ? ~ub : (ub | 0x80000000u);
                    const unsigned x = (ub & ~127u) | (unsigned)(127 - (32 * nb + (r & 3) + 8 * (r >> 2)) - 4 * hi);
                    INSP16(L[half], x);
                }
                __builtin_amdgcn_sched_barrier(0);
            }
            unsigned o[16];
#pragma unroll
            for (int j = 0; j < 16; ++j) o[j] = __shfl_xor(L[half][j], 32);
#pragma unroll
            for (int j = 0; j < 16; ++j) INSP16(L[half], o[j]);
            __builtin_amdgcn_sched_barrier(0);
        }
        float v1[16], v2[16];
        {
            unsigned w1[4] = {0u, 0u, 0u, 0u}, w2[4] = {0u, 0u, 0u, 0u};
#pragma unroll
            for (int j = 0; j < 16; ++j) {
                unsigned a = L[0][j] & ~127u, b = L[1][j] & ~127u;
                a = (a & 0x80000000u) ? (a & 0x7fffffffu) : ~a; b = (b & 0x80000000u) ? (b & 0x7fffffffu) : ~b;
                v1[j] = __uint_as_float(a); v2[j] = __uint_as_float(b);
                w1[j >> 2] |= (127u - (L[0][j] & 127u)) << (8 * (j & 3)); w2[j >> 2] |= (127u - (L[1][j] & 127u)) << (8 * (j & 3));
            }
            unsigned char* sb = lds + 2 * 128 * RT_KPITCH + tid * 4;
#pragma unroll
            for (int k = 0; k < 4; ++k) { *(unsigned*)(sb + k * 2048) = w1[k]; *(unsigned*)(sb + (4 + k) * 2048) = w2[k]; }
        }
        unsigned T[16];
#pragma unroll
        for (int j = 0; j < 16; ++j) T[j] = 0u;
#pragma unroll
        for (int a = 0; a < 16; ++a)
#pragma unroll
            for (int b = 0; b < 16; ++b) {
                if ((a + 1) * (b + 1) <= 16) {
                    unsigned ub = __float_as_uint(v1[a] + v2[b]);
                    ub = (ub & 0x80000000u) ? ~ub : (ub | 0x80000000u);
                    const unsigned x = (ub & ~255u) | (unsigned)(255 - (16 * a + b));
                    INSP16(T, x);
                }
            }
        float e[16]; int bi[16]; float sum = 0.f, v0 = 0.f;
        {
            const unsigned char* sb = lds + 2 * 128 * RT_KPITCH + tid * 4;
#pragma unroll
            for (int j = 0; j < 16; ++j) {
                unsigned ub = T[j] & ~255u;
                ub = (ub & 0x80000000u) ? (ub & 0x7fffffffu) : ~ub;
                const float val = __uint_as_float(ub);
                if (j == 0) v0 = val;
                e[j] = __expf(val - v0); sum += e[j];
                const unsigned flat = 255u - (T[j] & 255u), ca = flat >> 4, cb = flat & 15u;
                const unsigned ia = *(const unsigned char*)(sb + (ca >> 2) * 2048 + (ca & 3)), ib = *(const unsigned char*)(sb + (4 + (cb >> 2)) * 2048 + (cb & 3));
                bi[j] = (int)(ia * 128u + ib);
            }
        }
        const float inv = 1.f / sum;
        if (hi == 0) {
            int* ip = IDX + (size_t)row * 128 + h * 16; float* gp = GATE + (size_t)row * 128 + h * 16;
#pragma unroll
            for (int j = 0; j < 4; ++j) {
                *(int4*)(ip + 4 * j) = make_int4(bi[4 * j], bi[4 * j + 1], bi[4 * j + 2], bi[4 * j + 3]);
                *(float4*)(gp + 4 * j) = make_float4(e[4 * j] * inv, e[4 * j + 1] * inv, e[4 * j + 2] * inv, e[4 * j + 3] * inv);
            }
        }
    }
    __syncthreads();
}
__device__ __forceinline__ unsigned fp6_e2m3(float v) {
    const float a = fabsf(v);
    float c;
    if (a < 2.f) c = rintf(a * 8.f);
    else if (a < 4.f) c = 16.f + rintf((a - 2.f) * 4.f);
    else c = fminf(24.f + rintf((a - 4.f) * 2.f), 31.f);
    return (unsigned)c | (v < 0.f ? 32u : 0u);
}
__device__ __forceinline__ void ph_table_prep(const float* __restrict__ U, const float* __restrict__ V, unsigned char* __restrict__ T6, float* __restrict__ RS) {
    const int TID = opaque_tid(), BID = opaque_bid();
    const int wave = BID * NWV + (TID >> 6), lane = TID & 63, nw = gridDim.x * NWV;
    const int NROWS = DEPTH * 16384;
    for (int rr = wave; rr < 2 * NROWS; rr += nw) {
        const float* src = (rr < NROWS ? U : V) + (size_t)(rr < NROWS ? rr : rr - NROWS) * DM + lane * 16;
        float4 v[4]; float am = 0.f;
#pragma unroll
        for (int i = 0; i < 4; ++i) { v[i] = ((const float4*)src)[i]; am = fmaxf(am, fmaxf(fmaxf(fabsf(v[i].x), fabsf(v[i].y)), fmaxf(fabsf(v[i].z), fabsf(v[i].w)))); }
#pragma unroll
        for (int o = 1; o < 64; o <<= 1) am = fmaxf(am, __shfl_xor(am, o));
        am = fmaxf(am, 1e-30f);
        const float sc = exp2f(floorf(log2f(7.5f / am)));
        unsigned e[16];
#pragma unroll
        for (int i = 0; i < 4; ++i) { e[4 * i] = fp6_e2m3(v[i].x * sc); e[4 * i + 1] = fp6_e2m3(v[i].y * sc); e[4 * i + 2] = fp6_e2m3(v[i].z * sc); e[4 * i + 3] = fp6_e2m3(v[i].w * sc); }
        const unsigned d0 = e[0] | (e[1] << 6) | (e[2] << 12) | (e[3] << 18) | (e[4] << 24) | (e[5] << 30);
        const unsigned d1 = (e[5] >> 2) | (e[6] << 4) | (e[7] << 10) | (e[8] << 16) | (e[9] << 22) | (e[10] << 28);
        const unsigned d2 = (e[10] >> 4) | (e[11] << 2) | (e[12] << 8) | (e[13] << 14) | (e[14] << 20) | (e[15] << 26);
        unsigned* dst = (unsigned*)(T6 + (size_t)rr * 768 + lane * 12);
        dst[0] = d0; dst[1] = d1; dst[2] = d2;
        if (lane == 0) RS[rr] = 1.f / sc;
    }
}
typedef unsigned v6u32_t __attribute__((ext_vector_type(6)));
typedef float v32f_t __attribute__((ext_vector_type(32)));
typedef __bf16 v32bf_t __attribute__((ext_vector_type(32)));
typedef unsigned v16u_t __attribute__((ext_vector_type(16)));
struct u3 { unsigned x, y, z; };
#define BR4(j) ((((j) & 1) << 3) | (((j) & 2) << 1) | (((j) & 4) >> 1) | (((j) & 8) >> 3))
__device__ __forceinline__ void ph_peer_ffn8(const bf16* A2, const int* __restrict__ IDX, const float* __restrict__ GATE,
                            const unsigned char* __restrict__ U8, const float* __restrict__ RSU, const unsigned char* __restrict__ V8, const float* __restrict__ RSV,
                            const float* __restrict__ mods_l, const float* X, float* Xout, int nrows,
                            const float* __restrict__ gnext, const float* __restrict__ mods_next, bf16* Anext) {
    const int TID = opaque_tid(), BID = opaque_bid();
    const int wave = BID * NWV + (TID >> 6), lane = TID & 63, nw = gridDim.x * NWV;
    const int jl = BR4(lane & 15);
    const unsigned lane12 = (unsigned)lane * 12u;
    for (int r = wave; r < nrows; r += nw) {
        float xf[16];
        { int lx = lane; asm volatile("" : "+v"(lx)); const uint4* xp = (const uint4*)(A2 + (size_t)r * DM + lx * 16); const uint4 a = xp[0], b = xp[1]; const unsigned xw[8] = {a.x, a.y, a.z, a.w, b.x, b.y, b.z, b.w};
#pragma unroll
          for (int i = 0; i < 8; ++i) { xf[2 * i] = __uint_as_float(xw[i] << 16); xf[2 * i + 1] = __uint_as_float(xw[i] & 0xffff0000u); } }
        float acc[16];
#pragma unroll
        for (int k = 0; k < 16; ++k) acc[k] = 0.f;
        for (int g = 0; g < 8; ++g) {
            const int myid = IDX[(size_t)r * 128 + g * 16 + jl];
            u3 ub[16], vb[16];
#pragma unroll
            for (int j = 0; j < 16; ++j) { unsigned idv; asm volatile("v_mov_b32 %0, %1" : "=v"(idv) : "s"(__builtin_amdgcn_readlane(myid, BR4(j)))); ub[j] = *(const u3*)(U8 + (idv * 768u + lane12)); }
#pragma unroll
            for (int j = 0; j < 16; ++j) { unsigned idv; asm volatile("v_mov_b32 %0, %1" : "=v"(idv) : "s"(__builtin_amdgcn_readlane(myid, BR4(j)))); vb[j] = *(const u3*)(V8 + (idv * 768u + lane12)); }
            float d[16];
#pragma unroll
            for (int j = 0; j < 16; j += 2) {
                const v6u32_t src = {ub[j].x, ub[j].y, ub[j].z, ub[j + 1].x, ub[j + 1].y, ub[j + 1].z};
                const v32f_t f = __builtin_amdgcn_cvt_scalef32_pk32_f32_fp6(src, 1.0f);
                float d0 = 0.f, d1 = 0.f;
#pragma unroll
                for (int k = 0; k < 16; ++k) { d0 = __builtin_fmaf(f[k], xf[k], d0); d1 = __builtin_fmaf(f[16 + k], xf[k], d1); }
                d[j] = d0; d[j + 1] = d1;
                __builtin_amdgcn_sched_barrier(0);
            }
#pragma unroll
            for (int st = 0; st < 4; ++st) {
                const int n = 8 >> st, bit = 1 << st;
                const bool up = (lane & bit) != 0;
#pragma unroll
                for (int i = 0; i < 8; ++i) if (i < n) {
                    const float send = up ? d[i] : d[i + n], keep = up ? d[i + n] : d[i];
                    d[i] = keep + __shfl_xor(send, bit);
                }
            }
            float tot = d[0];
            tot += __shfl_xor(tot, 16); tot += __shfl_xor(tot, 32);
            const float w = GATE[(size_t)r * 128 + g * 16 + jl] * gelu_tanh(tot * RSU[myid]) * RSV[myid];
#pragma unroll
            for (int j = 0; j < 16; j += 2) {
                const float w0 = __int_as_float(__builtin_amdgcn_readlane(__float_as_int(w), BR4(j))), w1 = __int_as_float(__builtin_amdgcn_readlane(__float_as_int(w), BR4(j + 1)));
                const v6u32_t src = {vb[j].x, vb[j].y, vb[j].z, vb[j + 1].x, vb[j + 1].y, vb[j + 1].z};
                const v32f_t f = __builtin_amdgcn_cvt_scalef32_pk32_f32_fp6(src, 1.0f);
#pragma unroll
                for (int k = 0; k < 16; ++k) { acc[k] = __builtin_fmaf(w0, f[k], acc[k]); acc[k] = __builtin_fmaf(w1, f[16 + k], acc[k]); }
                __builtin_amdgcn_sched_barrier(0);
            }
        }
        int re = __builtin_amdgcn_readfirstlane(r); asm volatile("" : "+s"(re)); int le = lane; asm volatile("" : "+v"(le));
        const float4* g5 = (const float4*)(mods_l + (size_t)row_mod(re) * MODW + 5 * DM + le * 16);
        const float4* xr = (const float4*)(X + (size_t)re * DM + le * 16);
        float4 xn[4]; float ss = 0.f;
#pragma unroll
        for (int i = 0; i < 4; ++i) { float4 xv = xr[i], gg = g5[i];
            xv.x += gg.x * acc[4 * i]; xv.y += gg.y * acc[4 * i + 1]; xv.z += gg.z * acc[4 * i + 2]; xv.w += gg.w * acc[4 * i + 3]; xn[i] = xv;
            ss += xv.x * xv.x + xv.y * xv.y + xv.z * xv.z + xv.w * xv.w; }
        float4* xo = (float4*)(Xout + (size_t)re * DM + le * 16);
#pragma unroll
        for (int i = 0; i < 4; ++i) xo[i] = xn[i];
        if (gnext) {
            const float rstd = rsqrtf(wave_sum(ss) * (1.f / DM) + 1e-6f);
            const float* mn = mods_next + (size_t)row_mod(re) * MODW + le * 16;
            bf16* ar = Anext + (size_t)re * DM + le * 16;
#pragma unroll
            for (int i = 0; i < 4; ++i) {
                const float4 gg = ((const float4*)(gnext + le * 16))[i], sh = ((const float4*)mn)[i], sc = ((const float4*)(mn + DM))[i];
                float4 o;
                o.x = xn[i].x * rstd * gg.x * (1.f + sc.x) + sh.x; o.y = xn[i].y * rstd * gg.y * (1.f + sc.y) + sh.y;
                o.z = xn[i].z * rstd * gg.z * (1.f + sc.z) + sh.z; o.w = xn[i].w * rstd * gg.w * (1.f + sc.w) + sh.w;
                st4bf(ar + 4 * i, o);
            }
        }
    }
}
template <int N>
__device__ __forceinline__ void ph_gemm_bf16(const bf16* A, const bf16* Bt, bf16* O, unsigned char* lds) {
    pg8::Gemm g{A, Bt, RT, N, DM}; pg8::StaticOrder S; S.init(RT, N, (int)gridDim.x, opaque_bid());
    pg8::EpiBf16<0> E{O, N, nullptr, 0, 0, 1.f};
    pg8::gemm_phase<pg8::EpiBf16<0>, pg8::StaticOrder, true, true>((PG8_LAS unsigned char*)lds, g, S, E);
}
__device__ __forceinline__ void ph_gemm_res(const bf16* A, const bf16* Bt, float* X, const float* gate, unsigned char* lds) {
    pg8::Gemm g{A, Bt, RT, DM, DM}; pg8::StaticOrder S; S.init(RT, DM, (int)gridDim.x, opaque_bid());
    EpiResGate E{X, gate};
    pg8::gemm_phase<EpiResGate, pg8::StaticOrder, true, true>((PG8_LAS unsigned char*)lds, g, S, E);
}

#define XB_TMO      128
#define XB_XCNT(j)  (256  + 64 * (j))
#define XB_XSUB(j)  (1280 + 64 * (j))
#define XB_XGEN(j)  (2304 + 64 * (j))
#define XB_TOP      3328
#define XB_TOPGEN   3392
#define XCD_BAR_WORDS 3456
#define XB_SPIN_CAP (1u << 18)

__device__ __forceinline__ unsigned xb_ld(unsigned* p)              { return __hip_atomic_load(p, __ATOMIC_RELAXED, __HIP_MEMORY_SCOPE_AGENT); }
__device__ __forceinline__ unsigned xb_add(unsigned* p, unsigned v) { return __hip_atomic_fetch_add(p, v, __ATOMIC_RELAXED, __HIP_MEMORY_SCOPE_AGENT); }
__device__ __forceinline__ unsigned xb_xcc_id() { return (unsigned)__builtin_amdgcn_s_getreg((3 << 11) | 20) & 0xFu; }
#define XB_SPIN(cond, bar) do { unsigned _sp = 0; while (cond) { __builtin_amdgcn_s_sleep(1); \
    if ((++_sp & 255u) == 0u) { if (xb_ld(&(bar)[XB_TMO])) break; if (_sp > XB_SPIN_CAP) { atomicAdd(&(bar)[XB_TMO], 1u); break; } } } } while (0)

struct XcdBarrier {
    unsigned* bar; unsigned x;
    volatile LAS unsigned* st;
};

__device__ __forceinline__ XcdBarrier xcd_barrier_post(unsigned* bar, volatile LAS unsigned* st) {
    XcdBarrier b; b.bar = bar; b.x = xb_xcc_id(); b.st = st;
    if (threadIdx.x == 0) (void)xb_add(&bar[XB_XCNT(b.x)], 1u);
    return b;
}
__device__ __forceinline__ void xcd_barrier_complete(unsigned* bar, unsigned x, unsigned& nloc, unsigned& nx) {
    const unsigned G = gridDim.x * gridDim.y * gridDim.z;
    unsigned sum, cnt, mine, sp = 0u;
    for (;;) {
        sum = 0u; cnt = 0u; mine = 0u;
#pragma unroll
        for (unsigned j = 0; j < 16; ++j) { const unsigned c = xb_ld(&bar[XB_XCNT(j)]); sum += c; cnt += (c > 0u) ? 1u : 0u; mine = (j == x) ? c : mine; }
        if (sum == G) break;
        __builtin_amdgcn_s_sleep(1);
        if ((++sp & 255u) == 0u) { if (xb_ld(&bar[XB_TMO])) break; if (sp > XB_SPIN_CAP) { atomicAdd(&bar[XB_TMO], 1u); break; } }
    }
    nloc = mine > 0u ? mine : 1u; nx = cnt > 0u ? cnt : 1u;
}

__device__ __forceinline__ void xcd_barrier(const XcdBarrier& b) {
    asm volatile("s_waitcnt vmcnt(0)" ::: "memory");
    __syncthreads();
    if (threadIdx.x == 0) {
        unsigned* bar = b.bar;
        __builtin_amdgcn_s_waitcnt(0);
        unsigned nloc = b.st[0], nx = b.st[1];
        if (nloc == 0u) { xcd_barrier_complete(bar, b.x, nloc, nx); b.st[0] = nloc; b.st[1] = nx; }
        const unsigned old = xb_add(&bar[XB_XSUB(b.x)], 1u);
        const unsigned gen = old / nloc;
        if (old + 1u == (gen + 1u) * nloc) {
            __builtin_amdgcn_fence(__ATOMIC_RELEASE, "agent");
            asm volatile("s_waitcnt vmcnt(0)" ::: "memory");
            const unsigned og = xb_add(&bar[XB_TOP], 1u);
            const unsigned tg = og / nx;
            if (og + 1u == (tg + 1u) * nx) xb_add(&bar[XB_TOPGEN], 1u);
            else XB_SPIN(xb_ld(&bar[XB_TOPGEN]) == tg, bar);
            __builtin_amdgcn_fence(__ATOMIC_ACQUIRE, "agent");
            xb_add(&bar[XB_XGEN(b.x)], 1u);
            asm volatile("s_waitcnt vmcnt(0)" ::: "memory");
        } else {
            XB_SPIN(xb_ld(&bar[XB_XGEN(b.x)]) == gen, bar);
            __builtin_amdgcn_fence(__ATOMIC_ACQUIRE, "agent");
            asm volatile("s_waitcnt vmcnt(0)" ::: "memory");
        }
    }
    __syncthreads();
}

constexpr size_t ALIGN_UP(size_t x) { return (x + 255) & ~(size_t)255; }
constexpr size_t WS_X = 0;
constexpr size_t WS_A = WS_X + (size_t)RT * DM * 4;
constexpr size_t WS_P = WS_A + (size_t)RT * DM * 2;
constexpr size_t WS_ATT = WS_P + (size_t)RT * EVEN_LDP * 2;
constexpr size_t WS_OF = WS_ATT + (size_t)RT * DM * 2;
constexpr size_t WS_MODS = WS_OF + (size_t)RT * 512 * 4 * 2;
constexpr size_t WS_ROPE = WS_MODS + ALIGN_UP((size_t)DEPTH * NMOD * MODW * 4);
constexpr size_t WS_WINE = WS_ROPE + (size_t)SEQ * 32 * 8;
constexpr size_t WS_WOUTE = WS_WINE + (size_t)2 * EVEN_LDP * DM * 2;
constexpr size_t WS_WINO = WS_WOUTE + (size_t)2 * DM * DM * 2;
constexpr size_t WS_WOUTO = WS_WINO + (size_t)2 * ODD_IN * DM * 2;
constexpr size_t WS_WPQ = WS_WOUTO + (size_t)2 * DM * DM * 2;
constexpr size_t WS_T8 = WS_WPQ + (size_t)4 * DM * DM * 2;
constexpr size_t WS_RS = WS_T8 + (size_t)2 * DEPTH * 16384 * DM;
constexpr size_t WS_KC = WS_RS + (size_t)2 * DEPTH * 16384 * 4;
constexpr size_t WS_VT = WS_KC + (size_t)NB * 8 * KVLEN * 64 * 2;
constexpr size_t WS_KEYS = WS_VT + (size_t)NB * 4 * 128 * KVLEN * 2;
constexpr size_t WS_BAR = WS_KEYS + (size_t)DEPTH * 8 * 2 * 128 * 64 * 2;
constexpr size_t WS_BAR_BYTES = 16384;
constexpr size_t WS_END = WS_BAR + WS_BAR_BYTES;

__global__ void __launch_bounds__(NT, 2) mega(Params p) {
    extern __shared__ __attribute__((aligned(16))) unsigned char lds[];
    float* smem = (float*)lds;
    cg::grid_group grid = cg::this_grid();
    unsigned char* ws = p.ws;
    volatile LAS unsigned* bst = (volatile LAS unsigned*)((LAS unsigned char*)lds + 131072 + 512);
    if (threadIdx.x < 2) bst[threadIdx.x] = 0u;
    __syncthreads();
    (void)xcd_barrier_post((unsigned*)(ws + WS_BAR), bst);
#define GSYNC() do { XcdBarrier b_; b_.bar = (unsigned*)(ws + WS_BAR); b_.x = xb_xcc_id(); b_.st = (volatile LAS unsigned*)((LAS unsigned char*)lds + 131072 + 512); xcd_barrier(b_); } while (0)
#define X_ ((float*)(ws + WS_X))
#define A_ ((bf16*)(ws + WS_A))
#define P_ ((bf16*)(ws + WS_P))
#define ATT_ ((bf16*)(ws + WS_ATT))
#define OF_ ((float*)(ws + WS_OF))
#define OB_ (OF_ + (size_t)RT * 512)
#define MODS_ ((float*)(ws + WS_MODS))
#define ROPE_ ((float2*)(ws + WS_ROPE))
#define WINE_ ((bf16*)(ws + WS_WINE))
#define WOUTE_ ((bf16*)(ws + WS_WOUTE))
#define WINO_ ((bf16*)(ws + WS_WINO))
#define WOUTO_ ((bf16*)(ws + WS_WOUTO))
#define WPQ_ ((bf16*)(ws + WS_WPQ))
#define QP_ P_
#define KEYS_ ((bf16*)(ws + WS_KEYS))
#define KC_ ((bf16*)(ws + WS_KC))
#define VT_ ((bf16*)(ws + WS_VT))
#define T8_ (ws + WS_T8)
#define RS_ ((float*)(ws + WS_RS))
#define IDX_ ((int*)(ws + WS_P + (size_t)RT * DM * 2))
#define GATE_ ((float*)(ws + WS_P + (size_t)RT * DM * 2 + (size_t)RT * 128 * 4))

    ph_copy_in(p.in[0], p.in[2], X_);
    ph_rope_table(ROPE_);
    ph_weight_prep(p.in, WINE_, WOUTE_, WINO_, WOUTO_, WPQ_, KEYS_, lds);
    ph_table_prep(p.in[25], p.in[26], T8_, RS_);
    __syncthreads();
    ph_mods(p.in[1], p.in[3], p.in[4], p.in[5], MODS_, smem);
    grid.sync();
    ph_norm_mod(X_, p.in[6], MODS_, 0, A_);
    GSYNC();
    for (int hl = 0; hl < 2 * DEPTH; ++hl) {
        ws = p.ws; asm volatile("" : "+s"(ws));
        const int l = hl >> 1, part = hl & 1, i = l >> 1, odd = l & 1;
        const float* mods_l = MODS_ + (size_t)l * NMOD * MODW;
        if (part) {
            ph_norm_mod(X_, p.in[7] + l * DM, mods_l, 3, A_);
            GSYNC();
        }
        if (part) ph_gemm_bf16<DM>(A_, WPQ_ + (size_t)l * DM * DM, P_, lds);
        else if (odd) ph_gemm_bf16<ODD_IN>(A_, WINO_ + (size_t)i * ODD_IN * DM, P_, lds);
        else ph_gemm_bf16<EVEN_LDP>(A_, WINE_ + (size_t)i * EVEN_LDP * DM, P_, lds);
        GSYNC();
        if (part == 0) {
            const int ldp = odd ? ODD_IN : EVEN_LDP;
            ph_post(P_, ldp, odd ? 16 : 8, odd ? 1024 : 512, odd ? 4 : 8, odd ? 1280 : 1024, odd ? 256 : 512, odd ? 64 : 128,
                    (odd ? p.in[21] : p.in[10]) + i * 64, (odd ? p.in[22] : p.in[11]) + i * 64, ROPE_, KC_, VT_);
            GSYNC();
            if (!odd) {
                const int G_ = (int)gridDim.x, bid_ = (int)blockIdx.x;
                const int gu = (G_ == 256) ? (((bid_ >> 3) < 16) ? (bid_ & 7) * 16 + (bid_ >> 3) : -1) : bid_;
                ph_gla_chunk(P_, p.in[14] + i * 16 * 256, p.in[15] + i * 256, p.in[16] + i * 16 * 256, p.in[17] + i * 256, OF_, OB_, lds, gu, (G_ == 256) ? 1 << 20 : G_);
            }
            ph_attn_mfma(P_, ldp, KC_, VT_, ATT_, odd, l < DEPTH - 1, lds);
            GSYNC();
            if (!odd) {
                const float lam_init = 0.8f - 0.6f * expf(-0.3f * (float)l);
                ph_even_post(ATT_, p.in[12] + i * 256, p.in[13] + i * 128, lam_init, OF_, OB_, P_, p.in[18] + i * 128);
                GSYNC();
            }
            ph_gemm_res(ATT_, odd ? WOUTO_ + (size_t)i * DM * DM : WOUTE_ + (size_t)i * DM * DM, X_, mods_l + 2 * DM, lds);
            GSYNC();
        } else {
            const int last = (l == DEPTH - 1);
            const int nrows = last ? RL : RT;
            ph_route_mfma(QP_, KEYS_ + (size_t)l * 8 * 2 * 128 * 64, IDX_, GATE_, lds, nrows);
            GSYNC();
            ph_peer_ffn8(A_, IDX_, GATE_, T8_ + (size_t)l * 16384 * 768, RS_ + l * 16384, T8_ + (size_t)(DEPTH + l) * 16384 * 768, RS_ + (DEPTH + l) * 16384, mods_l,
                         X_, last ? p.out : X_, nrows, last ? nullptr : p.in[6] + (l + 1) * DM, mods_l + NMOD * MODW, A_);
            if (!last) GSYNC();
        }
    }
}

extern "C" void kernel_launch(void* const* d_in, const int* in_sizes, int n_in, void* d_out, int out_size, void* d_ws, size_t ws_size, hipStream_t stream) {
    static int grid_blocks = 0;
    if (!grid_blocks) {
        int dev = 0, cus = 0, per_cu = 0;
        (void)hipGetDevice(&dev);
        (void)hipDeviceGetAttribute(&cus, hipDeviceAttributeMultiprocessorCount, dev);
        (void)hipFuncSetAttribute((const void*)mega, hipFuncAttributeMaxDynamicSharedMemorySize, LDS_BYTES);
        (void)hipOccupancyMaxActiveBlocksPerMultiprocessor(&per_cu, mega, NT, LDS_BYTES);
        if (per_cu < 1) fprintf(stderr, "occupancy query says %d blocks/CU\n", per_cu);
        grid_blocks = cus;
        if (ws_size < WS_END) fprintf(stderr, "workspace too small: %zu < %zu\n", ws_size, (size_t)WS_END);
    }
    (void)hipMemsetAsync((unsigned char*)d_ws + WS_BAR, 0, WS_BAR_BYTES, stream);
    Params p{};
    for (int i = 0; i < 27; ++i) p.in[i] = (const float*)d_in[i];
    p.out = (float*)d_out; p.ws = (unsigned char*)d_ws;
    void* args[] = {&p};
    hipError_t e = hipLaunchCooperativeKernel((void*)mega, dim3(grid_blocks), dim3(NT), args, LDS_BYTES, stream);
    if (e != hipSuccess) fprintf(stderr, "cooperative launch failed: %s (grid %d)\n", hipGetErrorString(e), grid_blocks);
}
```

```cpp
#include <hip/hip_runtime.h>
#include <hip/hip_cooperative_groups.h>
#include <stdint.h>
#include <cstdio>
namespace cg = cooperative_groups;

#define DM 1024
#define NB 16
#define SEQ 2048
#define CTX 256
#define RL (NB * SEQ)
#define RC (NB * CTX)
#define RT (RL + RC)
#define DEPTH 4
#define EVEN_IN 3104
#define EVEN_LDP 3328
#define ODD_IN 1536
#define NMOD 17
#define MODW 6144
#define NT 512
#define NWV 8
#define LDS_BYTES 147456
#ifndef DUP_FFN
#define DUP_FFN 0
#endif
#ifndef DUP_ROUTE
#define DUP_ROUTE 0
#endif
#ifndef DUP_ATTN
#define DUP_ATTN 0
#endif
#ifndef DUP_GEMM
#define DUP_GEMM 0
#endif

typedef unsigned short bf16;
typedef float f32x2_t __attribute__((ext_vector_type(2)));
typedef __bf16 bf16x2_t __attribute__((ext_vector_type(2)));
struct Params {
    const float* in[27];
    float* out;
    unsigned char* ws;
};

__device__ __forceinline__ int row_mod(int r) { return r < RL ? (r >> 11) : 16; }
__device__ __forceinline__ float silu_f(float x) { return x / (1.f + expf(-x)); }
__device__ __forceinline__ float wave_sum(float v) {
#pragma unroll
    for (int o = 1; o < 64; o <<= 1) v += __shfl_xor(v, o);
    return v;
}
__device__ __forceinline__ float log_sigmoid_f(float z) { return fminf(z, 0.f) - log1pf(expf(-fabsf(z))); }
__device__ __forceinline__ float gelu_tanh(float x) { float u = 0.7978845608028654f * (x + 0.044715f * x * x * x); return 0.5f * x * (1.f + tanhf(u)); }
__device__ __forceinline__ float bf2f(bf16 v) { return __uint_as_float((unsigned)v << 16); }
__device__ __forceinline__ unsigned f2bf(float f) { unsigned u = __float_as_uint(f); return (u + 0x7fffu + ((u >> 16) & 1u)) >> 16; }
__device__ __forceinline__ unsigned pk2(float lo, float hi) { return f2bf(lo) | (f2bf(hi) << 16); }
__device__ __forceinline__ float4 ld4bf(const bf16* p) { uint2 u = *(const uint2*)p; return make_float4(__uint_as_float(u.x << 16), __uint_as_float(u.x & 0xffff0000u), __uint_as_float(u.y << 16), __uint_as_float(u.y & 0xffff0000u)); }
__device__ __forceinline__ void st4bf(bf16* p, float4 v) { *(uint2*)p = make_uint2(pk2(v.x, v.y), pk2(v.z, v.w)); }
__device__ __forceinline__ float2 ld2bf(const bf16* p) { unsigned u = *(const unsigned*)p; return make_float2(__uint_as_float(u << 16), __uint_as_float(u & 0xffff0000u)); }
__device__ __forceinline__ void st2bf(bf16* p, float2 v) { *(unsigned*)p = pk2(v.x, v.y); }

__device__ __forceinline__ int opaque_tid() { int t = threadIdx.x; asm volatile("" : "+v"(t)); return t; }
__device__ __forceinline__ int opaque_bid() { int b = blockIdx.x; asm volatile("" : "+s"(b)); return b; }

namespace pg8 {
#define PG8_LAS __attribute__((address_space(3)))
typedef unsigned short bf16_t;
typedef short bf16x8 __attribute__((ext_vector_type(8)));
typedef float f32x4 __attribute__((ext_vector_type(4)));
typedef unsigned u32x4 __attribute__((ext_vector_type(4)));
constexpr int BM = 256, BK = 64, HALF = 128, HTB = HALF * BK * 2  , STAGE_BYTES = 8 * HTB, NXCD = 8, WGM = 8;

__host__ __device__ __forceinline__ int lds_byte(int r, int c) { const int st = (r >> 4) * 2 + (c >> 5), rr = r & 15, cc = c & 31, ob = rr * 64 + cc * 2; return st * 1024 + (ob ^ (((ob >> 9) & 1) << 5)); }
__host__ __device__ __forceinline__ void stage_rc(int b, int& R, int& C) { const int st = b / 1024, sb = b % 1024, swz = sb ^ (((sb >> 9) & 1) << 5); R = (st >> 1) * 16 + swz / 64; C = (st & 1) * 32 + (swz % 64) / 2; }
__host__ __device__ __forceinline__ int perm32(int rho) { const int n = rho >> 4, i = rho & 15; return 8 * (i >> 2) + 4 * n + (i & 3); }

struct Unit { int pm, pn; };
struct Gemm { const bf16_t* A; const bf16_t* Bt; int M, N, K; };

struct StaticOrder {
    int nM, nN, nwg, G, c;
    __host__ __device__ void init(int M, int N, int G_, int c_) { nM = M / BM; nN = N / BM; nwg = nM * nN; G = G_; c = c_; }
    __host__ __device__ bool next(int i, Unit& u) const {
        const long L = (long)i * G + c; if (L >= nwg) return false;
        int wgid = (int)L; { const int q = nwg / NXCD, r = nwg % NXCD, xcd = wgid % NXCD, off = wgid / NXCD; wgid = (xcd < r ? xcd * (q + 1) : r * (q + 1) + (xcd - r) * q) + off; }
        const int nig = WGM * nN, gid = wgid / nig, fm = gid * WGM, gsz = (nM - fm) < WGM ? (nM - fm) : WGM;
        u.pm = fm + ((wgid % nig) % gsz); u.pn = (wgid % nig) / gsz; return true;
    }
    __device__ __forceinline__ void a_ready(const Unit&) const {}
    __device__ __forceinline__ void done(const Unit&) const {}
};

__device__ __forceinline__ unsigned cvt_pk_bf16(float lo, float hi) { unsigned r; asm volatile("v_cvt_pk_bf16_f32 %0, %1, %2" : "=v"(r) : "v"(lo), "v"(hi)); return r; }
typedef float f32x2 __attribute__((ext_vector_type(2)));
__device__ __forceinline__ f32x2 gelu_pk(f32x2 v) {
    const f32x2 av = __builtin_elementwise_abs(v), d = av * 0.2316418882f + 1.0f;
    f32x2 t; t.x = __builtin_amdgcn_rcpf(d.x); t.y = __builtin_amdgcn_rcpf(d.y);
    f32x2 q = t * 0.5307027145f + (-0.7265760135f); q = q * t + 0.7107068705f; q = q * t + (-0.142248368f); q = q * t + 0.127414796f; q = q * t;
    const f32x2 s = (v * v) * (-0.72134752044f);
    f32x2 e; e.x = __builtin_amdgcn_exp2f(s.x); e.y = __builtin_amdgcn_exp2f(s.y);
    const f32x2 m = v * (q * e), r = v - m;
    f32x2 o; o.x = v.x < 0.f ? m.x : r.x; o.y = v.y < 0.f ? m.y : r.y; return o;
}

template <int ACT  > struct EpiBf16 {
    static constexpr bool PERM = true, AFTER_DRAIN = false; static_assert(ACT == 0 || ACT == 1, "EpiBf16: ACT is 0 (none) or 1 (gelu_pk)");
    bf16_t* O; int ldc; const float* bias; int split_cols; size_t split_stride; float scale0;
    __device__ __forceinline__ void operator()(const f32x4 (&acc)[2][2][4][2], const Unit& u, int wr, int wc, int fr, int fq) const {
        const int row0 = u.pm * BM + wr * 64 + fr; int colt = u.pn * BM; bf16_t* base = O;
        float sc = 1.f; if (split_cols) { const int t = colt / split_cols; base += (size_t)t * split_stride; colt -= t * split_cols; if (t == 0) sc = scale0; }
        const int col0 = colt + wc * 32 + 8 * fq, bcol0 = u.pn * BM + wc * 32 + 8 * fq;
        f32x4 bv[2][2];
#pragma unroll
        for (int bj = 0; bj < 2; ++bj)
#pragma unroll
            for (int n = 0; n < 2; ++n) bv[bj][n] = bias ? *(const f32x4*)(bias + bcol0 + bj * HALF + 4 * n) : (f32x4){0.f, 0.f, 0.f, 0.f};
#pragma unroll
        for (int ai = 0; ai < 2; ++ai)
#pragma unroll
            for (int m = 0; m < 4; ++m) { bf16_t* rowp = base + (size_t)(row0 + ai * HALF + m * 16) * ldc + col0;
#pragma unroll
                for (int bj = 0; bj < 2; ++bj) { f32x4 v0 = acc[ai][bj][m][0] + bv[bj][0], v1 = acc[ai][bj][m][1] + bv[bj][1];
                    if (ACT == 1) { f32x2 a = gelu_pk((f32x2){v0[0], v0[1]}), b = gelu_pk((f32x2){v0[2], v0[3]}), c = gelu_pk((f32x2){v1[0], v1[1]}), d = gelu_pk((f32x2){v1[2], v1[3]});
                        v0 = (f32x4){a.x, a.y, b.x, b.y}; v1 = (f32x4){c.x, c.y, d.x, d.y}; }
                    v0 = v0 * sc; v1 = v1 * sc; u32x4 w; w.x = cvt_pk_bf16(v0[0], v0[1]); w.y = cvt_pk_bf16(v0[2], v0[3]); w.z = cvt_pk_bf16(v1[0], v1[1]); w.w = cvt_pk_bf16(v1[2], v1[3]);
                    *(u32x4*)(rowp + bj * HALF) = w; } }
    }
};
template <class Epi, class Sched, bool ALIGN_EPI = false, bool SP2 = false>
__device__ __forceinline__ void gemm_phase(PG8_LAS unsigned char* lds, const Gemm g, const Sched& S, const Epi& E) {
    const int tid = opaque_tid(), wid = __builtin_amdgcn_readfirstlane(tid >> 6), lane = tid & 63, wr = wid >> 2, wc = wid & 3, fr = lane & 15, fq = lane >> 4;
    const int K = g.K, nt = K / BK;
    unsigned voffA[2], voffB[2];
#pragma unroll
    for (int i = 0; i < 2; ++i) { int R, C; stage_rc(tid * 16 + i * 8192, R, C); const int Rb = Epi::PERM ? ((R & ~31) + perm32(R & 31)) : R;
        voffA[i] = (unsigned)(R * K + C) * 2u; voffB[i] = (unsigned)(Rb * K + C) * 2u; }
    const size_t kstep = (size_t)(BK * 2);
    const size_t hstep = (size_t)HALF * K * 2;
    const size_t tstep = 2 * hstep;
    const unsigned ldsw = (unsigned)wid * 1024u;
    const int aoff = lds_byte(wr * 64 + fr, fq * 8), boff = lds_byte(wc * 32 + fr, fq * 8);
#define PG8_SA(b, h) (((b) * 2 + (h)) * HTB)
#define PG8_SB(b, h) ((4 + (b) * 2 + (h)) * HTB)
#define PG8_STAGE(bufoff, gbase, voff) do { _Pragma("unroll") for (int _i = 0; _i < 2; ++_i) \
        __builtin_amdgcn_global_load_lds((const unsigned*)((const char*)(gbase) + (voff)[_i]), (PG8_LAS unsigned*)(lds + (bufoff) + ldsw + _i * 8192), 16, 0, 0); } while (0)
#define PG8_LDA(dst, b, h) do { _Pragma("unroll") for (int m = 0; m < 4; ++m) _Pragma("unroll") for (int k = 0; k < 2; ++k) dst[m][k] = *(const PG8_LAS bf16x8*)(lds + PG8_SA(b, h) + aoff + m * 2048 + k * 1024); } while (0)
#define PG8_LDB(dst, b, h) do { _Pragma("unroll") for (int n = 0; n < 2; ++n) _Pragma("unroll") for (int k = 0; k < 2; ++k) dst[n][k] = *(const PG8_LAS bf16x8*)(lds + PG8_SB(b, h) + boff + n * 2048 + k * 1024); } while (0)
#define PG8_MMA(ai, bj, At, Bt) do { __builtin_amdgcn_s_setprio(1); _Pragma("unroll") for (int m = 0; m < 4; ++m) _Pragma("unroll") for (int n = 0; n < 2; ++n) _Pragma("unroll") for (int k = 0; k < 2; ++k) \
        acc[ai][bj][m][n] = __builtin_amdgcn_mfma_f32_16x16x32_bf16(Bt[n][k], At[m][k], acc[ai][bj][m][n], 0, 0, 0); __builtin_amdgcn_s_setprio(0); } while (0)
#define PG8_WAIT_V(n) asm volatile("s_waitcnt vmcnt(" #n ")" ::: "memory")
#define PG8_WAIT_L(n) asm volatile("s_waitcnt lgkmcnt(" #n ")" ::: "memory")
#define PG8_BAR __builtin_amdgcn_s_barrier()
#define PG8_SCHED __builtin_amdgcn_sched_barrier(0)
    Unit cur, nxt; int ui = 0;
    if (!S.next(0, cur)) return;
    f32x4 acc[2][2][4][2];
#pragma unroll
    for (int a = 0; a < 2; ++a)
#pragma unroll
        for (int b = 0; b < 2; ++b)
#pragma unroll
            for (int m = 0; m < 4; ++m)
#pragma unroll
                for (int n = 0; n < 2; ++n) acc[a][b][m][n] = (f32x4){0.f, 0.f, 0.f, 0.f};
    bf16x8 At[4][2], B0[2][2], B1[2][2];
    const char* cA = (const char*)g.A + (size_t)cur.pm * tstep; const char* cB = (const char*)g.Bt + (size_t)cur.pn * tstep;
    S.a_ready(cur);
    if constexpr (SP2) {
        PG8_STAGE(PG8_SB(0, 0), cB, voffB); PG8_STAGE(PG8_SB(0, 1), cB + hstep, voffB); PG8_STAGE(PG8_SA(0, 0), cA, voffA); PG8_STAGE(PG8_SA(0, 1), cA + hstep, voffA);
        if (wr == 1) PG8_BAR;
        PG8_WAIT_V(2); PG8_BAR;
        PG8_STAGE(PG8_SB(1, 0), cB + kstep, voffB); PG8_STAGE(PG8_SA(1, 0), cA + kstep, voffA); PG8_STAGE(PG8_SB(1, 1), cB + hstep + kstep, voffB);
        PG8_WAIT_V(6); PG8_BAR;
    } else {
        PG8_STAGE(PG8_SB(0, 0), cB, voffB); PG8_STAGE(PG8_SA(0, 0), cA, voffA); PG8_STAGE(PG8_SB(0, 1), cB + hstep, voffB); PG8_STAGE(PG8_SA(0, 1), cA + hstep, voffA);
        if (wr == 1) PG8_BAR;
        PG8_WAIT_V(4); PG8_BAR;
        PG8_STAGE(PG8_SB(1, 0), cB + kstep, voffB); PG8_STAGE(PG8_SA(1, 0), cA + kstep, voffA); PG8_STAGE(PG8_SB(1, 1), cB + hstep + kstep, voffB);
        PG8_WAIT_V(6); PG8_BAR;
    }
    for (;;) {
        const bool has_next = S.next(ui + 1, nxt);
        const char* nA = has_next ? (const char*)g.A + (size_t)nxt.pm * tstep : cA; const char* nB = has_next ? (const char*)g.Bt + (size_t)nxt.pn * tstep : cB;
        for (int t = 0; t < nt; t += 2) {
            const bool last = (t == nt - 2);
            const char* a1 = cA + (size_t)(t + 1) * kstep;
            const char* a2 = last ? nA : cA + (size_t)(t + 2) * kstep; const char* b2 = last ? nB : cB + (size_t)(t + 2) * kstep;
            const char* a3 = a2 + kstep; const char* b3 = b2 + kstep;
            if (last && has_next) S.a_ready(nxt);
            if constexpr (SP2) {
            PG8_LDB(B0, 0, 0); PG8_LDB(B1, 0, 1); PG8_SCHED; PG8_LDA(At, 0, 0); PG8_STAGE(PG8_SA(1, 1), a1 + hstep, voffA);
            PG8_WAIT_V(8); PG8_WAIT_L(0); PG8_BAR; PG8_MMA(0, 0, At, B0); PG8_MMA(0, 1, At, B1); PG8_BAR; PG8_SCHED;
            PG8_LDA(At, 0, 1); PG8_STAGE(PG8_SB(0, 0), b2, voffB); PG8_STAGE(PG8_SB(0, 1), b2 + hstep, voffB); PG8_STAGE(PG8_SA(0, 0), a2, voffA);
            PG8_WAIT_V(8); PG8_WAIT_L(0); PG8_BAR; PG8_MMA(1, 0, At, B0); PG8_MMA(1, 1, At, B1); PG8_BAR; PG8_SCHED;
            PG8_LDB(B0, 1, 0); PG8_LDB(B1, 1, 1); PG8_SCHED; PG8_LDA(At, 1, 0); PG8_STAGE(PG8_SA(0, 1), a2 + hstep, voffA);
            PG8_WAIT_V(8); PG8_WAIT_L(0); PG8_BAR; PG8_MMA(0, 0, At, B0); PG8_MMA(0, 1, At, B1); PG8_BAR; PG8_SCHED;
            PG8_LDA(At, 1, 1); PG8_STAGE(PG8_SB(1, 0), b3, voffB); PG8_STAGE(PG8_SB(1, 1), b3 + hstep, voffB); PG8_STAGE(PG8_SA(1, 0), a3, voffA);
            PG8_WAIT_V(8); PG8_WAIT_L(0); PG8_BAR; PG8_MMA(1, 0, At, B0); PG8_MMA(1, 1, At, B1); PG8_BAR; PG8_SCHED;
            } else {
            PG8_LDB(B0, 0, 0); PG8_SCHED; PG8_LDA(At, 0, 0); PG8_STAGE(PG8_SA(1, 1), a1 + hstep, voffA);
            PG8_WAIT_L(8); PG8_BAR; PG8_WAIT_L(0); PG8_MMA(0, 0, At, B0); PG8_BAR; PG8_SCHED;
            PG8_LDB(B1, 0, 1); PG8_STAGE(PG8_SB(0, 0), b2, voffB);
            PG8_BAR; PG8_WAIT_L(0); PG8_MMA(0, 1, At, B1); PG8_BAR;
            PG8_LDA(At, 0, 1); PG8_STAGE(PG8_SA(0, 0), a2, voffA);
            PG8_BAR; PG8_WAIT_L(0); PG8_MMA(1, 0, At, B0); PG8_BAR; PG8_SCHED;
            PG8_STAGE(PG8_SB(0, 1), b2 + hstep, voffB);
            PG8_WAIT_V(6); PG8_BAR; PG8_MMA(1, 1, At, B1); PG8_BAR;
            PG8_LDB(B0, 1, 0); PG8_SCHED; PG8_LDA(At, 1, 0); PG8_STAGE(PG8_SA(0, 1), a2 + hstep, voffA);
            PG8_WAIT_L(8); PG8_BAR; PG8_WAIT_L(0); PG8_MMA(0, 0, At, B0); PG8_BAR; PG8_SCHED;
            PG8_LDB(B1, 1, 1); PG8_STAGE(PG8_SB(1, 0), b3, voffB);
            PG8_BAR; PG8_WAIT_L(0); PG8_MMA(0, 1, At, B1); PG8_BAR;
            PG8_LDA(At, 1, 1); PG8_STAGE(PG8_SA(1, 0), a3, voffA);
            PG8_BAR; PG8_WAIT_L(0); PG8_MMA(1, 0, At, B0); PG8_BAR; PG8_SCHED;
            PG8_STAGE(PG8_SB(1, 1), b3 + hstep, voffB);
            PG8_WAIT_V(6); PG8_BAR; PG8_MMA(1, 1, At, B1); PG8_BAR;
            }
        }
        if constexpr (ALIGN_EPI) { if (wr == 0) PG8_BAR; }
        if constexpr (!Epi::AFTER_DRAIN) { E(acc, cur, wr, wc, fr, fq); S.done(cur); }
        if (!has_next) break;
#pragma unroll
        for (int a = 0; a < 2; ++a)
#pragma unroll
            for (int b = 0; b < 2; ++b)
#pragma unroll
                for (int m = 0; m < 4; ++m)
#pragma unroll
                    for (int n = 0; n < 2; ++n) acc[a][b][m][n] = (f32x4){0.f, 0.f, 0.f, 0.f};
        cur = nxt; cA = nA; cB = nB; ++ui;
        if constexpr (ALIGN_EPI) { if (wr == 1) PG8_BAR; }
    }
    PG8_WAIT_V(0);
    if constexpr (!ALIGN_EPI) { if (wr == 0) PG8_BAR; }
    PG8_BAR;
    if constexpr (Epi::AFTER_DRAIN) { E.fused(acc, cur, wr, wc, fr, fq, lds, wid, lane); S.done(cur); }
#undef PG8_SA
#undef PG8_SB
#undef PG8_STAGE
#undef PG8_LDA
#undef PG8_LDB
#undef PG8_MMA
#undef PG8_WAIT_V
#undef PG8_WAIT_L
#undef PG8_BAR
#undef PG8_SCHED
}
}

struct EpiResGate {
    static constexpr bool PERM = false, AFTER_DRAIN = false;
    float* X; const float* gate;
    __device__ __forceinline__ void operator()(const pg8::f32x4 (&acc)[2][2][4][2], const pg8::Unit& u, int wr, int wc, int fr, int fq) const {
#pragma unroll
        for (int ai = 0; ai < 2; ++ai)
#pragma unroll
            for (int m = 0; m < 4; ++m) {
                const int r = u.pm * 256 + ai * 128 + wr * 64 + m * 16 + fr;
                const float* g = gate + (size_t)row_mod(r) * MODW; float* xr = X + (size_t)r * DM;
#pragma unroll
                for (int bj = 0; bj < 2; ++bj)
#pragma unroll
                    for (int n = 0; n < 2; ++n) {
                        const int c = u.pn * 256 + bj * 128 + wc * 32 + n * 16 + 4 * fq;
                        pg8::f32x4 xv = *(const pg8::f32x4*)(xr + c); const pg8::f32x4 gv = *(const pg8::f32x4*)(g + c);
                        xv = xv + gv * acc[ai][bj][m][n];
                        *(pg8::f32x4*)(xr + c) = xv;
                    }
            }
    }
};
#define LAS __attribute__((address_space(3)))
#define GAS __attribute__((address_space(1)))

__device__ __forceinline__ void ph_copy_in(const float* __restrict__ x, const float* __restrict__ ctx, float* __restrict__ X) {
    const int TID = opaque_tid(), BID = opaque_bid();
    size_t i = (size_t)BID * NT + TID;
    const size_t n4 = (size_t)RT * DM / 4, nl4 = (size_t)RL * DM / 4;
    for (; i < n4; i += (size_t)gridDim.x * NT) ((float4*)X)[i] = i < nl4 ? ((const float4*)x)[i] : ((const float4*)ctx)[i - nl4];
}
__device__ __forceinline__ void ph_copy_out(const float* __restrict__ X, float* __restrict__ out) {
    const int TID = opaque_tid(), BID = opaque_bid();
    size_t i = (size_t)BID * NT + TID;
    const size_t n4 = (size_t)RL * DM / 4;
    for (; i < n4; i += (size_t)gridDim.x * NT) ((float4*)out)[i] = ((const float4*)X)[i];
}
__device__ __forceinline__ void ph_rope_table(float2* __restrict__ rope) {
    const int TID = opaque_tid(), BID = opaque_bid();
    for (int i = BID * NT + TID; i < SEQ * 32; i += gridDim.x * NT) {
        int t = i >> 5, a = (i >> 4) & 1, f = i & 15;
        float pos = a == 0 ? (float)(t >> 6) : (float)(t & 63);
        float inv = powf(10000.f, -(float)f / 16.f);
        float ang = pos * inv;
        rope[i] = make_float2(cosf(ang), sinf(ang));
    }
}
__device__ __forceinline__ void transpose_item(const float* __restrict__ W, int N, bf16* __restrict__ WT, LAS float* scr, int item, int lane) {
    const int K = DM;
    const int nblk = N / 32, kb = item / nblk, nb = item % nblk, k0 = 64 * kb, n0 = 32 * nb;
#pragma unroll 8
    for (int i = 0; i < 32; ++i) { const int kk = 2 * i + (lane >> 5); scr[kk * 33 + (lane & 31)] = W[(size_t)(k0 + kk) * N + n0 + (lane & 31)]; }
    asm volatile("s_waitcnt lgkmcnt(0)" ::: "memory");
    const int c = lane & 7;
#pragma unroll
    for (int j = 0; j < 4; ++j) { const int n = (lane >> 3) + 8 * j; const LAS float* s = scr + (8 * c) * 33 + n;
        uint4 o; o.x = pk2(s[0 * 33], s[1 * 33]); o.y = pk2(s[2 * 33], s[3 * 33]); o.z = pk2(s[4 * 33], s[5 * 33]); o.w = pk2(s[6 * 33], s[7 * 33]);
        *(uint4*)(WT + (size_t)(n0 + n) * K + k0 + 8 * c) = o; }
    asm volatile("s_waitcnt lgkmcnt(0)" ::: "memory");
}
struct WPrep { const float* src[12]; bf16* dst[12]; };
__device__ __forceinline__ void ph_weight_prep(const float* const* in, bf16* WinE, bf16* WoutE, bf16* WinO, bf16* WoutO, bf16* Wpq, bf16* Kb, unsigned char* lds) {
    const int TID = opaque_tid(), BID = opaque_bid();
    const int lane = TID & 63, wv = TID >> 6;
    LAS float* scr = (LAS float*)((LAS unsigned char*)lds + wv * 16384);
    const int gw = BID * NWV + wv, NGW = gridDim.x * NWV;
    const int NITEMS = 2 * 1552 + 2 * 512 + 2 * 768 + 2 * 512 + 4 * 512;
    for (int it = gw; it < NITEMS; it += NGW) {
        int r = it;
        if (r < 3104) { int i = r / 1552; transpose_item(in[8] + (size_t)i * DM * EVEN_IN, EVEN_IN, WinE + (size_t)i * EVEN_LDP * DM, scr, r % 1552, lane); continue; } r -= 3104;
        if (r < 1024) { int i = r / 512; transpose_item(in[9] + (size_t)i * DM * DM, DM, WoutE + (size_t)i * DM * DM, scr, r % 512, lane); continue; } r -= 1024;
        if (r < 1536) { int i = r / 768; transpose_item(in[19] + (size_t)i * DM * ODD_IN, ODD_IN, WinO + (size_t)i * ODD_IN * DM, scr, r % 768, lane); continue; } r -= 1536;
        if (r < 1024) { int i = r / 512; transpose_item(in[20] + (size_t)i * DM * DM, DM, WoutO + (size_t)i * DM * DM, scr, r % 512, lane); continue; } r -= 1024;
        { int i = r / 512; transpose_item(in[23] + (size_t)i * DM * DM, DM, Wpq + (size_t)i * DM * DM, scr, r % 512, lane); }
    }
    for (int i4 = BID * NT + TID; i4 < DEPTH * 8 * 2 * 128 * 64 / 4; i4 += gridDim.x * NT) st4bf(Kb + 4 * (size_t)i4, ((const float4*)in[24])[i4]);
    for (int i = BID * NT + TID; i < 2 * 28672; i += gridDim.x * NT) {
        int w = i / 28672, o = i % 28672;
        ((uint4*)(WinE + (size_t)w * EVEN_LDP * DM + (size_t)EVEN_IN * DM))[o] = make_uint4(0u, 0u, 0u, 0u);
    }
}
__device__ __forceinline__ void ph_mods(const float* __restrict__ c, const float* __restrict__ cctx, const float* __restrict__ w_mod,
                        const float* __restrict__ b_mod, float* __restrict__ mods, float* smem) {
    const int TID = opaque_tid(), BID = opaque_bid();
    const int nslab = DEPTH * MODW / 128;
    if (BID >= nslab) return;
    const int lane = TID & 63, wv = TID >> 6, cl = lane & 15, kp = lane >> 4;
    float (*S)[DM] = (float (*)[DM])smem;
    for (int i = TID; i < NMOD * DM; i += NT) {
        int j = i / DM, k = i % DM;
        float v = j < 16 ? c[j * DM + k] : cctx[k];
        S[j][k] = silu_f(v);
    }
    __syncthreads();
    for (int slab = BID; slab < nslab; slab += gridDim.x) {
        const int l = slab / 48, n = (slab % 48) * 128 + wv * 16 + cl;
        const float* W = w_mod + (size_t)l * DM * MODW + n;
        float acc[NMOD];
#pragma unroll
        for (int j = 0; j < NMOD; ++j) acc[j] = 0.f;
#pragma unroll 4
        for (int kk = 0; kk < 256; ++kk) {
            const int k = kp * 256 + kk;
            const float w = W[(size_t)k * MODW];
#pragma unroll
            for (int j = 0; j < NMOD; ++j) acc[j] += S[j][k] * w;
        }
        const float bias = b_mod[l * MODW + n];
#pragma unroll
        for (int j = 0; j < NMOD; ++j) {
            float v = acc[j];
            v += __shfl_xor(v, 16); v += __shfl_xor(v, 32);
            if (kp == 0) mods[((size_t)l * NMOD + j) * MODW + n] = v + bias;
        }
    }
    __syncthreads();
}
__device__ __forceinline__ void ph_norm_mod(const float* __restrict__ X, const float* __restrict__ g, const float* __restrict__ mods_l, int shift_chunk, bf16* __restrict__ A) {
    const int TID = opaque_tid(), BID = opaque_bid();
    int wave = BID * NWV + (TID >> 6), lane = TID & 63;
    int nw = gridDim.x * NWV;
    for (int r = wave; r < RT; r += nw) {
        const float4* xr = (const float4*)(X + (size_t)r * DM);
        float4 v[4]; float s = 0.f;
#pragma unroll
        for (int i = 0; i < 4; ++i) { v[i] = xr[lane + 64 * i]; s += v[i].x * v[i].x + v[i].y * v[i].y + v[i].z * v[i].z + v[i].w * v[i].w; }
        s = wave_sum(s);
        float rstd = rsqrtf(s * (1.f / DM) + 1e-6f);
        const float* m = mods_l + (size_t)row_mod(r) * MODW;
        const float4* sh = (const float4*)(m + shift_chunk * DM);
        const float4* sc = (const float4*)(m + (shift_chunk + 1) * DM);
        const float4* g4 = (const float4*)g;
        bf16* ar = A + (size_t)r * DM;
#pragma unroll
        for (int i = 0; i < 4; ++i) {
            int c = lane + 64 * i;
            float4 gg = g4[c], a = sh[c], b = sc[c], o;
            o.x = v[i].x * rstd * gg.x * (1.f + b.x) + a.x;
            o.y = v[i].y * rstd * gg.y * (1.f + b.y) + a.y;
            o.z = v[i].z * rstd * gg.z * (1.f + b.z) + a.z;
            o.w = v[i].w * rstd * gg.w * (1.f + b.w) + a.w;
            st4bf(ar + 4 * c, o);
        }
    }
}
#define KVLEN (CTX + SEQ)
__device__ __forceinline__ void ph_post(bf16* __restrict__ P, int ldp, int nq, int kcol0, int nk, int vcol0, int VC, int DV,
                                        const float* __restrict__ qgain, const float* __restrict__ kgain, const float2* __restrict__ rope,
                                        bf16* __restrict__ Kc, bf16* __restrict__ Vt) {
    const int TID = opaque_tid(), BID = opaque_bid();
    const float C2 = 0.125f * 1.4426950408889634f;
    for (int tile = BID; tile < RT / 64; tile += gridDim.x) {
        const int r0 = tile * 64;
        int b, j0;
        if (r0 < RL) { b = r0 >> 11; j0 = CTX + (r0 & (SEQ - 1)); } else { b = (r0 - RL) >> 8; j0 = (r0 - RL) & (CTX - 1); }
        const int nh = nq + nk, sub = TID & 7;
        for (int ti = TID; ti < 64 * nh * 8; ti += NT) {
            const int item = ti >> 3, row = item / nh, hh = item % nh, r = r0 + row;
            const bool isk = hh >= nq; const int h = isk ? hh - nq : hh;
            bf16* src = P + (size_t)r * ldp + (isk ? kcol0 : 0) + h * 64 + sub * 8;
            const float* gain = (isk ? kgain : qgain) + sub * 8;
            const uint4 raw = *(const uint4*)src;
            const unsigned rw[4] = {raw.x, raw.y, raw.z, raw.w};
            float v[8]; float ssq = 0.f;
#pragma unroll
            for (int i = 0; i < 4; ++i) { v[2 * i] = __uint_as_float(rw[i] << 16); v[2 * i + 1] = __uint_as_float(rw[i] & 0xffff0000u); ssq += v[2 * i] * v[2 * i] + v[2 * i + 1] * v[2 * i + 1]; }
            ssq += __shfl_xor(ssq, 1); ssq += __shfl_xor(ssq, 2); ssq += __shfl_xor(ssq, 4);
            const float rstd = rsqrtf(ssq * (1.f / 64.f) + 1e-6f) * (isk ? 1.f : C2);
            const float4 g0 = ((const float4*)gain)[0], g1 = ((const float4*)gain)[1];
            const float gg[8] = {g0.x, g0.y, g0.z, g0.w, g1.x, g1.y, g1.z, g1.w};
#pragma unroll
            for (int i = 0; i < 8; ++i) v[i] = v[i] * rstd * gg[i];
            float pv[8];
#pragma unroll
            for (int i = 0; i < 8; ++i) pv[i] = __shfl_xor(v[i], 2);
            if (r < RL) {
                const float2* tab = rope + (size_t)(r & (SEQ - 1)) * 32 + (sub >> 2) * 16 + (sub & 1) * 8;
                const bool second = (sub & 2) != 0;
#pragma unroll
                for (int i = 0; i < 8; ++i) { const float2 cs = tab[i]; v[i] = second ? (v[i] * cs.x + pv[i] * cs.y) : (v[i] * cs.x - pv[i] * cs.y); }
            }
            bf16* dst = isk ? Kc + ((size_t)(b * nk + h) * KVLEN + j0 + row) * 64 + sub * 8 : src;
            *(uint4*)dst = make_uint4(pk2(v[0], v[1]), pk2(v[2], v[3]), pk2(v[4], v[5]), pk2(v[6], v[7]));
        }
        if (TID < VC) {
            const int c8 = TID >> 3, rg = TID & 7;
            unsigned in[8][4];
#pragma unroll
            for (int rr = 0; rr < 8; ++rr) { uint4 t = *(const uint4*)(P + (size_t)(r0 + rg * 8 + rr) * ldp + vcol0 + c8 * 8); in[rr][0] = t.x; in[rr][1] = t.y; in[rr][2] = t.z; in[rr][3] = t.w; }
#pragma unroll
            for (int c = 0; c < 8; ++c) {
                unsigned o[4];
#pragma unroll
                for (int q = 0; q < 4; ++q)
                    o[q] = (c & 1) ? __builtin_amdgcn_perm(in[2 * q + 1][c >> 1], in[2 * q][c >> 1], 0x07060302u) : __builtin_amdgcn_perm(in[2 * q + 1][c >> 1], in[2 * q][c >> 1], 0x05040100u);
                const int col = c8 * 8 + c, vh = col / DV, d = col % DV;
                bf16* vrow = Vt + ((size_t)(b * 4 + vh) * DV + d) * KVLEN + j0 + 16 * (rg >> 1) + 4 * (rg & 1);
                *(uint2*)vrow = make_uint2(o[0], o[1]);
                *(uint2*)(vrow + 8) = make_uint2(o[2], o[3]);
            }
        }
    }
}
typedef short bf16x8 __attribute__((ext_vector_type(8)));
typedef float f32x16 __attribute__((ext_vector_type(16)));
__device__ __forceinline__ int crow(int r, int hi) { return (r & 3) + 8 * (r >> 2) + 4 * hi; }
__device__ __forceinline__ unsigned cvt_pk_bf16_f32(float lo, float hi) { f32x2_t v = {lo, hi}; bf16x2_t b = __builtin_convertvector(v, bf16x2_t); return __builtin_bit_cast(unsigned, b); }
__device__ __forceinline__ float max3f(float a, float b, float c) { return fmaxf(fmaxf(a, b), c); }
__device__ __forceinline__ float max2f(float a, float b) { return fmaxf(a, b); }
#define ATT_KPITCH 144
#define ATT_VPITCH 144
template <int DV>
__device__ __forceinline__ void attn_unit(const bf16* __restrict__ Qbase, int ldq, const bf16* __restrict__ Kc, const bf16* __restrict__ Vt, int ntiles,
                                          bf16* __restrict__ Obase, int ldo, unsigned char* lds, int tid, float shift) {
    constexpr int NDB = DV / 32, NVL = DV / 64, KBYTES = 64 * ATT_KPITCH, VBYTES = DV * ATT_VPITCH;
    constexpr float THR = 8.f;
    const int lane = tid & 63, wid = tid >> 6, r32 = lane & 31, hi = lane >> 5;
    unsigned char* Kb0 = lds; unsigned char* Vb0 = lds + 2 * KBYTES;
    float* sc = (float*)(lds + 2 * KBYTES + 2 * VBYTES + wid * 128);
    bf16x8 qf[4];
    {
        const bf16* qrow = Qbase + (size_t)(wid * 32 + r32) * ldq;
#pragma unroll
        for (int s = 0; s < 4; ++s) qf[s] = *(const bf16x8*)(qrow + 16 * s + 8 * hi);
    }
    f32x16 o[NDB];
#pragma unroll
    for (int d = 0; d < NDB; ++d)
#pragma unroll
        for (int r = 0; r < 16; ++r) o[d][r] = 0.f;
    float l = 0.f;
    uint4 kreg, vreg0, vreg1 = make_uint4(0u, 0u, 0u, 0u);
    const int krow = tid >> 3, kch = tid & 7;
    const unsigned voff0 = (unsigned)(tid >> 3) * (unsigned)(KVLEN * 2) + (unsigned)(tid & 7) * 16u, voff1 = voff0 + 64u * (unsigned)(KVLEN * 2);
    const unsigned vlds0 = (unsigned)(tid >> 3) * ATT_VPITCH + (unsigned)(tid & 7) * 16u, vlds1 = vlds0 + 64u * ATT_VPITCH;
#define ATT_GLOAD_K(t) do { kreg = *(const uint4*)((const unsigned char*)Kc + ((unsigned)(t) * 8192u + (unsigned)tid * 16u)); } while (0)
#define ATT_GLOAD_V(t) do { vreg0 = *(const uint4*)((const unsigned char*)Vt + (voff0 + (unsigned)(t) * 128u)); if (NVL == 2) vreg1 = *(const uint4*)((const unsigned char*)Vt + (voff1 + (unsigned)(t) * 128u)); } while (0)
#define ATT_STORE_K(buf) do { *(uint4*)(Kb0 + (buf) * KBYTES + krow * ATT_KPITCH + kch * 16) = kreg; } while (0)
#define ATT_STORE_V(buf) do { *(uint4*)(Vb0 + (buf) * VBYTES + vlds0) = vreg0; if (NVL == 2) *(uint4*)(Vb0 + (buf) * VBYTES + vlds1) = vreg1; } while (0)
#define ATT_QK(S0, S1, buf) do { const unsigned char* kb_ = Kb0 + (buf) * KBYTES; \
        _Pragma("unroll") for (int r = 0; r < 16; ++r) { S0[r] = 0.f; S1[r] = 0.f; } \
        _Pragma("unroll") for (int s = 0; s < 4; ++s) { \
            const bf16x8 a0 = *(const bf16x8*)(kb_ + r32 * ATT_KPITCH + s * 32 + hi * 16); \
            const bf16x8 a1 = *(const bf16x8*)(kb_ + (32 + r32) * ATT_KPITCH + s * 32 + hi * 16); \
            S0 = __builtin_amdgcn_mfma_f32_32x32x16_bf16(a0, qf[s], S0, 0, 0, 0); \
            S1 = __builtin_amdgcn_mfma_f32_32x32x16_bf16(a1, qf[s], S1, 0, 0, 0); } } while (0)
    ATT_GLOAD_K(0); ATT_GLOAD_V(0);
    ATT_STORE_K(0); ATT_STORE_V(0); ATT_STORE_V(1);
    if (ntiles > 1) { ATT_GLOAD_K(1); ATT_STORE_K(1); }
    __syncthreads();
    f32x16 s0, s1;
    ATT_QK(s0, s1, 0);
    __syncthreads();
    uint4 pa0 = make_uint4(0u, 0u, 0u, 0u), pa1 = pa0, pa2 = pa0, pa3 = pa0;
#define ATT_PA(s) __builtin_bit_cast(bf16x8, (s) == 0 ? pa0 : (s) == 1 ? pa1 : (s) == 2 ? pa2 : pa3)
    for (int t = 0; t < ntiles; ++t) {
        if (t + 2 < ntiles) ATT_GLOAD_K(t + 2);
        if (t > 0) ATT_GLOAD_V(t);
        if (shift != 0.f) {
#pragma unroll
            for (int r = 0; r < 16; ++r) { s0[r] -= shift; s1[r] -= shift; }
        }
        f32x16 n0, n1;
        ATT_QK(n0, n1, (t + 1) & 1);
        {
            const unsigned char* vb = Vb0 + ((t + 1) & 1) * VBYTES;
#pragma unroll
            for (int d = 0; d < NDB; ++d) {
#pragma unroll
                for (int s = 0; s < 4; ++s) {
                    const bf16x8 vf = *(const bf16x8*)(vb + (32 * d + r32) * ATT_VPITCH + 32 * s + 16 * hi);
                    o[d] = __builtin_amdgcn_mfma_f32_32x32x16_bf16(ATT_PA(s), vf, o[d], 0, 0, 0);
                }
            }
        }
        float ps = 0.f;
#pragma unroll
        for (int r = 0; r < 16; ++r) { s0[r] = __builtin_amdgcn_exp2f(s0[r]); s1[r] = __builtin_amdgcn_exp2f(s1[r]); ps += s0[r] + s1[r]; }
        l += ps;
        uint4 pn0 = make_uint4(cvt_pk_bf16_f32(s0[0], s0[1]), cvt_pk_bf16_f32(s0[2], s0[3]), cvt_pk_bf16_f32(s0[4], s0[5]), cvt_pk_bf16_f32(s0[6], s0[7]));
        uint4 pn1 = make_uint4(cvt_pk_bf16_f32(s0[8], s0[9]), cvt_pk_bf16_f32(s0[10], s0[11]), cvt_pk_bf16_f32(s0[12], s0[13]), cvt_pk_bf16_f32(s0[14], s0[15]));
        uint4 pn2 = make_uint4(cvt_pk_bf16_f32(s1[0], s1[1]), cvt_pk_bf16_f32(s1[2], s1[3]), cvt_pk_bf16_f32(s1[4], s1[5]), cvt_pk_bf16_f32(s1[6], s1[7]));
        uint4 pn3 = make_uint4(cvt_pk_bf16_f32(s1[8], s1[9]), cvt_pk_bf16_f32(s1[10], s1[11]), cvt_pk_bf16_f32(s1[12], s1[13]), cvt_pk_bf16_f32(s1[14], s1[15]));
        asm volatile("" : "+v"(pn0.x), "+v"(pn0.y), "+v"(pn0.z), "+v"(pn0.w), "+v"(pn1.x), "+v"(pn1.y), "+v"(pn1.z), "+v"(pn1.w));
        asm volatile("" : "+v"(pn2.x), "+v"(pn2.y), "+v"(pn2.z), "+v"(pn2.w), "+v"(pn3.x), "+v"(pn3.y), "+v"(pn3.z), "+v"(pn3.w), "+v"(l));
        __builtin_amdgcn_sched_group_barrier(0x100, 4, 0);
#pragma unroll
        for (int i = 0; i < 8 + 4 * NDB; ++i) {
            __builtin_amdgcn_sched_group_barrier(0x008, 1, 0);
            __builtin_amdgcn_sched_group_barrier(0x100, 1, 0);
            __builtin_amdgcn_sched_group_barrier(0x002, NDB == 2 ? 5 : 4, 0);
            __builtin_amdgcn_sched_group_barrier(0x400, NDB == 2 ? 2 : 1, 0);
        }
        if (t + 2 < ntiles) ATT_STORE_K(t & 1);
        if (t > 0) ATT_STORE_V(t & 1);
        __syncthreads();
        s0 = n0; s1 = n1;
        pa0 = pn0; pa1 = pn1; pa2 = pn2; pa3 = pn3;
    }
    {
        const unsigned char* vb = Vb0 + ((ntiles - 1) & 1) * VBYTES;
#pragma unroll
        for (int d = 0; d < NDB; ++d) {
#pragma unroll
            for (int s = 0; s < 4; ++s) {
                const bf16x8 vf = *(const bf16x8*)(vb + (32 * d + r32) * ATT_VPITCH + 32 * s + 16 * hi);
                o[d] = __builtin_amdgcn_mfma_f32_32x32x16_bf16(ATT_PA(s), vf, o[d], 0, 0, 0);
            }
        }
    }
#undef ATT_GLOAD_K
#undef ATT_GLOAD_V
#undef ATT_STORE_K
#undef ATT_STORE_V
#undef ATT_QK
#undef ATT_PA
    l += __shfl_xor(l, 32);
    if (hi == 0) sc[r32] = 1.f / l;
    int tide = tid; asm volatile("" : "+v"(tide));
    const unsigned obase_off = (unsigned)(((tide >> 6) * 32 + 4 * ((tide >> 5) & 1)) * ldo + (tide & 31)) * 2u;
#pragma unroll
    for (int r = 0; r < 16; ++r) {
        const float iv = sc[crow(r, hi)];
        bf16* orow = (bf16*)((unsigned char*)Obase + (obase_off + (unsigned)(((r & 3) + 8 * (r >> 2)) * ldo) * 2u));
#pragma unroll
        for (int d = 0; d < NDB; ++d) orow[32 * d] = (bf16)f2bf(o[d][r] * iv);
    }
    __syncthreads();
}
__device__ __forceinline__ void attn_run_unit(const bf16* __restrict__ P, int ldp, const bf16* __restrict__ Kc, const bf16* __restrict__ Vt, bf16* __restrict__ ATT,
                                              int odd, int u, int nlat, unsigned char* lds, int TID, float shift) {
    int b, qh, row0, ntiles;
    if (u < nlat) {
        if (odd) { const int grp = u >> 5, w = u & 31; b = grp >> 2; qh = (grp & 3) * 4 + (w >> 3); row0 = b * SEQ + (w & 7) * 256; }
        else { const int grp = u >> 4, w = u & 15; b = grp >> 2; qh = (grp & 3) * 2 + (w >> 3); row0 = b * SEQ + (w & 7) * 256; }
        ntiles = KVLEN / 64;
    } else {
        const int idx = u - nlat;
        if (odd) { b = idx >> 4; qh = idx & 15; } else { b = idx >> 3; qh = idx & 7; }
        row0 = RL + b * CTX; ntiles = CTX / 64;
    }
    if (odd) attn_unit<64>(P + (size_t)row0 * ldp + qh * 64, ldp, Kc + (size_t)(b * 4 + (qh >> 2)) * KVLEN * 64, Vt + (size_t)(b * 4 + (qh >> 2)) * 64 * KVLEN, ntiles,
                           ATT + (size_t)row0 * DM + qh * 64, DM, lds, TID, shift);
    else attn_unit<128>(P + (size_t)row0 * ldp + qh * 64, ldp, Kc + (size_t)(b * 8 + qh) * KVLEN * 64, Vt + (size_t)(b * 4 + (qh >> 1)) * 128 * KVLEN, ntiles,
                        ATT + (size_t)row0 * DM + qh * 128, DM, lds, TID, shift);
}
__device__ __forceinline__ void ph_attn_mfma(const bf16* __restrict__ P, int ldp, const bf16* __restrict__ Kc, const bf16* __restrict__ Vt, bf16* __restrict__ ATT,
                                             int odd, int with_ctx, unsigned char* lds, const float* __restrict__ qgain, const float* __restrict__ kgain) {
    const int TID = opaque_tid(), BID = opaque_bid();
    float shift;
    {
        float gq = fabsf(qgain[TID & 63]), gk = fabsf(kgain[TID & 63]);
#pragma unroll
        for (int o = 1; o < 64; o <<= 1) { gq = fmaxf(gq, __shfl_xor(gq, o)); gk = fmaxf(gk, __shfl_xor(gk, o)); }
        shift = fmaxf(8.f * 1.4426950408889634f * gq * gk * 1.002f + 0.01f - 100.f, 0.f);
        shift = __int_as_float(__builtin_amdgcn_readfirstlane(__float_as_int(shift)));
    }
    const int G = gridDim.x, vcu = (G % 8 == 0) ? (BID & 7) * (G >> 3) + (BID >> 3) : BID;
    const int nlat = odd ? 2048 : 1024, nctx = with_ctx ? (odd ? 256 : 128) : 0;
    if (!odd && G == 256) {
        const int x = BID & 7, w = BID >> 3;
        if (w >= 16) { for (int i = 0; i < 5; ++i) attn_run_unit(P, ldp, Kc, Vt, ATT, odd, x * 128 + 16 * i + (w - 16), nlat, lds, TID, shift); }
        else {
            for (int i = 5; i < 8; ++i) attn_run_unit(P, ldp, Kc, Vt, ATT, odd, x * 128 + 16 * i + w, nlat, lds, TID, shift);
            if (nctx) attn_run_unit(P, ldp, Kc, Vt, ATT, odd, nlat + x * 16 + w, nlat, lds, TID, shift);
        }
        return;
    }
    for (int u = vcu; u < nlat + nctx; u += G) attn_run_unit(P, ldp, Kc, Vt, ATT, odd, u, nlat, lds, TID, shift);
}
typedef float f32x4_t __attribute__((ext_vector_type(4)));
#define GLA_PITCH 144
__device__ __forceinline__ void ph_gla_chunk(const bf16* __restrict__ P, const float* __restrict__ w_af, const float* __restrict__ b_af,
                                             const float* __restrict__ w_ab, const float* __restrict__ b_ab, float* __restrict__ OF, float* __restrict__ OB, unsigned char* lds, int unit0, int ustride) {
    const int TID = opaque_tid(), BID = opaque_bid();
    const int tid = TID, lane = tid & 63, wid = tid >> 6, l15 = lane & 15, q4 = lane >> 4;
    float* SEG = (float*)lds;
    float* DEC = (float*)(lds + 2048);
    unsigned char* QD = lds + 4096;
    unsigned char* KI = QD + 9216;
    unsigned char* KET = KI + 9216;
    unsigned char* AT = KET + 9216;
    unsigned char* VT = AT + 9216;
    unsigned char* QRAW = VT + 18432;
    unsigned char* KRAW = QRAW + 9216;
    unsigned char* VRAW = KRAW + 9216;
    unsigned char* GRAW = VRAW + 64 * 272;
#define GLA_ROWS(ch_, rb_, rs_) do { if (!dir) { rb_ = (ch_) < 4 ? RL + b * CTX + (ch_) * 64 : b * SEQ + ((ch_) - 4) * 64; rs_ = 1; } \
        else { rb_ = (ch_) < 4 ? RL + b * CTX + (CTX - 1 - (ch_) * 64) : b * SEQ + (SEQ - 1 - ((ch_) - 4) * 64); rs_ = -1; } } while (0)
#define GLA_GLOAD(ch_) do { int rb_, rs_; GLA_ROWS(ch_, rb_, rs_); \
        const bf16* pq_ = P + (size_t)(rb_ + rs_ * (tid >> 3)) * EVEN_LDP + h * 64 + (tid & 7) * 8; rq = *(const uint4*)(pq_ + 1536); rk = *(const uint4*)(pq_ + 1792); \
        rv0 = *(const uint4*)(P + (size_t)(rb_ + rs_ * (tid >> 4)) * EVEN_LDP + 2048 + h * 128 + (tid & 15) * 8); \
        rv1 = *(const uint4*)(P + (size_t)(rb_ + rs_ * (32 + (tid >> 4))) * EVEN_LDP + 2048 + h * 128 + (tid & 15) * 8); \
        if (tid < 128) rg = *(const uint4*)(P + (size_t)(rb_ + rs_ * (tid >> 1)) * EVEN_LDP + 3072 + dir * 16 + (tid & 1) * 8); } while (0)
#define GLA_STAGE() do { *(uint4*)(QRAW + (tid >> 3) * GLA_PITCH + (tid & 7) * 16) = rq; *(uint4*)(KRAW + (tid >> 3) * GLA_PITCH + (tid & 7) * 16) = rk; \
        *(uint4*)(VRAW + (tid >> 4) * 272 + (tid & 15) * 16) = rv0; *(uint4*)(VRAW + (32 + (tid >> 4)) * 272 + (tid & 15) * 16) = rv1; \
        if (tid < 128) *(uint4*)(GRAW + (tid >> 1) * 32 + (tid & 1) * 16) = rg; } while (0)
    for (int unit = unit0; unit >= 0 && unit < NB * 4 * 2; unit += ustride) {
        const int dir = unit & 1, h = (unit >> 1) & 3, b = unit >> 3;
        const float* wa = dir ? w_ab : w_af; const float* ba = dir ? b_ab : b_af;
        float* Od = dir ? OB : OF;
        const int d = tid & 63, seg = tid >> 6;
        float wreg[16];
#pragma unroll
        for (int j = 0; j < 16; ++j) wreg[j] = wa[j * 256 + h * 64 + d];
        const float breg = ba[h * 64 + d];
        { unsigned z_; asm volatile("v_mov_b32 %0, 0" : "=v"(z_)); for (int i = tid; i < 9216 / 16; i += NT) ((uint4*)AT)[i] = make_uint4(z_, z_, z_, z_); }
        f32x4_t S[4];
#pragma unroll
        for (int i = 0; i < 4; ++i) S[i] = (f32x4_t){0.f, 0.f, 0.f, 0.f};
        uint4 rq, rk, rv0, rv1, rg = make_uint4(0u, 0u, 0u, 0u);
        GLA_GLOAD(0);
        GLA_STAGE();
        __syncthreads();
        for (int ch = 0; ch < KVLEN / 64; ++ch) {
            int rbase, rsgn;
            GLA_ROWS(ch, rbase, rsgn);
            if (ch + 1 < KVLEN / 64) GLA_GLOAD(ch + 1);
            float cl[8];
            {
                float run = 0.f;
#pragma unroll
                for (int i = 0; i < 8; ++i) {
                    const uint4 g0 = *(const uint4*)(GRAW + (8 * seg + i) * 32), g1 = *(const uint4*)(GRAW + (8 * seg + i) * 32 + 16);
                    const unsigned gw[8] = {g0.x, g0.y, g0.z, g0.w, g1.x, g1.y, g1.z, g1.w};
                    float z = breg;
#pragma unroll
                    for (int j = 0; j < 8; ++j) { z += __uint_as_float(gw[j] << 16) * wreg[2 * j]; z += __uint_as_float(gw[j] & 0xffff0000u) * wreg[2 * j + 1]; }
                    run += (fminf(z, 0.f) - __logf(1.f + __expf(-fabsf(z)))) * (1.f / 16.f);
                    cl[i] = run;
                }
                SEG[seg * 64 + d] = run;
            }
            __syncthreads();
            {
                float prefix = 0.f, total = 0.f;
#pragma unroll
                for (int s2 = 0; s2 < 8; ++s2) { const float v = SEG[s2 * 64 + d]; total += v; prefix += (s2 < seg) ? v : 0.f; }
                const float etot = __expf(total);
                if (seg == 0) DEC[d] = etot;
                unsigned kew[4];
#pragma unroll
                for (int i = 0; i < 8; ++i) {
                    const int c = 8 * seg + i;
                    const float qv = bf2f(*(const bf16*)(QRAW + c * GLA_PITCH + d * 2)) * 0.125f, kv = bf2f(*(const bf16*)(KRAW + c * GLA_PITCH + d * 2));
                    const float e = __expf(prefix + cl[i]), ei = __builtin_amdgcn_rcpf(e);
                    *(bf16*)(QD + c * GLA_PITCH + d * 2) = (bf16)f2bf(qv * e);
                    *(bf16*)(KI + c * GLA_PITCH + d * 2) = (bf16)f2bf(kv * ei);
                    const unsigned kb = f2bf(kv * (etot * ei));
                    if (i & 1) kew[i >> 1] |= kb << 16; else kew[i >> 1] = kb;
                }
                *(uint4*)(KET + d * GLA_PITCH + seg * 16) = make_uint4(kew[0], kew[1], kew[2], kew[3]);
                const int v = tid & 127, cg = tid >> 7;
                unsigned vw[8];
#pragma unroll
                for (int i = 0; i < 16; ++i) {
                    const unsigned x = *(const bf16*)(VRAW + (16 * cg + i) * 272 + v * 2);
                    if (i & 1) vw[i >> 1] |= x << 16; else vw[i >> 1] = x;
                }
                *(uint4*)(VT + v * GLA_PITCH + cg * 32) = make_uint4(vw[0], vw[1], vw[2], vw[3]);
                *(uint4*)(VT + v * GLA_PITCH + cg * 32 + 16) = make_uint4(vw[4], vw[5], vw[6], vw[7]);
            }
            __syncthreads();
            for (int blk = wid; blk < 10; blk += NWV) {
                int sblk, cblk;
                if (blk < 4) { sblk = 0; cblk = blk; } else if (blk < 7) { sblk = 1; cblk = blk - 3; } else if (blk < 9) { sblk = 2; cblk = blk - 5; } else { sblk = 3; cblk = 3; }
                f32x4_t acc = (f32x4_t){0.f, 0.f, 0.f, 0.f};
#pragma unroll
                for (int kk = 0; kk < 2; ++kk) {
                    const bf16x8 a = *(const bf16x8*)(KI + (16 * sblk + l15) * GLA_PITCH + 64 * kk + 16 * q4);
                    const bf16x8 bq = *(const bf16x8*)(QD + (16 * cblk + l15) * GLA_PITCH + 64 * kk + 16 * q4);
                    acc = __builtin_amdgcn_mfma_f32_16x16x32_bf16(a, bq, acc, 0, 0, 0);
                }
                const int c = 16 * cblk + l15, s0 = 16 * sblk + 4 * q4;
                float av[4];
#pragma unroll
                for (int r = 0; r < 4; ++r) av[r] = (s0 + r <= c) ? acc[r] : 0.f;
                *(uint2*)(AT + c * GLA_PITCH + s0 * 2) = make_uint2(pk2(av[0], av[1]), pk2(av[2], av[3]));
            }
            __syncthreads();
            {
                const int v0 = 16 * wid;
                bf16x8 bv[2], sB[2];
#pragma unroll
                for (int kk = 0; kk < 2; ++kk) {
                    bv[kk] = *(const bf16x8*)(VT + (v0 + l15) * GLA_PITCH + 64 * kk + 16 * q4);
                    uint4 w = make_uint4(pk2(S[2 * kk][0], S[2 * kk][1]), pk2(S[2 * kk][2], S[2 * kk][3]), pk2(S[2 * kk + 1][0], S[2 * kk + 1][1]), pk2(S[2 * kk + 1][2], S[2 * kk + 1][3]));
                    sB[kk] = __builtin_bit_cast(bf16x8, w);
                }
#pragma unroll
                for (int cblk = 0; cblk < 4; ++cblk) {
                    f32x4_t acc = (f32x4_t){0.f, 0.f, 0.f, 0.f};
                    const unsigned char* arow = AT + (16 * cblk + l15) * GLA_PITCH;
                    const unsigned char* qrow = QD + (16 * cblk + l15) * GLA_PITCH;
#pragma unroll
                    for (int kk = 0; kk < 2; ++kk) {
                        if (kk == 0 || cblk >= 2) {
                            const bf16x8 a = *(const bf16x8*)(arow + 64 * kk + 16 * q4);
                            acc = __builtin_amdgcn_mfma_f32_16x16x32_bf16(a, bv[kk], acc, 0, 0, 0);
                        }
                    }
#pragma unroll
                    for (int kk = 0; kk < 2; ++kk) {
                        const uint2 a0 = *(const uint2*)(qrow + 64 * kk + 8 * q4), a1 = *(const uint2*)(qrow + 64 * kk + 32 + 8 * q4);
                        uint4 aw = make_uint4(a0.x, a0.y, a1.x, a1.y);
                        acc = __builtin_amdgcn_mfma_f32_16x16x32_bf16(__builtin_bit_cast(bf16x8, aw), sB[kk], acc, 0, 0, 0);
                    }
#pragma unroll
                    for (int r = 0; r < 4; ++r) Od[(size_t)(rbase + rsgn * (16 * cblk + 4 * q4 + r)) * 512 + h * 128 + v0 + l15] = acc[r];
                }
#pragma unroll
                for (int dblk = 0; dblk < 4; ++dblk) {
#pragma unroll
                    for (int r = 0; r < 4; ++r) S[dblk][r] *= DEC[16 * dblk + 4 * q4 + r];
#pragma unroll
                    for (int kk = 0; kk < 2; ++kk) {
                        const bf16x8 a = *(const bf16x8*)(KET + (16 * dblk + l15) * GLA_PITCH + 64 * kk + 16 * q4);
                        S[dblk] = __builtin_amdgcn_mfma_f32_16x16x32_bf16(a, bv[kk], S[dblk], 0, 0, 0);
                    }
                }
            }
            if (ch + 1 < KVLEN / 64) GLA_STAGE();
            __syncthreads();
        }
    }
#undef GLA_ROWS
#undef GLA_GLOAD
#undef GLA_STAGE
}
__device__ __forceinline__ void ph_even_post(bf16* __restrict__ ATT, const float* __restrict__ lamv, const float* __restrict__ subln, float lam_init,
                             const float* __restrict__ OF, const float* __restrict__ OB, const bf16* __restrict__ P, const float* __restrict__ gain) {
    const int TID = opaque_tid(), BID = opaque_bid();
    int wave = BID * NWV + (TID >> 6), lane = TID & 63;
    int nw = gridDim.x * NWV;
    float p1 = lamv[lane] * lamv[64 + lane], p2 = lamv[128 + lane] * lamv[192 + lane];
    p1 = wave_sum(p1); p2 = wave_sum(p2);
    const float lam = expf(p1) - expf(p2) + lam_init;
    for (int r = wave; r < RT; r += nw) {
        bf16* a = ATT + (size_t)r * DM;
        float d[4][2];
#pragma unroll
        for (int h = 0; h < 4; ++h) {
            float2 o0 = ld2bf(a + (2 * h) * 128 + lane * 2);
            float2 o1 = ld2bf(a + (2 * h + 1) * 128 + lane * 2);
            d[h][0] = o0.x - lam * o1.x; d[h][1] = o0.y - lam * o1.y;
        }
        float2 outd[4];
#pragma unroll
        for (int h = 0; h < 4; ++h) {
            float s = wave_sum(d[h][0] * d[h][0] + d[h][1] * d[h][1]);
            float rstd = rsqrtf(s * (1.f / 128.f) + 1e-6f) * (1.f - lam_init);
            float2 sg = *(const float2*)(subln + lane * 2);
            outd[h] = make_float2(d[h][0] * rstd * sg.x, d[h][1] * rstd * sg.y);
        }
        float2 outg[4];
#pragma unroll
        for (int h = 0; h < 4; ++h) {
            float2 x = *(const float2*)(OF + (size_t)r * 512 + h * 128 + lane * 2);
            float2 c = *(const float2*)(OB + (size_t)r * 512 + h * 128 + lane * 2);
            float o0 = x.x + c.x, o1 = x.y + c.y;
            float s = wave_sum(o0 * o0 + o1 * o1);
            float rstd = rsqrtf(s * (1.f / 128.f) + 1e-6f);
            float2 g = *(const float2*)(gain + lane * 2);
            float2 rr = ld2bf(P + (size_t)r * EVEN_LDP + 2560 + h * 128 + lane * 2);
            outg[h] = make_float2(o0 * rstd * g.x * silu_f(rr.x), o1 * rstd * g.y * silu_f(rr.y));
        }
#pragma unroll
        for (int h = 0; h < 4; ++h) {
            st2bf(a + h * 128 + lane * 2, outd[h]);
            st2bf(a + 512 + h * 128 + lane * 2, outg[h]);
        }
    }
}
#define INS16(tv, ti, v, n) do { \
    _Pragma("unroll") for (int j_ = 15; j_ >= 1; --j_) { bool c1_ = (v) > tv[j_ - 1]; bool c2_ = (v) > tv[j_]; \
        tv[j_] = c1_ ? tv[j_ - 1] : (c2_ ? (v) : tv[j_]); ti[j_] = c1_ ? ti[j_ - 1] : (c2_ ? (n) : ti[j_]); } \
    { bool c_ = (v) > tv[0]; tv[0] = c_ ? (v) : tv[0]; ti[0] = c_ ? (n) : ti[0]; } } while (0)

__device__ __forceinline__ void ph_peer_ffn(const bf16* __restrict__ A2, const int* __restrict__ IDX, const float* __restrict__ GATE,
                            const float* __restrict__ U, const float* __restrict__ V, const float* __restrict__ mods_l, float* __restrict__ X) {
    const int TID = opaque_tid(), BID = opaque_bid();
    int wave = BID * NWV + (TID >> 6), lane = TID & 63;
    int nw = gridDim.x * NWV;
    for (int r = wave; r < RT; r += nw) {
        float4 xa[4], acc[4];
#pragma unroll
        for (int i = 0; i < 4; ++i) { xa[i] = ld4bf(A2 + (size_t)r * DM + 4 * (lane + 64 * i)); acc[i] = make_float4(0.f, 0.f, 0.f, 0.f); }
        for (int e = 0; e < 128; ++e) {
            int id = IDX[(size_t)r * 128 + e]; float g = GATE[(size_t)r * 128 + e];
            const float4* ur = (const float4*)(U + (size_t)id * DM);
            float d = 0.f;
#pragma unroll
            for (int i = 0; i < 4; ++i) { float4 u = ur[lane + 64 * i]; d += u.x * xa[i].x + u.y * xa[i].y + u.z * xa[i].z + u.w * xa[i].w; }
            d = wave_sum(d);
            float w = g * gelu_tanh(d);
            const float4* vr = (const float4*)(V + (size_t)id * DM);
#pragma unroll
            for (int i = 0; i < 4; ++i) { float4 v = vr[lane + 64 * i]; acc[i].x += w * v.x; acc[i].y += w * v.y; acc[i].z += w * v.z; acc[i].w += w * v.w; }
        }
        const float4* g5 = (const float4*)(mods_l + (size_t)row_mod(r) * MODW + 5 * DM);
        float4* xr = (float4*)(X + (size_t)r * DM);
#pragma unroll
        for (int i = 0; i < 4; ++i) { float4 x = xr[lane + 64 * i], gg = g5[lane + 64 * i];
            x.x += gg.x * acc[i].x; x.y += gg.y * acc[i].y; x.z += gg.z * acc[i].z; x.w += gg.w * acc[i].w; xr[lane + 64 * i] = x; }
    }
}
#define RT_KPITCH 144
#define INSP16(t, x) do { unsigned x_ = (x); _Pragma("unroll") for (int j_ = 0; j_ < 16; ++j_) { const unsigned h_ = max(t[j_], x_); x_ = min(t[j_], x_); t[j_] = h_; } } while (0)
__device__ __forceinline__ void ph_route_mfma(const bf16* __restrict__ Qp, const bf16* __restrict__ Kb, int* __restrict__ IDX, float* __restrict__ GATE, unsigned char* lds, int nrows) {
    const int TID = opaque_tid(), BID = opaque_bid();
    const int tid = TID, lane = tid & 63, wid = tid >> 6, r32 = lane & 31, hi = lane >> 5;
    for (int u = BID; u < (nrows / 256) * 8; u += gridDim.x) {
        const int h = u & 7, row = (u >> 3) * 256 + wid * 32 + r32;
        __syncthreads();
        for (int i = tid; i < 2 * 128 * 8; i += NT) *(uint4*)(lds + (i >> 3) * RT_KPITCH + (i & 7) * 16) = *(const uint4*)(Kb + ((size_t)h * 256 + (i >> 3)) * 64 + (i & 7) * 8);
        __syncthreads();
        unsigned L[2][16];
#pragma unroll
        for (int half = 0; half < 2; ++half) {
            bf16x8 qf[4];
            const bf16* qrow = Qp + (size_t)row * DM + h * 128 + half * 64;
#pragma unroll
            for (int s = 0; s < 4; ++s) qf[s] = *(const bf16x8*)(qrow + 16 * s + 8 * hi);
#pragma unroll
            for (int j = 0; j < 16; ++j) L[half][j] = 0u;
#pragma unroll
            for (int nb = 0; nb < 4; ++nb) {
                f32x16 acc;
#pragma unroll
                for (int r = 0; r < 16; ++r) acc[r] = 0.f;
#pragma unroll
                for (int s = 0; s < 4; ++s) {
                    const bf16x8 a = *(const bf16x8*)(lds + (half * 128 + 32 * nb + r32) * RT_KPITCH + 32 * s + 16 * hi);
                    acc = __builtin_amdgcn_mfma_f32_32x32x16_bf16(a, qf[s], acc, 0, 0, 0);
                }
#pragma unroll
                for (int r = 0; r < 16; ++r) {
                    unsigned ub = __float_as_uint(acc[r]);
                    ub = (ub & 0x80000000u) ? ~ub : (ub | 0x80000000u);
                    const unsigned x = (ub & ~127u) | (unsigned)(127 - (32 * nb + (r & 3) + 8 * (r >> 2)) - 4 * hi);
                    INSP16(L[half], x);
                }
                __builtin_amdgcn_sched_barrier(0);
            }
            unsigned o[16];
#pragma unroll
            for (int j = 0; j < 16; ++j) o[j] = __shfl_xor(L[half][j], 32);
#pragma unroll
            for (int j = 0; j < 16; ++j) INSP16(L[half], o[j]);
            __builtin_amdgcn_sched_barrier(0);
        }
        float v1[16], v2[16];
        {
            unsigned w1[4] = {0u, 0u, 0u, 0u}, w2[4] = {0u, 0u, 0u, 0u};
#pragma unroll
            for (int j = 0; j < 16; ++j) {
                unsigned a = L[0][j] & ~127u, b = L[1][j] & ~127u;
                a = (a & 0x80000000u) ? (a & 0x7fffffffu) : ~a; b = (b & 0x80000000u) ? (b & 0x7fffffffu) : ~b;
                v1[j] = __uint_as_float(a); v2[j] = __uint_as_float(b);
                w1[j >> 2] |= (127u - (L[0][j] & 127u)) << (8 * (j & 3)); w2[j >> 2] |= (127u - (L[1][j] & 127u)) << (8 * (j & 3));
            }
            unsigned char* sb = lds + 2 * 128 * RT_KPITCH + tid * 4;
#pragma unroll
            for (int k = 0; k < 4; ++k) { *(unsigned*)(sb + k * 2048) = w1[k]; *(unsigned*)(sb + (4 + k) * 2048) = w2[k]; }
        }
        unsigned T[16];
#pragma unroll
        for (int j = 0; j < 16; ++j) T[j] = 0u;
#pragma unroll
        for (int a = 0; a < 16; ++a)
#pragma unroll
            for (int b = 0; b < 16; ++b) {
                if ((a + 1) * (b + 1) <= 16) {
                    unsigned ub = __float_as_uint(v1[a] + v2[b]);
                    ub = (ub & 0x80000000u) ? ~ub : (ub | 0x80000000u);
                    const unsigned x = (ub & ~255u) | (unsigned)(255 - (16 * a + b));
                    INSP16(T, x);
                }
            }
        float e[16]; int bi[16]; float sum = 0.f, v0 = 0.f;
        {
            const unsigned char* sb = lds + 2 * 128 * RT_KPITCH + tid * 4;
#pragma unroll
            for (int j = 0; j < 16; ++j) {
                unsigned ub = T[j] & ~255u;
                ub = (ub & 0x80000000u) ? (ub & 0x7fffffffu) : ~ub;
                const float val = __uint_as_float(ub);
                if (j == 0) v0 = val;
                e[j] = __expf(val - v0); sum += e[j];
                const unsigned flat = 255u - (T[j] & 255u), ca = flat >> 4, cb = flat & 15u;
                const unsigned ia = *(const unsigned char*)(sb + (ca >> 2) * 2048 + (ca & 3)), ib = *(const unsigned char*)(sb + (4 + (cb >> 2)) * 2048 + (cb & 3));
                bi[j] = (int)(ia * 128u + ib);
            }
        }
        const float inv = 1.f / sum;
        if (hi == 0) {
            int* ip = IDX + (size_t)row * 128 + h * 16; float* gp = GATE + (size_t)row * 128 + h * 16;
#pragma unroll
            for (int j = 0; j < 4; ++j) {
                *(int4*)(ip + 4 * j) = make_int4(bi[4 * j], bi[4 * j + 1], bi[4 * j + 2], bi[4 * j + 3]);
                *(float4*)(gp + 4 * j) = make_float4(e[4 * j] * inv, e[4 * j + 1] * inv, e[4 * j + 2] * inv, e[4 * j + 3] * inv);
            }
        }
    }
    __syncthreads();
}
__device__ __forceinline__ unsigned fp6_e2m3(float v) {
    const float a = fabsf(v);
    float c;
    if (a < 2.f) c = rintf(a * 8.f);
    else if (a < 4.f) c = 16.f + rintf((a - 2.f) * 4.f);
    else c = fminf(24.f + rintf((a - 4.f) * 2.f), 31.f);
    return (unsigned)c | (v < 0.f ? 32u : 0u);
}
__device__ __forceinline__ void ph_table_prep(const float* __restrict__ U, const float* __restrict__ V, unsigned char* __restrict__ T6, float* __restrict__ RS) {
    const int TID = opaque_tid(), BID = opaque_bid();
    const int wave = BID * NWV + (TID >> 6), lane = TID & 63, nw = gridDim.x * NWV;
    const int NROWS = DEPTH * 16384;
    for (int rr = wave; rr < 2 * NROWS; rr += nw) {
        const float* src = (rr < NROWS ? U : V) + (size_t)(rr < NROWS ? rr : rr - NROWS) * DM + lane * 16;
        float4 v[4]; float am = 0.f;
#pragma unroll
        for (int i = 0; i < 4; ++i) { v[i] = ((const float4*)src)[i]; am = fmaxf(am, fmaxf(fmaxf(fabsf(v[i].x), fabsf(v[i].y)), fmaxf(fabsf(v[i].z), fabsf(v[i].w)))); }
#pragma unroll
        for (int o = 1; o < 64; o <<= 1) am = fmaxf(am, __shfl_xor(am, o));
        am = fmaxf(am, 1e-30f);
        const float sc = exp2f(floorf(log2f(7.5f / am)));
        unsigned e[16];
#pragma unroll
        for (int i = 0; i < 4; ++i) { e[4 * i] = fp6_e2m3(v[i].x * sc); e[4 * i + 1] = fp6_e2m3(v[i].y * sc); e[4 * i + 2] = fp6_e2m3(v[i].z * sc); e[4 * i + 3] = fp6_e2m3(v[i].w * sc); }
        const unsigned d0 = e[0] | (e[1] << 6) | (e[2] << 12) | (e[3] << 18) | (e[4] << 24) | (e[5] << 30);
        const unsigned d1 = (e[5] >> 2) | (e[6] << 4) | (e[7] << 10) | (e[8] << 16) | (e[9] << 22) | (e[10] << 28);
        const unsigned d2 = (e[10] >> 4) | (e[11] << 2) | (e[12] << 8) | (e[13] << 14) | (e[14] << 20) | (e[15] << 26);
        unsigned* dst = (unsigned*)(T6 + (size_t)rr * 768 + lane * 12);
        dst[0] = d0; dst[1] = d1; dst[2] = d2;
        if (lane == 0) RS[rr] = 1.f / sc;
    }
}
typedef unsigned v6u32_t __attribute__((ext_vector_type(6)));
typedef float v32f_t __attribute__((ext_vector_type(32)));
typedef __bf16 v32bf_t __attribute__((ext_vector_type(32)));
typedef unsigned v16u_t __attribute__((ext_vector_type(16)));
struct u3 { unsigned x, y, z; };
#define BR4(j) ((((j) & 1) << 3) | (((j) & 2) << 1) | (((j) & 4) >> 1) | (((j) & 8) >> 3))
__device__ __forceinline__ void ph_peer_ffn8(const bf16* A2, const int* __restrict__ IDX, const float* __restrict__ GATE,
                            const unsigned char* __restrict__ U8, const float* __restrict__ RSU, const unsigned char* __restrict__ V8, const float* __restrict__ RSV,
                            const float* __restrict__ mods_l, const float* X, float* Xout, int nrows,
                            const float* __restrict__ gnext, const float* __restrict__ mods_next, bf16* Anext) {
    const int TID = opaque_tid(), BID = opaque_bid();
    const int wave = BID * NWV + (TID >> 6), lane = TID & 63, nw = gridDim.x * NWV;
    const int jl = BR4(lane & 15);
    const unsigned lane12 = (unsigned)lane * 12u;
    for (int r = wave; r < nrows; r += nw) {
        float xf[16];
        { int lx = lane; asm volatile("" : "+v"(lx)); const uint4* xp = (const uint4*)(A2 + (size_t)r * DM + lx * 16); const uint4 a = xp[0], b = xp[1]; const unsigned xw[8] = {a.x, a.y, a.z, a.w, b.x, b.y, b.z, b.w};
#pragma unroll
          for (int i = 0; i < 8; ++i) { xf[2 * i] = __uint_as_float(xw[i] << 16); xf[2 * i + 1] = __uint_as_float(xw[i] & 0xffff0000u); } }
        float acc[16];
#pragma unroll
        for (int k = 0; k < 16; ++k) acc[k] = 0.f;
        for (int g = 0; g < 8; ++g) {
            const int myid = IDX[(size_t)r * 128 + g * 16 + jl];
            u3 ub[16], vb[16];
#pragma unroll
            for (int j = 0; j < 16; ++j) { unsigned idv; asm volatile("v_mov_b32 %0, %1" : "=v"(idv) : "s"(__builtin_amdgcn_readlane(myid, BR4(j)))); ub[j] = *(const u3*)(U8 + (idv * 768u + lane12)); }
#pragma unroll
            for (int j = 0; j < 16; ++j) { unsigned idv; asm volatile("v_mov_b32 %0, %1" : "=v"(idv) : "s"(__builtin_amdgcn_readlane(myid, BR4(j)))); vb[j] = *(const u3*)(V8 + (idv * 768u + lane12)); }
            float d[16];
#pragma unroll
            for (int j = 0; j < 16; j += 2) {
                const v6u32_t src = {ub[j].x, ub[j].y, ub[j].z, ub[j + 1].x, ub[j + 1].y, ub[j + 1].z};
                const v32f_t f = __builtin_amdgcn_cvt_scalef32_pk32_f32_fp6(src, 1.0f);
                float d0 = 0.f, d1 = 0.f;
#pragma unroll
                for (int k = 0; k < 16; ++k) { d0 = __builtin_fmaf(f[k], xf[k], d0); d1 = __builtin_fmaf(f[16 + k], xf[k], d1); }
                d[j] = d0; d[j + 1] = d1;
                __builtin_amdgcn_sched_barrier(0);
            }
#pragma unroll
            for (int st = 0; st < 4; ++st) {
                const int n = 8 >> st, bit = 1 << st;
                const bool up = (lane & bit) != 0;
#pragma unroll
                for (int i = 0; i < 8; ++i) if (i < n) {
                    const float send = up ? d[i] : d[i + n], keep = up ? d[i + n] : d[i];
                    d[i] = keep + __shfl_xor(send, bit);
                }
            }
            float tot = d[0];
            tot += __shfl_xor(tot, 16); tot += __shfl_xor(tot, 32);
            const float w = GATE[(size_t)r * 128 + g * 16 + jl] * gelu_tanh(tot * RSU[myid]) * RSV[myid];
#pragma unroll
            for (int j = 0; j < 16; j += 2) {
                const float w0 = __int_as_float(__builtin_amdgcn_readlane(__float_as_int(w), BR4(j))), w1 = __int_as_float(__builtin_amdgcn_readlane(__float_as_int(w), BR4(j + 1)));
                const v6u32_t src = {vb[j].x, vb[j].y, vb[j].z, vb[j + 1].x, vb[j + 1].y, vb[j + 1].z};
                const v32f_t f = __builtin_amdgcn_cvt_scalef32_pk32_f32_fp6(src, 1.0f);
#pragma unroll
                for (int k = 0; k < 16; ++k) { acc[k] = __builtin_fmaf(w0, f[k], acc[k]); acc[k] = __builtin_fmaf(w1, f[16 + k], acc[k]); }
                __builtin_amdgcn_sched_barrier(0);
            }
        }
        int re = __builtin_amdgcn_readfirstlane(r); asm volatile("" : "+s"(re)); int le = lane; asm volatile("" : "+v"(le));
        const float4* g5 = (const float4*)(mods_l + (size_t)row_mod(re) * MODW + 5 * DM + le * 16);
        const float4* xr = (const float4*)(X + (size_t)re * DM + le * 16);
        float4 xn[4]; float ss = 0.f;
#pragma unroll
        for (int i = 0; i < 4; ++i) { float4 xv = xr[i], gg = g5[i];
            xv.x += gg.x * acc[4 * i]; xv.y += gg.y * acc[4 * i + 1]; xv.z += gg.z * acc[4 * i + 2]; xv.w += gg.w * acc[4 * i + 3]; xn[i] = xv;
            ss += xv.x * xv.x + xv.y * xv.y + xv.z * xv.z + xv.w * xv.w; }
        float4* xo = (float4*)(Xout + (size_t)re * DM + le * 16);
#pragma unroll
        for (int i = 0; i < 4; ++i) xo[i] = xn[i];
        if (gnext) {
            const float rstd = rsqrtf(wave_sum(ss) * (1.f / DM) + 1e-6f);
            const float* mn = mods_next + (size_t)row_mod(re) * MODW + le * 16;
            bf16* ar = Anext + (size_t)re * DM + le * 16;
#pragma unroll
            for (int i = 0; i < 4; ++i) {
                const float4 gg = ((const float4*)(gnext + le * 16))[i], sh = ((const float4*)mn)[i], sc = ((const float4*)(mn + DM))[i];
                float4 o;
                o.x = xn[i].x * rstd * gg.x * (1.f + sc.x) + sh.x; o.y = xn[i].y * rstd * gg.y * (1.f + sc.y) + sh.y;
                o.z = xn[i].z * rstd * gg.z * (1.f + sc.z) + sh.z; o.w = xn[i].w * rstd * gg.w * (1.f + sc.w) + sh.w;
                st4bf(ar + 4 * i, o);
            }
        }
    }
}
template <int N>
__device__ __forceinline__ void ph_gemm_bf16(const bf16* A, const bf16* Bt, bf16* O, unsigned char* lds) {
    pg8::Gemm g{A, Bt, RT, N, DM}; pg8::StaticOrder S; S.init(RT, N, (int)gridDim.x, opaque_bid());
    pg8::EpiBf16<0> E{O, N, nullptr, 0, 0, 1.f};
    pg8::gemm_phase<pg8::EpiBf16<0>, pg8::StaticOrder, true, true>((PG8_LAS unsigned char*)lds, g, S, E);
}
__device__ __forceinline__ void ph_gemm_res(const bf16* A, const bf16* Bt, float* X, const float* gate, unsigned char* lds) {
    pg8::Gemm g{A, Bt, RT, DM, DM}; pg8::StaticOrder S; S.init(RT, DM, (int)gridDim.x, opaque_bid());
    EpiResGate E{X, gate};
    pg8::gemm_phase<EpiResGate, pg8::StaticOrder, true, true>((PG8_LAS unsigned char*)lds, g, S, E);
}

#define XB_TMO      128
#define XB_XCNT(j)  (256  + 64 * (j))
#define XB_XSUB(j)  (1280 + 64 * (j))
#define XB_XGEN(j)  (2304 + 64 * (j))
#define XB_TOP      3328
#define XB_TOPGEN   3392
#define XCD_BAR_WORDS 3456
#define XB_SPIN_CAP (1u << 18)

__device__ __forceinline__ unsigned xb_ld(unsigned* p)              { return __hip_atomic_load(p, __ATOMIC_RELAXED, __HIP_MEMORY_SCOPE_AGENT); }
__device__ __forceinline__ unsigned xb_add(unsigned* p, unsigned v) { return __hip_atomic_fetch_add(p, v, __ATOMIC_RELAXED, __HIP_MEMORY_SCOPE_AGENT); }
__device__ __forceinline__ unsigned xb_xcc_id() { return (unsigned)__builtin_amdgcn_s_getreg((3 << 11) | 20) & 0xFu; }
#define XB_SPIN(cond, bar) do { unsigned _sp = 0; while (cond) { __builtin_amdgcn_s_sleep(1); \
    if ((++_sp & 255u) == 0u) { if (xb_ld(&(bar)[XB_TMO])) break; if (_sp > XB_SPIN_CAP) { atomicAdd(&(bar)[XB_TMO], 1u); break; } } } } while (0)

struct XcdBarrier {
    unsigned* bar; unsigned x;
    volatile LAS unsigned* st;
};

__device__ __forceinline__ XcdBarrier xcd_barrier_post(unsigned* bar, volatile LAS unsigned* st) {
    XcdBarrier b; b.bar = bar; b.x = xb_xcc_id(); b.st = st;
    if (threadIdx.x == 0) (void)xb_add(&bar[XB_XCNT(b.x)], 1u);
    return b;
}
__device__ __forceinline__ void xcd_barrier_complete(unsigned* bar, unsigned x, unsigned& nloc, unsigned& nx) {
    const unsigned G = gridDim.x * gridDim.y * gridDim.z;
    unsigned sum, cnt, mine, sp = 0u;
    for (;;) {
        sum = 0u; cnt = 0u; mine = 0u;
#pragma unroll
        for (unsigned j = 0; j < 16; ++j) { const unsigned c = xb_ld(&bar[XB_XCNT(j)]); sum += c; cnt += (c > 0u) ? 1u : 0u; mine = (j == x) ? c : mine; }
        if (sum == G) break;
        __builtin_amdgcn_s_sleep(1);
        if ((++sp & 255u) == 0u) { if (xb_ld(&bar[XB_TMO])) break; if (sp > XB_SPIN_CAP) { atomicAdd(&bar[XB_TMO], 1u); break; } }
    }
    nloc = mine > 0u ? mine : 1u; nx = cnt > 0u ? cnt : 1u;
}

__device__ __forceinline__ void xcd_barrier(const XcdBarrier& b) {
    asm volatile("s_waitcnt vmcnt(0)" ::: "memory");
    __syncthreads();
    if (threadIdx.x == 0) {
        unsigned* bar = b.bar;
        __builtin_amdgcn_s_waitcnt(0);
        unsigned nloc = b.st[0], nx = b.st[1];
        if (nloc == 0u) { xcd_barrier_complete(bar, b.x, nloc, nx); b.st[0] = nloc; b.st[1] = nx; }
        const unsigned old = xb_add(&bar[XB_XSUB(b.x)], 1u);
        const unsigned gen = old / nloc;
        if (old + 1u == (gen + 1u) * nloc) {
            __builtin_amdgcn_fence(__ATOMIC_RELEASE, "agent");
            asm volatile("s_waitcnt vmcnt(0)" ::: "memory");
            const unsigned og = xb_add(&bar[XB_TOP], 1u);
            const unsigned tg = og / nx;
            if (og + 1u == (tg + 1u) * nx) xb_add(&bar[XB_TOPGEN], 1u);
            else XB_SPIN(xb_ld(&bar[XB_TOPGEN]) == tg, bar);
            __builtin_amdgcn_fence(__ATOMIC_ACQUIRE, "agent");
            xb_add(&bar[XB_XGEN(b.x)], 1u);
            asm volatile("s_waitcnt vmcnt(0)" ::: "memory");
        } else {
            XB_SPIN(xb_ld(&bar[XB_XGEN(b.x)]) == gen, bar);
            __builtin_amdgcn_fence(__ATOMIC_ACQUIRE, "agent");
            asm volatile("s_waitcnt vmcnt(0)" ::: "memory");
        }
    }
    __syncthreads();
}

constexpr size_t ALIGN_UP(size_t x) { return (x + 255) & ~(size_t)255; }
constexpr size_t WS_X = 0;
constexpr size_t WS_A = WS_X + (size_t)RT * DM * 4;
constexpr size_t WS_P = WS_A + (size_t)RT * DM * 2;
constexpr size_t WS_ATT = WS_P + (size_t)RT * EVEN_LDP * 2;
constexpr size_t WS_OF = WS_ATT + (size_t)RT * DM * 2;
constexpr size_t WS_MODS = WS_OF + (size_t)RT * 512 * 4 * 2;
constexpr size_t WS_ROPE = WS_MODS + ALIGN_UP((size_t)DEPTH * NMOD * MODW * 4);
constexpr size_t WS_WINE = WS_ROPE + (size_t)SEQ * 32 * 8;
constexpr size_t WS_WOUTE = WS_WINE + (size_t)2 * EVEN_LDP * DM * 2;
constexpr size_t WS_WINO = WS_WOUTE + (size_t)2 * DM * DM * 2;
constexpr size_t WS_WOUTO = WS_WINO + (size_t)2 * ODD_IN * DM * 2;
constexpr size_t WS_WPQ = WS_WOUTO + (size_t)2 * DM * DM * 2;
constexpr size_t WS_T8 = WS_WPQ + (size_t)4 * DM * DM * 2;
constexpr size_t WS_RS = WS_T8 + (size_t)2 * DEPTH * 16384 * DM;
constexpr size_t WS_KC = WS_RS + (size_t)2 * DEPTH * 16384 * 4;
constexpr size_t WS_VT = WS_KC + (size_t)NB * 8 * KVLEN * 64 * 2;
constexpr size_t WS_KEYS = WS_VT + (size_t)NB * 4 * 128 * KVLEN * 2;
constexpr size_t WS_BAR = WS_KEYS + (size_t)DEPTH * 8 * 2 * 128 * 64 * 2;
constexpr size_t WS_BAR_BYTES = 16384;
constexpr size_t WS_END = WS_BAR + WS_BAR_BYTES;

__global__ void __launch_bounds__(NT, 2) mega(Params p) {
    extern __shared__ __attribute__((aligned(16))) unsigned char lds[];
    float* smem = (float*)lds;
    cg::grid_group grid = cg::this_grid();
    unsigned char* ws = p.ws;
    volatile LAS unsigned* bst = (volatile LAS unsigned*)((LAS unsigned char*)lds + 131072 + 512);
    if (threadIdx.x < 2) bst[threadIdx.x] = 0u;
    __syncthreads();
    (void)xcd_barrier_post((unsigned*)(ws + WS_BAR), bst);
#define GSYNC() do { XcdBarrier b_; b_.bar = (unsigned*)(ws + WS_BAR); b_.x = xb_xcc_id(); b_.st = (volatile LAS unsigned*)((LAS unsigned char*)lds + 131072 + 512); xcd_barrier(b_); } while (0)
#define X_ ((float*)(ws + WS_X))
#define A_ ((bf16*)(ws + WS_A))
#define P_ ((bf16*)(ws + WS_P))
#define ATT_ ((bf16*)(ws + WS_ATT))
#define OF_ ((float*)(ws + WS_OF))
#define OB_ (OF_ + (size_t)RT * 512)
#define MODS_ ((float*)(ws + WS_MODS))
#define ROPE_ ((float2*)(ws + WS_ROPE))
#define WINE_ ((bf16*)(ws + WS_WINE))
#define WOUTE_ ((bf16*)(ws + WS_WOUTE))
#define WINO_ ((bf16*)(ws + WS_WINO))
#define WOUTO_ ((bf16*)(ws + WS_WOUTO))
#define WPQ_ ((bf16*)(ws + WS_WPQ))
#define QP_ P_
#define KEYS_ ((bf16*)(ws + WS_KEYS))
#define KC_ ((bf16*)(ws + WS_KC))
#define VT_ ((bf16*)(ws + WS_VT))
#define T8_ (ws + WS_T8)
#define RS_ ((float*)(ws + WS_RS))
#define IDX_ ((int*)(ws + WS_P + (size_t)RT * DM * 2))
#define GATE_ ((float*)(ws + WS_P + (size_t)RT * DM * 2 + (size_t)RT * 128 * 4))

    ph_copy_in(p.in[0], p.in[2], X_);
    ph_rope_table(ROPE_);
    ph_weight_prep(p.in, WINE_, WOUTE_, WINO_, WOUTO_, WPQ_, KEYS_, lds);
    ph_table_prep(p.in[25], p.in[26], T8_, RS_);
    __syncthreads();
    ph_mods(p.in[1], p.in[3], p.in[4], p.in[5], MODS_, smem);
    grid.sync();
    ph_norm_mod(X_, p.in[6], MODS_, 0, A_);
    GSYNC();
    for (int hl = 0; hl < 2 * DEPTH; ++hl) {
        ws = p.ws; asm volatile("" : "+s"(ws));
        const int l = hl >> 1, part = hl & 1, i = l >> 1, odd = l & 1;
        const float* mods_l = MODS_ + (size_t)l * NMOD * MODW;
        if (part) {
            ph_norm_mod(X_, p.in[7] + l * DM, mods_l, 3, A_);
            GSYNC();
        }
        if (part) ph_gemm_bf16<DM>(A_, WPQ_ + (size_t)l * DM * DM, P_, lds);
        else if (odd) ph_gemm_bf16<ODD_IN>(A_, WINO_ + (size_t)i * ODD_IN * DM, P_, lds);
        else ph_gemm_bf16<EVEN_LDP>(A_, WINE_ + (size_t)i * EVEN_LDP * DM, P_, lds);
        GSYNC();
        if (part == 0) {
            const int ldp = odd ? ODD_IN : EVEN_LDP;
            ph_post(P_, ldp, odd ? 16 : 8, odd ? 1024 : 512, odd ? 4 : 8, odd ? 1280 : 1024, odd ? 256 : 512, odd ? 64 : 128,
                    (odd ? p.in[21] : p.in[10]) + i * 64, (odd ? p.in[22] : p.in[11]) + i * 64, ROPE_, KC_, VT_);
            GSYNC();
            if (!odd) {
                const int G_ = (int)gridDim.x, bid_ = (int)blockIdx.x;
                const int gu = (G_ == 256) ? (((bid_ >> 3) < 16) ? (bid_ & 7) * 16 + (bid_ >> 3) : -1) : bid_;
                ph_gla_chunk(P_, p.in[14] + i * 16 * 256, p.in[15] + i * 256, p.in[16] + i * 16 * 256, p.in[17] + i * 256, OF_, OB_, lds, gu, (G_ == 256) ? 1 << 20 : G_);
            }
            ph_attn_mfma(P_, ldp, KC_, VT_, ATT_, odd, l < DEPTH - 1, lds, (odd ? p.in[21] : p.in[10]) + i * 64, (odd ? p.in[22] : p.in[11]) + i * 64);
            GSYNC();
            if (!odd) {
                const float lam_init = 0.8f - 0.6f * expf(-0.3f * (float)l);
                ph_even_post(ATT_, p.in[12] + i * 256, p.in[13] + i * 128, lam_init, OF_, OB_, P_, p.in[18] + i * 128);
                GSYNC();
            }
            ph_gemm_res(ATT_, odd ? WOUTO_ + (size_t)i * DM * DM : WOUTE_ + (size_t)i * DM * DM, X_, mods_l + 2 * DM, lds);
            GSYNC();
        } else {
            const int last = (l == DEPTH - 1);
            const int nrows = last ? RL : RT;
            ph_route_mfma(QP_, KEYS_ + (size_t)l * 8 * 2 * 128 * 64, IDX_, GATE_, lds, nrows);
            GSYNC();
            ph_peer_ffn8(A_, IDX_, GATE_, T8_ + (size_t)l * 16384 * 768, RS_ + l * 16384, T8_ + (size_t)(DEPTH + l) * 16384 * 768, RS_ + (DEPTH + l) * 16384, mods_l,
                         X_, last ? p.out : X_, nrows, last ? nullptr : p.in[6] + (l + 1) * DM, mods_l + NMOD * MODW, A_);
            if (!last) GSYNC();
        }
    }
}

extern "C" void kernel_launch(void* const* d_in, const int* in_sizes, int n_in, void* d_out, int out_size, void* d_ws, size_t ws_size, hipStream_t stream) {
    static int grid_blocks = 0;
    if (!grid_blocks) {
        int dev = 0, cus = 0, per_cu = 0;
        (void)hipGetDevice(&dev);
        (void)hipDeviceGetAttribute(&cus, hipDeviceAttributeMultiprocessorCount, dev);
        (void)hipFuncSetAttribute((const void*)mega, hipFuncAttributeMaxDynamicSharedMemorySize, LDS_BYTES);
        (void)hipOccupancyMaxActiveBlocksPerMultiprocessor(&per_cu, mega, NT, LDS_BYTES);
        if (per_cu < 1) fprintf(stderr, "occupancy query says %d blocks/CU\n", per_cu);
        grid_blocks = cus;
        if (ws_size < WS_END) fprintf(stderr, "workspace too small: %zu < %zu\n", ws_size, (size_t)WS_END);
    }
    (void)hipMemsetAsync((unsigned char*)d_ws + WS_BAR, 0, WS_BAR_BYTES, stream);
    Params p{};
    for (int i = 0; i < 27; ++i) p.in[i] = (const float*)d_in[i];
    p.out = (float*)d_out; p.ws = (unsigned char*)d_ws;
    void* args[] = {&p};
    hipError_t e = hipLaunchCooperativeKernel((void*)mega, dim3(grid_blocks), dim3(NT), args, LDS_BYTES, stream);
    if (e != hipSuccess) fprintf(stderr, "cooperative launch failed: %s (grid %d)\n", hipGetErrorString(e), grid_blocks);
}
```

```cpp
#include <hip/hip_runtime.h>
#include <hip/hip_cooperative_groups.h>
#include <stdint.h>
#include <cstdio>
namespace cg = cooperative_groups;

#define DM 1024
#define NB 16
#define SEQ 2048
#define CTX 256
#define RL (NB * SEQ)
#define RC (NB * CTX)
#define RT (RL + RC)
#define DEPTH 4
#define EVEN_IN 3104
#define EVEN_LDP 3328
#define ODD_IN 1536
#define NMOD 17
#define MODW 6144
#define NT 512
#define NWV 8
#define LDS_BYTES 147456
#ifndef DUP_FFN
#define DUP_FFN 0
#endif
#ifndef DUP_ROUTE
#define DUP_ROUTE 0
#endif
#ifndef DUP_ATTN
#define DUP_ATTN 0
#endif
#ifndef DUP_GEMM
#define DUP_GEMM 0
#endif

typedef unsigned short bf16;
typedef float f32x2_t __attribute__((ext_vector_type(2)));
typedef __bf16 bf16x2_t __attribute__((ext_vector_type(2)));
struct Params {
    const float* in[27];
    float* out;
    unsigned char* ws;
};

__device__ __forceinline__ int row_mod(int r) { return r < RL ? (r >> 11) : 16; }
__device__ __forceinline__ float silu_f(float x) { return x / (1.f + expf(-x)); }
__device__ __forceinline__ float wave_sum(float v) {
#pragma unroll
    for (int o = 1; o < 64; o <<= 1) v += __shfl_xor(v, o);
    return v;
}
__device__ __forceinline__ float log_sigmoid_f(float z) { return fminf(z, 0.f) - log1pf(expf(-fabsf(z))); }
__device__ __forceinline__ float gelu_tanh(float x) { float u = 0.7978845608028654f * (x + 0.044715f * x * x * x); return 0.5f * x * (1.f + tanhf(u)); }
__device__ __forceinline__ float bf2f(bf16 v) { return __uint_as_float((unsigned)v << 16); }
__device__ __forceinline__ unsigned f2bf(float f) { unsigned u = __float_as_uint(f); return (u + 0x7fffu + ((u >> 16) & 1u)) >> 16; }
__device__ __forceinline__ unsigned pk2(float lo, float hi) { return f2bf(lo) | (f2bf(hi) << 16); }
__device__ __forceinline__ float4 ld4bf(const bf16* p) { uint2 u = *(const uint2*)p; return make_float4(__uint_as_float(u.x << 16), __uint_as_float(u.x & 0xffff0000u), __uint_as_float(u.y << 16), __uint_as_float(u.y & 0xffff0000u)); }
__device__ __forceinline__ void st4bf(bf16* p, float4 v) { *(uint2*)p = make_uint2(pk2(v.x, v.y), pk2(v.z, v.w)); }
__device__ __forceinline__ float2 ld2bf(const bf16* p) { unsigned u = *(const unsigned*)p; return make_float2(__uint_as_float(u << 16), __uint_as_float(u & 0xffff0000u)); }
__device__ __forceinline__ void st2bf(bf16* p, float2 v) { *(unsigned*)p = pk2(v.x, v.y); }

__device__ __forceinline__ int opaque_tid() { int t = threadIdx.x; asm volatile("" : "+v"(t)); return t; }
__device__ __forceinline__ int opaque_bid() { int b = blockIdx.x; asm volatile("" : "+s"(b)); return b; }

namespace pg8 {
#define PG8_LAS __attribute__((address_space(3)))
typedef unsigned short bf16_t;
typedef short bf16x8 __attribute__((ext_vector_type(8)));
typedef float f32x4 __attribute__((ext_vector_type(4)));
typedef unsigned u32x4 __attribute__((ext_vector_type(4)));
constexpr int BM = 256, BK = 64, HALF = 128, HTB = HALF * BK * 2  , STAGE_BYTES = 8 * HTB, NXCD = 8, WGM = 8;

__host__ __device__ __forceinline__ int lds_byte(int r, int c) { const int st = (r >> 4) * 2 + (c >> 5), rr = r & 15, cc = c & 31, ob = rr * 64 + cc * 2; return st * 1024 + (ob ^ (((ob >> 9) & 1) << 5)); }
__host__ __device__ __forceinline__ void stage_rc(int b, int& R, int& C) { const int st = b / 1024, sb = b % 1024, swz = sb ^ (((sb >> 9) & 1) << 5); R = (st >> 1) * 16 + swz / 64; C = (st & 1) * 32 + (swz % 64) / 2; }
__host__ __device__ __forceinline__ int perm32(int rho) { const int n = rho >> 4, i = rho & 15; return 8 * (i >> 2) + 4 * n + (i & 3); }

struct Unit { int pm, pn; };
struct Gemm { const bf16_t* A; const bf16_t* Bt; int M, N, K; };

struct StaticOrder {
    int nM, nN, nwg, G, c;
    __host__ __device__ void init(int M, int N, int G_, int c_) { nM = M / BM; nN = N / BM; nwg = nM * nN; G = G_; c = c_; }
    __host__ __device__ bool next(int i, Unit& u) const {
        const long L = (long)i * G + c; if (L >= nwg) return false;
        int wgid = (int)L; { const int q = nwg / NXCD, r = nwg % NXCD, xcd = wgid % NXCD, off = wgid / NXCD; wgid = (xcd < r ? xcd * (q + 1) : r * (q + 1) + (xcd - r) * q) + off; }
        const int nig = WGM * nN, gid = wgid / nig, fm = gid * WGM, gsz = (nM - fm) < WGM ? (nM - fm) : WGM;
        u.pm = fm + ((wgid % nig) % gsz); u.pn = (wgid % nig) / gsz; return true;
    }
    __device__ __forceinline__ void a_ready(const Unit&) const {}
    __device__ __forceinline__ void done(const Unit&) const {}
};

__device__ __forceinline__ unsigned cvt_pk_bf16(float lo, float hi) { unsigned r; asm volatile("v_cvt_pk_bf16_f32 %0, %1, %2" : "=v"(r) : "v"(lo), "v"(hi)); return r; }
typedef float f32x2 __attribute__((ext_vector_type(2)));
__device__ __forceinline__ f32x2 gelu_pk(f32x2 v) {
    const f32x2 av = __builtin_elementwise_abs(v), d = av * 0.2316418882f + 1.0f;
    f32x2 t; t.x = __builtin_amdgcn_rcpf(d.x); t.y = __builtin_amdgcn_rcpf(d.y);
    f32x2 q = t * 0.5307027145f + (-0.7265760135f); q = q * t + 0.7107068705f; q = q * t + (-0.142248368f); q = q * t + 0.127414796f; q = q * t;
    const f32x2 s = (v * v) * (-0.72134752044f);
    f32x2 e; e.x = __builtin_amdgcn_exp2f(s.x); e.y = __builtin_amdgcn_exp2f(s.y);
    const f32x2 m = v * (q * e), r = v - m;
    f32x2 o; o.x = v.x < 0.f ? m.x : r.x; o.y = v.y < 0.f ? m.y : r.y; return o;
}

template <int ACT  > struct EpiBf16 {
    static constexpr bool PERM = true, AFTER_DRAIN = false; static_assert(ACT == 0 || ACT == 1, "EpiBf16: ACT is 0 (none) or 1 (gelu_pk)");
    bf16_t* O; int ldc; const float* bias; int split_cols; size_t split_stride; float scale0;
    __device__ __forceinline__ void operator()(const f32x4 (&acc)[2][2][4][2], const Unit& u, int wr, int wc, int fr, int fq) const {
        const int row0 = u.pm * BM + wr * 64 + fr; int colt = u.pn * BM; bf16_t* base = O;
        float sc = 1.f; if (split_cols) { const int t = colt / split_cols; base += (size_t)t * split_stride; colt -= t * split_cols; if (t == 0) sc = scale0; }
        const int col0 = colt + wc * 32 + 8 * fq, bcol0 = u.pn * BM + wc * 32 + 8 * fq;
        f32x4 bv[2][2];
#pragma unroll
        for (int bj = 0; bj < 2; ++bj)
#pragma unroll
            for (int n = 0; n < 2; ++n) bv[bj][n] = bias ? *(const f32x4*)(bias + bcol0 + bj * HALF + 4 * n) : (f32x4){0.f, 0.f, 0.f, 0.f};
#pragma unroll
        for (int ai = 0; ai < 2; ++ai)
#pragma unroll
            for (int m = 0; m < 4; ++m) { bf16_t* rowp = base + (size_t)(row0 + ai * HALF + m * 16) * ldc + col0;
#pragma unroll
                for (int bj = 0; bj < 2; ++bj) { f32x4 v0 = acc[ai][bj][m][0] + bv[bj][0], v1 = acc[ai][bj][m][1] + bv[bj][1];
                    if (ACT == 1) { f32x2 a = gelu_pk((f32x2){v0[0], v0[1]}), b = gelu_pk((f32x2){v0[2], v0[3]}), c = gelu_pk((f32x2){v1[0], v1[1]}), d = gelu_pk((f32x2){v1[2], v1[3]});
                        v0 = (f32x4){a.x, a.y, b.x, b.y}; v1 = (f32x4){c.x, c.y, d.x, d.y}; }
                    v0 = v0 * sc; v1 = v1 * sc; u32x4 w; w.x = cvt_pk_bf16(v0[0], v0[1]); w.y = cvt_pk_bf16(v0[2], v0[3]); w.z = cvt_pk_bf16(v1[0], v1[1]); w.w = cvt_pk_bf16(v1[2], v1[3]);
                    *(u32x4*)(rowp + bj * HALF) = w; } }
    }
};
template <class Epi, class Sched, bool ALIGN_EPI = false, bool SP2 = false>
__device__ __forceinline__ void gemm_phase(PG8_LAS unsigned char* lds, const Gemm g, const Sched& S, const Epi& E) {
    const int tid = opaque_tid(), wid = __builtin_amdgcn_readfirstlane(tid >> 6), lane = tid & 63, wr = wid >> 2, wc = wid & 3, fr = lane & 15, fq = lane >> 4;
    const int K = g.K, nt = K / BK;
    unsigned voffA[2], voffB[2];
#pragma unroll
    for (int i = 0; i < 2; ++i) { int R, C; stage_rc(tid * 16 + i * 8192, R, C); const int Rb = Epi::PERM ? ((R & ~31) + perm32(R & 31)) : R;
        voffA[i] = (unsigned)(R * K + C) * 2u; voffB[i] = (unsigned)(Rb * K + C) * 2u; }
    const size_t kstep = (size_t)(BK * 2);
    const size_t hstep = (size_t)HALF * K * 2;
    const size_t tstep = 2 * hstep;
    const unsigned ldsw = (unsigned)wid * 1024u;
    const int aoff = lds_byte(wr * 64 + fr, fq * 8), boff = lds_byte(wc * 32 + fr, fq * 8);
#define PG8_SA(b, h) (((b) * 2 + (h)) * HTB)
#define PG8_SB(b, h) ((4 + (b) * 2 + (h)) * HTB)
#define PG8_STAGE(bufoff, gbase, voff) do { _Pragma("unroll") for (int _i = 0; _i < 2; ++_i) \
        __builtin_amdgcn_global_load_lds((const unsigned*)((const char*)(gbase) + (voff)[_i]), (PG8_LAS unsigned*)(lds + (bufoff) + ldsw + _i * 8192), 16, 0, 0); } while (0)
#define PG8_LDA(dst, b, h) do { _Pragma("unroll") for (int m = 0; m < 4; ++m) _Pragma("unroll") for (int k = 0; k < 2; ++k) dst[m][k] = *(const PG8_LAS bf16x8*)(lds + PG8_SA(b, h) + aoff + m * 2048 + k * 1024); } while (0)
#define PG8_LDB(dst, b, h) do { _Pragma("unroll") for (int n = 0; n < 2; ++n) _Pragma("unroll") for (int k = 0; k < 2; ++k) dst[n][k] = *(const PG8_LAS bf16x8*)(lds + PG8_SB(b, h) + boff + n * 2048 + k * 1024); } while (0)
#define PG8_MMA(ai, bj, At, Bt) do { __builtin_amdgcn_s_setprio(1); _Pragma("unroll") for (int m = 0; m < 4; ++m) _Pragma("unroll") for (int n = 0; n < 2; ++n) _Pragma("unroll") for (int k = 0; k < 2; ++k) \
        acc[ai][bj][m][n] = __builtin_amdgcn_mfma_f32_16x16x32_bf16(Bt[n][k], At[m][k], acc[ai][bj][m][n], 0, 0, 0); __builtin_amdgcn_s_setprio(0); } while (0)
#define PG8_WAIT_V(n) asm volatile("s_waitcnt vmcnt(" #n ")" ::: "memory")
#define PG8_WAIT_L(n) asm volatile("s_waitcnt lgkmcnt(" #n ")" ::: "memory")
#define PG8_BAR __builtin_amdgcn_s_barrier()
#define PG8_SCHED __builtin_amdgcn_sched_barrier(0)
    Unit cur, nxt; int ui = 0;
    if (!S.next(0, cur)) return;
    f32x4 acc[2][2][4][2];
#pragma unroll
    for (int a = 0; a < 2; ++a)
#pragma unroll
        for (int b = 0; b < 2; ++b)
#pragma unroll
            for (int m = 0; m < 4; ++m)
#pragma unroll
                for (int n = 0; n < 2; ++n) acc[a][b][m][n] = (f32x4){0.f, 0.f, 0.f, 0.f};
    bf16x8 At[4][2], B0[2][2], B1[2][2];
    const char* cA = (const char*)g.A + (size_t)cur.pm * tstep; const char* cB = (const char*)g.Bt + (size_t)cur.pn * tstep;
    S.a_ready(cur);
    if constexpr (SP2) {
        PG8_STAGE(PG8_SB(0, 0), cB, voffB); PG8_STAGE(PG8_SB(0, 1), cB + hstep, voffB); PG8_STAGE(PG8_SA(0, 0), cA, voffA); PG8_STAGE(PG8_SA(0, 1), cA + hstep, voffA);
        if (wr == 1) PG8_BAR;
        PG8_WAIT_V(2); PG8_BAR;
        PG8_STAGE(PG8_SB(1, 0), cB + kstep, voffB); PG8_STAGE(PG8_SA(1, 0), cA + kstep, voffA); PG8_STAGE(PG8_SB(1, 1), cB + hstep + kstep, voffB);
        PG8_WAIT_V(6); PG8_BAR;
    } else {
        PG8_STAGE(PG8_SB(0, 0), cB, voffB); PG8_STAGE(PG8_SA(0, 0), cA, voffA); PG8_STAGE(PG8_SB(0, 1), cB + hstep, voffB); PG8_STAGE(PG8_SA(0, 1), cA + hstep, voffA);
        if (wr == 1) PG8_BAR;
        PG8_WAIT_V(4); PG8_BAR;
        PG8_STAGE(PG8_SB(1, 0), cB + kstep, voffB); PG8_STAGE(PG8_SA(1, 0), cA + kstep, voffA); PG8_STAGE(PG8_SB(1, 1), cB + hstep + kstep, voffB);
        PG8_WAIT_V(6); PG8_BAR;
    }
    for (;;) {
        const bool has_next = S.next(ui + 1, nxt);
        const char* nA = has_next ? (const char*)g.A + (size_t)nxt.pm * tstep : cA; const char* nB = has_next ? (const char*)g.Bt + (size_t)nxt.pn * tstep : cB;
        for (int t = 0; t < nt; t += 2) {
            const bool last = (t == nt - 2);
            const char* a1 = cA + (size_t)(t + 1) * kstep;
            const char* a2 = last ? nA : cA + (size_t)(t + 2) * kstep; const char* b2 = last ? nB : cB + (size_t)(t + 2) * kstep;
            const char* a3 = a2 + kstep; const char* b3 = b2 + kstep;
            if (last && has_next) S.a_ready(nxt);
            if constexpr (SP2) {
            PG8_LDB(B0, 0, 0); PG8_LDB(B1, 0, 1); PG8_SCHED; PG8_LDA(At, 0, 0); PG8_STAGE(PG8_SA(1, 1), a1 + hstep, voffA);
            PG8_WAIT_V(8); PG8_WAIT_L(0); PG8_BAR; PG8_MMA(0, 0, At, B0); PG8_MMA(0, 1, At, B1); PG8_BAR; PG8_SCHED;
            PG8_LDA(At, 0, 1); PG8_STAGE(PG8_SB(0, 0), b2, voffB); PG8_STAGE(PG8_SB(0, 1), b2 + hstep, voffB); PG8_STAGE(PG8_SA(0, 0), a2, voffA);
            PG8_WAIT_V(8); PG8_WAIT_L(0); PG8_BAR; PG8_MMA(1, 0, At, B0); PG8_MMA(1, 1, At, B1); PG8_BAR; PG8_SCHED;
            PG8_LDB(B0, 1, 0); PG8_LDB(B1, 1, 1); PG8_SCHED; PG8_LDA(At, 1, 0); PG8_STAGE(PG8_SA(0, 1), a2 + hstep, voffA);
            PG8_WAIT_V(8); PG8_WAIT_L(0); PG8_BAR; PG8_MMA(0, 0, At, B0); PG8_MMA(0, 1, At, B1); PG8_BAR; PG8_SCHED;
            PG8_LDA(At, 1, 1); PG8_STAGE(PG8_SB(1, 0), b3, voffB); PG8_STAGE(PG8_SB(1, 1), b3 + hstep, voffB); PG8_STAGE(PG8_SA(1, 0), a3, voffA);
            PG8_WAIT_V(8); PG8_WAIT_L(0); PG8_BAR; PG8_MMA(1, 0, At, B0); PG8_MMA(1, 1, At, B1); PG8_BAR; PG8_SCHED;
            } else {
            PG8_LDB(B0, 0, 0); PG8_SCHED; PG8_LDA(At, 0, 0); PG8_STAGE(PG8_SA(1, 1), a1 + hstep, voffA);
            PG8_WAIT_L(8); PG8_BAR; PG8_WAIT_L(0); PG8_MMA(0, 0, At, B0); PG8_BAR; PG8_SCHED;
            PG8_LDB(B1, 0, 1); PG8_STAGE(PG8_SB(0, 0), b2, voffB);
            PG8_BAR; PG8_WAIT_L(0); PG8_MMA(0, 1, At, B1); PG8_BAR;
            PG8_LDA(At, 0, 1); PG8_STAGE(PG8_SA(0, 0), a2, voffA);
            PG8_BAR; PG8_WAIT_L(0); PG8_MMA(1, 0, At, B0); PG8_BAR; PG8_SCHED;
            PG8_STAGE(PG8_SB(0, 1), b2 + hstep, voffB);
            PG8_WAIT_V(6); PG8_BAR; PG8_MMA(1, 1, At, B1); PG8_BAR;
            PG8_LDB(B0, 1, 0); PG8_SCHED; PG8_LDA(At, 1, 0); PG8_STAGE(PG8_SA(0, 1), a2 + hstep, voffA);
            PG8_WAIT_L(8); PG8_BAR; PG8_WAIT_L(0); PG8_MMA(0, 0, At, B0); PG8_BAR; PG8_SCHED;
            PG8_LDB(B1, 1, 1); PG8_STAGE(PG8_SB(1, 0), b3, voffB);
            PG8_BAR; PG8_WAIT_L(0); PG8_MMA(0, 1, At, B1); PG8_BAR;
            PG8_LDA(At, 1, 1); PG8_STAGE(PG8_SA(1, 0), a3, voffA);
            PG8_BAR; PG8_WAIT_L(0); PG8_MMA(1, 0, At, B0); PG8_BAR; PG8_SCHED;
            PG8_STAGE(PG8_SB(1, 1), b3 + hstep, voffB);
            PG8_WAIT_V(6); PG8_BAR; PG8_MMA(1, 1, At, B1); PG8_BAR;
            }
        }
        if constexpr (ALIGN_EPI) { if (wr == 0) PG8_BAR; }
        if constexpr (!Epi::AFTER_DRAIN) { E(acc, cur, wr, wc, fr, fq); S.done(cur); }
        if (!has_next) break;
#pragma unroll
        for (int a = 0; a < 2; ++a)
#pragma unroll
            for (int b = 0; b < 2; ++b)
#pragma unroll
                for (int m = 0; m < 4; ++m)
#pragma unroll
                    for (int n = 0; n < 2; ++n) acc[a][b][m][n] = (f32x4){0.f, 0.f, 0.f, 0.f};
        cur = nxt; cA = nA; cB = nB; ++ui;
        if constexpr (ALIGN_EPI) { if (wr == 1) PG8_BAR; }
    }
    PG8_WAIT_V(0);
    if constexpr (!ALIGN_EPI) { if (wr == 0) PG8_BAR; }
    PG8_BAR;
    if constexpr (Epi::AFTER_DRAIN) { E.fused(acc, cur, wr, wc, fr, fq, lds, wid, lane); S.done(cur); }
#undef PG8_SA
#undef PG8_SB
#undef PG8_STAGE
#undef PG8_LDA
#undef PG8_LDB
#undef PG8_MMA
#undef PG8_WAIT_V
#undef PG8_WAIT_L
#undef PG8_BAR
#undef PG8_SCHED
}
}

struct EpiResGate {
    static constexpr bool PERM = false, AFTER_DRAIN = false;
    float* X; const float* gate;
    __device__ __forceinline__ void operator()(const pg8::f32x4 (&acc)[2][2][4][2], const pg8::Unit& u, int wr, int wc, int fr, int fq) const {
#pragma unroll
        for (int ai = 0; ai < 2; ++ai)
#pragma unroll
            for (int m = 0; m < 4; ++m) {
                const int r = u.pm * 256 + ai * 128 + wr * 64 + m * 16 + fr;
                const float* g = gate + (size_t)row_mod(r) * MODW; float* xr = X + (size_t)r * DM;
#pragma unroll
                for (int bj = 0; bj < 2; ++bj)
#pragma unroll
                    for (int n = 0; n < 2; ++n) {
                        const int c = u.pn * 256 + bj * 128 + wc * 32 + n * 16 + 4 * fq;
                        pg8::f32x4 xv = *(const pg8::f32x4*)(xr + c); const pg8::f32x4 gv = *(const pg8::f32x4*)(g + c);
                        xv = xv + gv * acc[ai][bj][m][n];
                        *(pg8::f32x4*)(xr + c) = xv;
                    }
            }
    }
};
#define LAS __attribute__((address_space(3)))
#define GAS __attribute__((address_space(1)))

__device__ __forceinline__ void ph_copy_in(const float* __restrict__ x, const float* __restrict__ ctx, float* __restrict__ X) {
    const int TID = opaque_tid(), BID = opaque_bid();
    size_t i = (size_t)BID * NT + TID;
    const size_t n4 = (size_t)RT * DM / 4, nl4 = (size_t)RL * DM / 4;
    for (; i < n4; i += (size_t)gridDim.x * NT) ((float4*)X)[i] = i < nl4 ? ((const float4*)x)[i] : ((const float4*)ctx)[i - nl4];
}
__device__ __forceinline__ void ph_copy_out(const float* __restrict__ X, float* __restrict__ out) {
    const int TID = opaque_tid(), BID = opaque_bid();
    size_t i = (size_t)BID * NT + TID;
    const size_t n4 = (size_t)RL * DM / 4;
    for (; i < n4; i += (size_t)gridDim.x * NT) ((float4*)out)[i] = ((const float4*)X)[i];
}
__device__ __forceinline__ void ph_rope_table(float2* __restrict__ rope) {
    const int TID = opaque_tid(), BID = opaque_bid();
    for (int i = BID * NT + TID; i < SEQ * 32; i += gridDim.x * NT) {
        int t = i >> 5, a = (i >> 4) & 1, f = i & 15;
        float pos = a == 0 ? (float)(t >> 6) : (float)(t & 63);
        float inv = powf(10000.f, -(float)f / 16.f);
        float ang = pos * inv;
        rope[i] = make_float2(cosf(ang), sinf(ang));
    }
}
__device__ __forceinline__ void transpose_item(const float* __restrict__ W, int N, bf16* __restrict__ WT, LAS float* scr, int item, int lane) {
    const int K = DM;
    const int nblk = N / 32, kb = item / nblk, nb = item % nblk, k0 = 64 * kb, n0 = 32 * nb;
#pragma unroll 8
    for (int i = 0; i < 32; ++i) { const int kk = 2 * i + (lane >> 5); scr[kk * 33 + (lane & 31)] = W[(size_t)(k0 + kk) * N + n0 + (lane & 31)]; }
    asm volatile("s_waitcnt lgkmcnt(0)" ::: "memory");
    const int c = lane & 7;
#pragma unroll
    for (int j = 0; j < 4; ++j) { const int n = (lane >> 3) + 8 * j; const LAS float* s = scr + (8 * c) * 33 + n;
        uint4 o; o.x = pk2(s[0 * 33], s[1 * 33]); o.y = pk2(s[2 * 33], s[3 * 33]); o.z = pk2(s[4 * 33], s[5 * 33]); o.w = pk2(s[6 * 33], s[7 * 33]);
        *(uint4*)(WT + (size_t)(n0 + n) * K + k0 + 8 * c) = o; }
    asm volatile("s_waitcnt lgkmcnt(0)" ::: "memory");
}
struct WPrep { const float* src[12]; bf16* dst[12]; };
__device__ __forceinline__ void ph_weight_prep(const float* const* in, bf16* WinE, bf16* WoutE, bf16* WinO, bf16* WoutO, bf16* Wpq, bf16* Kb, unsigned char* lds) {
    const int TID = opaque_tid(), BID = opaque_bid();
    const int lane = TID & 63, wv = TID >> 6;
    LAS float* scr = (LAS float*)((LAS unsigned char*)lds + wv * 16384);
    const int gw = BID * NWV + wv, NGW = gridDim.x * NWV;
    const int NITEMS = 2 * 1552 + 2 * 512 + 2 * 768 + 2 * 512 + 4 * 512;
    for (int it = gw; it < NITEMS; it += NGW) {
        int r = it;
        if (r < 3104) { int i = r / 1552; transpose_item(in[8] + (size_t)i * DM * EVEN_IN, EVEN_IN, WinE + (size_t)i * EVEN_LDP * DM, scr, r % 1552, lane); continue; } r -= 3104;
        if (r < 1024) { int i = r / 512; transpose_item(in[9] + (size_t)i * DM * DM, DM, WoutE + (size_t)i * DM * DM, scr, r % 512, lane); continue; } r -= 1024;
        if (r < 1536) { int i = r / 768; transpose_item(in[19] + (size_t)i * DM * ODD_IN, ODD_IN, WinO + (size_t)i * ODD_IN * DM, scr, r % 768, lane); continue; } r -= 1536;
        if (r < 1024) { int i = r / 512; transpose_item(in[20] + (size_t)i * DM * DM, DM, WoutO + (size_t)i * DM * DM, scr, r % 512, lane); continue; } r -= 1024;
        { int i = r / 512; transpose_item(in[23] + (size_t)i * DM * DM, DM, Wpq + (size_t)i * DM * DM, scr, r % 512, lane); }
    }
    for (int i4 = BID * NT + TID; i4 < DEPTH * 8 * 2 * 128 * 64 / 4; i4 += gridDim.x * NT) st4bf(Kb + 4 * (size_t)i4, ((const float4*)in[24])[i4]);
    for (int i = BID * NT + TID; i < 2 * 28672; i += gridDim.x * NT) {
        int w = i / 28672, o = i % 28672;
        ((uint4*)(WinE + (size_t)w * EVEN_LDP * DM + (size_t)EVEN_IN * DM))[o] = make_uint4(0u, 0u, 0u, 0u);
    }
}
__device__ __forceinline__ void ph_mods(const float* __restrict__ c, const float* __restrict__ cctx, const float* __restrict__ w_mod,
                        const float* __restrict__ b_mod, float* __restrict__ mods, float* smem) {
    const int TID = opaque_tid(), BID = opaque_bid();
    const int nslab = DEPTH * MODW / 128;
    if (BID >= nslab) return;
    const int lane = TID & 63, wv = TID >> 6, cl = lane & 15, kp = lane >> 4;
    float (*S)[DM] = (float (*)[DM])smem;
    for (int i = TID; i < NMOD * DM; i += NT) {
        int j = i / DM, k = i % DM;
        float v = j < 16 ? c[j * DM + k] : cctx[k];
        S[j][k] = silu_f(v);
    }
    __syncthreads();
    for (int slab = BID; slab < nslab; slab += gridDim.x) {
        const int l = slab / 48, n = (slab % 48) * 128 + wv * 16 + cl;
        const float* W = w_mod + (size_t)l * DM * MODW + n;
        float acc[NMOD];
#pragma unroll
        for (int j = 0; j < NMOD; ++j) acc[j] = 0.f;
#pragma unroll 4
        for (int kk = 0; kk < 256; ++kk) {
            const int k = kp * 256 + kk;
            const float w = W[(size_t)k * MODW];
#pragma unroll
            for (int j = 0; j < NMOD; ++j) acc[j] += S[j][k] * w;
        }
        const float bias = b_mod[l * MODW + n];
#pragma unroll
        for (int j = 0; j < NMOD; ++j) {
            float v = acc[j];
            v += __shfl_xor(v, 16); v += __shfl_xor(v, 32);
            if (kp == 0) mods[((size_t)l * NMOD + j) * MODW + n] = v + bias;
        }
    }
    __syncthreads();
}
__device__ __forceinline__ void ph_norm_mod(const float* __restrict__ X, const float* __restrict__ g, const float* __restrict__ mods_l, int shift_chunk, bf16* __restrict__ A) {
    const int TID = opaque_tid(), BID = opaque_bid();
    int wave = BID * NWV + (TID >> 6), lane = TID & 63;
    int nw = gridDim.x * NWV;
    for (int r = wave; r < RT; r += nw) {
        const float4* xr = (const float4*)(X + (size_t)r * DM);
        float4 v[4]; float s = 0.f;
#pragma unroll
        for (int i = 0; i < 4; ++i) { v[i] = xr[lane + 64 * i]; s += v[i].x * v[i].x + v[i].y * v[i].y + v[i].z * v[i].z + v[i].w * v[i].w; }
        s = wave_sum(s);
        float rstd = rsqrtf(s * (1.f / DM) + 1e-6f);
        const float* m = mods_l + (size_t)row_mod(r) * MODW;
        const float4* sh = (const float4*)(m + shift_chunk * DM);
        const float4* sc = (const float4*)(m + (shift_chunk + 1) * DM);
        const float4* g4 = (const float4*)g;
        bf16* ar = A + (size_t)r * DM;
#pragma unroll
        for (int i = 0; i < 4; ++i) {
            int c = lane + 64 * i;
            float4 gg = g4[c], a = sh[c], b = sc[c], o;
            o.x = v[i].x * rstd * gg.x * (1.f + b.x) + a.x;
            o.y = v[i].y * rstd * gg.y * (1.f + b.y) + a.y;
            o.z = v[i].z * rstd * gg.z * (1.f + b.z) + a.z;
            o.w = v[i].w * rstd * gg.w * (1.f + b.w) + a.w;
            st4bf(ar + 4 * c, o);
        }
    }
}
#define KVLEN (CTX + SEQ)
__device__ __forceinline__ void ph_post(bf16* __restrict__ P, int ldp, int nq, int kcol0, int nk, int vcol0, int VC, int DV,
                                        const float* __restrict__ qgain, const float* __restrict__ kgain, const float2* __restrict__ rope,
                                        bf16* __restrict__ Kc, bf16* __restrict__ Vt) {
    const int TID = opaque_tid(), BID = opaque_bid();
    const float C2 = 0.125f * 1.4426950408889634f;
    for (int tile = BID; tile < RT / 64; tile += gridDim.x) {
        const int r0 = tile * 64;
        int b, j0;
        if (r0 < RL) { b = r0 >> 11; j0 = CTX + (r0 & (SEQ - 1)); } else { b = (r0 - RL) >> 8; j0 = (r0 - RL) & (CTX - 1); }
        const int nh = nq + nk, sub = TID & 7;
        for (int ti = TID; ti < 64 * nh * 8; ti += NT) {
            const int item = ti >> 3, row = item / nh, hh = item % nh, r = r0 + row;
            const bool isk = hh >= nq; const int h = isk ? hh - nq : hh;
            bf16* src = P + (size_t)r * ldp + (isk ? kcol0 : 0) + h * 64 + sub * 8;
            const float* gain = (isk ? kgain : qgain) + sub * 8;
            const uint4 raw = *(const uint4*)src;
            const unsigned rw[4] = {raw.x, raw.y, raw.z, raw.w};
            float v[8]; float ssq = 0.f;
#pragma unroll
            for (int i = 0; i < 4; ++i) { v[2 * i] = __uint_as_float(rw[i] << 16); v[2 * i + 1] = __uint_as_float(rw[i] & 0xffff0000u); ssq += v[2 * i] * v[2 * i] + v[2 * i + 1] * v[2 * i + 1]; }
            ssq += __shfl_xor(ssq, 1); ssq += __shfl_xor(ssq, 2); ssq += __shfl_xor(ssq, 4);
            const float rstd = rsqrtf(ssq * (1.f / 64.f) + 1e-6f) * (isk ? 1.f : C2);
            const float4 g0 = ((const float4*)gain)[0], g1 = ((const float4*)gain)[1];
            const float gg[8] = {g0.x, g0.y, g0.z, g0.w, g1.x, g1.y, g1.z, g1.w};
#pragma unroll
            for (int i = 0; i < 8; ++i) v[i] = v[i] * rstd * gg[i];
            float pv[8];
#pragma unroll
            for (int i = 0; i < 8; ++i) pv[i] = __shfl_xor(v[i], 2);
            if (r < RL) {
                const float2* tab = rope + (size_t)(r & (SEQ - 1)) * 32 + (sub >> 2) * 16 + (sub & 1) * 8;
                const bool second = (sub & 2) != 0;
#pragma unroll
                for (int i = 0; i < 8; ++i) { const float2 cs = tab[i]; v[i] = second ? (v[i] * cs.x + pv[i] * cs.y) : (v[i] * cs.x - pv[i] * cs.y); }
            }
            bf16* dst = isk ? Kc + ((size_t)(b * nk + h) * KVLEN + j0 + row) * 64 + sub * 8 : src;
            *(uint4*)dst = make_uint4(pk2(v[0], v[1]), pk2(v[2], v[3]), pk2(v[4], v[5]), pk2(v[6], v[7]));
        }
        if (TID < VC) {
            const int c8 = TID >> 3, rg = TID & 7;
            unsigned in[8][4];
#pragma unroll
            for (int rr = 0; rr < 8; ++rr) { uint4 t = *(const uint4*)(P + (size_t)(r0 + rg * 8 + rr) * ldp + vcol0 + c8 * 8); in[rr][0] = t.x; in[rr][1] = t.y; in[rr][2] = t.z; in[rr][3] = t.w; }
#pragma unroll
            for (int c = 0; c < 8; ++c) {
                unsigned o[4];
#pragma unroll
                for (int q = 0; q < 4; ++q)
                    o[q] = (c & 1) ? __builtin_amdgcn_perm(in[2 * q + 1][c >> 1], in[2 * q][c >> 1], 0x07060302u) : __builtin_amdgcn_perm(in[2 * q + 1][c >> 1], in[2 * q][c >> 1], 0x05040100u);
                const int col = c8 * 8 + c, vh = col / DV, d = col % DV;
                bf16* vrow = Vt + ((size_t)(b * 4 + vh) * DV + d) * KVLEN + j0 + 16 * (rg >> 1) + 4 * (rg & 1);
                *(uint2*)vrow = make_uint2(o[0], o[1]);
                *(uint2*)(vrow + 8) = make_uint2(o[2], o[3]);
            }
        }
    }
}
typedef short bf16x8 __attribute__((ext_vector_type(8)));
typedef float f32x16 __attribute__((ext_vector_type(16)));
__device__ __forceinline__ int crow(int r, int hi) { return (r & 3) + 8 * (r >> 2) + 4 * hi; }
__device__ __forceinline__ unsigned cvt_pk_bf16_f32(float lo, float hi) { f32x2_t v = {lo, hi}; bf16x2_t b = __builtin_convertvector(v, bf16x2_t); return __builtin_bit_cast(unsigned, b); }
__device__ __forceinline__ float max3f(float a, float b, float c) { return fmaxf(fmaxf(a, b), c); }
__device__ __forceinline__ float max2f(float a, float b) { return fmaxf(a, b); }
#define ATT_KPITCH 144
#define ATT_VPITCH 144
template <int DV>
__device__ __forceinline__ void attn_unit(const bf16* __restrict__ Qbase, int ldq, const bf16* __restrict__ Kc, const bf16* __restrict__ Vt, int ntiles,
                                          bf16* __restrict__ Obase, int ldo, unsigned char* lds, int tid, float shift) {
    constexpr int NDB = DV / 32, NVL = DV / 64, KBYTES = 64 * ATT_KPITCH, VBYTES = DV * ATT_VPITCH;
    constexpr float THR = 8.f;
    const int lane = tid & 63, wid = tid >> 6, r32 = lane & 31, hi = lane >> 5;
    unsigned char* Kb0 = lds; unsigned char* Vb0 = lds + 2 * KBYTES;
    float* sc = (float*)(lds + 2 * KBYTES + 2 * VBYTES + wid * 128);
    bf16x8 qf[4];
    {
        const bf16* qrow = Qbase + (size_t)(wid * 32 + r32) * ldq;
#pragma unroll
        for (int s = 0; s < 4; ++s) qf[s] = *(const bf16x8*)(qrow + 16 * s + 8 * hi);
    }
    f32x16 o[NDB];
#pragma unroll
    for (int d = 0; d < NDB; ++d)
#pragma unroll
        for (int r = 0; r < 16; ++r) o[d][r] = 0.f;
    float l = 0.f;
    uint4 kreg, vreg0, vreg1 = make_uint4(0u, 0u, 0u, 0u);
    const int krow = tid >> 3, kch = tid & 7;
    const unsigned voff0 = (unsigned)(tid >> 3) * (unsigned)(KVLEN * 2) + (unsigned)(tid & 7) * 16u, voff1 = voff0 + 64u * (unsigned)(KVLEN * 2);
    const unsigned vlds0 = (unsigned)(tid >> 3) * ATT_VPITCH + (unsigned)(tid & 7) * 16u, vlds1 = vlds0 + 64u * ATT_VPITCH;
#define ATT_GLOAD_K(t) do { kreg = *(const uint4*)((const unsigned char*)Kc + ((unsigned)(t) * 8192u + (unsigned)tid * 16u)); } while (0)
#define ATT_GLOAD_V(t) do { vreg0 = *(const uint4*)((const unsigned char*)Vt + (voff0 + (unsigned)(t) * 128u)); if (NVL == 2) vreg1 = *(const uint4*)((const unsigned char*)Vt + (voff1 + (unsigned)(t) * 128u)); } while (0)
#define ATT_STORE_K(buf) do { *(uint4*)(Kb0 + (buf) * KBYTES + krow * ATT_KPITCH + kch * 16) = kreg; } while (0)
#define ATT_STORE_V(buf) do { *(uint4*)(Vb0 + (buf) * VBYTES + vlds0) = vreg0; if (NVL == 2) *(uint4*)(Vb0 + (buf) * VBYTES + vlds1) = vreg1; } while (0)
#define ATT_QK(S0, S1, buf) do { const unsigned char* kb_ = Kb0 + (buf) * KBYTES; \
        _Pragma("unroll") for (int r = 0; r < 16; ++r) { S0[r] = 0.f; S1[r] = 0.f; } \
        _Pragma("unroll") for (int s = 0; s < 4; ++s) { \
            const bf16x8 a0 = *(const bf16x8*)(kb_ + r32 * ATT_KPITCH + s * 32 + hi * 16); \
            const bf16x8 a1 = *(const bf16x8*)(kb_ + (32 + r32) * ATT_KPITCH + s * 32 + hi * 16); \
            S0 = __builtin_amdgcn_mfma_f32_32x32x16_bf16(a0, qf[s], S0, 0, 0, 0); \
            S1 = __builtin_amdgcn_mfma_f32_32x32x16_bf16(a1, qf[s], S1, 0, 0, 0); } } while (0)
    ATT_GLOAD_K(0); ATT_GLOAD_V(0);
    ATT_STORE_K(0); ATT_STORE_V(0); ATT_STORE_V(1);
    if (ntiles > 1) { ATT_GLOAD_K(1); ATT_STORE_K(1); }
    __syncthreads();
    f32x16 s0, s1;
    ATT_QK(s0, s1, 0);
    __syncthreads();
    uint4 pa0 = make_uint4(0u, 0u, 0u, 0u), pa1 = pa0, pa2 = pa0, pa3 = pa0;
#define ATT_PA(s) __builtin_bit_cast(bf16x8, (s) == 0 ? pa0 : (s) == 1 ? pa1 : (s) == 2 ? pa2 : pa3)
    for (int t = 0; t < ntiles; ++t) {
        if (t + 2 < ntiles) ATT_GLOAD_K(t + 2);
        if (t > 0) ATT_GLOAD_V(t);
        if (shift != 0.f) {
#pragma unroll
            for (int r = 0; r < 16; ++r) { s0[r] -= shift; s1[r] -= shift; }
        }
        f32x16 n0, n1;
        ATT_QK(n0, n1, (t + 1) & 1);
        {
            const unsigned char* vb = Vb0 + ((t + 1) & 1) * VBYTES;
#pragma unroll
            for (int d = 0; d < NDB; ++d) {
#pragma unroll
                for (int s = 0; s < 4; ++s) {
                    const bf16x8 vf = *(const bf16x8*)(vb + (32 * d + r32) * ATT_VPITCH + 32 * s + 16 * hi);
                    o[d] = __builtin_amdgcn_mfma_f32_32x32x16_bf16(ATT_PA(s), vf, o[d], 0, 0, 0);
                }
            }
        }
        float ps = 0.f;
#pragma unroll
        for (int r = 0; r < 16; ++r) { s0[r] = __builtin_amdgcn_exp2f(s0[r]); s1[r] = __builtin_amdgcn_exp2f(s1[r]); ps += s0[r] + s1[r]; }
        l += ps;
        uint4 pn0 = make_uint4(cvt_pk_bf16_f32(s0[0], s0[1]), cvt_pk_bf16_f32(s0[2], s0[3]), cvt_pk_bf16_f32(s0[4], s0[5]), cvt_pk_bf16_f32(s0[6], s0[7]));
        uint4 pn1 = make_uint4(cvt_pk_bf16_f32(s0[8], s0[9]), cvt_pk_bf16_f32(s0[10], s0[11]), cvt_pk_bf16_f32(s0[12], s0[13]), cvt_pk_bf16_f32(s0[14], s0[15]));
        uint4 pn2 = make_uint4(cvt_pk_bf16_f32(s1[0], s1[1]), cvt_pk_bf16_f32(s1[2], s1[3]), cvt_pk_bf16_f32(s1[4], s1[5]), cvt_pk_bf16_f32(s1[6], s1[7]));
        uint4 pn3 = make_uint4(cvt_pk_bf16_f32(s1[8], s1[9]), cvt_pk_bf16_f32(s1[10], s1[11]), cvt_pk_bf16_f32(s1[12], s1[13]), cvt_pk_bf16_f32(s1[14], s1[15]));
        asm volatile("" : "+v"(pn0.x), "+v"(pn0.y), "+v"(pn0.z), "+v"(pn0.w), "+v"(pn1.x), "+v"(pn1.y), "+v"(pn1.z), "+v"(pn1.w));
        asm volatile("" : "+v"(pn2.x), "+v"(pn2.y), "+v"(pn2.z), "+v"(pn2.w), "+v"(pn3.x), "+v"(pn3.y), "+v"(pn3.z), "+v"(pn3.w), "+v"(l));
        __builtin_amdgcn_sched_group_barrier(0x100, 4, 0);
#pragma unroll
        for (int i = 0; i < 8 + 4 * NDB; ++i) {
            __builtin_amdgcn_sched_group_barrier(0x008, 1, 0);
            __builtin_amdgcn_sched_group_barrier(0x100, 1, 0);
            __builtin_amdgcn_sched_group_barrier(0x002, NDB == 2 ? 5 : 4, 0);
            __builtin_amdgcn_sched_group_barrier(0x400, NDB == 2 ? 2 : 1, 0);
        }
        if (t + 2 < ntiles) ATT_STORE_K(t & 1);
        if (t > 0) ATT_STORE_V(t & 1);
        __syncthreads();
        s0 = n0; s1 = n1;
        pa0 = pn0; pa1 = pn1; pa2 = pn2; pa3 = pn3;
    }
    {
        const unsigned char* vb = Vb0 + ((ntiles - 1) & 1) * VBYTES;
#pragma unroll
        for (int d = 0; d < NDB; ++d) {
#pragma unroll
            for (int s = 0; s < 4; ++s) {
                const bf16x8 vf = *(const bf16x8*)(vb + (32 * d + r32) * ATT_VPITCH + 32 * s + 16 * hi);
                o[d] = __builtin_amdgcn_mfma_f32_32x32x16_bf16(ATT_PA(s), vf, o[d], 0, 0, 0);
            }
        }
    }
#undef ATT_GLOAD_K
#undef ATT_GLOAD_V
#undef ATT_STORE_K
#undef ATT_STORE_V
#undef ATT_QK
#undef ATT_PA
    l += __shfl_xor(l, 32);
    if (hi == 0) sc[r32] = 1.f / l;
    int tide = tid; asm volatile("" : "+v"(tide));
    const unsigned obase_off = (unsigned)(((tide >> 6) * 32 + 4 * ((tide >> 5) & 1)) * ldo + (tide & 31)) * 2u;
#pragma unroll
    for (int r = 0; r < 16; ++r) {
        const float iv = sc[crow(r, hi)];
        bf16* orow = (bf16*)((unsigned char*)Obase + (obase_off + (unsigned)(((r & 3) + 8 * (r >> 2)) * ldo) * 2u));
#pragma unroll
        for (int d = 0; d < NDB; ++d) orow[32 * d] = (bf16)f2bf(o[d][r] * iv);
    }
    __syncthreads();
}
__device__ __forceinline__ void attn_run_unit(const bf16* __restrict__ P, int ldp, const bf16* __restrict__ Kc, const bf16* __restrict__ Vt, bf16* __restrict__ ATT,
                                              int odd, int u, int nlat, unsigned char* lds, int TID, float shift) {
    int b, qh, row0, ntiles;
    if (u < nlat) {
        if (odd) { const int grp = u >> 5, w = u & 31; b = grp >> 2; qh = (grp & 3) * 4 + (w >> 3); row0 = b * SEQ + (w & 7) * 256; }
        else { const int grp = u >> 4, w = u & 15; b = grp >> 2; qh = (grp & 3) * 2 + (w >> 3); row0 = b * SEQ + (w & 7) * 256; }
        ntiles = KVLEN / 64;
    } else {
        const int idx = u - nlat;
        if (odd) { b = idx >> 4; qh = idx & 15; } else { b = idx >> 3; qh = idx & 7; }
        row0 = RL + b * CTX; ntiles = CTX / 64;
    }
    if (odd) attn_unit<64>(P + (size_t)row0 * ldp + qh * 64, ldp, Kc + (size_t)(b * 4 + (qh >> 2)) * KVLEN * 64, Vt + (size_t)(b * 4 + (qh >> 2)) * 64 * KVLEN, ntiles,
                           ATT + (size_t)row0 * DM + qh * 64, DM, lds, TID, shift);
    else attn_unit<128>(P + (size_t)row0 * ldp + qh * 64, ldp, Kc + (size_t)(b * 8 + qh) * KVLEN * 64, Vt + (size_t)(b * 4 + (qh >> 1)) * 128 * KVLEN, ntiles,
                        ATT + (size_t)row0 * DM + qh * 128, DM, lds, TID, shift);
}
__device__ __forceinline__ void ph_attn_mfma(const bf16* __restrict__ P, int ldp, const bf16* __restrict__ Kc, const bf16* __restrict__ Vt, bf16* __restrict__ ATT,
                                             int odd, int with_ctx, unsigned char* lds, const float* __restrict__ qgain, const float* __restrict__ kgain) {
    const int TID = opaque_tid(), BID = opaque_bid();
    float shift;
    {
        float gq = fabsf(qgain[TID & 63]), gk = fabsf(kgain[TID & 63]);
#pragma unroll
        for (int o = 1; o < 64; o <<= 1) { gq = fmaxf(gq, __shfl_xor(gq, o)); gk = fmaxf(gk, __shfl_xor(gk, o)); }
        shift = fmaxf(8.f * 1.4426950408889634f * gq * gk * 1.002f + 0.01f - 100.f, 0.f);
        shift = __int_as_float(__builtin_amdgcn_readfirstlane(__float_as_int(shift)));
    }
    const int G = gridDim.x, vcu = (G % 8 == 0) ? (BID & 7) * (G >> 3) + (BID >> 3) : BID;
    const int nlat = odd ? 2048 : 1024, nctx = with_ctx ? (odd ? 256 : 128) : 0;
    if (!odd && G == 256) {
        const int x = BID & 7, w = BID >> 3;
        if (w >= 16) { for (int i = 0; i < 5; ++i) attn_run_unit(P, ldp, Kc, Vt, ATT, odd, x * 128 + 16 * i + (w - 16), nlat, lds, TID, shift); }
        else {
            for (int i = 5; i < 8; ++i) attn_run_unit(P, ldp, Kc, Vt, ATT, odd, x * 128 + 16 * i + w, nlat, lds, TID, shift);
            if (nctx) attn_run_unit(P, ldp, Kc, Vt, ATT, odd, nlat + x * 16 + w, nlat, lds, TID, shift);
        }
        return;
    }
    for (int u = vcu; u < nlat + nctx; u += G) attn_run_unit(P, ldp, Kc, Vt, ATT, odd, u, nlat, lds, TID, shift);
}
typedef float f32x4_t __attribute__((ext_vector_type(4)));
#define GLA_PITCH 144
__device__ __forceinline__ void ph_gla_chunk(const bf16* __restrict__ P, const float* __restrict__ w_af, const float* __restrict__ b_af,
                                             const float* __restrict__ w_ab, const float* __restrict__ b_ab, float* __restrict__ OF, float* __restrict__ OB, unsigned char* lds, int unit0, int ustride) {
    const int TID = opaque_tid(), BID = opaque_bid();
    const int tid = TID, lane = tid & 63, wid = tid >> 6, l15 = lane & 15, q4 = lane >> 4;
    float* SEG = (float*)lds;
    float* DEC = (float*)(lds + 2048);
    unsigned char* QD = lds + 4096;
    unsigned char* KI = QD + 9216;
    unsigned char* KET = KI + 9216;
    unsigned char* AT = KET + 9216;
    unsigned char* VT = AT + 9216;
    unsigned char* QRAW = VT + 18432;
    unsigned char* KRAW = QRAW + 9216;
    unsigned char* VRAW = KRAW + 9216;
    unsigned char* GRAW = VRAW + 64 * 272;
#define GLA_ROWS(ch_, rb_, rs_) do { if (!dir) { rb_ = (ch_) < 4 ? RL + b * CTX + (ch_) * 64 : b * SEQ + ((ch_) - 4) * 64; rs_ = 1; } \
        else { rb_ = (ch_) < 4 ? RL + b * CTX + (CTX - 1 - (ch_) * 64) : b * SEQ + (SEQ - 1 - ((ch_) - 4) * 64); rs_ = -1; } } while (0)
#define GLA_GLOAD(ch_) do { int rb_, rs_; GLA_ROWS(ch_, rb_, rs_); \
        const bf16* pq_ = P + (size_t)(rb_ + rs_ * (tid >> 3)) * EVEN_LDP + h * 64 + (tid & 7) * 8; rq = *(const uint4*)(pq_ + 1536); rk = *(const uint4*)(pq_ + 1792); \
        rv0 = *(const uint4*)(P + (size_t)(rb_ + rs_ * (tid >> 4)) * EVEN_LDP + 2048 + h * 128 + (tid & 15) * 8); \
        rv1 = *(const uint4*)(P + (size_t)(rb_ + rs_ * (32 + (tid >> 4))) * EVEN_LDP + 2048 + h * 128 + (tid & 15) * 8); \
        if (tid < 128) rg = *(const uint4*)(P + (size_t)(rb_ + rs_ * (tid >> 1)) * EVEN_LDP + 3072 + dir * 16 + (tid & 1) * 8); } while (0)
#define GLA_STAGE() do { *(uint4*)(QRAW + (tid >> 3) * GLA_PITCH + (tid & 7) * 16) = rq; *(uint4*)(KRAW + (tid >> 3) * GLA_PITCH + (tid & 7) * 16) = rk; \
        *(uint4*)(VRAW + (tid >> 4) * 272 + (tid & 15) * 16) = rv0; *(uint4*)(VRAW + (32 + (tid >> 4)) * 272 + (tid & 15) * 16) = rv1; \
        if (tid < 128) *(uint4*)(GRAW + (tid >> 1) * 32 + (tid & 1) * 16) = rg; } while (0)
    for (int unit = unit0; unit >= 0 && unit < NB * 4 * 2; unit += ustride) {
        const int dir = unit & 1, h = (unit >> 1) & 3, b = unit >> 3;
        const float* wa = dir ? w_ab : w_af; const float* ba = dir ? b_ab : b_af;
        float* Od = dir ? OB : OF;
        const int d = tid & 63, seg = tid >> 6;
        float wreg[16];
#pragma unroll
        for (int j = 0; j < 16; ++j) wreg[j] = wa[j * 256 + h * 64 + d];
        const float breg = ba[h * 64 + d];
        { unsigned z_; asm volatile("v_mov_b32 %0, 0" : "=v"(z_)); for (int i = tid; i < 9216 / 16; i += NT) ((uint4*)AT)[i] = make_uint4(z_, z_, z_, z_); }
        f32x4_t S[4];
#pragma unroll
        for (int i = 0; i < 4; ++i) S[i] = (f32x4_t){0.f, 0.f, 0.f, 0.f};
        uint4 rq, rk, rv0, rv1, rg = make_uint4(0u, 0u, 0u, 0u);
        GLA_GLOAD(0);
        GLA_STAGE();
        __syncthreads();
        for (int ch = 0; ch < KVLEN / 64; ++ch) {
            int rbase, rsgn;
            GLA_ROWS(ch, rbase, rsgn);
            if (ch + 1 < KVLEN / 64) GLA_GLOAD(ch + 1);
            float cl[8];
            {
                float run = 0.f;
#pragma unroll
                for (int i = 0; i < 8; ++i) {
                    const uint4 g0 = *(const uint4*)(GRAW + (8 * seg + i) * 32), g1 = *(const uint4*)(GRAW + (8 * seg + i) * 32 + 16);
                    const unsigned gw[8] = {g0.x, g0.y, g0.z, g0.w, g1.x, g1.y, g1.z, g1.w};
                    float z = breg;
#pragma unroll
                    for (int j = 0; j < 8; ++j) { z += __uint_as_float(gw[j] << 16) * wreg[2 * j]; z += __uint_as_float(gw[j] & 0xffff0000u) * wreg[2 * j + 1]; }
                    run += (fminf(z, 0.f) - __logf(1.f + __expf(-fabsf(z)))) * (1.f / 16.f);
                    cl[i] = run;
                }
                SEG[seg * 64 + d] = run;
            }
            __syncthreads();
            {
                float prefix = 0.f, total = 0.f;
#pragma unroll
                for (int s2 = 0; s2 < 8; ++s2) { const float v = SEG[s2 * 64 + d]; total += v; prefix += (s2 < seg) ? v : 0.f; }
                const float etot = __expf(total);
                if (seg == 0) DEC[d] = etot;
                unsigned kew[4];
#pragma unroll
                for (int i = 0; i < 8; ++i) {
                    const int c = 8 * seg + i;
                    const float qv = bf2f(*(const bf16*)(QRAW + c * GLA_PITCH + d * 2)) * 0.125f, kv = bf2f(*(const bf16*)(KRAW + c * GLA_PITCH + d * 2));
                    const float e = __expf(prefix + cl[i]), ei = __builtin_amdgcn_rcpf(e);
                    *(bf16*)(QD + c * GLA_PITCH + d * 2) = (bf16)f2bf(qv * e);
                    *(bf16*)(KI + c * GLA_PITCH + d * 2) = (bf16)f2bf(kv * ei);
                    const unsigned kb = f2bf(kv * (etot * ei));
                    if (i & 1) kew[i >> 1] |= kb << 16; else kew[i >> 1] = kb;
                }
                *(uint4*)(KET + d * GLA_PITCH + seg * 16) = make_uint4(kew[0], kew[1], kew[2], kew[3]);
                const int v = tid & 127, cg = tid >> 7;
                unsigned vw[8];
#pragma unroll
                for (int i = 0; i < 16; ++i) {
                    const unsigned x = *(const bf16*)(VRAW + (16 * cg + i) * 272 + v * 2);
                    if (i & 1) vw[i >> 1] |= x << 16; else vw[i >> 1] = x;
                }
                *(uint4*)(VT + v * GLA_PITCH + cg * 32) = make_uint4(vw[0], vw[1], vw[2], vw[3]);
                *(uint4*)(VT + v * GLA_PITCH + cg * 32 + 16) = make_uint4(vw[4], vw[5], vw[6], vw[7]);
            }
            __syncthreads();
            for (int blk = wid; blk < 10; blk += NWV) {
                int sblk, cblk;
                if (blk < 4) { sblk = 0; cblk = blk; } else if (blk < 7) { sblk = 1; cblk = blk - 3; } else if (blk < 9) { sblk = 2; cblk = blk - 5; } else { sblk = 3; cblk = 3; }
                f32x4_t acc = (f32x4_t){0.f, 0.f, 0.f, 0.f};
#pragma unroll
                for (int kk = 0; kk < 2; ++kk) {
                    const bf16x8 a = *(const bf16x8*)(KI + (16 * sblk + l15) * GLA_PITCH + 64 * kk + 16 * q4);
                    const bf16x8 bq = *(const bf16x8*)(QD + (16 * cblk + l15) * GLA_PITCH + 64 * kk + 16 * q4);
                    acc = __builtin_amdgcn_mfma_f32_16x16x32_bf16(a, bq, acc, 0, 0, 0);
                }
                const int c = 16 * cblk + l15, s0 = 16 * sblk + 4 * q4;
                float av[4];
#pragma unroll
                for (int r = 0; r < 4; ++r) av[r] = (s0 + r <= c) ? acc[r] : 0.f;
                *(uint2*)(AT + c * GLA_PITCH + s0 * 2) = make_uint2(pk2(av[0], av[1]), pk2(av[2], av[3]));
            }
            __syncthreads();
            {
                const int v0 = 16 * wid;
                bf16x8 bv[2], sB[2];
#pragma unroll
                for (int kk = 0; kk < 2; ++kk) {
                    bv[kk] = *(const bf16x8*)(VT + (v0 + l15) * GLA_PITCH + 64 * kk + 16 * q4);
                    uint4 w = make_uint4(pk2(S[2 * kk][0], S[2 * kk][1]), pk2(S[2 * kk][2], S[2 * kk][3]), pk2(S[2 * kk + 1][0], S[2 * kk + 1][1]), pk2(S[2 * kk + 1][2], S[2 * kk + 1][3]));
                    sB[kk] = __builtin_bit_cast(bf16x8, w);
                }
#pragma unroll
                for (int cblk = 0; cblk < 4; ++cblk) {
                    f32x4_t acc = (f32x4_t){0.f, 0.f, 0.f, 0.f};
                    const unsigned char* arow = AT + (16 * cblk + l15) * GLA_PITCH;
                    const unsigned char* qrow = QD + (16 * cblk + l15) * GLA_PITCH;
#pragma unroll
                    for (int kk = 0; kk < 2; ++kk) {
                        if (kk == 0 || cblk >= 2) {
                            const bf16x8 a = *(const bf16x8*)(arow + 64 * kk + 16 * q4);
                            acc = __builtin_amdgcn_mfma_f32_16x16x32_bf16(a, bv[kk], acc, 0, 0, 0);
                        }
                    }
#pragma unroll
                    for (int kk = 0; kk < 2; ++kk) {
                        const uint2 a0 = *(const uint2*)(qrow + 64 * kk + 8 * q4), a1 = *(const uint2*)(qrow + 64 * kk + 32 + 8 * q4);
                        uint4 aw = make_uint4(a0.x, a0.y, a1.x, a1.y);
                        acc = __builtin_amdgcn_mfma_f32_16x16x32_bf16(__builtin_bit_cast(bf16x8, aw), sB[kk], acc, 0, 0, 0);
                    }
#pragma unroll
                    for (int r = 0; r < 4; ++r) Od[(size_t)(rbase + rsgn * (16 * cblk + 4 * q4 + r)) * 512 + h * 128 + v0 + l15] = acc[r];
                }
#pragma unroll
                for (int dblk = 0; dblk < 4; ++dblk) {
#pragma unroll
                    for (int r = 0; r < 4; ++r) S[dblk][r] *= DEC[16 * dblk + 4 * q4 + r];
#pragma unroll
                    for (int kk = 0; kk < 2; ++kk) {
                        const bf16x8 a = *(const bf16x8*)(KET + (16 * dblk + l15) * GLA_PITCH + 64 * kk + 16 * q4);
                        S[dblk] = __builtin_amdgcn_mfma_f32_16x16x32_bf16(a, bv[kk], S[dblk], 0, 0, 0);
                    }
                }
            }
            if (ch + 1 < KVLEN / 64) GLA_STAGE();
            __syncthreads();
        }
    }
#undef GLA_ROWS
#undef GLA_GLOAD
#undef GLA_STAGE
}
__device__ __forceinline__ void ph_even_post(bf16* __restrict__ ATT, const float* __restrict__ lamv, const float* __restrict__ subln, float lam_init,
                             const float* __restrict__ OF, const float* __restrict__ OB, const bf16* __restrict__ P, const float* __restrict__ gain) {
    const int TID = opaque_tid(), BID = opaque_bid();
    int wave = BID * NWV + (TID >> 6), lane = TID & 63;
    int nw = gridDim.x * NWV;
    float p1 = lamv[lane] * lamv[64 + lane], p2 = lamv[128 + lane] * lamv[192 + lane];
    p1 = wave_sum(p1); p2 = wave_sum(p2);
    const float lam = expf(p1) - expf(p2) + lam_init;
    for (int r = wave; r < RT; r += nw) {
        bf16* a = ATT + (size_t)r * DM;
        float d[4][2];
#pragma unroll
        for (int h = 0; h < 4; ++h) {
            float2 o0 = ld2bf(a + (2 * h) * 128 + lane * 2);
            float2 o1 = ld2bf(a + (2 * h + 1) * 128 + lane * 2);
            d[h][0] = o0.x - lam * o1.x; d[h][1] = o0.y - lam * o1.y;
        }
        float2 outd[4];
#pragma unroll
        for (int h = 0; h < 4; ++h) {
            float s = wave_sum(d[h][0] * d[h][0] + d[h][1] * d[h][1]);
            float rstd = rsqrtf(s * (1.f / 128.f) + 1e-6f) * (1.f - lam_init);
            float2 sg = *(const float2*)(subln + lane * 2);
            outd[h] = make_float2(d[h][0] * rstd * sg.x, d[h][1] * rstd * sg.y);
        }
        float2 outg[4];
#pragma unroll
        for (int h = 0; h < 4; ++h) {
            float2 x = *(const float2*)(OF + (size_t)r * 512 + h * 128 + lane * 2);
            float2 c = *(const float2*)(OB + (size_t)r * 512 + h * 128 + lane * 2);
            float o0 = x.x + c.x, o1 = x.y + c.y;
            float s = wave_sum(o0 * o0 + o1 * o1);
            float rstd = rsqrtf(s * (1.f / 128.f) + 1e-6f);
            float2 g = *(const float2*)(gain + lane * 2);
            float2 rr = ld2bf(P + (size_t)r * EVEN_LDP + 2560 + h * 128 + lane * 2);
            outg[h] = make_float2(o0 * rstd * g.x * silu_f(rr.x), o1 * rstd * g.y * silu_f(rr.y));
        }
#pragma unroll
        for (int h = 0; h < 4; ++h) {
            st2bf(a + h * 128 + lane * 2, outd[h]);
            st2bf(a + 512 + h * 128 + lane * 2, outg[h]);
        }
    }
}
#define INS16(tv, ti, v, n) do { \
    _Pragma("unroll") for (int j_ = 15; j_ >= 1; --j_) { bool c1_ = (v) > tv[j_ - 1]; bool c2_ = (v) > tv[j_]; \
        tv[j_] = c1_ ? tv[j_ - 1] : (c2_ ? (v) : tv[j_]); ti[j_] = c1_ ? ti[j_ - 1] : (c2_ ? (n) : ti[j_]); } \
    { bool c_ = (v) > tv[0]; tv[0] = c_ ? (v) : tv[0]; ti[0] = c_ ? (n) : ti[0]; } } while (0)

__device__ __forceinline__ void ph_peer_ffn(const bf16* __restrict__ A2, const int* __restrict__ IDX, const float* __restrict__ GATE,
                            const float* __restrict__ U, const float* __restrict__ V, const float* __restrict__ mods_l, float* __restrict__ X) {
    const int TID = opaque_tid(), BID = opaque_bid();
    int wave = BID * NWV + (TID >> 6), lane = TID & 63;
    int nw = gridDim.x * NWV;
    for (int r = wave; r < RT; r += nw) {
        float4 xa[4], acc[4];
#pragma unroll
        for (int i = 0; i < 4; ++i) { xa[i] = ld4bf(A2 + (size_t)r * DM + 4 * (lane + 64 * i)); acc[i] = make_float4(0.f, 0.f, 0.f, 0.f); }
        for (int e = 0; e < 128; ++e) {
            int id = IDX[(size_t)r * 128 + e]; float g = GATE[(size_t)r * 128 + e];
            const float4* ur = (const float4*)(U + (size_t)id * DM);
            float d = 0.f;
#pragma unroll
            for (int i = 0; i < 4; ++i) { float4 u = ur[lane + 64 * i]; d += u.x * xa[i].x + u.y * xa[i].y + u.z * xa[i].z + u.w * xa[i].w; }
            d = wave_sum(d);
            float w = g * gelu_tanh(d);
            const float4* vr = (const float4*)(V + (size_t)id * DM);
#pragma unroll
            for (int i = 0; i < 4; ++i) { float4 v = vr[lane + 64 * i]; acc[i].x += w * v.x; acc[i].y += w * v.y; acc[i].z += w * v.z; acc[i].w += w * v.w; }
        }
        const float4* g5 = (const float4*)(mods_l + (size_t)row_mod(r) * MODW + 5 * DM);
        float4* xr = (float4*)(X + (size_t)r * DM);
#pragma unroll
        for (int i = 0; i < 4; ++i) { float4 x = xr[lane + 64 * i], gg = g5[lane + 64 * i];
            x.x += gg.x * acc[i].x; x.y += gg.y * acc[i].y; x.z += gg.z * acc[i].z; x.w += gg.w * acc[i].w; xr[lane + 64 * i] = x; }
    }
}

#define CE_DESC(a, b) do { const unsigned hi_ = max((a), (b)); (b) = min((a), (b)); (a) = hi_; } while (0)
#define SORT16_DESC(t) do { \
    _Pragma("unroll") for (int k_ = 2; k_ <= 16; k_ <<= 1) \
    _Pragma("unroll") for (int j_ = k_ >> 1; j_ > 0; j_ >>= 1) \
    _Pragma("unroll") for (int i_ = 0; i_ < 16; ++i_) { const int l_ = i_ ^ j_; if (l_ > i_) { if ((i_ & k_) == 0) CE_DESC(t[i_], t[l_]); else CE_DESC(t[l_], t[i_]); } } } while (0)
#define MERGE16_DESC(a, b) do { \
    _Pragma("unroll") for (int i_ = 0; i_ < 16; ++i_) a[i_] = max(a[i_], b[15 - i_]); \
    _Pragma("unroll") for (int j_ = 8; j_ > 0; j_ >>= 1) \
    _Pragma("unroll") for (int i_ = 0; i_ < 16; ++i_) { if ((i_ & j_) == 0) CE_DESC(a[i_], a[i_ | j_]); } } while (0)
#define RT_KPITCH 144
#define INSP16(t, x) do { unsigned x_ = (x); _Pragma("unroll") for (int j_ = 0; j_ < 16; ++j_) { const unsigned h_ = max(t[j_], x_); x_ = min(t[j_], x_); t[j_] = h_; } } while (0)
__device__ __forceinline__ void ph_route_mfma(const bf16* __restrict__ Qp, const bf16* __restrict__ Kb, int* __restrict__ IDX, float* __restrict__ GATE, unsigned char* lds, int nrows) {
    const int TID = opaque_tid(), BID = opaque_bid();
    const int tid = TID, lane = tid & 63, wid = tid >> 6, r32 = lane & 31, hi = lane >> 5;
    for (int u = BID; u < (nrows / 256) * 8; u += gridDim.x) {
        const int h = u & 7, row = (u >> 3) * 256 + wid * 32 + r32;
        __syncthreads();
        for (int i = tid; i < 2 * 128 * 8; i += NT) *(uint4*)(lds + (i >> 3) * RT_KPITCH + (i & 7) * 16) = *(const uint4*)(Kb + ((size_t)h * 256 + (i >> 3)) * 64 + (i & 7) * 8);
        __syncthreads();
        unsigned L[2][16];
#pragma unroll
        for (int half = 0; half < 2; ++half) {
            bf16x8 qf[4];
            const bf16* qrow = Qp + (size_t)row * DM + h * 128 + half * 64;
#pragma unroll
            for (int s = 0; s < 4; ++s) qf[s] = *(const bf16x8*)(qrow + 16 * s + 8 * hi);
#pragma unroll
            for (int nb = 0; nb < 4; ++nb) {
                f32x16 acc;
#pragma unroll
                for (int r = 0; r < 16; ++r) acc[r] = 0.f;
#pragma unroll
                for (int s = 0; s < 4; ++s) {
                    const bf16x8 a = *(const bf16x8*)(lds + (half * 128 + 32 * nb + r32) * RT_KPITCH + 32 * s + 16 * hi);
                    acc = __builtin_amdgcn_mfma_f32_32x32x16_bf16(a, qf[s], acc, 0, 0, 0);
                }
                unsigned run[16];
#pragma unroll
                for (int r = 0; r < 16; ++r) {
                    unsigned ub = __float_as_uint(acc[r]);
                    ub = (ub & 0x80000000u) ? ~ub : (ub | 0x80000000u);
                    run[r] = (ub & ~127u) | (unsigned)(127 - (32 * nb + (r & 3) + 8 * (r >> 2)) - 4 * hi);
                }
                SORT16_DESC(run);
                if (nb == 0) {
#pragma unroll
                    for (int j = 0; j < 16; ++j) L[half][j] = run[j];
                } else MERGE16_DESC(L[half], run);
                __builtin_amdgcn_sched_barrier(0);
            }
            unsigned o[16];
#pragma unroll
            for (int j = 0; j < 16; ++j) o[j] = __shfl_xor(L[half][j], 32);
            MERGE16_DESC(L[half], o);
            __builtin_amdgcn_sched_barrier(0);
        }
        float v1[16], v2[16];
        {
            unsigned w1[4] = {0u, 0u, 0u, 0u}, w2[4] = {0u, 0u, 0u, 0u};
#pragma unroll
            for (int j = 0; j < 16; ++j) {
                unsigned a = L[0][j] & ~127u, b = L[1][j] & ~127u;
                a = (a & 0x80000000u) ? (a & 0x7fffffffu) : ~a; b = (b & 0x80000000u) ? (b & 0x7fffffffu) : ~b;
                v1[j] = __uint_as_float(a); v2[j] = __uint_as_float(b);
                w1[j >> 2] |= (127u - (L[0][j] & 127u)) << (8 * (j & 3)); w2[j >> 2] |= (127u - (L[1][j] & 127u)) << (8 * (j & 3));
            }
            unsigned char* sb = lds + 2 * 128 * RT_KPITCH + tid * 4;
#pragma unroll
            for (int k = 0; k < 4; ++k) { *(unsigned*)(sb + k * 2048) = w1[k]; *(unsigned*)(sb + (4 + k) * 2048) = w2[k]; }
        }
#define CAND(a, b) ({ unsigned ub_ = __float_as_uint(v1[a] + v2[b]); ub_ = (ub_ & 0x80000000u) ? ~ub_ : (ub_ | 0x80000000u); (ub_ & ~255u) | (unsigned)(255 - (16 * (a) + (b))); })
        unsigned T[16], R1[16], R2[16], R3[16];
#pragma unroll
        for (int b = 0; b < 16; ++b) T[b] = CAND(0, b);
        {
#pragma unroll
            for (int b = 0; b < 8; ++b) R1[b] = CAND(1, b);
#pragma unroll
            for (int b = 0; b < 5; ++b) R1[8 + b] = CAND(2, b);
#pragma unroll
            for (int b = 0; b < 3; ++b) R1[13 + b] = CAND(4, b);
#pragma unroll
            for (int b = 0; b < 4; ++b) R2[b] = CAND(3, b);
#pragma unroll
            for (int a = 5; a < 8; ++a) { R2[4 + 2 * (a - 5)] = CAND(a, 0); R2[5 + 2 * (a - 5)] = CAND(a, 1); }
#pragma unroll
            for (int a = 8; a < 14; ++a) R2[10 + (a - 8)] = CAND(a, 0);
            R3[0] = CAND(14, 0); R3[1] = CAND(15, 0);
#pragma unroll
            for (int j = 2; j < 16; ++j) R3[j] = 0u;
        }
        SORT16_DESC(R1); MERGE16_DESC(T, R1);
        SORT16_DESC(R2); MERGE16_DESC(T, R2);
        if (R3[0] < R3[1]) { const unsigned t_ = R3[0]; R3[0] = R3[1]; R3[1] = t_; }
        MERGE16_DESC(T, R3);
#undef CAND
        float e[16]; int bi[16]; float sum = 0.f, v0 = 0.f;
        {
            const unsigned char* sb = lds + 2 * 128 * RT_KPITCH + tid * 4;
#pragma unroll
            for (int j = 0; j < 16; ++j) {
                unsigned ub = T[j] & ~255u;
                ub = (ub & 0x80000000u) ? (ub & 0x7fffffffu) : ~ub;
                const float val = __uint_as_float(ub);
                if (j == 0) v0 = val;
                e[j] = __expf(val - v0); sum += e[j];
                const unsigned flat = 255u - (T[j] & 255u), ca = flat >> 4, cb = flat & 15u;
                const unsigned ia = *(const unsigned char*)(sb + (ca >> 2) * 2048 + (ca & 3)), ib = *(const unsigned char*)(sb + (4 + (cb >> 2)) * 2048 + (cb & 3));
                bi[j] = (int)(ia * 128u + ib);
            }
        }
        const float inv = 1.f / sum;
        if (hi == 0) {
            int* ip = IDX + (size_t)row * 128 + h * 16; float* gp = GATE + (size_t)row * 128 + h * 16;
#pragma unroll
            for (int j = 0; j < 4; ++j) {
                *(int4*)(ip + 4 * j) = make_int4(bi[4 * j], bi[4 * j + 1], bi[4 * j + 2], bi[4 * j + 3]);
                *(float4*)(gp + 4 * j) = make_float4(e[4 * j] * inv, e[4 * j + 1] * inv, e[4 * j + 2] * inv, e[4 * j + 3] * inv);
            }
        }
    }
    __syncthreads();
}
__device__ __forceinline__ unsigned fp6_e2m3(float v) {
    const float a = fabsf(v);
    float c;
    if (a < 2.f) c = rintf(a * 8.f);
    else if (a < 4.f) c = 16.f + rintf((a - 2.f) * 4.f);
    else c = fminf(24.f + rintf((a - 4.f) * 2.f), 31.f);
    return (unsigned)c | (v < 0.f ? 32u : 0u);
}
__device__ __forceinline__ void ph_table_prep(const float* __restrict__ U, const float* __restrict__ V, unsigned char* __restrict__ T6, float* __restrict__ RS) {
    const int TID = opaque_tid(), BID = opaque_bid();
    const int wave = BID * NWV + (TID >> 6), lane = TID & 63, nw = gridDim.x * NWV;
    const int NROWS = DEPTH * 16384;
    for (int rr = wave; rr < 2 * NROWS; rr += nw) {
        const float* src = (rr < NROWS ? U : V) + (size_t)(rr < NROWS ? rr : rr - NROWS) * DM + lane * 16;
        float4 v[4]; float am = 0.f;
#pragma unroll
        for (int i = 0; i < 4; ++i) { v[i] = ((const float4*)src)[i]; am = fmaxf(am, fmaxf(fmaxf(fabsf(v[i].x), fabsf(v[i].y)), fmaxf(fabsf(v[i].z), fabsf(v[i].w)))); }
#pragma unroll
        for (int o = 1; o < 64; o <<= 1) am = fmaxf(am, __shfl_xor(am, o));
        am = fmaxf(am, 1e-30f);
        const float sc = exp2f(floorf(log2f(7.5f / am)));
        unsigned e[16];
#pragma unroll
        for (int i = 0; i < 4; ++i) { e[4 * i] = fp6_e2m3(v[i].x * sc); e[4 * i + 1] = fp6_e2m3(v[i].y * sc); e[4 * i + 2] = fp6_e2m3(v[i].z * sc); e[4 * i + 3] = fp6_e2m3(v[i].w * sc); }
        const unsigned d0 = e[0] | (e[1] << 6) | (e[2] << 12) | (e[3] << 18) | (e[4] << 24) | (e[5] << 30);
        const unsigned d1 = (e[5] >> 2) | (e[6] << 4) | (e[7] << 10) | (e[8] << 16) | (e[9] << 22) | (e[10] << 28);
        const unsigned d2 = (e[10] >> 4) | (e[11] << 2) | (e[12] << 8) | (e[13] << 14) | (e[14] << 20) | (e[15] << 26);
        unsigned* dst = (unsigned*)(T6 + (size_t)rr * 768 + lane * 12);
        dst[0] = d0; dst[1] = d1; dst[2] = d2;
        if (lane == 0) RS[rr] = 1.f / sc;
    }
}
typedef unsigned v6u32_t __attribute__((ext_vector_type(6)));
typedef float v32f_t __attribute__((ext_vector_type(32)));
typedef __bf16 v32bf_t __attribute__((ext_vector_type(32)));
typedef unsigned v16u_t __attribute__((ext_vector_type(16)));
struct u3 { unsigned x, y, z; };
#define BR4(j) ((((j) & 1) << 3) | (((j) & 2) << 1) | (((j) & 4) >> 1) | (((j) & 8) >> 3))
__device__ __forceinline__ void ph_peer_ffn8(const bf16* A2, const int* __restrict__ IDX, const float* __restrict__ GATE,
                            const unsigned char* __restrict__ U8, const float* __restrict__ RSU, const unsigned char* __restrict__ V8, const float* __restrict__ RSV,
                            const float* __restrict__ mods_l, const float* X, float* Xout, int nrows,
                            const float* __restrict__ gnext, const float* __restrict__ mods_next, bf16* Anext) {
    const int TID = opaque_tid(), BID = opaque_bid();
    const int wave = BID * NWV + (TID >> 6), lane = TID & 63, nw = gridDim.x * NWV;
    const int jl = BR4(lane & 15);
    const unsigned lane12 = (unsigned)lane * 12u;
    for (int r = wave; r < nrows; r += nw) {
        float xf[16];
        { int lx = lane; asm volatile("" : "+v"(lx)); const uint4* xp = (const uint4*)(A2 + (size_t)r * DM + lx * 16); const uint4 a = xp[0], b = xp[1]; const unsigned xw[8] = {a.x, a.y, a.z, a.w, b.x, b.y, b.z, b.w};
#pragma unroll
          for (int i = 0; i < 8; ++i) { xf[2 * i] = __uint_as_float(xw[i] << 16); xf[2 * i + 1] = __uint_as_float(xw[i] & 0xffff0000u); } }
        float acc[16];
#pragma unroll
        for (int k = 0; k < 16; ++k) acc[k] = 0.f;
        for (int g = 0; g < 8; ++g) {
            const int myid = IDX[(size_t)r * 128 + g * 16 + jl];
            u3 ub[16], vb[16];
#pragma unroll
            for (int j = 0; j < 16; ++j) { unsigned idv; asm volatile("v_mov_b32 %0, %1" : "=v"(idv) : "s"(__builtin_amdgcn_readlane(myid, BR4(j)))); ub[j] = *(const u3*)(U8 + (idv * 768u + lane12)); }
#pragma unroll
            for (int j = 0; j < 16; ++j) { unsigned idv; asm volatile("v_mov_b32 %0, %1" : "=v"(idv) : "s"(__builtin_amdgcn_readlane(myid, BR4(j)))); vb[j] = *(const u3*)(V8 + (idv * 768u + lane12)); }
            float d[16];
#pragma unroll
            for (int j = 0; j < 16; j += 2) {
                const v6u32_t src = {ub[j].x, ub[j].y, ub[j].z, ub[j + 1].x, ub[j + 1].y, ub[j + 1].z};
                const v32f_t f = __builtin_amdgcn_cvt_scalef32_pk32_f32_fp6(src, 1.0f);
                float d0 = 0.f, d1 = 0.f;
#pragma unroll
                for (int k = 0; k < 16; ++k) { d0 = __builtin_fmaf(f[k], xf[k], d0); d1 = __builtin_fmaf(f[16 + k], xf[k], d1); }
                d[j] = d0; d[j + 1] = d1;
                __builtin_amdgcn_sched_barrier(0);
            }
#pragma unroll
            for (int st = 0; st < 4; ++st) {
                const int n = 8 >> st, bit = 1 << st;
                const bool up = (lane & bit) != 0;
#pragma unroll
                for (int i = 0; i < 8; ++i) if (i < n) {
                    const float send = up ? d[i] : d[i + n], keep = up ? d[i + n] : d[i];
                    d[i] = keep + __shfl_xor(send, bit);
                }
            }
            float tot = d[0];
            tot += __shfl_xor(tot, 16); tot += __shfl_xor(tot, 32);
            const float w = GATE[(size_t)r * 128 + g * 16 + jl] * gelu_tanh(tot * RSU[myid]) * RSV[myid];
#pragma unroll
            for (int j = 0; j < 16; j += 2) {
                const float w0 = __int_as_float(__builtin_amdgcn_readlane(__float_as_int(w), BR4(j))), w1 = __int_as_float(__builtin_amdgcn_readlane(__float_as_int(w), BR4(j + 1)));
                const v6u32_t src = {vb[j].x, vb[j].y, vb[j].z, vb[j + 1].x, vb[j + 1].y, vb[j + 1].z};
                const v32f_t f = __builtin_amdgcn_cvt_scalef32_pk32_f32_fp6(src, 1.0f);
#pragma unroll
                for (int k = 0; k < 16; ++k) { acc[k] = __builtin_fmaf(w0, f[k], acc[k]); acc[k] = __builtin_fmaf(w1, f[16 + k], acc[k]); }
                __builtin_amdgcn_sched_barrier(0);
            }
        }
        int re = __builtin_amdgcn_readfirstlane(r); asm volatile("" : "+s"(re)); int le = lane; asm volatile("" : "+v"(le));
        const float4* g5 = (const float4*)(mods_l + (size_t)row_mod(re) * MODW + 5 * DM + le * 16);
        const float4* xr = (const float4*)(X + (size_t)re * DM + le * 16);
        float4 xn[4]; float ss = 0.f;
#pragma unroll
        for (int i = 0; i < 4; ++i) { float4 xv = xr[i], gg = g5[i];
            xv.x += gg.x * acc[4 * i]; xv.y += gg.y * acc[4 * i + 1]; xv.z += gg.z * acc[4 * i + 2]; xv.w += gg.w * acc[4 * i + 3]; xn[i] = xv;
            ss += xv.x * xv.x + xv.y * xv.y + xv.z * xv.z + xv.w * xv.w; }
        float4* xo = (float4*)(Xout + (size_t)re * DM + le * 16);
#pragma unroll
        for (int i = 0; i < 4; ++i) xo[i] = xn[i];
        if (gnext) {
            const float rstd = rsqrtf(wave_sum(ss) * (1.f / DM) + 1e-6f);
            const float* mn = mods_next + (size_t)row_mod(re) * MODW + le * 16;
            bf16* ar = Anext + (size_t)re * DM + le * 16;
#pragma unroll
            for (int i = 0; i < 4; ++i) {
                const float4 gg = ((const float4*)(gnext + le * 16))[i], sh = ((const float4*)mn)[i], sc = ((const float4*)(mn + DM))[i];
                float4 o;
                o.x = xn[i].x * rstd * gg.x * (1.f + sc.x) + sh.x; o.y = xn[i].y * rstd * gg.y * (1.f + sc.y) + sh.y;
                o.z = xn[i].z * rstd * gg.z * (1.f + sc.z) + sh.z; o.w = xn[i].w * rstd * gg.w * (1.f + sc.w) + sh.w;
                st4bf(ar + 4 * i, o);
            }
        }
    }
}
template <int N>
__device__ __forceinline__ void ph_gemm_bf16(const bf16* A, const bf16* Bt, bf16* O, unsigned char* lds) {
    pg8::Gemm g{A, Bt, RT, N, DM}; pg8::StaticOrder S; S.init(RT, N, (int)gridDim.x, opaque_bid());
    pg8::EpiBf16<0> E{O, N, nullptr, 0, 0, 1.f};
    pg8::gemm_phase<pg8::EpiBf16<0>, pg8::StaticOrder, true, true>((PG8_LAS unsigned char*)lds, g, S, E);
}
__device__ __forceinline__ void ph_gemm_res(const bf16* A, const bf16* Bt, float* X, const float* gate, unsigned char* lds) {
    pg8::Gemm g{A, Bt, RT, DM, DM}; pg8::StaticOrder S; S.init(RT, DM, (int)gridDim.x, opaque_bid());
    EpiResGate E{X, gate};
    pg8::gemm_phase<EpiResGate, pg8::StaticOrder, true, true>((PG8_LAS unsigned char*)lds, g, S, E);
}

#define XB_TMO      128
#define XB_XCNT(j)  (256  + 64 * (j))
#define XB_XSUB(j)  (1280 + 64 * (j))
#define XB_XGEN(j)  (2304 + 64 * (j))
#define XB_TOP      3328
#define XB_TOPGEN   3392
#define XCD_BAR_WORDS 3456
#define XB_SPIN_CAP (1u << 18)

__device__ __forceinline__ unsigned xb_ld(unsigned* p)              { return __hip_atomic_load(p, __ATOMIC_RELAXED, __HIP_MEMORY_SCOPE_AGENT); }
__device__ __forceinline__ unsigned xb_add(unsigned* p, unsigned v) { return __hip_atomic_fetch_add(p, v, __ATOMIC_RELAXED, __HIP_MEMORY_SCOPE_AGENT); }
__device__ __forceinline__ unsigned xb_xcc_id() { return (unsigned)__builtin_amdgcn_s_getreg((3 << 11) | 20) & 0xFu; }
#define XB_SPIN(cond, bar) do { unsigned _sp = 0; while (cond) { __builtin_amdgcn_s_sleep(1); \
    if ((++_sp & 255u) == 0u) { if (xb_ld(&(bar)[XB_TMO])) break; if (_sp > XB_SPIN_CAP) { atomicAdd(&(bar)[XB_TMO], 1u); break; } } } } while (0)

struct XcdBarrier {
    unsigned* bar; unsigned x;
    volatile LAS unsigned* st;
};

__device__ __forceinline__ XcdBarrier xcd_barrier_post(unsigned* bar, volatile LAS unsigned* st) {
    XcdBarrier b; b.bar = bar; b.x = xb_xcc_id(); b.st = st;
    if (threadIdx.x == 0) (void)xb_add(&bar[XB_XCNT(b.x)], 1u);
    return b;
}
__device__ __forceinline__ void xcd_barrier_complete(unsigned* bar, unsigned x, unsigned& nloc, unsigned& nx) {
    const unsigned G = gridDim.x * gridDim.y * gridDim.z;
    unsigned sum, cnt, mine, sp = 0u;
    for (;;) {
        sum = 0u; cnt = 0u; mine = 0u;
#pragma unroll
        for (unsigned j = 0; j < 16; ++j) { const unsigned c = xb_ld(&bar[XB_XCNT(j)]); sum += c; cnt += (c > 0u) ? 1u : 0u; mine = (j == x) ? c : mine; }
        if (sum == G) break;
        __builtin_amdgcn_s_sleep(1);
        if ((++sp & 255u) == 0u) { if (xb_ld(&bar[XB_TMO])) break; if (sp > XB_SPIN_CAP) { atomicAdd(&bar[XB_TMO], 1u); break; } }
    }
    nloc = mine > 0u ? mine : 1u; nx = cnt > 0u ? cnt : 1u;
}

__device__ __forceinline__ void xcd_barrier(const XcdBarrier& b) {
    asm volatile("s_waitcnt vmcnt(0)" ::: "memory");
    __syncthreads();
    if (threadIdx.x == 0) {
        unsigned* bar = b.bar;
        __builtin_amdgcn_s_waitcnt(0);
        unsigned nloc = b.st[0], nx = b.st[1];
        if (nloc == 0u) { xcd_barrier_complete(bar, b.x, nloc, nx); b.st[0] = nloc; b.st[1] = nx; }
        const unsigned old = xb_add(&bar[XB_XSUB(b.x)], 1u);
        const unsigned gen = old / nloc;
        if (old + 1u == (gen + 1u) * nloc) {
            __builtin_amdgcn_fence(__ATOMIC_RELEASE, "agent");
            asm volatile("s_waitcnt vmcnt(0)" ::: "memory");
            const unsigned og = xb_add(&bar[XB_TOP], 1u);
            const unsigned tg = og / nx;
            if (og + 1u == (tg + 1u) * nx) xb_add(&bar[XB_TOPGEN], 1u);
            else XB_SPIN(xb_ld(&bar[XB_TOPGEN]) == tg, bar);
            __builtin_amdgcn_fence(__ATOMIC_ACQUIRE, "agent");
            xb_add(&bar[XB_XGEN(b.x)], 1u);
            asm volatile("s_waitcnt vmcnt(0)" ::: "memory");
        } else {
            XB_SPIN(xb_ld(&bar[XB_XGEN(b.x)]) == gen, bar);
            __builtin_amdgcn_fence(__ATOMIC_ACQUIRE, "agent");
            asm volatile("s_waitcnt vmcnt(0)" ::: "memory");
        }
    }
    __syncthreads();
}

constexpr size_t ALIGN_UP(size_t x) { return (x + 255) & ~(size_t)255; }
constexpr size_t WS_X = 0;
constexpr size_t WS_A = WS_X + (size_t)RT * DM * 4;
constexpr size_t WS_P = WS_A + (size_t)RT * DM * 2;
constexpr size_t WS_ATT = WS_P + (size_t)RT * EVEN_LDP * 2;
constexpr size_t WS_OF = WS_ATT + (size_t)RT * DM * 2;
constexpr size_t WS_MODS = WS_OF + (size_t)RT * 512 * 4 * 2;
constexpr size_t WS_ROPE = WS_MODS + ALIGN_UP((size_t)DEPTH * NMOD * MODW * 4);
constexpr size_t WS_WINE = WS_ROPE + (size_t)SEQ * 32 * 8;
constexpr size_t WS_WOUTE = WS_WINE + (size_t)2 * EVEN_LDP * DM * 2;
constexpr size_t WS_WINO = WS_WOUTE + (size_t)2 * DM * DM * 2;
constexpr size_t WS_WOUTO = WS_WINO + (size_t)2 * ODD_IN * DM * 2;
constexpr size_t WS_WPQ = WS_WOUTO + (size_t)2 * DM * DM * 2;
constexpr size_t WS_T8 = WS_WPQ + (size_t)4 * DM * DM * 2;
constexpr size_t WS_RS = WS_T8 + (size_t)2 * DEPTH * 16384 * DM;
constexpr size_t WS_KC = WS_RS + (size_t)2 * DEPTH * 16384 * 4;
constexpr size_t WS_VT = WS_KC + (size_t)NB * 8 * KVLEN * 64 * 2;
constexpr size_t WS_KEYS = WS_VT + (size_t)NB * 4 * 128 * KVLEN * 2;
constexpr size_t WS_BAR = WS_KEYS + (size_t)DEPTH * 8 * 2 * 128 * 64 * 2;
constexpr size_t WS_BAR_BYTES = 16384;
constexpr size_t WS_END = WS_BAR + WS_BAR_BYTES;

__global__ void __launch_bounds__(NT, 2) mega(Params p) {
    extern __shared__ __attribute__((aligned(16))) unsigned char lds[];
    float* smem = (float*)lds;
    cg::grid_group grid = cg::this_grid();
    unsigned char* ws = p.ws;
    volatile LAS unsigned* bst = (volatile LAS unsigned*)((LAS unsigned char*)lds + 131072 + 512);
    if (threadIdx.x < 2) bst[threadIdx.x] = 0u;
    __syncthreads();
    (void)xcd_barrier_post((unsigned*)(ws + WS_BAR), bst);
#define GSYNC() do { XcdBarrier b_; b_.bar = (unsigned*)(ws + WS_BAR); b_.x = xb_xcc_id(); b_.st = (volatile LAS unsigned*)((LAS unsigned char*)lds + 131072 + 512); xcd_barrier(b_); } while (0)
#define X_ ((float*)(ws + WS_X))
#define A_ ((bf16*)(ws + WS_A))
#define P_ ((bf16*)(ws + WS_P))
#define ATT_ ((bf16*)(ws + WS_ATT))
#define OF_ ((float*)(ws + WS_OF))
#define OB_ (OF_ + (size_t)RT * 512)
#define MODS_ ((float*)(ws + WS_MODS))
#define ROPE_ ((float2*)(ws + WS_ROPE))
#define WINE_ ((bf16*)(ws + WS_WINE))
#define WOUTE_ ((bf16*)(ws + WS_WOUTE))
#define WINO_ ((bf16*)(ws + WS_WINO))
#define WOUTO_ ((bf16*)(ws + WS_WOUTO))
#define WPQ_ ((bf16*)(ws + WS_WPQ))
#define QP_ P_
#define KEYS_ ((bf16*)(ws + WS_KEYS))
#define KC_ ((bf16*)(ws + WS_KC))
#define VT_ ((bf16*)(ws + WS_VT))
#define T8_ (ws + WS_T8)
#define RS_ ((float*)(ws + WS_RS))
#define IDX_ ((int*)(ws + WS_P + (size_t)RT * DM * 2))
#define GATE_ ((float*)(ws + WS_P + (size_t)RT * DM * 2 + (size_t)RT * 128 * 4))

    ph_copy_in(p.in[0], p.in[2], X_);
    ph_rope_table(ROPE_);
    ph_weight_prep(p.in, WINE_, WOUTE_, WINO_, WOUTO_, WPQ_, KEYS_, lds);
    ph_table_prep(p.in[25], p.in[26], T8_, RS_);
    __syncthreads();
    ph_mods(p.in[1], p.in[3], p.in[4], p.in[5], MODS_, smem);
    grid.sync();
    ph_norm_mod(X_, p.in[6], MODS_, 0, A_);
    GSYNC();
    for (int hl = 0; hl < 2 * DEPTH; ++hl) {
        ws = p.ws; asm volatile("" : "+s"(ws));
        const int l = hl >> 1, part = hl & 1, i = l >> 1, odd = l & 1;
        const float* mods_l = MODS_ + (size_t)l * NMOD * MODW;
        if (part) {
            ph_norm_mod(X_, p.in[7] + l * DM, mods_l, 3, A_);
            GSYNC();
        }
        if (part) ph_gemm_bf16<DM>(A_, WPQ_ + (size_t)l * DM * DM, P_, lds);
        else if (odd) ph_gemm_bf16<ODD_IN>(A_, WINO_ + (size_t)i * ODD_IN * DM, P_, lds);
        else ph_gemm_bf16<EVEN_LDP>(A_, WINE_ + (size_t)i * EVEN_LDP * DM, P_, lds);
        GSYNC();
        if (part == 0) {
            const int ldp = odd ? ODD_IN : EVEN_LDP;
            ph_post(P_, ldp, odd ? 16 : 8, odd ? 1024 : 512, odd ? 4 : 8, odd ? 1280 : 1024, odd ? 256 : 512, odd ? 64 : 128,
                    (odd ? p.in[21] : p.in[10]) + i * 64, (odd ? p.in[22] : p.in[11]) + i * 64, ROPE_, KC_, VT_);
            GSYNC();
            if (!odd) {
                const int G_ = (int)gridDim.x, bid_ = (int)blockIdx.x;
                const int gu = (G_ == 256) ? (((bid_ >> 3) < 16) ? (bid_ & 7) * 16 + (bid_ >> 3) : -1) : bid_;
                ph_gla_chunk(P_, p.in[14] + i * 16 * 256, p.in[15] + i * 256, p.in[16] + i * 16 * 256, p.in[17] + i * 256, OF_, OB_, lds, gu, (G_ == 256) ? 1 << 20 : G_);
            }
            ph_attn_mfma(P_, ldp, KC_, VT_, ATT_, odd, l < DEPTH - 1, lds, (odd ? p.in[21] : p.in[10]) + i * 64, (odd ? p.in[22] : p.in[11]) + i * 64);
            GSYNC();
            if (!odd) {
                const float lam_init = 0.8f - 0.6f * expf(-0.3f * (float)l);
                ph_even_post(ATT_, p.in[12] + i * 256, p.in[13] + i * 128, lam_init, OF_, OB_, P_, p.in[18] + i * 128);
                GSYNC();
            }
            ph_gemm_res(ATT_, odd ? WOUTO_ + (size_t)i * DM * DM : WOUTE_ + (size_t)i * DM * DM, X_, mods_l + 2 * DM, lds);
            GSYNC();
        } else {
            const int last = (l == DEPTH - 1);
            const int nrows = last ? RL : RT;
            ph_route_mfma(QP_, KEYS_ + (size_t)l * 8 * 2 * 128 * 64, IDX_, GATE_, lds, nrows);
            GSYNC();
            ph_peer_ffn8(A_, IDX_, GATE_, T8_ + (size_t)l * 16384 * 768, RS_ + l * 16384, T8_ + (size_t)(DEPTH + l) * 16384 * 768, RS_ + (DEPTH + l) * 16384, mods_l,
                         X_, last ? p.out : X_, nrows, last ? nullptr : p.in[6] + (l + 1) * DM, mods_l + NMOD * MODW, A_);
            if (!last) GSYNC();
        }
    }
}

extern "C" void kernel_launch(void* const* d_in, const int* in_sizes, int n_in, void* d_out, int out_size, void* d_ws, size_t ws_size, hipStream_t stream) {
    static int grid_blocks = 0;
    if (!grid_blocks) {
        int dev = 0, cus = 0, per_cu = 0;
        (void)hipGetDevice(&dev);
        (void)hipDeviceGetAttribute(&cus, hipDeviceAttributeMultiprocessorCount, dev);
        (void)hipFuncSetAttribute((const void*)mega, hipFuncAttributeMaxDynamicSharedMemorySize, LDS_BYTES);
        (void)hipOccupancyMaxActiveBlocksPerMultiprocessor(&per_cu, mega, NT, LDS_BYTES);
        if (per_cu < 1) fprintf(stderr, "occupancy query says %d blocks/CU\n", per_cu);
        grid_blocks = cus;
        if (ws_size < WS_END) fprintf(stderr, "workspace too small: %zu < %zu\n", ws_size, (size_t)WS_END);
    }
    (void)hipMemsetAsync((unsigned char*)d_ws + WS_BAR, 0, WS_BAR_BYTES, stream);
    Params p{};
    for (int i = 0; i < 27; ++i) p.in[i] = (const float*)d_in[i];
    p.out = (float*)d_out; p.ws = (unsigned char*)d_ws;
    void* args[] = {&p};
    hipError_t e = hipLaunchCooperativeKernel((void*)mega, dim3(grid_blocks), dim3(NT), args, LDS_BYTES, stream);
    if (e != hipSuccess) fprintf(stderr, "cooperative launch failed: %s (grid %d)\n", hipGetErrorString(e), grid_blocks);
}
```

```cpp
#include <hip/hip_runtime.h>
#include <hip/hip_cooperative_groups.h>
#include <stdint.h>
#include <cstdio>
namespace cg = cooperative_groups;

#define DM 1024
#define NB 16
#define SEQ 2048
#define CTX 256
#define RL (NB * SEQ)
#define RC (NB * CTX)
#define RT (RL + RC)
#define DEPTH 4
#define EVEN_IN 3104
#define EVEN_LDP 3328
#define ODD_IN 1536
#define NMOD 17
#define MODW 6144
#define NT 512
#define NWV 8
#define LDS_BYTES 147456

typedef unsigned short bf16;
typedef float f32x2_t __attribute__((ext_vector_type(2)));
typedef __bf16 bf16x2_t __attribute__((ext_vector_type(2)));
struct Params {
    const float* in[27];
    float* out;
    unsigned char* ws;
};

__device__ __forceinline__ int row_mod(int r) { return r < RL ? (r >> 11) : 16; }
__device__ __forceinline__ float silu_f(float x) { return x / (1.f + expf(-x)); }
template <int M> __device__ __forceinline__ float shx(float v) {
    static_assert(M == 1 || M == 2 || M == 4 || M == 8 || M == 16, "mask");
    if constexpr (M == 1) return __int_as_float(__builtin_amdgcn_update_dpp(0, __float_as_int(v), 0xB1, 0xF, 0xF, true));
    else if constexpr (M == 2) return __int_as_float(__builtin_amdgcn_update_dpp(0, __float_as_int(v), 0x4E, 0xF, 0xF, true));
    else if constexpr (M == 8) return __int_as_float(__builtin_amdgcn_update_dpp(0, __float_as_int(v), 0x128, 0xF, 0xF, true));
    else return __int_as_float(__builtin_amdgcn_ds_swizzle(__float_as_int(v), (M << 10) | 0x1f));
}
__device__ __forceinline__ float sum32(float v) { const auto r = __builtin_amdgcn_permlane32_swap(__float_as_uint(v), __float_as_uint(v), false, false); return __uint_as_float(r[0]) + __uint_as_float(r[1]); }
__device__ __forceinline__ float max32(float v) { const auto r = __builtin_amdgcn_permlane32_swap(__float_as_uint(v), __float_as_uint(v), false, false); return fmaxf(__uint_as_float(r[0]), __uint_as_float(r[1])); }
__device__ __forceinline__ unsigned xchg32(unsigned v, bool upper) { const auto r = __builtin_amdgcn_permlane32_swap(v, v, false, false); return upper ? r[0] : r[1]; }
__device__ __forceinline__ float wave_sum(float v) { v += shx<1>(v); v += shx<2>(v); v += shx<4>(v); v += shx<8>(v); v += shx<16>(v); return sum32(v); }
__device__ __forceinline__ float wave_max(float v) { v = fmaxf(v, shx<1>(v)); v = fmaxf(v, shx<2>(v)); v = fmaxf(v, shx<4>(v)); v = fmaxf(v, shx<8>(v)); v = fmaxf(v, shx<16>(v)); return max32(v); }
__device__ __forceinline__ float log_sigmoid_f(float z) { return fminf(z, 0.f) - log1pf(expf(-fabsf(z))); }
__device__ __forceinline__ float gelu_tanh(float x) { const float u = 0.7978845608028654f * (x + 0.044715f * x * x * x); return x * __builtin_amdgcn_rcpf(1.f + __expf(-2.f * u)); }
__device__ __forceinline__ float bf2f(bf16 v) { return __uint_as_float((unsigned)v << 16); }
__device__ __forceinline__ unsigned f2bf(float f) { unsigned u = __float_as_uint(f); return (u + 0x7fffu + ((u >> 16) & 1u)) >> 16; }
__device__ __forceinline__ unsigned pk2(float lo, float hi) { return f2bf(lo) | (f2bf(hi) << 16); }
__device__ __forceinline__ float4 ld4bf(const bf16* p) { uint2 u = *(const uint2*)p; return make_float4(__uint_as_float(u.x << 16), __uint_as_float(u.x & 0xffff0000u), __uint_as_float(u.y << 16), __uint_as_float(u.y & 0xffff0000u)); }
__device__ __forceinline__ void st4bf(bf16* p, float4 v) { *(uint2*)p = make_uint2(pk2(v.x, v.y), pk2(v.z, v.w)); }
__device__ __forceinline__ float2 ld2bf(const bf16* p) { unsigned u = *(const unsigned*)p; return make_float2(__uint_as_float(u << 16), __uint_as_float(u & 0xffff0000u)); }
__device__ __forceinline__ void st2bf(bf16* p, float2 v) { *(unsigned*)p = pk2(v.x, v.y); }

__device__ __forceinline__ int opaque_tid(int wids) { int ln; asm volatile("v_mbcnt_lo_u32_b32 %0, -1, 0\n\tv_mbcnt_hi_u32_b32 %0, -1, %0" : "=v"(ln)); return (wids << 6) | ln; }
__device__ __forceinline__ int opaque_bid() { int b = blockIdx.x; asm volatile("" : "+s"(b)); return b; }

namespace pg8 {
#define PG8_LAS __attribute__((address_space(3)))
typedef unsigned short bf16_t;
typedef short bf16x8 __attribute__((ext_vector_type(8)));
typedef float f32x4 __attribute__((ext_vector_type(4)));
typedef unsigned u32x4 __attribute__((ext_vector_type(4)));
constexpr int BM = 256, BK = 64, HALF = 128, HTB = HALF * BK * 2  , STAGE_BYTES = 8 * HTB, NXCD = 8, WGM = 8;

__host__ __device__ __forceinline__ int lds_byte(int r, int c) { const int st = (r >> 4) * 2 + (c >> 5), rr = r & 15, cc = c & 31, ob = rr * 64 + cc * 2; return st * 1024 + (ob ^ (((ob >> 9) & 1) << 5)); }
__host__ __device__ __forceinline__ void stage_rc(int b, int& R, int& C) { const int st = b / 1024, sb = b % 1024, swz = sb ^ (((sb >> 9) & 1) << 5); R = (st >> 1) * 16 + swz / 64; C = (st & 1) * 32 + (swz % 64) / 2; }
__host__ __device__ __forceinline__ int perm32(int rho) { const int n = rho >> 4, i = rho & 15; return 8 * (i >> 2) + 4 * n + (i & 3); }

struct Unit { int pm, pn; };
struct Gemm { const bf16_t* A; const bf16_t* Bt; int M, N, K; };

struct StaticOrder {
    int nM, nN, nwg, G, c;
    __host__ __device__ void init(int M, int N, int G_, int c_) { nM = M / BM; nN = N / BM; nwg = nM * nN; G = G_; c = c_; }
    __host__ __device__ bool next(int i, Unit& u) const {
        const long L = (long)i * G + c; if (L >= nwg) return false;
        int wgid = (int)L; { const int q = nwg / NXCD, r = nwg % NXCD, xcd = wgid % NXCD, off = wgid / NXCD; wgid = (xcd < r ? xcd * (q + 1) : r * (q + 1) + (xcd - r) * q) + off; }
        const int nig = WGM * nN, gid = wgid / nig, fm = gid * WGM, gsz = (nM - fm) < WGM ? (nM - fm) : WGM;
        u.pm = fm + ((wgid % nig) % gsz); u.pn = (wgid % nig) / gsz; return true;
    }
    __device__ __forceinline__ void a_ready(const Unit&) const {}
    __device__ __forceinline__ void done(const Unit&) const {}
};

__device__ __forceinline__ unsigned cvt_pk_bf16(float lo, float hi) { unsigned r; asm volatile("v_cvt_pk_bf16_f32 %0, %1, %2" : "=v"(r) : "v"(lo), "v"(hi)); return r; }
typedef float f32x2 __attribute__((ext_vector_type(2)));
__device__ __forceinline__ f32x2 gelu_pk(f32x2 v) {
    const f32x2 av = __builtin_elementwise_abs(v), d = av * 0.2316418882f + 1.0f;
    f32x2 t; t.x = __builtin_amdgcn_rcpf(d.x); t.y = __builtin_amdgcn_rcpf(d.y);
    f32x2 q = t * 0.5307027145f + (-0.7265760135f); q = q * t + 0.7107068705f; q = q * t + (-0.142248368f); q = q * t + 0.127414796f; q = q * t;
    const f32x2 s = (v * v) * (-0.72134752044f);
    f32x2 e; e.x = __builtin_amdgcn_exp2f(s.x); e.y = __builtin_amdgcn_exp2f(s.y);
    const f32x2 m = v * (q * e), r = v - m;
    f32x2 o; o.x = v.x < 0.f ? m.x : r.x; o.y = v.y < 0.f ? m.y : r.y; return o;
}

template <int ACT  > struct EpiBf16 {
    static constexpr bool PERM = true, AFTER_DRAIN = false; static_assert(ACT == 0 || ACT == 1, "EpiBf16: ACT is 0 (none) or 1 (gelu_pk)");
    bf16_t* O; int ldc; const float* bias; int split_cols; size_t split_stride; float scale0;
    __device__ __forceinline__ void operator()(const f32x4 (&acc)[2][2][4][2], const Unit& u, int wr, int wc, int fr, int fq) const {
        const int row0 = u.pm * BM + wr * 64 + fr; int colt = u.pn * BM; bf16_t* base = O;
        float sc = 1.f; if (split_cols) { const int t = colt / split_cols; base += (size_t)t * split_stride; colt -= t * split_cols; if (t == 0) sc = scale0; }
        const int col0 = colt + wc * 32 + 8 * fq, bcol0 = u.pn * BM + wc * 32 + 8 * fq;
        f32x4 bv[2][2];
#pragma unroll
        for (int bj = 0; bj < 2; ++bj)
#pragma unroll
            for (int n = 0; n < 2; ++n) bv[bj][n] = bias ? *(const f32x4*)(bias + bcol0 + bj * HALF + 4 * n) : (f32x4){0.f, 0.f, 0.f, 0.f};
#pragma unroll
        for (int ai = 0; ai < 2; ++ai)
#pragma unroll
            for (int m = 0; m < 4; ++m) { bf16_t* rowp = base + (size_t)(row0 + ai * HALF + m * 16) * ldc + col0;
#pragma unroll
                for (int bj = 0; bj < 2; ++bj) { f32x4 v0 = acc[ai][bj][m][0] + bv[bj][0], v1 = acc[ai][bj][m][1] + bv[bj][1];
                    if (ACT == 1) { f32x2 a = gelu_pk((f32x2){v0[0], v0[1]}), b = gelu_pk((f32x2){v0[2], v0[3]}), c = gelu_pk((f32x2){v1[0], v1[1]}), d = gelu_pk((f32x2){v1[2], v1[3]});
                        v0 = (f32x4){a.x, a.y, b.x, b.y}; v1 = (f32x4){c.x, c.y, d.x, d.y}; }
                    v0 = v0 * sc; v1 = v1 * sc; u32x4 w; w.x = cvt_pk_bf16(v0[0], v0[1]); w.y = cvt_pk_bf16(v0[2], v0[3]); w.z = cvt_pk_bf16(v1[0], v1[1]); w.w = cvt_pk_bf16(v1[2], v1[3]);
                    *(u32x4*)(rowp + bj * HALF) = w; } }
    }
};
template <class Epi, class Sched, bool ALIGN_EPI = false, bool SP2 = false>
__device__ __forceinline__ void gemm_phase(PG8_LAS unsigned char* lds, const Gemm g, const Sched& S, const Epi& E, const int WIDS) {
    const int tid = opaque_tid(WIDS), wid = __builtin_amdgcn_readfirstlane(tid >> 6), lane = tid & 63, wr = wid >> 2, wc = wid & 3, fr = lane & 15, fq = lane >> 4;
    const int K = g.K, nt = K / BK;
    unsigned voffA[2], voffB[2];
#pragma unroll
    for (int i = 0; i < 2; ++i) { int R, C; stage_rc(tid * 16 + i * 8192, R, C); const int Rb = Epi::PERM ? ((R & ~31) + perm32(R & 31)) : R;
        voffA[i] = (unsigned)(R * K + C) * 2u; voffB[i] = (unsigned)(Rb * K + C) * 2u; }
    const size_t kstep = (size_t)(BK * 2);
    const size_t hstep = (size_t)HALF * K * 2;
    const size_t tstep = 2 * hstep;
    const unsigned ldsw = (unsigned)wid * 1024u;
    const int aoff = lds_byte(wr * 64 + fr, fq * 8), boff = lds_byte(wc * 32 + fr, fq * 8);
#define PG8_SA(b, h) (((b) * 2 + (h)) * HTB)
#define PG8_SB(b, h) ((4 + (b) * 2 + (h)) * HTB)
#define PG8_STAGE(bufoff, gbase, voff) do { _Pragma("unroll") for (int _i = 0; _i < 2; ++_i) \
        __builtin_amdgcn_global_load_lds((const unsigned*)((const char*)(gbase) + (voff)[_i]), (PG8_LAS unsigned*)(lds + (bufoff) + ldsw + _i * 8192), 16, 0, 0); } while (0)
#define PG8_LDA(dst, b, h) do { _Pragma("unroll") for (int m = 0; m < 4; ++m) _Pragma("unroll") for (int k = 0; k < 2; ++k) dst[m][k] = *(const PG8_LAS bf16x8*)(lds + PG8_SA(b, h) + aoff + m * 2048 + k * 1024); } while (0)
#define PG8_LDB(dst, b, h) do { _Pragma("unroll") for (int n = 0; n < 2; ++n) _Pragma("unroll") for (int k = 0; k < 2; ++k) dst[n][k] = *(const PG8_LAS bf16x8*)(lds + PG8_SB(b, h) + boff + n * 2048 + k * 1024); } while (0)
#define PG8_MMA(ai, bj, At, Bt) do { __builtin_amdgcn_s_setprio(1); _Pragma("unroll") for (int m = 0; m < 4; ++m) _Pragma("unroll") for (int n = 0; n < 2; ++n) _Pragma("unroll") for (int k = 0; k < 2; ++k) \
        acc[ai][bj][m][n] = __builtin_amdgcn_mfma_f32_16x16x32_bf16(Bt[n][k], At[m][k], acc[ai][bj][m][n], 0, 0, 0); __builtin_amdgcn_s_setprio(0); } while (0)
#define PG8_WAIT_V(n) asm volatile("s_waitcnt vmcnt(" #n ")" ::: "memory")
#define PG8_WAIT_L(n) asm volatile("s_waitcnt lgkmcnt(" #n ")" ::: "memory")
#define PG8_BAR __builtin_amdgcn_s_barrier()
#define PG8_SCHED __builtin_amdgcn_sched_barrier(0)
    Unit cur, nxt; int ui = 0;
    if (!S.next(0, cur)) return;
    f32x4 acc[2][2][4][2];
#pragma unroll
    for (int a = 0; a < 2; ++a)
#pragma unroll
        for (int b = 0; b < 2; ++b)
#pragma unroll
            for (int m = 0; m < 4; ++m)
#pragma unroll
                for (int n = 0; n < 2; ++n) acc[a][b][m][n] = (f32x4){0.f, 0.f, 0.f, 0.f};
    bf16x8 At[4][2], B0[2][2], B1[2][2];
    const char* cA = (const char*)g.A + (size_t)cur.pm * tstep; const char* cB = (const char*)g.Bt + (size_t)cur.pn * tstep;
    S.a_ready(cur);
    if constexpr (SP2) {
        PG8_STAGE(PG8_SB(0, 0), cB, voffB); PG8_STAGE(PG8_SB(0, 1), cB + hstep, voffB); PG8_STAGE(PG8_SA(0, 0), cA, voffA); PG8_STAGE(PG8_SA(0, 1), cA + hstep, voffA);
        if (wr == 1) PG8_BAR;
        PG8_WAIT_V(2); PG8_BAR;
        PG8_STAGE(PG8_SB(1, 0), cB + kstep, voffB); PG8_STAGE(PG8_SA(1, 0), cA + kstep, voffA); PG8_STAGE(PG8_SB(1, 1), cB + hstep + kstep, voffB);
        PG8_WAIT_V(6); PG8_BAR;
    } else {
        PG8_STAGE(PG8_SB(0, 0), cB, voffB); PG8_STAGE(PG8_SA(0, 0), cA, voffA); PG8_STAGE(PG8_SB(0, 1), cB + hstep, voffB); PG8_STAGE(PG8_SA(0, 1), cA + hstep, voffA);
        if (wr == 1) PG8_BAR;
        PG8_WAIT_V(4); PG8_BAR;
        PG8_STAGE(PG8_SB(1, 0), cB + kstep, voffB); PG8_STAGE(PG8_SA(1, 0), cA + kstep, voffA); PG8_STAGE(PG8_SB(1, 1), cB + hstep + kstep, voffB);
        PG8_WAIT_V(6); PG8_BAR;
    }
    for (;;) {
        const bool has_next = S.next(ui + 1, nxt);
        const char* nA = has_next ? (const char*)g.A + (size_t)nxt.pm * tstep : cA; const char* nB = has_next ? (const char*)g.Bt + (size_t)nxt.pn * tstep : cB;
        for (int t = 0; t < nt; t += 2) {
            const bool last = (t == nt - 2);
            const char* a1 = cA + (size_t)(t + 1) * kstep;
            const char* a2 = last ? nA : cA + (size_t)(t + 2) * kstep; const char* b2 = last ? nB : cB + (size_t)(t + 2) * kstep;
            const char* a3 = a2 + kstep; const char* b3 = b2 + kstep;
            if (last && has_next) S.a_ready(nxt);
            if constexpr (SP2) {
            PG8_LDB(B0, 0, 0); PG8_LDB(B1, 0, 1); PG8_SCHED; PG8_LDA(At, 0, 0); PG8_STAGE(PG8_SA(1, 1), a1 + hstep, voffA);
            PG8_WAIT_V(8); PG8_WAIT_L(0); PG8_BAR; PG8_MMA(0, 0, At, B0); PG8_MMA(0, 1, At, B1); PG8_BAR; PG8_SCHED;
            PG8_LDA(At, 0, 1); PG8_STAGE(PG8_SB(0, 0), b2, voffB); PG8_STAGE(PG8_SB(0, 1), b2 + hstep, voffB); PG8_STAGE(PG8_SA(0, 0), a2, voffA);
            PG8_WAIT_V(8); PG8_WAIT_L(0); PG8_BAR; PG8_MMA(1, 0, At, B0); PG8_MMA(1, 1, At, B1); PG8_BAR; PG8_SCHED;
            PG8_LDB(B0, 1, 0); PG8_LDB(B1, 1, 1); PG8_SCHED; PG8_LDA(At, 1, 0); PG8_STAGE(PG8_SA(0, 1), a2 + hstep, voffA);
            PG8_WAIT_V(8); PG8_WAIT_L(0); PG8_BAR; PG8_MMA(0, 0, At, B0); PG8_MMA(0, 1, At, B1); PG8_BAR; PG8_SCHED;
            PG8_LDA(At, 1, 1); PG8_STAGE(PG8_SB(1, 0), b3, voffB); PG8_STAGE(PG8_SB(1, 1), b3 + hstep, voffB); PG8_STAGE(PG8_SA(1, 0), a3, voffA);
            PG8_WAIT_V(8); PG8_WAIT_L(0); PG8_BAR; PG8_MMA(1, 0, At, B0); PG8_MMA(1, 1, At, B1); PG8_BAR; PG8_SCHED;
            } else {
            PG8_LDB(B0, 0, 0); PG8_SCHED; PG8_LDA(At, 0, 0); PG8_STAGE(PG8_SA(1, 1), a1 + hstep, voffA);
            PG8_WAIT_L(8); PG8_BAR; PG8_WAIT_L(0); PG8_MMA(0, 0, At, B0); PG8_BAR; PG8_SCHED;
            PG8_LDB(B1, 0, 1); PG8_STAGE(PG8_SB(0, 0), b2, voffB);
            PG8_BAR; PG8_WAIT_L(0); PG8_MMA(0, 1, At, B1); PG8_BAR;
            PG8_LDA(At, 0, 1); PG8_STAGE(PG8_SA(0, 0), a2, voffA);
            PG8_BAR; PG8_WAIT_L(0); PG8_MMA(1, 0, At, B0); PG8_BAR; PG8_SCHED;
            PG8_STAGE(PG8_SB(0, 1), b2 + hstep, voffB);
            PG8_WAIT_V(6); PG8_BAR; PG8_MMA(1, 1, At, B1); PG8_BAR;
            PG8_LDB(B0, 1, 0); PG8_SCHED; PG8_LDA(At, 1, 0); PG8_STAGE(PG8_SA(0, 1), a2 + hstep, voffA);
            PG8_WAIT_L(8); PG8_BAR; PG8_WAIT_L(0); PG8_MMA(0, 0, At, B0); PG8_BAR; PG8_SCHED;
            PG8_LDB(B1, 1, 1); PG8_STAGE(PG8_SB(1, 0), b3, voffB);
            PG8_BAR; PG8_WAIT_L(0); PG8_MMA(0, 1, At, B1); PG8_BAR;
            PG8_LDA(At, 1, 1); PG8_STAGE(PG8_SA(1, 0), a3, voffA);
            PG8_BAR; PG8_WAIT_L(0); PG8_MMA(1, 0, At, B0); PG8_BAR; PG8_SCHED;
            PG8_STAGE(PG8_SB(1, 1), b3 + hstep, voffB);
            PG8_WAIT_V(6); PG8_BAR; PG8_MMA(1, 1, At, B1); PG8_BAR;
            }
        }
        if constexpr (ALIGN_EPI) { if (wr == 0) PG8_BAR; }
        if constexpr (!Epi::AFTER_DRAIN) { E(acc, cur, wr, wc, fr, fq); S.done(cur); }
        if (!has_next) break;
#pragma unroll
        for (int a = 0; a < 2; ++a)
#pragma unroll
            for (int b = 0; b < 2; ++b)
#pragma unroll
                for (int m = 0; m < 4; ++m)
#pragma unroll
                    for (int n = 0; n < 2; ++n) acc[a][b][m][n] = (f32x4){0.f, 0.f, 0.f, 0.f};
        cur = nxt; cA = nA; cB = nB; ++ui;
        if constexpr (ALIGN_EPI) { if (wr == 1) PG8_BAR; }
    }
    PG8_WAIT_V(0);
    if constexpr (!ALIGN_EPI) { if (wr == 0) PG8_BAR; }
    PG8_BAR;
    if constexpr (Epi::AFTER_DRAIN) { E.fused(acc, cur, wr, wc, fr, fq, lds, wid, lane); S.done(cur); }
#undef PG8_SA
#undef PG8_SB
#undef PG8_STAGE
#undef PG8_LDA
#undef PG8_LDB
#undef PG8_MMA
#undef PG8_WAIT_V
#undef PG8_WAIT_L
#undef PG8_BAR
#undef PG8_SCHED
}
}

struct EpiResGate {
    static constexpr bool PERM = true, AFTER_DRAIN = false;
    bf16* X; const float* gate;
    __device__ __forceinline__ void operator()(const pg8::f32x4 (&acc)[2][2][4][2], const pg8::Unit& u, int wr, int wc, int fr, int fq) const {
        const int row0 = u.pm * 256 + wr * 64 + fr, col0 = u.pn * 256 + wc * 32 + 8 * fq;
#pragma unroll
        for (int ai = 0; ai < 2; ++ai)
#pragma unroll
            for (int m = 0; m < 4; ++m) {
                const int r = row0 + ai * 128 + m * 16;
                const float* g = gate + (size_t)row_mod(r) * MODW + col0; bf16* xr = X + (size_t)r * DM + col0;
#pragma unroll
                for (int bj = 0; bj < 2; ++bj) {
                    const uint4 raw = *(const uint4*)(xr + bj * 128);
                    const pg8::f32x4 g0 = *(const pg8::f32x4*)(g + bj * 128), g1 = *(const pg8::f32x4*)(g + bj * 128 + 4);
                    pg8::f32x4 v0 = {__uint_as_float(raw.x << 16), __uint_as_float(raw.x & 0xffff0000u), __uint_as_float(raw.y << 16), __uint_as_float(raw.y & 0xffff0000u)};
                    pg8::f32x4 v1 = {__uint_as_float(raw.z << 16), __uint_as_float(raw.z & 0xffff0000u), __uint_as_float(raw.w << 16), __uint_as_float(raw.w & 0xffff0000u)};
                    v0 = v0 + g0 * acc[ai][bj][m][0]; v1 = v1 + g1 * acc[ai][bj][m][1];
                    *(uint4*)(xr + bj * 128) = make_uint4(pk2(v0[0], v0[1]), pk2(v0[2], v0[3]), pk2(v1[0], v1[1]), pk2(v1[2], v1[3]));
                }
            }
    }
};
#define LAS __attribute__((address_space(3)))
#define GAS __attribute__((address_space(1)))

__device__ __forceinline__ void ph_rope_table(const int WIDS, float2* __restrict__ rope) {
    const int TID = opaque_tid(WIDS), BID = opaque_bid();
    for (int i = BID * NT + TID; i < SEQ * 32; i += gridDim.x * NT) {
        int t = i >> 5, a = (i >> 4) & 1, f = i & 15;
        float pos = a == 0 ? (float)(t >> 6) : (float)(t & 63);
        float inv = powf(10000.f, -(float)f / 16.f);
        float ang = pos * inv;
        rope[i] = make_float2(cosf(ang), sinf(ang));
    }
}
__device__ __forceinline__ void transpose_item(const float* __restrict__ W, int N, bf16* __restrict__ WT, LAS float* scr, int item, int lane) {
    const int K = DM;
    const int nblk = N / 32, kb = item / nblk, nb = item % nblk, k0 = 64 * kb, n0 = 32 * nb;
#pragma unroll 8
    for (int i = 0; i < 32; ++i) { const int kk = 2 * i + (lane >> 5); scr[kk * 33 + (lane & 31)] = W[(size_t)(k0 + kk) * N + n0 + (lane & 31)]; }
    asm volatile("s_waitcnt lgkmcnt(0)" ::: "memory");
    const int c = lane & 7;
#pragma unroll
    for (int j = 0; j < 4; ++j) { const int n = (lane >> 3) + 8 * j; const LAS float* s = scr + (8 * c) * 33 + n;
        uint4 o; o.x = pk2(s[0 * 33], s[1 * 33]); o.y = pk2(s[2 * 33], s[3 * 33]); o.z = pk2(s[4 * 33], s[5 * 33]); o.w = pk2(s[6 * 33], s[7 * 33]);
        *(uint4*)(WT + (size_t)(n0 + n) * K + k0 + 8 * c) = o; }
    asm volatile("s_waitcnt lgkmcnt(0)" ::: "memory");
}
struct WPrep { const float* src[12]; bf16* dst[12]; };
__device__ __forceinline__ void ph_weight_prep(const int WIDS, const float* const* in, bf16* WinE, bf16* WoutE, bf16* WinO, bf16* WoutO, bf16* Wpq, bf16* Kb, unsigned char* lds) {
    const int TID = opaque_tid(WIDS), BID = opaque_bid();
    const int lane = TID & 63, wv = TID >> 6;
    LAS float* scr = (LAS float*)((LAS unsigned char*)lds + wv * 16384);
    const int gw = BID * NWV + wv, NGW = gridDim.x * NWV;
    const int NITEMS = 2 * 1552 + 2 * 512 + 2 * 768 + 2 * 512 + 4 * 512;
    for (int it = gw; it < NITEMS; it += NGW) {
        int r = it;
        if (r < 3104) { int i = r / 1552; transpose_item(in[8] + (size_t)i * DM * EVEN_IN, EVEN_IN, WinE + (size_t)i * EVEN_LDP * DM, scr, r % 1552, lane); continue; } r -= 3104;
        if (r < 1024) { int i = r / 512; transpose_item(in[9] + (size_t)i * DM * DM, DM, WoutE + (size_t)i * DM * DM, scr, r % 512, lane); continue; } r -= 1024;
        if (r < 1536) { int i = r / 768; transpose_item(in[19] + (size_t)i * DM * ODD_IN, ODD_IN, WinO + (size_t)i * ODD_IN * DM, scr, r % 768, lane); continue; } r -= 1536;
        if (r < 1024) { int i = r / 512; transpose_item(in[20] + (size_t)i * DM * DM, DM, WoutO + (size_t)i * DM * DM, scr, r % 512, lane); continue; } r -= 1024;
        { int i = r / 512; transpose_item(in[23] + (size_t)i * DM * DM, DM, Wpq + (size_t)i * DM * DM, scr, r % 512, lane); }
    }
    for (int i4 = BID * NT + TID; i4 < DEPTH * 8 * 2 * 128 * 64 / 4; i4 += gridDim.x * NT) st4bf(Kb + 4 * (size_t)i4, ((const float4*)in[24])[i4]);
    for (int i = BID * NT + TID; i < 2 * 28672; i += gridDim.x * NT) {
        int w = i / 28672, o = i % 28672;
        ((uint4*)(WinE + (size_t)w * EVEN_LDP * DM + (size_t)EVEN_IN * DM))[o] = make_uint4(0u, 0u, 0u, 0u);
    }
}
__device__ __forceinline__ void ph_mods(const int WIDS, const float* __restrict__ c, const float* __restrict__ cctx, const float* __restrict__ w_mod,
                        const float* __restrict__ b_mod, float* __restrict__ mods, float* smem) {
    const int TID = opaque_tid(WIDS), BID = opaque_bid();
    const int nslab = DEPTH * MODW / 128;
    if (BID >= nslab) return;
    const int lane = TID & 63, wv = TID >> 6, cl = lane & 15, kp = lane >> 4;
    float (*S)[DM] = (float (*)[DM])smem;
    for (int i = TID; i < NMOD * DM; i += NT) {
        int j = i / DM, k = i % DM;
        float v = j < 16 ? c[j * DM + k] : cctx[k];
        S[j][k] = silu_f(v);
    }
    __syncthreads();
    for (int slab = BID; slab < nslab; slab += gridDim.x) {
        const int l = slab / 48, n = (slab % 48) * 128 + wv * 16 + cl;
        const float* W = w_mod + (size_t)l * DM * MODW + n;
        float acc[NMOD];
#pragma unroll
        for (int j = 0; j < NMOD; ++j) acc[j] = 0.f;
#pragma unroll 4
        for (int kk = 0; kk < 256; ++kk) {
            const int k = kp * 256 + kk;
            const float w = W[(size_t)k * MODW];
#pragma unroll
            for (int j = 0; j < NMOD; ++j) acc[j] += S[j][k] * w;
        }
        const float bias = b_mod[l * MODW + n];
#pragma unroll
        for (int j = 0; j < NMOD; ++j) {
            float v = acc[j];
            v += shx<16>(v); v = sum32(v);
            if (kp == 0) mods[((size_t)l * NMOD + j) * MODW + n] = v + bias;
        }
    }
    __syncthreads();
}
__device__ __forceinline__ void ph_norm_mod(const int WIDS, const float* __restrict__ Xf, const float* __restrict__ Xcf, const bf16* __restrict__ Xb, bf16* __restrict__ Xb_out,
                                            const float* __restrict__ g, const float* __restrict__ mods_l, int shift_chunk, bf16* __restrict__ A, int nrows) {
    const int TID = opaque_tid(WIDS), BID = opaque_bid();
    int wave = BID * NWV + (TID >> 6), lane = TID & 63;
    int nw = gridDim.x * NWV;
    for (int r = wave; r < nrows; r += nw) {
        float4 v[4]; float s = 0.f;
        if (Xb) {
#pragma unroll
            for (int i = 0; i < 4; ++i) v[i] = ld4bf(Xb + (size_t)r * DM + 4 * (lane + 64 * i));
        } else {
            const float4* xr = (const float4*)(r < RL ? Xf + (size_t)r * DM : Xcf + (size_t)(r - RL) * DM);
#pragma unroll
            for (int i = 0; i < 4; ++i) { v[i] = xr[lane + 64 * i]; st4bf(Xb_out + (size_t)r * DM + 4 * (lane + 64 * i), v[i]); }
        }
#pragma unroll
        for (int i = 0; i < 4; ++i) s += v[i].x * v[i].x + v[i].y * v[i].y + v[i].z * v[i].z + v[i].w * v[i].w;
        s = wave_sum(s);
        float rstd = rsqrtf(s * (1.f / DM) + 1e-6f);
        const float* m = mods_l + (size_t)row_mod(r) * MODW;
        const float4* sh = (const float4*)(m + shift_chunk * DM);
        const float4* sc = (const float4*)(m + (shift_chunk + 1) * DM);
        const float4* g4 = (const float4*)g;
        bf16* ar = A + (size_t)r * DM;
#pragma unroll
        for (int i = 0; i < 4; ++i) {
            int c = lane + 64 * i;
            float4 gg = g4[c], a = sh[c], b = sc[c], o;
            o.x = v[i].x * rstd * gg.x * (1.f + b.x) + a.x;
            o.y = v[i].y * rstd * gg.y * (1.f + b.y) + a.y;
            o.z = v[i].z * rstd * gg.z * (1.f + b.z) + a.z;
            o.w = v[i].w * rstd * gg.w * (1.f + b.w) + a.w;
            st4bf(ar + 4 * c, o);
        }
    }
}
#define KVLEN (CTX + SEQ)
__device__ __forceinline__ void ph_post(const int WIDS, bf16* __restrict__ P, int ldp, int nq, int kcol0, int nk, int vcol0, int VC, int DV,
                                        const float* __restrict__ qgain, const float* __restrict__ kgain, const float2* __restrict__ rope,
                                        bf16* __restrict__ Kc, bf16* __restrict__ Vt) {
    const int TID = opaque_tid(WIDS), BID = opaque_bid();
    const float C2 = 0.125f * 1.4426950408889634f;
    for (int tile = BID; tile < RT / 64; tile += gridDim.x) {
        const int r0 = tile * 64;
        int b, j0;
        if (r0 < RL) { b = r0 >> 11; j0 = CTX + (r0 & (SEQ - 1)); } else { b = (r0 - RL) >> 8; j0 = (r0 - RL) & (CTX - 1); }
        const int nh = nq + nk, sub = TID & 7;
        for (int ti0 = TID; ti0 < 64 * nh * 8; ti0 += 4 * NT) {
            uint4 raw4[4]; bf16* src4[4];
#pragma unroll
            for (int u = 0; u < 4; ++u) {
                const int item = (ti0 + u * NT) >> 3, row = item / nh, hh = item % nh;
                src4[u] = P + (size_t)(r0 + row) * ldp + (hh >= nq ? kcol0 + (hh - nq) * 64 : hh * 64) + sub * 8;
                raw4[u] = *(const uint4*)src4[u];
            }
#pragma unroll
            for (int u = 0; u < 4; ++u) {
            const int item = (ti0 + u * NT) >> 3, row = item / nh, hh = item % nh, r = r0 + row;
            const bool isk = hh >= nq; const int h = isk ? hh - nq : hh;
            bf16* src = src4[u];
            const float* gain = (isk ? kgain : qgain) + sub * 8;
            const uint4 raw = raw4[u];
            const unsigned rw[4] = {raw.x, raw.y, raw.z, raw.w};
            float v[8]; float ssq = 0.f;
#pragma unroll
            for (int i = 0; i < 4; ++i) { v[2 * i] = __uint_as_float(rw[i] << 16); v[2 * i + 1] = __uint_as_float(rw[i] & 0xffff0000u); ssq += v[2 * i] * v[2 * i] + v[2 * i + 1] * v[2 * i + 1]; }
            ssq += shx<1>(ssq); ssq += shx<2>(ssq); ssq += shx<4>(ssq);
            const float rstd = rsqrtf(ssq * (1.f / 64.f) + 1e-6f) * (isk ? 1.f : C2);
            const float4 g0 = ((const float4*)gain)[0], g1 = ((const float4*)gain)[1];
            const float gg[8] = {g0.x, g0.y, g0.z, g0.w, g1.x, g1.y, g1.z, g1.w};
#pragma unroll
            for (int i = 0; i < 8; ++i) v[i] = v[i] * rstd * gg[i];
            float pv[8];
#pragma unroll
            for (int i = 0; i < 8; ++i) pv[i] = shx<2>(v[i]);
            if (r < RL) {
                const float2* tab = rope + (size_t)(r & (SEQ - 1)) * 32 + (sub >> 2) * 16 + (sub & 1) * 8;
                const bool second = (sub & 2) != 0;
#pragma unroll
                for (int i = 0; i < 8; ++i) { const float2 cs = tab[i]; v[i] = second ? (v[i] * cs.x + pv[i] * cs.y) : (v[i] * cs.x - pv[i] * cs.y); }
            }
            bf16* dst = isk ? Kc + ((size_t)(b * nk + h) * KVLEN + j0 + row) * 64 + sub * 8 : src;
            *(uint4*)dst = make_uint4(pk2(v[0], v[1]), pk2(v[2], v[3]), pk2(v[4], v[5]), pk2(v[6], v[7]));
            }
        }
        if (TID < VC) {
            const int c8 = TID >> 3, rg = TID & 7;
            unsigned in[8][4];
#pragma unroll
            for (int rr = 0; rr < 8; ++rr) { uint4 t = *(const uint4*)(P + (size_t)(r0 + rg * 8 + rr) * ldp + vcol0 + c8 * 8); in[rr][0] = t.x; in[rr][1] = t.y; in[rr][2] = t.z; in[rr][3] = t.w; }
#pragma unroll
            for (int c = 0; c < 8; ++c) {
                unsigned o[4];
#pragma unroll
                for (int q = 0; q < 4; ++q)
                    o[q] = (c & 1) ? __builtin_amdgcn_perm(in[2 * q + 1][c >> 1], in[2 * q][c >> 1], 0x07060302u) : __builtin_amdgcn_perm(in[2 * q + 1][c >> 1], in[2 * q][c >> 1], 0x05040100u);
                const int col = c8 * 8 + c, vh = col / DV, d = col % DV;
                bf16* vrow = Vt + ((size_t)(b * 4 + vh) * DV + d) * KVLEN + j0 + 16 * (rg >> 1) + 4 * (rg & 1);
                *(uint2*)vrow = make_uint2(o[0], o[1]);
                *(uint2*)(vrow + 8) = make_uint2(o[2], o[3]);
            }
        }
    }
}
typedef short bf16x8 __attribute__((ext_vector_type(8)));
typedef float f32x16 __attribute__((ext_vector_type(16)));
__device__ __forceinline__ int crow(int r, int hi) { return (r & 3) + 8 * (r >> 2) + 4 * hi; }
__device__ __forceinline__ unsigned cvt_pk_bf16_f32(float lo, float hi) { f32x2_t v = {lo, hi}; bf16x2_t b = __builtin_convertvector(v, bf16x2_t); return __builtin_bit_cast(unsigned, b); }
#define ATT_KPITCH 144
#define ATT_VPITCH 144
template <int DV>
__device__ __forceinline__ void attn_unit(const bf16* __restrict__ Qbase, int ldq, const bf16* __restrict__ Kc, const bf16* __restrict__ Vt, int ntiles,
                                          bf16* __restrict__ Obase, int ldo, unsigned char* lds, int tid, float shift, int qrow0, const float* __restrict__ qgain, const float2* __restrict__ rope) {
    constexpr int NDB = DV / 32, NVL = DV / 64, KBYTES = 64 * ATT_KPITCH, VBYTES = DV * ATT_VPITCH;
    constexpr float THR = 8.f;
    const int lane = tid & 63, wid = tid >> 6, r32 = lane & 31, hi = lane >> 5;
    unsigned char* Kb0 = lds; unsigned char* Vb0 = lds + 2 * KBYTES;
    float* sc = (float*)(lds + 2 * KBYTES + 2 * VBYTES + wid * 128);
    bf16x8 qf[4];
    {
        int tq = tid; asm volatile("" : "+v"(tq));
        const int hq = (tq >> 5) & 1, rq = ((tq >> 6) << 5) | (tq & 31);
        const unsigned qoff = (unsigned)(rq * ldq + 8 * hq) * 2u;
        float qv[4][8]; float ssq = 0.f;
#pragma unroll
        for (int s = 0; s < 4; ++s) {
            const uint4 raw = *(const uint4*)((const unsigned char*)Qbase + (qoff + 32u * s));
            const unsigned rw[4] = {raw.x, raw.y, raw.z, raw.w};
#pragma unroll
            for (int i = 0; i < 4; ++i) { qv[s][2 * i] = __uint_as_float(rw[i] << 16); qv[s][2 * i + 1] = __uint_as_float(rw[i] & 0xffff0000u); ssq += qv[s][2 * i] * qv[s][2 * i] + qv[s][2 * i + 1] * qv[s][2 * i + 1]; }
        }
        ssq = sum32(ssq);
        const float rstd = rsqrtf(ssq * (1.f / 64.f) + 1e-6f) * (0.125f * 1.4426950408889634f);
#pragma unroll
        for (int s = 0; s < 4; ++s) {
            const float4 g0 = *(const float4*)((const unsigned char*)qgain + ((unsigned)(16 * s + 8 * hq) * 4u)), g1 = *(const float4*)((const unsigned char*)qgain + ((unsigned)(16 * s + 8 * hq) * 4u + 16u));
            const float gg[8] = {g0.x, g0.y, g0.z, g0.w, g1.x, g1.y, g1.z, g1.w};
#pragma unroll
            for (int i = 0; i < 8; ++i) qv[s][i] = qv[s][i] * rstd * gg[i];
        }
        if (qrow0 < RL) {
            const unsigned toff = (unsigned)((((qrow0 + rq) & (SEQ - 1)) * 32 + 8 * hq) * 8);
#pragma unroll
            for (int a = 0; a < 2; ++a)
#pragma unroll
                for (int i = 0; i < 8; ++i) { const float2 cs = *(const float2*)((const unsigned char*)rope + (toff + (unsigned)(a * 16 + i) * 8u)); const float x1 = qv[2 * a][i], x2 = qv[2 * a + 1][i]; qv[2 * a][i] = x1 * cs.x - x2 * cs.y; qv[2 * a + 1][i] = x2 * cs.x + x1 * cs.y; }
        }
#pragma unroll
        for (int s = 0; s < 4; ++s) {
            const uint4 w = make_uint4(pk2(qv[s][0], qv[s][1]), pk2(qv[s][2], qv[s][3]), pk2(qv[s][4], qv[s][5]), pk2(qv[s][6], qv[s][7]));
            qf[s] = __builtin_bit_cast(bf16x8, w);
        }
    }
    f32x16 o[NDB];
#pragma unroll
    for (int d = 0; d < NDB; ++d)
#pragma unroll
        for (int r = 0; r < 16; ++r) o[d][r] = 0.f;
    float l = 0.f;
    uint4 kreg, vreg0, vreg1 = make_uint4(0u, 0u, 0u, 0u);
    const int krow = tid >> 3, kch = tid & 7;
    const unsigned voff0 = (unsigned)(tid >> 3) * (unsigned)(KVLEN * 2) + (unsigned)(tid & 7) * 16u, voff1 = voff0 + 64u * (unsigned)(KVLEN * 2);
    const unsigned vlds0 = (unsigned)(tid >> 3) * ATT_VPITCH + (unsigned)(tid & 7) * 16u, vlds1 = vlds0 + 64u * ATT_VPITCH;
#define ATT_GLOAD_K(t) do { kreg = *(const uint4*)((const unsigned char*)Kc + ((unsigned)(t) * 8192u + (unsigned)tid * 16u)); } while (0)
#define ATT_GLOAD_V(t) do { vreg0 = *(const uint4*)((const unsigned char*)Vt + (voff0 + (unsigned)(t) * 128u)); if (NVL == 2) vreg1 = *(const uint4*)((const unsigned char*)Vt + (voff1 + (unsigned)(t) * 128u)); } while (0)
#define ATT_STORE_K(buf) do { *(uint4*)(Kb0 + (buf) * KBYTES + krow * ATT_KPITCH + kch * 16) = kreg; } while (0)
#define ATT_STORE_V(buf) do { *(uint4*)(Vb0 + (buf) * VBYTES + vlds0) = vreg0; if (NVL == 2) *(uint4*)(Vb0 + (buf) * VBYTES + vlds1) = vreg1; } while (0)
#define ATT_QK(S0, S1, buf) do { const unsigned char* kb_ = Kb0 + (buf) * KBYTES; \
        _Pragma("unroll") for (int r = 0; r < 16; ++r) { S0[r] = 0.f; S1[r] = 0.f; } \
        _Pragma("unroll") for (int s = 0; s < 4; ++s) { \
            const bf16x8 a0 = *(const bf16x8*)(kb_ + r32 * ATT_KPITCH + s * 32 + hi * 16); \
            const bf16x8 a1 = *(const bf16x8*)(kb_ + (32 + r32) * ATT_KPITCH + s * 32 + hi * 16); \
            S0 = __builtin_amdgcn_mfma_f32_32x32x16_bf16(a0, qf[s], S0, 0, 0, 0); \
            S1 = __builtin_amdgcn_mfma_f32_32x32x16_bf16(a1, qf[s], S1, 0, 0, 0); } } while (0)
    {
        ATT_GLOAD_K(0); ATT_GLOAD_V(0);
        const uint4 k0 = kreg;
        ATT_GLOAD_K(ntiles > 1 ? 1 : 0);
        *(uint4*)(Kb0 + krow * ATT_KPITCH + kch * 16) = k0;
        ATT_STORE_V(0); ATT_STORE_V(1);
        ATT_STORE_K(1);
    }
    __syncthreads();
    f32x16 s0, s1;
    ATT_QK(s0, s1, 0);
    __syncthreads();
    uint4 pa[4], pb[4];
#pragma unroll
    for (int i = 0; i < 4; ++i) pa[i] = make_uint4(0u, 0u, 0u, 0u);
    f32x16 n0, n1;
    auto tile = [&](f32x16& S0, f32x16& S1, f32x16& N0, f32x16& N1, uint4 (&PA)[4], uint4 (&PN)[4], const int t, const int par) __attribute__((always_inline)) {
        if (t + 2 < ntiles) ATT_GLOAD_K(t + 2);
        if (t > 0) ATT_GLOAD_V(t);
        if (shift != 0.f) {
#pragma unroll
            for (int r = 0; r < 16; ++r) { S0[r] -= shift; S1[r] -= shift; }
        }
        float ps0 = 0.f, ps1 = 0.f;
        unsigned pw[16];
        {
            constexpr int M = 8 + 4 * NDB, G = 2 + NDB, PF = 4;
            const unsigned char* kfa = Kb0 + (1 - par) * KBYTES + r32 * ATT_KPITCH + hi * 16;
            const unsigned char* vfa = Vb0 + (1 - par) * VBYTES + r32 * ATT_VPITCH + hi * 16;
#define ATT_CH(c) (NDB == 2 ? ((c) == 0 ? -1 : (c) == 1 ? 0 : (c) == 2 ? -2 : 1) : ((c) == 0 ? -1 : (c) == 1 ? 0 : (c) == 2 ? 1 : (c) == 3 ? -2 : (c) == 4 ? 2 : 3))
#define ATT_FRAG(i) (ATT_CH((i) % G) == -1 ? *(const bf16x8*)(kfa + ((i) / G) * 32) : ATT_CH((i) % G) == -2 ? *(const bf16x8*)(kfa + 32 * ATT_KPITCH + ((i) / G) * 32) \
                     : *(const bf16x8*)(vfa + (ATT_CH((i) % G) < 0 ? 0 : ATT_CH((i) % G)) * 32 * ATT_VPITCH + ((i) / G) * 32))
#define ATT_EX(e) ((e) < 16 ? S0[(e) & 15] : S1[(e) & 15])
            bf16x8 fr[M];
#pragma unroll
            for (int i = 0; i < PF; ++i) fr[i] = ATT_FRAG(i);
            __builtin_amdgcn_sched_barrier(0);
#pragma unroll
            for (int i = 0; i < M; ++i) {
                if (i + PF < M) fr[i + PF] = ATT_FRAG(i + PF);
                const int kd = ATT_CH(i % G), st = i / G;
                if (kd == -1) { if (st == 0) { f32x16 z; _Pragma("unroll") for (int r = 0; r < 16; ++r) z[r] = 0.f; N0 = __builtin_amdgcn_mfma_f32_32x32x16_bf16(fr[i], qf[st], z, 0, 0, 0); } else N0 = __builtin_amdgcn_mfma_f32_32x32x16_bf16(fr[i], qf[st], N0, 0, 0, 0); }
                else if (kd == -2) { if (st == 0) { f32x16 z; _Pragma("unroll") for (int r = 0; r < 16; ++r) z[r] = 0.f; N1 = __builtin_amdgcn_mfma_f32_32x32x16_bf16(fr[i], qf[st], z, 0, 0, 0); } else N1 = __builtin_amdgcn_mfma_f32_32x32x16_bf16(fr[i], qf[st], N1, 0, 0, 0); }
                else o[kd < 0 ? 0 : kd] = __builtin_amdgcn_mfma_f32_32x32x16_bf16(fr[i], __builtin_bit_cast(bf16x8, PA[st]), o[kd < 0 ? 0 : kd], 0, 0, 0);
                const int lo = (i * 32) / M, hi_e = ((i + 1) * 32) / M, lop = i == 0 ? 0 : ((i - 1) * 32) / M;
#pragma unroll
                for (int e = 0; e < 32; ++e) if (e >= lo && e < hi_e) { if (e < 16) S0[e & 15] = __builtin_amdgcn_exp2f(S0[e & 15]); else S1[e & 15] = __builtin_amdgcn_exp2f(S1[e & 15]); }
#pragma unroll
                for (int e = 0; e < 32; ++e) if (i > 0 && e >= lop && e < lo) {
                    if (e & 1) { ps1 += ATT_EX(e); pw[e >> 1] = cvt_pk_bf16_f32(ATT_EX(e - 1), ATT_EX(e)); } else ps0 += ATT_EX(e);
                }
                __builtin_amdgcn_sched_barrier(0);
            }
            constexpr int lol = ((M - 1) * 32) / M;
#pragma unroll
            for (int e = 0; e < 32; ++e) if (e >= lol) {
                if (e & 1) { ps1 += ATT_EX(e); pw[e >> 1] = cvt_pk_bf16_f32(ATT_EX(e - 1), ATT_EX(e)); } else ps0 += ATT_EX(e);
            }
#undef ATT_CH
#undef ATT_FRAG
#undef ATT_EX
        }
        l += ps0 + ps1;
        asm volatile("" : "+v"(pw[0]), "+v"(pw[1]), "+v"(pw[2]), "+v"(pw[3]), "+v"(pw[4]), "+v"(pw[5]), "+v"(pw[6]), "+v"(pw[7]));
        asm volatile("" : "+v"(pw[8]), "+v"(pw[9]), "+v"(pw[10]), "+v"(pw[11]), "+v"(pw[12]), "+v"(pw[13]), "+v"(pw[14]), "+v"(pw[15]), "+v"(l));
        PN[0] = make_uint4(pw[0], pw[1], pw[2], pw[3]); PN[1] = make_uint4(pw[4], pw[5], pw[6], pw[7]); PN[2] = make_uint4(pw[8], pw[9], pw[10], pw[11]); PN[3] = make_uint4(pw[12], pw[13], pw[14], pw[15]);
        __builtin_amdgcn_sched_barrier(0);
        if (t + 2 < ntiles) ATT_STORE_K(par);
        if (t > 0) ATT_STORE_V(par);
        __syncthreads();
    };
    for (int t = 0; t < ntiles; t += 2) {
        tile(s0, s1, n0, n1, pa, pb, t, 0);
        tile(n0, n1, s0, s1, pb, pa, t + 1, 1);
    }
    {
        const unsigned char* vb = Vb0 + VBYTES;
#pragma unroll
        for (int d = 0; d < NDB; ++d) {
#pragma unroll
            for (int s = 0; s < 4; ++s) {
                const bf16x8 vf = *(const bf16x8*)(vb + (32 * d + r32) * ATT_VPITCH + 32 * s + 16 * hi);
                o[d] = __builtin_amdgcn_mfma_f32_32x32x16_bf16(vf, __builtin_bit_cast(bf16x8, pa[s]), o[d], 0, 0, 0);
            }
        }
    }
#undef ATT_GLOAD_K
#undef ATT_GLOAD_V
#undef ATT_STORE_K
#undef ATT_STORE_V
#undef ATT_QK
    l = sum32(l);
    const float iv = 1.f / l;
    int tide = tid; asm volatile("" : "+v"(tide));
    unsigned char* orow = (unsigned char*)Obase + ((unsigned)(((tide >> 6) * 32 + (tide & 31)) * ldo) * 2u + (((tide >> 5) & 1) ? 16u : 0u));
#pragma unroll
    for (int d = 0; d < NDB; ++d) {
#pragma unroll
        for (int gp = 0; gp < 2; ++gp) {
            uint2 a, b;
            a.x = cvt_pk_bf16_f32(o[d][8 * gp + 0] * iv, o[d][8 * gp + 1] * iv); a.y = cvt_pk_bf16_f32(o[d][8 * gp + 2] * iv, o[d][8 * gp + 3] * iv);
            b.x = cvt_pk_bf16_f32(o[d][8 * gp + 4] * iv, o[d][8 * gp + 5] * iv); b.y = cvt_pk_bf16_f32(o[d][8 * gp + 6] * iv, o[d][8 * gp + 7] * iv);
            { const auto r_ = __builtin_amdgcn_permlane32_swap(a.x, b.x, false, false); a.x = r_[0]; b.x = r_[1]; }
            { const auto r_ = __builtin_amdgcn_permlane32_swap(a.y, b.y, false, false); a.y = r_[0]; b.y = r_[1]; }
            *(uint4*)(orow + (32 * d + 16 * gp) * 2) = make_uint4(a.x, a.y, b.x, b.y);
        }
    }
    __syncthreads();
}
__device__ __forceinline__ void attn_run_unit(const bf16* __restrict__ P, int ldp, const bf16* __restrict__ Kc, const bf16* __restrict__ Vt, bf16* __restrict__ ATT,
                                              int odd, int u, int nlat, unsigned char* lds, int TID, float shift, const float* __restrict__ qgain, const float2* __restrict__ rope) {
    int b, qh, row0, ntiles;
    if (u < nlat) {
        if (odd) { const int grp = u >> 5, w = u & 31; b = grp >> 2; qh = (grp & 3) * 4 + (w >> 3); row0 = b * SEQ + (w & 7) * 256; }
        else { const int grp = u >> 4, w = u & 15; b = grp >> 2; qh = (grp & 3) * 2 + (w >> 3); row0 = b * SEQ + (w & 7) * 256; }
        ntiles = KVLEN / 64;
    } else {
        const int idx = u - nlat;
        if (odd) { b = idx >> 4; qh = idx & 15; } else { b = idx >> 3; qh = idx & 7; }
        row0 = RL + b * CTX; ntiles = CTX / 64;
    }
    if (odd) attn_unit<64>(P + (size_t)row0 * ldp + qh * 64, ldp, Kc + (size_t)(b * 4 + (qh >> 2)) * KVLEN * 64, Vt + (size_t)(b * 4 + (qh >> 2)) * 64 * KVLEN, ntiles,
                           ATT + (size_t)row0 * DM + qh * 64, DM, lds, TID, shift, row0, qgain, rope);
    else attn_unit<128>(P + (size_t)row0 * ldp + qh * 64, ldp, Kc + (size_t)(b * 8 + qh) * KVLEN * 64, Vt + (size_t)(b * 4 + (qh >> 1)) * 128 * KVLEN, ntiles,
                        ATT + (size_t)row0 * DM + qh * 128, DM, lds, TID, shift, row0, qgain, rope);
}
__device__ __forceinline__ void ph_attn_mfma(const int WIDS, const bf16* __restrict__ P, int ldp, const bf16* __restrict__ Kc, const bf16* __restrict__ Vt, bf16* __restrict__ ATT,
                                             int odd, int with_ctx, unsigned char* lds, const float* __restrict__ qgain, const float* __restrict__ kgain, const float2* __restrict__ rope) {
    const int TID = opaque_tid(WIDS), BID = opaque_bid();
    float shift;
    {
        float gq = fabsf(qgain[TID & 63]), gk = fabsf(kgain[TID & 63]);
        gq = wave_max(gq); gk = wave_max(gk);
        shift = fmaxf(8.f * 1.4426950408889634f * gq * gk * 1.002f + 0.01f - 100.f, 0.f);
        shift = __int_as_float(__builtin_amdgcn_readfirstlane(__float_as_int(shift)));
    }
    const int G = gridDim.x, vcu = (G % 8 == 0) ? (BID & 7) * (G >> 3) + (BID >> 3) : BID;
    const int nlat = odd ? 2048 : 1024, nctx = with_ctx ? (odd ? 256 : 128) : 0;
    if (!odd && G == 256) {
        const int x = BID & 7, w = BID >> 3, wl = w & 15;
        constexpr int KG = 2;
        const int i0 = w >= 16 ? 0 : 8 - KG, i1 = w >= 16 ? 8 - KG : 8, nun = (i1 - i0) + ((w >= 16 && nctx) ? 1 : 0);
        for (int j = 0; j < nun; ++j) {
            const int i = i0 + j;
            attn_run_unit(P, ldp, Kc, Vt, ATT, odd, i < i1 ? x * 128 + 16 * i + wl : nlat + x * 16 + wl, nlat, lds, TID, shift, qgain, rope);
        }
        return;
    }
    for (int u = vcu; u < nlat + nctx; u += G) attn_run_unit(P, ldp, Kc, Vt, ATT, odd, u, nlat, lds, TID, shift, qgain, rope);
}
typedef float f32x4_t __attribute__((ext_vector_type(4)));
#define GLA_PITCH 144
__device__ __forceinline__ void ph_gla_chunk(const int WIDS, const bf16* __restrict__ P, const float* __restrict__ w_af, const float* __restrict__ b_af,
                                             const float* __restrict__ w_ab, const float* __restrict__ b_ab, bf16* __restrict__ OF, bf16* __restrict__ OB, unsigned char* lds, int unit0, int ustride) {
    const int TID = opaque_tid(WIDS), BID = opaque_bid();
    const int tid = TID, lane = tid & 63, wid = tid >> 6, l15 = lane & 15, q4 = lane >> 4;
    float* SEG = (float*)lds;
    float* DEC = (float*)(lds + 2048);
    unsigned char* QD = lds + 4096;
    unsigned char* KI = QD + 9216;
    unsigned char* KET = KI + 9216;
    unsigned char* AT = KET + 9216;
    unsigned char* VT = AT + 9216;
    unsigned char* QRAW = VT + 18432;
    unsigned char* KRAW = QRAW + 9216;
    unsigned char* VRAW = KRAW + 9216;
    unsigned char* GRAW = VRAW + 64 * 272;
#define GLA_ROWS(ch_, rb_, rs_) do { if (!dir) { rb_ = (ch_) < 4 ? RL + b * CTX + (ch_) * 64 : b * SEQ + ((ch_) - 4) * 64; rs_ = 1; } \
        else { rb_ = (ch_) < 4 ? RL + b * CTX + (CTX - 1 - (ch_) * 64) : b * SEQ + (SEQ - 1 - ((ch_) - 4) * 64); rs_ = -1; } } while (0)
#define GLA_GLOAD(ch_) do { int rb_, rs_; GLA_ROWS(ch_, rb_, rs_); \
        const bf16* pq_ = P + (size_t)(rb_ + rs_ * (tid >> 3)) * EVEN_LDP + h * 64 + (tid & 7) * 8; rq = *(const uint4*)(pq_ + 1536); rk = *(const uint4*)(pq_ + 1792); \
        rv0 = *(const uint4*)(P + (size_t)(rb_ + rs_ * (tid >> 4)) * EVEN_LDP + 2048 + h * 128 + (tid & 15) * 8); \
        rv1 = *(const uint4*)(P + (size_t)(rb_ + rs_ * (32 + (tid >> 4))) * EVEN_LDP + 2048 + h * 128 + (tid & 15) * 8); \
        if (tid < 128) rg = *(const uint4*)(P + (size_t)(rb_ + rs_ * (tid >> 1)) * EVEN_LDP + 3072 + dir * 16 + (tid & 1) * 8); } while (0)
#define GLA_STAGE() do { *(uint4*)(QRAW + (tid >> 3) * GLA_PITCH + (tid & 7) * 16) = rq; *(uint4*)(KRAW + (tid >> 3) * GLA_PITCH + (tid & 7) * 16) = rk; \
        *(uint4*)(VRAW + (tid >> 4) * 272 + (tid & 15) * 16) = rv0; *(uint4*)(VRAW + (32 + (tid >> 4)) * 272 + (tid & 15) * 16) = rv1; \
        if (tid < 128) *(uint4*)(GRAW + (tid >> 1) * 32 + (tid & 1) * 16) = rg; } while (0)
    for (int unit = unit0; unit >= 0 && unit < NB * 4 * 2; unit += ustride) {
        const int dir = unit & 1, h = (unit >> 1) & 3, b = unit >> 3;
        const float* wa = dir ? w_ab : w_af; const float* ba = dir ? b_ab : b_af;
        bf16* Od = dir ? OB : OF;
        const int d = tid & 63, seg = tid >> 6;
        float wreg[16];
#pragma unroll
        for (int j = 0; j < 16; ++j) wreg[j] = wa[j * 256 + h * 64 + d];
        const float breg = ba[h * 64 + d];
        { unsigned z_; asm volatile("v_mov_b32 %0, 0" : "=v"(z_)); for (int i = tid; i < 9216 / 16; i += NT) ((uint4*)AT)[i] = make_uint4(z_, z_, z_, z_); }
        f32x4_t S[4];
#pragma unroll
        for (int i = 0; i < 4; ++i) S[i] = (f32x4_t){0.f, 0.f, 0.f, 0.f};
        uint4 rq, rk, rv0, rv1, rg = make_uint4(0u, 0u, 0u, 0u);
        GLA_GLOAD(0);
        GLA_STAGE();
        __syncthreads();
        for (int ch = 0; ch < KVLEN / 64; ++ch) {
            int rbase, rsgn;
            GLA_ROWS(ch, rbase, rsgn);
            if (ch + 1 < KVLEN / 64) GLA_GLOAD(ch + 1);
            float cl[8];
            {
                float run = 0.f;
#pragma unroll
                for (int i = 0; i < 8; ++i) {
                    const uint4 g0 = *(const uint4*)(GRAW + (8 * seg + i) * 32), g1 = *(const uint4*)(GRAW + (8 * seg + i) * 32 + 16);
                    const unsigned gw[8] = {g0.x, g0.y, g0.z, g0.w, g1.x, g1.y, g1.z, g1.w};
                    float z = breg;
#pragma unroll
                    for (int j = 0; j < 8; ++j) { z += __uint_as_float(gw[j] << 16) * wreg[2 * j]; z += __uint_as_float(gw[j] & 0xffff0000u) * wreg[2 * j + 1]; }
                    run += (fminf(z, 0.f) - __logf(1.f + __expf(-fabsf(z)))) * (1.f / 16.f);
                    cl[i] = run;
                }
                SEG[seg * 64 + d] = run;
            }
            __syncthreads();
            {
                float prefix = 0.f, total = 0.f;
#pragma unroll
                for (int s2 = 0; s2 < 8; ++s2) { const float v = SEG[s2 * 64 + d]; total += v; prefix += (s2 < seg) ? v : 0.f; }
                const float etot = __expf(total);
                if (seg == 0) DEC[d] = etot;
                unsigned kew[4];
#pragma unroll
                for (int i = 0; i < 8; ++i) {
                    const int c = 8 * seg + i;
                    const float qv = bf2f(*(const bf16*)(QRAW + c * GLA_PITCH + d * 2)) * 0.125f, kv = bf2f(*(const bf16*)(KRAW + c * GLA_PITCH + d * 2));
                    const float e = __expf(prefix + cl[i]), ei = __builtin_amdgcn_rcpf(e);
                    *(bf16*)(QD + c * GLA_PITCH + d * 2) = (bf16)f2bf(qv * e);
                    *(bf16*)(KI + c * GLA_PITCH + d * 2) = (bf16)f2bf(kv * ei);
                    const unsigned kb = f2bf(kv * (etot * ei));
                    if (i & 1) kew[i >> 1] |= kb << 16; else kew[i >> 1] = kb;
                }
                *(uint4*)(KET + d * GLA_PITCH + seg * 16) = make_uint4(kew[0], kew[1], kew[2], kew[3]);
                const int v = tid & 127, cg = tid >> 7;
                unsigned vw[8];
#pragma unroll
                for (int i = 0; i < 16; ++i) {
                    const unsigned x = *(const bf16*)(VRAW + (16 * cg + i) * 272 + v * 2);
                    if (i & 1) vw[i >> 1] |= x << 16; else vw[i >> 1] = x;
                }
                *(uint4*)(VT + v * GLA_PITCH + cg * 32) = make_uint4(vw[0], vw[1], vw[2], vw[3]);
                *(uint4*)(VT + v * GLA_PITCH + cg * 32 + 16) = make_uint4(vw[4], vw[5], vw[6], vw[7]);
            }
            __syncthreads();
            for (int blk = wid; blk < 10; blk += NWV) {
                int sblk, cblk;
                if (blk < 4) { sblk = 0; cblk = blk; } else if (blk < 7) { sblk = 1; cblk = blk - 3; } else if (blk < 9) { sblk = 2; cblk = blk - 5; } else { sblk = 3; cblk = 3; }
                f32x4_t acc = (f32x4_t){0.f, 0.f, 0.f, 0.f};
#pragma unroll
                for (int kk = 0; kk < 2; ++kk) {
                    const bf16x8 a = *(const bf16x8*)(KI + (16 * sblk + l15) * GLA_PITCH + 64 * kk + 16 * q4);
                    const bf16x8 bq = *(const bf16x8*)(QD + (16 * cblk + l15) * GLA_PITCH + 64 * kk + 16 * q4);
                    acc = __builtin_amdgcn_mfma_f32_16x16x32_bf16(a, bq, acc, 0, 0, 0);
                }
                const int c = 16 * cblk + l15, s0 = 16 * sblk + 4 * q4;
                float av[4];
#pragma unroll
                for (int r = 0; r < 4; ++r) av[r] = (s0 + r <= c) ? acc[r] : 0.f;
                *(uint2*)(AT + c * GLA_PITCH + s0 * 2) = make_uint2(pk2(av[0], av[1]), pk2(av[2], av[3]));
            }
            __syncthreads();
            {
                const int v0 = 16 * wid;
                bf16x8 bv[2], sB[2];
#pragma unroll
                for (int kk = 0; kk < 2; ++kk) {
                    bv[kk] = *(const bf16x8*)(VT + (v0 + l15) * GLA_PITCH + 64 * kk + 16 * q4);
                    uint4 w = make_uint4(pk2(S[2 * kk][0], S[2 * kk][1]), pk2(S[2 * kk][2], S[2 * kk][3]), pk2(S[2 * kk + 1][0], S[2 * kk + 1][1]), pk2(S[2 * kk + 1][2], S[2 * kk + 1][3]));
                    sB[kk] = __builtin_bit_cast(bf16x8, w);
                }
#pragma unroll
                for (int cblk = 0; cblk < 4; ++cblk) {
                    f32x4_t acc = (f32x4_t){0.f, 0.f, 0.f, 0.f};
                    const unsigned char* arow = AT + (16 * cblk + l15) * GLA_PITCH;
                    const unsigned char* qrow = QD + (16 * cblk + l15) * GLA_PITCH;
#pragma unroll
                    for (int kk = 0; kk < 2; ++kk) {
                        if (kk == 0 || cblk >= 2) {
                            const bf16x8 a = *(const bf16x8*)(arow + 64 * kk + 16 * q4);
                            acc = __builtin_amdgcn_mfma_f32_16x16x32_bf16(a, bv[kk], acc, 0, 0, 0);
                        }
                    }
#pragma unroll
                    for (int kk = 0; kk < 2; ++kk) {
                        const uint2 a0 = *(const uint2*)(qrow + 64 * kk + 8 * q4), a1 = *(const uint2*)(qrow + 64 * kk + 32 + 8 * q4);
                        uint4 aw = make_uint4(a0.x, a0.y, a1.x, a1.y);
                        acc = __builtin_amdgcn_mfma_f32_16x16x32_bf16(__builtin_bit_cast(bf16x8, aw), sB[kk], acc, 0, 0, 0);
                    }
#pragma unroll
                    for (int r = 0; r < 4; ++r) Od[(size_t)(rbase + rsgn * (16 * cblk + 4 * q4 + r)) * 512 + h * 128 + v0 + l15] = (bf16)f2bf(acc[r]);
                }
#pragma unroll
                for (int dblk = 0; dblk < 4; ++dblk) {
#pragma unroll
                    for (int r = 0; r < 4; ++r) S[dblk][r] *= DEC[16 * dblk + 4 * q4 + r];
#pragma unroll
                    for (int kk = 0; kk < 2; ++kk) {
                        const bf16x8 a = *(const bf16x8*)(KET + (16 * dblk + l15) * GLA_PITCH + 64 * kk + 16 * q4);
                        S[dblk] = __builtin_amdgcn_mfma_f32_16x16x32_bf16(a, bv[kk], S[dblk], 0, 0, 0);
                    }
                }
            }
            if (ch + 1 < KVLEN / 64) GLA_STAGE();
            __syncthreads();
        }
    }
#undef GLA_ROWS
#undef GLA_GLOAD
#undef GLA_STAGE
}
__device__ __forceinline__ void ph_even_post(const int WIDS, bf16* __restrict__ ATT, const float* __restrict__ lamv, const float* __restrict__ subln, float lam_init,
                             const bf16* __restrict__ OF, const bf16* __restrict__ OB, const bf16* __restrict__ P, const float* __restrict__ gain) {
    const int TID = opaque_tid(WIDS), BID = opaque_bid();
    int wave = BID * NWV + (TID >> 6), lane = TID & 63;
    int nw = gridDim.x * NWV;
    float p1 = lamv[lane] * lamv[64 + lane], p2 = lamv[128 + lane] * lamv[192 + lane];
    p1 = wave_sum(p1); p2 = wave_sum(p2);
    const float lam = expf(p1) - expf(p2) + lam_init;
    const int hh = lane >> 4, cc = lane & 15;
    float sg8[8], g8[8];
    { const float4 a0 = ((const float4*)(subln + 8 * cc))[0], a1 = ((const float4*)(subln + 8 * cc))[1], b0 = ((const float4*)(gain + 8 * cc))[0], b1 = ((const float4*)(gain + 8 * cc))[1];
      sg8[0] = a0.x; sg8[1] = a0.y; sg8[2] = a0.z; sg8[3] = a0.w; sg8[4] = a1.x; sg8[5] = a1.y; sg8[6] = a1.z; sg8[7] = a1.w;
      g8[0] = b0.x; g8[1] = b0.y; g8[2] = b0.z; g8[3] = b0.w; g8[4] = b1.x; g8[5] = b1.y; g8[6] = b1.z; g8[7] = b1.w; }
    for (int r0 = wave; r0 < RT; r0 += 2 * nw) {
        const int r1 = r0 + nw < RT ? r0 + nw : r0;
        uint4 o0[2], o1[2], xf[2], xb[2], rr[2];
#pragma unroll
        for (int q = 0; q < 2; ++q) {
            const int r = q ? r1 : r0;
            const bf16* a = ATT + (size_t)r * DM + 8 * cc;
            o0[q] = *(const uint4*)(a + (2 * hh) * 128); o1[q] = *(const uint4*)(a + (2 * hh + 1) * 128);
            xf[q] = *(const uint4*)(OF + (size_t)r * 512 + hh * 128 + 8 * cc); xb[q] = *(const uint4*)(OB + (size_t)r * 512 + hh * 128 + 8 * cc);
            rr[q] = *(const uint4*)(P + (size_t)r * EVEN_LDP + 2560 + hh * 128 + 8 * cc);
        }
#pragma unroll
        for (int q = 0; q < 2; ++q) {
            if (q == 1 && r1 == r0) break;
            bf16* a = ATT + (size_t)(q ? r1 : r0) * DM + hh * 128 + 8 * cc;
            const unsigned w0[4] = {o0[q].x, o0[q].y, o0[q].z, o0[q].w}, w1[4] = {o1[q].x, o1[q].y, o1[q].z, o1[q].w};
            const unsigned wf[4] = {xf[q].x, xf[q].y, xf[q].z, xf[q].w}, wb[4] = {xb[q].x, xb[q].y, xb[q].z, xb[q].w}, wr[4] = {rr[q].x, rr[q].y, rr[q].z, rr[q].w};
            float d[8], e[8], gt[8]; float sd = 0.f, se = 0.f;
#pragma unroll
            for (int i = 0; i < 4; ++i) {
                d[2 * i] = __uint_as_float(w0[i] << 16) - lam * __uint_as_float(w1[i] << 16); d[2 * i + 1] = __uint_as_float(w0[i] & 0xffff0000u) - lam * __uint_as_float(w1[i] & 0xffff0000u);
                e[2 * i] = __uint_as_float(wf[i] << 16) + __uint_as_float(wb[i] << 16); e[2 * i + 1] = __uint_as_float(wf[i] & 0xffff0000u) + __uint_as_float(wb[i] & 0xffff0000u);
                gt[2 * i] = __uint_as_float(wr[i] << 16); gt[2 * i + 1] = __uint_as_float(wr[i] & 0xffff0000u);
                sd += d[2 * i] * d[2 * i] + d[2 * i + 1] * d[2 * i + 1]; se += e[2 * i] * e[2 * i] + e[2 * i + 1] * e[2 * i + 1];
            }
            sd += shx<1>(sd); sd += shx<2>(sd); sd += shx<4>(sd); sd += shx<8>(sd);
            se += shx<1>(se); se += shx<2>(se); se += shx<4>(se); se += shx<8>(se);
            const float rd = rsqrtf(sd * (1.f / 128.f) + 1e-6f) * (1.f - lam_init), re = rsqrtf(se * (1.f / 128.f) + 1e-6f);
            float od[8], og[8];
#pragma unroll
            for (int i = 0; i < 8; ++i) { od[i] = d[i] * rd * sg8[i]; og[i] = e[i] * re * g8[i] * (gt[i] * __builtin_amdgcn_rcpf(1.f + __expf(-gt[i]))); }
            *(uint4*)a = make_uint4(pk2(od[0], od[1]), pk2(od[2], od[3]), pk2(od[4], od[5]), pk2(od[6], od[7]));
            *(uint4*)(a + 512) = make_uint4(pk2(og[0], og[1]), pk2(og[2], og[3]), pk2(og[4], og[5]), pk2(og[6], og[7]));
        }
    }
}

#define CE_DESC(a, b) do { const unsigned hi_ = max((a), (b)); (b) = min((a), (b)); (a) = hi_; } while (0)
#define SORT16_DESC(t) do { CE_DESC(t[0], t[1]); CE_DESC(t[2], t[3]); CE_DESC(t[4], t[5]); CE_DESC(t[6], t[7]); CE_DESC(t[8], t[9]); CE_DESC(t[10], t[11]); CE_DESC(t[12], t[13]); CE_DESC(t[14], t[15]); CE_DESC(t[0], t[2]); CE_DESC(t[1], t[3]); CE_DESC(t[4], t[6]); CE_DESC(t[5], t[7]); CE_DESC(t[8], t[10]); CE_DESC(t[9], t[11]); CE_DESC(t[12], t[14]); CE_DESC(t[13], t[15]); CE_DESC(t[1], t[2]); CE_DESC(t[5], t[6]); CE_DESC(t[9], t[10]); CE_DESC(t[13], t[14]); CE_DESC(t[0], t[4]); CE_DESC(t[1], t[5]); CE_DESC(t[2], t[6]); CE_DESC(t[3], t[7]); CE_DESC(t[8], t[12]); CE_DESC(t[9], t[13]); CE_DESC(t[10], t[14]); CE_DESC(t[11], t[15]); CE_DESC(t[2], t[4]); CE_DESC(t[3], t[5]); CE_DESC(t[10], t[12]); CE_DESC(t[11], t[13]); CE_DESC(t[1], t[2]); CE_DESC(t[3], t[4]); CE_DESC(t[5], t[6]); CE_DESC(t[9], t[10]); CE_DESC(t[11], t[12]); CE_DESC(t[13], t[14]); CE_DESC(t[0], t[8]); CE_DESC(t[1], t[9]); CE_DESC(t[2], t[10]); CE_DESC(t[3], t[11]); CE_DESC(t[4], t[12]); CE_DESC(t[5], t[13]); CE_DESC(t[6], t[14]); CE_DESC(t[7], t[15]); CE_DESC(t[4], t[8]); CE_DESC(t[5], t[9]); CE_DESC(t[6], t[10]); CE_DESC(t[7], t[11]); CE_DESC(t[2], t[4]); CE_DESC(t[3], t[5]); CE_DESC(t[6], t[8]); CE_DESC(t[7], t[9]); CE_DESC(t[10], t[12]); CE_DESC(t[11], t[13]); CE_DESC(t[1], t[2]); CE_DESC(t[3], t[4]); CE_DESC(t[5], t[6]); CE_DESC(t[7], t[8]); CE_DESC(t[9], t[10]); CE_DESC(t[11], t[12]); CE_DESC(t[13], t[14]); } while (0)
#define MERGE16_DESC(a, b) do { \
    _Pragma("unroll") for (int i_ = 0; i_ < 16; ++i_) a[i_] = max(a[i_], b[15 - i_]); \
    _Pragma("unroll") for (int j_ = 8; j_ > 0; j_ >>= 1) \
    _Pragma("unroll") for (int i_ = 0; i_ < 16; ++i_) { if ((i_ & j_) == 0) CE_DESC(a[i_], a[i_ | j_]); } } while (0)
#define RT_KPITCH 144
#define INSP16(t, x) do { unsigned x_ = (x); _Pragma("unroll") for (int j_ = 0; j_ < 16; ++j_) { const unsigned h_ = max(t[j_], x_); x_ = min(t[j_], x_); t[j_] = h_; } } while (0)
#define ROUTE_SCORE_BODY(LL_) { \
        _Pragma("unroll") \
        for (int half = 0; half < 2; ++half) { \
            bf16x8 qf[4]; \
            const bf16* qrow = Qp + (size_t)row * DM + h * 128 + half * 64; \
        _Pragma("unroll") \
            for (int s = 0; s < 4; ++s) qf[s] = *(const bf16x8*)(qrow + 16 * s + 8 * hi); \
        _Pragma("unroll") \
            for (int nb = 0; nb < 4; ++nb) { \
                f32x16 acc; \
        _Pragma("unroll") \
                for (int r = 0; r < 16; ++r) acc[r] = 0.f; \
        _Pragma("unroll") \
                for (int s = 0; s < 4; ++s) { \
                    const bf16x8 a = *(const bf16x8*)(lds + (half * 128 + 32 * nb + r32) * RT_KPITCH + 32 * s + 16 * hi); \
                    acc = __builtin_amdgcn_mfma_f32_32x32x16_bf16(a, qf[s], acc, 0, 0, 0); \
                } \
                unsigned run[16]; \
        _Pragma("unroll") \
                for (int r = 0; r < 16; ++r) { \
                    unsigned ub = __float_as_uint(acc[r]); \
                    ub = (ub & 0x80000000u) ? ~ub : (ub | 0x80000000u); \
                    run[r] = (ub & ~127u) | (unsigned)(127 - (32 * nb + (r & 3) + 8 * (r >> 2)) - 4 * hi); \
                } \
                SORT16_DESC(run); \
                if (nb == 0) { \
        _Pragma("unroll") \
                    for (int j = 0; j < 16; ++j) LL_[half][j] = run[j]; \
                } else MERGE16_DESC(LL_[half], run); \
                __builtin_amdgcn_sched_barrier(0); \
            } \
            unsigned o[16]; \
        _Pragma("unroll") \
            for (int j = 0; j < 16; ++j) o[j] = xchg32(LL_[half][j], hi != 0); \
            MERGE16_DESC(LL_[half], o); \
            __builtin_amdgcn_sched_barrier(0); \
        } }
__device__ __forceinline__ void ph_route_mfma(const int WIDS, const bf16* __restrict__ Qp, const bf16* __restrict__ Kb, int* __restrict__ IDX, float* __restrict__ GATE, unsigned char* lds, int nrows) {
    const int TID = opaque_tid(WIDS), BID = opaque_bid();
    const int tid = TID, lane = tid & 63, wid = tid >> 6, r32 = lane & 31, hi = lane >> 5;
    const int nu = (nrows / 256) * 8, G = gridDim.x;
    int hcur = -1;
    for (int uA = BID; uA < nu; uA += 2 * G) {
        const int uB = uA + G; const bool pair = uB < nu;
        unsigned L[2][16];
        {
            unsigned LA[2][16];
            { const int u_ = uA; const int h = u_ & 7, row = (u_ >> 3) * 256 + wid * 32 + r32;
              if (h != hcur) { __syncthreads();
                  for (int i = tid; i < 2 * 128 * 8; i += NT) *(uint4*)(lds + (i >> 3) * RT_KPITCH + (i & 7) * 16) = *(const uint4*)(Kb + ((size_t)h * 256 + (i >> 3)) * 64 + (i & 7) * 8);
                  __syncthreads(); hcur = h; }
              ROUTE_SCORE_BODY(LA) }
#pragma unroll
            for (int x_ = 0; x_ < 2; ++x_)
#pragma unroll
                for (int j = 0; j < 16; ++j) L[x_][j] = LA[x_][j];
        }
        if (pair) {
            unsigned LB[2][16];
            { const int u_ = uB; const int h = u_ & 7, row = (u_ >> 3) * 256 + wid * 32 + r32;
              if (h != hcur) { __syncthreads();
                  for (int i = tid; i < 2 * 128 * 8; i += NT) *(uint4*)(lds + (i >> 3) * RT_KPITCH + (i & 7) * 16) = *(const uint4*)(Kb + ((size_t)h * 256 + (i >> 3)) * 64 + (i & 7) * 8);
                  __syncthreads(); hcur = h; }
              ROUTE_SCORE_BODY(LB) }
#pragma unroll
            for (int x_ = 0; x_ < 2; ++x_)
#pragma unroll
                for (int j = 0; j < 16; ++j) L[x_][j] = hi ? LB[x_][j] : L[x_][j];
        }
        const int uu = (pair && hi) ? uB : uA;
        const int h = uu & 7, row = (uu >> 3) * 256 + wid * 32 + r32;
        float v1[16], v2[16];
        {
            unsigned w1[4] = {0u, 0u, 0u, 0u}, w2[4] = {0u, 0u, 0u, 0u};
#pragma unroll
            for (int j = 0; j < 16; ++j) {
                unsigned a = L[0][j] & ~127u, b = L[1][j] & ~127u;
                a = (a & 0x80000000u) ? (a & 0x7fffffffu) : ~a; b = (b & 0x80000000u) ? (b & 0x7fffffffu) : ~b;
                v1[j] = __uint_as_float(a); v2[j] = __uint_as_float(b);
                w1[j >> 2] |= (127u - (L[0][j] & 127u)) << (8 * (j & 3)); w2[j >> 2] |= (127u - (L[1][j] & 127u)) << (8 * (j & 3));
            }
            unsigned char* sb = lds + 2 * 128 * RT_KPITCH + tid * 4;
#pragma unroll
            for (int k = 0; k < 4; ++k) { *(unsigned*)(sb + k * 2048) = w1[k]; *(unsigned*)(sb + (4 + k) * 2048) = w2[k]; }
        }
#define CAND(a, b) ({ unsigned ub_ = __float_as_uint(v1[a] + v2[b]); ub_ = (ub_ & 0x80000000u) ? ~ub_ : (ub_ | 0x80000000u); (ub_ & ~255u) | (unsigned)(255 - (16 * (a) + (b))); })
        unsigned T[16], R1[16], R2[16], R3[16];
#pragma unroll
        for (int b = 0; b < 16; ++b) T[b] = CAND(0, b);
        {
#pragma unroll
            for (int b = 0; b < 8; ++b) R1[b] = CAND(1, b);
#pragma unroll
            for (int b = 0; b < 5; ++b) R1[8 + b] = CAND(2, b);
#pragma unroll
            for (int b = 0; b < 3; ++b) R1[13 + b] = CAND(4, b);
#pragma unroll
            for (int b = 0; b < 4; ++b) R2[b] = CAND(3, b);
#pragma unroll
            for (int a = 5; a < 8; ++a) { R2[4 + 2 * (a - 5)] = CAND(a, 0); R2[5 + 2 * (a - 5)] = CAND(a, 1); }
#pragma unroll
            for (int a = 8; a < 14; ++a) R2[10 + (a - 8)] = CAND(a, 0);
            R3[0] = CAND(14, 0); R3[1] = CAND(15, 0);
#pragma unroll
            for (int j = 2; j < 16; ++j) R3[j] = 0u;
        }
        SORT16_DESC(R1); MERGE16_DESC(T, R1);
        SORT16_DESC(R2); MERGE16_DESC(T, R2);
        if (R3[0] < R3[1]) { const unsigned t_ = R3[0]; R3[0] = R3[1]; R3[1] = t_; }
        MERGE16_DESC(T, R3);
#undef CAND
        float e[16]; int bi[16]; float sum = 0.f, v0 = 0.f;
        {
            const unsigned char* sb = lds + 2 * 128 * RT_KPITCH + tid * 4;
#pragma unroll
            for (int j = 0; j < 16; ++j) {
                unsigned ub = T[j] & ~255u;
                ub = (ub & 0x80000000u) ? (ub & 0x7fffffffu) : ~ub;
                const float val = __uint_as_float(ub);
                if (j == 0) v0 = val;
                e[j] = __expf(val - v0); sum += e[j];
                const unsigned flat = 255u - (T[j] & 255u), ca = flat >> 4, cb = flat & 15u;
                const unsigned ia = *(const unsigned char*)(sb + (ca >> 2) * 2048 + (ca & 3)), ib = *(const unsigned char*)(sb + (4 + (cb >> 2)) * 2048 + (cb & 3));
                bi[j] = (int)(ia * 128u + ib);
            }
        }
        const float inv = 1.f / sum;
        if (pair || hi == 0) {
            int* ip = IDX + (size_t)row * 128 + h * 16; float* gp = GATE + (size_t)row * 128 + h * 16;
#pragma unroll
            for (int j = 0; j < 4; ++j) {
#define ROUTE_PK(k_) ((int)((cvt_pk_bf16_f32(0.f, e[k_] * inv) & 0xffff0000u) | (unsigned)bi[k_]))
                *(int4*)(ip + 4 * j) = make_int4(ROUTE_PK(4 * j), ROUTE_PK(4 * j + 1), ROUTE_PK(4 * j + 2), ROUTE_PK(4 * j + 3));
#undef ROUTE_PK
            }
        }
    }
    __syncthreads();
}
#undef ROUTE_SCORE_BODY
__device__ __forceinline__ unsigned fp6_e2m3(float v) {
    const float a = fabsf(v);
    float c;
    if (a < 2.f) c = rintf(a * 8.f);
    else if (a < 4.f) c = 16.f + rintf((a - 2.f) * 4.f);
    else c = fminf(24.f + rintf((a - 4.f) * 2.f), 31.f);
    return (unsigned)c | (v < 0.f ? 32u : 0u);
}
__device__ __forceinline__ void ph_table_prep(const int WIDS, const float* __restrict__ U, const float* __restrict__ V, unsigned char* __restrict__ T6, float* __restrict__ RS, int rr0, int rr1, int wv, int nwv) {
    const int TID = opaque_tid(WIDS);
    const int lane = TID & 63;
    const int NROWS = DEPTH * 16384;
    for (int ra = rr0 + wv; ra < rr1; ra += 2 * nwv) {
        const int rb = ra + nwv < rr1 ? ra + nwv : ra;
        float4 v2[2][4];
#pragma unroll
        for (int q = 0; q < 2; ++q) {
            const int rr = q ? rb : ra;
            const float* src = (rr < NROWS ? U : V) + (size_t)(rr < NROWS ? rr : rr - NROWS) * DM + lane * 16;
#pragma unroll
            for (int i = 0; i < 4; ++i) v2[q][i] = ((const float4*)src)[i];
        }
#pragma unroll
        for (int q = 0; q < 2; ++q) {
            if (q == 1 && rb == ra) break;
            const int rr = q ? rb : ra;
            float am = 0.f;
#pragma unroll
            for (int i = 0; i < 4; ++i) am = fmaxf(am, fmaxf(fmaxf(fabsf(v2[q][i].x), fabsf(v2[q][i].y)), fmaxf(fabsf(v2[q][i].z), fabsf(v2[q][i].w))));
            am = wave_max(am);
            am = fmaxf(am, 1e-30f);
            const float sc = exp2f(floorf(log2f(7.5f / am)));
            unsigned e[16];
#pragma unroll
            for (int i = 0; i < 4; ++i) { e[4 * i] = fp6_e2m3(v2[q][i].x * sc); e[4 * i + 1] = fp6_e2m3(v2[q][i].y * sc); e[4 * i + 2] = fp6_e2m3(v2[q][i].z * sc); e[4 * i + 3] = fp6_e2m3(v2[q][i].w * sc); }
            const unsigned d0 = e[0] | (e[1] << 6) | (e[2] << 12) | (e[3] << 18) | (e[4] << 24) | (e[5] << 30);
            const unsigned d1 = (e[5] >> 2) | (e[6] << 4) | (e[7] << 10) | (e[8] << 16) | (e[9] << 22) | (e[10] << 28);
            const unsigned d2 = (e[10] >> 4) | (e[11] << 2) | (e[12] << 8) | (e[13] << 14) | (e[14] << 20) | (e[15] << 26);
            unsigned* dst = (unsigned*)(T6 + (size_t)rr * 768 + lane * 12);
            dst[0] = d0; dst[1] = d1; dst[2] = d2;
            if (lane == 0) ((unsigned short*)RS)[(rr < NROWS ? rr : rr - NROWS) * 2 + (rr < NROWS ? 1 : 0)] = (unsigned short)(__float_as_uint(1.f / sc) >> 16);
        }
    }
}
typedef unsigned v6u32_t __attribute__((ext_vector_type(6)));
typedef float v32f_t __attribute__((ext_vector_type(32)));
typedef __bf16 v32bf_t __attribute__((ext_vector_type(32)));
typedef unsigned v16u_t __attribute__((ext_vector_type(16)));
struct u3 { unsigned x, y, z; };
typedef unsigned v3u_t __attribute__((ext_vector_type(3)));
typedef unsigned u32x4v __attribute__((ext_vector_type(4)));
typedef unsigned u32x2v __attribute__((ext_vector_type(2)));
#define BR4(j) ((((j) & 1) << 3) | (((j) & 2) << 1) | (((j) & 4) >> 1) | (((j) & 8) >> 3))
__device__ __forceinline__ void ph_peer_ffn8(const int WIDS, const bf16* A2, const int* __restrict__ IDX, const float* __restrict__ GATE,
                            const unsigned char* __restrict__ U8, const float* __restrict__ RSU, const unsigned char* __restrict__ V8, const float* __restrict__ RSV,
                            const float* __restrict__ mods_l, bf16* X, float* Xout_f32, int nrows,
                            const float* __restrict__ gnext, const float* __restrict__ mods_next, bf16* Anext) {
    const int TID = opaque_tid(WIDS), BID = opaque_bid();
    const int wave = BID * NWV + (TID >> 6), lane = TID & 63, nw = gridDim.x * NWV;
    const int jl = BR4(lane & 15);
    const unsigned lane12 = (unsigned)lane * 12u;
    for (int r = wave; r < nrows; r += nw) {
        float xf[16];
        { int lx = lane; asm volatile("" : "+v"(lx)); const u32x4v* xp = (const u32x4v*)(A2 + (size_t)r * DM + lx * 16); const u32x4v a = __builtin_nontemporal_load(xp), b = __builtin_nontemporal_load(xp + 1); const unsigned xw[8] = {a.x, a.y, a.z, a.w, b.x, b.y, b.z, b.w};
#pragma unroll
          for (int i = 0; i < 8; ++i) { xf[2 * i] = __uint_as_float(xw[i] << 16); xf[2 * i + 1] = __uint_as_float(xw[i] & 0xffff0000u); } }
        float acc[16];
#pragma unroll
        for (int k = 0; k < 16; ++k) acc[k] = 0.f;
        int rg_ = __builtin_amdgcn_readfirstlane(r); asm volatile("" : "+s"(rg_));
        int nid = *(const int*)((const unsigned char*)IDX + ((unsigned)(rg_ * 128 + jl) * 4u));
        for (int g = 0; g < 8; ++g) {
            const int myid = nid & 0xffff; const float mygate = __uint_as_float((unsigned)nid & 0xffff0000u);
            nid = *(const int*)((const unsigned char*)IDX + ((unsigned)(rg_ * 128 + ((g + 1) & 7) * 16 + jl) * 4u));
            const unsigned rs2 = *(const unsigned*)((const unsigned char*)RSU + (unsigned)myid * 4u);
            const float rsu = __uint_as_float(rs2 & 0xffff0000u), rsv = __uint_as_float(rs2 << 16);
            u3 ub[16], vb[16];
            const unsigned myoff = (unsigned)myid * 768u;
            unsigned l12 = lane12; asm("" : "+v"(l12));
#pragma unroll
            for (int j = 0; j < 16; ++j) { const unsigned so = (unsigned)__builtin_amdgcn_readlane((int)myoff, BR4(j)); const unsigned char GAS* rp = (const unsigned char GAS*)(U8 + so); asm("" : "+s"(rp)); const v3u_t t_ = *(const v3u_t GAS*)(rp + l12); ub[j].x = t_.x; ub[j].y = t_.y; ub[j].z = t_.z; }
#pragma unroll
            for (int j = 0; j < 16; ++j) { const unsigned so = (unsigned)__builtin_amdgcn_readlane((int)myoff, BR4(j)); const unsigned char GAS* rp = (const unsigned char GAS*)(V8 + so); asm("" : "+s"(rp)); const v3u_t t_ = *(const v3u_t GAS*)(rp + l12); vb[j].x = t_.x; vb[j].y = t_.y; vb[j].z = t_.z; }
            float d[16];
#pragma unroll
            for (int j = 0; j < 16; j += 2) {
                const v6u32_t src = {ub[j].x, ub[j].y, ub[j].z, ub[j + 1].x, ub[j + 1].y, ub[j + 1].z};
                const v32f_t f = __builtin_amdgcn_cvt_scalef32_pk32_f32_fp6(src, 1.0f);
                float d0 = 0.f, d1 = 0.f;
#pragma unroll
                for (int k = 0; k < 16; ++k) { d0 = __builtin_fmaf(f[k], xf[k], d0); d1 = __builtin_fmaf(f[16 + k], xf[k], d1); }
                d[j] = d0; d[j + 1] = d1;
                __builtin_amdgcn_sched_barrier(0);
            }
#define PEER_TR(st_, n_, M_) do { const bool up = (lane & (M_)) != 0; _Pragma("unroll") for (int i = 0; i < (n_); ++i) { \
                const float send = up ? d[i] : d[i + (n_)], keep = up ? d[i + (n_)] : d[i]; d[i] = keep + shx<M_>(send); } } while (0)
            PEER_TR(0, 8, 1); PEER_TR(1, 4, 2); PEER_TR(2, 2, 4); PEER_TR(3, 1, 8);
#undef PEER_TR
            float tot = d[0];
            tot += shx<16>(tot); tot = sum32(tot);
            const float w = mygate * gelu_tanh(tot * rsu) * rsv;
#pragma unroll
            for (int j = 0; j < 16; j += 2) {
                const float w0 = __int_as_float(__builtin_amdgcn_readlane(__float_as_int(w), BR4(j))), w1 = __int_as_float(__builtin_amdgcn_readlane(__float_as_int(w), BR4(j + 1)));
                const v6u32_t src = {vb[j].x, vb[j].y, vb[j].z, vb[j + 1].x, vb[j + 1].y, vb[j + 1].z};
                const v32f_t f = __builtin_amdgcn_cvt_scalef32_pk32_f32_fp6(src, 1.0f);
#pragma unroll
                for (int k = 0; k < 16; ++k) { acc[k] = __builtin_fmaf(w0, f[k], acc[k]); acc[k] = __builtin_fmaf(w1, f[16 + k], acc[k]); }
                __builtin_amdgcn_sched_barrier(0);
            }
        }
        int re = __builtin_amdgcn_readfirstlane(r); asm volatile("" : "+s"(re)); int le = lane; asm volatile("" : "+v"(le));
        const float4* g5 = (const float4*)(mods_l + (size_t)row_mod(re) * MODW + 5 * DM + le * 16);
        bf16* xrb = X + (size_t)re * DM + le * 16;
        float4 xn[4]; float ss = 0.f;
        const u32x4v xr0 = __builtin_nontemporal_load((const u32x4v*)xrb), xr1 = __builtin_nontemporal_load((const u32x4v*)xrb + 1);
        const unsigned xrw[8] = {xr0.x, xr0.y, xr0.z, xr0.w, xr1.x, xr1.y, xr1.z, xr1.w};
#pragma unroll
        for (int i = 0; i < 4; ++i) { float4 xv = make_float4(__uint_as_float(xrw[2 * i] << 16), __uint_as_float(xrw[2 * i] & 0xffff0000u), __uint_as_float(xrw[2 * i + 1] << 16), __uint_as_float(xrw[2 * i + 1] & 0xffff0000u)), gg = g5[i];
            xv.x += gg.x * acc[4 * i]; xv.y += gg.y * acc[4 * i + 1]; xv.z += gg.z * acc[4 * i + 2]; xv.w += gg.w * acc[4 * i + 3]; xn[i] = xv;
            ss += xv.x * xv.x + xv.y * xv.y + xv.z * xv.z + xv.w * xv.w; }
        if (Xout_f32) {
            float4* xo = (float4*)(Xout_f32 + (size_t)re * DM + le * 16);
#pragma unroll
            for (int i = 0; i < 4; ++i) xo[i] = xn[i];
        } else {
            const u32x4v w0 = {pk2(xn[0].x, xn[0].y), pk2(xn[0].z, xn[0].w), pk2(xn[1].x, xn[1].y), pk2(xn[1].z, xn[1].w)}, w1 = {pk2(xn[2].x, xn[2].y), pk2(xn[2].z, xn[2].w), pk2(xn[3].x, xn[3].y), pk2(xn[3].z, xn[3].w)};
            __builtin_nontemporal_store(w0, (u32x4v*)xrb); __builtin_nontemporal_store(w1, (u32x4v*)xrb + 1);
        }
        if (gnext) {
            const float rstd = rsqrtf(wave_sum(ss) * (1.f / DM) + 1e-6f);
            const float* mn = mods_next + (size_t)row_mod(re) * MODW + le * 16;
            bf16* ar = Anext + (size_t)re * DM + le * 16;
#pragma unroll
            for (int i = 0; i < 4; ++i) {
                const float4 gg = ((const float4*)(gnext + le * 16))[i], sh = ((const float4*)mn)[i], sc = ((const float4*)(mn + DM))[i];
                float4 o;
                o.x = xn[i].x * rstd * gg.x * (1.f + sc.x) + sh.x; o.y = xn[i].y * rstd * gg.y * (1.f + sc.y) + sh.y;
                o.z = xn[i].z * rstd * gg.z * (1.f + sc.z) + sh.z; o.w = xn[i].w * rstd * gg.w * (1.f + sc.w) + sh.w;
                __builtin_nontemporal_store((u32x2v){pk2(o.x, o.y), pk2(o.z, o.w)}, (u32x2v*)(ar + 4 * i));
            }
        }
    }
}
template <int N>
__device__ __forceinline__ void ph_gemm_bf16(const int WIDS, const bf16* A, const bf16* Bt, bf16* O, unsigned char* lds, int M) {
    pg8::Gemm g{A, Bt, M, N, DM}; pg8::StaticOrder S; S.init(M, N, (int)gridDim.x, opaque_bid());
    pg8::EpiBf16<0> E{O, N, nullptr, 0, 0, 1.f};
    pg8::gemm_phase<pg8::EpiBf16<0>, pg8::StaticOrder, true, true>((PG8_LAS unsigned char*)lds, g, S, E, WIDS);
}
__device__ __forceinline__ void ph_gemm_res(const int WIDS, const bf16* A, const bf16* Bt, bf16* X, const float* gate, unsigned char* lds, int M) {
    pg8::Gemm g{A, Bt, M, DM, DM}; pg8::StaticOrder S; S.init(M, DM, (int)gridDim.x, opaque_bid());
    EpiResGate E{X, gate};
    pg8::gemm_phase<EpiResGate, pg8::StaticOrder, true, true>((PG8_LAS unsigned char*)lds, g, S, E, WIDS);
}

#define XB_TMO      128
#define XB_XCNT(j)  (256  + 64 * (j))
#define XB_XSUB(j)  (1280 + 64 * (j))
#define XB_XGEN(j)  (2304 + 64 * (j))
#define XB_TOP      3328
#define XB_TOPGEN   3392
#define XCD_BAR_WORDS 3456
#define XB_SPIN_CAP (1u << 18)

__device__ __forceinline__ unsigned xb_ld(unsigned* p)              { return __hip_atomic_load(p, __ATOMIC_RELAXED, __HIP_MEMORY_SCOPE_AGENT); }
__device__ __forceinline__ unsigned xb_add(unsigned* p, unsigned v) { return __hip_atomic_fetch_add(p, v, __ATOMIC_RELAXED, __HIP_MEMORY_SCOPE_AGENT); }
__device__ __forceinline__ unsigned xb_xcc_id() { return (unsigned)__builtin_amdgcn_s_getreg((3 << 11) | 20) & 0xFu; }
#define XB_SPIN(cond, bar) do { unsigned _sp = 0; while (cond) { __builtin_amdgcn_s_sleep(1); \
    if ((++_sp & 255u) == 0u) { if (xb_ld(&(bar)[XB_TMO])) break; if (_sp > XB_SPIN_CAP) { atomicAdd(&(bar)[XB_TMO], 1u); break; } } } } while (0)

struct XcdBarrier {
    bool leader;
    unsigned* bar; unsigned x;
    volatile LAS unsigned* st;
};

__device__ __forceinline__ XcdBarrier xcd_barrier_post(unsigned* bar, volatile LAS unsigned* st, bool leader) {
    XcdBarrier b; b.leader = leader; b.bar = bar; b.x = xb_xcc_id(); b.st = st;
    if (leader) (void)xb_add(&bar[XB_XCNT(b.x)], 1u);
    return b;
}
__device__ __forceinline__ void xcd_barrier_complete(unsigned* bar, unsigned x, unsigned& nloc, unsigned& nx) {
    const unsigned G = gridDim.x * gridDim.y * gridDim.z;
    unsigned sum, cnt, mine, sp = 0u;
    for (;;) {
        sum = 0u; cnt = 0u; mine = 0u;
#pragma unroll
        for (unsigned j = 0; j < 16; ++j) { const unsigned c = xb_ld(&bar[XB_XCNT(j)]); sum += c; cnt += (c > 0u) ? 1u : 0u; mine = (j == x) ? c : mine; }
        if (sum == G) break;
        __builtin_amdgcn_s_sleep(1);
        if ((++sp & 255u) == 0u) { if (xb_ld(&bar[XB_TMO])) break; if (sp > XB_SPIN_CAP) { atomicAdd(&bar[XB_TMO], 1u); break; } }
    }
    nloc = mine > 0u ? mine : 1u; nx = cnt > 0u ? cnt : 1u;
}

__device__ __forceinline__ void xcd_barrier(const XcdBarrier& b) {
    asm volatile("s_waitcnt vmcnt(0)" ::: "memory");
    __syncthreads();
    if (b.leader) {
        unsigned* bar = b.bar;
        __builtin_amdgcn_s_waitcnt(0);
        unsigned nloc = b.st[0], nx = b.st[1];
        if (nloc == 0u) { xcd_barrier_complete(bar, b.x, nloc, nx); b.st[0] = nloc; b.st[1] = nx; }
        const unsigned old = xb_add(&bar[XB_XSUB(b.x)], 1u);
        const unsigned gen = old / nloc;
        if (old + 1u == (gen + 1u) * nloc) {
            __builtin_amdgcn_fence(__ATOMIC_RELEASE, "agent");
            asm volatile("s_waitcnt vmcnt(0)" ::: "memory");
            const unsigned og = xb_add(&bar[XB_TOP], 1u);
            const unsigned tg = og / nx;
            if (og + 1u == (tg + 1u) * nx) xb_add(&bar[XB_TOPGEN], 1u);
            else XB_SPIN(xb_ld(&bar[XB_TOPGEN]) == tg, bar);
            __builtin_amdgcn_fence(__ATOMIC_ACQUIRE, "agent");
            xb_add(&bar[XB_XGEN(b.x)], 1u);
            asm volatile("s_waitcnt vmcnt(0)" ::: "memory");
        } else {
            XB_SPIN(xb_ld(&bar[XB_XGEN(b.x)]) == gen, bar);
            __builtin_amdgcn_fence(__ATOMIC_ACQUIRE, "agent");
            asm volatile("s_waitcnt vmcnt(0)" ::: "memory");
        }
    }
    __syncthreads();
}

constexpr size_t ALIGN_UP(size_t x) { return (x + 255) & ~(size_t)255; }
constexpr size_t WS_X = 0;
constexpr size_t WS_A = WS_X + (size_t)RT * DM * 4;
constexpr size_t WS_P = WS_A + (size_t)RT * DM * 2;
constexpr size_t WS_ATT = WS_P + (size_t)RT * EVEN_LDP * 2;
constexpr size_t WS_OF = WS_ATT + (size_t)RT * DM * 2;
constexpr size_t WS_MODS = WS_OF + (size_t)RT * 512 * 4 * 2;
constexpr size_t WS_ROPE = WS_MODS + ALIGN_UP((size_t)DEPTH * NMOD * MODW * 4);
constexpr size_t WS_WINE = WS_ROPE + (size_t)SEQ * 32 * 8;
constexpr size_t WS_WOUTE = WS_WINE + (size_t)2 * EVEN_LDP * DM * 2;
constexpr size_t WS_WINO = WS_WOUTE + (size_t)2 * DM * DM * 2;
constexpr size_t WS_WOUTO = WS_WINO + (size_t)2 * ODD_IN * DM * 2;
constexpr size_t WS_WPQ = WS_WOUTO + (size_t)2 * DM * DM * 2;
constexpr size_t WS_T8 = WS_WPQ + (size_t)4 * DM * DM * 2;
constexpr size_t WS_RS = WS_T8 + (size_t)2 * DEPTH * 16384 * DM;
constexpr size_t WS_KC = WS_RS + (size_t)2 * DEPTH * 16384 * 4;
constexpr size_t WS_VT = WS_KC + (size_t)NB * 8 * KVLEN * 64 * 2;
constexpr size_t WS_KEYS = WS_VT + (size_t)NB * 4 * 128 * KVLEN * 2;
constexpr size_t WS_BAR = WS_KEYS + (size_t)DEPTH * 8 * 2 * 128 * 64 * 2;
constexpr size_t WS_BAR_BYTES = 16384;
constexpr size_t WS_END = WS_BAR + WS_BAR_BYTES;

__global__ void __launch_bounds__(NT, 2) __attribute__((target("no-packed-fp32-ops"))) mega(Params p) {
    extern __shared__ __attribute__((aligned(16))) unsigned char lds[];
    float* smem = (float*)lds;
    cg::grid_group grid = cg::this_grid();
    unsigned char* ws = (unsigned char*)(unsigned char GAS*)p.ws;
    int wid_s = __builtin_amdgcn_readfirstlane((int)threadIdx.x >> 6);
    asm volatile("" : "+s"(wid_s));
#define MYTID() opaque_tid(wid_s)
    volatile LAS unsigned* bst = (volatile LAS unsigned*)((LAS unsigned char*)lds + 131072 + 512);
    if (MYTID() < 2) bst[MYTID()] = 0u;
    __syncthreads();
    (void)xcd_barrier_post((unsigned*)(ws + WS_BAR), bst, MYTID() == 0);
#define GSYNC() do { XcdBarrier b_; b_.leader = (MYTID() == 0); b_.bar = (unsigned*)(ws + WS_BAR); b_.x = xb_xcc_id(); b_.st = (volatile LAS unsigned*)((LAS unsigned char*)lds + 131072 + 512); xcd_barrier(b_); } while (0)
#define X_ ((bf16*)(ws + WS_X))
#define A_ ((bf16*)(ws + WS_A))
#define P_ ((bf16*)(ws + WS_P))
#define ATT_ ((bf16*)(ws + WS_ATT))
#define OF_ ((bf16*)(ws + WS_OF))
#define OB_ (OF_ + (size_t)RT * 512)
#define MODS_ ((float*)(ws + WS_MODS))
#define ROPE_ ((float2*)(ws + WS_ROPE))
#define WINE_ ((bf16*)(ws + WS_WINE))
#define WOUTE_ ((bf16*)(ws + WS_WOUTE))
#define WINO_ ((bf16*)(ws + WS_WINO))
#define WOUTO_ ((bf16*)(ws + WS_WOUTO))
#define WPQ_ ((bf16*)(ws + WS_WPQ))
#define QP_ P_
#define KEYS_ ((bf16*)(ws + WS_KEYS))
#define KC_ ((bf16*)(ws + WS_KC))
#define VT_ ((bf16*)(ws + WS_VT))
#define T8_ (ws + WS_T8)
#define RS_ ((float*)(ws + WS_RS))
#define IDX_ ((int*)(ws + WS_P + (size_t)RT * DM * 2))
#define GATE_ ((float*)(ws + WS_P + (size_t)RT * DM * 2 + (size_t)RT * 128 * 4))

    ph_rope_table(wid_s, ROPE_);
    ph_weight_prep(wid_s, p.in, WINE_, WOUTE_, WINO_, WOUTO_, WPQ_, KEYS_, lds);
    {
        const int G_ = (int)gridDim.x, wv_ = (int)blockIdx.x * NWV + wid_s, nwv_ = G_ * NWV, NR_ = DEPTH * 16384;
        if (G_ == 256) { ph_table_prep(wid_s, p.in[25], p.in[26], T8_, RS_, 0, 16384, wv_, nwv_); ph_table_prep(wid_s, p.in[25], p.in[26], T8_, RS_, NR_, NR_ + 16384, wv_, nwv_); }
        else ph_table_prep(wid_s, p.in[25], p.in[26], T8_, RS_, 0, 2 * NR_, wv_, nwv_);
    }
    __syncthreads();
    ph_mods(wid_s, p.in[1], p.in[3], p.in[4], p.in[5], MODS_, smem);
    grid.sync();
    ph_norm_mod(wid_s, p.in[0], p.in[2], nullptr, X_, p.in[6], MODS_, 0, A_, RT);
    GSYNC();
    for (int hl = 0; hl < 2 * DEPTH; ++hl) {
        { unsigned long long wsi_ = (unsigned long long)p.ws; asm volatile("" : "+s"(wsi_)); ws = (unsigned char*)(unsigned char GAS*)wsi_; }
        const int l = hl >> 1, part = hl & 1, i = l >> 1, odd = l & 1;
        const float* mods_l = MODS_ + (size_t)l * NMOD * MODW;
        if (part) {
            ph_norm_mod(wid_s, nullptr, nullptr, X_, nullptr, p.in[7] + l * DM, mods_l, 3, A_, l == DEPTH - 1 ? RL : RT);
            GSYNC();
        }
        if (part) ph_gemm_bf16<DM>(wid_s, A_, WPQ_ + (size_t)l * DM * DM, P_, lds, l == DEPTH - 1 ? RL : RT);
        else if (odd) ph_gemm_bf16<ODD_IN>(wid_s, A_, WINO_ + (size_t)i * ODD_IN * DM, P_, lds, RT);
        else ph_gemm_bf16<EVEN_LDP>(wid_s, A_, WINE_ + (size_t)i * EVEN_LDP * DM, P_, lds, RT);
        if (part && l + 1 < DEPTH && gridDim.x == 256 && blockIdx.x >= 64)
            ph_table_prep(wid_s, p.in[25], p.in[26], T8_, RS_, DEPTH * 16384 + (l + 1) * 16384, DEPTH * 16384 + (l + 2) * 16384, ((int)blockIdx.x - 64) * NWV + wid_s, 192 * NWV);
        GSYNC();
        if (part == 0) {
            const int ldp = odd ? ODD_IN : EVEN_LDP;
            ph_post(wid_s, P_, ldp, 0  , odd ? 1024 : 512, odd ? 4 : 8, odd ? 1280 : 1024, odd ? 256 : 512, odd ? 64 : 128,
                    (odd ? p.in[21] : p.in[10]) + i * 64, (odd ? p.in[22] : p.in[11]) + i * 64, ROPE_, KC_, VT_);
            GSYNC();
            if (!odd) {
                const int G_ = (int)gridDim.x, bid_ = (int)blockIdx.x;
                const int gu = (G_ == 256) ? (((bid_ >> 3) < 16) ? (bid_ & 7) * 16 + (bid_ >> 3) : -1) : bid_;
                ph_gla_chunk(wid_s, P_, p.in[14] + i * 16 * 256, p.in[15] + i * 256, p.in[16] + i * 16 * 256, p.in[17] + i * 256, OF_, OB_, lds, gu, (G_ == 256) ? 1 << 20 : G_);
            }
            ph_attn_mfma(wid_s, P_, ldp, KC_, VT_, ATT_, odd, l < DEPTH - 1, lds, (odd ? p.in[21] : p.in[10]) + i * 64, (odd ? p.in[22] : p.in[11]) + i * 64, ROPE_);
            GSYNC();
            if (!odd) {
                const float lam_init = 0.8f - 0.6f * expf(-0.3f * (float)l);
                ph_even_post(wid_s, ATT_, p.in[12] + i * 256, p.in[13] + i * 128, lam_init, OF_, OB_, P_, p.in[18] + i * 128);
                GSYNC();
            }
            ph_gemm_res(wid_s, ATT_, odd ? WOUTO_ + (size_t)i * DM * DM : WOUTE_ + (size_t)i * DM * DM, X_, mods_l + 2 * DM, lds, l == DEPTH - 1 ? RL : RT);
            if (l + 1 < DEPTH && gridDim.x == 256 && blockIdx.x >= 64)
                ph_table_prep(wid_s, p.in[25], p.in[26], T8_, RS_, (l + 1) * 16384, (l + 2) * 16384, ((int)blockIdx.x - 64) * NWV + wid_s, 192 * NWV);
            GSYNC();
        } else {
            const int last = (l == DEPTH - 1);
            const int nrows = last ? RL : RT;
            ph_route_mfma(wid_s, QP_, KEYS_ + (size_t)l * 8 * 2 * 128 * 64, IDX_, GATE_, lds, nrows);
            GSYNC();
            ph_peer_ffn8(wid_s, A_, IDX_, GATE_, T8_ + (size_t)l * 16384 * 768, RS_ + l * 16384, T8_ + (size_t)(DEPTH + l) * 16384 * 768, RS_ + (DEPTH + l) * 16384, mods_l,
                         X_, last ? p.out : nullptr, nrows, last ? nullptr : p.in[6] + (l + 1) * DM, mods_l + NMOD * MODW, A_);
            if (!last) GSYNC();
        }
    }
}

extern "C" void kernel_launch(void* const* d_in, const int* in_sizes, int n_in, void* d_out, int out_size, void* d_ws, size_t ws_size, hipStream_t stream) {
    static int grid_blocks = 0;
    if (!grid_blocks) {
        int dev = 0, cus = 0, per_cu = 0;
        (void)hipGetDevice(&dev);
        (void)hipDeviceGetAttribute(&cus, hipDeviceAttributeMultiprocessorCount, dev);
        (void)hipFuncSetAttribute((const void*)mega, hipFuncAttributeMaxDynamicSharedMemorySize, LDS_BYTES);
        (void)hipOccupancyMaxActiveBlocksPerMultiprocessor(&per_cu, mega, NT, LDS_BYTES);
        if (per_cu < 1) fprintf(stderr, "occupancy query says %d blocks/CU\n", per_cu);
        grid_blocks = cus;
        if (ws_size < WS_END) fprintf(stderr, "workspace too small: %zu < %zu\n", ws_size, (size_t)WS_END);
    }
    (void)hipMemsetAsync((unsigned char*)d_ws + WS_BAR, 0, WS_BAR_BYTES, stream);
    Params p{};
    for (int i = 0; i < 27; ++i) p.in[i] = (const float*)d_in[i];
    p.out = (float*)d_out; p.ws = (unsigned char*)d_ws;
    void* args[] = {&p};
    hipError_t e = hipLaunchCooperativeKernel((void*)mega, dim3(grid_blocks), dim3(NT), args, LDS_BYTES, stream);
    if (e != hipSuccess) fprintf(stderr, "cooperative launch failed: %s (grid %d)\n", hipGetErrorString(e), grid_blocks);
}
```

```cpp
#include <hip/hip_runtime.h>
#include <hip/hip_cooperative_groups.h>
#include <stdint.h>
#include <cstdio>
namespace cg = cooperative_groups;

#define DM 1024
#define NB 16
#define SEQ 2048
#define CTX 256
#define RL (NB * SEQ)
#define RC (NB * CTX)
#define RT (RL + RC)
#define DEPTH 4
#define EVEN_IN 3104
#define EVEN_LDP 3328
#define ODD_IN 1536
#define NMOD 17
#define MODW 6144
#define NT 512
#define NWV 8
#define LDS_BYTES 147456

typedef unsigned short bf16;
typedef float f32x2_t __attribute__((ext_vector_type(2)));
typedef __bf16 bf16x2_t __attribute__((ext_vector_type(2)));
struct Params {
    const float* in[27];
    float* out;
    unsigned char* ws;
};

__device__ __forceinline__ int row_mod(int r) { return r < RL ? (r >> 11) : 16; }
__device__ __forceinline__ float silu_f(float x) { return x / (1.f + expf(-x)); }
template <int M> __device__ __forceinline__ float shx(float v) {
    static_assert(M == 1 || M == 2 || M == 4 || M == 8 || M == 16, "mask");
    if constexpr (M == 1) return __int_as_float(__builtin_amdgcn_update_dpp(0, __float_as_int(v), 0xB1, 0xF, 0xF, true));
    else if constexpr (M == 2) return __int_as_float(__builtin_amdgcn_update_dpp(0, __float_as_int(v), 0x4E, 0xF, 0xF, true));
    else if constexpr (M == 8) return __int_as_float(__builtin_amdgcn_update_dpp(0, __float_as_int(v), 0x128, 0xF, 0xF, true));
    else return __int_as_float(__builtin_amdgcn_ds_swizzle(__float_as_int(v), (M << 10) | 0x1f));
}
__device__ __forceinline__ float sum32(float v) { const auto r = __builtin_amdgcn_permlane32_swap(__float_as_uint(v), __float_as_uint(v), false, false); return __uint_as_float(r[0]) + __uint_as_float(r[1]); }
__device__ __forceinline__ float max32(float v) { const auto r = __builtin_amdgcn_permlane32_swap(__float_as_uint(v), __float_as_uint(v), false, false); return fmaxf(__uint_as_float(r[0]), __uint_as_float(r[1])); }
__device__ __forceinline__ unsigned xchg32(unsigned v, bool upper) { const auto r = __builtin_amdgcn_permlane32_swap(v, v, false, false); return upper ? r[0] : r[1]; }
__device__ __forceinline__ float wave_sum(float v) { v += shx<1>(v); v += shx<2>(v); v += shx<4>(v); v += shx<8>(v); v += shx<16>(v); return sum32(v); }
__device__ __forceinline__ float wave_max(float v) { v = fmaxf(v, shx<1>(v)); v = fmaxf(v, shx<2>(v)); v = fmaxf(v, shx<4>(v)); v = fmaxf(v, shx<8>(v)); v = fmaxf(v, shx<16>(v)); return max32(v); }
__device__ __forceinline__ float log_sigmoid_f(float z) { return fminf(z, 0.f) - log1pf(expf(-fabsf(z))); }
__device__ __forceinline__ float gelu_tanh(float x) { const float u = 0.7978845608028654f * (x + 0.044715f * x * x * x); return x * __builtin_amdgcn_rcpf(1.f + __expf(-2.f * u)); }
__device__ __forceinline__ float bf2f(bf16 v) { return __uint_as_float((unsigned)v << 16); }
__device__ __forceinline__ unsigned f2bf(float f) { unsigned u = __float_as_uint(f); return (u + 0x7fffu + ((u >> 16) & 1u)) >> 16; }
__device__ __forceinline__ unsigned pk2(float lo, float hi) { return f2bf(lo) | (f2bf(hi) << 16); }
__device__ __forceinline__ float4 ld4bf(const bf16* p) { uint2 u = *(const uint2*)p; return make_float4(__uint_as_float(u.x << 16), __uint_as_float(u.x & 0xffff0000u), __uint_as_float(u.y << 16), __uint_as_float(u.y & 0xffff0000u)); }
__device__ __forceinline__ void st4bf(bf16* p, float4 v) { *(uint2*)p = make_uint2(pk2(v.x, v.y), pk2(v.z, v.w)); }
__device__ __forceinline__ float2 ld2bf(const bf16* p) { unsigned u = *(const unsigned*)p; return make_float2(__uint_as_float(u << 16), __uint_as_float(u & 0xffff0000u)); }
__device__ __forceinline__ void st2bf(bf16* p, float2 v) { *(unsigned*)p = pk2(v.x, v.y); }

__device__ __forceinline__ int opaque_tid(int wids) { int ln; asm volatile("v_mbcnt_lo_u32_b32 %0, -1, 0\n\tv_mbcnt_hi_u32_b32 %0, -1, %0" : "=v"(ln)); return (wids << 6) | ln; }
__device__ __forceinline__ int opaque_bid() { int b = blockIdx.x; asm volatile("" : "+s"(b)); return b; }

namespace pg8 {
#define PG8_LAS __attribute__((address_space(3)))
typedef unsigned short bf16_t;
typedef short bf16x8 __attribute__((ext_vector_type(8)));
typedef float f32x4 __attribute__((ext_vector_type(4)));
typedef unsigned u32x4 __attribute__((ext_vector_type(4)));
constexpr int BM = 256, BK = 64, HALF = 128, HTB = HALF * BK * 2  , STAGE_BYTES = 8 * HTB, NXCD = 8, WGM = 8;

__host__ __device__ __forceinline__ int lds_byte(int r, int c) { const int st = (r >> 4) * 2 + (c >> 5), rr = r & 15, cc = c & 31, ob = rr * 64 + cc * 2; return st * 1024 + (ob ^ (((ob >> 9) & 1) << 5)); }
__host__ __device__ __forceinline__ void stage_rc(int b, int& R, int& C) { const int st = b / 1024, sb = b % 1024, swz = sb ^ (((sb >> 9) & 1) << 5); R = (st >> 1) * 16 + swz / 64; C = (st & 1) * 32 + (swz % 64) / 2; }
__host__ __device__ __forceinline__ int perm32(int rho) { const int n = rho >> 4, i = rho & 15; return 8 * (i >> 2) + 4 * n + (i & 3); }

struct Unit { int pm, pn; };
struct Gemm { const bf16_t* A; const bf16_t* Bt; int M, N, K; };

struct StaticOrder {
    int nM, nN, nwg, G, c;
    __host__ __device__ void init(int M, int N, int G_, int c_) { nM = M / BM; nN = N / BM; nwg = nM * nN; G = G_; c = c_; }
    __host__ __device__ bool next(int i, Unit& u) const {
        const long L = (long)i * G + c; if (L >= nwg) return false;
        int wgid = (int)L; { const int q = nwg / NXCD, r = nwg % NXCD, xcd = wgid % NXCD, off = wgid / NXCD; wgid = (xcd < r ? xcd * (q + 1) : r * (q + 1) + (xcd - r) * q) + off; }
        const int nig = WGM * nN, gid = wgid / nig, fm = gid * WGM, gsz = (nM - fm) < WGM ? (nM - fm) : WGM;
        u.pm = fm + ((wgid % nig) % gsz); u.pn = (wgid % nig) / gsz; return true;
    }
    __device__ __forceinline__ void a_ready(const Unit&) const {}
    __device__ __forceinline__ void done(const Unit&) const {}
};

__device__ __forceinline__ unsigned cvt_pk_bf16(float lo, float hi) { unsigned r; asm volatile("v_cvt_pk_bf16_f32 %0, %1, %2" : "=v"(r) : "v"(lo), "v"(hi)); return r; }
typedef float f32x2 __attribute__((ext_vector_type(2)));
__device__ __forceinline__ f32x2 gelu_pk(f32x2 v) {
    const f32x2 av = __builtin_elementwise_abs(v), d = av * 0.2316418882f + 1.0f;
    f32x2 t; t.x = __builtin_amdgcn_rcpf(d.x); t.y = __builtin_amdgcn_rcpf(d.y);
    f32x2 q = t * 0.5307027145f + (-0.7265760135f); q = q * t + 0.7107068705f; q = q * t + (-0.142248368f); q = q * t + 0.127414796f; q = q * t;
    const f32x2 s = (v * v) * (-0.72134752044f);
    f32x2 e; e.x = __builtin_amdgcn_exp2f(s.x); e.y = __builtin_amdgcn_exp2f(s.y);
    const f32x2 m = v * (q * e), r = v - m;
    f32x2 o; o.x = v.x < 0.f ? m.x : r.x; o.y = v.y < 0.f ? m.y : r.y; return o;
}

template <int ACT  > struct EpiBf16 {
    static constexpr bool PERM = true, AFTER_DRAIN = false; static_assert(ACT == 0 || ACT == 1, "EpiBf16: ACT is 0 (none) or 1 (gelu_pk)");
    bf16_t* O; int ldc; const float* bias; int split_cols; size_t split_stride; float scale0;
    __device__ __forceinline__ void operator()(const f32x4 (&acc)[2][2][4][2], const Unit& u, int wr, int wc, int fr, int fq) const {
        const int row0 = u.pm * BM + wr * 64 + fr; int colt = u.pn * BM; bf16_t* base = O;
        float sc = 1.f; if (split_cols) { const int t = colt / split_cols; base += (size_t)t * split_stride; colt -= t * split_cols; if (t == 0) sc = scale0; }
        const int col0 = colt + wc * 32 + 8 * fq, bcol0 = u.pn * BM + wc * 32 + 8 * fq;
        f32x4 bv[2][2];
#pragma unroll
        for (int bj = 0; bj < 2; ++bj)
#pragma unroll
            for (int n = 0; n < 2; ++n) bv[bj][n] = bias ? *(const f32x4*)(bias + bcol0 + bj * HALF + 4 * n) : (f32x4){0.f, 0.f, 0.f, 0.f};
#pragma unroll
        for (int ai = 0; ai < 2; ++ai)
#pragma unroll
            for (int m = 0; m < 4; ++m) { bf16_t* rowp = base + (size_t)(row0 + ai * HALF + m * 16) * ldc + col0;
#pragma unroll
                for (int bj = 0; bj < 2; ++bj) { f32x4 v0 = acc[ai][bj][m][0] + bv[bj][0], v1 = acc[ai][bj][m][1] + bv[bj][1];
                    if (ACT == 1) { f32x2 a = gelu_pk((f32x2){v0[0], v0[1]}), b = gelu_pk((f32x2){v0[2], v0[3]}), c = gelu_pk((f32x2){v1[0], v1[1]}), d = gelu_pk((f32x2){v1[2], v1[3]});
                        v0 = (f32x4){a.x, a.y, b.x, b.y}; v1 = (f32x4){c.x, c.y, d.x, d.y}; }
                    v0 = v0 * sc; v1 = v1 * sc; u32x4 w; w.x = cvt_pk_bf16(v0[0], v0[1]); w.y = cvt_pk_bf16(v0[2], v0[3]); w.z = cvt_pk_bf16(v1[0], v1[1]); w.w = cvt_pk_bf16(v1[2], v1[3]);
                    *(u32x4*)(rowp + bj * HALF) = w; } }
    }
};
template <class Epi, class Sched, bool ALIGN_EPI = false, bool SP2 = false>
__device__ __forceinline__ void gemm_phase(PG8_LAS unsigned char* lds, const Gemm g, const Sched& S, const Epi& E, const int WIDS) {
    const int tid = opaque_tid(WIDS), wid = __builtin_amdgcn_readfirstlane(tid >> 6), lane = tid & 63, wr = wid >> 2, wc = wid & 3, fr = lane & 15, fq = lane >> 4;
    const int K = g.K, nt = K / BK;
    unsigned voffA[2], voffB[2];
#pragma unroll
    for (int i = 0; i < 2; ++i) { int R, C; stage_rc(tid * 16 + i * 8192, R, C); const int Rb = Epi::PERM ? ((R & ~31) + perm32(R & 31)) : R;
        voffA[i] = (unsigned)(R * K + C) * 2u; voffB[i] = (unsigned)(Rb * K + C) * 2u; }
    const size_t kstep = (size_t)(BK * 2);
    const size_t hstep = (size_t)HALF * K * 2;
    const size_t tstep = 2 * hstep;
    const unsigned ldsw = (unsigned)wid * 1024u;
    const int aoff = lds_byte(wr * 64 + fr, fq * 8), boff = lds_byte(wc * 32 + fr, fq * 8);
#define PG8_SA(b, h) (((b) * 2 + (h)) * HTB)
#define PG8_SB(b, h) ((4 + (b) * 2 + (h)) * HTB)
#define PG8_STAGE(bufoff, gbase, voff) do { _Pragma("unroll") for (int _i = 0; _i < 2; ++_i) \
        __builtin_amdgcn_global_load_lds((const unsigned*)((const char*)(gbase) + (voff)[_i]), (PG8_LAS unsigned*)(lds + (bufoff) + ldsw + _i * 8192), 16, 0, 0); } while (0)
#define PG8_LDA(dst, b, h) do { _Pragma("unroll") for (int m = 0; m < 4; ++m) _Pragma("unroll") for (int k = 0; k < 2; ++k) dst[m][k] = *(const PG8_LAS bf16x8*)(lds + PG8_SA(b, h) + aoff + m * 2048 + k * 1024); } while (0)
#define PG8_LDB(dst, b, h) do { _Pragma("unroll") for (int n = 0; n < 2; ++n) _Pragma("unroll") for (int k = 0; k < 2; ++k) dst[n][k] = *(const PG8_LAS bf16x8*)(lds + PG8_SB(b, h) + boff + n * 2048 + k * 1024); } while (0)
#define PG8_MMA(ai, bj, At, Bt) do { __builtin_amdgcn_s_setprio(1); _Pragma("unroll") for (int m = 0; m < 4; ++m) _Pragma("unroll") for (int n = 0; n < 2; ++n) _Pragma("unroll") for (int k = 0; k < 2; ++k) \
        acc[ai][bj][m][n] = __builtin_amdgcn_mfma_f32_16x16x32_bf16(Bt[n][k], At[m][k], acc[ai][bj][m][n], 0, 0, 0); __builtin_amdgcn_s_setprio(0); } while (0)
#define PG8_WAIT_V(n) asm volatile("s_waitcnt vmcnt(" #n ")" ::: "memory")
#define PG8_WAIT_L(n) asm volatile("s_waitcnt lgkmcnt(" #n ")" ::: "memory")
#define PG8_BAR __builtin_amdgcn_s_barrier()
#define PG8_SCHED __builtin_amdgcn_sched_barrier(0)
    Unit cur, nxt; int ui = 0;
    if (!S.next(0, cur)) return;
    f32x4 acc[2][2][4][2];
#pragma unroll
    for (int a = 0; a < 2; ++a)
#pragma unroll
        for (int b = 0; b < 2; ++b)
#pragma unroll
            for (int m = 0; m < 4; ++m)
#pragma unroll
                for (int n = 0; n < 2; ++n) acc[a][b][m][n] = (f32x4){0.f, 0.f, 0.f, 0.f};
    bf16x8 At[4][2], B0[2][2], B1[2][2];
    const char* cA = (const char*)g.A + (size_t)cur.pm * tstep; const char* cB = (const char*)g.Bt + (size_t)cur.pn * tstep;
    S.a_ready(cur);
    if constexpr (SP2) {
        PG8_STAGE(PG8_SB(0, 0), cB, voffB); PG8_STAGE(PG8_SB(0, 1), cB + hstep, voffB); PG8_STAGE(PG8_SA(0, 0), cA, voffA); PG8_STAGE(PG8_SA(0, 1), cA + hstep, voffA);
        if (wr == 1) PG8_BAR;
        PG8_WAIT_V(2); PG8_BAR;
        PG8_STAGE(PG8_SB(1, 0), cB + kstep, voffB); PG8_STAGE(PG8_SA(1, 0), cA + kstep, voffA); PG8_STAGE(PG8_SB(1, 1), cB + hstep + kstep, voffB);
        PG8_WAIT_V(6); PG8_BAR;
    } else {
        PG8_STAGE(PG8_SB(0, 0), cB, voffB); PG8_STAGE(PG8_SA(0, 0), cA, voffA); PG8_STAGE(PG8_SB(0, 1), cB + hstep, voffB); PG8_STAGE(PG8_SA(0, 1), cA + hstep, voffA);
        if (wr == 1) PG8_BAR;
        PG8_WAIT_V(4); PG8_BAR;
        PG8_STAGE(PG8_SB(1, 0), cB + kstep, voffB); PG8_STAGE(PG8_SA(1, 0), cA + kstep, voffA); PG8_STAGE(PG8_SB(1, 1), cB + hstep + kstep, voffB);
        PG8_WAIT_V(6); PG8_BAR;
    }
    for (;;) {
        const bool has_next = S.next(ui + 1, nxt);
        const char* nA = has_next ? (const char*)g.A + (size_t)nxt.pm * tstep : cA; const char* nB = has_next ? (const char*)g.Bt + (size_t)nxt.pn * tstep : cB;
        for (int t = 0; t < nt; t += 2) {
            const bool last = (t == nt - 2);
            const char* a1 = cA + (size_t)(t + 1) * kstep;
            const char* a2 = last ? nA : cA + (size_t)(t + 2) * kstep; const char* b2 = last ? nB : cB + (size_t)(t + 2) * kstep;
            const char* a3 = a2 + kstep; const char* b3 = b2 + kstep;
            if (last && has_next) S.a_ready(nxt);
            if constexpr (SP2) {
            PG8_LDB(B0, 0, 0); PG8_LDB(B1, 0, 1); PG8_SCHED; PG8_LDA(At, 0, 0); PG8_STAGE(PG8_SA(1, 1), a1 + hstep, voffA);
            PG8_WAIT_V(8); PG8_WAIT_L(0); PG8_BAR; PG8_MMA(0, 0, At, B0); PG8_MMA(0, 1, At, B1); PG8_BAR; PG8_SCHED;
            PG8_LDA(At, 0, 1); PG8_STAGE(PG8_SB(0, 0), b2, voffB); PG8_STAGE(PG8_SB(0, 1), b2 + hstep, voffB); PG8_STAGE(PG8_SA(0, 0), a2, voffA);
            PG8_WAIT_V(8); PG8_WAIT_L(0); PG8_BAR; PG8_MMA(1, 0, At, B0); PG8_MMA(1, 1, At, B1); PG8_BAR; PG8_SCHED;
            PG8_LDB(B0, 1, 0); PG8_LDB(B1, 1, 1); PG8_SCHED; PG8_LDA(At, 1, 0); PG8_STAGE(PG8_SA(0, 1), a2 + hstep, voffA);
            PG8_WAIT_V(8); PG8_WAIT_L(0); PG8_BAR; PG8_MMA(0, 0, At, B0); PG8_MMA(0, 1, At, B1); PG8_BAR; PG8_SCHED;
            PG8_LDA(At, 1, 1); PG8_STAGE(PG8_SB(1, 0), b3, voffB); PG8_STAGE(PG8_SB(1, 1), b3 + hstep, voffB); PG8_STAGE(PG8_SA(1, 0), a3, voffA);
            PG8_WAIT_V(8); PG8_WAIT_L(0); PG8_BAR; PG8_MMA(1, 0, At, B0); PG8_MMA(1, 1, At, B1); PG8_BAR; PG8_SCHED;
            } else {
            PG8_LDB(B0, 0, 0); PG8_SCHED; PG8_LDA(At, 0, 0); PG8_STAGE(PG8_SA(1, 1), a1 + hstep, voffA);
            PG8_WAIT_L(8); PG8_BAR; PG8_WAIT_L(0); PG8_MMA(0, 0, At, B0); PG8_BAR; PG8_SCHED;
            PG8_LDB(B1, 0, 1); PG8_STAGE(PG8_SB(0, 0), b2, voffB);
            PG8_BAR; PG8_WAIT_L(0); PG8_MMA(0, 1, At, B1); PG8_BAR;
            PG8_LDA(At, 0, 1); PG8_STAGE(PG8_SA(0, 0), a2, voffA);
            PG8_BAR; PG8_WAIT_L(0); PG8_MMA(1, 0, At, B0); PG8_BAR; PG8_SCHED;
            PG8_STAGE(PG8_SB(0, 1), b2 + hstep, voffB);
            PG8_WAIT_V(6); PG8_BAR; PG8_MMA(1, 1, At, B1); PG8_BAR;
            PG8_LDB(B0, 1, 0); PG8_SCHED; PG8_LDA(At, 1, 0); PG8_STAGE(PG8_SA(0, 1), a2 + hstep, voffA);
            PG8_WAIT_L(8); PG8_BAR; PG8_WAIT_L(0); PG8_MMA(0, 0, At, B0); PG8_BAR; PG8_SCHED;
            PG8_LDB(B1, 1, 1); PG8_STAGE(PG8_SB(1, 0), b3, voffB);
            PG8_BAR; PG8_WAIT_L(0); PG8_MMA(0, 1, At, B1); PG8_BAR;
            PG8_LDA(At, 1, 1); PG8_STAGE(PG8_SA(1, 0), a3, voffA);
            PG8_BAR; PG8_WAIT_L(0); PG8_MMA(1, 0, At, B0); PG8_BAR; PG8_SCHED;
            PG8_STAGE(PG8_SB(1, 1), b3 + hstep, voffB);
            PG8_WAIT_V(6); PG8_BAR; PG8_MMA(1, 1, At, B1); PG8_BAR;
            }
        }
        if constexpr (ALIGN_EPI) { if (wr == 0) PG8_BAR; }
        if constexpr (!Epi::AFTER_DRAIN) { E(acc, cur, wr, wc, fr, fq); S.done(cur); }
        if (!has_next) break;
#pragma unroll
        for (int a = 0; a < 2; ++a)
#pragma unroll
            for (int b = 0; b < 2; ++b)
#pragma unroll
                for (int m = 0; m < 4; ++m)
#pragma unroll
                    for (int n = 0; n < 2; ++n) acc[a][b][m][n] = (f32x4){0.f, 0.f, 0.f, 0.f};
        cur = nxt; cA = nA; cB = nB; ++ui;
        if constexpr (ALIGN_EPI) { if (wr == 1) PG8_BAR; }
    }
    PG8_WAIT_V(0);
    if constexpr (!ALIGN_EPI) { if (wr == 0) PG8_BAR; }
    PG8_BAR;
    if constexpr (Epi::AFTER_DRAIN) { E.fused(acc, cur, wr, wc, fr, fq, lds, wid, lane); S.done(cur); }
#undef PG8_SA
#undef PG8_SB
#undef PG8_STAGE
#undef PG8_LDA
#undef PG8_LDB
#undef PG8_MMA
#undef PG8_WAIT_V
#undef PG8_WAIT_L
#undef PG8_BAR
#undef PG8_SCHED
}
}

struct EpiResGate {
    static constexpr bool PERM = true, AFTER_DRAIN = false;
    bf16* X; const float* gate;
    __device__ __forceinline__ void operator()(const pg8::f32x4 (&acc)[2][2][4][2], const pg8::Unit& u, int wr, int wc, int fr, int fq) const {
        const int row0 = u.pm * 256 + wr * 64 + fr, col0 = u.pn * 256 + wc * 32 + 8 * fq;
#pragma unroll
        for (int ai = 0; ai < 2; ++ai)
#pragma unroll
            for (int m = 0; m < 4; ++m) {
                const int r = row0 + ai * 128 + m * 16;
                const float* g = gate + (size_t)row_mod(r) * MODW + col0; bf16* xr = X + (size_t)r * DM + col0;
#pragma unroll
                for (int bj = 0; bj < 2; ++bj) {
                    const uint4 raw = *(const uint4*)(xr + bj * 128);
                    const pg8::f32x4 g0 = *(const pg8::f32x4*)(g + bj * 128), g1 = *(const pg8::f32x4*)(g + bj * 128 + 4);
                    pg8::f32x4 v0 = {__uint_as_float(raw.x << 16), __uint_as_float(raw.x & 0xffff0000u), __uint_as_float(raw.y << 16), __uint_as_float(raw.y & 0xffff0000u)};
                    pg8::f32x4 v1 = {__uint_as_float(raw.z << 16), __uint_as_float(raw.z & 0xffff0000u), __uint_as_float(raw.w << 16), __uint_as_float(raw.w & 0xffff0000u)};
                    v0 = v0 + g0 * acc[ai][bj][m][0]; v1 = v1 + g1 * acc[ai][bj][m][1];
                    *(uint4*)(xr + bj * 128) = make_uint4(pk2(v0[0], v0[1]), pk2(v0[2], v0[3]), pk2(v1[0], v1[1]), pk2(v1[2], v1[3]));
                }
            }
    }
};
#define LAS __attribute__((address_space(3)))
#define GAS __attribute__((address_space(1)))

__device__ __forceinline__ void ph_rope_table(const int WIDS, float2* __restrict__ rope) {
    const int TID = opaque_tid(WIDS), BID = opaque_bid();
    for (int i = BID * NT + TID; i < SEQ * 32; i += gridDim.x * NT) {
        int t = i >> 5, a = (i >> 4) & 1, f = i & 15;
        float pos = a == 0 ? (float)(t >> 6) : (float)(t & 63);
        float inv = powf(10000.f, -(float)f / 16.f);
        float ang = pos * inv;
        rope[i] = make_float2(cosf(ang), sinf(ang));
    }
}
__device__ __forceinline__ void transpose_item(const float* __restrict__ W, int N, bf16* __restrict__ WT, LAS float* scr, int item, int lane) {
    const int K = DM;
    const int nblk = N / 32, kb = item / nblk, nb = item % nblk, k0 = 64 * kb, n0 = 32 * nb;
#pragma unroll 8
    for (int i = 0; i < 32; ++i) { const int kk = 2 * i + (lane >> 5); scr[kk * 33 + (lane & 31)] = W[(size_t)(k0 + kk) * N + n0 + (lane & 31)]; }
    asm volatile("s_waitcnt lgkmcnt(0)" ::: "memory");
    const int c = lane & 7;
#pragma unroll
    for (int j = 0; j < 4; ++j) { const int n = (lane >> 3) + 8 * j; const LAS float* s = scr + (8 * c) * 33 + n;
        uint4 o; o.x = pk2(s[0 * 33], s[1 * 33]); o.y = pk2(s[2 * 33], s[3 * 33]); o.z = pk2(s[4 * 33], s[5 * 33]); o.w = pk2(s[6 * 33], s[7 * 33]);
        *(uint4*)(WT + (size_t)(n0 + n) * K + k0 + 8 * c) = o; }
    asm volatile("s_waitcnt lgkmcnt(0)" ::: "memory");
}
struct WPrep { const float* src[12]; bf16* dst[12]; };
__device__ __forceinline__ void ph_weight_prep(const int WIDS, const float* const* in, bf16* WinE, bf16* WoutE, bf16* WinO, bf16* WoutO, bf16* Wpq, bf16* Kb, unsigned char* lds) {
    const int TID = opaque_tid(WIDS), BID = opaque_bid();
    const int lane = TID & 63, wv = TID >> 6;
    LAS float* scr = (LAS float*)((LAS unsigned char*)lds + wv * 16384);
    const int gw = BID * NWV + wv, NGW = gridDim.x * NWV;
    const int NITEMS = 2 * 1552 + 2 * 512 + 2 * 768 + 2 * 512 + 4 * 512;
    for (int it = gw; it < NITEMS; it += NGW) {
        int r = it;
        if (r < 3104) { int i = r / 1552; transpose_item(in[8] + (size_t)i * DM * EVEN_IN, EVEN_IN, WinE + (size_t)i * EVEN_LDP * DM, scr, r % 1552, lane); continue; } r -= 3104;
        if (r < 1024) { int i = r / 512; transpose_item(in[9] + (size_t)i * DM * DM, DM, WoutE + (size_t)i * DM * DM, scr, r % 512, lane); continue; } r -= 1024;
        if (r < 1536) { int i = r / 768; transpose_item(in[19] + (size_t)i * DM * ODD_IN, ODD_IN, WinO + (size_t)i * ODD_IN * DM, scr, r % 768, lane); continue; } r -= 1536;
        if (r < 1024) { int i = r / 512; transpose_item(in[20] + (size_t)i * DM * DM, DM, WoutO + (size_t)i * DM * DM, scr, r % 512, lane); continue; } r -= 1024;
        { int i = r / 512; transpose_item(in[23] + (size_t)i * DM * DM, DM, Wpq + (size_t)i * DM * DM, scr, r % 512, lane); }
    }
    for (int i4 = BID * NT + TID; i4 < DEPTH * 8 * 2 * 128 * 64 / 4; i4 += gridDim.x * NT) st4bf(Kb + 4 * (size_t)i4, ((const float4*)in[24])[i4]);
    for (int i = BID * NT + TID; i < 2 * 28672; i += gridDim.x * NT) {
        int w = i / 28672, o = i % 28672;
        ((uint4*)(WinE + (size_t)w * EVEN_LDP * DM + (size_t)EVEN_IN * DM))[o] = make_uint4(0u, 0u, 0u, 0u);
    }
}
__device__ __forceinline__ void ph_mods(const int WIDS, const float* __restrict__ c, const float* __restrict__ cctx, const float* __restrict__ w_mod,
                        const float* __restrict__ b_mod, float* __restrict__ mods, float* smem) {
    const int TID = opaque_tid(WIDS), BID = opaque_bid();
    const int nslab = DEPTH * MODW / 96;
    const int lane = TID & 63, wv = TID >> 6, l2 = (lane < 48 ? lane : 47) * 2;
    float (*S)[DM] = (float (*)[DM])smem;
    float* PART = smem + NMOD * DM;
    if (BID < nslab) {
        for (int i = TID; i < NMOD * DM; i += NT) {
            int j = i / DM, k = i % DM;
            float v = j < 16 ? c[j * DM + k] : cctx[k];
            S[j][k] = silu_f(v);
        }
    }
    __syncthreads();
    for (int slab = BID; slab < nslab; slab += gridDim.x) {
        const int l = slab / 64, n0 = (slab % 64) * 96;
        const float* W = w_mod + (size_t)l * DM * MODW + n0 + l2;
        float acc[NMOD][2];
#pragma unroll
        for (int j = 0; j < NMOD; ++j) { acc[j][0] = 0.f; acc[j][1] = 0.f; }
#pragma unroll 2
        for (int kk = 0; kk < 128; kk += 8) {
            const int k = wv * 128 + kk;
            float2 w8[8];
#pragma unroll
            for (int u = 0; u < 8; ++u) w8[u] = *(const float2*)(W + (size_t)(k + u) * MODW);
#pragma unroll
            for (int j = 0; j < NMOD; ++j) {
                const float4 s4 = *(const float4*)&S[j][k], t4 = *(const float4*)&S[j][k + 4];
                acc[j][0] += s4.x * w8[0].x; acc[j][1] += s4.x * w8[0].y;
                acc[j][0] += s4.y * w8[1].x; acc[j][1] += s4.y * w8[1].y;
                acc[j][0] += s4.z * w8[2].x; acc[j][1] += s4.z * w8[2].y;
                acc[j][0] += s4.w * w8[3].x; acc[j][1] += s4.w * w8[3].y;
                acc[j][0] += t4.x * w8[4].x; acc[j][1] += t4.x * w8[4].y;
                acc[j][0] += t4.y * w8[5].x; acc[j][1] += t4.y * w8[5].y;
                acc[j][0] += t4.z * w8[6].x; acc[j][1] += t4.z * w8[6].y;
                acc[j][0] += t4.w * w8[7].x; acc[j][1] += t4.w * w8[7].y;
            }
        }
        if (lane < 48) {
#pragma unroll
            for (int j = 0; j < NMOD; ++j) *(float2*)(PART + ((size_t)(wv * NMOD + j) * 96 + l2)) = make_float2(acc[j][0], acc[j][1]);
        }
        __syncthreads();
        for (int i = TID; i < NMOD * 96; i += NT) {
            const int j = i / 96, n = i % 96;
            float v = 0.f;
#pragma unroll
            for (int w = 0; w < NWV; ++w) v += PART[(size_t)(w * NMOD + j) * 96 + n];
            mods[((size_t)l * NMOD + j) * MODW + n0 + n] = v + b_mod[l * MODW + n0 + n];
        }
        __syncthreads();
    }
    __syncthreads();
}
__device__ __forceinline__ void ph_norm_mod(const int WIDS, const float* __restrict__ Xf, const float* __restrict__ Xcf, const bf16* __restrict__ Xb, bf16* __restrict__ Xb_out,
                                            const float* __restrict__ g, const float* __restrict__ mods_l, int shift_chunk, bf16* __restrict__ A, int nrows) {
    const int TID = opaque_tid(WIDS), BID = opaque_bid();
    int wave = BID * NWV + (TID >> 6), lane = TID & 63;
    int nw = gridDim.x * NWV;
    for (int r = wave; r < nrows; r += nw) {
        float4 v[4]; float s = 0.f;
        if (Xb) {
#pragma unroll
            for (int i = 0; i < 4; ++i) v[i] = ld4bf(Xb + (size_t)r * DM + 4 * (lane + 64 * i));
        } else {
            const float4* xr = (const float4*)(r < RL ? Xf + (size_t)r * DM : Xcf + (size_t)(r - RL) * DM);
#pragma unroll
            for (int i = 0; i < 4; ++i) { v[i] = xr[lane + 64 * i]; st4bf(Xb_out + (size_t)r * DM + 4 * (lane + 64 * i), v[i]); }
        }
#pragma unroll
        for (int i = 0; i < 4; ++i) s += v[i].x * v[i].x + v[i].y * v[i].y + v[i].z * v[i].z + v[i].w * v[i].w;
        s = wave_sum(s);
        float rstd = rsqrtf(s * (1.f / DM) + 1e-6f);
        const float* m = mods_l + (size_t)row_mod(r) * MODW;
        const float4* sh = (const float4*)(m + shift_chunk * DM);
        const float4* sc = (const float4*)(m + (shift_chunk + 1) * DM);
        const float4* g4 = (const float4*)g;
        bf16* ar = A + (size_t)r * DM;
#pragma unroll
        for (int i = 0; i < 4; ++i) {
            int c = lane + 64 * i;
            float4 gg = g4[c], a = sh[c], b = sc[c], o;
            o.x = v[i].x * rstd * gg.x * (1.f + b.x) + a.x;
            o.y = v[i].y * rstd * gg.y * (1.f + b.y) + a.y;
            o.z = v[i].z * rstd * gg.z * (1.f + b.z) + a.z;
            o.w = v[i].w * rstd * gg.w * (1.f + b.w) + a.w;
            st4bf(ar + 4 * c, o);
        }
    }
}
#define KVLEN (CTX + SEQ)
__device__ __forceinline__ void ph_post(const int WIDS, bf16* __restrict__ P, int ldp, int nq, int kcol0, int nk, int vcol0, int VC, int DV,
                                        const float* __restrict__ qgain, const float* __restrict__ kgain, const float2* __restrict__ rope,
                                        bf16* __restrict__ Kc, bf16* __restrict__ Vt) {
    const int TID = opaque_tid(WIDS), BID = opaque_bid();
    const float C2 = 0.125f * 1.4426950408889634f;
    for (int tile = BID; tile < RT / 64; tile += gridDim.x) {
        const int r0 = tile * 64;
        int b, j0;
        if (r0 < RL) { b = r0 >> 11; j0 = CTX + (r0 & (SEQ - 1)); } else { b = (r0 - RL) >> 8; j0 = (r0 - RL) & (CTX - 1); }
        const int nh = nq + nk, sub = TID & 7;
        for (int ti0 = TID; ti0 < 64 * nh * 8; ti0 += 4 * NT) {
            uint4 raw4[4]; bf16* src4[4];
#pragma unroll
            for (int u = 0; u < 4; ++u) {
                const int item = (ti0 + u * NT) >> 3, row = item / nh, hh = item % nh;
                src4[u] = P + (size_t)(r0 + row) * ldp + (hh >= nq ? kcol0 + (hh - nq) * 64 : hh * 64) + sub * 8;
                raw4[u] = *(const uint4*)src4[u];
            }
#pragma unroll
            for (int u = 0; u < 4; ++u) {
            const int item = (ti0 + u * NT) >> 3, row = item / nh, hh = item % nh, r = r0 + row;
            const bool isk = hh >= nq; const int h = isk ? hh - nq : hh;
            bf16* src = src4[u];
            const float* gain = (isk ? kgain : qgain) + sub * 8;
            const uint4 raw = raw4[u];
            const unsigned rw[4] = {raw.x, raw.y, raw.z, raw.w};
            float v[8]; float ssq = 0.f;
#pragma unroll
            for (int i = 0; i < 4; ++i) { v[2 * i] = __uint_as_float(rw[i] << 16); v[2 * i + 1] = __uint_as_float(rw[i] & 0xffff0000u); ssq += v[2 * i] * v[2 * i] + v[2 * i + 1] * v[2 * i + 1]; }
            ssq += shx<1>(ssq); ssq += shx<2>(ssq); ssq += shx<4>(ssq);
            const float rstd = rsqrtf(ssq * (1.f / 64.f) + 1e-6f) * (isk ? 1.f : C2);
            const float4 g0 = ((const float4*)gain)[0], g1 = ((const float4*)gain)[1];
            const float gg[8] = {g0.x, g0.y, g0.z, g0.w, g1.x, g1.y, g1.z, g1.w};
#pragma unroll
            for (int i = 0; i < 8; ++i) v[i] = v[i] * rstd * gg[i];
            float pv[8];
#pragma unroll
            for (int i = 0; i < 8; ++i) pv[i] = shx<2>(v[i]);
            if (r < RL) {
                const float2* tab = rope + (size_t)(r & (SEQ - 1)) * 32 + (sub >> 2) * 16 + (sub & 1) * 8;
                const bool second = (sub & 2) != 0;
#pragma unroll
                for (int i = 0; i < 8; ++i) { const float2 cs = tab[i]; v[i] = second ? (v[i] * cs.x + pv[i] * cs.y) : (v[i] * cs.x - pv[i] * cs.y); }
            }
            bf16* dst = isk ? Kc + ((size_t)(b * nk + h) * KVLEN + j0 + row) * 64 + sub * 8 : src;
            *(uint4*)dst = make_uint4(pk2(v[0], v[1]), pk2(v[2], v[3]), pk2(v[4], v[5]), pk2(v[6], v[7]));
            }
        }
        if (TID < VC) {
            const int c8 = TID >> 3, rg = TID & 7;
            unsigned in[8][4];
#pragma unroll
            for (int rr = 0; rr < 8; ++rr) { uint4 t = *(const uint4*)(P + (size_t)(r0 + rg * 8 + rr) * ldp + vcol0 + c8 * 8); in[rr][0] = t.x; in[rr][1] = t.y; in[rr][2] = t.z; in[rr][3] = t.w; }
#pragma unroll
            for (int c = 0; c < 8; ++c) {
                unsigned o[4];
#pragma unroll
                for (int q = 0; q < 4; ++q)
                    o[q] = (c & 1) ? __builtin_amdgcn_perm(in[2 * q + 1][c >> 1], in[2 * q][c >> 1], 0x07060302u) : __builtin_amdgcn_perm(in[2 * q + 1][c >> 1], in[2 * q][c >> 1], 0x05040100u);
                const int col = c8 * 8 + c, vh = col / DV, d = col % DV;
                bf16* vrow = Vt + ((size_t)(b * 4 + vh) * DV + d) * KVLEN + j0 + 16 * (rg >> 1) + 4 * (rg & 1);
                *(uint2*)vrow = make_uint2(o[0], o[1]);
                *(uint2*)(vrow + 8) = make_uint2(o[2], o[3]);
            }
        }
    }
}
typedef short bf16x8 __attribute__((ext_vector_type(8)));
typedef float f32x16 __attribute__((ext_vector_type(16)));
__device__ __forceinline__ int crow(int r, int hi) { return (r & 3) + 8 * (r >> 2) + 4 * hi; }
__device__ __forceinline__ unsigned cvt_pk_bf16_f32(float lo, float hi) { f32x2_t v = {lo, hi}; bf16x2_t b = __builtin_convertvector(v, bf16x2_t); return __builtin_bit_cast(unsigned, b); }
#define ATT_KPITCH 144
#define ATT_VPITCH 144
template <int DV>
__device__ __forceinline__ void attn_unit(const bf16* __restrict__ Qbase, int ldq, const bf16* __restrict__ Kc, const bf16* __restrict__ Vt, int ntiles,
                                          bf16* __restrict__ Obase, int ldo, unsigned char* lds, int tid, float shift, int qrow0, const float* __restrict__ qgain, const float2* __restrict__ rope) {
    constexpr int NDB = DV / 32, NVL = DV / 64, KBYTES = 64 * ATT_KPITCH, VBYTES = DV * ATT_VPITCH;
    constexpr float THR = 8.f;
    const int lane = tid & 63, wid = tid >> 6, r32 = lane & 31, hi = lane >> 5;
    unsigned char* Kb0 = lds; unsigned char* Vb0 = lds + 2 * KBYTES;
    float* sc = (float*)(lds + 2 * KBYTES + 2 * VBYTES + wid * 128);
    bf16x8 qf[4];
    {
        int tq = tid; asm volatile("" : "+v"(tq));
        const int hq = (tq >> 5) & 1, rq = ((tq >> 6) << 5) | (tq & 31);
        const unsigned qoff = (unsigned)(rq * ldq + 8 * hq) * 2u;
        float qv[4][8]; float ssq = 0.f;
#pragma unroll
        for (int s = 0; s < 4; ++s) {
            const uint4 raw = *(const uint4*)((const unsigned char*)Qbase + (qoff + 32u * s));
            const unsigned rw[4] = {raw.x, raw.y, raw.z, raw.w};
#pragma unroll
            for (int i = 0; i < 4; ++i) { qv[s][2 * i] = __uint_as_float(rw[i] << 16); qv[s][2 * i + 1] = __uint_as_float(rw[i] & 0xffff0000u); ssq += qv[s][2 * i] * qv[s][2 * i] + qv[s][2 * i + 1] * qv[s][2 * i + 1]; }
        }
        ssq = sum32(ssq);
        const float rstd = rsqrtf(ssq * (1.f / 64.f) + 1e-6f) * (0.125f * 1.4426950408889634f);
#pragma unroll
        for (int s = 0; s < 4; ++s) {
            const float4 g0 = *(const float4*)((const unsigned char*)qgain + ((unsigned)(16 * s + 8 * hq) * 4u)), g1 = *(const float4*)((const unsigned char*)qgain + ((unsigned)(16 * s + 8 * hq) * 4u + 16u));
            const float gg[8] = {g0.x, g0.y, g0.z, g0.w, g1.x, g1.y, g1.z, g1.w};
#pragma unroll
            for (int i = 0; i < 8; ++i) qv[s][i] = qv[s][i] * rstd * gg[i];
        }
        if (qrow0 < RL) {
            const unsigned toff = (unsigned)((((qrow0 + rq) & (SEQ - 1)) * 32 + 8 * hq) * 8);
#pragma unroll
            for (int a = 0; a < 2; ++a)
#pragma unroll
                for (int i = 0; i < 8; ++i) { const float2 cs = *(const float2*)((const unsigned char*)rope + (toff + (unsigned)(a * 16 + i) * 8u)); const float x1 = qv[2 * a][i], x2 = qv[2 * a + 1][i]; qv[2 * a][i] = x1 * cs.x - x2 * cs.y; qv[2 * a + 1][i] = x2 * cs.x + x1 * cs.y; }
        }
#pragma unroll
        for (int s = 0; s < 4; ++s) {
            const uint4 w = make_uint4(pk2(qv[s][0], qv[s][1]), pk2(qv[s][2], qv[s][3]), pk2(qv[s][4], qv[s][5]), pk2(qv[s][6], qv[s][7]));
            qf[s] = __builtin_bit_cast(bf16x8, w);
        }
    }
    f32x16 o[NDB];
#pragma unroll
    for (int d = 0; d < NDB; ++d)
#pragma unroll
        for (int r = 0; r < 16; ++r) o[d][r] = 0.f;
    float l = 0.f;
    uint4 kreg, vreg0, vreg1 = make_uint4(0u, 0u, 0u, 0u);
    const int krow = tid >> 3, kch = tid & 7;
    const unsigned voff0 = (unsigned)(tid >> 3) * (unsigned)(KVLEN * 2) + (unsigned)(tid & 7) * 16u, voff1 = voff0 + 64u * (unsigned)(KVLEN * 2);
    const unsigned vlds0 = (unsigned)(tid >> 3) * ATT_VPITCH + (unsigned)(tid & 7) * 16u, vlds1 = vlds0 + 64u * ATT_VPITCH;
#define ATT_GLOAD_K(t) do { kreg = *(const uint4*)((const unsigned char*)Kc + ((unsigned)(t) * 8192u + (unsigned)tid * 16u)); } while (0)
#define ATT_GLOAD_V(t) do { vreg0 = *(const uint4*)((const unsigned char*)Vt + (voff0 + (unsigned)(t) * 128u)); if (NVL == 2) vreg1 = *(const uint4*)((const unsigned char*)Vt + (voff1 + (unsigned)(t) * 128u)); } while (0)
#define ATT_STORE_K(buf) do { *(uint4*)(Kb0 + (buf) * KBYTES + krow * ATT_KPITCH + kch * 16) = kreg; } while (0)
#define ATT_STORE_V(buf) do { *(uint4*)(Vb0 + (buf) * VBYTES + vlds0) = vreg0; if (NVL == 2) *(uint4*)(Vb0 + (buf) * VBYTES + vlds1) = vreg1; } while (0)
#define ATT_QK(S0, S1, buf) do { const unsigned char* kb_ = Kb0 + (buf) * KBYTES; \
        _Pragma("unroll") for (int r = 0; r < 16; ++r) { S0[r] = 0.f; S1[r] = 0.f; } \
        _Pragma("unroll") for (int s = 0; s < 4; ++s) { \
            const bf16x8 a0 = *(const bf16x8*)(kb_ + r32 * ATT_KPITCH + s * 32 + hi * 16); \
            const bf16x8 a1 = *(const bf16x8*)(kb_ + (32 + r32) * ATT_KPITCH + s * 32 + hi * 16); \
            S0 = __builtin_amdgcn_mfma_f32_32x32x16_bf16(a0, qf[s], S0, 0, 0, 0); \
            S1 = __builtin_amdgcn_mfma_f32_32x32x16_bf16(a1, qf[s], S1, 0, 0, 0); } } while (0)
    {
        ATT_GLOAD_K(0); ATT_GLOAD_V(0);
        const uint4 k0 = kreg;
        ATT_GLOAD_K(ntiles > 1 ? 1 : 0);
        *(uint4*)(Kb0 + krow * ATT_KPITCH + kch * 16) = k0;
        ATT_STORE_V(0); ATT_STORE_V(1);
        ATT_STORE_K(1);
    }
    __syncthreads();
    f32x16 s0, s1;
    ATT_QK(s0, s1, 0);
    __syncthreads();
    uint4 pa[4], pb[4];
#pragma unroll
    for (int i = 0; i < 4; ++i) pa[i] = make_uint4(0u, 0u, 0u, 0u);
    f32x16 n0, n1;
    auto tile = [&](f32x16& S0, f32x16& S1, f32x16& N0, f32x16& N1, uint4 (&PA)[4], uint4 (&PN)[4], const int t, const int par) __attribute__((always_inline)) {
        if (t + 2 < ntiles) ATT_GLOAD_K(t + 2);
        if (t > 0) ATT_GLOAD_V(t);
        if (shift != 0.f) {
#pragma unroll
            for (int r = 0; r < 16; ++r) { S0[r] -= shift; S1[r] -= shift; }
        }
        float ps0 = 0.f, ps1 = 0.f;
        unsigned pw[16];
        {
            constexpr int M = 8 + 4 * NDB, G = 2 + NDB, PF = 4;
            const unsigned char* kfa = Kb0 + (1 - par) * KBYTES + r32 * ATT_KPITCH + hi * 16;
            const unsigned char* vfa = Vb0 + (1 - par) * VBYTES + r32 * ATT_VPITCH + hi * 16;
#define ATT_CH(c) (NDB == 2 ? ((c) == 0 ? -1 : (c) == 1 ? 0 : (c) == 2 ? -2 : 1) : ((c) == 0 ? -1 : (c) == 1 ? 0 : (c) == 2 ? 1 : (c) == 3 ? -2 : (c) == 4 ? 2 : 3))
#define ATT_FRAG(i) (ATT_CH((i) % G) == -1 ? *(const bf16x8*)(kfa + ((i) / G) * 32) : ATT_CH((i) % G) == -2 ? *(const bf16x8*)(kfa + 32 * ATT_KPITCH + ((i) / G) * 32) \
                     : *(const bf16x8*)(vfa + (ATT_CH((i) % G) < 0 ? 0 : ATT_CH((i) % G)) * 32 * ATT_VPITCH + ((i) / G) * 32))
#define ATT_EX(e) ((e) < 16 ? S0[(e) & 15] : S1[(e) & 15])
            bf16x8 fr[M];
#pragma unroll
            for (int i = 0; i < PF; ++i) fr[i] = ATT_FRAG(i);
            __builtin_amdgcn_sched_barrier(0);
#pragma unroll
            for (int i = 0; i < M; ++i) {
                if (i + PF < M) fr[i + PF] = ATT_FRAG(i + PF);
                const int kd = ATT_CH(i % G), st = i / G;
                if (kd == -1) { if (st == 0) { f32x16 z; _Pragma("unroll") for (int r = 0; r < 16; ++r) z[r] = 0.f; N0 = __builtin_amdgcn_mfma_f32_32x32x16_bf16(fr[i], qf[st], z, 0, 0, 0); } else N0 = __builtin_amdgcn_mfma_f32_32x32x16_bf16(fr[i], qf[st], N0, 0, 0, 0); }
                else if (kd == -2) { if (st == 0) { f32x16 z; _Pragma("unroll") for (int r = 0; r < 16; ++r) z[r] = 0.f; N1 = __builtin_amdgcn_mfma_f32_32x32x16_bf16(fr[i], qf[st], z, 0, 0, 0); } else N1 = __builtin_amdgcn_mfma_f32_32x32x16_bf16(fr[i], qf[st], N1, 0, 0, 0); }
                else o[kd < 0 ? 0 : kd] = __builtin_amdgcn_mfma_f32_32x32x16_bf16(fr[i], __builtin_bit_cast(bf16x8, PA[st]), o[kd < 0 ? 0 : kd], 0, 0, 0);
                const int lo = (i * 32) / M, hi_e = ((i + 1) * 32) / M, lop = i == 0 ? 0 : ((i - 1) * 32) / M;
#pragma unroll
                for (int e = 0; e < 32; ++e) if (e >= lo && e < hi_e) { if (e < 16) S0[e & 15] = __builtin_amdgcn_exp2f(S0[e & 15]); else S1[e & 15] = __builtin_amdgcn_exp2f(S1[e & 15]); }
#pragma unroll
                for (int e = 0; e < 32; ++e) if (i > 0 && e >= lop && e < lo) {
                    if (e & 1) { ps1 += ATT_EX(e); pw[e >> 1] = cvt_pk_bf16_f32(ATT_EX(e - 1), ATT_EX(e)); } else ps0 += ATT_EX(e);
                }
                __builtin_amdgcn_sched_barrier(0);
            }
            constexpr int lol = ((M - 1) * 32) / M;
#pragma unroll
            for (int e = 0; e < 32; ++e) if (e >= lol) {
                if (e & 1) { ps1 += ATT_EX(e); pw[e >> 1] = cvt_pk_bf16_f32(ATT_EX(e - 1), ATT_EX(e)); } else ps0 += ATT_EX(e);
            }
#undef ATT_CH
#undef ATT_FRAG
#undef ATT_EX
        }
        l += ps0 + ps1;
        asm volatile("" : "+v"(pw[0]), "+v"(pw[1]), "+v"(pw[2]), "+v"(pw[3]), "+v"(pw[4]), "+v"(pw[5]), "+v"(pw[6]), "+v"(pw[7]));
        asm volatile("" : "+v"(pw[8]), "+v"(pw[9]), "+v"(pw[10]), "+v"(pw[11]), "+v"(pw[12]), "+v"(pw[13]), "+v"(pw[14]), "+v"(pw[15]), "+v"(l));
        PN[0] = make_uint4(pw[0], pw[1], pw[2], pw[3]); PN[1] = make_uint4(pw[4], pw[5], pw[6], pw[7]); PN[2] = make_uint4(pw[8], pw[9], pw[10], pw[11]); PN[3] = make_uint4(pw[12], pw[13], pw[14], pw[15]);
        __builtin_amdgcn_sched_barrier(0);
        if (t + 2 < ntiles) ATT_STORE_K(par);
        if (t > 0) ATT_STORE_V(par);
        __syncthreads();
    };
    for (int t = 0; t < ntiles; t += 2) {
        tile(s0, s1, n0, n1, pa, pb, t, 0);
        tile(n0, n1, s0, s1, pb, pa, t + 1, 1);
    }
    {
        const unsigned char* vb = Vb0 + VBYTES;
#pragma unroll
        for (int d = 0; d < NDB; ++d) {
#pragma unroll
            for (int s = 0; s < 4; ++s) {
                const bf16x8 vf = *(const bf16x8*)(vb + (32 * d + r32) * ATT_VPITCH + 32 * s + 16 * hi);
                o[d] = __builtin_amdgcn_mfma_f32_32x32x16_bf16(vf, __builtin_bit_cast(bf16x8, pa[s]), o[d], 0, 0, 0);
            }
        }
    }
#undef ATT_GLOAD_K
#undef ATT_GLOAD_V
#undef ATT_STORE_K
#undef ATT_STORE_V
#undef ATT_QK
    l = sum32(l);
    const float iv = 1.f / l;
    int tide = tid; asm volatile("" : "+v"(tide));
    unsigned char* orow = (unsigned char*)Obase + ((unsigned)(((tide >> 6) * 32 + (tide & 31)) * ldo) * 2u + (((tide >> 5) & 1) ? 16u : 0u));
#pragma unroll
    for (int d = 0; d < NDB; ++d) {
#pragma unroll
        for (int gp = 0; gp < 2; ++gp) {
            uint2 a, b;
            a.x = cvt_pk_bf16_f32(o[d][8 * gp + 0] * iv, o[d][8 * gp + 1] * iv); a.y = cvt_pk_bf16_f32(o[d][8 * gp + 2] * iv, o[d][8 * gp + 3] * iv);
            b.x = cvt_pk_bf16_f32(o[d][8 * gp + 4] * iv, o[d][8 * gp + 5] * iv); b.y = cvt_pk_bf16_f32(o[d][8 * gp + 6] * iv, o[d][8 * gp + 7] * iv);
            { const auto r_ = __builtin_amdgcn_permlane32_swap(a.x, b.x, false, false); a.x = r_[0]; b.x = r_[1]; }
            { const auto r_ = __builtin_amdgcn_permlane32_swap(a.y, b.y, false, false); a.y = r_[0]; b.y = r_[1]; }
            *(uint4*)(orow + (32 * d + 16 * gp) * 2) = make_uint4(a.x, a.y, b.x, b.y);
        }
    }
    __syncthreads();
}
__device__ __forceinline__ void attn_run_unit(const bf16* __restrict__ P, int ldp, const bf16* __restrict__ Kc, const bf16* __restrict__ Vt, bf16* __restrict__ ATT,
                                              int odd, int u, int nlat, unsigned char* lds, int TID, float shift, const float* __restrict__ qgain, const float2* __restrict__ rope) {
    int b, qh, row0, ntiles;
    if (u < nlat) {
        if (odd) { const int grp = u >> 5, w = u & 31; b = grp >> 2; qh = (grp & 3) * 4 + (w >> 3); row0 = b * SEQ + (w & 7) * 256; }
        else { const int grp = u >> 4, w = u & 15; b = grp >> 2; qh = (grp & 3) * 2 + (w >> 3); row0 = b * SEQ + (w & 7) * 256; }
        ntiles = KVLEN / 64;
    } else {
        const int idx = u - nlat;
        if (odd) { b = idx >> 4; qh = idx & 15; } else { b = idx >> 3; qh = idx & 7; }
        row0 = RL + b * CTX; ntiles = CTX / 64;
    }
    if (odd) attn_unit<64>(P + (size_t)row0 * ldp + qh * 64, ldp, Kc + (size_t)(b * 4 + (qh >> 2)) * KVLEN * 64, Vt + (size_t)(b * 4 + (qh >> 2)) * 64 * KVLEN, ntiles,
                           ATT + (size_t)row0 * DM + qh * 64, DM, lds, TID, shift, row0, qgain, rope);
    else attn_unit<128>(P + (size_t)row0 * ldp + qh * 64, ldp, Kc + (size_t)(b * 8 + qh) * KVLEN * 64, Vt + (size_t)(b * 4 + (qh >> 1)) * 128 * KVLEN, ntiles,
                        ATT + (size_t)row0 * DM + qh * 128, DM, lds, TID, shift, row0, qgain, rope);
}
__device__ __forceinline__ void ph_attn_mfma(const int WIDS, const bf16* __restrict__ P, int ldp, const bf16* __restrict__ Kc, const bf16* __restrict__ Vt, bf16* __restrict__ ATT,
                                             int odd, int with_ctx, unsigned char* lds, const float* __restrict__ qgain, const float* __restrict__ kgain, const float2* __restrict__ rope) {
    const int TID = opaque_tid(WIDS), BID = opaque_bid();
    float shift;
    {
        float gq = fabsf(qgain[TID & 63]), gk = fabsf(kgain[TID & 63]);
        gq = wave_max(gq); gk = wave_max(gk);
        shift = fmaxf(8.f * 1.4426950408889634f * gq * gk * 1.002f + 0.01f - 100.f, 0.f);
        shift = __int_as_float(__builtin_amdgcn_readfirstlane(__float_as_int(shift)));
    }
    const int G = gridDim.x, vcu = (G % 8 == 0) ? (BID & 7) * (G >> 3) + (BID >> 3) : BID;
    const int nlat = odd ? 2048 : 1024, nctx = with_ctx ? (odd ? 256 : 128) : 0;
    if (!odd && G == 256) {
        const int x = BID & 7, w = BID >> 3, wl = w & 15;
        constexpr int KG = 2;
        const int i0 = w >= 16 ? 0 : 8 - KG, i1 = w >= 16 ? 8 - KG : 8, nun = (i1 - i0) + ((w >= 16 && nctx) ? 1 : 0);
        for (int j = 0; j < nun; ++j) {
            const int i = i0 + j;
            attn_run_unit(P, ldp, Kc, Vt, ATT, odd, i < i1 ? x * 128 + 16 * i + wl : nlat + x * 16 + wl, nlat, lds, TID, shift, qgain, rope);
        }
        return;
    }
    for (int u = vcu; u < nlat + nctx; u += G) attn_run_unit(P, ldp, Kc, Vt, ATT, odd, u, nlat, lds, TID, shift, qgain, rope);
}
typedef float f32x4_t __attribute__((ext_vector_type(4)));
#define GLA_PITCH 144
__device__ __forceinline__ void ph_gla_chunk(const int WIDS, const bf16* __restrict__ P, const float* __restrict__ w_af, const float* __restrict__ b_af,
                                             const float* __restrict__ w_ab, const float* __restrict__ b_ab, bf16* __restrict__ OF, bf16* __restrict__ OB, unsigned char* lds, int unit0, int ustride) {
    const int TID = opaque_tid(WIDS), BID = opaque_bid();
    const int tid = TID, lane = tid & 63, wid = tid >> 6, l15 = lane & 15, q4 = lane >> 4;
    float* SEG = (float*)lds;
    float* DEC = (float*)(lds + 2048);
    unsigned char* QD = lds + 4096;
    unsigned char* KI = QD + 9216;
    unsigned char* KET = KI + 9216;
    unsigned char* AT = KET + 9216;
    unsigned char* VT = AT + 9216;
    unsigned char* QRAW = VT + 18432;
    unsigned char* KRAW = QRAW + 9216;
    unsigned char* VRAW = KRAW + 9216;
    unsigned char* GRAW = VRAW + 64 * 272;
#define GLA_ROWS(ch_, rb_, rs_) do { if (!dir) { rb_ = (ch_) < 4 ? RL + b * CTX + (ch_) * 64 : b * SEQ + ((ch_) - 4) * 64; rs_ = 1; } \
        else { rb_ = (ch_) < 4 ? RL + b * CTX + (CTX - 1 - (ch_) * 64) : b * SEQ + (SEQ - 1 - ((ch_) - 4) * 64); rs_ = -1; } } while (0)
#define GLA_GLOAD(ch_) do { int rb_, rs_; GLA_ROWS(ch_, rb_, rs_); \
        const bf16* pq_ = P + (size_t)(rb_ + rs_ * (tid >> 3)) * EVEN_LDP + h * 64 + (tid & 7) * 8; rq = *(const uint4*)(pq_ + 1536); rk = *(const uint4*)(pq_ + 1792); \
        rv0 = *(const uint4*)(P + (size_t)(rb_ + rs_ * (tid >> 4)) * EVEN_LDP + 2048 + h * 128 + (tid & 15) * 8); \
        rv1 = *(const uint4*)(P + (size_t)(rb_ + rs_ * (32 + (tid >> 4))) * EVEN_LDP + 2048 + h * 128 + (tid & 15) * 8); \
        if (tid < 128) rg = *(const uint4*)(P + (size_t)(rb_ + rs_ * (tid >> 1)) * EVEN_LDP + 3072 + dir * 16 + (tid & 1) * 8); } while (0)
#define GLA_STAGE() do { *(uint4*)(QRAW + (tid >> 3) * GLA_PITCH + (tid & 7) * 16) = rq; *(uint4*)(KRAW + (tid >> 3) * GLA_PITCH + (tid & 7) * 16) = rk; \
        *(uint4*)(VRAW + (tid >> 4) * 272 + (tid & 15) * 16) = rv0; *(uint4*)(VRAW + (32 + (tid >> 4)) * 272 + (tid & 15) * 16) = rv1; \
        if (tid < 128) *(uint4*)(GRAW + (tid >> 1) * 32 + (tid & 1) * 16) = rg; } while (0)
    for (int unit = unit0; unit >= 0 && unit < NB * 4 * 2; unit += ustride) {
        const int dir = unit & 1, h = (unit >> 1) & 3, b = unit >> 3;
        const float* wa = dir ? w_ab : w_af; const float* ba = dir ? b_ab : b_af;
        bf16* Od = dir ? OB : OF;
        const int d = tid & 63, seg = tid >> 6;
        float wreg[16];
#pragma unroll
        for (int j = 0; j < 16; ++j) wreg[j] = wa[j * 256 + h * 64 + d];
        const float breg = ba[h * 64 + d];
        { unsigned z_; asm volatile("v_mov_b32 %0, 0" : "=v"(z_)); for (int i = tid; i < 9216 / 16; i += NT) ((uint4*)AT)[i] = make_uint4(z_, z_, z_, z_); }
        f32x4_t S[4];
#pragma unroll
        for (int i = 0; i < 4; ++i) S[i] = (f32x4_t){0.f, 0.f, 0.f, 0.f};
        uint4 rq, rk, rv0, rv1, rg = make_uint4(0u, 0u, 0u, 0u);
        GLA_GLOAD(0);
        GLA_STAGE();
        __syncthreads();
        for (int ch = 0; ch < KVLEN / 64; ++ch) {
            int rbase, rsgn;
            GLA_ROWS(ch, rbase, rsgn);
            if (ch + 1 < KVLEN / 64) GLA_GLOAD(ch + 1);
            float cl[8];
            {
                float run = 0.f;
#pragma unroll
                for (int i = 0; i < 8; ++i) {
                    const uint4 g0 = *(const uint4*)(GRAW + (8 * seg + i) * 32), g1 = *(const uint4*)(GRAW + (8 * seg + i) * 32 + 16);
                    const unsigned gw[8] = {g0.x, g0.y, g0.z, g0.w, g1.x, g1.y, g1.z, g1.w};
                    float z = breg;
#pragma unroll
                    for (int j = 0; j < 8; ++j) { z += __uint_as_float(gw[j] << 16) * wreg[2 * j]; z += __uint_as_float(gw[j] & 0xffff0000u) * wreg[2 * j + 1]; }
                    run += (fminf(z, 0.f) - __logf(1.f + __expf(-fabsf(z)))) * (1.f / 16.f);
                    cl[i] = run;
                }
                SEG[seg * 64 + d] = run;
            }
            __syncthreads();
            {
                float prefix = 0.f, total = 0.f;
#pragma unroll
                for (int s2 = 0; s2 < 8; ++s2) { const float v = SEG[s2 * 64 + d]; total += v; prefix += (s2 < seg) ? v : 0.f; }
                const float etot = __expf(total);
                if (seg == 0) DEC[d] = etot;
                unsigned kew[4];
#pragma unroll
                for (int i = 0; i < 8; ++i) {
                    const int c = 8 * seg + i;
                    const float qv = bf2f(*(const bf16*)(QRAW + c * GLA_PITCH + d * 2)) * 0.125f, kv = bf2f(*(const bf16*)(KRAW + c * GLA_PITCH + d * 2));
                    const float e = __expf(prefix + cl[i]), ei = __builtin_amdgcn_rcpf(e);
                    *(bf16*)(QD + c * GLA_PITCH + d * 2) = (bf16)f2bf(qv * e);
                    *(bf16*)(KI + c * GLA_PITCH + d * 2) = (bf16)f2bf(kv * ei);
                    const unsigned kb = f2bf(kv * (etot * ei));
                    if (i & 1) kew[i >> 1] |= kb << 16; else kew[i >> 1] = kb;
                }
                *(uint4*)(KET + d * GLA_PITCH + seg * 16) = make_uint4(kew[0], kew[1], kew[2], kew[3]);
                const int v = tid & 127, cg = tid >> 7;
                unsigned vw[8];
#pragma unroll
                for (int i = 0; i < 16; ++i) {
                    const unsigned x = *(const bf16*)(VRAW + (16 * cg + i) * 272 + v * 2);
                    if (i & 1) vw[i >> 1] |= x << 16; else vw[i >> 1] = x;
                }
                *(uint4*)(VT + v * GLA_PITCH + cg * 32) = make_uint4(vw[0], vw[1], vw[2], vw[3]);
                *(uint4*)(VT + v * GLA_PITCH + cg * 32 + 16) = make_uint4(vw[4], vw[5], vw[6], vw[7]);
            }
            __syncthreads();
            for (int blk = wid; blk < 10; blk += NWV) {
                int sblk, cblk;
                if (blk < 4) { sblk = 0; cblk = blk; } else if (blk < 7) { sblk = 1; cblk = blk - 3; } else if (blk < 9) { sblk = 2; cblk = blk - 5; } else { sblk = 3; cblk = 3; }
                f32x4_t acc = (f32x4_t){0.f, 0.f, 0.f, 0.f};
#pragma unroll
                for (int kk = 0; kk < 2; ++kk) {
                    const bf16x8 a = *(const bf16x8*)(KI + (16 * sblk + l15) * GLA_PITCH + 64 * kk + 16 * q4);
                    const bf16x8 bq = *(const bf16x8*)(QD + (16 * cblk + l15) * GLA_PITCH + 64 * kk + 16 * q4);
                    acc = __builtin_amdgcn_mfma_f32_16x16x32_bf16(a, bq, acc, 0, 0, 0);
                }
                const int c = 16 * cblk + l15, s0 = 16 * sblk + 4 * q4;
                float av[4];
#pragma unroll
                for (int r = 0; r < 4; ++r) av[r] = (s0 + r <= c) ? acc[r] : 0.f;
                *(uint2*)(AT + c * GLA_PITCH + s0 * 2) = make_uint2(pk2(av[0], av[1]), pk2(av[2], av[3]));
            }
            __syncthreads();
            {
                const int v0 = 16 * wid;
                bf16x8 bv[2], sB[2];
#pragma unroll
                for (int kk = 0; kk < 2; ++kk) {
                    bv[kk] = *(const bf16x8*)(VT + (v0 + l15) * GLA_PITCH + 64 * kk + 16 * q4);
                    uint4 w = make_uint4(pk2(S[2 * kk][0], S[2 * kk][1]), pk2(S[2 * kk][2], S[2 * kk][3]), pk2(S[2 * kk + 1][0], S[2 * kk + 1][1]), pk2(S[2 * kk + 1][2], S[2 * kk + 1][3]));
                    sB[kk] = __builtin_bit_cast(bf16x8, w);
                }
#pragma unroll
                for (int cblk = 0; cblk < 4; ++cblk) {
                    f32x4_t acc = (f32x4_t){0.f, 0.f, 0.f, 0.f};
                    const unsigned char* arow = AT + (16 * cblk + l15) * GLA_PITCH;
                    const unsigned char* qrow = QD + (16 * cblk + l15) * GLA_PITCH;
#pragma unroll
                    for (int kk = 0; kk < 2; ++kk) {
                        if (kk == 0 || cblk >= 2) {
                            const bf16x8 a = *(const bf16x8*)(arow + 64 * kk + 16 * q4);
                            acc = __builtin_amdgcn_mfma_f32_16x16x32_bf16(a, bv[kk], acc, 0, 0, 0);
                        }
                    }
#pragma unroll
                    for (int kk = 0; kk < 2; ++kk) {
                        const uint2 a0 = *(const uint2*)(qrow + 64 * kk + 8 * q4), a1 = *(const uint2*)(qrow + 64 * kk + 32 + 8 * q4);
                        uint4 aw = make_uint4(a0.x, a0.y, a1.x, a1.y);
                        acc = __builtin_amdgcn_mfma_f32_16x16x32_bf16(__builtin_bit_cast(bf16x8, aw), sB[kk], acc, 0, 0, 0);
                    }
#pragma unroll
                    for (int r = 0; r < 4; ++r) Od[(size_t)(rbase + rsgn * (16 * cblk + 4 * q4 + r)) * 512 + h * 128 + v0 + l15] = (bf16)f2bf(acc[r]);
                }
#pragma unroll
                for (int dblk = 0; dblk < 4; ++dblk) {
#pragma unroll
                    for (int r = 0; r < 4; ++r) S[dblk][r] *= DEC[16 * dblk + 4 * q4 + r];
#pragma unroll
                    for (int kk = 0; kk < 2; ++kk) {
                        const bf16x8 a = *(const bf16x8*)(KET + (16 * dblk + l15) * GLA_PITCH + 64 * kk + 16 * q4);
                        S[dblk] = __builtin_amdgcn_mfma_f32_16x16x32_bf16(a, bv[kk], S[dblk], 0, 0, 0);
                    }
                }
            }
            if (ch + 1 < KVLEN / 64) GLA_STAGE();
            __syncthreads();
        }
    }
#undef GLA_ROWS
#undef GLA_GLOAD
#undef GLA_STAGE
}
__device__ __forceinline__ void ph_even_post(const int WIDS, bf16* __restrict__ ATT, const float* __restrict__ lamv, const float* __restrict__ subln, float lam_init,
                             const bf16* __restrict__ OF, const bf16* __restrict__ OB, const bf16* __restrict__ P, const float* __restrict__ gain) {
    const int TID = opaque_tid(WIDS), BID = opaque_bid();
    int wave = BID * NWV + (TID >> 6), lane = TID & 63;
    int nw = gridDim.x * NWV;
    float p1 = lamv[lane] * lamv[64 + lane], p2 = lamv[128 + lane] * lamv[192 + lane];
    p1 = wave_sum(p1); p2 = wave_sum(p2);
    const float lam = expf(p1) - expf(p2) + lam_init;
    const int hh = lane >> 4, cc = lane & 15;
    float sg8[8], g8[8];
    { const float4 a0 = ((const float4*)(subln + 8 * cc))[0], a1 = ((const float4*)(subln + 8 * cc))[1], b0 = ((const float4*)(gain + 8 * cc))[0], b1 = ((const float4*)(gain + 8 * cc))[1];
      sg8[0] = a0.x; sg8[1] = a0.y; sg8[2] = a0.z; sg8[3] = a0.w; sg8[4] = a1.x; sg8[5] = a1.y; sg8[6] = a1.z; sg8[7] = a1.w;
      g8[0] = b0.x; g8[1] = b0.y; g8[2] = b0.z; g8[3] = b0.w; g8[4] = b1.x; g8[5] = b1.y; g8[6] = b1.z; g8[7] = b1.w; }
    for (int r0 = wave; r0 < RT; r0 += 2 * nw) {
        const int r1 = r0 + nw < RT ? r0 + nw : r0;
        uint4 o0[2], o1[2], xf[2], xb[2], rr[2];
#pragma unroll
        for (int q = 0; q < 2; ++q) {
            const int r = q ? r1 : r0;
            const bf16* a = ATT + (size_t)r * DM + 8 * cc;
            o0[q] = *(const uint4*)(a + (2 * hh) * 128); o1[q] = *(const uint4*)(a + (2 * hh + 1) * 128);
            xf[q] = *(const uint4*)(OF + (size_t)r * 512 + hh * 128 + 8 * cc); xb[q] = *(const uint4*)(OB + (size_t)r * 512 + hh * 128 + 8 * cc);
            rr[q] = *(const uint4*)(P + (size_t)r * EVEN_LDP + 2560 + hh * 128 + 8 * cc);
        }
#pragma unroll
        for (int q = 0; q < 2; ++q) {
            if (q == 1 && r1 == r0) break;
            bf16* a = ATT + (size_t)(q ? r1 : r0) * DM + hh * 128 + 8 * cc;
            const unsigned w0[4] = {o0[q].x, o0[q].y, o0[q].z, o0[q].w}, w1[4] = {o1[q].x, o1[q].y, o1[q].z, o1[q].w};
            const unsigned wf[4] = {xf[q].x, xf[q].y, xf[q].z, xf[q].w}, wb[4] = {xb[q].x, xb[q].y, xb[q].z, xb[q].w}, wr[4] = {rr[q].x, rr[q].y, rr[q].z, rr[q].w};
            float d[8], e[8], gt[8]; float sd = 0.f, se = 0.f;
#pragma unroll
            for (int i = 0; i < 4; ++i) {
                d[2 * i] = __uint_as_float(w0[i] << 16) - lam * __uint_as_float(w1[i] << 16); d[2 * i + 1] = __uint_as_float(w0[i] & 0xffff0000u) - lam * __uint_as_float(w1[i] & 0xffff0000u);
                e[2 * i] = __uint_as_float(wf[i] << 16) + __uint_as_float(wb[i] << 16); e[2 * i + 1] = __uint_as_float(wf[i] & 0xffff0000u) + __uint_as_float(wb[i] & 0xffff0000u);
                gt[2 * i] = __uint_as_float(wr[i] << 16); gt[2 * i + 1] = __uint_as_float(wr[i] & 0xffff0000u);
                sd += d[2 * i] * d[2 * i] + d[2 * i + 1] * d[2 * i + 1]; se += e[2 * i] * e[2 * i] + e[2 * i + 1] * e[2 * i + 1];
            }
            sd += shx<1>(sd); sd += shx<2>(sd); sd += shx<4>(sd); sd += shx<8>(sd);
            se += shx<1>(se); se += shx<2>(se); se += shx<4>(se); se += shx<8>(se);
            const float rd = rsqrtf(sd * (1.f / 128.f) + 1e-6f) * (1.f - lam_init), re = rsqrtf(se * (1.f / 128.f) + 1e-6f);
            float od[8], og[8];
#pragma unroll
            for (int i = 0; i < 8; ++i) { od[i] = d[i] * rd * sg8[i]; og[i] = e[i] * re * g8[i] * (gt[i] * __builtin_amdgcn_rcpf(1.f + __expf(-gt[i]))); }
            *(uint4*)a = make_uint4(pk2(od[0], od[1]), pk2(od[2], od[3]), pk2(od[4], od[5]), pk2(od[6], od[7]));
            *(uint4*)(a + 512) = make_uint4(pk2(og[0], og[1]), pk2(og[2], og[3]), pk2(og[4], og[5]), pk2(og[6], og[7]));
        }
    }
}

#define CE_DESC(a, b) do { const unsigned hi_ = max((a), (b)); (b) = min((a), (b)); (a) = hi_; } while (0)
#define SORT16_DESC(t) do { CE_DESC(t[0], t[1]); CE_DESC(t[2], t[3]); CE_DESC(t[4], t[5]); CE_DESC(t[6], t[7]); CE_DESC(t[8], t[9]); CE_DESC(t[10], t[11]); CE_DESC(t[12], t[13]); CE_DESC(t[14], t[15]); CE_DESC(t[0], t[2]); CE_DESC(t[1], t[3]); CE_DESC(t[4], t[6]); CE_DESC(t[5], t[7]); CE_DESC(t[8], t[10]); CE_DESC(t[9], t[11]); CE_DESC(t[12], t[14]); CE_DESC(t[13], t[15]); CE_DESC(t[1], t[2]); CE_DESC(t[5], t[6]); CE_DESC(t[9], t[10]); CE_DESC(t[13], t[14]); CE_DESC(t[0], t[4]); CE_DESC(t[1], t[5]); CE_DESC(t[2], t[6]); CE_DESC(t[3], t[7]); CE_DESC(t[8], t[12]); CE_DESC(t[9], t[13]); CE_DESC(t[10], t[14]); CE_DESC(t[11], t[15]); CE_DESC(t[2], t[4]); CE_DESC(t[3], t[5]); CE_DESC(t[10], t[12]); CE_DESC(t[11], t[13]); CE_DESC(t[1], t[2]); CE_DESC(t[3], t[4]); CE_DESC(t[5], t[6]); CE_DESC(t[9], t[10]); CE_DESC(t[11], t[12]); CE_DESC(t[13], t[14]); CE_DESC(t[0], t[8]); CE_DESC(t[1], t[9]); CE_DESC(t[2], t[10]); CE_DESC(t[3], t[11]); CE_DESC(t[4], t[12]); CE_DESC(t[5], t[13]); CE_DESC(t[6], t[14]); CE_DESC(t[7], t[15]); CE_DESC(t[4], t[8]); CE_DESC(t[5], t[9]); CE_DESC(t[6], t[10]); CE_DESC(t[7], t[11]); CE_DESC(t[2], t[4]); CE_DESC(t[3], t[5]); CE_DESC(t[6], t[8]); CE_DESC(t[7], t[9]); CE_DESC(t[10], t[12]); CE_DESC(t[11], t[13]); CE_DESC(t[1], t[2]); CE_DESC(t[3], t[4]); CE_DESC(t[5], t[6]); CE_DESC(t[7], t[8]); CE_DESC(t[9], t[10]); CE_DESC(t[11], t[12]); CE_DESC(t[13], t[14]); } while (0)
#define MERGE16_DESC(a, b) do { \
    _Pragma("unroll") for (int i_ = 0; i_ < 16; ++i_) a[i_] = max(a[i_], b[15 - i_]); \
    _Pragma("unroll") for (int j_ = 8; j_ > 0; j_ >>= 1) \
    _Pragma("unroll") for (int i_ = 0; i_ < 16; ++i_) { if ((i_ & j_) == 0) CE_DESC(a[i_], a[i_ | j_]); } } while (0)
#define RT_KPITCH 144
#define INSP16(t, x) do { unsigned x_ = (x); _Pragma("unroll") for (int j_ = 0; j_ < 16; ++j_) { const unsigned h_ = max(t[j_], x_); x_ = min(t[j_], x_); t[j_] = h_; } } while (0)
#define ROUTE_SCORE_BODY(LL_) { \
        _Pragma("unroll") \
        for (int half = 0; half < 2; ++half) { \
            bf16x8 qf[4]; \
            const bf16* qrow = Qp + (size_t)row * DM + h * 128 + half * 64; \
        _Pragma("unroll") \
            for (int s = 0; s < 4; ++s) qf[s] = *(const bf16x8*)(qrow + 16 * s + 8 * hi); \
        _Pragma("unroll") \
            for (int nb = 0; nb < 4; ++nb) { \
                f32x16 acc; \
        _Pragma("unroll") \
                for (int r = 0; r < 16; ++r) acc[r] = 0.f; \
        _Pragma("unroll") \
                for (int s = 0; s < 4; ++s) { \
                    const bf16x8 a = *(const bf16x8*)(lds + (half * 128 + 32 * nb + r32) * RT_KPITCH + 32 * s + 16 * hi); \
                    acc = __builtin_amdgcn_mfma_f32_32x32x16_bf16(a, qf[s], acc, 0, 0, 0); \
                } \
                unsigned run[16]; \
        _Pragma("unroll") \
                for (int r = 0; r < 16; ++r) { \
                    unsigned ub = __float_as_uint(acc[r]); \
                    ub = (ub & 0x80000000u) ? ~ub : (ub | 0x80000000u); \
                    run[r] = (ub & ~127u) | (unsigned)(127 - (32 * nb + (r & 3) + 8 * (r >> 2)) - 4 * hi); \
                } \
                SORT16_DESC(run); \
                if (nb == 0) { \
        _Pragma("unroll") \
                    for (int j = 0; j < 16; ++j) LL_[half][j] = run[j]; \
                } else MERGE16_DESC(LL_[half], run); \
                __builtin_amdgcn_sched_barrier(0); \
            } \
            unsigned o[16]; \
        _Pragma("unroll") \
            for (int j = 0; j < 16; ++j) o[j] = xchg32(LL_[half][j], hi != 0); \
            MERGE16_DESC(LL_[half], o); \
            __builtin_amdgcn_sched_barrier(0); \
        } }
__device__ __forceinline__ void ph_route_mfma(const int WIDS, const bf16* __restrict__ Qp, const bf16* __restrict__ Kb, int* __restrict__ IDX, float* __restrict__ GATE, unsigned char* lds, int nrows) {
    const int TID = opaque_tid(WIDS), BID = opaque_bid();
    const int tid = TID, lane = tid & 63, wid = tid >> 6, r32 = lane & 31, hi = lane >> 5;
    const int nu = (nrows / 256) * 8, G = gridDim.x;
    int hcur = -1;
    for (int uA = BID; uA < nu; uA += 2 * G) {
        const int uB = uA + G; const bool pair = uB < nu;
        unsigned L[2][16];
        {
            unsigned LA[2][16];
            { const int u_ = uA; const int h = u_ & 7, row = (u_ >> 3) * 256 + wid * 32 + r32;
              if (h != hcur) { __syncthreads();
                  for (int i = tid; i < 2 * 128 * 8; i += NT) *(uint4*)(lds + (i >> 3) * RT_KPITCH + (i & 7) * 16) = *(const uint4*)(Kb + ((size_t)h * 256 + (i >> 3)) * 64 + (i & 7) * 8);
                  __syncthreads(); hcur = h; }
              ROUTE_SCORE_BODY(LA) }
#pragma unroll
            for (int x_ = 0; x_ < 2; ++x_)
#pragma unroll
                for (int j = 0; j < 16; ++j) L[x_][j] = LA[x_][j];
        }
        if (pair) {
            unsigned LB[2][16];
            { const int u_ = uB; const int h = u_ & 7, row = (u_ >> 3) * 256 + wid * 32 + r32;
              if (h != hcur) { __syncthreads();
                  for (int i = tid; i < 2 * 128 * 8; i += NT) *(uint4*)(lds + (i >> 3) * RT_KPITCH + (i & 7) * 16) = *(const uint4*)(Kb + ((size_t)h * 256 + (i >> 3)) * 64 + (i & 7) * 8);
                  __syncthreads(); hcur = h; }
              ROUTE_SCORE_BODY(LB) }
#pragma unroll
            for (int x_ = 0; x_ < 2; ++x_)
#pragma unroll
                for (int j = 0; j < 16; ++j) L[x_][j] = hi ? LB[x_][j] : L[x_][j];
        }
        const int uu = (pair && hi) ? uB : uA;
        const int h = uu & 7, row = (uu >> 3) * 256 + wid * 32 + r32;
        float v1[16], v2[16];
        {
            unsigned w1[4] = {0u, 0u, 0u, 0u}, w2[4] = {0u, 0u, 0u, 0u};
#pragma unroll
            for (int j = 0; j < 16; ++j) {
                unsigned a = L[0][j] & ~127u, b = L[1][j] & ~127u;
                a = (a & 0x80000000u) ? (a & 0x7fffffffu) : ~a; b = (b & 0x80000000u) ? (b & 0x7fffffffu) : ~b;
                v1[j] = __uint_as_float(a); v2[j] = __uint_as_float(b);
                w1[j >> 2] |= (127u - (L[0][j] & 127u)) << (8 * (j & 3)); w2[j >> 2] |= (127u - (L[1][j] & 127u)) << (8 * (j & 3));
            }
            unsigned char* sb = lds + 2 * 128 * RT_KPITCH + tid * 4;
#pragma unroll
            for (int k = 0; k < 4; ++k) { *(unsigned*)(sb + k * 2048) = w1[k]; *(unsigned*)(sb + (4 + k) * 2048) = w2[k]; }
        }
#define CAND(a, b) ({ unsigned ub_ = __float_as_uint(v1[a] + v2[b]); ub_ = (ub_ & 0x80000000u) ? ~ub_ : (ub_ | 0x80000000u); (ub_ & ~255u) | (unsigned)(255 - (16 * (a) + (b))); })
        unsigned T[16], R1[16], R2[16], R3[16];
#pragma unroll
        for (int b = 0; b < 16; ++b) T[b] = CAND(0, b);
        {
#pragma unroll
            for (int b = 0; b < 8; ++b) R1[b] = CAND(1, b);
#pragma unroll
            for (int b = 0; b < 5; ++b) R1[8 + b] = CAND(2, b);
#pragma unroll
            for (int b = 0; b < 3; ++b) R1[13 + b] = CAND(4, b);
#pragma unroll
            for (int b = 0; b < 4; ++b) R2[b] = CAND(3, b);
#pragma unroll
            for (int a = 5; a < 8; ++a) { R2[4 + 2 * (a - 5)] = CAND(a, 0); R2[5 + 2 * (a - 5)] = CAND(a, 1); }
#pragma unroll
            for (int a = 8; a < 14; ++a) R2[10 + (a - 8)] = CAND(a, 0);
            R3[0] = CAND(14, 0); R3[1] = CAND(15, 0);
#pragma unroll
            for (int j = 2; j < 16; ++j) R3[j] = 0u;
        }
        SORT16_DESC(R1); MERGE16_DESC(T, R1);
        SORT16_DESC(R2); MERGE16_DESC(T, R2);
        if (R3[0] < R3[1]) { const unsigned t_ = R3[0]; R3[0] = R3[1]; R3[1] = t_; }
        MERGE16_DESC(T, R3);
#undef CAND
        float e[16]; int bi[16]; float sum = 0.f, v0 = 0.f;
        {
            const unsigned char* sb = lds + 2 * 128 * RT_KPITCH + tid * 4;
#pragma unroll
            for (int j = 0; j < 16; ++j) {
                unsigned ub = T[j] & ~255u;
                ub = (ub & 0x80000000u) ? (ub & 0x7fffffffu) : ~ub;
                const float val = __uint_as_float(ub);
                if (j == 0) v0 = val;
                e[j] = __expf(val - v0); sum += e[j];
                const unsigned flat = 255u - (T[j] & 255u), ca = flat >> 4, cb = flat & 15u;
                const unsigned ia = *(const unsigned char*)(sb + (ca >> 2) * 2048 + (ca & 3)), ib = *(const unsigned char*)(sb + (4 + (cb >> 2)) * 2048 + (cb & 3));
                bi[j] = (int)(ia * 128u + ib);
            }
        }
        const float inv = 1.f / sum;
        if (pair || hi == 0) {
            int* ip = IDX + (size_t)row * 128 + h * 16; float* gp = GATE + (size_t)row * 128 + h * 16;
#pragma unroll
            for (int j = 0; j < 4; ++j) {
#define ROUTE_PK(k_) ((int)((cvt_pk_bf16_f32(0.f, e[k_] * inv) & 0xffff0000u) | (unsigned)bi[k_]))
                *(int4*)(ip + 4 * j) = make_int4(ROUTE_PK(4 * j), ROUTE_PK(4 * j + 1), ROUTE_PK(4 * j + 2), ROUTE_PK(4 * j + 3));
#undef ROUTE_PK
            }
        }
    }
    __syncthreads();
}
#undef ROUTE_SCORE_BODY
__device__ __forceinline__ unsigned fp6_e2m3(float v) {
    const float a = fabsf(v);
    float c;
    if (a < 2.f) c = rintf(a * 8.f);
    else if (a < 4.f) c = 16.f + rintf((a - 2.f) * 4.f);
    else c = fminf(24.f + rintf((a - 4.f) * 2.f), 31.f);
    return (unsigned)c | (v < 0.f ? 32u : 0u);
}
__device__ __forceinline__ void ph_table_prep(const int WIDS, const float* __restrict__ U, const float* __restrict__ V, unsigned char* __restrict__ T6, float* __restrict__ RS, int rr0, int rr1, int wv, int nwv) {
    const int TID = opaque_tid(WIDS);
    const int lane = TID & 63;
    const int NROWS = DEPTH * 16384;
    for (int ra = rr0 + wv; ra < rr1; ra += 2 * nwv) {
        const int rb = ra + nwv < rr1 ? ra + nwv : ra;
        float4 v2[2][4];
#pragma unroll
        for (int q = 0; q < 2; ++q) {
            const int rr = q ? rb : ra;
            const float* src = (rr < NROWS ? U : V) + (size_t)(rr < NROWS ? rr : rr - NROWS) * DM + lane * 16;
#pragma unroll
            for (int i = 0; i < 4; ++i) v2[q][i] = ((const float4*)src)[i];
        }
#pragma unroll
        for (int q = 0; q < 2; ++q) {
            if (q == 1 && rb == ra) break;
            const int rr = q ? rb : ra;
            float am = 0.f;
#pragma unroll
            for (int i = 0; i < 4; ++i) am = fmaxf(am, fmaxf(fmaxf(fabsf(v2[q][i].x), fabsf(v2[q][i].y)), fmaxf(fabsf(v2[q][i].z), fabsf(v2[q][i].w))));
            am = wave_max(am);
            am = fmaxf(am, 1e-30f);
            const float sc = exp2f(floorf(log2f(7.5f / am)));
            unsigned e[16];
#pragma unroll
            for (int i = 0; i < 4; ++i) { e[4 * i] = fp6_e2m3(v2[q][i].x * sc); e[4 * i + 1] = fp6_e2m3(v2[q][i].y * sc); e[4 * i + 2] = fp6_e2m3(v2[q][i].z * sc); e[4 * i + 3] = fp6_e2m3(v2[q][i].w * sc); }
            const unsigned d0 = e[0] | (e[1] << 6) | (e[2] << 12) | (e[3] << 18) | (e[4] << 24) | (e[5] << 30);
            const unsigned d1 = (e[5] >> 2) | (e[6] << 4) | (e[7] << 10) | (e[8] << 16) | (e[9] << 22) | (e[10] << 28);
            const unsigned d2 = (e[10] >> 4) | (e[11] << 2) | (e[12] << 8) | (e[13] << 14) | (e[14] << 20) | (e[15] << 26);
            unsigned* dst = (unsigned*)(T6 + (size_t)rr * 768 + lane * 12);
            dst[0] = d0; dst[1] = d1; dst[2] = d2;
            if (lane == 0) ((unsigned short*)RS)[(rr < NROWS ? rr : rr - NROWS) * 2 + (rr < NROWS ? 1 : 0)] = (unsigned short)(__float_as_uint(1.f / sc) >> 16);
        }
    }
}
typedef unsigned v6u32_t __attribute__((ext_vector_type(6)));
typedef float v32f_t __attribute__((ext_vector_type(32)));
typedef __bf16 v32bf_t __attribute__((ext_vector_type(32)));
typedef unsigned v16u_t __attribute__((ext_vector_type(16)));
struct u3 { unsigned x, y, z; };
typedef unsigned v3u_t __attribute__((ext_vector_type(3)));
typedef unsigned u32x4v __attribute__((ext_vector_type(4)));
typedef unsigned u32x2v __attribute__((ext_vector_type(2)));
#define BR4(j) ((((j) & 1) << 3) | (((j) & 2) << 1) | (((j) & 4) >> 1) | (((j) & 8) >> 3))
__device__ __forceinline__ void ph_peer_ffn8(const int WIDS, const bf16* A2, const int* __restrict__ IDX, const float* __restrict__ GATE,
                            const unsigned char* __restrict__ U8, const float* __restrict__ RSU, const unsigned char* __restrict__ V8, const float* __restrict__ RSV,
                            const float* __restrict__ mods_l, bf16* X, float* Xout_f32, int nrows,
                            const float* __restrict__ gnext, const float* __restrict__ mods_next, bf16* Anext) {
    const int TID = opaque_tid(WIDS), BID = opaque_bid();
    const int wave = BID * NWV + (TID >> 6), lane = TID & 63, nw = gridDim.x * NWV;
    const int jl = BR4(lane & 15);
    const unsigned lane12 = (unsigned)lane * 12u;
    for (int r = wave; r < nrows; r += nw) {
        float xf[16];
        { int lx = lane; asm volatile("" : "+v"(lx)); const u32x4v* xp = (const u32x4v*)(A2 + (size_t)r * DM + lx * 16); const u32x4v a = __builtin_nontemporal_load(xp), b = __builtin_nontemporal_load(xp + 1); const unsigned xw[8] = {a.x, a.y, a.z, a.w, b.x, b.y, b.z, b.w};
#pragma unroll
          for (int i = 0; i < 8; ++i) { xf[2 * i] = __uint_as_float(xw[i] << 16); xf[2 * i + 1] = __uint_as_float(xw[i] & 0xffff0000u); } }
        float acc[16];
#pragma unroll
        for (int k = 0; k < 16; ++k) acc[k] = 0.f;
        int rg_ = __builtin_amdgcn_readfirstlane(r); asm volatile("" : "+s"(rg_));
        int nid = *(const int*)((const unsigned char*)IDX + ((unsigned)(rg_ * 128 + jl) * 4u));
        for (int g = 0; g < 8; ++g) {
            const int myid = nid & 0xffff; const float mygate = __uint_as_float((unsigned)nid & 0xffff0000u);
            nid = *(const int*)((const unsigned char*)IDX + ((unsigned)(rg_ * 128 + ((g + 1) & 7) * 16 + jl) * 4u));
            const unsigned rs2 = *(const unsigned*)((const unsigned char*)RSU + (unsigned)myid * 4u);
            const float rsu = __uint_as_float(rs2 & 0xffff0000u), rsv = __uint_as_float(rs2 << 16);
            u3 ub[16], vb[16];
            const unsigned myoff = (unsigned)myid * 768u;
            unsigned l12 = lane12; asm("" : "+v"(l12));
#pragma unroll
            for (int j = 0; j < 16; ++j) { const unsigned so = (unsigned)__builtin_amdgcn_readlane((int)myoff, BR4(j)); const unsigned char GAS* rp = (const unsigned char GAS*)(U8 + so); asm("" : "+s"(rp)); const v3u_t t_ = *(const v3u_t GAS*)(rp + l12); ub[j].x = t_.x; ub[j].y = t_.y; ub[j].z = t_.z; }
#pragma unroll
            for (int j = 0; j < 16; ++j) { const unsigned so = (unsigned)__builtin_amdgcn_readlane((int)myoff, BR4(j)); const unsigned char GAS* rp = (const unsigned char GAS*)(V8 + so); asm("" : "+s"(rp)); const v3u_t t_ = *(const v3u_t GAS*)(rp + l12); vb[j].x = t_.x; vb[j].y = t_.y; vb[j].z = t_.z; }
            float d[16];
#pragma unroll
            for (int j = 0; j < 16; j += 2) {
                const v6u32_t src = {ub[j].x, ub[j].y, ub[j].z, ub[j + 1].x, ub[j + 1].y, ub[j + 1].z};
                const v32f_t f = __builtin_amdgcn_cvt_scalef32_pk32_f32_fp6(src, 1.0f);
                float d0 = 0.f, d1 = 0.f;
#pragma unroll
                for (int k = 0; k < 16; ++k) { d0 = __builtin_fmaf(f[k], xf[k], d0); d1 = __builtin_fmaf(f[16 + k], xf[k], d1); }
                d[j] = d0; d[j + 1] = d1;
                __builtin_amdgcn_sched_barrier(0);
            }
#define PEER_TR(st_, n_, M_) do { const bool up = (lane & (M_)) != 0; _Pragma("unroll") for (int i = 0; i < (n_); ++i) { \
                const float send = up ? d[i] : d[i + (n_)], keep = up ? d[i + (n_)] : d[i]; d[i] = keep + shx<M_>(send); } } while (0)
            PEER_TR(0, 8, 1); PEER_TR(1, 4, 2); PEER_TR(2, 2, 4); PEER_TR(3, 1, 8);
#undef PEER_TR
            float tot = d[0];
            tot += shx<16>(tot); tot = sum32(tot);
            const float w = mygate * gelu_tanh(tot * rsu) * rsv;
#pragma unroll
            for (int j = 0; j < 16; j += 2) {
                const float w0 = __int_as_float(__builtin_amdgcn_readlane(__float_as_int(w), BR4(j))), w1 = __int_as_float(__builtin_amdgcn_readlane(__float_as_int(w), BR4(j + 1)));
                const v6u32_t src = {vb[j].x, vb[j].y, vb[j].z, vb[j + 1].x, vb[j + 1].y, vb[j + 1].z};
                const v32f_t f = __builtin_amdgcn_cvt_scalef32_pk32_f32_fp6(src, 1.0f);
#pragma unroll
                for (int k = 0; k < 16; ++k) { acc[k] = __builtin_fmaf(w0, f[k], acc[k]); acc[k] = __builtin_fmaf(w1, f[16 + k], acc[k]); }
                __builtin_amdgcn_sched_barrier(0);
            }
        }
        int re = __builtin_amdgcn_readfirstlane(r); asm volatile("" : "+s"(re)); int le = lane; asm volatile("" : "+v"(le));
        const float4* g5 = (const float4*)(mods_l + (size_t)row_mod(re) * MODW + 5 * DM + le * 16);
        bf16* xrb = X + (size_t)re * DM + le * 16;
        float4 xn[4]; float ss = 0.f;
        const u32x4v xr0 = __builtin_nontemporal_load((const u32x4v*)xrb), xr1 = __builtin_nontemporal_load((const u32x4v*)xrb + 1);
        const unsigned xrw[8] = {xr0.x, xr0.y, xr0.z, xr0.w, xr1.x, xr1.y, xr1.z, xr1.w};
#pragma unroll
        for (int i = 0; i < 4; ++i) { float4 xv = make_float4(__uint_as_float(xrw[2 * i] << 16), __uint_as_float(xrw[2 * i] & 0xffff0000u), __uint_as_float(xrw[2 * i + 1] << 16), __uint_as_float(xrw[2 * i + 1] & 0xffff0000u)), gg = g5[i];
            xv.x += gg.x * acc[4 * i]; xv.y += gg.y * acc[4 * i + 1]; xv.z += gg.z * acc[4 * i + 2]; xv.w += gg.w * acc[4 * i + 3]; xn[i] = xv;
            ss += xv.x * xv.x + xv.y * xv.y + xv.z * xv.z + xv.w * xv.w; }
        if (Xout_f32) {
            float4* xo = (float4*)(Xout_f32 + (size_t)re * DM + le * 16);
#pragma unroll
            for (int i = 0; i < 4; ++i) xo[i] = xn[i];
        } else {
            const u32x4v w0 = {pk2(xn[0].x, xn[0].y), pk2(xn[0].z, xn[0].w), pk2(xn[1].x, xn[1].y), pk2(xn[1].z, xn[1].w)}, w1 = {pk2(xn[2].x, xn[2].y), pk2(xn[2].z, xn[2].w), pk2(xn[3].x, xn[3].y), pk2(xn[3].z, xn[3].w)};
            __builtin_nontemporal_store(w0, (u32x4v*)xrb); __builtin_nontemporal_store(w1, (u32x4v*)xrb + 1);
        }
        if (gnext) {
            const float rstd = rsqrtf(wave_sum(ss) * (1.f / DM) + 1e-6f);
            const float* mn = mods_next + (size_t)row_mod(re) * MODW + le * 16;
            bf16* ar = Anext + (size_t)re * DM + le * 16;
#pragma unroll
            for (int i = 0; i < 4; ++i) {
                const float4 gg = ((const float4*)(gnext + le * 16))[i], sh = ((const float4*)mn)[i], sc = ((const float4*)(mn + DM))[i];
                float4 o;
                o.x = xn[i].x * rstd * gg.x * (1.f + sc.x) + sh.x; o.y = xn[i].y * rstd * gg.y * (1.f + sc.y) + sh.y;
                o.z = xn[i].z * rstd * gg.z * (1.f + sc.z) + sh.z; o.w = xn[i].w * rstd * gg.w * (1.f + sc.w) + sh.w;
                __builtin_nontemporal_store((u32x2v){pk2(o.x, o.y), pk2(o.z, o.w)}, (u32x2v*)(ar + 4 * i));
            }
        }
    }
}
template <int N>
__device__ __forceinline__ void ph_gemm_bf16(const int WIDS, const bf16* A, const bf16* Bt, bf16* O, unsigned char* lds, int M) {
    pg8::Gemm g{A, Bt, M, N, DM}; pg8::StaticOrder S; S.init(M, N, (int)gridDim.x, opaque_bid());
    pg8::EpiBf16<0> E{O, N, nullptr, 0, 0, 1.f};
    pg8::gemm_phase<pg8::EpiBf16<0>, pg8::StaticOrder, true, true>((PG8_LAS unsigned char*)lds, g, S, E, WIDS);
}
__device__ __forceinline__ void ph_gemm_res(const int WIDS, const bf16* A, const bf16* Bt, bf16* X, const float* gate, unsigned char* lds, int M) {
    pg8::Gemm g{A, Bt, M, DM, DM}; pg8::StaticOrder S; S.init(M, DM, (int)gridDim.x, opaque_bid());
    EpiResGate E{X, gate};
    pg8::gemm_phase<EpiResGate, pg8::StaticOrder, true, true>((PG8_LAS unsigned char*)lds, g, S, E, WIDS);
}

#define XB_TMO      128
#define XB_XCNT(j)  (256  + 64 * (j))
#define XB_XSUB(j)  (1280 + 64 * (j))
#define XB_XGEN(j)  (2304 + 64 * (j))
#define XB_TOP      3328
#define XB_TOPGEN   3392
#define XCD_BAR_WORDS 3456
#define XB_SPIN_CAP (1u << 18)

__device__ __forceinline__ unsigned xb_ld(unsigned* p)              { return __hip_atomic_load(p, __ATOMIC_RELAXED, __HIP_MEMORY_SCOPE_AGENT); }
__device__ __forceinline__ unsigned xb_add(unsigned* p, unsigned v) { return __hip_atomic_fetch_add(p, v, __ATOMIC_RELAXED, __HIP_MEMORY_SCOPE_AGENT); }
__device__ __forceinline__ unsigned xb_xcc_id() { return (unsigned)__builtin_amdgcn_s_getreg((3 << 11) | 20) & 0xFu; }
#define XB_SPIN(cond, bar) do { unsigned _sp = 0; while (cond) { __builtin_amdgcn_s_sleep(1); \
    if ((++_sp & 255u) == 0u) { if (xb_ld(&(bar)[XB_TMO])) break; if (_sp > XB_SPIN_CAP) { atomicAdd(&(bar)[XB_TMO], 1u); break; } } } } while (0)

struct XcdBarrier {
    bool leader;
    unsigned* bar; unsigned x;
    volatile LAS unsigned* st;
};

__device__ __forceinline__ XcdBarrier xcd_barrier_post(unsigned* bar, volatile LAS unsigned* st, bool leader) {
    XcdBarrier b; b.leader = leader; b.bar = bar; b.x = xb_xcc_id(); b.st = st;
    if (leader) (void)xb_add(&bar[XB_XCNT(b.x)], 1u);
    return b;
}
__device__ __forceinline__ void xcd_barrier_complete(unsigned* bar, unsigned x, unsigned& nloc, unsigned& nx) {
    const unsigned G = gridDim.x * gridDim.y * gridDim.z;
    unsigned sum, cnt, mine, sp = 0u;
    for (;;) {
        sum = 0u; cnt = 0u; mine = 0u;
#pragma unroll
        for (unsigned j = 0; j < 16; ++j) { const unsigned c = xb_ld(&bar[XB_XCNT(j)]); sum += c; cnt += (c > 0u) ? 1u : 0u; mine = (j == x) ? c : mine; }
        if (sum == G) break;
        __builtin_amdgcn_s_sleep(1);
        if ((++sp & 255u) == 0u) { if (xb_ld(&bar[XB_TMO])) break; if (sp > XB_SPIN_CAP) { atomicAdd(&bar[XB_TMO], 1u); break; } }
    }
    nloc = mine > 0u ? mine : 1u; nx = cnt > 0u ? cnt : 1u;
}

__device__ __forceinline__ void xcd_barrier(const XcdBarrier& b) {
    asm volatile("s_waitcnt vmcnt(0)" ::: "memory");
    __syncthreads();
    if (b.leader) {
        unsigned* bar = b.bar;
        __builtin_amdgcn_s_waitcnt(0);
        unsigned nloc = b.st[0], nx = b.st[1];
        if (nloc == 0u) { xcd_barrier_complete(bar, b.x, nloc, nx); b.st[0] = nloc; b.st[1] = nx; }
        const unsigned old = xb_add(&bar[XB_XSUB(b.x)], 1u);
        const unsigned gen = old / nloc;
        if (old + 1u == (gen + 1u) * nloc) {
            __builtin_amdgcn_fence(__ATOMIC_RELEASE, "agent");
            asm volatile("s_waitcnt vmcnt(0)" ::: "memory");
            const unsigned og = xb_add(&bar[XB_TOP], 1u);
            const unsigned tg = og / nx;
            if (og + 1u == (tg + 1u) * nx) xb_add(&bar[XB_TOPGEN], 1u);
            else XB_SPIN(xb_ld(&bar[XB_TOPGEN]) == tg, bar);
            __builtin_amdgcn_fence(__ATOMIC_ACQUIRE, "agent");
            xb_add(&bar[XB_XGEN(b.x)], 1u);
            asm volatile("s_waitcnt vmcnt(0)" ::: "memory");
        } else {
            XB_SPIN(xb_ld(&bar[XB_XGEN(b.x)]) == gen, bar);
            __builtin_amdgcn_fence(__ATOMIC_ACQUIRE, "agent");
            asm volatile("s_waitcnt vmcnt(0)" ::: "memory");
        }
    }
    __syncthreads();
}

constexpr size_t ALIGN_UP(size_t x) { return (x + 255) & ~(size_t)255; }
constexpr size_t WS_X = 0;
constexpr size_t WS_A = WS_X + (size_t)RT * DM * 4;
constexpr size_t WS_P = WS_A + (size_t)RT * DM * 2;
constexpr size_t WS_ATT = WS_P + (size_t)RT * EVEN_LDP * 2;
constexpr size_t WS_OF = WS_ATT + (size_t)RT * DM * 2;
constexpr size_t WS_MODS = WS_OF + (size_t)RT * 512 * 4 * 2;
constexpr size_t WS_ROPE = WS_MODS + ALIGN_UP((size_t)DEPTH * NMOD * MODW * 4);
constexpr size_t WS_WINE = WS_ROPE + (size_t)SEQ * 32 * 8;
constexpr size_t WS_WOUTE = WS_WINE + (size_t)2 * EVEN_LDP * DM * 2;
constexpr size_t WS_WINO = WS_WOUTE + (size_t)2 * DM * DM * 2;
constexpr size_t WS_WOUTO = WS_WINO + (size_t)2 * ODD_IN * DM * 2;
constexpr size_t WS_WPQ = WS_WOUTO + (size_t)2 * DM * DM * 2;
constexpr size_t WS_T8 = WS_WPQ + (size_t)4 * DM * DM * 2;
constexpr size_t WS_RS = WS_T8 + (size_t)2 * DEPTH * 16384 * DM;
constexpr size_t WS_KC = WS_RS + (size_t)2 * DEPTH * 16384 * 4;
constexpr size_t WS_VT = WS_KC + (size_t)NB * 8 * KVLEN * 64 * 2;
constexpr size_t WS_KEYS = WS_VT + (size_t)NB * 4 * 128 * KVLEN * 2;
constexpr size_t WS_BAR = WS_KEYS + (size_t)DEPTH * 8 * 2 * 128 * 64 * 2;
constexpr size_t WS_BAR_BYTES = 16384;
constexpr size_t WS_END = WS_BAR + WS_BAR_BYTES;

__global__ void __launch_bounds__(NT, 2) __attribute__((target("no-packed-fp32-ops"))) mega(Params p) {
    extern __shared__ __attribute__((aligned(16))) unsigned char lds[];
    float* smem = (float*)lds;
    cg::grid_group grid = cg::this_grid();
    unsigned char* ws = (unsigned char*)(unsigned char GAS*)p.ws;
    int wid_s = __builtin_amdgcn_readfirstlane((int)threadIdx.x >> 6);
    asm volatile("" : "+s"(wid_s));
#define MYTID() opaque_tid(wid_s)
    volatile LAS unsigned* bst = (volatile LAS unsigned*)((LAS unsigned char*)lds + 131072 + 512);
    if (MYTID() < 2) bst[MYTID()] = 0u;
    __syncthreads();
    (void)xcd_barrier_post((unsigned*)(ws + WS_BAR), bst, MYTID() == 0);
#define GSYNC() do { XcdBarrier b_; b_.leader = (MYTID() == 0); b_.bar = (unsigned*)(ws + WS_BAR); b_.x = xb_xcc_id(); b_.st = (volatile LAS unsigned*)((LAS unsigned char*)lds + 131072 + 512); xcd_barrier(b_); } while (0)
#define X_ ((bf16*)(ws + WS_X))
#define A_ ((bf16*)(ws + WS_A))
#define P_ ((bf16*)(ws + WS_P))
#define ATT_ ((bf16*)(ws + WS_ATT))
#define OF_ ((bf16*)(ws + WS_OF))
#define OB_ (OF_ + (size_t)RT * 512)
#define MODS_ ((float*)(ws + WS_MODS))
#define ROPE_ ((float2*)(ws + WS_ROPE))
#define WINE_ ((bf16*)(ws + WS_WINE))
#define WOUTE_ ((bf16*)(ws + WS_WOUTE))
#define WINO_ ((bf16*)(ws + WS_WINO))
#define WOUTO_ ((bf16*)(ws + WS_WOUTO))
#define WPQ_ ((bf16*)(ws + WS_WPQ))
#define QP_ P_
#define KEYS_ ((bf16*)(ws + WS_KEYS))
#define KC_ ((bf16*)(ws + WS_KC))
#define VT_ ((bf16*)(ws + WS_VT))
#define T8_ (ws + WS_T8)
#define RS_ ((float*)(ws + WS_RS))
#define IDX_ ((int*)(ws + WS_P + (size_t)RT * DM * 2))
#define GATE_ ((float*)(ws + WS_P + (size_t)RT * DM * 2 + (size_t)RT * 128 * 4))

    ph_rope_table(wid_s, ROPE_);
    ph_weight_prep(wid_s, p.in, WINE_, WOUTE_, WINO_, WOUTO_, WPQ_, KEYS_, lds);
    {
        const int G_ = (int)gridDim.x, wv_ = (int)blockIdx.x * NWV + wid_s, nwv_ = G_ * NWV, NR_ = DEPTH * 16384;
        if (G_ == 256) { ph_table_prep(wid_s, p.in[25], p.in[26], T8_, RS_, 0, 16384, wv_, nwv_); ph_table_prep(wid_s, p.in[25], p.in[26], T8_, RS_, NR_, NR_ + 16384, wv_, nwv_); }
        else ph_table_prep(wid_s, p.in[25], p.in[26], T8_, RS_, 0, 2 * NR_, wv_, nwv_);
    }
    __syncthreads();
    ph_mods(wid_s, p.in[1], p.in[3], p.in[4], p.in[5], MODS_, smem);
    grid.sync();
    ph_norm_mod(wid_s, p.in[0], p.in[2], nullptr, X_, p.in[6], MODS_, 0, A_, RT);
    GSYNC();
    for (int hl = 0; hl < 2 * DEPTH; ++hl) {
        { unsigned long long wsi_ = (unsigned long long)p.ws; asm volatile("" : "+s"(wsi_)); ws = (unsigned char*)(unsigned char GAS*)wsi_; }
        const int l = hl >> 1, part = hl & 1, i = l >> 1, odd = l & 1;
        const float* mods_l = MODS_ + (size_t)l * NMOD * MODW;
        if (part) {
            ph_norm_mod(wid_s, nullptr, nullptr, X_, nullptr, p.in[7] + l * DM, mods_l, 3, A_, l == DEPTH - 1 ? RL : RT);
            GSYNC();
        }
        if (part) ph_gemm_bf16<DM>(wid_s, A_, WPQ_ + (size_t)l * DM * DM, P_, lds, l == DEPTH - 1 ? RL : RT);
        else if (odd) ph_gemm_bf16<ODD_IN>(wid_s, A_, WINO_ + (size_t)i * ODD_IN * DM, P_, lds, RT);
        else ph_gemm_bf16<EVEN_LDP>(wid_s, A_, WINE_ + (size_t)i * EVEN_LDP * DM, P_, lds, RT);
        if (part && l + 1 < DEPTH && gridDim.x == 256 && blockIdx.x >= 64)
            ph_table_prep(wid_s, p.in[25], p.in[26], T8_, RS_, DEPTH * 16384 + (l + 1) * 16384, DEPTH * 16384 + (l + 2) * 16384, ((int)blockIdx.x - 64) * NWV + wid_s, 192 * NWV);
        GSYNC();
        if (part == 0) {
            const int ldp = odd ? ODD_IN : EVEN_LDP;
            ph_post(wid_s, P_, ldp, 0  , odd ? 1024 : 512, odd ? 4 : 8, odd ? 1280 : 1024, odd ? 256 : 512, odd ? 64 : 128,
                    (odd ? p.in[21] : p.in[10]) + i * 64, (odd ? p.in[22] : p.in[11]) + i * 64, ROPE_, KC_, VT_);
            GSYNC();
            if (!odd) {
                const int G_ = (int)gridDim.x, bid_ = (int)blockIdx.x;
                const int gu = (G_ == 256) ? (((bid_ >> 3) < 16) ? (bid_ & 7) * 16 + (bid_ >> 3) : -1) : bid_;
                ph_gla_chunk(wid_s, P_, p.in[14] + i * 16 * 256, p.in[15] + i * 256, p.in[16] + i * 16 * 256, p.in[17] + i * 256, OF_, OB_, lds, gu, (G_ == 256) ? 1 << 20 : G_);
            }
            ph_attn_mfma(wid_s, P_, ldp, KC_, VT_, ATT_, odd, l < DEPTH - 1, lds, (odd ? p.in[21] : p.in[10]) + i * 64, (odd ? p.in[22] : p.in[11]) + i * 64, ROPE_);
            GSYNC();
            if (!odd) {
                const float lam_init = 0.8f - 0.6f * expf(-0.3f * (float)l);
                ph_even_post(wid_s, ATT_, p.in[12] + i * 256, p.in[13] + i * 128, lam_init, OF_, OB_, P_, p.in[18] + i * 128);
                GSYNC();
            }
            ph_gemm_res(wid_s, ATT_, odd ? WOUTO_ + (size_t)i * DM * DM : WOUTE_ + (size_t)i * DM * DM, X_, mods_l + 2 * DM, lds, l == DEPTH - 1 ? RL : RT);
            if (l + 1 < DEPTH && gridDim.x == 256 && blockIdx.x >= 64)
                ph_table_prep(wid_s, p.in[25], p.in[26], T8_, RS_, (l + 1) * 16384, (l + 2) * 16384, ((int)blockIdx.x - 64) * NWV + wid_s, 192 * NWV);
            GSYNC();
        } else {
            const int last = (l == DEPTH - 1);
            const int nrows = last ? RL : RT;
            ph_route_mfma(wid_s, QP_, KEYS_ + (size_t)l * 8 * 2 * 128 * 64, IDX_, GATE_, lds, nrows);
            GSYNC();
            ph_peer_ffn8(wid_s, A_, IDX_, GATE_, T8_ + (size_t)l * 16384 * 768, RS_ + l * 16384, T8_ + (size_t)(DEPTH + l) * 16384 * 768, RS_ + (DEPTH + l) * 16384, mods_l,
                         X_, last ? p.out : nullptr, nrows, last ? nullptr : p.in[6] + (l + 1) * DM, mods_l + NMOD * MODW, A_);
            if (!last) GSYNC();
        }
    }
}

extern "C" void kernel_launch(void* const* d_in, const int* in_sizes, int n_in, void* d_out, int out_size, void* d_ws, size_t ws_size, hipStream_t stream) {
    static int grid_blocks = 0;
    if (!grid_blocks) {
        int dev = 0, cus = 0, per_cu = 0;
        (void)hipGetDevice(&dev);
        (void)hipDeviceGetAttribute(&cus, hipDeviceAttributeMultiprocessorCount, dev);
        (void)hipFuncSetAttribute((const void*)mega, hipFuncAttributeMaxDynamicSharedMemorySize, LDS_BYTES);
        (void)hipOccupancyMaxActiveBlocksPerMultiprocessor(&per_cu, mega, NT, LDS_BYTES);
        if (per_cu < 1) fprintf(stderr, "occupancy query says %d blocks/CU\n", per_cu);
        grid_blocks = cus;
        if (ws_size < WS_END) fprintf(stderr, "workspace too small: %zu < %zu\n", ws_size, (size_t)WS_END);
    }
    (void)hipMemsetAsync((unsigned char*)d_ws + WS_BAR, 0, WS_BAR_BYTES, stream);
    Params p{};
    for (int i = 0; i < 27; ++i) p.in[i] = (const float*)d_in[i];
    p.out = (float*)d_out; p.ws = (unsigned char*)d_ws;
    void* args[] = {&p};
    hipError_t e = hipLaunchCooperativeKernel((void*)mega, dim3(grid_blocks), dim3(NT), args, LDS_BYTES, stream);
    if (e != hipSuccess) fprintf(stderr, "cooperative launch failed: %s (grid %d)\n", hipGetErrorString(e), grid_blocks);
}
```
